# Optimizing an MI355X kernel written in HIP

```python
import math
import jax
import jax.numpy as jnp
from jax import lax
import numpy as np

D_MODEL = 1024
BATCH = 4
SEQ = 4096
DEPTH = 2

GRID_W = 64
CTX_LEN = 256
Q_BLOCK = 128
NORM_EPS = 1e-6
ROPE_BASE = 10000.0

LRU_WIDTH = 512
LRU_BLOCKS = 8
LRU_BLOCK_W = LRU_WIDTH // LRU_BLOCKS
LRU_C = 8.0
CONV_W = 4
CONV_PAD_L = 2
LRU_A_MIN = 0.9
LRU_A_MAX = 0.999

MLA_HEADS = 4
MLA_Q_RANK = 384
MLA_KV_RANK = 256
MLA_NOPE = 128
MLA_ROPE = 64
MLA_V = 128
MLA_QK = MLA_NOPE + MLA_ROPE

EVEN_IN = 2 * LRU_WIDTH + MLA_Q_RANK + MLA_KV_RANK + MLA_ROPE
EVEN_MIX = LRU_WIDTH + MLA_HEADS * MLA_V

DIFF_HEADS = 8
DIFF_HEAD_DIM = 64
DIFF_V = 2 * DIFF_HEAD_DIM
ODD_IN = 3 * DIFF_HEADS * 2 * DIFF_HEAD_DIM
ODD_MIX = DIFF_HEADS * DIFF_V

N_EXPERTS = 32
TOP_K = 4
D_FF = 1024
SWIGLU_LIMIT = 7.0
SWIGLU_ALPHA = 1.702
MOE_BLOCK = 128

N_EVEN = (DEPTH + 1) // 2
N_ODD = DEPTH // 2

kernel_name = "hybrid_rglru_mla_diffattn_moe_dit"

F32 = jnp.float32


def _normal(key, shape, scale):
    return jax.random.normal(key, shape, F32) * scale


def rms_norm(x, g):
    xf = x.astype(F32)
    y = xf * lax.rsqrt(jnp.mean(xf * xf, axis=-1, keepdims=True) + NORM_EPS)
    return (y * g.astype(F32)).astype(x.dtype)


def axial_rope_tables(n_tokens, rot_dim):
    n_rows = n_tokens // GRID_W
    rows = jnp.repeat(jnp.arange(n_rows, dtype=F32), GRID_W)
    cols = jnp.tile(jnp.arange(GRID_W, dtype=F32), n_rows)
    axis_dim = rot_dim // 2
    inv_freq = ROPE_BASE ** (-jnp.arange(0, axis_dim, 2, dtype=F32) / axis_dim)
    ang_r = rows[:, None] * inv_freq
    ang_c = cols[:, None] * inv_freq
    ang = jnp.concatenate([ang_r, ang_r, ang_c, ang_c], axis=-1)
    return jnp.cos(ang), jnp.sin(ang)


def apply_axial_rope(x, cos, sin):
    r = x.shape[-1]
    quarter = r // 4
    xf = x.astype(F32)
    xs = xf.reshape(x.shape[:-1] + (2, 2, quarter))
    rot = jnp.stack([-xs[..., 1, :], xs[..., 0, :]], axis=-2).reshape(x.shape)
    bshape = (1, x.shape[1]) + (1,) * (x.ndim - 3) + (r,)
    return (xf * cos.reshape(bshape) + rot * sin.reshape(bshape)).astype(x.dtype)


def _to_q_blocks(q):
    b, h, s, d = q.shape
    return jnp.moveaxis(q.reshape(b, h, s // Q_BLOCK, Q_BLOCK, d), 2, 0)


def _from_q_blocks(o):
    nb, b, h, qb, d = o.shape
    return jnp.moveaxis(o, 0, 2).reshape(b, h, nb * qb, d)


def attend(q, k, v):
    scale = q.shape[-1] ** -0.5

    def one(qi):
        s = jnp.einsum('bhqd,bhkd->bhqk', qi, k).astype(F32) * scale
        p = jax.nn.softmax(s, axis=-1)
        return jnp.einsum('bhqk,bhkd->bhqd', p.astype(v.dtype), v)

    return _from_q_blocks(lax.map(one, _to_q_blocks(q)))


def diff_attend(q1, q2, k1, k2, v, lam):
    scale = q1.shape[-1] ** -0.5

    def one(qs):
        a, b = qs
        p1 = jax.nn.softmax(jnp.einsum('bhqd,bhkd->bhqk', a, k1).astype(F32) * scale, axis=-1)
        p2 = jax.nn.softmax(jnp.einsum('bhqd,bhkd->bhqk', b, k2).astype(F32) * scale, axis=-1)
        return jnp.einsum('bhqk,bhkd->bhqd', (p1 - lam * p2).astype(v.dtype), v)

    return _from_q_blocks(lax.map(one, (_to_q_blocks(q1), _to_q_blocks(q2))))


def heads_to_tokens(o):
    b, h, s, d = o.shape
    return o.transpose(0, 2, 1, 3).reshape(b, s, h * d)


def centred_dwconv(x, w, b):
    y = lax.conv_general_dilated(
        x, w[:, None, :], window_strides=(1,),
        padding=[(CONV_PAD_L, CONV_W - 1 - CONV_PAD_L)],
        dimension_numbers=('NWC', 'WIO', 'NWC'),
        feature_group_count=x.shape[-1])
    return y + b


def rglru_coeffs(xr, wa, ba, wx, bx, lam):
    b, l, w = xr.shape
    xb = xr.reshape(b, l, LRU_BLOCKS, LRU_BLOCK_W)
    r = jax.nn.sigmoid((jnp.einsum('blnd,nde->blne', xb, wa).reshape(b, l, w) + ba).astype(F32))
    i = jax.nn.sigmoid((jnp.einsum('blnd,nde->blne', xb, wx).reshape(b, l, w) + bx).astype(F32))
    log_a = -LRU_C * r * jax.nn.softplus(-lam.astype(F32))
    a = jnp.exp(log_a)
    u = jnp.sqrt(-jnp.expm1(2.0 * log_a)) * i * xr.astype(F32)
    return a, u


def linear_scan(a, u, h0, reverse):
    if reverse:
        a, u = jnp.flip(a, 1), jnp.flip(u, 1)

    def comb(left, right):
        return left[0] * right[0], right[0] * left[1] + right[1]

    a_cum, h = lax.associative_scan(comb, (a, u), axis=1)
    if h0 is not None:
        h = h + a_cum * h0[:, None, :]
    return jnp.flip(h, 1) if reverse else h


def _rope_tail(t, rope):
    cos, sin = rope
    return jnp.concatenate([t[..., :MLA_NOPE], apply_axial_rope(t[..., MLA_NOPE:], cos, sin)], axis=-1)


def mla_q(q_lat, q_norm_g, w_uq, qn_g, rope):
    b, l, _ = q_lat.shape
    q = (rms_norm(q_lat, q_norm_g) @ w_uq).reshape(b, l, MLA_HEADS, MLA_QK)
    q = rms_norm(q, qn_g)
    if rope is not None:
        q = _rope_tail(q, rope)
    return q.transpose(0, 2, 1, 3)


def mla_kv(kv_lat, k_rope, kv_norm_g, w_ukv, kn_g, rope):
    b, l, _ = kv_lat.shape
    kv = (rms_norm(kv_lat, kv_norm_g) @ w_ukv).reshape(b, l, MLA_HEADS, MLA_NOPE + MLA_V)
    k_nope, v = jnp.split(kv, [MLA_NOPE], axis=-1)
    k_r = jnp.broadcast_to(k_rope[:, :, None, :], (b, l, MLA_HEADS, MLA_ROPE))
    k = rms_norm(jnp.concatenate([k_nope, k_r], axis=-1), kn_g)
    if rope is not None:
        k = _rope_tail(k, rope)
    return k.transpose(0, 2, 1, 3), v.transpose(0, 2, 1, 3)


def lru_mla_mixer(hl, hc, w_in, w_out, conv_w, conv_b, wa, ba, wx, bx, lam,
                  q_norm_g, w_uq, kv_norm_g, w_ukv, qn_g, kn_g, need_ctx_out):
    splits = [LRU_WIDTH, 2 * LRU_WIDTH, 2 * LRU_WIDTH + MLA_Q_RANK,
              2 * LRU_WIDTH + MLA_Q_RANK + MLA_KV_RANK]
    gl, rl, qcl, kvcl, krl = jnp.split(hl @ w_in, splits, axis=-1)
    gc, rc, qcc, kvcc, krc = jnp.split(hc @ w_in, splits, axis=-1)

    xl = centred_dwconv(rl, conv_w, conv_b)
    xc = centred_dwconv(rc, conv_w, conv_b)
    rec_l, rec_c = [], []
    for d, rev in enumerate((False, True)):
        ac, uc = rglru_coeffs(xc, wa[d], ba[d], wx[d], bx[d], lam[d])
        hcs = linear_scan(ac, uc, None, rev)
        h0 = hcs[:, 0] if rev else hcs[:, -1]
        al, ul = rglru_coeffs(xl, wa[d], ba[d], wx[d], bx[d], lam[d])
        rec_l.append(linear_scan(al, ul, h0, rev))
        rec_c.append(hcs)
    lru_l = jax.nn.gelu(gl) * (rec_l[0] + rec_l[1]).astype(hl.dtype)

    rope = axial_rope_tables(hl.shape[1], MLA_ROPE)
    kl, vl = mla_kv(kvcl, krl, kv_norm_g, w_ukv, kn_g, rope)
    kc, vc = mla_kv(kvcc, krc, kv_norm_g, w_ukv, kn_g, None)
    ql = mla_q(qcl, q_norm_g, w_uq, qn_g, rope)
    mla_l = attend(ql, jnp.concatenate([kc, kl], axis=2), jnp.concatenate([vc, vl], axis=2))
    out_l = jnp.concatenate([lru_l, heads_to_tokens(mla_l)], axis=-1) @ w_out
    if not need_ctx_out:
        return out_l, None

    lru_c = jax.nn.gelu(gc) * (rec_c[0] + rec_c[1]).astype(hc.dtype)
    qc = mla_q(qcc, q_norm_g, w_uq, qn_g, None)
    mla_c = attend(qc, kc, vc)
    out_c = jnp.concatenate([lru_c, heads_to_tokens(mla_c)], axis=-1) @ w_out
    return out_l, out_c


def diff_mixer(hl, hc, w_in, w_out, qn_g, kn_g, lq1, lk1, lq2, lk2, subln_g, lam_init, need_ctx_out):
    def qkv(z, rope):
        b, l, _ = z.shape
        q, k, v = jnp.split(z, 3, axis=-1)
        q = rms_norm(q.reshape(b, l, DIFF_HEADS, 2, DIFF_HEAD_DIM), qn_g)
        k = rms_norm(k.reshape(b, l, DIFF_HEADS, 2, DIFF_HEAD_DIM), kn_g)
        if rope is not None:
            q = apply_axial_rope(q, *rope)
            k = apply_axial_rope(k, *rope)
        q = q.transpose(0, 2, 1, 3, 4)
        k = k.transpose(0, 2, 1, 3, 4)
        v = v.reshape(b, l, DIFF_HEADS, DIFF_V).transpose(0, 2, 1, 3)
        return q, k, v

    lam = (jnp.exp(jnp.sum(lq1.astype(F32) * lk1.astype(F32)))
           - jnp.exp(jnp.sum(lq2.astype(F32) * lk2.astype(F32))) + lam_init)

    def finish(o):
        o = rms_norm(o, subln_g) * (1.0 - lam_init)
        return heads_to_tokens(o) @ w_out

    rope = axial_rope_tables(hl.shape[1], DIFF_HEAD_DIM)
    ql, kl, vl = qkv(hl @ w_in, rope)
    qc, kc, vc = qkv(hc @ w_in, None)
    k_all = jnp.concatenate([kc, kl], axis=2)
    v_all = jnp.concatenate([vc, vl], axis=2)
    out_l = finish(diff_attend(ql[..., 0, :], ql[..., 1, :], k_all[..., 0, :], k_all[..., 1, :], v_all, lam))
    if not need_ctx_out:
        return out_l, None
    out_c = finish(diff_attend(qc[..., 0, :], qc[..., 1, :], kc[..., 0, :], kc[..., 1, :], vc, lam))
    return out_l, out_c


def moe_ffn(h, router_w, router_b, w_gu, b_gu, w_down, b_down):
    t, d = h.shape
    logits = (h @ router_w).astype(F32) + router_b.astype(F32)
    top_logit, top_e = lax.top_k(logits, TOP_K)
    top_w = jax.nn.softmax(top_logit, axis=-1)

    n_assign = t * TOP_K
    flat_e = top_e.reshape(-1)
    flat_tok = jnp.arange(n_assign, dtype=jnp.int32) // TOP_K
    flat_w = top_w.reshape(-1)
    order = jnp.argsort(flat_e)
    se = flat_e[order]
    counts = jnp.bincount(flat_e, length=N_EXPERTS)
    padded = (counts + MOE_BLOCK - 1) // MOE_BLOCK * MOE_BLOCK
    starts = jnp.cumsum(counts) - counts
    pends = jnp.cumsum(padded)
    pstarts = pends - padded
    dest = pstarts[se] + jnp.arange(n_assign, dtype=jnp.int32) - starts[se]

    n_blocks = -(-n_assign // MOE_BLOCK) + N_EXPERTS
    n_rows = n_blocks * MOE_BLOCK
    row_tok = jnp.zeros((n_rows,), jnp.int32).at[dest].set(flat_tok[order])
    row_w = jnp.zeros((n_rows,), F32).at[dest].set(flat_w[order])
    block_start = jnp.arange(n_blocks, dtype=jnp.int32) * MOE_BLOCK
    block_e = jnp.minimum(jnp.searchsorted(pends, block_start, side='right'), N_EXPERTS - 1)
    xs = h[row_tok].reshape(n_blocks, MOE_BLOCK, d)

    def expert_block(args):
        xb, e = args
        gu = xb @ w_gu[e] + b_gu[e]
        g, u = jnp.split(gu, 2, axis=-1)
        g = jnp.minimum(g, SWIGLU_LIMIT)
        u = jnp.clip(u, -SWIGLU_LIMIT, SWIGLU_LIMIT)
        act = (u + 1.0) * g * jax.nn.sigmoid(SWIGLU_ALPHA * g)
        return act @ w_down[e] + b_down[e]

    ys = lax.map(expert_block, (xs, block_e)).reshape(n_rows, d)
    out = jax.ops.segment_sum(ys.astype(F32) * row_w[:, None], row_tok, num_segments=t)
    return out.astype(h.dtype)


def setup_inputs(seed: int = 0) -> dict:
    key = jax.random.key(seed)
    ks = jax.random.split(key, 40)
    d = D_MODEL
    gain = lambda k, shape: 1.0 + _normal(k, shape, 0.02)
    a0 = jax.random.uniform(ks[16], (N_EVEN, 2, LRU_WIDTH), F32, LRU_A_MIN, LRU_A_MAX)
    s = a0 ** (1.0 / LRU_C)
    lru_lambda = jnp.log(s) - jnp.log1p(-s)
    return {
        "x": _normal(ks[0], (BATCH, SEQ, d), 1.0),
        "c": _normal(ks[1], (BATCH, d), 1.0),
        "ctx": _normal(ks[2], (BATCH, CTX_LEN, d), 1.0),
        "c_ctx": _normal(ks[3], (d,), 1.0),
        "mod_w": _normal(ks[4], (DEPTH, d, 6 * d), 0.5 * d ** -0.5),
        "mod_b": _normal(ks[5], (DEPTH, 6 * d), 0.02),
        "norm1_g": gain(ks[6], (DEPTH, d)),
        "norm2_g": gain(ks[7], (DEPTH, d)),
        "ev_w_in": _normal(ks[8], (N_EVEN, d, EVEN_IN), d ** -0.5),
        "ev_w_out": _normal(ks[9], (N_EVEN, EVEN_MIX, d), EVEN_MIX ** -0.5),
        "lru_conv_w": _normal(ks[10], (N_EVEN, CONV_W, LRU_WIDTH), CONV_W ** -0.5),
        "lru_conv_b": _normal(ks[11], (N_EVEN, LRU_WIDTH), 0.01),
        "lru_wa": _normal(ks[12], (N_EVEN, 2, LRU_BLOCKS, LRU_BLOCK_W, LRU_BLOCK_W), LRU_BLOCK_W ** -0.5),
        "lru_ba": _normal(ks[13], (N_EVEN, 2, LRU_WIDTH), 0.01),
        "lru_wx": _normal(ks[14], (N_EVEN, 2, LRU_BLOCKS, LRU_BLOCK_W, LRU_BLOCK_W), LRU_BLOCK_W ** -0.5),
        "lru_bx": _normal(ks[15], (N_EVEN, 2, LRU_WIDTH), 0.01),
        "lru_lambda": lru_lambda,
        "mla_q_norm_g": gain(ks[17], (N_EVEN, MLA_Q_RANK)),
        "mla_w_uq": _normal(ks[18], (N_EVEN, MLA_Q_RANK, MLA_HEADS * MLA_QK), MLA_Q_RANK ** -0.5),
        "mla_kv_norm_g": gain(ks[19], (N_EVEN, MLA_KV_RANK)),
        "mla_w_ukv": _normal(ks[20], (N_EVEN, MLA_KV_RANK, MLA_HEADS * (MLA_NOPE + MLA_V)), MLA_KV_RANK ** -0.5),
        "mla_qn_g": gain(ks[21], (N_EVEN, MLA_QK)),
        "mla_kn_g": gain(ks[22], (N_EVEN, MLA_QK)),
        "od_w_in": _normal(ks[23], (N_ODD, d, ODD_IN), d ** -0.5),
        "od_w_out": _normal(ks[24], (N_ODD, ODD_MIX, d), ODD_MIX ** -0.5),
        "diff_qn_g": gain(ks[25], (N_ODD, DIFF_HEAD_DIM)),
        "diff_kn_g": gain(ks[26], (N_ODD, DIFF_HEAD_DIM)),
        "diff_lq1": _normal(ks[27], (N_ODD, DIFF_HEAD_DIM), 0.1),
        "diff_lk1": _normal(ks[28], (N_ODD, DIFF_HEAD_DIM), 0.1),
        "diff_lq2": _normal(ks[29], (N_ODD, DIFF_HEAD_DIM), 0.1),
        "diff_lk2": _normal(ks[30], (N_ODD, DIFF_HEAD_DIM), 0.1),
        "diff_subln_g": gain(ks[31], (N_ODD, DIFF_V)),
        "router_w": _normal(ks[32], (DEPTH, d, N_EXPERTS), d ** -0.5),
        "router_b": _normal(ks[33], (DEPTH, N_EXPERTS), 0.01),
        "moe_w_gu": _normal(ks[34], (DEPTH, N_EXPERTS, d, 2 * D_FF), d ** -0.5),
        "moe_b_gu": _normal(ks[35], (DEPTH, N_EXPERTS, 2 * D_FF), 0.01),
        "moe_w_down": _normal(ks[36], (DEPTH, N_EXPERTS, D_FF, d), D_FF ** -0.5),
        "moe_b_down": _normal(ks[37], (DEPTH, N_EXPERTS, d), 0.01),
    }


def reference(x, c, ctx, c_ctx, mod_w, mod_b, norm1_g, norm2_g,
              ev_w_in, ev_w_out, lru_conv_w, lru_conv_b, lru_wa, lru_ba, lru_wx, lru_bx, lru_lambda,
              mla_q_norm_g, mla_w_uq, mla_kv_norm_g, mla_w_ukv, mla_qn_g, mla_kn_g,
              od_w_in, od_w_out, diff_qn_g, diff_kn_g, diff_lq1, diff_lk1, diff_lq2, diff_lk2, diff_subln_g,
              router_w, router_b, moe_w_gu, moe_b_gu, moe_w_down, moe_b_down):
    b, s, d = x.shape
    xl, xc = x, ctx
    for layer in range(DEPTH):
        last = layer == DEPTH - 1
        mod_l = jax.nn.silu(c) @ mod_w[layer] + mod_b[layer]
        mod_c = jax.nn.silu(c_ctx) @ mod_w[layer] + mod_b[layer]
        sh1, sc1, g1, sh2, sc2, g2 = jnp.split(mod_l[:, None, :], 6, axis=-1)
        csh1, csc1, cg1, csh2, csc2, cg2 = jnp.split(mod_c, 6, axis=-1)

        hl = rms_norm(xl, norm1_g[layer]) * (1.0 + sc1) + sh1
        hc = rms_norm(xc, norm1_g[layer]) * (1.0 + csc1) + csh1
        i = layer // 2
        if layer % 2 == 0:
            ml, mc = lru_mla_mixer(hl, hc, ev_w_in[i], ev_w_out[i], lru_conv_w[i], lru_conv_b[i],
                                   lru_wa[i], lru_ba[i], lru_wx[i], lru_bx[i], lru_lambda[i],
                                   mla_q_norm_g[i], mla_w_uq[i], mla_kv_norm_g[i], mla_w_ukv[i],
                                   mla_qn_g[i], mla_kn_g[i], not last)
        else:
            lam_init = 0.8 - 0.6 * math.exp(-0.3 * layer)
            ml, mc = diff_mixer(hl, hc, od_w_in[i], od_w_out[i], diff_qn_g[i], diff_kn_g[i],
                                diff_lq1[i], diff_lk1[i], diff_lq2[i], diff_lk2[i], diff_subln_g[i],
                                lam_init, not last)
        xl = xl + g1 * ml
        hl2 = rms_norm(xl, norm2_g[layer]) * (1.0 + sc2) + sh2
        moe_args = (router_w[layer], router_b[layer], moe_w_gu[layer], moe_b_gu[layer],
                    moe_w_down[layer], moe_b_down[layer])
        if last:
            fl = moe_ffn(hl2.reshape(b * s, d), *moe_args)
            xl = xl + g2 * fl.reshape(b, s, d)
        else:
            xc = xc + cg1 * mc
            hc2 = rms_norm(xc, norm2_g[layer]) * (1.0 + csc2) + csh2
            f = moe_ffn(jnp.concatenate([hl2.reshape(b * s, d), hc2.reshape(-1, d)], axis=0), *moe_args)
            xl = xl + g2 * f[:b * s].reshape(b, s, d)
            xc = xc + cg2 * f[b * s:].reshape(xc.shape)
    return xl
```

```cpp
#include <hip/hip_runtime.h>
#include <cstdio>
#include <cstdint>

typedef unsigned short bf16;
typedef unsigned u32x4 __attribute__((ext_vector_type(4)));
typedef float f32x4 __attribute__((ext_vector_type(4)));

constexpr int D = 1024, NB = 4, SEQ = 4096, CTX = 256, SU = SEQ + CTX, R = NB * SU;
constexpr int GRID_W = 64;
constexpr int LRU_W = 512, LRU_NB = 8, LRU_BW = 64;
constexpr int MLA_H = 4, MLA_QR = 384, MLA_KVR = 256, MLA_NOPE = 128, MLA_ROPE = 64, MLA_V = 128, MLA_QK = 192;
constexpr int EVEN_IN = 1728, EVEN_IN_P = 1792;
constexpr int DIFF_H = 8, ODD_IN = 3072;
constexpr int NE = 32, TOPK = 4, DFF = 1024;
constexpr float EPS = 1e-6f;
constexpr int CHUNK = 128, NCH = SU / CHUNK;

constexpr size_t al256(size_t x) { return (x + 255) / 256 * 256; }
constexpr size_t WS_CTL = 0;
constexpr size_t WS_MOD = 1u << 20;
constexpr size_t WS_SCAL = WS_MOD + al256(2 * 5 * 6144 * 4);
constexpr size_t WS_WEVIN = WS_SCAL + 4096;
constexpr size_t WS_WEVOUT = WS_WEVIN + (size_t)EVEN_IN_P * D * 2;
constexpr size_t WS_WUQ = WS_WEVOUT + (size_t)D * D * 2;
constexpr size_t WS_WUKV = WS_WUQ + (size_t)768 * 384 * 2;
constexpr size_t WS_WLRU = WS_WUKV + (size_t)1024 * 256 * 2;
constexpr size_t WS_WODIN = WS_WLRU + (size_t)32 * 4096 * 2;
constexpr size_t WS_WODOUT = WS_WODIN + (size_t)ODD_IN * D * 2;
constexpr size_t WS_WGU = WS_WODOUT + (size_t)D * D * 2;
constexpr size_t WS_WDN = WS_WGU + (size_t)2 * NE * 2048 * 1024 * 2;
constexpr size_t WS_XC = WS_WDN + (size_t)2 * NE * 1024 * 1024 * 2;
constexpr size_t WS_H = WS_XC + (size_t)NB * CTX * D * 4;
constexpr size_t WS_Z = WS_H + (size_t)R * D * 2;
constexpr size_t WS_QP = WS_Z + (size_t)R * ODD_IN * 2;
constexpr size_t WS_KVP = WS_QP + (size_t)R * 768 * 2;
constexpr size_t WS_QM = WS_KVP + (size_t)R * 1024 * 2;
constexpr size_t WS_KM = WS_QM + (size_t)R * 768 * 2;
constexpr size_t WS_VM = WS_KM + (size_t)R * 768 * 2;
constexpr size_t WS_AGG = WS_VM + (size_t)R * 512 * 2;
constexpr size_t WS_MIX = WS_AGG + al256((size_t)NB * NCH * 2 * 512 * 2 * 4);
constexpr size_t WS_TOKOF = WS_MIX + (size_t)R * D * 2;
constexpr size_t WS_PAIROF = WS_TOKOF + (size_t)NE * R * 4;
constexpr size_t WS_GATEOF = WS_PAIROF + (size_t)NE * R * 4;
constexpr size_t ACT_ROWS = (size_t)R * TOPK + NE * 256;
constexpr size_t WS_ACT = WS_GATEOF + (size_t)NE * R * 4;
constexpr size_t WS_Y = WS_ACT + ACT_ROWS * 1024 * 2;
constexpr size_t WS_END = WS_Y + (size_t)R * TOPK * 1024 * 2;

constexpr int CW_CNT = 64;

__device__ __forceinline__ float bf2f(bf16 v) { return __uint_as_float((unsigned)v << 16); }
__device__ __forceinline__ bf16 f2bf(float f) { unsigned u = __float_as_uint(f); return (bf16)((u + 0x7fffu + ((u >> 16) & 1u)) >> 16); }
__device__ __forceinline__ float wave_sum(float v) {
#pragma unroll
    for (int o = 1; o < 64; o <<= 1) v += __shfl_xor(v, o);
    return v;
}
__device__ __forceinline__ float sigmoidf_(float x) { return 1.f / (1.f + __expf(-x)); }
__device__ __forceinline__ float gelu_tanh(float x) { const float t = tanhf(0.7978845608028654f * (x + 0.044715f * x * x * x)); return 0.5f * x * (1.f + t); }

struct Ptrs {
    const float* in[38];
    float* out;
    unsigned char* ws;
};

__device__ __forceinline__ const float* res_in_row(const Ptrs& P, int layer, int u) {
    const int b = u / SU, j = u % SU;
    if (layer == 0) return j < CTX ? P.in[2] + (size_t)(b * CTX + j) * D : P.in[0] + (size_t)(b * SEQ + j - CTX) * D;
    return j < CTX ? (const float*)(P.ws + WS_XC) + (size_t)(b * CTX + j) * D : P.out + (size_t)(b * SEQ + j - CTX) * D;
}
__device__ __forceinline__ float* res_out_row(const Ptrs& P, int u) {
    const int b = u / SU, j = u % SU;
    return j < CTX ? (float*)(P.ws + WS_XC) + (size_t)(b * CTX + j) * D : P.out + (size_t)(b * SEQ + j - CTX) * D;
}
__device__ __forceinline__ const float* mod_row(const Ptrs& P, int layer, int u) {
    const int b = u / SU, j = u % SU;
    return (const float*)(P.ws + WS_MOD) + (size_t)(layer * 5 + (j < CTX ? 4 : b)) * 6144;
}

__global__ __launch_bounds__(256) void k_transpose_cvt(const float* __restrict__ src, int K, int N, bf16* __restrict__ dst, int Npad, const float* __restrict__ rowscale, int perm,
                                                       size_t src_stride, size_t dst_stride) {
    __shared__ float tile[64][65];
    src += blockIdx.z * src_stride; dst += blockIdx.z * dst_stride;
    const int n0 = blockIdx.x * 64, k0 = blockIdx.y * 64, tid = threadIdx.x;
    for (int i = 0; i < 16; ++i) {
        const int k = i * 4 + (tid >> 6), n = tid & 63; int np = n0 + n;
        int sc = np; if (perm == 1) sc = (np / 256) * 128 + (np % 128) + ((np % 256) / 128) * 1024;
        float v = 0.f; if (sc < N) v = src[(size_t)(k0 + k) * N + sc];
        if (rowscale) v *= rowscale[k0 + k];
        tile[k][n] = v;
    }
    __syncthreads();
    for (int i = 0; i < 16; ++i) {
        const int n = i * 4 + (tid >> 6), k = tid & 63;
        dst[(size_t)(n0 + n) * K + k0 + k] = f2bf(tile[k][n]);
    }
}

__global__ __launch_bounds__(256) void k_modvec(Ptrs P) {
    __shared__ float s[5][1024];
    const int layer = blockIdx.y, j = blockIdx.x * 256 + threadIdx.x;
    for (int i = threadIdx.x; i < 5 * 1024; i += 256) { const int r = i / 1024, k = i % 1024; const float c = r < 4 ? P.in[1][r * 1024 + k] : P.in[3][k]; s[r][k] = c / (1.f + __expf(-c)); }
    __syncthreads();
    const float* w = P.in[4] + (size_t)layer * 1024 * 6144;
    float a[5] = {0, 0, 0, 0, 0};
    for (int k = 0; k < 1024; ++k) { const float wv = w[(size_t)k * 6144 + j];
#pragma unroll
        for (int r = 0; r < 5; ++r) a[r] += s[r][k] * wv; }
    const float bv = P.in[5][layer * 6144 + j];
    float* o = (float*)(P.ws + WS_MOD) + (size_t)layer * 5 * 6144;
#pragma unroll
    for (int r = 0; r < 5; ++r) o[r * 6144 + j] = a[r] + bv;
}

constexpr float LOG2E = 1.4426950408889634f;
__global__ void k_scalars(Ptrs P) {
    if (threadIdx.x != 0) return;
    float* sc = (float*)(P.ws + WS_SCAL);
    float mq = 0, mk = 0;
    for (int i = 0; i < 192; ++i) { mq = fmaxf(mq, fabsf(P.in[21][i])); mk = fmaxf(mk, fabsf(P.in[22][i])); }
    sc[0] = sqrtf(192.f) * mq * mk * LOG2E;
    mq = 0; mk = 0;
    for (int i = 0; i < 64; ++i) { mq = fmaxf(mq, fabsf(P.in[25][i])); mk = fmaxf(mk, fabsf(P.in[26][i])); }
    sc[1] = 8.f * mq * mk * LOG2E;
    float s1 = 0, s2 = 0;
    for (int i = 0; i < 64; ++i) { s1 += P.in[27][i] * P.in[28][i]; s2 += P.in[29][i] * P.in[30][i]; }
    const float lam_init = 0.8f - 0.6f * expf(-0.3f * 1.f);
    sc[2] = expf(s1) - expf(s2) + lam_init;
    sc[3] = 1.f - lam_init;
}

__global__ __launch_bounds__(256) void k_norm_mod(Ptrs P, int layer, int which, int latent_only) {
    const int wave = threadIdx.x >> 6, lane = threadIdx.x & 63;
    const int u = blockIdx.x * 4 + wave; if (u >= R) return;
    if (latent_only && (u % SU) < CTX) return;
    const float* x = (which == 0) ? res_in_row(P, layer, u) : (const float*)res_out_row(P, u);
    const float* g = (which == 0 ? P.in[6] : P.in[7]) + layer * D;
    const float* md = mod_row(P, layer, u) + (which == 0 ? 0 : 3 * D);
    float v[16]; float ss = 0.f;
#pragma unroll
    for (int j = 0; j < 4; ++j) { const f32x4 t = *(const f32x4*)(x + j * 256 + lane * 4); v[4 * j] = t.x; v[4 * j + 1] = t.y; v[4 * j + 2] = t.z; v[4 * j + 3] = t.w; ss += t.x * t.x + t.y * t.y + t.z * t.z + t.w * t.w; }
    const float rstd = rsqrtf(wave_sum(ss) * (1.f / D) + EPS);
    bf16* h = (bf16*)(P.ws + WS_H) + (size_t)u * D;
#pragma unroll
    for (int j = 0; j < 4; ++j)
#pragma unroll
        for (int e = 0; e < 4; ++e) { const int c = j * 256 + lane * 4 + e; const float y = v[4 * j + e] * rstd * g[c] * (1.f + md[D + c]) + md[c]; v[4 * j + e] = y; }
#pragma unroll
    for (int j = 0; j < 4; ++j) { unsigned lo = f2bf(v[4 * j]) | ((unsigned)f2bf(v[4 * j + 1]) << 16), hi = f2bf(v[4 * j + 2]) | ((unsigned)f2bf(v[4 * j + 3]) << 16);
        *(uint2*)(h + j * 256 + lane * 4) = make_uint2(lo, hi); }
    if (which == 1) {
        const float* rw = P.in[32] + (size_t)layer * D * NE; const float* rb = P.in[33] + layer * NE;
        float lg[NE];
#pragma unroll
        for (int e = 0; e < NE; ++e) lg[e] = 0.f;
        for (int j = 0; j < 4; ++j)
            for (int q = 0; q < 4; ++q) { const int c = j * 256 + lane * 4 + q; const float hv = v[4 * j + q];
#pragma unroll
                for (int e = 0; e < NE; ++e) lg[e] += hv * rw[(size_t)c * NE + e]; }
#pragma unroll
        for (int e = 0; e < NE; ++e) lg[e] = wave_sum(lg[e]) + rb[e];
        int te[4]; float tv[4];
#pragma unroll
        for (int k = 0; k < 4; ++k) { float best = -3.4e38f; int bi = 0;
#pragma unroll
            for (int e = 0; e < NE; ++e) { const bool ok = lg[e] > best; best = ok ? lg[e] : best; bi = ok ? e : bi; }
            te[k] = bi; tv[k] = best;
#pragma unroll
            for (int e = 0; e < NE; ++e) lg[e] = (e == bi) ? -3.4e38f : lg[e]; }
        float den = 0.f, w[4];
#pragma unroll
        for (int k = 0; k < 4; ++k) { w[k] = __expf(tv[k] - tv[0]); den += w[k]; }
        if (lane == 0) {
            unsigned* cnt = (unsigned*)(P.ws + WS_CTL) + CW_CNT + layer * 64;
            int* tok_of = (int*)(P.ws + WS_TOKOF); int* pair_of = (int*)(P.ws + WS_PAIROF); float* gate_of = (float*)(P.ws + WS_GATEOF);
            for (int k = 0; k < 4; ++k) { const unsigned rk = atomicAdd(&cnt[te[k]], 1u); tok_of[(size_t)te[k] * R + rk] = u; pair_of[(size_t)te[k] * R + rk] = u * 4 + k; gate_of[(size_t)te[k] * R + rk] = w[k] / den; }
        }
    }
}

template <class Prob, bool PAIR>
__global__ __launch_bounds__(256) void k_gemm_naive(Prob pr) {
    __shared__ float As[32][68];
    __shared__ float Bs[32][68];
    __shared__ float B2s[PAIR ? 32 : 1][68];
    if (!pr.setup(blockIdx.y)) return;
    const int tid = threadIdx.x, tx = tid & 15, ty = tid >> 4, n0 = blockIdx.x * 64;
    float acc[4][4] = {}, acc2[4][4] = {};
    const int lr = tid >> 2, lk = (tid & 3) * 8;
    const bf16* ap = pr.arow(lr); const bf16* bp = pr.brow(n0 + lr); const bf16* b2p = PAIR ? pr.brow2(n0 + lr) : nullptr;
    for (int k0 = 0; k0 < pr.K; k0 += 32) {
        u32x4 av = {0, 0, 0, 0}; if (ap) av = *(const u32x4*)(ap + k0 + lk);
        const u32x4 bv = *(const u32x4*)(bp + k0 + lk);
        u32x4 b2v = {0, 0, 0, 0}; if (PAIR) b2v = *(const u32x4*)(b2p + k0 + lk);
#pragma unroll
        for (int i = 0; i < 4; ++i) {
            As[lk + 2 * i][lr] = __uint_as_float(av[i] << 16); As[lk + 2 * i + 1][lr] = __uint_as_float(av[i] & 0xffff0000u);
            Bs[lk + 2 * i][lr] = __uint_as_float(bv[i] << 16); Bs[lk + 2 * i + 1][lr] = __uint_as_float(bv[i] & 0xffff0000u);
            if (PAIR) { B2s[lk + 2 * i][lr] = __uint_as_float(b2v[i] << 16); B2s[lk + 2 * i + 1][lr] = __uint_as_float(b2v[i] & 0xffff0000u); }
        }
        __syncthreads();
#pragma unroll 8
        for (int k = 0; k < 32; ++k) {
            const f32x4 a = *(const f32x4*)&As[k][ty * 4]; const f32x4 b = *(const f32x4*)&Bs[k][tx * 4];
#pragma unroll
            for (int i = 0; i < 4; ++i)
#pragma unroll
                for (int j = 0; j < 4; ++j) acc[i][j] += a[i] * b[j];
            if (PAIR) { const f32x4 b2 = *(const f32x4*)&B2s[k][tx * 4];
#pragma unroll
                for (int i = 0; i < 4; ++i)
#pragma unroll
                    for (int j = 0; j < 4; ++j) acc2[i][j] += a[i] * b2[j]; }
        }
        __syncthreads();
    }
#pragma unroll
    for (int i = 0; i < 4; ++i)
#pragma unroll
        for (int j = 0; j < 4; ++j) pr.epi(ty * 4 + i, n0 + tx * 4 + j, acc[i][j], acc2[i][j]);
}

struct ProbPlain {
    const bf16* A; int lda; const bf16* Bt; int K; bf16* C; int ldc; int m0;
    __device__ bool setup(int by) { m0 = by * 64; return true; }
    __device__ const bf16* arow(int m) const { return A + (size_t)(m0 + m) * lda; }
    __device__ const bf16* brow(int n) const { return Bt + (size_t)n * K; }
    __device__ const bf16* brow2(int n) const { return nullptr; }
    __device__ void epi(int m, int n, float a, float) const { C[(size_t)(m0 + m) * ldc + n] = f2bf(a); }
};
struct ProbOut {
    Ptrs P; const bf16* A; const bf16* Bt; int K; int layer; int latent_only; int m0;
    __device__ bool setup(int by) { m0 = by * 64; if (latent_only && (m0 % SU) < CTX) return false; return true; }
    __device__ const bf16* arow(int m) const { return A + (size_t)(m0 + m) * D; }
    __device__ const bf16* brow(int n) const { return Bt + (size_t)n * K; }
    __device__ const bf16* brow2(int n) const { return nullptr; }
    __device__ void epi(int m, int n, float a, float) const { const int u = m0 + m; const float g1 = mod_row(P, layer, u)[2 * D + n]; res_out_row(P, u)[n] = res_in_row(P, layer, u)[n] + g1 * a; }
};
struct ProbMoe1 {
    Ptrs P; int layer; int K; int e, row0  , cnt_e, actbase;
    __device__ bool setup(int by) {
        const unsigned* cnt = (const unsigned*)(P.ws + WS_CTL) + CW_CNT + layer * 64;
        int t = by, ab = 0;
        for (int x = 0; x < NE; ++x) { const int c = (int)cnt[x], nt = (c + 63) / 64; if (t < nt) { e = x; row0 = t * 64; cnt_e = c; actbase = ab; return true; } t -= nt; ab += (c + 255) / 256 * 256; }
        return false;
    }
    __device__ const bf16* arow(int m) const { const int r = row0 + m; if (r >= cnt_e) return nullptr; const int u = ((const int*)(P.ws + WS_TOKOF))[(size_t)e * R + r]; return (const bf16*)(P.ws + WS_H) + (size_t)u * D; }
    __device__ const bf16* brow(int j) const { return (const bf16*)(P.ws + WS_WGU) + ((size_t)(layer * NE + e) * 2048 + (j / 128) * 256 + (j % 128)) * 1024; }
    __device__ const bf16* brow2(int j) const { return brow(j) + (size_t)128 * 1024; }
    __device__ void epi(int m, int j, float ag, float au) const {
        const int r = row0 + m; if (r >= cnt_e) return;
        const float* bgu = P.in[35] + (size_t)(layer * NE + e) * 2048;
        float g = ag + bgu[j], uu = au + bgu[1024 + j];
        g = fminf(g, 7.f); uu = fminf(fmaxf(uu, -7.f), 7.f);
        const float act = (uu + 1.f) * g * sigmoidf_(1.702f * g);
        ((bf16*)(P.ws + WS_ACT))[(size_t)(actbase + r) * 1024 + j] = f2bf(act);
    }
};
struct ProbMoe2 {
    Ptrs P; int layer; int K; int e, row0, cnt_e, actbase;
    __device__ bool setup(int by) {
        const unsigned* cnt = (const unsigned*)(P.ws + WS_CTL) + CW_CNT + layer * 64;
        int t = by, ab = 0;
        for (int x = 0; x < NE; ++x) { const int c = (int)cnt[x], nt = (c + 63) / 64; if (t < nt) { e = x; row0 = t * 64; cnt_e = c; actbase = ab; return true; } t -= nt; ab += (c + 255) / 256 * 256; }
        return false;
    }
    __device__ const bf16* arow(int m) const { const int r = row0 + m; if (r >= cnt_e) return nullptr; return (const bf16*)(P.ws + WS_ACT) + (size_t)(actbase + r) * 1024; }
    __device__ const bf16* brow(int n) const { return (const bf16*)(P.ws + WS_WDN) + ((size_t)(layer * NE + e) * 1024 + n) * 1024; }
    __device__ const bf16* brow2(int n) const { return nullptr; }
    __device__ void epi(int m, int n, float a, float) const {
        const int r = row0 + m; if (r >= cnt_e) return;
        const int pair = ((const int*)(P.ws + WS_PAIROF))[(size_t)e * R + r]; const float gw = ((const float*)(P.ws + WS_GATEOF))[(size_t)e * R + r];
        const float y = (a + P.in[37][(size_t)(layer * NE + e) * 1024 + n]) * gw;
        ((bf16*)(P.ws + WS_Y))[(size_t)pair * 1024 + n] = f2bf(y);
    }
};

__global__ __launch_bounds__(256) void k_combine(Ptrs P, int layer, int latent_only) {
    const int u = blockIdx.x; if (latent_only && (u % SU) < CTX) return;
    const float* g2 = mod_row(P, layer, u) + 5 * D; float* x = res_out_row(P, u);
    const bf16* y = (const bf16*)(P.ws + WS_Y) + (size_t)u * 4 * 1024;
    for (int c = threadIdx.x; c < D; c += 256) { const float f = bf2f(y[c]) + bf2f(y[1024 + c]) + bf2f(y[2048 + c]) + bf2f(y[3072 + c]); x[c] += g2[c] * f; }
}

__device__ __forceinline__ int bwd_pos(int c) { return c < 2 ? 1 - c : 2 + (NCH - 1 - c); }
__device__ __forceinline__ int bwd_chunk_at(int p) { return p < 2 ? 1 - p : NCH - 1 - (p - 2); }
__global__ __launch_bounds__(256) void k_lru(Ptrs P, int mode) {
    __shared__ float xs[CHUNK][64];
    __shared__ float aS[CHUNK][64];
    __shared__ float uS[CHUNK][64];
    __shared__ float hF[CHUNK][64];
    __shared__ unsigned short wS[2][64][66];
    const int n = blockIdx.x, c = blockIdx.y, b = blockIdx.z, tid = threadIdx.x;
    const int j0 = c * CHUNK, seg_lo = (c < 2) ? 0 : CTX, seg_hi = (c < 2) ? CTX : SU;
    const bf16* Z = (const bf16*)(P.ws + WS_Z);
    const float* cw = P.in[10]; const float* cb = P.in[11];
    for (int i = tid; i < CHUNK * 64; i += 256) {
        const int t = i >> 6, ch = i & 63, cg = n * 64 + ch; float acc = cb[cg];
#pragma unroll
        for (int k = 0; k < 4; ++k) { const int j = j0 + t - 2 + k; if (j >= seg_lo && j < seg_hi) acc += cw[k * LRU_W + cg] * bf2f(Z[(size_t)(b * SU + j) * EVEN_IN_P + 512 + cg]); }
        xs[t][ch] = acc;
    }
    float* agg = (float*)(P.ws + WS_AGG);
    for (int dir = 0; dir < 2; ++dir) {
        __syncthreads();
        const bf16* wl = (const bf16*)(P.ws + WS_WLRU) + (size_t)(dir * 2) * 8 * 4096;
        for (int i = tid; i < 2 * 4096; i += 256) { const int gate = i >> 12, e = (i >> 6) & 63, d = i & 63; wS[gate][d][e] = wl[((size_t)gate * 8 + n) * 4096 + e * 64 + d]; }
        __syncthreads();
        const float* ba = P.in[13] + dir * LRU_W + n * 64; const float* bx = P.in[15] + dir * LRU_W + n * 64; const float* lam = P.in[16] + dir * LRU_W + n * 64;
        for (int i = tid; i < CHUNK * 64; i += 256) {
            const int t = i >> 6, e = i & 63; float ra = ba[e], ri = bx[e];
            for (int d = 0; d < 64; ++d) { const float xv = bf2f(f2bf(xs[t][d])); ra += xv * bf2f(wS[0][d][e]); ri += xv * bf2f(wS[1][d][e]); }
            const float r = sigmoidf_(ra), ig = sigmoidf_(ri);
            const float sp = log1pf(__expf(-lam[e]));
            const float log_a = -8.f * r * sp;
            const float a = __expf(log_a);
            const float mult = sqrtf(fmaxf(-expm1f(2.f * log_a), 0.f));
            aS[t][e] = a; uS[t][e] = mult * ig * xs[t][e];
        }
        __syncthreads();
        if (tid < 64) {
            const int ch = tid; float h = 0.f;
            if (mode == 1) {
                const int pos = dir == 0 ? c : bwd_pos(c);
                for (int p = 0; p < pos; ++p) { const int cc = dir == 0 ? p : bwd_chunk_at(p); const float* ag = agg + ((((size_t)b * NCH + cc) * 2 + dir) * 512 + n * 64 + ch) * 2; h = ag[0] * h + ag[1]; }
            }
            float ap = 1.f;
            if (dir == 0) { for (int t = 0; t < CHUNK; ++t) { const float a = aS[t][ch]; h = a * h + uS[t][ch]; ap *= a; if (mode == 1) hF[t][ch] = h; } }
            else { for (int t = CHUNK - 1; t >= 0; --t) { const float a = aS[t][ch]; h = a * h + uS[t][ch]; ap *= a; if (mode == 1) uS[t][ch] = h; } }
            if (mode == 0) { float* ag = agg + ((((size_t)b * NCH + c) * 2 + dir) * 512 + n * 64 + ch) * 2; ag[0] = ap; ag[1] = h; }
        }
    }
    if (mode == 1) {
        __syncthreads();
        bf16* mix = (bf16*)(P.ws + WS_MIX);
        for (int i = tid; i < CHUNK * 64; i += 256) { const int t = i >> 6, ch = i & 63; const size_t u = (size_t)b * SU + j0 + t;
            const float gl = bf2f(Z[u * EVEN_IN_P + n * 64 + ch]); mix[u * D + n * 64 + ch] = f2bf(gelu_tanh(gl) * (hF[t][ch] + uS[t][ch])); }
    }
}

__device__ __forceinline__ void rope_angles(int t, int q, float& cr, float& sr, float& cc, float& scn) {
    const float f = exp2f(-(float)(2 * q) / 32.f * 13.287712379549449f);
    const float ar = (float)(t / GRID_W) * f, ac = (float)(t % GRID_W) * f;
    sincosf(ar, &sr, &cr); sincosf(ac, &scn, &cc);
}
__global__ __launch_bounds__(256) void k_mla_prep(Ptrs P) {
    const int wave = threadIdx.x >> 6, lane = threadIdx.x & 63;
    const int u = blockIdx.x * 4 + wave; if (u >= R) return;
    const int j = u % SU; const bool latent = j >= CTX; const int t = j - CTX;
    const bf16* z = (const bf16*)(P.ws + WS_Z) + (size_t)u * EVEN_IN_P;
    float sq = 0.f, sk = 0.f;
    for (int i = lane; i < 384; i += 64) { const float v = bf2f(z[1024 + i]); sq += v * v; }
    for (int i = lane; i < 256; i += 64) { const float v = bf2f(z[1408 + i]); sk += v * v; }
    const float rq = rsqrtf(wave_sum(sq) * (1.f / 384.f) + EPS), rk = rsqrtf(wave_sum(sk) * (1.f / 256.f) + EPS);
    const bf16* qp = (const bf16*)(P.ws + WS_QP) + (size_t)u * 768; const bf16* kvp = (const bf16*)(P.ws + WS_KVP) + (size_t)u * 1024;
    bf16* qm = (bf16*)(P.ws + WS_QM) + (size_t)u * 768; bf16* km = (bf16*)(P.ws + WS_KM) + (size_t)u * 768; bf16* vm = (bf16*)(P.ws + WS_VM) + (size_t)u * 512;
    const float* qn = P.in[21]; const float* kn = P.in[22];
    float cs = 1.f, sn = 0.f;
    if (latent) { float cr, sr, cc, sc2; rope_angles(t, lane & 15, cr, sr, cc, sc2); cs = (lane >> 5) ? cc : cr; sn = (lane >> 5) ? sc2 : sr; }
    const float kr_raw = bf2f(z[1664 + lane]);
    for (int h = 0; h < MLA_H; ++h) {
        float q0 = bf2f(qp[h * 192 + lane]) * rq, q1 = bf2f(qp[h * 192 + 64 + lane]) * rq, q2 = bf2f(qp[h * 192 + 128 + lane]) * rq;
        float r = rsqrtf(wave_sum(q0 * q0 + q1 * q1 + q2 * q2) * (1.f / 192.f) + EPS);
        q0 *= r * qn[lane]; q1 *= r * qn[64 + lane]; q2 *= r * qn[128 + lane];
        { const float other = __shfl_xor(q2, 16); const float rot = ((lane >> 4) & 1) ? other : -other; q2 = q2 * cs + rot * sn; }
        qm[h * 192 + lane] = f2bf(q0); qm[h * 192 + 64 + lane] = f2bf(q1); qm[h * 192 + 128 + lane] = f2bf(q2);
        float k0 = bf2f(kvp[h * 256 + lane]) * rk, k1 = bf2f(kvp[h * 256 + 64 + lane]) * rk, k2 = kr_raw;
        const float v0 = bf2f(kvp[h * 256 + 128 + lane]) * rk, v1 = bf2f(kvp[h * 256 + 192 + lane]) * rk;
        r = rsqrtf(wave_sum(k0 * k0 + k1 * k1 + k2 * k2) * (1.f / 192.f) + EPS);
        k0 *= r * kn[lane]; k1 *= r * kn[64 + lane]; k2 *= r * kn[128 + lane];
        { const float other = __shfl_xor(k2, 16); const float rot = ((lane >> 4) & 1) ? other : -other; k2 = k2 * cs + rot * sn; }
        km[h * 192 + lane] = f2bf(k0); km[h * 192 + 64 + lane] = f2bf(k1); km[h * 192 + 128 + lane] = f2bf(k2);
        vm[h * 128 + lane] = f2bf(v0); vm[h * 128 + 64 + lane] = f2bf(v1);
    }
}

__global__ __launch_bounds__(256) void k_diff_prep(Ptrs P) {
    const int wave = threadIdx.x >> 6, lane = threadIdx.x & 63;
    const int u = blockIdx.x * 4 + wave; if (u >= R) return;
    const int j = u % SU; const bool latent = j >= CTX; const int t = j - CTX;
    bf16* z = (bf16*)(P.ws + WS_Z) + (size_t)u * ODD_IN;
    float cs = 1.f, sn = 0.f;
    if (latent) { float cr, sr, cc, sc2; rope_angles(t, lane & 15, cr, sr, cc, sc2); cs = (lane >> 5) ? cc : cr; sn = (lane >> 5) ? sc2 : sr; }
    for (int qk = 0; qk < 2; ++qk) {
        const float* gn = (qk == 0 ? P.in[25] : P.in[26]);
        for (int g = 0; g < 16; ++g) {
            bf16* p = z + qk * 1024 + g * 64;
            float v = bf2f(p[lane]);
            const float r = rsqrtf(wave_sum(v * v) * (1.f / 64.f) + EPS);
            v *= r * gn[lane];
            const float other = __shfl_xor(v, 16); const float rot = ((lane >> 4) & 1) ? other : -other; v = v * cs + rot * sn;
            p[lane] = f2bf(v);
        }
    }
}

template <int DKH, int NSM, int MODE>
__global__ __launch_bounds__(256) void k_attn_naive(Ptrs P, const bf16* Qb, int ldq, int qoff_h, const bf16* Kb, int ldk, int koff_h, const bf16* Vb, int ldv, int voff_h,
                                                    int q_j0, int nq_blocks, int key_j0, int nkeys, float c2, int scal_idx) {
    constexpr int DK = DKH * NSM;
    extern __shared__ float sm[];
    float* Qs = sm;
    float* Ks = Qs + 64 * (DK + 1);
    float* Vs = Ks + 32 * (DK + 1);
    float* Ps = Vs + 32 * 128;
    const int tid = threadIdx.x, q = tid >> 2, part = tid & 3;
    const int qb = blockIdx.x % nq_blocks, h = blockIdx.y, b = blockIdx.z;
    const size_t uq0 = (size_t)b * SU + q_j0 + qb * 64, uk0 = (size_t)b * SU + key_j0;
    const float M = ((const float*)(P.ws + WS_SCAL))[scal_idx];
    for (int i = tid; i < 64 * DK; i += 256) { const int r = i / DK, c = i % DK; Qs[r * (DK + 1) + c] = bf2f(Qb[(uq0 + r) * ldq + h * qoff_h + c]); }
    float o[NSM][32]; float l[NSM];
#pragma unroll
    for (int s = 0; s < NSM; ++s) { l[s] = 0.f;
#pragma unroll
        for (int d = 0; d < 32; ++d) o[s][d] = 0.f; }
    for (int k0 = 0; k0 < nkeys; k0 += 32) {
        __syncthreads();
        for (int i = tid; i < 32 * DK; i += 256) { const int r = i / DK, c = i % DK; Ks[r * (DK + 1) + c] = bf2f(Kb[(uk0 + k0 + r) * ldk + h * koff_h + c]); }
        for (int i = tid; i < 32 * 128; i += 256) { const int r = i >> 7, c = i & 127; Vs[r * 128 + c] = bf2f(Vb[(uk0 + k0 + r) * ldv + h * voff_h + c]); }
        __syncthreads();
#pragma unroll
        for (int s = 0; s < NSM; ++s) {
            float sc[8];
#pragma unroll
            for (int kk = 0; kk < 8; ++kk) sc[kk] = 0.f;
            for (int d = 0; d < DKH; ++d) { const float qv = Qs[q * (DK + 1) + s * DKH + d];
#pragma unroll
                for (int kk = 0; kk < 8; ++kk) sc[kk] += qv * Ks[(part * 8 + kk) * (DK + 1) + s * DKH + d]; }
#pragma unroll
            for (int kk = 0; kk < 8; ++kk) { const float p = exp2f(sc[kk] * c2 - M); l[s] += p; Ps[(s * 64 + q) * 33 + part * 8 + kk] = p; }
        }
        __syncthreads();
#pragma unroll
        for (int s = 0; s < NSM; ++s)
            for (int kk = 0; kk < 32; ++kk) { const float p = Ps[(s * 64 + q) * 33 + kk];
#pragma unroll
                for (int d = 0; d < 32; ++d) o[s][d] += p * Vs[kk * 128 + d * 4 + part]; }
    }
#pragma unroll
    for (int s = 0; s < NSM; ++s) { l[s] += __shfl_xor(l[s], 1); l[s] += __shfl_xor(l[s], 2); }
    bf16* mix = (bf16*)(P.ws + WS_MIX) + (uq0 + q) * D;
    if (MODE == 0) {
        const float il = 1.f / l[0];
#pragma unroll
        for (int d = 0; d < 32; ++d) mix[512 + h * 128 + d * 4 + part] = f2bf(o[0][d] * il);
    } else {
        const float* scal = (const float*)(P.ws + WS_SCAL); const float lam = scal[2], oml = scal[3];
        const float il1 = 1.f / l[0], il2 = lam / l[NSM - 1];
        float v[32]; float ss = 0.f;
#pragma unroll
        for (int d = 0; d < 32; ++d) { v[d] = o[0][d] * il1 - o[NSM - 1][d] * il2; ss += v[d] * v[d]; }
        ss += __shfl_xor(ss, 1); ss += __shfl_xor(ss, 2);
        const float r = rsqrtf(ss * (1.f / 128.f) + EPS) * oml; const float* sg = P.in[31];
#pragma unroll
        for (int d = 0; d < 32; ++d) mix[h * 128 + d * 4 + part] = f2bf(v[d] * r * sg[d * 4 + part]);
    }
}

#include <cstring>
template <class T> static T zeroed() { T t; memset((void*)&t, 0, sizeof(T)); return t; }
extern "C" void kernel_launch(void* const* d_in, const int* in_sizes, int n_in, void* d_out, int out_size, void* d_ws, size_t ws_size, hipStream_t stream) {
    if (n_in != 38 || ws_size < WS_END) { fprintf(stderr, "kernel_launch: bad args n_in=%d ws=%zu need %zu\n", n_in, ws_size, (size_t)WS_END); return; }
    Ptrs P = zeroed<Ptrs>(); for (int i = 0; i < 38; ++i) P.in[i] = (const float*)d_in[i]; P.out = (float*)d_out; P.ws = (unsigned char*)d_ws;
    unsigned char* ws = (unsigned char*)d_ws;
    hipMemsetAsync(ws + WS_CTL, 0, 1u << 20, stream);
    static bool attr = false;
    constexpr int SM_MLA = (64 * 193 + 32 * 193 + 32 * 128 + 64 * 33) * 4, SM_DIFF = (64 * 129 + 32 * 129 + 32 * 128 + 2 * 64 * 33) * 4;
    if (!attr) {
        hipFuncSetAttribute((const void*)k_attn_naive<192, 1, 0>, hipFuncAttributeMaxDynamicSharedMemorySize, SM_MLA);
        hipFuncSetAttribute((const void*)k_attn_naive<64, 2, 1>, hipFuncAttributeMaxDynamicSharedMemorySize, SM_DIFF);
        attr = true;
    }
    auto tc = [&](const float* src, int K, int N, size_t dst_off, int Npad, const float* rs, int perm, int batch, size_t sstr, size_t dstr) {
        hipLaunchKernelGGL(k_transpose_cvt, dim3(Npad / 64, K / 64, batch), dim3(256), 0, stream, src, K, N, (bf16*)(ws + dst_off), Npad, rs, perm, sstr, dstr);
    };
    tc(P.in[8], 1024, EVEN_IN, WS_WEVIN, EVEN_IN_P, nullptr, 0, 1, 0, 0);
    tc(P.in[9], 1024, 1024, WS_WEVOUT, 1024, nullptr, 0, 1, 0, 0);
    tc(P.in[18], 384, 768, WS_WUQ, 768, P.in[17], 0, 1, 0, 0);
    tc(P.in[20], 256, 1024, WS_WUKV, 1024, P.in[19], 0, 1, 0, 0);
    tc(P.in[12], 64, 64, WS_WLRU, 64, nullptr, 0, 8, 4096, 4096);
    tc(P.in[14], 64, 64, WS_WLRU + 8 * 4096 * 2, 64, nullptr, 0, 8, 4096, 4096);
    tc(P.in[12] + 8 * 4096, 64, 64, WS_WLRU + 16 * 4096 * 2, 64, nullptr, 0, 8, 4096, 4096);
    tc(P.in[14] + 8 * 4096, 64, 64, WS_WLRU + 24 * 4096 * 2, 64, nullptr, 0, 8, 4096, 4096);
    tc(P.in[23], 1024, ODD_IN, WS_WODIN, ODD_IN, nullptr, 0, 1, 0, 0);
    tc(P.in[24], 1024, 1024, WS_WODOUT, 1024, nullptr, 0, 1, 0, 0);
    tc(P.in[34], 1024, 2048, WS_WGU, 2048, nullptr, 1, 2 * NE, (size_t)1024 * 2048, (size_t)2048 * 1024);
    tc(P.in[36], 1024, 1024, WS_WDN, 1024, nullptr, 0, 2 * NE, (size_t)1024 * 1024, (size_t)1024 * 1024);
    hipLaunchKernelGGL(k_modvec, dim3(6144 / 256, 2), dim3(256), 0, stream, P);
    hipLaunchKernelGGL(k_scalars, dim3(1), dim3(64), 0, stream, P);

    const bf16* H = (const bf16*)(ws + WS_H); bf16* Z = (bf16*)(ws + WS_Z); const bf16* MIX = (const bf16*)(ws + WS_MIX);
    hipLaunchKernelGGL(k_norm_mod, dim3(R / 4), dim3(256), 0, stream, P, 0, 0, 0);
    { ProbPlain pr = zeroed<ProbPlain>(); pr.A = H; pr.lda = D; pr.Bt = (const bf16*)(ws + WS_WEVIN); pr.K = D; pr.C = Z; pr.ldc = EVEN_IN_P; pr.m0 = 0;
      hipLaunchKernelGGL((k_gemm_naive<ProbPlain, false>), dim3(EVEN_IN_P / 64, R / 64), dim3(256), 0, stream, pr); }
    { ProbPlain pr = zeroed<ProbPlain>(); pr.A = Z + 1024; pr.lda = EVEN_IN_P; pr.Bt = (const bf16*)(ws + WS_WUQ); pr.K = 384; pr.C = (bf16*)(ws + WS_QP); pr.ldc = 768; pr.m0 = 0;
      hipLaunchKernelGGL((k_gemm_naive<ProbPlain, false>), dim3(768 / 64, R / 64), dim3(256), 0, stream, pr); }
    { ProbPlain pr = zeroed<ProbPlain>(); pr.A = Z + 1408; pr.lda = EVEN_IN_P; pr.Bt = (const bf16*)(ws + WS_WUKV); pr.K = 256; pr.C = (bf16*)(ws + WS_KVP); pr.ldc = 1024; pr.m0 = 0;
      hipLaunchKernelGGL((k_gemm_naive<ProbPlain, false>), dim3(1024 / 64, R / 64), dim3(256), 0, stream, pr); }
    hipLaunchKernelGGL(k_lru, dim3(8, NCH, NB), dim3(256), 0, stream, P, 0);
    hipLaunchKernelGGL(k_mla_prep, dim3(R / 4), dim3(256), 0, stream, P);
    hipLaunchKernelGGL(k_lru, dim3(8, NCH, NB), dim3(256), 0, stream, P, 1);
    { const bf16* Qm = (const bf16*)(ws + WS_QM); const bf16* Km = (const bf16*)(ws + WS_KM); const bf16* Vm = (const bf16*)(ws + WS_VM);
      const float c2 = 0.07216878364870322f * LOG2E;
      hipLaunchKernelGGL((k_attn_naive<192, 1, 0>), dim3(SEQ / 64, MLA_H, NB), dim3(256), SM_MLA, stream, P, Qm, 768, 192, Km, 768, 192, Vm, 512, 128, CTX, SEQ / 64, 0, SU, c2, 0);
      hipLaunchKernelGGL((k_attn_naive<192, 1, 0>), dim3(CTX / 64, MLA_H, NB), dim3(256), SM_MLA, stream, P, Qm, 768, 192, Km, 768, 192, Vm, 512, 128, 0, CTX / 64, 0, CTX, c2, 0); }
    { ProbOut pr = zeroed<ProbOut>(); pr.P = P; pr.A = MIX; pr.Bt = (const bf16*)(ws + WS_WEVOUT); pr.K = D; pr.layer = 0; pr.latent_only = 0; pr.m0 = 0;
      hipLaunchKernelGGL((k_gemm_naive<ProbOut, false>), dim3(D / 64, R / 64), dim3(256), 0, stream, pr); }
    hipLaunchKernelGGL(k_norm_mod, dim3(R / 4), dim3(256), 0, stream, P, 0, 1, 0);
    { ProbMoe1 pr = zeroed<ProbMoe1>(); pr.P = P; pr.layer = 0; pr.K = D; pr.e = 0; pr.row0 = 0; pr.cnt_e = 0; pr.actbase = 0;
      hipLaunchKernelGGL((k_gemm_naive<ProbMoe1, true>), dim3(1024 / 64, (R * TOPK) / 64 + NE), dim3(256), 0, stream, pr); }
    { ProbMoe2 pr = zeroed<ProbMoe2>(); pr.P = P; pr.layer = 0; pr.K = D; pr.e = 0; pr.row0 = 0; pr.cnt_e = 0; pr.actbase = 0;
      hipLaunchKernelGGL((k_gemm_naive<ProbMoe2, false>), dim3(1024 / 64, (R * TOPK) / 64 + NE), dim3(256), 0, stream, pr); }
    hipLaunchKernelGGL(k_combine, dim3(R), dim3(256), 0, stream, P, 0, 0);
    hipLaunchKernelGGL(k_norm_mod, dim3(R / 4), dim3(256), 0, stream, P, 1, 0, 0);
    { ProbPlain pr = zeroed<ProbPlain>(); pr.A = H; pr.lda = D; pr.Bt = (const bf16*)(ws + WS_WODIN); pr.K = D; pr.C = Z; pr.ldc = ODD_IN; pr.m0 = 0;
      hipLaunchKernelGGL((k_gemm_naive<ProbPlain, false>), dim3(ODD_IN / 64, R / 64), dim3(256), 0, stream, pr); }
    hipLaunchKernelGGL(k_diff_prep, dim3(R / 4), dim3(256), 0, stream, P);
    { const float c2 = 0.125f * LOG2E;
      hipLaunchKernelGGL((k_attn_naive<64, 2, 1>), dim3(SEQ / 64, DIFF_H, NB), dim3(256), SM_DIFF, stream, P, Z, ODD_IN, 128, Z + 1024, ODD_IN, 128, Z + 2048, ODD_IN, 128, CTX, SEQ / 64, 0, SU, c2, 1); }
    { ProbOut pr = zeroed<ProbOut>(); pr.P = P; pr.A = MIX; pr.Bt = (const bf16*)(ws + WS_WODOUT); pr.K = D; pr.layer = 1; pr.latent_only = 1; pr.m0 = 0;
      hipLaunchKernelGGL((k_gemm_naive<ProbOut, false>), dim3(D / 64, R / 64), dim3(256), 0, stream, pr); }
    hipLaunchKernelGGL(k_norm_mod, dim3(R / 4), dim3(256), 0, stream, P, 1, 1, 1);
    { ProbMoe1 pr = zeroed<ProbMoe1>(); pr.P = P; pr.layer = 1; pr.K = D; pr.e = 0; pr.row0 = 0; pr.cnt_e = 0; pr.actbase = 0;
      hipLaunchKernelGGL((k_gemm_naive<ProbMoe1, true>), dim3(1024 / 64, (R * TOPK) / 64 + NE), dim3(256), 0, stream, pr); }
    { ProbMoe2 pr = zeroed<ProbMoe2>(); pr.P = P; pr.layer = 1; pr.K = D; pr.e = 0; pr.row0 = 0; pr.cnt_e = 0; pr.actbase = 0;
      hipLaunchKernelGGL((k_gemm_naive<ProbMoe2, false>), dim3(1024 / 64, (R * TOPK) / 64 + NE), dim3(256), 0, stream, pr); }
    hipLaunchKernelGGL(k_combine, dim3(R), dim3(256), 0, stream, P, 1, 1);
}
```

```cpp
#include <hip/hip_runtime.h>
#include <cstdio>
#include <cstdint>
#include <cstring>

typedef unsigned short bf16;
typedef unsigned u32x4 __attribute__((ext_vector_type(4)));
typedef float f32x4 __attribute__((ext_vector_type(4)));

constexpr int D = 1024, NB = 4, SEQ = 4096, CTX = 256, SU = SEQ + CTX, R = NB * SU;
constexpr int GRID_W = 64;
constexpr int LRU_W = 512, LRU_NB = 8, LRU_BW = 64;
constexpr int MLA_H = 4, MLA_QR = 384, MLA_KVR = 256, MLA_NOPE = 128, MLA_ROPE = 64, MLA_V = 128, MLA_QK = 192;
constexpr int EVEN_IN = 1728, EVEN_IN_P = 1792;
constexpr int DIFF_H = 8, ODD_IN = 3072;
constexpr int NE = 32, TOPK = 4, DFF = 1024;
constexpr float EPS = 1e-6f;
constexpr int CHUNK = 128, NCH = SU / CHUNK;

constexpr size_t al256(size_t x) { return (x + 255) / 256 * 256; }
constexpr size_t WS_CTL = 0;
constexpr size_t WS_MOD = 1u << 20;
constexpr size_t WS_SCAL = WS_MOD + al256(2 * 5 * 6144 * 4);
constexpr size_t WS_WEVIN = WS_SCAL + 4096;
constexpr size_t WS_WEVOUT = WS_WEVIN + (size_t)EVEN_IN_P * D * 2;
constexpr size_t WS_WUQ = WS_WEVOUT + (size_t)D * D * 2;
constexpr size_t WS_WUKV = WS_WUQ + (size_t)768 * 384 * 2;
constexpr size_t WS_WLRU = WS_WUKV + (size_t)1024 * 256 * 2;
constexpr size_t WS_WODIN = WS_WLRU + (size_t)32 * 4096 * 2;
constexpr size_t WS_WODOUT = WS_WODIN + (size_t)ODD_IN * D * 2;
constexpr size_t WS_WGU = WS_WODOUT + (size_t)D * D * 2;
constexpr size_t WS_WDN = WS_WGU + (size_t)2 * NE * 2048 * 1024 * 2;
constexpr size_t WS_XC = WS_WDN + (size_t)2 * NE * 1024 * 1024 * 2;
constexpr size_t WS_H = WS_XC + (size_t)NB * CTX * D * 4;
constexpr size_t WS_Z = WS_H + (size_t)R * D * 2;
constexpr size_t WS_QP = WS_Z + (size_t)R * ODD_IN * 2;
constexpr size_t WS_KVP = WS_QP + (size_t)R * 768 * 2;
constexpr size_t WS_QM = WS_KVP + (size_t)R * 1024 * 2;
constexpr size_t WS_KM = WS_QM + (size_t)R * 768 * 2;
constexpr size_t WS_VM = WS_KM + (size_t)R * 768 * 2;
constexpr size_t WS_AGG = WS_VM + (size_t)R * 512 * 2;
constexpr size_t WS_MIX = WS_AGG + al256((size_t)NB * NCH * 2 * 512 * 2 * 4);
constexpr size_t WS_TOKOF = WS_MIX + (size_t)R * D * 2;
constexpr size_t WS_PAIROF = WS_TOKOF + (size_t)NE * R * 4;
constexpr size_t WS_GATEOF = WS_PAIROF + (size_t)NE * R * 4;
constexpr size_t ACT_ROWS = (size_t)R * TOPK + NE * 256;
constexpr size_t WS_ACT = WS_GATEOF + (size_t)NE * R * 4;
constexpr size_t WS_Y = WS_ACT + ACT_ROWS * 1024 * 2;
constexpr size_t WS_END = WS_Y + (size_t)R * TOPK * 1024 * 2;

constexpr int CW_CNT = 64;

__device__ __forceinline__ float bf2f(bf16 v) { return __uint_as_float((unsigned)v << 16); }
__device__ __forceinline__ bf16 f2bf(float f) { unsigned u = __float_as_uint(f); return (bf16)((u + 0x7fffu + ((u >> 16) & 1u)) >> 16); }
__device__ __forceinline__ float wave_sum(float v) {
#pragma unroll
    for (int o = 1; o < 64; o <<= 1) v += __shfl_xor(v, o);
    return v;
}
__device__ __forceinline__ float sigmoidf_(float x) { return 1.f / (1.f + __expf(-x)); }
__device__ __forceinline__ float gelu_tanh(float x) { const float t = tanhf(0.7978845608028654f * (x + 0.044715f * x * x * x)); return 0.5f * x * (1.f + t); }

struct Ptrs {
    const float* in[38];
    float* out;
    unsigned char* ws;
};

__device__ __forceinline__ const float* res_in_row(const Ptrs& P, int layer, int u) {
    const int b = u / SU, j = u % SU;
    if (layer == 0) return j < CTX ? P.in[2] + (size_t)(b * CTX + j) * D : P.in[0] + (size_t)(b * SEQ + j - CTX) * D;
    return j < CTX ? (const float*)(P.ws + WS_XC) + (size_t)(b * CTX + j) * D : P.out + (size_t)(b * SEQ + j - CTX) * D;
}
__device__ __forceinline__ float* res_out_row(const Ptrs& P, int u) {
    const int b = u / SU, j = u % SU;
    return j < CTX ? (float*)(P.ws + WS_XC) + (size_t)(b * CTX + j) * D : P.out + (size_t)(b * SEQ + j - CTX) * D;
}
__device__ __forceinline__ const float* mod_row(const Ptrs& P, int layer, int u) {
    const int b = u / SU, j = u % SU;
    return (const float*)(P.ws + WS_MOD) + (size_t)(layer * 5 + (j < CTX ? 4 : b)) * 6144;
}

constexpr float LOG2E = 1.4426950408889634f;
#define GAS __attribute__((address_space(1)))
#define LAS __attribute__((address_space(3)))
constexpr int NT = 512;
constexpr int LDS_BYTES = 147456;
constexpr int RING_BYTES = 131072, LDSCTL_OFF = RING_BYTES, MISC_OFF = LDSCTL_OFF + 320;
constexpr int CW_BAR = 4096;
constexpr int CW_TMO = 0;

#define XB_TMO      128
#define XB_XCNT(j)  (256  + 64 * (j))
#define XB_XSUB(j)  (1280 + 64 * (j))
#define XB_XGEN(j)  (2304 + 64 * (j))
#define XB_TOP      3328
#define XB_TOPGEN   3392
#define XCD_BAR_WORDS 3456
#define XB_SPIN_CAP (1u << 22)
__device__ __forceinline__ unsigned xb_ld(unsigned* p)              { return __hip_atomic_load(p, __ATOMIC_RELAXED, __HIP_MEMORY_SCOPE_AGENT); }
__device__ __forceinline__ unsigned xb_add(unsigned* p, unsigned v) { return __hip_atomic_fetch_add(p, v, __ATOMIC_RELAXED, __HIP_MEMORY_SCOPE_AGENT); }
__device__ __forceinline__ unsigned xb_xcc_id() { return (unsigned)__builtin_amdgcn_s_getreg((3 << 11) | 20) & 0xFu; }
#define XB_SPIN(cond, bar) do { unsigned _sp = 0; while (cond) { __builtin_amdgcn_s_sleep(1); \
    if ((++_sp & 255u) == 0u) { if (xb_ld(&(bar)[XB_TMO])) break; if (_sp > XB_SPIN_CAP) { atomicAdd(&(bar)[XB_TMO], 1u); break; } } } } while (0)
struct XcdBarrier { unsigned* bar; unsigned x; volatile LAS unsigned* st; };
__device__ __forceinline__ XcdBarrier xcd_barrier_post(unsigned* bar, volatile LAS unsigned* st) {
    XcdBarrier b; b.bar = bar; b.x = xb_xcc_id(); b.st = st;
    if (threadIdx.x == 0) (void)xb_add(&bar[XB_XCNT(b.x)], 1u);
    return b;
}
__device__ __forceinline__ void xcd_barrier_complete(unsigned* bar, unsigned x, unsigned& nloc, unsigned& nx) {
    const unsigned G = gridDim.x * gridDim.y * gridDim.z;
    unsigned sum, cnt, mine, sp = 0u;
    for (;;) {
        sum = 0u; cnt = 0u; mine = 0u;
#pragma unroll
        for (unsigned j = 0; j < 16; ++j) { const unsigned c = xb_ld(&bar[XB_XCNT(j)]); sum += c; cnt += (c > 0u) ? 1u : 0u; mine = (j == x) ? c : mine; }
        if (sum == G) break;
        __builtin_amdgcn_s_sleep(1);
        if ((++sp & 255u) == 0u) { if (xb_ld(&bar[XB_TMO])) break; if (sp > XB_SPIN_CAP) { atomicAdd(&bar[XB_TMO], 1u); break; } }
    }
    nloc = mine > 0u ? mine : 1u; nx = cnt > 0u ? cnt : 1u;
}
__device__ __forceinline__ void xcd_barrier(const XcdBarrier& b) {
    asm volatile("s_waitcnt vmcnt(0)" ::: "memory");
    __syncthreads();
    if (threadIdx.x == 0) {
        unsigned* bar = b.bar;
        __builtin_amdgcn_s_waitcnt(0);
        unsigned nloc = b.st[0], nx = b.st[1];
        if (nloc == 0u) { xcd_barrier_complete(bar, b.x, nloc, nx); b.st[0] = nloc; b.st[1] = nx; }
        const unsigned old = xb_add(&bar[XB_XSUB(b.x)], 1u);
        const unsigned gen = old / nloc;
        if (old + 1u == (gen + 1u) * nloc) {
            __builtin_amdgcn_fence(__ATOMIC_RELEASE, "agent");
            asm volatile("s_waitcnt vmcnt(0)" ::: "memory");
            const unsigned og = xb_add(&bar[XB_TOP], 1u);
            const unsigned tg = og / nx;
            if (og + 1u == (tg + 1u) * nx) xb_add(&bar[XB_TOPGEN], 1u);
            else XB_SPIN(xb_ld(&bar[XB_TOPGEN]) == tg, bar);
            __builtin_amdgcn_fence(__ATOMIC_ACQUIRE, "agent");
            xb_add(&bar[XB_XGEN(b.x)], 1u);
            asm volatile("s_waitcnt vmcnt(0)" ::: "memory");
        } else {
            XB_SPIN(xb_ld(&bar[XB_XGEN(b.x)]) == gen, bar);
            __builtin_amdgcn_fence(__ATOMIC_ACQUIRE, "agent");
            asm volatile("s_waitcnt vmcnt(0)" ::: "memory");
        }
    }
    __syncthreads();
}

__device__ __forceinline__ void transpose_tile(const float* __restrict__ src, int K, int N, bf16* __restrict__ dst, const float* __restrict__ rowscale, int perm, int n0, int k0, float* tile  ) {
    const int tid = threadIdx.x;
    __syncthreads();
#pragma unroll
    for (int i = 0; i < 8; ++i) {
        const int k = i * 8 + (tid >> 6), n = tid & 63; const int np = n0 + n;
        int sc = np; if (perm == 1) sc = (np / 256) * 128 + (np % 128) + ((np % 256) / 128) * 1024;
        float v = 0.f; if (sc < N) v = src[(size_t)(k0 + k) * N + sc];
        if (rowscale) v *= rowscale[k0 + k];
        tile[k * 65 + n] = v;
    }
    __syncthreads();
#pragma unroll
    for (int i = 0; i < 8; ++i) {
        const int n = i * 8 + (tid >> 6), k = tid & 63;
        dst[(size_t)(n0 + n) * K + k0 + k] = f2bf(tile[k * 65 + n]);
    }
}
struct TJob { const float* src; bf16* dst; const float* rs; int K, N, Npad, perm, batch; size_t sstr, dstr; };
__device__ __forceinline__ void run_tjob(const TJob& j, float* tile, int& base, int G) {
    const int tn = j.Npad / 64, tk = j.K / 64, per = tn * tk, total = per * j.batch;
    int first = ((int)blockIdx.x - base % G + G) % G;
    for (int it = first; it < total; it += G) { const int z = it / per, r = it % per; transpose_tile(j.src + z * j.sstr, j.K, j.N, j.dst + z * j.dstr, j.rs, j.perm, (r % tn) * 64, (r / tn) * 64, tile); }
    base += total;
}
__device__ __forceinline__ void ph_prologue(const Ptrs& P, unsigned char* lds) {
    float* tile = (float*)lds; unsigned char* ws = P.ws; const int G = gridDim.x; int base = 0;
    TJob j;
    j = TJob{P.in[34], (bf16*)(ws + WS_WGU), nullptr, 1024, 2048, 2048, 1, 2 * NE, (size_t)1024 * 2048, (size_t)2048 * 1024}; run_tjob(j, tile, base, G);
    j = TJob{P.in[36], (bf16*)(ws + WS_WDN), nullptr, 1024, 1024, 1024, 0, 2 * NE, (size_t)1024 * 1024, (size_t)1024 * 1024}; run_tjob(j, tile, base, G);
    j = TJob{P.in[8], (bf16*)(ws + WS_WEVIN), nullptr, 1024, EVEN_IN, EVEN_IN_P, 0, 1, 0, 0}; run_tjob(j, tile, base, G);
    j = TJob{P.in[9], (bf16*)(ws + WS_WEVOUT), nullptr, 1024, 1024, 1024, 0, 1, 0, 0}; run_tjob(j, tile, base, G);
    j = TJob{P.in[18], (bf16*)(ws + WS_WUQ), P.in[17], 384, 768, 768, 0, 1, 0, 0}; run_tjob(j, tile, base, G);
    j = TJob{P.in[20], (bf16*)(ws + WS_WUKV), P.in[19], 256, 1024, 1024, 0, 1, 0, 0}; run_tjob(j, tile, base, G);
    j = TJob{P.in[12], (bf16*)(ws + WS_WLRU), nullptr, 64, 64, 64, 0, 8, 4096, 4096}; run_tjob(j, tile, base, G);
    j = TJob{P.in[14], (bf16*)(ws + WS_WLRU) + 8 * 4096, nullptr, 64, 64, 64, 0, 8, 4096, 4096}; run_tjob(j, tile, base, G);
    j = TJob{P.in[12] + 8 * 4096, (bf16*)(ws + WS_WLRU) + 16 * 4096, nullptr, 64, 64, 64, 0, 8, 4096, 4096}; run_tjob(j, tile, base, G);
    j = TJob{P.in[14] + 8 * 4096, (bf16*)(ws + WS_WLRU) + 24 * 4096, nullptr, 64, 64, 64, 0, 8, 4096, 4096}; run_tjob(j, tile, base, G);
    j = TJob{P.in[23], (bf16*)(ws + WS_WODIN), nullptr, 1024, ODD_IN, ODD_IN, 0, 1, 0, 0}; run_tjob(j, tile, base, G);
    j = TJob{P.in[24], (bf16*)(ws + WS_WODOUT), nullptr, 1024, 1024, 1024, 0, 1, 0, 0}; run_tjob(j, tile, base, G);
    __syncthreads();
    {
        float* s = (float*)lds;
        for (int it = (int)blockIdx.x; it < 24; it += G) {
            const int layer = it / 12, jc = (it % 12) * 512 + threadIdx.x;
            __syncthreads();
            for (int i = threadIdx.x; i < 5 * 1024; i += NT) { const int r = i / 1024, k = i % 1024; const float c = r < 4 ? P.in[1][r * 1024 + k] : P.in[3][k]; s[i] = c / (1.f + __expf(-c)); }
            __syncthreads();
            const float* w = P.in[4] + (size_t)layer * 1024 * 6144;
            float a[5] = {0, 0, 0, 0, 0};
            for (int k = 0; k < 1024; ++k) { const float wv = w[(size_t)k * 6144 + jc];
#pragma unroll
                for (int r = 0; r < 5; ++r) a[r] += s[r * 1024 + k] * wv; }
            const float bv = P.in[5][layer * 6144 + jc];
            float* o = (float*)(ws + WS_MOD) + (size_t)layer * 5 * 6144;
#pragma unroll
            for (int r = 0; r < 5; ++r) o[r * 6144 + jc] = a[r] + bv;
        }
    }
    if ((int)blockIdx.x == G - 1 && threadIdx.x == 0) {
        float* sc = (float*)(ws + WS_SCAL);
        float mq = 0, mk = 0;
        for (int i = 0; i < 192; ++i) { mq = fmaxf(mq, fabsf(P.in[21][i])); mk = fmaxf(mk, fabsf(P.in[22][i])); }
        sc[0] = sqrtf(192.f) * mq * mk * LOG2E;
        mq = 0; mk = 0;
        for (int i = 0; i < 64; ++i) { mq = fmaxf(mq, fabsf(P.in[25][i])); mk = fmaxf(mk, fabsf(P.in[26][i])); }
        sc[1] = 8.f * mq * mk * LOG2E;
        float s1 = 0, s2 = 0;
        for (int i = 0; i < 64; ++i) { s1 += P.in[27][i] * P.in[28][i]; s2 += P.in[29][i] * P.in[30][i]; }
        const float lam_init = 0.8f - 0.6f * expf(-0.3f * 1.f);
        sc[2] = expf(s1) - expf(s2) + lam_init;
        sc[3] = 1.f - lam_init;
    }
}

__device__ __forceinline__ void norm_mod_store(const Ptrs& P, float (&v)[16], int lane, int u, int layer, int which) {
    const float* g = (which == 0 ? P.in[6] : P.in[7]) + layer * D;
    const float* md = mod_row(P, layer, u) + (which == 0 ? 0 : 3 * D);
    float ss = 0.f;
#pragma unroll
    for (int i = 0; i < 16; ++i) ss += v[i] * v[i];
    const float rstd = rsqrtf(wave_sum(ss) * (1.f / D) + EPS);
    bf16* h = (bf16*)(P.ws + WS_H) + (size_t)u * D;
#pragma unroll
    for (int j = 0; j < 4; ++j) {
        const int c = j * 256 + lane * 4;
        const f32x4 gv = *(const f32x4*)(g + c), scv = *(const f32x4*)(md + D + c), shv = *(const f32x4*)(md + c);
#pragma unroll
        for (int e = 0; e < 4; ++e) v[4 * j + e] = v[4 * j + e] * rstd * gv[e] * (1.f + scv[e]) + shv[e];
        const unsigned lo = f2bf(v[4 * j]) | ((unsigned)f2bf(v[4 * j + 1]) << 16), hi = f2bf(v[4 * j + 2]) | ((unsigned)f2bf(v[4 * j + 3]) << 16);
        *(uint2*)(h + c) = make_uint2(lo, hi);
    }
}
__device__ __forceinline__ void router_row(const Ptrs& P, const float (&v)[16], int lane, int u, int layer) {
    const float* rw = P.in[32] + (size_t)layer * D * NE; const float* rb = P.in[33] + layer * NE;
    float lg[NE];
#pragma unroll
    for (int e = 0; e < NE; ++e) lg[e] = 0.f;
    for (int j = 0; j < 4; ++j)
        for (int q = 0; q < 4; ++q) { const int c = j * 256 + lane * 4 + q; const float hv = v[4 * j + q];
#pragma unroll
            for (int e4 = 0; e4 < NE / 4; ++e4) { const f32x4 w = *(const f32x4*)(rw + (size_t)c * NE + e4 * 4); lg[e4 * 4] += hv * w[0]; lg[e4 * 4 + 1] += hv * w[1]; lg[e4 * 4 + 2] += hv * w[2]; lg[e4 * 4 + 3] += hv * w[3]; } }
#pragma unroll
    for (int e = 0; e < NE; ++e) lg[e] = wave_sum(lg[e]) + rb[e];
    int te[4]; float tv[4];
#pragma unroll
    for (int k = 0; k < 4; ++k) { float best = -3.4e38f; int bi = 0;
#pragma unroll
        for (int e = 0; e < NE; ++e) { const bool ok = lg[e] > best; best = ok ? lg[e] : best; bi = ok ? e : bi; }
        te[k] = bi; tv[k] = best;
#pragma unroll
        for (int e = 0; e < NE; ++e) lg[e] = (e == bi) ? -3.4e38f : lg[e]; }
    float den = 0.f, w[4];
#pragma unroll
    for (int k = 0; k < 4; ++k) { w[k] = __expf(tv[k] - tv[0]); den += w[k]; }
    if (lane == 0) {
        unsigned* cnt = (unsigned*)(P.ws + WS_CTL) + CW_CNT + layer * 64;
        int* tok_of = (int*)(P.ws + WS_TOKOF); int* pair_of = (int*)(P.ws + WS_PAIROF); float* gate_of = (float*)(P.ws + WS_GATEOF);
#pragma unroll
        for (int k = 0; k < 4; ++k) { const unsigned rk = atomicAdd(&cnt[te[k]], 1u); tok_of[(size_t)te[k] * R + rk] = u; pair_of[(size_t)te[k] * R + rk] = u * 4 + k; gate_of[(size_t)te[k] * R + rk] = w[k] / den; }
    }
}
__device__ __forceinline__ void ph_rows(const Ptrs& P, int layer, int mode, int latent_only, int next_norm) {
    const int wave = threadIdx.x >> 6, lane = threadIdx.x & 63, G = gridDim.x;
    for (int u = (int)blockIdx.x * 8 + wave; u < R; u += G * 8) {
        if (latent_only && (u % SU) < CTX) continue;
        float v[16];
        const float* x = (mode == 0) ? res_in_row(P, layer, u) : (const float*)res_out_row(P, u);
#pragma unroll
        for (int j = 0; j < 4; ++j) { const f32x4 t = *(const f32x4*)(x + j * 256 + lane * 4); v[4 * j] = t[0]; v[4 * j + 1] = t[1]; v[4 * j + 2] = t[2]; v[4 * j + 3] = t[3]; }
        if (mode == 2) {
            const float* g2 = mod_row(P, layer, u) + 5 * D; float* xo = res_out_row(P, u);
            const bf16* y = (const bf16*)(P.ws + WS_Y) + (size_t)u * 4 * 1024;
#pragma unroll
            for (int j = 0; j < 4; ++j) { const int c = j * 256 + lane * 4; const f32x4 gv = *(const f32x4*)(g2 + c); f32x4 o;
#pragma unroll
                for (int e = 0; e < 4; ++e) { const float f = bf2f(y[c + e]) + bf2f(y[1024 + c + e]) + bf2f(y[2048 + c + e]) + bf2f(y[3072 + c + e]); v[4 * j + e] += gv[e] * f; o[e] = v[4 * j + e]; }
                *(f32x4*)(xo + c) = o; }
            if (next_norm) norm_mod_store(P, v, lane, u, layer + 1, 0);
        } else {
            norm_mod_store(P, v, lane, u, layer, mode);
            if (mode == 1) router_row(P, v, lane, u, layer);
        }
    }
}

template <class Prob, bool PAIR>
__device__ __forceinline__ void gemm_naive_tile(Prob& pr, float* lds, int n0) {
    float* As = lds;
    float* Bs = As + 32 * 132;
    float* B2s = Bs + 32 * 68;
    const int tid = threadIdx.x, tx = tid & 15, ty = tid >> 4;
    float acc[4][4] = {}, acc2[4][4] = {};
    const int lr = tid >> 2, lk = (tid & 3) * 8;
    const bf16* ap = pr.arow(lr); const bf16* bp = pr.brow(n0 + (lr & 63)); const bf16* b2p = PAIR ? pr.brow2(n0 + (lr & 63)) : nullptr;
    for (int k0 = 0; k0 < pr.K; k0 += 32) {
        u32x4 av = {0, 0, 0, 0}; if (ap) av = *(const u32x4*)(ap + k0 + lk);
        u32x4 bv = {0, 0, 0, 0}, b2v = {0, 0, 0, 0};
        if (lr < 64) bv = *(const u32x4*)(bp + k0 + lk); else if (PAIR) b2v = *(const u32x4*)(b2p + k0 + lk);
        __syncthreads();
#pragma unroll
        for (int i = 0; i < 4; ++i) {
            As[(lk + 2 * i) * 132 + lr] = __uint_as_float(av[i] << 16); As[(lk + 2 * i + 1) * 132 + lr] = __uint_as_float(av[i] & 0xffff0000u);
            if (lr < 64) { Bs[(lk + 2 * i) * 68 + lr] = __uint_as_float(bv[i] << 16); Bs[(lk + 2 * i + 1) * 68 + lr] = __uint_as_float(bv[i] & 0xffff0000u); }
            else if (PAIR) { B2s[(lk + 2 * i) * 68 + lr - 64] = __uint_as_float(b2v[i] << 16); B2s[(lk + 2 * i + 1) * 68 + lr - 64] = __uint_as_float(b2v[i] & 0xffff0000u); }
        }
        __syncthreads();
#pragma unroll 8
        for (int k = 0; k < 32; ++k) {
            const f32x4 a = *(const f32x4*)&As[k * 132 + ty * 4]; const f32x4 b = *(const f32x4*)&Bs[k * 68 + tx * 4];
#pragma unroll
            for (int i = 0; i < 4; ++i)
#pragma unroll
                for (int j = 0; j < 4; ++j) acc[i][j] += a[i] * b[j];
            if (PAIR) { const f32x4 b2 = *(const f32x4*)&B2s[k * 68 + tx * 4];
#pragma unroll
                for (int i = 0; i < 4; ++i)
#pragma unroll
                    for (int j = 0; j < 4; ++j) acc2[i][j] += a[i] * b2[j]; }
        }
    }
#pragma unroll
    for (int i = 0; i < 4; ++i)
#pragma unroll
        for (int j = 0; j < 4; ++j) pr.epi(ty * 4 + i, n0 + tx * 4 + j, acc[i][j], acc2[i][j]);
}
template <class Prob, bool PAIR>
__device__ __forceinline__ void ph_gemm_naive(Prob pr, unsigned char* lds, int nMt, int nNt, int item0) {
    const int G = gridDim.x, total = nMt * nNt;
    int first = ((int)blockIdx.x - item0 % G + G) % G;
    for (int it = first; it < total; it += G) { const int mt = it / nNt, nt = it % nNt; if (!pr.setup(mt)) continue; gemm_naive_tile<Prob, PAIR>(pr, (float*)lds, nt * 64); }
    __syncthreads();
}
struct ProbPlain {
    const bf16* A; int lda; const bf16* Bt; int K; bf16* C; int ldc; int m0;
    __device__ bool setup(int by) { m0 = by * 128; return true; }
    __device__ const bf16* arow(int m) const { return A + (size_t)(m0 + m) * lda; }
    __device__ const bf16* brow(int n) const { return Bt + (size_t)n * K; }
    __device__ const bf16* brow2(int n) const { return nullptr; }
    __device__ void epi(int m, int n, float a, float) const { C[(size_t)(m0 + m) * ldc + n] = f2bf(a); }
};
struct ProbOut {
    Ptrs P; const bf16* A; const bf16* Bt; int K; int layer; int latent_only; int m0;
    __device__ bool setup(int by) { m0 = by * 128; if (latent_only && (m0 % SU) < CTX) return false; return true; }
    __device__ const bf16* arow(int m) const { return A + (size_t)(m0 + m) * D; }
    __device__ const bf16* brow(int n) const { return Bt + (size_t)n * K; }
    __device__ const bf16* brow2(int n) const { return nullptr; }
    __device__ void epi(int m, int n, float a, float) const { const int u = m0 + m; const float g1 = mod_row(P, layer, u)[2 * D + n]; res_out_row(P, u)[n] = res_in_row(P, layer, u)[n] + g1 * a; }
};
__device__ __forceinline__ bool moe_find(const Ptrs& P, int layer, int t, int rows_per_tile, int& e, int& row0, int& cnt_e, int& actbase) {
    const unsigned* cnt = (const unsigned*)(P.ws + WS_CTL) + CW_CNT + layer * 64;
    int ab = 0;
    for (int x = 0; x < NE; ++x) { const int c = (int)cnt[x], nt = (c + rows_per_tile - 1) / rows_per_tile; if (t < nt) { e = x; row0 = t * rows_per_tile; cnt_e = c; actbase = ab; return true; } t -= nt; ab += (c + 255) / 256 * 256; }
    return false;
}
struct ProbMoe1 {
    Ptrs P; int layer; int K; int e, row0, cnt_e, actbase;
    __device__ bool setup(int by) { return moe_find(P, layer, by, 128, e, row0, cnt_e, actbase); }
    __device__ const bf16* arow(int m) const { const int r = row0 + m; if (r >= cnt_e) return nullptr; const int u = ((const int*)(P.ws + WS_TOKOF))[(size_t)e * R + r]; return (const bf16*)(P.ws + WS_H) + (size_t)u * D; }
    __device__ const bf16* brow(int j) const { return (const bf16*)(P.ws + WS_WGU) + ((size_t)(layer * NE + e) * 2048 + (j / 128) * 256 + (j % 128)) * 1024; }
    __device__ const bf16* brow2(int j) const { return brow(j) + (size_t)128 * 1024; }
    __device__ void epi(int m, int j, float ag, float au) const {
        const int r = row0 + m; if (r >= cnt_e) return;
        const float* bgu = P.in[35] + (size_t)(layer * NE + e) * 2048;
        float g = ag + bgu[j], uu = au + bgu[1024 + j];
        g = fminf(g, 7.f); uu = fminf(fmaxf(uu, -7.f), 7.f);
        const float act = (uu + 1.f) * g * sigmoidf_(1.702f * g);
        ((bf16*)(P.ws + WS_ACT))[(size_t)(actbase + r) * 1024 + j] = f2bf(act);
    }
};
struct ProbMoe2 {
    Ptrs P; int layer; int K; int e, row0, cnt_e, actbase;
    __device__ bool setup(int by) { return moe_find(P, layer, by, 128, e, row0, cnt_e, actbase); }
    __device__ const bf16* arow(int m) const { const int r = row0 + m; if (r >= cnt_e) return nullptr; return (const bf16*)(P.ws + WS_ACT) + (size_t)(actbase + r) * 1024; }
    __device__ const bf16* brow(int n) const { return (const bf16*)(P.ws + WS_WDN) + ((size_t)(layer * NE + e) * 1024 + n) * 1024; }
    __device__ const bf16* brow2(int n) const { return nullptr; }
    __device__ void epi(int m, int n, float a, float) const {
        const int r = row0 + m; if (r >= cnt_e) return;
        const int pair = ((const int*)(P.ws + WS_PAIROF))[(size_t)e * R + r]; const float gw = ((const float*)(P.ws + WS_GATEOF))[(size_t)e * R + r];
        const float y = (a + P.in[37][(size_t)(layer * NE + e) * 1024 + n]) * gw;
        ((bf16*)(P.ws + WS_Y))[(size_t)pair * 1024 + n] = f2bf(y);
    }
};

__device__ __forceinline__ int bwd_pos(int c) { return c < 2 ? 1 - c : 2 + (NCH - 1 - c); }
__device__ __forceinline__ int bwd_chunk_at(int p) { return p < 2 ? 1 - p : NCH - 1 - (p - 2); }
__device__ __forceinline__ void lru_item(const Ptrs& P, unsigned char* lds, int mode, int n, int c, int b) {
    float* X = (float*)lds;
    float* A = X + CHUNK * 64;
    float* B = A + CHUNK * 64;
    bf16* wS = (bf16*)(B + CHUNK * 64);
    const int tid = threadIdx.x;
    const int j0 = c * CHUNK, seg_lo = (c < 2) ? 0 : CTX, seg_hi = (c < 2) ? CTX : SU;
    const bf16* Z = (const bf16*)(P.ws + WS_Z);
    const float* cw = P.in[10]; const float* cb = P.in[11];
    __syncthreads();
    for (int i = tid; i < CHUNK * 64; i += NT) {
        const int t = i >> 6, ch = i & 63, cg = n * 64 + ch; float acc = cb[cg];
#pragma unroll
        for (int k = 0; k < 4; ++k) { const int j = j0 + t - 2 + k; if (j >= seg_lo && j < seg_hi) acc += cw[k * LRU_W + cg] * bf2f(Z[(size_t)(b * SU + j) * EVEN_IN_P + 512 + cg]); }
        X[i] = acc;
    }
    float* agg = (float*)(P.ws + WS_AGG);
    for (int dir = 0; dir < 2; ++dir) {
        __syncthreads();
        const bf16* wl = (const bf16*)(P.ws + WS_WLRU) + (size_t)(dir * 2) * 8 * 4096;
        for (int i = tid; i < 2 * 4096; i += NT) { const int gate = i >> 12, e = (i >> 6) & 63, d = i & 63; wS[(gate * 64 + d) * 66 + e] = wl[((size_t)gate * 8 + n) * 4096 + e * 64 + d]; }
        __syncthreads();
        const float* ba = P.in[13] + dir * LRU_W + n * 64; const float* bx = P.in[15] + dir * LRU_W + n * 64; const float* lam = P.in[16] + dir * LRU_W + n * 64;
        float ra_[16], ru_[16];
#pragma unroll
        for (int q = 0; q < 16; ++q) {
            const int i = tid + q * NT, t = i >> 6, e = i & 63; float ra = ba[e], ri = bx[e];
            for (int d = 0; d < 64; ++d) { const float xv = bf2f(f2bf(X[t * 64 + d])); ra += xv * bf2f(wS[d * 66 + e]); ri += xv * bf2f(wS[(64 + d) * 66 + e]); }
            const float r = sigmoidf_(ra), ig = sigmoidf_(ri);
            const float sp = log1pf(__expf(-lam[e]));
            const float log_a = -8.f * r * sp;
            ra_[q] = __expf(log_a);
            ru_[q] = sqrtf(fmaxf(-expm1f(2.f * log_a), 0.f)) * ig * X[t * 64 + e];
        }
        __syncthreads();
        float* U = dir == 0 ? B : X;
#pragma unroll
        for (int q = 0; q < 16; ++q) { const int i = tid + q * NT; A[i] = ra_[q]; U[i] = ru_[q]; }
        __syncthreads();
        if (tid < 64) {
            const int ch = tid; float h = 0.f;
            if (mode == 1) {
                const int pos = dir == 0 ? c : bwd_pos(c);
                for (int p = 0; p < pos; ++p) { const int cc = dir == 0 ? p : bwd_chunk_at(p); const float* ag = agg + ((((size_t)b * NCH + cc) * 2 + dir) * 512 + n * 64 + ch) * 2; h = ag[0] * h + ag[1]; }
            }
            float ap = 1.f;
            if (dir == 0) { for (int t = 0; t < CHUNK; ++t) { const float a = A[t * 64 + ch]; h = a * h + U[t * 64 + ch]; ap *= a; U[t * 64 + ch] = h; } }
            else { for (int t = CHUNK - 1; t >= 0; --t) { const float a = A[t * 64 + ch]; h = a * h + U[t * 64 + ch]; ap *= a; U[t * 64 + ch] = h; } }
            if (mode == 0) { float* ag = agg + ((((size_t)b * NCH + c) * 2 + dir) * 512 + n * 64 + ch) * 2; ag[0] = ap; ag[1] = h; }
        }
    }
    if (mode == 1) {
        __syncthreads();
        bf16* mix = (bf16*)(P.ws + WS_MIX);
        for (int i = tid; i < CHUNK * 64; i += NT) { const int t = i >> 6, ch = i & 63; const size_t u = (size_t)b * SU + j0 + t;
            const float gl = bf2f(Z[u * EVEN_IN_P + n * 64 + ch]); mix[u * D + n * 64 + ch] = f2bf(gelu_tanh(gl) * (B[i] + X[i])); }
    }
}
__device__ __forceinline__ void ph_lru(const Ptrs& P, unsigned char* lds, int mode, int item0) {
    const int G = gridDim.x, total = 8 * NCH * NB;
    int first = ((int)blockIdx.x - item0 % G + G) % G;
    for (int it = first; it < total; it += G) lru_item(P, lds, mode, it % 8, (it / 8) % NCH, it / (8 * NCH));
    __syncthreads();
}

__device__ __forceinline__ void rope_angles(int t, int q, float& cr, float& sr, float& cc, float& scn) {
    const float f = exp2f(-(float)(2 * q) / 32.f * 13.287712379549449f);
    const float ar = (float)(t / GRID_W) * f, ac = (float)(t % GRID_W) * f;
    sincosf(ar, &sr, &cr); sincosf(ac, &scn, &cc);
}
__device__ __forceinline__ void ph_mla_prep(const Ptrs& P) {
    const int wave = threadIdx.x >> 6, lane = threadIdx.x & 63, G = gridDim.x;
    const float* qn = P.in[21]; const float* kn = P.in[22];
    for (int u = (int)blockIdx.x * 8 + wave; u < R; u += G * 8) {
        const int j = u % SU; const bool latent = j >= CTX; const int t = j - CTX;
        const bf16* z = (const bf16*)(P.ws + WS_Z) + (size_t)u * EVEN_IN_P;
        float sq = 0.f, sk = 0.f;
        for (int i = lane; i < 384; i += 64) { const float v = bf2f(z[1024 + i]); sq += v * v; }
        for (int i = lane; i < 256; i += 64) { const float v = bf2f(z[1408 + i]); sk += v * v; }
        const float rq = rsqrtf(wave_sum(sq) * (1.f / 384.f) + EPS), rk = rsqrtf(wave_sum(sk) * (1.f / 256.f) + EPS);
        const bf16* qp = (const bf16*)(P.ws + WS_QP) + (size_t)u * 768; const bf16* kvp = (const bf16*)(P.ws + WS_KVP) + (size_t)u * 1024;
        bf16* qm = (bf16*)(P.ws + WS_QM) + (size_t)u * 768; bf16* km = (bf16*)(P.ws + WS_KM) + (size_t)u * 768; bf16* vm = (bf16*)(P.ws + WS_VM) + (size_t)u * 512;
        float cs = 1.f, sn = 0.f;
        if (latent) { float cr, sr, cc, sc2; rope_angles(t, lane & 15, cr, sr, cc, sc2); cs = (lane >> 5) ? cc : cr; sn = (lane >> 5) ? sc2 : sr; }
        const float kr_raw = bf2f(z[1664 + lane]);
        for (int h = 0; h < MLA_H; ++h) {
            float q0 = bf2f(qp[h * 192 + lane]) * rq, q1 = bf2f(qp[h * 192 + 64 + lane]) * rq, q2 = bf2f(qp[h * 192 + 128 + lane]) * rq;
            float r = rsqrtf(wave_sum(q0 * q0 + q1 * q1 + q2 * q2) * (1.f / 192.f) + EPS);
            q0 *= r * qn[lane]; q1 *= r * qn[64 + lane]; q2 *= r * qn[128 + lane];
            { const float other = __shfl_xor(q2, 16); const float rot = ((lane >> 4) & 1) ? other : -other; q2 = q2 * cs + rot * sn; }
            qm[h * 192 + lane] = f2bf(q0); qm[h * 192 + 64 + lane] = f2bf(q1); qm[h * 192 + 128 + lane] = f2bf(q2);
            float k0 = bf2f(kvp[h * 256 + lane]) * rk, k1 = bf2f(kvp[h * 256 + 64 + lane]) * rk, k2 = kr_raw;
            const float v0 = bf2f(kvp[h * 256 + 128 + lane]) * rk, v1 = bf2f(kvp[h * 256 + 192 + lane]) * rk;
            r = rsqrtf(wave_sum(k0 * k0 + k1 * k1 + k2 * k2) * (1.f / 192.f) + EPS);
            k0 *= r * kn[lane]; k1 *= r * kn[64 + lane]; k2 *= r * kn[128 + lane];
            { const float other = __shfl_xor(k2, 16); const float rot = ((lane >> 4) & 1) ? other : -other; k2 = k2 * cs + rot * sn; }
            km[h * 192 + lane] = f2bf(k0); km[h * 192 + 64 + lane] = f2bf(k1); km[h * 192 + 128 + lane] = f2bf(k2);
            vm[h * 128 + lane] = f2bf(v0); vm[h * 128 + 64 + lane] = f2bf(v1);
        }
    }
}
__device__ __forceinline__ void ph_diff_prep(const Ptrs& P) {
    const int wave = threadIdx.x >> 6, lane = threadIdx.x & 63, G = gridDim.x;
    for (int u = (int)blockIdx.x * 8 + wave; u < R; u += G * 8) {
        const int j = u % SU; const bool latent = j >= CTX; const int t = j - CTX;
        bf16* z = (bf16*)(P.ws + WS_Z) + (size_t)u * ODD_IN;
        float cs = 1.f, sn = 0.f;
        if (latent) { float cr, sr, cc, sc2; rope_angles(t, lane & 15, cr, sr, cc, sc2); cs = (lane >> 5) ? cc : cr; sn = (lane >> 5) ? sc2 : sr; }
        for (int qk = 0; qk < 2; ++qk) {
            const float* gn = (qk == 0 ? P.in[25] : P.in[26]);
            for (int g = 0; g < 16; ++g) {
                bf16* p = z + qk * 1024 + g * 64;
                float v = bf2f(p[lane]);
                const float r = rsqrtf(wave_sum(v * v) * (1.f / 64.f) + EPS);
                v *= r * gn[lane];
                const float other = __shfl_xor(v, 16); const float rot = ((lane >> 4) & 1) ? other : -other; v = v * cs + rot * sn;
                p[lane] = f2bf(v);
            }
        }
    }
}

template <int DKH, int NSM, int MODE>
__device__ __forceinline__ void attn_naive_item(const Ptrs& P, float* sm, const bf16* Qb, int ldq, int qoff_h, const bf16* Kb, int ldk, int koff_h, const bf16* Vb, int ldv, int voff_h,
                                                int q_j0, int key_j0, int nkeys, float c2, int scal_idx, int qb, int h, int b) {
    constexpr int DK = DKH * NSM;
    float* Qs = sm; float* Ks = Qs + 64 * (DK + 1); float* Vs = Ks + 32 * (DK + 1); float* Ps = Vs + 32 * 128;
    const int tid = threadIdx.x, q = tid >> 3, part = tid & 7;
    const size_t uq0 = (size_t)b * SU + q_j0 + qb * 64, uk0 = (size_t)b * SU + key_j0;
    const float M = ((const float*)(P.ws + WS_SCAL))[scal_idx];
    __syncthreads();
    for (int i = tid; i < 64 * DK; i += NT) { const int r = i / DK, c = i % DK; Qs[r * (DK + 1) + c] = bf2f(Qb[(uq0 + r) * ldq + h * qoff_h + c]); }
    float o[NSM][16]; float l[NSM];
#pragma unroll
    for (int s = 0; s < NSM; ++s) { l[s] = 0.f;
#pragma unroll
        for (int d = 0; d < 16; ++d) o[s][d] = 0.f; }
    for (int k0 = 0; k0 < nkeys; k0 += 32) {
        __syncthreads();
        for (int i = tid; i < 32 * DK; i += NT) { const int r = i / DK, c = i % DK; Ks[r * (DK + 1) + c] = bf2f(Kb[(uk0 + k0 + r) * ldk + h * koff_h + c]); }
        for (int i = tid; i < 32 * 128; i += NT) { const int r = i >> 7, c = i & 127; Vs[r * 128 + c] = bf2f(Vb[(uk0 + k0 + r) * ldv + h * voff_h + c]); }
        __syncthreads();
#pragma unroll
        for (int s = 0; s < NSM; ++s) {
            float sc[4] = {0.f, 0.f, 0.f, 0.f};
            for (int d = 0; d < DKH; ++d) { const float qv = Qs[q * (DK + 1) + s * DKH + d];
#pragma unroll
                for (int kk = 0; kk < 4; ++kk) sc[kk] += qv * Ks[(part * 4 + kk) * (DK + 1) + s * DKH + d]; }
#pragma unroll
            for (int kk = 0; kk < 4; ++kk) { const float p = exp2f(sc[kk] * c2 - M); l[s] += p; Ps[(s * 64 + q) * 33 + part * 4 + kk] = p; }
        }
        __syncthreads();
#pragma unroll
        for (int s = 0; s < NSM; ++s)
            for (int kk = 0; kk < 32; ++kk) { const float p = Ps[(s * 64 + q) * 33 + kk];
#pragma unroll
                for (int d = 0; d < 16; ++d) o[s][d] += p * Vs[kk * 128 + d * 8 + part]; }
    }
#pragma unroll
    for (int s = 0; s < NSM; ++s) { l[s] += __shfl_xor(l[s], 1); l[s] += __shfl_xor(l[s], 2); l[s] += __shfl_xor(l[s], 4); }
    bf16* mix = (bf16*)(P.ws + WS_MIX) + (uq0 + q) * D;
    if (MODE == 0) {
        const float il = 1.f / l[0];
#pragma unroll
        for (int d = 0; d < 16; ++d) mix[512 + h * 128 + d * 8 + part] = f2bf(o[0][d] * il);
    } else {
        const float* scal = (const float*)(P.ws + WS_SCAL); const float lam = scal[2], oml = scal[3];
        const float il1 = 1.f / l[0], il2 = lam / l[NSM - 1];
        float v[16]; float ss = 0.f;
#pragma unroll
        for (int d = 0; d < 16; ++d) { v[d] = o[0][d] * il1 - o[NSM - 1][d] * il2; ss += v[d] * v[d]; }
        ss += __shfl_xor(ss, 1); ss += __shfl_xor(ss, 2); ss += __shfl_xor(ss, 4);
        const float r = rsqrtf(ss * (1.f / 128.f) + EPS) * oml; const float* sg = P.in[31];
#pragma unroll
        for (int d = 0; d < 16; ++d) mix[h * 128 + d * 8 + part] = f2bf(v[d] * r * sg[d * 8 + part]);
    }
}

struct Args { Ptrs P; int ph_lo, ph_hi; };
constexpr int N_PHASES = 19;
__global__ void __launch_bounds__(NT, 2) mega(Args args) {
    extern __shared__ __attribute__((aligned(16))) unsigned char lds[];
    const Ptrs& P = args.P;
    unsigned char* ws = P.ws;
    const int tid = threadIdx.x, G = gridDim.x;
    volatile LAS unsigned* MISC = (volatile LAS unsigned*)((LAS unsigned char*)lds + MISC_OFF);
    for (int u = tid; u < (LDS_BYTES - LDSCTL_OFF) / 4; u += NT) ((LAS unsigned*)((LAS unsigned char*)lds + LDSCTL_OFF))[u] = 0u;
    __syncthreads();
    XcdBarrier bar = xcd_barrier_post((unsigned*)(ws + WS_CTL) + CW_BAR, MISC + 8);
    const int lo = args.ph_lo, hi = args.ph_hi;
#define IN(k) (lo <= (k) && (k) < hi)
#define SEAM(k) do { if (IN(k) && IN((k) + 1)) xcd_barrier(bar); } while (0)
    const bf16* H = (const bf16*)(ws + WS_H); bf16* Z = (bf16*)(ws + WS_Z); const bf16* MIX = (const bf16*)(ws + WS_MIX);
    const bf16* Qm = (const bf16*)(ws + WS_QM); const bf16* Km = (const bf16*)(ws + WS_KM); const bf16* Vm = (const bf16*)(ws + WS_VM);

    if (IN(0)) { ph_prologue(P, lds); } SEAM(0);
    if (IN(1)) { ph_rows(P, 0, 0, 0, 0); } SEAM(1);
    if (IN(2)) { ProbPlain pr{H, D, (const bf16*)(ws + WS_WEVIN), D, Z, EVEN_IN_P, 0}; ph_gemm_naive<ProbPlain, false>(pr, lds, R / 128, EVEN_IN_P / 64, 0); } SEAM(2);
    if (IN(3)) {
        { ProbPlain pr{Z + 1024, EVEN_IN_P, (const bf16*)(ws + WS_WUQ), 384, (bf16*)(ws + WS_QP), 768, 0}; ph_gemm_naive<ProbPlain, false>(pr, lds, R / 128, 768 / 64, 0); }
        { ProbPlain pr{Z + 1408, EVEN_IN_P, (const bf16*)(ws + WS_WUKV), 256, (bf16*)(ws + WS_KVP), 1024, 0}; ph_gemm_naive<ProbPlain, false>(pr, lds, R / 128, 1024 / 64, (R / 128) * 12); }
        ph_lru(P, lds, 0, (R / 128) * 28);
    } SEAM(3);
    if (IN(4)) { ph_mla_prep(P); } SEAM(4);
    if (IN(5)) {
        ph_lru(P, lds, 1, 0);
        const float c2 = 0.07216878364870322f * LOG2E;
        const int nlat = (SEQ / 64) * MLA_H * NB, nctx = (CTX / 64) * MLA_H * NB;
        int first = ((int)blockIdx.x - (8 * NCH * NB) % G + G) % G;
        for (int it = first; it < nlat + nctx; it += G) {
            if (it < nlat) { const int qb = it % (SEQ / 64), h = (it / (SEQ / 64)) % MLA_H, b = it / ((SEQ / 64) * MLA_H);
                attn_naive_item<192, 1, 0>(P, (float*)lds, Qm, 768, 192, Km, 768, 192, Vm, 512, 128, CTX, 0, SU, c2, 0, qb, h, b); }
            else { const int i2 = it - nlat; const int qb = i2 % (CTX / 64), h = (i2 / (CTX / 64)) % MLA_H, b = i2 / ((CTX / 64) * MLA_H);
                attn_naive_item<192, 1, 0>(P, (float*)lds, Qm, 768, 192, Km, 768, 192, Vm, 512, 128, 0, 0, CTX, c2, 0, qb, h, b); }
        }
        __syncthreads();
    } SEAM(5);
    if (IN(6)) { ProbOut pr{P, MIX, (const bf16*)(ws + WS_WEVOUT), D, 0, 0, 0}; ph_gemm_naive<ProbOut, false>(pr, lds, R / 128, D / 64, 0); } SEAM(6);
    if (IN(7)) { ph_rows(P, 0, 1, 0, 0); } SEAM(7);
    if (IN(8)) { ProbMoe1 pr{P, 0, D, 0, 0, 0, 0}; ph_gemm_naive<ProbMoe1, true>(pr, lds, (R * TOPK) / 128 + NE, 1024 / 64, 0); } SEAM(8);
    if (IN(9)) { ProbMoe2 pr{P, 0, D, 0, 0, 0, 0}; ph_gemm_naive<ProbMoe2, false>(pr, lds, (R * TOPK) / 128 + NE, 1024 / 64, 0); } SEAM(9);
    if (IN(10)) { ph_rows(P, 0, 2, 0, 1); } SEAM(10);
    if (IN(11)) { ProbPlain pr{H, D, (const bf16*)(ws + WS_WODIN), D, Z, ODD_IN, 0}; ph_gemm_naive<ProbPlain, false>(pr, lds, R / 128, ODD_IN / 64, 0); } SEAM(11);
    if (IN(12)) { ph_diff_prep(P); } SEAM(12);
    if (IN(13)) {
        const float c2 = 0.125f * LOG2E; const int n = (SEQ / 64) * DIFF_H * NB;
        for (int it = (int)blockIdx.x; it < n; it += G) { const int qb = it % (SEQ / 64), h = (it / (SEQ / 64)) % DIFF_H, b = it / ((SEQ / 64) * DIFF_H);
            attn_naive_item<64, 2, 1>(P, (float*)lds, Z, ODD_IN, 128, Z + 1024, ODD_IN, 128, Z + 2048, ODD_IN, 128, CTX, 0, SU, c2, 1, qb, h, b); }
        __syncthreads();
    } SEAM(13);
    if (IN(14)) { ProbOut pr{P, MIX, (const bf16*)(ws + WS_WODOUT), D, 1, 1, 0}; ph_gemm_naive<ProbOut, false>(pr, lds, R / 128, D / 64, 0); } SEAM(14);
    if (IN(15)) { ph_rows(P, 1, 1, 1, 0); } SEAM(15);
    if (IN(16)) { ProbMoe1 pr{P, 1, D, 0, 0, 0, 0}; ph_gemm_naive<ProbMoe1, true>(pr, lds, (R * TOPK) / 128 + NE, 1024 / 64, 0); } SEAM(16);
    if (IN(17)) { ProbMoe2 pr{P, 1, D, 0, 0, 0, 0}; ph_gemm_naive<ProbMoe2, false>(pr, lds, (R * TOPK) / 128 + NE, 1024 / 64, 0); } SEAM(17);
    if (IN(18)) { ph_rows(P, 1, 2, 1, 0); }
#undef IN
#undef SEAM
}

#ifndef MK_PER_PHASE
#define MK_PER_PHASE 0
#endif
extern "C" void kernel_launch(void* const* d_in, const int* in_sizes, int n_in, void* d_out, int out_size, void* d_ws, size_t ws_size, hipStream_t stream) {
    static int grid = 0;
    if (grid == 0) {
        if (n_in != 38 || ws_size < WS_END) { fprintf(stderr, "kernel_launch: bad args n_in=%d ws=%zu need %zu\n", n_in, ws_size, (size_t)WS_END); grid = -1; return; }
        int dev = 0, cus = 0, per_cu = 0;
        if (hipGetDevice(&dev) != hipSuccess || hipDeviceGetAttribute(&cus, hipDeviceAttributeMultiprocessorCount, dev) != hipSuccess) { grid = -1; return; }
        if (hipFuncSetAttribute((const void*)mega, hipFuncAttributeMaxDynamicSharedMemorySize, LDS_BYTES) != hipSuccess) { fprintf(stderr, "kernel_launch: hipFuncSetAttribute failed\n"); grid = -1; return; }
        if (hipOccupancyMaxActiveBlocksPerMultiprocessor(&per_cu, (const void*)mega, NT, LDS_BYTES) != hipSuccess || per_cu < 1) { fprintf(stderr, "kernel_launch: occupancy query says %d blocks/CU\n", per_cu); grid = -1; return; }
        (void)hipGetLastError();
        grid = cus;
    }
    if (grid < 0) return;
    if (hipMemsetAsync((char*)d_ws + WS_CTL, 0, 1u << 20, stream) != hipSuccess) return;
    Args a; memset((void*)&a, 0, sizeof(a));
    for (int i = 0; i < 38; ++i) a.P.in[i] = (const float*)d_in[i];
    a.P.out = (float*)d_out; a.P.ws = (unsigned char*)d_ws;
#if MK_PER_PHASE
    for (int p = 0; p < N_PHASES; ++p) { a.ph_lo = p; a.ph_hi = p + 1; hipLaunchKernelGGL(mega, dim3(grid), dim3(NT), LDS_BYTES, stream, a); }
#else
    a.ph_lo = 0; a.ph_hi = N_PHASES;
    hipLaunchKernelGGL(mega, dim3(grid), dim3(NT), LDS_BYTES, stream, a);
#endif
    const hipError_t le = hipPeekAtLastError();
    if (le != hipSuccess) fprintf(stderr, "kernel_launch: launch failed: %s\n", hipGetErrorName(le));
}
```

```cpp
#include <hip/hip_runtime.h>
#include <cstdio>
#include <cstdint>
#include <cstring>

typedef unsigned short bf16;
typedef unsigned u32x4 __attribute__((ext_vector_type(4)));
typedef float f32x4 __attribute__((ext_vector_type(4)));

constexpr int D = 1024, NB = 4, SEQ = 4096, CTX = 256, SU = SEQ + CTX, R = NB * SU;
constexpr int GRID_W = 64;
constexpr int LRU_W = 512, LRU_NB = 8, LRU_BW = 64;
constexpr int MLA_H = 4, MLA_QR = 384, MLA_KVR = 256, MLA_NOPE = 128, MLA_ROPE = 64, MLA_V = 128, MLA_QK = 192;
constexpr int EVEN_IN = 1728, EVEN_IN_P = 1792;
constexpr int DIFF_H = 8, ODD_IN = 3072;
constexpr int NE = 32, TOPK = 4, DFF = 1024;
constexpr float EPS = 1e-6f;
constexpr int CHUNK = 128, NCH = SU / CHUNK;

constexpr size_t al256(size_t x) { return (x + 255) / 256 * 256; }
constexpr size_t WS_CTL = 0;
constexpr size_t WS_MOD = 1u << 20;
constexpr size_t WS_SCAL = WS_MOD + al256(2 * 5 * 6144 * 4);
constexpr size_t WS_WEVIN = WS_SCAL + 4096;
constexpr size_t WS_WEVOUT = WS_WEVIN + (size_t)EVEN_IN_P * D * 2;
constexpr size_t WS_WUQ = WS_WEVOUT + (size_t)D * D * 2;
constexpr size_t WS_WUKV = WS_WUQ + (size_t)768 * 384 * 2;
constexpr size_t WS_WLRU = WS_WUKV + (size_t)1024 * 256 * 2;
constexpr size_t WS_WODIN = WS_WLRU + (size_t)32 * 4096 * 2;
constexpr size_t WS_WODOUT = WS_WODIN + (size_t)ODD_IN * D * 2;
constexpr size_t WS_WGU = WS_WODOUT + (size_t)D * D * 2;
constexpr size_t WS_WDN = WS_WGU + (size_t)2 * NE * 2048 * 1024 * 2;
constexpr size_t WS_XC = WS_WDN + (size_t)2 * NE * 1024 * 1024 * 2;
constexpr size_t WS_H = WS_XC + (size_t)NB * CTX * D * 4;
constexpr size_t WS_Z = WS_H + (size_t)R * D * 2;
constexpr size_t WS_QP = WS_Z + (size_t)R * ODD_IN * 2;
constexpr size_t WS_KVP = WS_QP + (size_t)R * 768 * 2;
constexpr size_t WS_QM = WS_KVP + (size_t)R * 1024 * 2;
constexpr size_t WS_KM = WS_QM + (size_t)R * 768 * 2;
constexpr size_t WS_VM = WS_KM + (size_t)R * 768 * 2;
constexpr size_t WS_AGG = WS_VM + (size_t)R * 512 * 2;
constexpr size_t WS_MIX = WS_AGG + al256((size_t)NB * NCH * 2 * 512 * 2 * 4);
constexpr size_t WS_TOKOF = WS_MIX + (size_t)R * D * 2;
constexpr size_t WS_PAIROF = WS_TOKOF + (size_t)NE * R * 4;
constexpr size_t WS_GATEOF = WS_PAIROF + (size_t)NE * R * 4;
constexpr size_t ACT_ROWS = (size_t)R * TOPK + NE * 256;
constexpr size_t WS_ACT = WS_GATEOF + (size_t)NE * R * 4;
constexpr size_t WS_Y = WS_ACT + ACT_ROWS * 1024 * 2;
constexpr size_t WS_END = WS_Y + (size_t)R * TOPK * 1024 * 2;

constexpr int CW_CNT = 64;

__device__ __forceinline__ float bf2f(bf16 v) { return __uint_as_float((unsigned)v << 16); }
__device__ __forceinline__ bf16 f2bf(float f) { unsigned u = __float_as_uint(f); return (bf16)((u + 0x7fffu + ((u >> 16) & 1u)) >> 16); }
__device__ __forceinline__ float wave_sum(float v) {
#pragma unroll
    for (int o = 1; o < 64; o <<= 1) v += __shfl_xor(v, o);
    return v;
}
__device__ __forceinline__ float sigmoidf_(float x) { return 1.f / (1.f + __expf(-x)); }
__device__ __forceinline__ float gelu_tanh(float x) { const float t = tanhf(0.7978845608028654f * (x + 0.044715f * x * x * x)); return 0.5f * x * (1.f + t); }

struct Ptrs {
    const float* in[38];
    float* out;
    unsigned char* ws;
};

__device__ __forceinline__ const float* res_in_row(const Ptrs& P, int layer, int u) {
    const int b = u / SU, j = u % SU;
    if (layer == 0) return j < CTX ? P.in[2] + (size_t)(b * CTX + j) * D : P.in[0] + (size_t)(b * SEQ + j - CTX) * D;
    return j < CTX ? (const float*)(P.ws + WS_XC) + (size_t)(b * CTX + j) * D : P.out + (size_t)(b * SEQ + j - CTX) * D;
}
__device__ __forceinline__ float* res_out_row(const Ptrs& P, int u) {
    const int b = u / SU, j = u % SU;
    return j < CTX ? (float*)(P.ws + WS_XC) + (size_t)(b * CTX + j) * D : P.out + (size_t)(b * SEQ + j - CTX) * D;
}
__device__ __forceinline__ const float* mod_row(const Ptrs& P, int layer, int u) {
    const int b = u / SU, j = u % SU;
    return (const float*)(P.ws + WS_MOD) + (size_t)(layer * 5 + (j < CTX ? 4 : b)) * 6144;
}

constexpr float LOG2E = 1.4426950408889634f;
#define GAS __attribute__((address_space(1)))
#define LAS __attribute__((address_space(3)))
constexpr int NT = 512;
constexpr int LDS_BYTES = 147456;
constexpr int RING_BYTES = 131072, LDSCTL_OFF = RING_BYTES, MISC_OFF = LDSCTL_OFF + 320;
constexpr int CW_BAR = 4096;
constexpr int CW_TMO = 0;

#define XB_TMO      128
#define XB_XCNT(j)  (256  + 64 * (j))
#define XB_XSUB(j)  (1280 + 64 * (j))
#define XB_XGEN(j)  (2304 + 64 * (j))
#define XB_TOP      3328
#define XB_TOPGEN   3392
#define XCD_BAR_WORDS 3456
#define XB_SPIN_CAP (1u << 22)
__device__ __forceinline__ unsigned xb_ld(unsigned* p)              { return __hip_atomic_load(p, __ATOMIC_RELAXED, __HIP_MEMORY_SCOPE_AGENT); }
__device__ __forceinline__ unsigned xb_add(unsigned* p, unsigned v) { return __hip_atomic_fetch_add(p, v, __ATOMIC_RELAXED, __HIP_MEMORY_SCOPE_AGENT); }
__device__ __forceinline__ unsigned xb_xcc_id() { return (unsigned)__builtin_amdgcn_s_getreg((3 << 11) | 20) & 0xFu; }
#define XB_SPIN(cond, bar) do { unsigned _sp = 0; while (cond) { __builtin_amdgcn_s_sleep(1); \
    if ((++_sp & 255u) == 0u) { if (xb_ld(&(bar)[XB_TMO])) break; if (_sp > XB_SPIN_CAP) { atomicAdd(&(bar)[XB_TMO], 1u); break; } } } } while (0)
struct XcdBarrier { unsigned* bar; unsigned x; volatile LAS unsigned* st; };
__device__ __forceinline__ XcdBarrier xcd_barrier_post(unsigned* bar, volatile LAS unsigned* st) {
    XcdBarrier b; b.bar = bar; b.x = xb_xcc_id(); b.st = st;
    if (threadIdx.x == 0) (void)xb_add(&bar[XB_XCNT(b.x)], 1u);
    return b;
}
__device__ __forceinline__ void xcd_barrier_complete(unsigned* bar, unsigned x, unsigned& nloc, unsigned& nx) {
    const unsigned G = gridDim.x * gridDim.y * gridDim.z;
    unsigned sum, cnt, mine, sp = 0u;
    for (;;) {
        sum = 0u; cnt = 0u; mine = 0u;
#pragma unroll
        for (unsigned j = 0; j < 16; ++j) { const unsigned c = xb_ld(&bar[XB_XCNT(j)]); sum += c; cnt += (c > 0u) ? 1u : 0u; mine = (j == x) ? c : mine; }
        if (sum == G) break;
        __builtin_amdgcn_s_sleep(1);
        if ((++sp & 255u) == 0u) { if (xb_ld(&bar[XB_TMO])) break; if (sp > XB_SPIN_CAP) { atomicAdd(&bar[XB_TMO], 1u); break; } }
    }
    nloc = mine > 0u ? mine : 1u; nx = cnt > 0u ? cnt : 1u;
}
__device__ __forceinline__ void xcd_barrier(const XcdBarrier& b) {
    asm volatile("s_waitcnt vmcnt(0)" ::: "memory");
    __syncthreads();
    if (threadIdx.x == 0) {
        unsigned* bar = b.bar;
        __builtin_amdgcn_s_waitcnt(0);
        unsigned nloc = b.st[0], nx = b.st[1];
        if (nloc == 0u) { xcd_barrier_complete(bar, b.x, nloc, nx); b.st[0] = nloc; b.st[1] = nx; }
        const unsigned old = xb_add(&bar[XB_XSUB(b.x)], 1u);
        const unsigned gen = old / nloc;
        if (old + 1u == (gen + 1u) * nloc) {
            __builtin_amdgcn_fence(__ATOMIC_RELEASE, "agent");
            asm volatile("s_waitcnt vmcnt(0)" ::: "memory");
            const unsigned og = xb_add(&bar[XB_TOP], 1u);
            const unsigned tg = og / nx;
            if (og + 1u == (tg + 1u) * nx) xb_add(&bar[XB_TOPGEN], 1u);
            else XB_SPIN(xb_ld(&bar[XB_TOPGEN]) == tg, bar);
            __builtin_amdgcn_fence(__ATOMIC_ACQUIRE, "agent");
            xb_add(&bar[XB_XGEN(b.x)], 1u);
            asm volatile("s_waitcnt vmcnt(0)" ::: "memory");
        } else {
            XB_SPIN(xb_ld(&bar[XB_XGEN(b.x)]) == gen, bar);
            __builtin_amdgcn_fence(__ATOMIC_ACQUIRE, "agent");
            asm volatile("s_waitcnt vmcnt(0)" ::: "memory");
        }
    }
    __syncthreads();
}

__device__ __forceinline__ void transpose_tile(const float* __restrict__ src, int K, int N, bf16* __restrict__ dst, const float* __restrict__ rowscale, int perm, int n0, int k0, float* tile  ) {
    const int tid = threadIdx.x;
    __syncthreads();
#pragma unroll
    for (int i = 0; i < 8; ++i) {
        const int k = i * 8 + (tid >> 6), n = tid & 63; const int np = n0 + n;
        int sc = np; if (perm == 1) sc = (np / 256) * 128 + (np % 128) + ((np % 256) / 128) * 1024;
        float v = 0.f; if (sc < N) v = src[(size_t)(k0 + k) * N + sc];
        if (rowscale) v *= rowscale[k0 + k];
        tile[k * 65 + n] = v;
    }
    __syncthreads();
#pragma unroll
    for (int i = 0; i < 8; ++i) {
        const int n = i * 8 + (tid >> 6), k = tid & 63;
        dst[(size_t)(n0 + n) * K + k0 + k] = f2bf(tile[k * 65 + n]);
    }
}
struct TJob { const float* src; bf16* dst; const float* rs; int K, N, Npad, perm, batch; size_t sstr, dstr; };
__device__ __forceinline__ void run_tjob(const TJob& j, float* tile, int& base, int G) {
    const int tn = j.Npad / 64, tk = j.K / 64, per = tn * tk, total = per * j.batch;
    int first = ((int)blockIdx.x - base % G + G) % G;
    for (int it = first; it < total; it += G) { const int z = it / per, r = it % per; transpose_tile(j.src + z * j.sstr, j.K, j.N, j.dst + z * j.dstr, j.rs, j.perm, (r % tn) * 64, (r / tn) * 64, tile); }
    base += total;
}
__device__ __forceinline__ void ph_prologue(const Ptrs& P, unsigned char* lds) {
    float* tile = (float*)lds; unsigned char* ws = P.ws; const int G = gridDim.x; int base = 0;
    TJob j;
    j = TJob{P.in[34], (bf16*)(ws + WS_WGU), nullptr, 1024, 2048, 2048, 1, 2 * NE, (size_t)1024 * 2048, (size_t)2048 * 1024}; run_tjob(j, tile, base, G);
    j = TJob{P.in[36], (bf16*)(ws + WS_WDN), nullptr, 1024, 1024, 1024, 0, 2 * NE, (size_t)1024 * 1024, (size_t)1024 * 1024}; run_tjob(j, tile, base, G);
    j = TJob{P.in[8], (bf16*)(ws + WS_WEVIN), nullptr, 1024, EVEN_IN, EVEN_IN_P, 0, 1, 0, 0}; run_tjob(j, tile, base, G);
    j = TJob{P.in[9], (bf16*)(ws + WS_WEVOUT), nullptr, 1024, 1024, 1024, 0, 1, 0, 0}; run_tjob(j, tile, base, G);
    j = TJob{P.in[18], (bf16*)(ws + WS_WUQ), P.in[17], 384, 768, 768, 0, 1, 0, 0}; run_tjob(j, tile, base, G);
    j = TJob{P.in[20], (bf16*)(ws + WS_WUKV), P.in[19], 256, 1024, 1024, 0, 1, 0, 0}; run_tjob(j, tile, base, G);
    j = TJob{P.in[12], (bf16*)(ws + WS_WLRU), nullptr, 64, 64, 64, 0, 8, 4096, 4096}; run_tjob(j, tile, base, G);
    j = TJob{P.in[14], (bf16*)(ws + WS_WLRU) + 8 * 4096, nullptr, 64, 64, 64, 0, 8, 4096, 4096}; run_tjob(j, tile, base, G);
    j = TJob{P.in[12] + 8 * 4096, (bf16*)(ws + WS_WLRU) + 16 * 4096, nullptr, 64, 64, 64, 0, 8, 4096, 4096}; run_tjob(j, tile, base, G);
    j = TJob{P.in[14] + 8 * 4096, (bf16*)(ws + WS_WLRU) + 24 * 4096, nullptr, 64, 64, 64, 0, 8, 4096, 4096}; run_tjob(j, tile, base, G);
    j = TJob{P.in[23], (bf16*)(ws + WS_WODIN), nullptr, 1024, ODD_IN, ODD_IN, 0, 1, 0, 0}; run_tjob(j, tile, base, G);
    j = TJob{P.in[24], (bf16*)(ws + WS_WODOUT), nullptr, 1024, 1024, 1024, 0, 1, 0, 0}; run_tjob(j, tile, base, G);
    __syncthreads();
    {
        float* s = (float*)lds;
        for (int it = (int)blockIdx.x; it < 24; it += G) {
            const int layer = it / 12, jc = (it % 12) * 512 + threadIdx.x;
            __syncthreads();
            for (int i = threadIdx.x; i < 5 * 1024; i += NT) { const int r = i / 1024, k = i % 1024; const float c = r < 4 ? P.in[1][r * 1024 + k] : P.in[3][k]; s[i] = c / (1.f + __expf(-c)); }
            __syncthreads();
            const float* w = P.in[4] + (size_t)layer * 1024 * 6144;
            float a[5] = {0, 0, 0, 0, 0};
            for (int k = 0; k < 1024; ++k) { const float wv = w[(size_t)k * 6144 + jc];
#pragma unroll
                for (int r = 0; r < 5; ++r) a[r] += s[r * 1024 + k] * wv; }
            const float bv = P.in[5][layer * 6144 + jc];
            float* o = (float*)(ws + WS_MOD) + (size_t)layer * 5 * 6144;
#pragma unroll
            for (int r = 0; r < 5; ++r) o[r * 6144 + jc] = a[r] + bv;
        }
    }
    if ((int)blockIdx.x == G - 1 && threadIdx.x == 0) {
        float* sc = (float*)(ws + WS_SCAL);
        float mq = 0, mk = 0;
        for (int i = 0; i < 192; ++i) { mq = fmaxf(mq, fabsf(P.in[21][i])); mk = fmaxf(mk, fabsf(P.in[22][i])); }
        sc[0] = sqrtf(192.f) * mq * mk * LOG2E;
        mq = 0; mk = 0;
        for (int i = 0; i < 64; ++i) { mq = fmaxf(mq, fabsf(P.in[25][i])); mk = fmaxf(mk, fabsf(P.in[26][i])); }
        sc[1] = 8.f * mq * mk * LOG2E;
        float s1 = 0, s2 = 0;
        for (int i = 0; i < 64; ++i) { s1 += P.in[27][i] * P.in[28][i]; s2 += P.in[29][i] * P.in[30][i]; }
        const float lam_init = 0.8f - 0.6f * expf(-0.3f * 1.f);
        sc[2] = expf(s1) - expf(s2) + lam_init;
        sc[3] = 1.f - lam_init;
    }
}

__device__ __forceinline__ void norm_mod_store(const Ptrs& P, float (&v)[16], int lane, int u, int layer, int which) {
    const float* g = (which == 0 ? P.in[6] : P.in[7]) + layer * D;
    const float* md = mod_row(P, layer, u) + (which == 0 ? 0 : 3 * D);
    float ss = 0.f;
#pragma unroll
    for (int i = 0; i < 16; ++i) ss += v[i] * v[i];
    const float rstd = rsqrtf(wave_sum(ss) * (1.f / D) + EPS);
    bf16* h = (bf16*)(P.ws + WS_H) + (size_t)u * D;
#pragma unroll
    for (int j = 0; j < 4; ++j) {
        const int c = j * 256 + lane * 4;
        const f32x4 gv = *(const f32x4*)(g + c), scv = *(const f32x4*)(md + D + c), shv = *(const f32x4*)(md + c);
#pragma unroll
        for (int e = 0; e < 4; ++e) v[4 * j + e] = v[4 * j + e] * rstd * gv[e] * (1.f + scv[e]) + shv[e];
        const unsigned lo = f2bf(v[4 * j]) | ((unsigned)f2bf(v[4 * j + 1]) << 16), hi = f2bf(v[4 * j + 2]) | ((unsigned)f2bf(v[4 * j + 3]) << 16);
        *(uint2*)(h + c) = make_uint2(lo, hi);
    }
}
__device__ __forceinline__ void router_row(const Ptrs& P, const float (&v)[16], int lane, int u, int layer) {
    const float* rw = P.in[32] + (size_t)layer * D * NE; const float* rb = P.in[33] + layer * NE;
    float lg[NE];
#pragma unroll
    for (int e = 0; e < NE; ++e) lg[e] = 0.f;
    for (int j = 0; j < 4; ++j)
        for (int q = 0; q < 4; ++q) { const int c = j * 256 + lane * 4 + q; const float hv = v[4 * j + q];
#pragma unroll
            for (int e4 = 0; e4 < NE / 4; ++e4) { const f32x4 w = *(const f32x4*)(rw + (size_t)c * NE + e4 * 4); lg[e4 * 4] += hv * w[0]; lg[e4 * 4 + 1] += hv * w[1]; lg[e4 * 4 + 2] += hv * w[2]; lg[e4 * 4 + 3] += hv * w[3]; } }
#pragma unroll
    for (int e = 0; e < NE; ++e) lg[e] = wave_sum(lg[e]) + rb[e];
    int te[4]; float tv[4];
#pragma unroll
    for (int k = 0; k < 4; ++k) { float best = -3.4e38f; int bi = 0;
#pragma unroll
        for (int e = 0; e < NE; ++e) { const bool ok = lg[e] > best; best = ok ? lg[e] : best; bi = ok ? e : bi; }
        te[k] = bi; tv[k] = best;
#pragma unroll
        for (int e = 0; e < NE; ++e) lg[e] = (e == bi) ? -3.4e38f : lg[e]; }
    float den = 0.f, w[4];
#pragma unroll
    for (int k = 0; k < 4; ++k) { w[k] = __expf(tv[k] - tv[0]); den += w[k]; }
    if (lane == 0) {
        unsigned* cnt = (unsigned*)(P.ws + WS_CTL) + CW_CNT + layer * 64;
        int* tok_of = (int*)(P.ws + WS_TOKOF); int* pair_of = (int*)(P.ws + WS_PAIROF); float* gate_of = (float*)(P.ws + WS_GATEOF);
#pragma unroll
        for (int k = 0; k < 4; ++k) { const unsigned rk = atomicAdd(&cnt[te[k]], 1u); tok_of[(size_t)te[k] * R + rk] = u; pair_of[(size_t)te[k] * R + rk] = u * 4 + k; gate_of[(size_t)te[k] * R + rk] = w[k] / den; }
    }
}
__device__ __forceinline__ void ph_rows(const Ptrs& P, int layer, int mode, int latent_only, int next_norm) {
    const int wave = threadIdx.x >> 6, lane = threadIdx.x & 63, G = gridDim.x;
    for (int u = (int)blockIdx.x * 8 + wave; u < R; u += G * 8) {
        if (latent_only && (u % SU) < CTX) continue;
        float v[16];
        const float* x = (mode == 0) ? res_in_row(P, layer, u) : (const float*)res_out_row(P, u);
#pragma unroll
        for (int j = 0; j < 4; ++j) { const f32x4 t = *(const f32x4*)(x + j * 256 + lane * 4); v[4 * j] = t[0]; v[4 * j + 1] = t[1]; v[4 * j + 2] = t[2]; v[4 * j + 3] = t[3]; }
        if (mode == 2) {
            const float* g2 = mod_row(P, layer, u) + 5 * D; float* xo = res_out_row(P, u);
            const bf16* y = (const bf16*)(P.ws + WS_Y) + (size_t)u * 4 * 1024;
#pragma unroll
            for (int j = 0; j < 4; ++j) { const int c = j * 256 + lane * 4; const f32x4 gv = *(const f32x4*)(g2 + c); f32x4 o;
#pragma unroll
                for (int e = 0; e < 4; ++e) { const float f = bf2f(y[c + e]) + bf2f(y[1024 + c + e]) + bf2f(y[2048 + c + e]) + bf2f(y[3072 + c + e]); v[4 * j + e] += gv[e] * f; o[e] = v[4 * j + e]; }
                *(f32x4*)(xo + c) = o; }
            if (next_norm) norm_mod_store(P, v, lane, u, layer + 1, 0);
        } else {
            norm_mod_store(P, v, lane, u, layer, mode);
            if (mode == 1) router_row(P, v, lane, u, layer);
        }
    }
}

template <class Prob, bool PAIR>
__device__ __forceinline__ void gemm_naive_tile(Prob& pr, float* lds, int n0) {
    float* As = lds;
    float* Bs = As + 32 * 132;
    float* B2s = Bs + 32 * 68;
    const int tid = threadIdx.x, tx = tid & 15, ty = tid >> 4;
    float acc[4][4] = {}, acc2[4][4] = {};
    const int lr = tid >> 2, lk = (tid & 3) * 8;
    const bf16* ap = pr.arow(lr); const bf16* bp = pr.brow(n0 + (lr & 63)); const bf16* b2p = PAIR ? pr.brow2(n0 + (lr & 63)) : nullptr;
    for (int k0 = 0; k0 < pr.K; k0 += 32) {
        u32x4 av = {0, 0, 0, 0}; if (ap) av = *(const u32x4*)(ap + k0 + lk);
        u32x4 bv = {0, 0, 0, 0}, b2v = {0, 0, 0, 0};
        if (lr < 64) bv = *(const u32x4*)(bp + k0 + lk); else if (PAIR) b2v = *(const u32x4*)(b2p + k0 + lk);
        __syncthreads();
#pragma unroll
        for (int i = 0; i < 4; ++i) {
            As[(lk + 2 * i) * 132 + lr] = __uint_as_float(av[i] << 16); As[(lk + 2 * i + 1) * 132 + lr] = __uint_as_float(av[i] & 0xffff0000u);
            if (lr < 64) { Bs[(lk + 2 * i) * 68 + lr] = __uint_as_float(bv[i] << 16); Bs[(lk + 2 * i + 1) * 68 + lr] = __uint_as_float(bv[i] & 0xffff0000u); }
            else if (PAIR) { B2s[(lk + 2 * i) * 68 + lr - 64] = __uint_as_float(b2v[i] << 16); B2s[(lk + 2 * i + 1) * 68 + lr - 64] = __uint_as_float(b2v[i] & 0xffff0000u); }
        }
        __syncthreads();
#pragma unroll 8
        for (int k = 0; k < 32; ++k) {
            const f32x4 a = *(const f32x4*)&As[k * 132 + ty * 4]; const f32x4 b = *(const f32x4*)&Bs[k * 68 + tx * 4];
#pragma unroll
            for (int i = 0; i < 4; ++i)
#pragma unroll
                for (int j = 0; j < 4; ++j) acc[i][j] += a[i] * b[j];
            if (PAIR) { const f32x4 b2 = *(const f32x4*)&B2s[k * 68 + tx * 4];
#pragma unroll
                for (int i = 0; i < 4; ++i)
#pragma unroll
                    for (int j = 0; j < 4; ++j) acc2[i][j] += a[i] * b2[j]; }
        }
    }
#pragma unroll
    for (int i = 0; i < 4; ++i)
#pragma unroll
        for (int j = 0; j < 4; ++j) pr.epi(ty * 4 + i, n0 + tx * 4 + j, acc[i][j], acc2[i][j]);
}
template <class Prob, bool PAIR>
__device__ __forceinline__ void ph_gemm_naive(Prob pr, unsigned char* lds, int nMt, int nNt, int item0) {
    const int G = gridDim.x, total = nMt * nNt;
    int first = ((int)blockIdx.x - item0 % G + G) % G;
    for (int it = first; it < total; it += G) { const int mt = it / nNt, nt = it % nNt; if (!pr.setup(mt)) continue; gemm_naive_tile<Prob, PAIR>(pr, (float*)lds, nt * 64); }
    __syncthreads();
}
struct ProbPlain {
    const bf16* A; int lda; const bf16* Bt; int K; bf16* C; int ldc; int m0;
    __device__ bool setup(int by) { m0 = by * 128; return true; }
    __device__ const bf16* arow(int m) const { return A + (size_t)(m0 + m) * lda; }
    __device__ const bf16* brow(int n) const { return Bt + (size_t)n * K; }
    __device__ const bf16* brow2(int n) const { return nullptr; }
    __device__ void epi(int m, int n, float a, float) const { C[(size_t)(m0 + m) * ldc + n] = f2bf(a); }
};
struct ProbOut {
    Ptrs P; const bf16* A; const bf16* Bt; int K; int layer; int latent_only; int m0;
    __device__ bool setup(int by) { m0 = by * 128; if (latent_only && (m0 % SU) < CTX) return false; return true; }
    __device__ const bf16* arow(int m) const { return A + (size_t)(m0 + m) * D; }
    __device__ const bf16* brow(int n) const { return Bt + (size_t)n * K; }
    __device__ const bf16* brow2(int n) const { return nullptr; }
    __device__ void epi(int m, int n, float a, float) const { const int u = m0 + m; const float g1 = mod_row(P, layer, u)[2 * D + n]; res_out_row(P, u)[n] = res_in_row(P, layer, u)[n] + g1 * a; }
};
__device__ __forceinline__ bool moe_find(const Ptrs& P, int layer, int t, int rows_per_tile, int& e, int& row0, int& cnt_e, int& actbase) {
    const unsigned* cnt = (const unsigned*)(P.ws + WS_CTL) + CW_CNT + layer * 64;
    int ab = 0;
    for (int x = 0; x < NE; ++x) { const int c = (int)cnt[x], nt = (c + rows_per_tile - 1) / rows_per_tile; if (t < nt) { e = x; row0 = t * rows_per_tile; cnt_e = c; actbase = ab; return true; } t -= nt; ab += (c + 255) / 256 * 256; }
    return false;
}
struct ProbMoe1 {
    Ptrs P; int layer; int K; int e, row0, cnt_e, actbase;
    __device__ bool setup(int by) { return moe_find(P, layer, by, 128, e, row0, cnt_e, actbase); }
    __device__ const bf16* arow(int m) const { const int r = row0 + m; if (r >= cnt_e) return nullptr; const int u = ((const int*)(P.ws + WS_TOKOF))[(size_t)e * R + r]; return (const bf16*)(P.ws + WS_H) + (size_t)u * D; }
    __device__ const bf16* brow(int j) const { return (const bf16*)(P.ws + WS_WGU) + ((size_t)(layer * NE + e) * 2048 + (j / 128) * 256 + (j % 128)) * 1024; }
    __device__ const bf16* brow2(int j) const { return brow(j) + (size_t)128 * 1024; }
    __device__ void epi(int m, int j, float ag, float au) const {
        const int r = row0 + m; if (r >= cnt_e) return;
        const float* bgu = P.in[35] + (size_t)(layer * NE + e) * 2048;
        float g = ag + bgu[j], uu = au + bgu[1024 + j];
        g = fminf(g, 7.f); uu = fminf(fmaxf(uu, -7.f), 7.f);
        const float act = (uu + 1.f) * g * sigmoidf_(1.702f * g);
        ((bf16*)(P.ws + WS_ACT))[(size_t)(actbase + r) * 1024 + j] = f2bf(act);
    }
};
struct ProbMoe2 {
    Ptrs P; int layer; int K; int e, row0, cnt_e, actbase;
    __device__ bool setup(int by) { return moe_find(P, layer, by, 128, e, row0, cnt_e, actbase); }
    __device__ const bf16* arow(int m) const { const int r = row0 + m; if (r >= cnt_e) return nullptr; return (const bf16*)(P.ws + WS_ACT) + (size_t)(actbase + r) * 1024; }
    __device__ const bf16* brow(int n) const { return (const bf16*)(P.ws + WS_WDN) + ((size_t)(layer * NE + e) * 1024 + n) * 1024; }
    __device__ const bf16* brow2(int n) const { return nullptr; }
    __device__ void epi(int m, int n, float a, float) const {
        const int r = row0 + m; if (r >= cnt_e) return;
        const int pair = ((const int*)(P.ws + WS_PAIROF))[(size_t)e * R + r]; const float gw = ((const float*)(P.ws + WS_GATEOF))[(size_t)e * R + r];
        const float y = (a + P.in[37][(size_t)(layer * NE + e) * 1024 + n]) * gw;
        ((bf16*)(P.ws + WS_Y))[(size_t)pair * 1024 + n] = f2bf(y);
    }
};

namespace g8 {
typedef short bf16x8 __attribute__((ext_vector_type(8)));
constexpr int BM = 256, BK = 64, HALF = 128, HTB = HALF * BK * 2, STAGE_BYTES = 8 * HTB, NXCD = 8, WGM = 8;
__host__ __device__ __forceinline__ int lds_byte(int r, int c) { const int st = (r >> 4) * 2 + (c >> 5), rr = r & 15, cc = c & 31, ob = rr * 64 + cc * 2; return st * 1024 + (ob ^ (((ob >> 9) & 1) << 5)); }
__host__ __device__ __forceinline__ void stage_rc(int b, int& R, int& C) { const int st = b / 1024, sb = b % 1024, swz = sb ^ (((sb >> 9) & 1) << 5); R = (st >> 1) * 16 + swz / 64; C = (st & 1) * 32 + (swz % 64) / 2; }
__host__ __device__ __forceinline__ int perm32(int rho) { const int n = rho >> 4, i = rho & 15; return 8 * (i >> 2) + 4 * n + (i & 3); }
struct Unit { const char* a; const char* b; int pm, pn, e, aux, cnt; };
__device__ __forceinline__ unsigned cvt_pk_bf16(float lo, float hi) { unsigned r; asm volatile("v_cvt_pk_bf16_f32 %0, %1, %2" : "=v"(r) : "v"(lo), "v"(hi)); return r; }

template <class Epi, class Sched, bool GATHER, bool ALIGN_EPI>
__device__ __forceinline__ void gemm_phase(LAS unsigned char* lds, const int lda, const int K, const Sched& S, const Epi& E) {
    const int tid = threadIdx.x, wid = __builtin_amdgcn_readfirstlane(tid >> 6), lane = tid & 63, wr = wid >> 2, wc = wid & 3, fr = lane & 15, fq = lane >> 4;
    const int nt = K / BK;
    int Rr[2], Cc[2]; unsigned voffB[2];
#pragma unroll
    for (int i = 0; i < 2; ++i) { stage_rc(tid * 16 + i * 8192, Rr[i], Cc[i]); const int Rb = Epi::PERM ? ((Rr[i] & ~31) + perm32(Rr[i] & 31)) : Rr[i]; voffB[i] = (unsigned)(Rb * K + Cc[i]) * 2u; }
    const size_t kstep = (size_t)(BK * 2);
    const size_t hstepB = (size_t)HALF * K * 2;
    const unsigned ldsw = (unsigned)wid * 1024u;
    const int aoff = lds_byte(wr * 64 + fr, fq * 8), boff = lds_byte(wc * 32 + fr, fq * 8);
#define G8_SA(b, h) (((b) * 2 + (h)) * HTB)
#define G8_SB(b, h) ((4 + (b) * 2 + (h)) * HTB)
#define G8_STAGE(bufoff, gbase, v0, v1) do { \
        __builtin_amdgcn_global_load_lds((const unsigned*)((const char*)(gbase) + (v0)), (LAS unsigned*)(lds + (bufoff) + ldsw), 16, 0, 0); \
        __builtin_amdgcn_global_load_lds((const unsigned*)((const char*)(gbase) + (v1)), (LAS unsigned*)(lds + (bufoff) + ldsw + 8192), 16, 0, 0); } while (0)
#define G8_LDA(dst, b, h) do { _Pragma("unroll") for (int m = 0; m < 4; ++m) _Pragma("unroll") for (int k = 0; k < 2; ++k) dst[m][k] = *(const LAS bf16x8*)(lds + G8_SA(b, h) + aoff + m * 2048 + k * 1024); } while (0)
#define G8_LDB(dst, b, h) do { _Pragma("unroll") for (int n = 0; n < 2; ++n) _Pragma("unroll") for (int k = 0; k < 2; ++k) dst[n][k] = *(const LAS bf16x8*)(lds + G8_SB(b, h) + boff + n * 2048 + k * 1024); } while (0)
#define G8_MMA(ai, bj, At, Bt) do { __builtin_amdgcn_s_setprio(1); _Pragma("unroll") for (int m = 0; m < 4; ++m) _Pragma("unroll") for (int n = 0; n < 2; ++n) _Pragma("unroll") for (int k = 0; k < 2; ++k) \
        acc[ai][bj][m][n] = __builtin_amdgcn_mfma_f32_16x16x32_bf16(Bt[n][k], At[m][k], acc[ai][bj][m][n], 0, 0, 0); __builtin_amdgcn_s_setprio(0); } while (0)
#define G8_WAIT_V(n) asm volatile("s_waitcnt vmcnt(" #n ")" ::: "memory")
#define G8_WAIT_L(n) asm volatile("s_waitcnt lgkmcnt(" #n ")" ::: "memory")
#define G8_BAR __builtin_amdgcn_s_barrier()
#define G8_SCHED __builtin_amdgcn_sched_barrier(0)
    Unit cur, nxt; int ui = 0;
    if (!S.next(0, cur)) return;
    unsigned vA0[2], vA1[2], nA0[2], nA1[2];
#pragma unroll
    for (int i = 0; i < 2; ++i) {
        if (GATHER) { vA0[i] = S.arow_off(cur, Rr[i]) + (unsigned)Cc[i] * 2u; vA1[i] = S.arow_off(cur, HALF + Rr[i]) + (unsigned)Cc[i] * 2u; }
        else { vA0[i] = (unsigned)(Rr[i] * lda + Cc[i]) * 2u; vA1[i] = (unsigned)((HALF + Rr[i]) * lda + Cc[i]) * 2u; }
        nA0[i] = vA0[i]; nA1[i] = vA1[i];
    }
    f32x4 acc[2][2][4][2];
#pragma unroll
    for (int a = 0; a < 2; ++a)
#pragma unroll
        for (int b = 0; b < 2; ++b)
#pragma unroll
            for (int m = 0; m < 4; ++m)
#pragma unroll
                for (int n = 0; n < 2; ++n) acc[a][b][m][n] = (f32x4){0.f, 0.f, 0.f, 0.f};
    bf16x8 At[4][2], B0[2][2], B1[2][2];
    const char* cA = cur.a; const char* cB = cur.b;
    G8_STAGE(G8_SB(0, 0), cB, voffB[0], voffB[1]); G8_STAGE(G8_SB(0, 1), cB + hstepB, voffB[0], voffB[1]); G8_STAGE(G8_SA(0, 0), cA, vA0[0], vA0[1]); G8_STAGE(G8_SA(0, 1), cA, vA1[0], vA1[1]);
    if (wr == 1) G8_BAR;
    G8_WAIT_V(2); G8_BAR;
    G8_STAGE(G8_SB(1, 0), cB + kstep, voffB[0], voffB[1]); G8_STAGE(G8_SA(1, 0), cA + kstep, vA0[0], vA0[1]); G8_STAGE(G8_SB(1, 1), cB + hstepB + kstep, voffB[0], voffB[1]);
    G8_WAIT_V(6); G8_BAR;
    for (;;) {
        const bool has_next = S.next(ui + 1, nxt);
        const char* nA = has_next ? nxt.a : cA; const char* nB = has_next ? nxt.b : cB;
        if (GATHER) {
#pragma unroll
            for (int i = 0; i < 2; ++i) { if (has_next) { nA0[i] = S.arow_off(nxt, Rr[i]) + (unsigned)Cc[i] * 2u; nA1[i] = S.arow_off(nxt, HALF + Rr[i]) + (unsigned)Cc[i] * 2u; } else { nA0[i] = vA0[i]; nA1[i] = vA1[i]; } }
        }
        for (int t = 0; t < nt; t += 2) {
            const bool last = (t == nt - 2);
            const char* a1 = cA + (size_t)(t + 1) * kstep;
            const char* a2 = last ? nA : cA + (size_t)(t + 2) * kstep; const char* b2 = last ? nB : cB + (size_t)(t + 2) * kstep;
            const char* a3 = a2 + kstep; const char* b3 = b2 + kstep;
            unsigned x00 = vA0[0], x01 = vA0[1], x10 = vA1[0], x11 = vA1[1];
            if (GATHER) { x00 = last ? nA0[0] : vA0[0]; x01 = last ? nA0[1] : vA0[1]; x10 = last ? nA1[0] : vA1[0]; x11 = last ? nA1[1] : vA1[1]; }
            G8_LDB(B0, 0, 0); G8_LDB(B1, 0, 1); G8_SCHED; G8_LDA(At, 0, 0); G8_STAGE(G8_SA(1, 1), a1, vA1[0], vA1[1]);
            G8_WAIT_V(8); G8_WAIT_L(0); G8_BAR; G8_MMA(0, 0, At, B0); G8_MMA(0, 1, At, B1); G8_BAR; G8_SCHED;
            G8_LDA(At, 0, 1); G8_STAGE(G8_SB(0, 0), b2, voffB[0], voffB[1]); G8_STAGE(G8_SB(0, 1), b2 + hstepB, voffB[0], voffB[1]); G8_STAGE(G8_SA(0, 0), a2, x00, x01);
            G8_WAIT_V(8); G8_WAIT_L(0); G8_BAR; G8_MMA(1, 0, At, B0); G8_MMA(1, 1, At, B1); G8_BAR; G8_SCHED;
            G8_LDB(B0, 1, 0); G8_LDB(B1, 1, 1); G8_SCHED; G8_LDA(At, 1, 0); G8_STAGE(G8_SA(0, 1), a2, x10, x11);
            G8_WAIT_V(8); G8_WAIT_L(0); G8_BAR; G8_MMA(0, 0, At, B0); G8_MMA(0, 1, At, B1); G8_BAR; G8_SCHED;
            G8_LDA(At, 1, 1); G8_STAGE(G8_SB(1, 0), b3, voffB[0], voffB[1]); G8_STAGE(G8_SB(1, 1), b3 + hstepB, voffB[0], voffB[1]); G8_STAGE(G8_SA(1, 0), a3, x00, x01);
            G8_WAIT_V(8); G8_WAIT_L(0); G8_BAR; G8_MMA(1, 0, At, B0); G8_MMA(1, 1, At, B1); G8_BAR; G8_SCHED;
        }
        if constexpr (ALIGN_EPI) { if (wr == 0) G8_BAR; }
        E(acc, cur, wr, wc, fr, fq);
        if (!has_next) break;
#pragma unroll
        for (int a = 0; a < 2; ++a)
#pragma unroll
            for (int b = 0; b < 2; ++b)
#pragma unroll
                for (int m = 0; m < 4; ++m)
#pragma unroll
                    for (int n = 0; n < 2; ++n) acc[a][b][m][n] = (f32x4){0.f, 0.f, 0.f, 0.f};
        cur = nxt; cA = nA; cB = nB; ++ui;
        if (GATHER) {
#pragma unroll
            for (int i = 0; i < 2; ++i) { vA0[i] = nA0[i]; vA1[i] = nA1[i]; }
        }
        if constexpr (ALIGN_EPI) { if (wr == 1) G8_BAR; }
    }
    G8_WAIT_V(0);
    if constexpr (!ALIGN_EPI) { if (wr == 0) G8_BAR; }
    G8_BAR;
#undef G8_SA
#undef G8_SB
#undef G8_STAGE
#undef G8_LDA
#undef G8_LDB
#undef G8_MMA
#undef G8_WAIT_V
#undef G8_WAIT_L
#undef G8_BAR
#undef G8_SCHED
}

struct DenseOrder {
    const char* A; const char* Bt; int lda, K, nM, nN, nwg, G, c, skip_ctx;
    __device__ void init(const bf16* A_, int lda_, const bf16* Bt_, int K_, int M, int N, int G_, int c_, int skip_ctx_) {
        A = (const char*)A_; Bt = (const char*)Bt_; lda = lda_; K = K_; skip_ctx = skip_ctx_; nM = M / BM; if (skip_ctx) nM = nM / 17 * 16; nN = N / BM; nwg = nM * nN; G = G_; c = c_; }
    __device__ bool next(int i, Unit& u) const {
        const long L = (long)i * G + c; if (L >= nwg) return false;
        int wgid = (int)L; { const int q = nwg / NXCD, r = nwg % NXCD, xcd = wgid % NXCD, off = wgid / NXCD; wgid = (xcd < r ? xcd * (q + 1) : r * (q + 1) + (xcd - r) * q) + off; }
        const int nig = WGM * nN, gid = wgid / nig, fm = gid * WGM, gsz = (nM - fm) < WGM ? (nM - fm) : WGM;
        int pm = fm + ((wgid % nig) % gsz); const int pn = (wgid % nig) / gsz;
        if (skip_ctx) pm = (pm / 16) * 17 + 1 + (pm % 16);
        u.pm = pm; u.pn = pn; u.e = 0; u.aux = 0; u.cnt = 0;
        u.a = A + (size_t)pm * BM * lda * 2; u.b = Bt + (size_t)pn * BM * K * 2; return true;
    }
    __device__ unsigned arow_off(const Unit&, int) const { return 0u; }
};
}
namespace g8 {
struct MoeOrder {
    const unsigned* cnt; const char* Abase; const char* Bbase; const int* rowtab; size_t bstride; int nN, K, G, vcu, gather;
    __device__ bool next(int i, Unit& u) const {
        int L = i * G + vcu, ab = 0;
        for (int e = 0; e < NE; ++e) { const int c = (int)cnt[e], mt = (c + 255) >> 8, tl = mt * nN;
            if (L < tl) { u.e = e; u.pm = L / nN; u.pn = L % nN; u.aux = ab; u.cnt = c;
                u.a = gather ? Abase : Abase + (size_t)(ab + u.pm * 256) * 1024 * 2; u.b = Bbase + (size_t)e * bstride + (size_t)u.pn * 256 * K * 2; return true; }
            L -= tl; ab += mt * 256; }
        return false;
    }
    __device__ unsigned arow_off(const Unit& u, int r) const { int rr = u.pm * 256 + r; rr = rr < u.cnt ? rr : u.cnt - 1; return (unsigned)rowtab[(size_t)u.e * R + rr] * (unsigned)(D * 2); }
};
struct EpiStoreBf16 {
    static constexpr bool PERM = true; bf16* C; int ldc;
    __device__ __forceinline__ void operator()(const f32x4 (&acc)[2][2][4][2], const Unit& u, int wr, int wc, int fr, int fq) const {
        const int row0 = u.pm * BM + wr * 64 + fr, col0 = u.pn * BM + wc * 32 + 8 * fq;
#pragma unroll
        for (int ai = 0; ai < 2; ++ai)
#pragma unroll
            for (int m = 0; m < 4; ++m) { bf16* rowp = C + (size_t)(row0 + ai * HALF + m * 16) * ldc + col0;
#pragma unroll
                for (int bj = 0; bj < 2; ++bj) { const f32x4 v0 = acc[ai][bj][m][0], v1 = acc[ai][bj][m][1];
                    u32x4 w; w.x = cvt_pk_bf16(v0[0], v0[1]); w.y = cvt_pk_bf16(v0[2], v0[3]); w.z = cvt_pk_bf16(v1[0], v1[1]); w.w = cvt_pk_bf16(v1[2], v1[3]);
                    *(u32x4*)(rowp + bj * HALF) = w; } }
    }
};
struct EpiOut {
    static constexpr bool PERM = false; Ptrs P; int layer;
    __device__ __forceinline__ void operator()(const f32x4 (&acc)[2][2][4][2], const Unit& u, int wr, int wc, int fr, int fq) const {
        const int b = u.pm / 17, jt = u.pm % 17;
        const float* g1 = (const float*)(P.ws + WS_MOD) + (size_t)(layer * 5 + (jt == 0 ? 4 : b)) * 6144 + 2 * D;
        const float* in0; float* out0;
        if (jt == 0) { out0 = (float*)(P.ws + WS_XC) + (size_t)(b * CTX) * D; in0 = layer == 0 ? P.in[2] + (size_t)(b * CTX) * D : out0; }
        else { out0 = P.out + (size_t)(b * SEQ + (jt - 1) * 256) * D; in0 = layer == 0 ? P.in[0] + (size_t)(b * SEQ + (jt - 1) * 256) * D : out0; }
        const int col0 = u.pn * BM + wc * 32 + 4 * fq;
        f32x4 gv[2][2];
#pragma unroll
        for (int bj = 0; bj < 2; ++bj)
#pragma unroll
            for (int n = 0; n < 2; ++n) gv[bj][n] = *(const f32x4*)(g1 + col0 + bj * HALF + n * 16);
#pragma unroll
        for (int ai = 0; ai < 2; ++ai)
#pragma unroll
            for (int m = 0; m < 4; ++m) { const size_t off = (size_t)(ai * HALF + wr * 64 + m * 16 + fr) * D + col0;
#pragma unroll
                for (int bj = 0; bj < 2; ++bj)
#pragma unroll
                    for (int n = 0; n < 2; ++n) { const f32x4 xi = *(const f32x4*)(in0 + off + bj * HALF + n * 16); *(f32x4*)(out0 + off + bj * HALF + n * 16) = xi + gv[bj][n] * acc[ai][bj][m][n]; } }
    }
};
struct EpiMoe1 {
    static constexpr bool PERM = true; Ptrs P; int layer;
    __device__ __forceinline__ void operator()(const f32x4 (&acc)[2][2][4][2], const Unit& u, int wr, int wc, int fr, int fq) const {
        const float* bgu = P.in[35] + (size_t)(layer * NE + u.e) * 2048;
        const int cl = u.pn * 128 + wc * 32 + 8 * fq;
        f32x4 bg[2], bu[2];
#pragma unroll
        for (int n = 0; n < 2; ++n) { bg[n] = *(const f32x4*)(bgu + cl + 4 * n); bu[n] = *(const f32x4*)(bgu + 1024 + cl + 4 * n); }
        bf16* act = (bf16*)(P.ws + WS_ACT) + (size_t)(u.aux + u.pm * 256 + wr * 64 + fr) * 1024 + cl;
#pragma unroll
        for (int ai = 0; ai < 2; ++ai)
#pragma unroll
            for (int m = 0; m < 4; ++m) { float o[8];
#pragma unroll
                for (int n = 0; n < 2; ++n)
#pragma unroll
                    for (int j = 0; j < 4; ++j) { float g = acc[ai][0][m][n][j] + bg[n][j], uu = acc[ai][1][m][n][j] + bu[n][j];
                        g = fminf(g, 7.f); uu = fminf(fmaxf(uu, -7.f), 7.f);
                        const float sg = __builtin_amdgcn_rcpf(1.f + __expf(-1.702f * g)); o[n * 4 + j] = (uu + 1.f) * g * sg; }
                u32x4 w; w.x = cvt_pk_bf16(o[0], o[1]); w.y = cvt_pk_bf16(o[2], o[3]); w.z = cvt_pk_bf16(o[4], o[5]); w.w = cvt_pk_bf16(o[6], o[7]);
                *(u32x4*)(act + (size_t)(ai * HALF + m * 16) * 1024) = w; }
    }
};
struct EpiMoe2 {
    static constexpr bool PERM = true; Ptrs P; int layer;
    __device__ __forceinline__ void operator()(const f32x4 (&acc)[2][2][4][2], const Unit& u, int wr, int wc, int fr, int fq) const {
        const float* bd = P.in[37] + (size_t)(layer * NE + u.e) * 1024;
        const int col0 = u.pn * BM + wc * 32 + 8 * fq;
        f32x4 bv[2][2];
#pragma unroll
        for (int bj = 0; bj < 2; ++bj)
#pragma unroll
            for (int n = 0; n < 2; ++n) bv[bj][n] = *(const f32x4*)(bd + col0 + bj * HALF + 4 * n);
        const int* pair_of = (const int*)(P.ws + WS_PAIROF) + (size_t)u.e * R; const float* gate_of = (const float*)(P.ws + WS_GATEOF) + (size_t)u.e * R;
        bf16* Y = (bf16*)(P.ws + WS_Y);
#pragma unroll
        for (int ai = 0; ai < 2; ++ai)
#pragma unroll
            for (int m = 0; m < 4; ++m) { const int r = u.pm * 256 + ai * HALF + wr * 64 + m * 16 + fr;
                if (r < u.cnt) { const int pair = pair_of[r]; const float gw = gate_of[r]; bf16* rowp = Y + (size_t)pair * 1024 + col0;
#pragma unroll
                    for (int bj = 0; bj < 2; ++bj) { const f32x4 v0 = (acc[ai][bj][m][0] + bv[bj][0]) * gw, v1 = (acc[ai][bj][m][1] + bv[bj][1]) * gw;
                        u32x4 w; w.x = cvt_pk_bf16(v0[0], v0[1]); w.y = cvt_pk_bf16(v0[2], v0[3]); w.z = cvt_pk_bf16(v1[0], v1[1]); w.w = cvt_pk_bf16(v1[2], v1[3]);
                        *(u32x4*)(rowp + bj * HALF) = w; } } }
    }
};
}

__device__ __forceinline__ int bwd_pos(int c) { return c < 2 ? 1 - c : 2 + (NCH - 1 - c); }
__device__ __forceinline__ int bwd_chunk_at(int p) { return p < 2 ? 1 - p : NCH - 1 - (p - 2); }
__device__ __forceinline__ void lru_item(const Ptrs& P, unsigned char* lds, int mode, int n, int c, int b) {
    float* X = (float*)lds;
    float* A = X + CHUNK * 64;
    float* B = A + CHUNK * 64;
    bf16* wS = (bf16*)(B + CHUNK * 64);
    const int tid = threadIdx.x;
    const int j0 = c * CHUNK, seg_lo = (c < 2) ? 0 : CTX, seg_hi = (c < 2) ? CTX : SU;
    const bf16* Z = (const bf16*)(P.ws + WS_Z);
    const float* cw = P.in[10]; const float* cb = P.in[11];
    __syncthreads();
    for (int i = tid; i < CHUNK * 64; i += NT) {
        const int t = i >> 6, ch = i & 63, cg = n * 64 + ch; float acc = cb[cg];
#pragma unroll
        for (int k = 0; k < 4; ++k) { const int j = j0 + t - 2 + k; if (j >= seg_lo && j < seg_hi) acc += cw[k * LRU_W + cg] * bf2f(Z[(size_t)(b * SU + j) * EVEN_IN_P + 512 + cg]); }
        X[i] = acc;
    }
    float* agg = (float*)(P.ws + WS_AGG);
    for (int dir = 0; dir < 2; ++dir) {
        __syncthreads();
        const bf16* wl = (const bf16*)(P.ws + WS_WLRU) + (size_t)(dir * 2) * 8 * 4096;
        for (int i = tid; i < 2 * 4096; i += NT) { const int gate = i >> 12, e = (i >> 6) & 63, d = i & 63; wS[(gate * 64 + d) * 66 + e] = wl[((size_t)gate * 8 + n) * 4096 + e * 64 + d]; }
        __syncthreads();
        const float* ba = P.in[13] + dir * LRU_W + n * 64; const float* bx = P.in[15] + dir * LRU_W + n * 64; const float* lam = P.in[16] + dir * LRU_W + n * 64;
        float ra_[16], ru_[16];
#pragma unroll
        for (int q = 0; q < 16; ++q) {
            const int i = tid + q * NT, t = i >> 6, e = i & 63; float ra = ba[e], ri = bx[e];
            for (int d = 0; d < 64; ++d) { const float xv = bf2f(f2bf(X[t * 64 + d])); ra += xv * bf2f(wS[d * 66 + e]); ri += xv * bf2f(wS[(64 + d) * 66 + e]); }
            const float r = sigmoidf_(ra), ig = sigmoidf_(ri);
            const float sp = log1pf(__expf(-lam[e]));
            const float log_a = -8.f * r * sp;
            ra_[q] = __expf(log_a);
            ru_[q] = sqrtf(fmaxf(-expm1f(2.f * log_a), 0.f)) * ig * X[t * 64 + e];
        }
        __syncthreads();
        float* U = dir == 0 ? B : X;
#pragma unroll
        for (int q = 0; q < 16; ++q) { const int i = tid + q * NT; A[i] = ra_[q]; U[i] = ru_[q]; }
        __syncthreads();
        if (tid < 64) {
            const int ch = tid; float h = 0.f;
            if (mode == 1) {
                const int pos = dir == 0 ? c : bwd_pos(c);
                for (int p = 0; p < pos; ++p) { const int cc = dir == 0 ? p : bwd_chunk_at(p); const float* ag = agg + ((((size_t)b * NCH + cc) * 2 + dir) * 512 + n * 64 + ch) * 2; h = ag[0] * h + ag[1]; }
            }
            float ap = 1.f;
            if (dir == 0) { for (int t = 0; t < CHUNK; ++t) { const float a = A[t * 64 + ch]; h = a * h + U[t * 64 + ch]; ap *= a; U[t * 64 + ch] = h; } }
            else { for (int t = CHUNK - 1; t >= 0; --t) { const float a = A[t * 64 + ch]; h = a * h + U[t * 64 + ch]; ap *= a; U[t * 64 + ch] = h; } }
            if (mode == 0) { float* ag = agg + ((((size_t)b * NCH + c) * 2 + dir) * 512 + n * 64 + ch) * 2; ag[0] = ap; ag[1] = h; }
        }
    }
    if (mode == 1) {
        __syncthreads();
        bf16* mix = (bf16*)(P.ws + WS_MIX);
        for (int i = tid; i < CHUNK * 64; i += NT) { const int t = i >> 6, ch = i & 63; const size_t u = (size_t)b * SU + j0 + t;
            const float gl = bf2f(Z[u * EVEN_IN_P + n * 64 + ch]); mix[u * D + n * 64 + ch] = f2bf(gelu_tanh(gl) * (B[i] + X[i])); }
    }
}
__device__ __forceinline__ void ph_lru(const Ptrs& P, unsigned char* lds, int mode, int item0) {
    const int G = gridDim.x, total = 8 * NCH * NB;
    int first = ((int)blockIdx.x - item0 % G + G) % G;
    for (int it = first; it < total; it += G) lru_item(P, lds, mode, it % 8, (it / 8) % NCH, it / (8 * NCH));
    __syncthreads();
}

__device__ __forceinline__ void rope_angles(int t, int q, float& cr, float& sr, float& cc, float& scn) {
    const float f = exp2f(-(float)(2 * q) / 32.f * 13.287712379549449f);
    const float ar = (float)(t / GRID_W) * f, ac = (float)(t % GRID_W) * f;
    sincosf(ar, &sr, &cr); sincosf(ac, &scn, &cc);
}
__device__ __forceinline__ void ph_mla_prep(const Ptrs& P) {
    const int wave = threadIdx.x >> 6, lane = threadIdx.x & 63, G = gridDim.x;
    const float* qn = P.in[21]; const float* kn = P.in[22];
    for (int u = (int)blockIdx.x * 8 + wave; u < R; u += G * 8) {
        const int j = u % SU; const bool latent = j >= CTX; const int t = j - CTX;
        const bf16* z = (const bf16*)(P.ws + WS_Z) + (size_t)u * EVEN_IN_P;
        float sq = 0.f, sk = 0.f;
        for (int i = lane; i < 384; i += 64) { const float v = bf2f(z[1024 + i]); sq += v * v; }
        for (int i = lane; i < 256; i += 64) { const float v = bf2f(z[1408 + i]); sk += v * v; }
        const float rq = rsqrtf(wave_sum(sq) * (1.f / 384.f) + EPS), rk = rsqrtf(wave_sum(sk) * (1.f / 256.f) + EPS);
        const bf16* qp = (const bf16*)(P.ws + WS_QP) + (size_t)u * 768; const bf16* kvp = (const bf16*)(P.ws + WS_KVP) + (size_t)u * 1024;
        bf16* qm = (bf16*)(P.ws + WS_QM) + (size_t)u * 768; bf16* km = (bf16*)(P.ws + WS_KM) + (size_t)u * 768; bf16* vm = (bf16*)(P.ws + WS_VM) + (size_t)u * 512;
        float cs = 1.f, sn = 0.f;
        if (latent) { float cr, sr, cc, sc2; rope_angles(t, lane & 15, cr, sr, cc, sc2); cs = (lane >> 5) ? cc : cr; sn = (lane >> 5) ? sc2 : sr; }
        const float kr_raw = bf2f(z[1664 + lane]);
        for (int h = 0; h < MLA_H; ++h) {
            float q0 = bf2f(qp[h * 192 + lane]) * rq, q1 = bf2f(qp[h * 192 + 64 + lane]) * rq, q2 = bf2f(qp[h * 192 + 128 + lane]) * rq;
            float r = rsqrtf(wave_sum(q0 * q0 + q1 * q1 + q2 * q2) * (1.f / 192.f) + EPS);
            q0 *= r * qn[lane]; q1 *= r * qn[64 + lane]; q2 *= r * qn[128 + lane];
            { const float other = __shfl_xor(q2, 16); const float rot = ((lane >> 4) & 1) ? other : -other; q2 = q2 * cs + rot * sn; }
            qm[h * 192 + lane] = f2bf(q0); qm[h * 192 + 64 + lane] = f2bf(q1); qm[h * 192 + 128 + lane] = f2bf(q2);
            float k0 = bf2f(kvp[h * 256 + lane]) * rk, k1 = bf2f(kvp[h * 256 + 64 + lane]) * rk, k2 = kr_raw;
            const float v0 = bf2f(kvp[h * 256 + 128 + lane]) * rk, v1 = bf2f(kvp[h * 256 + 192 + lane]) * rk;
            r = rsqrtf(wave_sum(k0 * k0 + k1 * k1 + k2 * k2) * (1.f / 192.f) + EPS);
            k0 *= r * kn[lane]; k1 *= r * kn[64 + lane]; k2 *= r * kn[128 + lane];
            { const float other = __shfl_xor(k2, 16); const float rot = ((lane >> 4) & 1) ? other : -other; k2 = k2 * cs + rot * sn; }
            km[h * 192 + lane] = f2bf(k0); km[h * 192 + 64 + lane] = f2bf(k1); km[h * 192 + 128 + lane] = f2bf(k2);
            vm[h * 128 + lane] = f2bf(v0); vm[h * 128 + 64 + lane] = f2bf(v1);
        }
    }
}
__device__ __forceinline__ void ph_diff_prep(const Ptrs& P) {
    const int wave = threadIdx.x >> 6, lane = threadIdx.x & 63, G = gridDim.x;
    for (int u = (int)blockIdx.x * 8 + wave; u < R; u += G * 8) {
        const int j = u % SU; const bool latent = j >= CTX; const int t = j - CTX;
        bf16* z = (bf16*)(P.ws + WS_Z) + (size_t)u * ODD_IN;
        float cs = 1.f, sn = 0.f;
        if (latent) { float cr, sr, cc, sc2; rope_angles(t, lane & 15, cr, sr, cc, sc2); cs = (lane >> 5) ? cc : cr; sn = (lane >> 5) ? sc2 : sr; }
        for (int qk = 0; qk < 2; ++qk) {
            const float* gn = (qk == 0 ? P.in[25] : P.in[26]);
            for (int g = 0; g < 16; ++g) {
                bf16* p = z + qk * 1024 + g * 64;
                float v = bf2f(p[lane]);
                const float r = rsqrtf(wave_sum(v * v) * (1.f / 64.f) + EPS);
                v *= r * gn[lane];
                const float other = __shfl_xor(v, 16); const float rot = ((lane >> 4) & 1) ? other : -other; v = v * cs + rot * sn;
                p[lane] = f2bf(v);
            }
        }
    }
}

template <int DKH, int NSM, int MODE>
__device__ __forceinline__ void attn_naive_item(const Ptrs& P, float* sm, const bf16* Qb, int ldq, int qoff_h, const bf16* Kb, int ldk, int koff_h, const bf16* Vb, int ldv, int voff_h,
                                                int q_j0, int key_j0, int nkeys, float c2, int scal_idx, int qb, int h, int b) {
    constexpr int DK = DKH * NSM;
    float* Qs = sm; float* Ks = Qs + 64 * (DK + 1); float* Vs = Ks + 32 * (DK + 1); float* Ps = Vs + 32 * 128;
    const int tid = threadIdx.x, q = tid >> 3, part = tid & 7;
    const size_t uq0 = (size_t)b * SU + q_j0 + qb * 64, uk0 = (size_t)b * SU + key_j0;
    const float M = ((const float*)(P.ws + WS_SCAL))[scal_idx];
    __syncthreads();
    for (int i = tid; i < 64 * DK; i += NT) { const int r = i / DK, c = i % DK; Qs[r * (DK + 1) + c] = bf2f(Qb[(uq0 + r) * ldq + h * qoff_h + c]); }
    float o[NSM][16]; float l[NSM];
#pragma unroll
    for (int s = 0; s < NSM; ++s) { l[s] = 0.f;
#pragma unroll
        for (int d = 0; d < 16; ++d) o[s][d] = 0.f; }
    for (int k0 = 0; k0 < nkeys; k0 += 32) {
        __syncthreads();
        for (int i = tid; i < 32 * DK; i += NT) { const int r = i / DK, c = i % DK; Ks[r * (DK + 1) + c] = bf2f(Kb[(uk0 + k0 + r) * ldk + h * koff_h + c]); }
        for (int i = tid; i < 32 * 128; i += NT) { const int r = i >> 7, c = i & 127; Vs[r * 128 + c] = bf2f(Vb[(uk0 + k0 + r) * ldv + h * voff_h + c]); }
        __syncthreads();
#pragma unroll
        for (int s = 0; s < NSM; ++s) {
            float sc[4] = {0.f, 0.f, 0.f, 0.f};
            for (int d = 0; d < DKH; ++d) { const float qv = Qs[q * (DK + 1) + s * DKH + d];
#pragma unroll
                for (int kk = 0; kk < 4; ++kk) sc[kk] += qv * Ks[(part * 4 + kk) * (DK + 1) + s * DKH + d]; }
#pragma unroll
            for (int kk = 0; kk < 4; ++kk) { const float p = exp2f(sc[kk] * c2 - M); l[s] += p; Ps[(s * 64 + q) * 33 + part * 4 + kk] = p; }
        }
        __syncthreads();
#pragma unroll
        for (int s = 0; s < NSM; ++s)
            for (int kk = 0; kk < 32; ++kk) { const float p = Ps[(s * 64 + q) * 33 + kk];
#pragma unroll
                for (int d = 0; d < 16; ++d) o[s][d] += p * Vs[kk * 128 + d * 8 + part]; }
    }
#pragma unroll
    for (int s = 0; s < NSM; ++s) { l[s] += __shfl_xor(l[s], 1); l[s] += __shfl_xor(l[s], 2); l[s] += __shfl_xor(l[s], 4); }
    bf16* mix = (bf16*)(P.ws + WS_MIX) + (uq0 + q) * D;
    if (MODE == 0) {
        const float il = 1.f / l[0];
#pragma unroll
        for (int d = 0; d < 16; ++d) mix[512 + h * 128 + d * 8 + part] = f2bf(o[0][d] * il);
    } else {
        const float* scal = (const float*)(P.ws + WS_SCAL); const float lam = scal[2], oml = scal[3];
        const float il1 = 1.f / l[0], il2 = lam / l[NSM - 1];
        float v[16]; float ss = 0.f;
#pragma unroll
        for (int d = 0; d < 16; ++d) { v[d] = o[0][d] * il1 - o[NSM - 1][d] * il2; ss += v[d] * v[d]; }
        ss += __shfl_xor(ss, 1); ss += __shfl_xor(ss, 2); ss += __shfl_xor(ss, 4);
        const float r = rsqrtf(ss * (1.f / 128.f) + EPS) * oml; const float* sg = P.in[31];
#pragma unroll
        for (int d = 0; d < 16; ++d) mix[h * 128 + d * 8 + part] = f2bf(v[d] * r * sg[d * 8 + part]);
    }
}

struct Args { Ptrs P; int ph_lo, ph_hi; };
constexpr int N_PHASES = 19;
__global__ void __launch_bounds__(NT, 2) mega(Args args) {
    extern __shared__ __attribute__((aligned(16))) unsigned char lds[];
    const Ptrs& P = args.P;
    unsigned char* ws = P.ws;
    const int tid = threadIdx.x, G = gridDim.x;
    const int vcu = (G % 8 == 0) ? ((int)blockIdx.x % 8) * (G / 8) + (int)blockIdx.x / 8 : (int)blockIdx.x;
    LAS unsigned char* LDSP = (LAS unsigned char*)lds;
    volatile LAS unsigned* MISC = (volatile LAS unsigned*)((LAS unsigned char*)lds + MISC_OFF);
    for (int u = tid; u < (LDS_BYTES - LDSCTL_OFF) / 4; u += NT) ((LAS unsigned*)((LAS unsigned char*)lds + LDSCTL_OFF))[u] = 0u;
    __syncthreads();
    XcdBarrier bar = xcd_barrier_post((unsigned*)(ws + WS_CTL) + CW_BAR, MISC + 8);
    const int lo = args.ph_lo, hi = args.ph_hi;
#define IN(k) (lo <= (k) && (k) < hi)
#define SEAM(k) do { if (IN(k) && IN((k) + 1)) xcd_barrier(bar); } while (0)
    const bf16* H = (const bf16*)(ws + WS_H); bf16* Z = (bf16*)(ws + WS_Z); const bf16* MIX = (const bf16*)(ws + WS_MIX);
    const bf16* Qm = (const bf16*)(ws + WS_QM); const bf16* Km = (const bf16*)(ws + WS_KM); const bf16* Vm = (const bf16*)(ws + WS_VM);

    if (IN(0)) { ph_prologue(P, lds); } SEAM(0);
    if (IN(1)) { ph_rows(P, 0, 0, 0, 0); } SEAM(1);
    if (IN(2)) { g8::DenseOrder S; S.init(H, D, (const bf16*)(ws + WS_WEVIN), D, R, EVEN_IN_P, G, (int)blockIdx.x, 0); g8::EpiStoreBf16 E{Z, EVEN_IN_P};
        g8::gemm_phase<g8::EpiStoreBf16, g8::DenseOrder, false, true>(LDSP, D, D, S, E); } SEAM(2);
    if (IN(3)) {
        { g8::DenseOrder S; S.init(Z + 1024, EVEN_IN_P, (const bf16*)(ws + WS_WUQ), 384, R, 768, G, (int)blockIdx.x, 0); g8::EpiStoreBf16 E{(bf16*)(ws + WS_QP), 768};
          g8::gemm_phase<g8::EpiStoreBf16, g8::DenseOrder, false, true>(LDSP, EVEN_IN_P, 384, S, E); }
        { g8::DenseOrder S; S.init(Z + 1408, EVEN_IN_P, (const bf16*)(ws + WS_WUKV), 256, R, 1024, G, (int)blockIdx.x, 0); g8::EpiStoreBf16 E{(bf16*)(ws + WS_KVP), 1024};
          g8::gemm_phase<g8::EpiStoreBf16, g8::DenseOrder, false, true>(LDSP, EVEN_IN_P, 256, S, E); }
        ph_lru(P, lds, 0, 0);
    } SEAM(3);
    if (IN(4)) { ph_mla_prep(P); } SEAM(4);
    if (IN(5)) {
        ph_lru(P, lds, 1, 0);
        const float c2 = 0.07216878364870322f * LOG2E;
        const int nlat = (SEQ / 64) * MLA_H * NB, nctx = (CTX / 64) * MLA_H * NB;
        int first = ((int)blockIdx.x - (8 * NCH * NB) % G + G) % G;
        for (int it = first; it < nlat + nctx; it += G) {
            if (it < nlat) { const int qb = it % (SEQ / 64), h = (it / (SEQ / 64)) % MLA_H, b = it / ((SEQ / 64) * MLA_H);
                attn_naive_item<192, 1, 0>(P, (float*)lds, Qm, 768, 192, Km, 768, 192, Vm, 512, 128, CTX, 0, SU, c2, 0, qb, h, b); }
            else { const int i2 = it - nlat; const int qb = i2 % (CTX / 64), h = (i2 / (CTX / 64)) % MLA_H, b = i2 / ((CTX / 64) * MLA_H);
                attn_naive_item<192, 1, 0>(P, (float*)lds, Qm, 768, 192, Km, 768, 192, Vm, 512, 128, 0, 0, CTX, c2, 0, qb, h, b); }
        }
        __syncthreads();
    } SEAM(5);
    if (IN(6)) { g8::DenseOrder S; S.init(MIX, D, (const bf16*)(ws + WS_WEVOUT), D, R, D, G, (int)blockIdx.x, 0); g8::EpiOut E{P, 0};
        g8::gemm_phase<g8::EpiOut, g8::DenseOrder, false, true>(LDSP, D, D, S, E); } SEAM(6);
    if (IN(7)) { ph_rows(P, 0, 1, 0, 0); } SEAM(7);
    if (IN(8)) { g8::MoeOrder S{(const unsigned*)(ws + WS_CTL) + CW_CNT + 0 * 64, (const char*)H, (const char*)(ws + WS_WGU) + (size_t)0 * NE * 2048 * 1024 * 2, (const int*)(ws + WS_TOKOF), (size_t)2048 * 1024 * 2, 8, D, G, vcu, 1};
        g8::EpiMoe1 E{P, 0}; g8::gemm_phase<g8::EpiMoe1, g8::MoeOrder, true, true>(LDSP, D, D, S, E); } SEAM(8);
    if (IN(9)) { g8::MoeOrder S{(const unsigned*)(ws + WS_CTL) + CW_CNT + 0 * 64, (const char*)(ws + WS_ACT), (const char*)(ws + WS_WDN) + (size_t)0 * NE * 1024 * 1024 * 2, nullptr, (size_t)1024 * 1024 * 2, 4, D, G, vcu, 0};
        g8::EpiMoe2 E{P, 0}; g8::gemm_phase<g8::EpiMoe2, g8::MoeOrder, false, true>(LDSP, D, D, S, E); } SEAM(9);
    if (IN(10)) { ph_rows(P, 0, 2, 0, 1); } SEAM(10);
    if (IN(11)) { g8::DenseOrder S; S.init(H, D, (const bf16*)(ws + WS_WODIN), D, R, ODD_IN, G, (int)blockIdx.x, 0); g8::EpiStoreBf16 E{Z, ODD_IN};
        g8::gemm_phase<g8::EpiStoreBf16, g8::DenseOrder, false, true>(LDSP, D, D, S, E); } SEAM(11);
    if (IN(12)) { ph_diff_prep(P); } SEAM(12);
    if (IN(13)) {
        const float c2 = 0.125f * LOG2E; const int n = (SEQ / 64) * DIFF_H * NB;
        for (int it = (int)blockIdx.x; it < n; it += G) { const int qb = it % (SEQ / 64), h = (it / (SEQ / 64)) % DIFF_H, b = it / ((SEQ / 64) * DIFF_H);
            attn_naive_item<64, 2, 1>(P, (float*)lds, Z, ODD_IN, 128, Z + 1024, ODD_IN, 128, Z + 2048, ODD_IN, 128, CTX, 0, SU, c2, 1, qb, h, b); }
        __syncthreads();
    } SEAM(13);
    if (IN(14)) { g8::DenseOrder S; S.init(MIX, D, (const bf16*)(ws + WS_WODOUT), D, R, D, G, (int)blockIdx.x, 1); g8::EpiOut E{P, 1};
        g8::gemm_phase<g8::EpiOut, g8::DenseOrder, false, true>(LDSP, D, D, S, E); } SEAM(14);
    if (IN(15)) { ph_rows(P, 1, 1, 1, 0); } SEAM(15);
    if (IN(16)) { g8::MoeOrder S{(const unsigned*)(ws + WS_CTL) + CW_CNT + 1 * 64, (const char*)H, (const char*)(ws + WS_WGU) + (size_t)1 * NE * 2048 * 1024 * 2, (const int*)(ws + WS_TOKOF), (size_t)2048 * 1024 * 2, 8, D, G, vcu, 1};
        g8::EpiMoe1 E{P, 1}; g8::gemm_phase<g8::EpiMoe1, g8::MoeOrder, true, true>(LDSP, D, D, S, E); } SEAM(16);
    if (IN(17)) { g8::MoeOrder S{(const unsigned*)(ws + WS_CTL) + CW_CNT + 1 * 64, (const char*)(ws + WS_ACT), (const char*)(ws + WS_WDN) + (size_t)1 * NE * 1024 * 1024 * 2, nullptr, (size_t)1024 * 1024 * 2, 4, D, G, vcu, 0};
        g8::EpiMoe2 E{P, 1}; g8::gemm_phase<g8::EpiMoe2, g8::MoeOrder, false, true>(LDSP, D, D, S, E); } SEAM(17);
    if (IN(18)) { ph_rows(P, 1, 2, 1, 0); }
#undef IN
#undef SEAM
}

#ifndef MK_PER_PHASE
#define MK_PER_PHASE 0
#endif
extern "C" void kernel_launch(void* const* d_in, const int* in_sizes, int n_in, void* d_out, int out_size, void* d_ws, size_t ws_size, hipStream_t stream) {
    static int grid = 0;
    if (grid == 0) {
        if (n_in != 38 || ws_size < WS_END) { fprintf(stderr, "kernel_launch: bad args n_in=%d ws=%zu need %zu\n", n_in, ws_size, (size_t)WS_END); grid = -1; return; }
        int dev = 0, cus = 0, per_cu = 0;
        if (hipGetDevice(&dev) != hipSuccess || hipDeviceGetAttribute(&cus, hipDeviceAttributeMultiprocessorCount, dev) != hipSuccess) { grid = -1; return; }
        if (hipFuncSetAttribute((const void*)mega, hipFuncAttributeMaxDynamicSharedMemorySize, LDS_BYTES) != hipSuccess) { fprintf(stderr, "kernel_launch: hipFuncSetAttribute failed\n"); grid = -1; return; }
        if (hipOccupancyMaxActiveBlocksPerMultiprocessor(&per_cu, (const void*)mega, NT, LDS_BYTES) != hipSuccess || per_cu < 1) { fprintf(stderr, "kernel_launch: occupancy query says %d blocks/CU\n", per_cu); grid = -1; return; }
        (void)hipGetLastError();
        grid = cus;
    }
    if (grid < 0) return;
    if (hipMemsetAsync((char*)d_ws + WS_CTL, 0, 1u << 20, stream) != hipSuccess) return;
    Args a; memset((void*)&a, 0, sizeof(a));
    for (int i = 0; i < 38; ++i) a.P.in[i] = (const float*)d_in[i];
    a.P.out = (float*)d_out; a.P.ws = (unsigned char*)d_ws;
#if MK_PER_PHASE
    for (int p = 0; p < N_PHASES; ++p) { a.ph_lo = p; a.ph_hi = p + 1; hipLaunchKernelGGL(mega, dim3(grid), dim3(NT), LDS_BYTES, stream, a); }
#else
    a.ph_lo = 0; a.ph_hi = N_PHASES;
    hipLaunchKernelGGL(mega, dim3(grid), dim3(NT), LDS_BYTES, stream, a);
#endif
    const hipError_t le = hipPeekAtLastError();
    if (le != hipSuccess) fprintf(stderr, "kernel_launch: launch failed: %s\n", hipGetErrorName(le));
}
```

```cpp
#include <hip/hip_runtime.h>
#include <cstdio>
#include <cstdint>
#include <cstring>

typedef unsigned short bf16;
typedef unsigned u32x4 __attribute__((ext_vector_type(4)));
typedef float f32x4 __attribute__((ext_vector_type(4)));

constexpr int D = 1024, NB = 4, SEQ = 4096, CTX = 256, SU = SEQ + CTX, R = NB * SU;
constexpr int GRID_W = 64;
constexpr int LRU_W = 512, LRU_NB = 8, LRU_BW = 64;
constexpr int MLA_H = 4, MLA_QR = 384, MLA_KVR = 256, MLA_NOPE = 128, MLA_ROPE = 64, MLA_V = 128, MLA_QK = 192;
constexpr int EVEN_IN = 1728, EVEN_IN_P = 1792;
constexpr int DIFF_H = 8, ODD_IN = 3072;
constexpr int NE = 32, TOPK = 4, DFF = 1024;
constexpr float EPS = 1e-6f;
constexpr int CHUNK = 128, NCH = SU / CHUNK;

constexpr size_t al256(size_t x) { return (x + 255) / 256 * 256; }
constexpr size_t WS_CTL = 0;
constexpr size_t WS_MOD = 1u << 20;
constexpr size_t WS_SCAL = WS_MOD + al256(2 * 5 * 6144 * 4);
constexpr size_t WS_WEVIN = WS_SCAL + 4096;
constexpr size_t WS_WEVOUT = WS_WEVIN + (size_t)EVEN_IN_P * D * 2;
constexpr size_t WS_WUQ = WS_WEVOUT + (size_t)D * D * 2;
constexpr size_t WS_WUKV = WS_WUQ + (size_t)768 * 384 * 2;
constexpr size_t WS_WLRU = WS_WUKV + (size_t)1024 * 256 * 2;
constexpr size_t WS_WODIN = WS_WLRU + (size_t)32 * 4096 * 2;
constexpr size_t WS_WODOUT = WS_WODIN + (size_t)ODD_IN * D * 2;
constexpr size_t WS_WGU = WS_WODOUT + (size_t)D * D * 2;
constexpr size_t WS_WDN = WS_WGU + (size_t)2 * NE * 2048 * 1024 * 2;
constexpr size_t WS_XC = WS_WDN + (size_t)2 * NE * 1024 * 1024 * 2;
constexpr size_t WS_H = WS_XC + (size_t)NB * CTX * D * 4;
constexpr size_t WS_Z = WS_H + (size_t)R * D * 2;
constexpr size_t WS_QP = WS_Z + (size_t)R * ODD_IN * 2;
constexpr size_t WS_KVP = WS_QP + (size_t)R * 768 * 2;
constexpr size_t WS_QM = WS_KVP + (size_t)R * 1024 * 2;
constexpr size_t WS_KM = WS_QM + (size_t)R * 768 * 2;
constexpr size_t WS_VM = WS_KM + (size_t)R * 768 * 2;
constexpr size_t WS_AGG = WS_VM + (size_t)R * 512 * 2;
constexpr size_t WS_MIX = WS_AGG + al256((size_t)NB * NCH * 2 * 512 * 2 * 4);
constexpr size_t WS_TOKOF = WS_MIX + (size_t)R * D * 2;
constexpr size_t WS_PAIROF = WS_TOKOF + (size_t)NE * R * 4;
constexpr size_t WS_GATEOF = WS_PAIROF + (size_t)NE * R * 4;
constexpr size_t ACT_ROWS = (size_t)R * TOPK + NE * 256;
constexpr size_t WS_ACT = WS_GATEOF + (size_t)NE * R * 4;
constexpr size_t WS_Y = WS_ACT + ACT_ROWS * 1024 * 2;
constexpr size_t WS_END = WS_Y + (size_t)R * TOPK * 1024 * 2;

constexpr int CW_CNT = 64;

__device__ __forceinline__ float bf2f(bf16 v) { return __uint_as_float((unsigned)v << 16); }
__device__ __forceinline__ bf16 f2bf(float f) { unsigned u = __float_as_uint(f); return (bf16)((u + 0x7fffu + ((u >> 16) & 1u)) >> 16); }
__device__ __forceinline__ float wave_sum(float v) {
#pragma unroll
    for (int o = 1; o < 64; o <<= 1) v += __shfl_xor(v, o);
    return v;
}
__device__ __forceinline__ float sigmoidf_(float x) { return 1.f / (1.f + __expf(-x)); }
__device__ __forceinline__ float gelu_tanh(float x) { const float t = tanhf(0.7978845608028654f * (x + 0.044715f * x * x * x)); return 0.5f * x * (1.f + t); }

struct Ptrs {
    const float* in[38];
    float* out;
    unsigned char* ws;
};

__device__ __forceinline__ const float* res_in_row(const Ptrs& P, int layer, int u) {
    const int b = u / SU, j = u % SU;
    if (layer == 0) return j < CTX ? P.in[2] + (size_t)(b * CTX + j) * D : P.in[0] + (size_t)(b * SEQ + j - CTX) * D;
    return j < CTX ? (const float*)(P.ws + WS_XC) + (size_t)(b * CTX + j) * D : P.out + (size_t)(b * SEQ + j - CTX) * D;
}
__device__ __forceinline__ float* res_out_row(const Ptrs& P, int u) {
    const int b = u / SU, j = u % SU;
    return j < CTX ? (float*)(P.ws + WS_XC) + (size_t)(b * CTX + j) * D : P.out + (size_t)(b * SEQ + j - CTX) * D;
}
__device__ __forceinline__ const float* mod_row(const Ptrs& P, int layer, int u) {
    const int b = u / SU, j = u % SU;
    return (const float*)(P.ws + WS_MOD) + (size_t)(layer * 5 + (j < CTX ? 4 : b)) * 6144;
}

constexpr float LOG2E = 1.4426950408889634f;
#define GAS __attribute__((address_space(1)))
#define LAS __attribute__((address_space(3)))
constexpr int NT = 512;
constexpr int LDS_BYTES = 147456;
constexpr int RING_BYTES = 131072, LDSCTL_OFF = RING_BYTES, MISC_OFF = LDSCTL_OFF + 320;
constexpr int CW_BAR = 4096;
constexpr int CW_TMO = 0;

#define XB_TMO      128
#define XB_XCNT(j)  (256  + 64 * (j))
#define XB_XSUB(j)  (1280 + 64 * (j))
#define XB_XGEN(j)  (2304 + 64 * (j))
#define XB_TOP      3328
#define XB_TOPGEN   3392
#define XCD_BAR_WORDS 3456
#define XB_SPIN_CAP (1u << 22)
__device__ __forceinline__ unsigned xb_ld(unsigned* p)              { return __hip_atomic_load(p, __ATOMIC_RELAXED, __HIP_MEMORY_SCOPE_AGENT); }
__device__ __forceinline__ unsigned xb_add(unsigned* p, unsigned v) { return __hip_atomic_fetch_add(p, v, __ATOMIC_RELAXED, __HIP_MEMORY_SCOPE_AGENT); }
__device__ __forceinline__ unsigned xb_xcc_id() { return (unsigned)__builtin_amdgcn_s_getreg((3 << 11) | 20) & 0xFu; }
#define XB_SPIN(cond, bar) do { unsigned _sp = 0; while (cond) { __builtin_amdgcn_s_sleep(1); \
    if ((++_sp & 255u) == 0u) { if (xb_ld(&(bar)[XB_TMO])) break; if (_sp > XB_SPIN_CAP) { atomicAdd(&(bar)[XB_TMO], 1u); break; } } } } while (0)
struct XcdBarrier { unsigned* bar; unsigned x; volatile LAS unsigned* st; };
__device__ __forceinline__ XcdBarrier xcd_barrier_post(unsigned* bar, volatile LAS unsigned* st) {
    XcdBarrier b; b.bar = bar; b.x = xb_xcc_id(); b.st = st;
    if (threadIdx.x == 0) (void)xb_add(&bar[XB_XCNT(b.x)], 1u);
    return b;
}
__device__ __forceinline__ void xcd_barrier_complete(unsigned* bar, unsigned x, unsigned& nloc, unsigned& nx) {
    const unsigned G = gridDim.x * gridDim.y * gridDim.z;
    unsigned sum, cnt, mine, sp = 0u;
    for (;;) {
        sum = 0u; cnt = 0u; mine = 0u;
#pragma unroll
        for (unsigned j = 0; j < 16; ++j) { const unsigned c = xb_ld(&bar[XB_XCNT(j)]); sum += c; cnt += (c > 0u) ? 1u : 0u; mine = (j == x) ? c : mine; }
        if (sum == G) break;
        __builtin_amdgcn_s_sleep(1);
        if ((++sp & 255u) == 0u) { if (xb_ld(&bar[XB_TMO])) break; if (sp > XB_SPIN_CAP) { atomicAdd(&bar[XB_TMO], 1u); break; } }
    }
    nloc = mine > 0u ? mine : 1u; nx = cnt > 0u ? cnt : 1u;
}
__device__ __forceinline__ void xcd_barrier(const XcdBarrier& b) {
    asm volatile("s_waitcnt vmcnt(0)" ::: "memory");
    __syncthreads();
    if (threadIdx.x == 0) {
        unsigned* bar = b.bar;
        __builtin_amdgcn_s_waitcnt(0);
        unsigned nloc = b.st[0], nx = b.st[1];
        if (nloc == 0u) { xcd_barrier_complete(bar, b.x, nloc, nx); b.st[0] = nloc; b.st[1] = nx; }
        const unsigned old = xb_add(&bar[XB_XSUB(b.x)], 1u);
        const unsigned gen = old / nloc;
        if (old + 1u == (gen + 1u) * nloc) {
            __builtin_amdgcn_fence(__ATOMIC_RELEASE, "agent");
            asm volatile("s_waitcnt vmcnt(0)" ::: "memory");
            const unsigned og = xb_add(&bar[XB_TOP], 1u);
            const unsigned tg = og / nx;
            if (og + 1u == (tg + 1u) * nx) xb_add(&bar[XB_TOPGEN], 1u);
            else XB_SPIN(xb_ld(&bar[XB_TOPGEN]) == tg, bar);
            __builtin_amdgcn_fence(__ATOMIC_ACQUIRE, "agent");
            xb_add(&bar[XB_XGEN(b.x)], 1u);
            asm volatile("s_waitcnt vmcnt(0)" ::: "memory");
        } else {
            XB_SPIN(xb_ld(&bar[XB_XGEN(b.x)]) == gen, bar);
            __builtin_amdgcn_fence(__ATOMIC_ACQUIRE, "agent");
            asm volatile("s_waitcnt vmcnt(0)" ::: "memory");
        }
    }
    __syncthreads();
}

__device__ __forceinline__ void transpose_tile(const float* __restrict__ src, int K, int N, bf16* __restrict__ dst, const float* __restrict__ rowscale, int perm, int n0, int k0, float* tile  ) {
    const int tid = threadIdx.x;
    __syncthreads();
#pragma unroll
    for (int i = 0; i < 8; ++i) {
        const int k = i * 8 + (tid >> 6), n = tid & 63; const int np = n0 + n;
        int sc = np; if (perm == 1) sc = (np / 256) * 128 + (np % 128) + ((np % 256) / 128) * 1024;
        float v = 0.f; if (sc < N) v = src[(size_t)(k0 + k) * N + sc];
        if (rowscale) v *= rowscale[k0 + k];
        tile[k * 65 + n] = v;
    }
    __syncthreads();
#pragma unroll
    for (int i = 0; i < 8; ++i) {
        const int n = i * 8 + (tid >> 6), k = tid & 63;
        dst[(size_t)(n0 + n) * K + k0 + k] = f2bf(tile[k * 65 + n]);
    }
}
struct TJob { const float* src; bf16* dst; const float* rs; int K, N, Npad, perm, batch; size_t sstr, dstr; };
__device__ __forceinline__ void run_tjob(const TJob& j, float* tile, int& base, int G) {
    const int tn = j.Npad / 64, tk = j.K / 64, per = tn * tk, total = per * j.batch;
    int first = ((int)blockIdx.x - base % G + G) % G;
    for (int it = first; it < total; it += G) { const int z = it / per, r = it % per; transpose_tile(j.src + z * j.sstr, j.K, j.N, j.dst + z * j.dstr, j.rs, j.perm, (r % tn) * 64, (r / tn) * 64, tile); }
    base += total;
}
__device__ __forceinline__ void ph_prologue(const Ptrs& P, unsigned char* lds) {
    float* tile = (float*)lds; unsigned char* ws = P.ws; const int G = gridDim.x; int base = 0;
    TJob j;
    j = TJob{P.in[34], (bf16*)(ws + WS_WGU), nullptr, 1024, 2048, 2048, 1, 2 * NE, (size_t)1024 * 2048, (size_t)2048 * 1024}; run_tjob(j, tile, base, G);
    j = TJob{P.in[36], (bf16*)(ws + WS_WDN), nullptr, 1024, 1024, 1024, 0, 2 * NE, (size_t)1024 * 1024, (size_t)1024 * 1024}; run_tjob(j, tile, base, G);
    j = TJob{P.in[8], (bf16*)(ws + WS_WEVIN), nullptr, 1024, EVEN_IN, EVEN_IN_P, 0, 1, 0, 0}; run_tjob(j, tile, base, G);
    j = TJob{P.in[9], (bf16*)(ws + WS_WEVOUT), nullptr, 1024, 1024, 1024, 0, 1, 0, 0}; run_tjob(j, tile, base, G);
    j = TJob{P.in[18], (bf16*)(ws + WS_WUQ), P.in[17], 384, 768, 768, 0, 1, 0, 0}; run_tjob(j, tile, base, G);
    j = TJob{P.in[20], (bf16*)(ws + WS_WUKV), P.in[19], 256, 1024, 1024, 0, 1, 0, 0}; run_tjob(j, tile, base, G);
    j = TJob{P.in[12], (bf16*)(ws + WS_WLRU), nullptr, 64, 64, 64, 0, 8, 4096, 4096}; run_tjob(j, tile, base, G);
    j = TJob{P.in[14], (bf16*)(ws + WS_WLRU) + 8 * 4096, nullptr, 64, 64, 64, 0, 8, 4096, 4096}; run_tjob(j, tile, base, G);
    j = TJob{P.in[12] + 8 * 4096, (bf16*)(ws + WS_WLRU) + 16 * 4096, nullptr, 64, 64, 64, 0, 8, 4096, 4096}; run_tjob(j, tile, base, G);
    j = TJob{P.in[14] + 8 * 4096, (bf16*)(ws + WS_WLRU) + 24 * 4096, nullptr, 64, 64, 64, 0, 8, 4096, 4096}; run_tjob(j, tile, base, G);
    j = TJob{P.in[23], (bf16*)(ws + WS_WODIN), nullptr, 1024, ODD_IN, ODD_IN, 0, 1, 0, 0}; run_tjob(j, tile, base, G);
    j = TJob{P.in[24], (bf16*)(ws + WS_WODOUT), nullptr, 1024, 1024, 1024, 0, 1, 0, 0}; run_tjob(j, tile, base, G);
    __syncthreads();
    {
        float* s = (float*)lds;
        for (int it = (int)blockIdx.x; it < 24; it += G) {
            const int layer = it / 12, jc = (it % 12) * 512 + threadIdx.x;
            __syncthreads();
            for (int i = threadIdx.x; i < 5 * 1024; i += NT) { const int r = i / 1024, k = i % 1024; const float c = r < 4 ? P.in[1][r * 1024 + k] : P.in[3][k]; s[i] = c / (1.f + __expf(-c)); }
            __syncthreads();
            const float* w = P.in[4] + (size_t)layer * 1024 * 6144;
            float a[5] = {0, 0, 0, 0, 0};
            for (int k = 0; k < 1024; ++k) { const float wv = w[(size_t)k * 6144 + jc];
#pragma unroll
                for (int r = 0; r < 5; ++r) a[r] += s[r * 1024 + k] * wv; }
            const float bv = P.in[5][layer * 6144 + jc];
            float* o = (float*)(ws + WS_MOD) + (size_t)layer * 5 * 6144;
#pragma unroll
            for (int r = 0; r < 5; ++r) o[r * 6144 + jc] = a[r] + bv;
        }
    }
    if ((int)blockIdx.x == G - 1 && threadIdx.x == 0) {
        float* sc = (float*)(ws + WS_SCAL);
        float mq = 0, mk = 0;
        for (int i = 0; i < 192; ++i) { mq = fmaxf(mq, fabsf(P.in[21][i])); mk = fmaxf(mk, fabsf(P.in[22][i])); }
        sc[0] = sqrtf(192.f) * mq * mk * LOG2E;
        mq = 0; mk = 0;
        for (int i = 0; i < 64; ++i) { mq = fmaxf(mq, fabsf(P.in[25][i])); mk = fmaxf(mk, fabsf(P.in[26][i])); }
        sc[1] = 8.f * mq * mk * LOG2E;
        float s1 = 0, s2 = 0;
        for (int i = 0; i < 64; ++i) { s1 += P.in[27][i] * P.in[28][i]; s2 += P.in[29][i] * P.in[30][i]; }
        const float lam_init = 0.8f - 0.6f * expf(-0.3f * 1.f);
        sc[2] = expf(s1) - expf(s2) + lam_init;
        sc[3] = 1.f - lam_init;
    }
}

__device__ __forceinline__ void norm_mod_store(const Ptrs& P, float (&v)[16], int lane, int u, int layer, int which) {
    const float* g = (which == 0 ? P.in[6] : P.in[7]) + layer * D;
    const float* md = mod_row(P, layer, u) + (which == 0 ? 0 : 3 * D);
    float ss = 0.f;
#pragma unroll
    for (int i = 0; i < 16; ++i) ss += v[i] * v[i];
    const float rstd = rsqrtf(wave_sum(ss) * (1.f / D) + EPS);
    bf16* h = (bf16*)(P.ws + WS_H) + (size_t)u * D;
#pragma unroll
    for (int j = 0; j < 4; ++j) {
        const int c = j * 256 + lane * 4;
        const f32x4 gv = *(const f32x4*)(g + c), scv = *(const f32x4*)(md + D + c), shv = *(const f32x4*)(md + c);
#pragma unroll
        for (int e = 0; e < 4; ++e) v[4 * j + e] = v[4 * j + e] * rstd * gv[e] * (1.f + scv[e]) + shv[e];
        const unsigned lo = f2bf(v[4 * j]) | ((unsigned)f2bf(v[4 * j + 1]) << 16), hi = f2bf(v[4 * j + 2]) | ((unsigned)f2bf(v[4 * j + 3]) << 16);
        *(uint2*)(h + c) = make_uint2(lo, hi);
    }
}
__device__ __forceinline__ void router_row(const Ptrs& P, const float (&v)[16], int lane, int u, int layer) {
    const float* rw = P.in[32] + (size_t)layer * D * NE; const float* rb = P.in[33] + layer * NE;
    float lg[NE];
#pragma unroll
    for (int e = 0; e < NE; ++e) lg[e] = 0.f;
    for (int j = 0; j < 4; ++j)
        for (int q = 0; q < 4; ++q) { const int c = j * 256 + lane * 4 + q; const float hv = v[4 * j + q];
#pragma unroll
            for (int e4 = 0; e4 < NE / 4; ++e4) { const f32x4 w = *(const f32x4*)(rw + (size_t)c * NE + e4 * 4); lg[e4 * 4] += hv * w[0]; lg[e4 * 4 + 1] += hv * w[1]; lg[e4 * 4 + 2] += hv * w[2]; lg[e4 * 4 + 3] += hv * w[3]; } }
#pragma unroll
    for (int e = 0; e < NE; ++e) lg[e] = wave_sum(lg[e]) + rb[e];
    int te[4]; float tv[4];
#pragma unroll
    for (int k = 0; k < 4; ++k) { float best = -3.4e38f; int bi = 0;
#pragma unroll
        for (int e = 0; e < NE; ++e) { const bool ok = lg[e] > best; best = ok ? lg[e] : best; bi = ok ? e : bi; }
        te[k] = bi; tv[k] = best;
#pragma unroll
        for (int e = 0; e < NE; ++e) lg[e] = (e == bi) ? -3.4e38f : lg[e]; }
    float den = 0.f, w[4];
#pragma unroll
    for (int k = 0; k < 4; ++k) { w[k] = __expf(tv[k] - tv[0]); den += w[k]; }
    if (lane == 0) {
        unsigned* cnt = (unsigned*)(P.ws + WS_CTL) + CW_CNT + layer * 64;
        int* tok_of = (int*)(P.ws + WS_TOKOF); int* pair_of = (int*)(P.ws + WS_PAIROF); float* gate_of = (float*)(P.ws + WS_GATEOF);
#pragma unroll
        for (int k = 0; k < 4; ++k) { const unsigned rk = atomicAdd(&cnt[te[k]], 1u); tok_of[(size_t)te[k] * R + rk] = u; pair_of[(size_t)te[k] * R + rk] = u * 4 + k; gate_of[(size_t)te[k] * R + rk] = w[k] / den; }
    }
}
__device__ __forceinline__ void ph_rows(const Ptrs& P, int layer, int mode, int latent_only, int next_norm) {
    const int wave = threadIdx.x >> 6, lane = threadIdx.x & 63, G = gridDim.x;
    for (int u = (int)blockIdx.x * 8 + wave; u < R; u += G * 8) {
        if (latent_only && (u % SU) < CTX) continue;
        float v[16];
        const float* x = (mode == 0) ? res_in_row(P, layer, u) : (const float*)res_out_row(P, u);
#pragma unroll
        for (int j = 0; j < 4; ++j) { const f32x4 t = *(const f32x4*)(x + j * 256 + lane * 4); v[4 * j] = t[0]; v[4 * j + 1] = t[1]; v[4 * j + 2] = t[2]; v[4 * j + 3] = t[3]; }
        if (mode == 2) {
            const float* g2 = mod_row(P, layer, u) + 5 * D; float* xo = res_out_row(P, u);
            const bf16* y = (const bf16*)(P.ws + WS_Y) + (size_t)u * 4 * 1024;
#pragma unroll
            for (int j = 0; j < 4; ++j) { const int c = j * 256 + lane * 4; const f32x4 gv = *(const f32x4*)(g2 + c); f32x4 o;
#pragma unroll
                for (int e = 0; e < 4; ++e) { const float f = bf2f(y[c + e]) + bf2f(y[1024 + c + e]) + bf2f(y[2048 + c + e]) + bf2f(y[3072 + c + e]); v[4 * j + e] += gv[e] * f; o[e] = v[4 * j + e]; }
                *(f32x4*)(xo + c) = o; }
            if (next_norm) norm_mod_store(P, v, lane, u, layer + 1, 0);
        } else {
            norm_mod_store(P, v, lane, u, layer, mode);
            if (mode == 1) router_row(P, v, lane, u, layer);
        }
    }
}

template <class Prob, bool PAIR>
__device__ __forceinline__ void gemm_naive_tile(Prob& pr, float* lds, int n0) {
    float* As = lds;
    float* Bs = As + 32 * 132;
    float* B2s = Bs + 32 * 68;
    const int tid = threadIdx.x, tx = tid & 15, ty = tid >> 4;
    float acc[4][4] = {}, acc2[4][4] = {};
    const int lr = tid >> 2, lk = (tid & 3) * 8;
    const bf16* ap = pr.arow(lr); const bf16* bp = pr.brow(n0 + (lr & 63)); const bf16* b2p = PAIR ? pr.brow2(n0 + (lr & 63)) : nullptr;
    for (int k0 = 0; k0 < pr.K; k0 += 32) {
        u32x4 av = {0, 0, 0, 0}; if (ap) av = *(const u32x4*)(ap + k0 + lk);
        u32x4 bv = {0, 0, 0, 0}, b2v = {0, 0, 0, 0};
        if (lr < 64) bv = *(const u32x4*)(bp + k0 + lk); else if (PAIR) b2v = *(const u32x4*)(b2p + k0 + lk);
        __syncthreads();
#pragma unroll
        for (int i = 0; i < 4; ++i) {
            As[(lk + 2 * i) * 132 + lr] = __uint_as_float(av[i] << 16); As[(lk + 2 * i + 1) * 132 + lr] = __uint_as_float(av[i] & 0xffff0000u);
            if (lr < 64) { Bs[(lk + 2 * i) * 68 + lr] = __uint_as_float(bv[i] << 16); Bs[(lk + 2 * i + 1) * 68 + lr] = __uint_as_float(bv[i] & 0xffff0000u); }
            else if (PAIR) { B2s[(lk + 2 * i) * 68 + lr - 64] = __uint_as_float(b2v[i] << 16); B2s[(lk + 2 * i + 1) * 68 + lr - 64] = __uint_as_float(b2v[i] & 0xffff0000u); }
        }
        __syncthreads();
#pragma unroll 8
        for (int k = 0; k < 32; ++k) {
            const f32x4 a = *(const f32x4*)&As[k * 132 + ty * 4]; const f32x4 b = *(const f32x4*)&Bs[k * 68 + tx * 4];
#pragma unroll
            for (int i = 0; i < 4; ++i)
#pragma unroll
                for (int j = 0; j < 4; ++j) acc[i][j] += a[i] * b[j];
            if (PAIR) { const f32x4 b2 = *(const f32x4*)&B2s[k * 68 + tx * 4];
#pragma unroll
                for (int i = 0; i < 4; ++i)
#pragma unroll
                    for (int j = 0; j < 4; ++j) acc2[i][j] += a[i] * b2[j]; }
        }
    }
#pragma unroll
    for (int i = 0; i < 4; ++i)
#pragma unroll
        for (int j = 0; j < 4; ++j) pr.epi(ty * 4 + i, n0 + tx * 4 + j, acc[i][j], acc2[i][j]);
}
template <class Prob, bool PAIR>
__device__ __forceinline__ void ph_gemm_naive(Prob pr, unsigned char* lds, int nMt, int nNt, int item0) {
    const int G = gridDim.x, total = nMt * nNt;
    int first = ((int)blockIdx.x - item0 % G + G) % G;
    for (int it = first; it < total; it += G) { const int mt = it / nNt, nt = it % nNt; if (!pr.setup(mt)) continue; gemm_naive_tile<Prob, PAIR>(pr, (float*)lds, nt * 64); }
    __syncthreads();
}
struct ProbPlain {
    const bf16* A; int lda; const bf16* Bt; int K; bf16* C; int ldc; int m0;
    __device__ bool setup(int by) { m0 = by * 128; return true; }
    __device__ const bf16* arow(int m) const { return A + (size_t)(m0 + m) * lda; }
    __device__ const bf16* brow(int n) const { return Bt + (size_t)n * K; }
    __device__ const bf16* brow2(int n) const { return nullptr; }
    __device__ void epi(int m, int n, float a, float) const { C[(size_t)(m0 + m) * ldc + n] = f2bf(a); }
};
struct ProbOut {
    Ptrs P; const bf16* A; const bf16* Bt; int K; int layer; int latent_only; int m0;
    __device__ bool setup(int by) { m0 = by * 128; if (latent_only && (m0 % SU) < CTX) return false; return true; }
    __device__ const bf16* arow(int m) const { return A + (size_t)(m0 + m) * D; }
    __device__ const bf16* brow(int n) const { return Bt + (size_t)n * K; }
    __device__ const bf16* brow2(int n) const { return nullptr; }
    __device__ void epi(int m, int n, float a, float) const { const int u = m0 + m; const float g1 = mod_row(P, layer, u)[2 * D + n]; res_out_row(P, u)[n] = res_in_row(P, layer, u)[n] + g1 * a; }
};
__device__ __forceinline__ bool moe_find(const Ptrs& P, int layer, int t, int rows_per_tile, int& e, int& row0, int& cnt_e, int& actbase) {
    const unsigned* cnt = (const unsigned*)(P.ws + WS_CTL) + CW_CNT + layer * 64;
    int ab = 0;
    for (int x = 0; x < NE; ++x) { const int c = (int)cnt[x], nt = (c + rows_per_tile - 1) / rows_per_tile; if (t < nt) { e = x; row0 = t * rows_per_tile; cnt_e = c; actbase = ab; return true; } t -= nt; ab += (c + 255) / 256 * 256; }
    return false;
}
struct ProbMoe1 {
    Ptrs P; int layer; int K; int e, row0, cnt_e, actbase;
    __device__ bool setup(int by) { return moe_find(P, layer, by, 128, e, row0, cnt_e, actbase); }
    __device__ const bf16* arow(int m) const { const int r = row0 + m; if (r >= cnt_e) return nullptr; const int u = ((const int*)(P.ws + WS_TOKOF))[(size_t)e * R + r]; return (const bf16*)(P.ws + WS_H) + (size_t)u * D; }
    __device__ const bf16* brow(int j) const { return (const bf16*)(P.ws + WS_WGU) + ((size_t)(layer * NE + e) * 2048 + (j / 128) * 256 + (j % 128)) * 1024; }
    __device__ const bf16* brow2(int j) const { return brow(j) + (size_t)128 * 1024; }
    __device__ void epi(int m, int j, float ag, float au) const {
        const int r = row0 + m; if (r >= cnt_e) return;
        const float* bgu = P.in[35] + (size_t)(layer * NE + e) * 2048;
        float g = ag + bgu[j], uu = au + bgu[1024 + j];
        g = fminf(g, 7.f); uu = fminf(fmaxf(uu, -7.f), 7.f);
        const float act = (uu + 1.f) * g * sigmoidf_(1.702f * g);
        ((bf16*)(P.ws + WS_ACT))[(size_t)(actbase + r) * 1024 + j] = f2bf(act);
    }
};
struct ProbMoe2 {
    Ptrs P; int layer; int K; int e, row0, cnt_e, actbase;
    __device__ bool setup(int by) { return moe_find(P, layer, by, 128, e, row0, cnt_e, actbase); }
    __device__ const bf16* arow(int m) const { const int r = row0 + m; if (r >= cnt_e) return nullptr; return (const bf16*)(P.ws + WS_ACT) + (size_t)(actbase + r) * 1024; }
    __device__ const bf16* brow(int n) const { return (const bf16*)(P.ws + WS_WDN) + ((size_t)(layer * NE + e) * 1024 + n) * 1024; }
    __device__ const bf16* brow2(int n) const { return nullptr; }
    __device__ void epi(int m, int n, float a, float) const {
        const int r = row0 + m; if (r >= cnt_e) return;
        const int pair = ((const int*)(P.ws + WS_PAIROF))[(size_t)e * R + r]; const float gw = ((const float*)(P.ws + WS_GATEOF))[(size_t)e * R + r];
        const float y = (a + P.in[37][(size_t)(layer * NE + e) * 1024 + n]) * gw;
        ((bf16*)(P.ws + WS_Y))[(size_t)pair * 1024 + n] = f2bf(y);
    }
};

namespace g8 {
typedef short bf16x8 __attribute__((ext_vector_type(8)));
constexpr int BM = 256, BK = 64, HALF = 128, HTB = HALF * BK * 2, STAGE_BYTES = 8 * HTB, NXCD = 8, WGM = 8;
__host__ __device__ __forceinline__ int lds_byte(int r, int c) { const int st = (r >> 4) * 2 + (c >> 5), rr = r & 15, cc = c & 31, ob = rr * 64 + cc * 2; return st * 1024 + (ob ^ (((ob >> 9) & 1) << 5)); }
__host__ __device__ __forceinline__ void stage_rc(int b, int& R, int& C) { const int st = b / 1024, sb = b % 1024, swz = sb ^ (((sb >> 9) & 1) << 5); R = (st >> 1) * 16 + swz / 64; C = (st & 1) * 32 + (swz % 64) / 2; }
__host__ __device__ __forceinline__ int perm32(int rho) { const int n = rho >> 4, i = rho & 15; return 8 * (i >> 2) + 4 * n + (i & 3); }
struct Unit { const char* a; const char* b; int pm, pn, e, aux, cnt; };
__device__ __forceinline__ unsigned cvt_pk_bf16(float lo, float hi) { unsigned r; asm volatile("v_cvt_pk_bf16_f32 %0, %1, %2" : "=v"(r) : "v"(lo), "v"(hi)); return r; }

template <class Epi, class Sched, bool GATHER, bool ALIGN_EPI>
__device__ __forceinline__ void gemm_phase(LAS unsigned char* lds, const int lda, const int K, const Sched& S, const Epi& E) {
    const int tid = threadIdx.x, wid = __builtin_amdgcn_readfirstlane(tid >> 6), lane = tid & 63, wr = wid >> 2, wc = wid & 3, fr = lane & 15, fq = lane >> 4;
    const int nt = K / BK;
    int Rr[2], Cc[2]; unsigned voffB[2];
#pragma unroll
    for (int i = 0; i < 2; ++i) { stage_rc(tid * 16 + i * 8192, Rr[i], Cc[i]); const int Rb = Epi::PERM ? ((Rr[i] & ~31) + perm32(Rr[i] & 31)) : Rr[i]; voffB[i] = (unsigned)(Rb * K + Cc[i]) * 2u; }
    const size_t kstep = (size_t)(BK * 2);
    const size_t hstepB = (size_t)HALF * K * 2;
    const unsigned ldsw = (unsigned)wid * 1024u;
    const int aoff = lds_byte(wr * 64 + fr, fq * 8), boff = lds_byte(wc * 32 + fr, fq * 8);
#define G8_SA(b, h) (((b) * 2 + (h)) * HTB)
#define G8_SB(b, h) ((4 + (b) * 2 + (h)) * HTB)
#define G8_STAGE(bufoff, gbase, v0, v1) do { \
        __builtin_amdgcn_global_load_lds((const unsigned*)((const char*)(gbase) + (v0)), (LAS unsigned*)(lds + (bufoff) + ldsw), 16, 0, 0); \
        __builtin_amdgcn_global_load_lds((const unsigned*)((const char*)(gbase) + (v1)), (LAS unsigned*)(lds + (bufoff) + ldsw + 8192), 16, 0, 0); } while (0)
#define G8_LDA(dst, b, h) do { _Pragma("unroll") for (int m = 0; m < 4; ++m) _Pragma("unroll") for (int k = 0; k < 2; ++k) dst[m][k] = *(const LAS bf16x8*)(lds + G8_SA(b, h) + aoff + m * 2048 + k * 1024); } while (0)
#define G8_LDB(dst, b, h) do { _Pragma("unroll") for (int n = 0; n < 2; ++n) _Pragma("unroll") for (int k = 0; k < 2; ++k) dst[n][k] = *(const LAS bf16x8*)(lds + G8_SB(b, h) + boff + n * 2048 + k * 1024); } while (0)
#define G8_MMA(ai, bj, At, Bt) do { __builtin_amdgcn_s_setprio(1); _Pragma("unroll") for (int m = 0; m < 4; ++m) _Pragma("unroll") for (int n = 0; n < 2; ++n) _Pragma("unroll") for (int k = 0; k < 2; ++k) \
        acc[ai][bj][m][n] = __builtin_amdgcn_mfma_f32_16x16x32_bf16(Bt[n][k], At[m][k], acc[ai][bj][m][n], 0, 0, 0); __builtin_amdgcn_s_setprio(0); } while (0)
#define G8_WAIT_V(n) asm volatile("s_waitcnt vmcnt(" #n ")" ::: "memory")
#define G8_WAIT_L(n) asm volatile("s_waitcnt lgkmcnt(" #n ")" ::: "memory")
#define G8_BAR __builtin_amdgcn_s_barrier()
#define G8_SCHED __builtin_amdgcn_sched_barrier(0)
    Unit cur, nxt; int ui = 0;
    if (!S.next(0, cur)) return;
    unsigned vA0[2], vA1[2], nA0[2], nA1[2];
#pragma unroll
    for (int i = 0; i < 2; ++i) {
        if (GATHER) { vA0[i] = S.arow_off(cur, Rr[i]) + (unsigned)Cc[i] * 2u; vA1[i] = S.arow_off(cur, HALF + Rr[i]) + (unsigned)Cc[i] * 2u; }
        else { vA0[i] = (unsigned)(Rr[i] * lda + Cc[i]) * 2u; vA1[i] = (unsigned)((HALF + Rr[i]) * lda + Cc[i]) * 2u; }
        nA0[i] = vA0[i]; nA1[i] = vA1[i];
    }
    f32x4 acc[2][2][4][2];
#pragma unroll
    for (int a = 0; a < 2; ++a)
#pragma unroll
        for (int b = 0; b < 2; ++b)
#pragma unroll
            for (int m = 0; m < 4; ++m)
#pragma unroll
                for (int n = 0; n < 2; ++n) acc[a][b][m][n] = (f32x4){0.f, 0.f, 0.f, 0.f};
    bf16x8 At[4][2], B0[2][2], B1[2][2];
    const char* cA = cur.a; const char* cB = cur.b;
    G8_STAGE(G8_SB(0, 0), cB, voffB[0], voffB[1]); G8_STAGE(G8_SB(0, 1), cB + hstepB, voffB[0], voffB[1]); G8_STAGE(G8_SA(0, 0), cA, vA0[0], vA0[1]); G8_STAGE(G8_SA(0, 1), cA, vA1[0], vA1[1]);
    if (wr == 1) G8_BAR;
    G8_WAIT_V(2); G8_BAR;
    G8_STAGE(G8_SB(1, 0), cB + kstep, voffB[0], voffB[1]); G8_STAGE(G8_SA(1, 0), cA + kstep, vA0[0], vA0[1]); G8_STAGE(G8_SB(1, 1), cB + hstepB + kstep, voffB[0], voffB[1]);
    G8_WAIT_V(6); G8_BAR;
    for (;;) {
        const bool has_next = S.next(ui + 1, nxt);
        const char* nA = has_next ? nxt.a : cA; const char* nB = has_next ? nxt.b : cB;
        if (GATHER) {
#pragma unroll
            for (int i = 0; i < 2; ++i) { if (has_next) { nA0[i] = S.arow_off(nxt, Rr[i]) + (unsigned)Cc[i] * 2u; nA1[i] = S.arow_off(nxt, HALF + Rr[i]) + (unsigned)Cc[i] * 2u; } else { nA0[i] = vA0[i]; nA1[i] = vA1[i]; } }
        }
        for (int t = 0; t < nt; t += 2) {
            const bool last = (t == nt - 2);
            const char* a1 = cA + (size_t)(t + 1) * kstep;
            const char* a2 = last ? nA : cA + (size_t)(t + 2) * kstep; const char* b2 = last ? nB : cB + (size_t)(t + 2) * kstep;
            const char* a3 = a2 + kstep; const char* b3 = b2 + kstep;
            unsigned x00 = vA0[0], x01 = vA0[1], x10 = vA1[0], x11 = vA1[1];
            if (GATHER) { x00 = last ? nA0[0] : vA0[0]; x01 = last ? nA0[1] : vA0[1]; x10 = last ? nA1[0] : vA1[0]; x11 = last ? nA1[1] : vA1[1]; }
            G8_LDB(B0, 0, 0); G8_LDB(B1, 0, 1); G8_SCHED; G8_LDA(At, 0, 0); G8_STAGE(G8_SA(1, 1), a1, vA1[0], vA1[1]);
            G8_WAIT_V(8); G8_WAIT_L(0); G8_BAR; G8_MMA(0, 0, At, B0); G8_MMA(0, 1, At, B1); G8_BAR; G8_SCHED;
            G8_LDA(At, 0, 1); G8_STAGE(G8_SB(0, 0), b2, voffB[0], voffB[1]); G8_STAGE(G8_SB(0, 1), b2 + hstepB, voffB[0], voffB[1]); G8_STAGE(G8_SA(0, 0), a2, x00, x01);
            G8_WAIT_V(8); G8_WAIT_L(0); G8_BAR; G8_MMA(1, 0, At, B0); G8_MMA(1, 1, At, B1); G8_BAR; G8_SCHED;
            G8_LDB(B0, 1, 0); G8_LDB(B1, 1, 1); G8_SCHED; G8_LDA(At, 1, 0); G8_STAGE(G8_SA(0, 1), a2, x10, x11);
            G8_WAIT_V(8); G8_WAIT_L(0); G8_BAR; G8_MMA(0, 0, At, B0); G8_MMA(0, 1, At, B1); G8_BAR; G8_SCHED;
            G8_LDA(At, 1, 1); G8_STAGE(G8_SB(1, 0), b3, voffB[0], voffB[1]); G8_STAGE(G8_SB(1, 1), b3 + hstepB, voffB[0], voffB[1]); G8_STAGE(G8_SA(1, 0), a3, x00, x01);
            G8_WAIT_V(8); G8_WAIT_L(0); G8_BAR; G8_MMA(1, 0, At, B0); G8_MMA(1, 1, At, B1); G8_BAR; G8_SCHED;
        }
        if constexpr (ALIGN_EPI) { if (wr == 0) G8_BAR; }
        E(acc, cur, wr, wc, fr, fq);
        if (!has_next) break;
#pragma unroll
        for (int a = 0; a < 2; ++a)
#pragma unroll
            for (int b = 0; b < 2; ++b)
#pragma unroll
                for (int m = 0; m < 4; ++m)
#pragma unroll
                    for (int n = 0; n < 2; ++n) acc[a][b][m][n] = (f32x4){0.f, 0.f, 0.f, 0.f};
        cur = nxt; cA = nA; cB = nB; ++ui;
        if (GATHER) {
#pragma unroll
            for (int i = 0; i < 2; ++i) { vA0[i] = nA0[i]; vA1[i] = nA1[i]; }
        }
        if constexpr (ALIGN_EPI) { if (wr == 1) G8_BAR; }
    }
    G8_WAIT_V(0);
    if constexpr (!ALIGN_EPI) { if (wr == 0) G8_BAR; }
    G8_BAR;
#undef G8_SA
#undef G8_SB
#undef G8_STAGE
#undef G8_LDA
#undef G8_LDB
#undef G8_MMA
#undef G8_WAIT_V
#undef G8_WAIT_L
#undef G8_BAR
#undef G8_SCHED
}

struct DenseOrder {
    const char* A; const char* Bt; int lda, K, nM, nN, nwg, G, c, skip_ctx;
    __device__ void init(const bf16* A_, int lda_, const bf16* Bt_, int K_, int M, int N, int G_, int c_, int skip_ctx_) {
        A = (const char*)A_; Bt = (const char*)Bt_; lda = lda_; K = K_; skip_ctx = skip_ctx_; nM = M / BM; if (skip_ctx) nM = nM / 17 * 16; nN = N / BM; nwg = nM * nN; G = G_; c = c_; }
    __device__ bool next(int i, Unit& u) const {
        const long L = (long)i * G + c; if (L >= nwg) return false;
        int wgid = (int)L; { const int q = nwg / NXCD, r = nwg % NXCD, xcd = wgid % NXCD, off = wgid / NXCD; wgid = (xcd < r ? xcd * (q + 1) : r * (q + 1) + (xcd - r) * q) + off; }
        const int nig = WGM * nN, gid = wgid / nig, fm = gid * WGM, gsz = (nM - fm) < WGM ? (nM - fm) : WGM;
        int pm = fm + ((wgid % nig) % gsz); const int pn = (wgid % nig) / gsz;
        if (skip_ctx) pm = (pm / 16) * 17 + 1 + (pm % 16);
        u.pm = pm; u.pn = pn; u.e = 0; u.aux = 0; u.cnt = 0;
        u.a = A + (size_t)pm * BM * lda * 2; u.b = Bt + (size_t)pn * BM * K * 2; return true;
    }
    __device__ unsigned arow_off(const Unit&, int) const { return 0u; }
};
}
namespace g8 {
struct MoeOrder {
    const unsigned* cnt; const char* Abase; const char* Bbase; const int* rowtab; size_t bstride; int nN, K, G, vcu, gather;
    __device__ bool next(int i, Unit& u) const {
        int L = i * G + vcu, ab = 0;
        for (int e = 0; e < NE; ++e) { const int c = (int)cnt[e], mt = (c + 255) >> 8, tl = mt * nN;
            if (L < tl) { u.e = e; u.pm = L / nN; u.pn = L % nN; u.aux = ab; u.cnt = c;
                u.a = gather ? Abase : Abase + (size_t)(ab + u.pm * 256) * 1024 * 2; u.b = Bbase + (size_t)e * bstride + (size_t)u.pn * 256 * K * 2; return true; }
            L -= tl; ab += mt * 256; }
        return false;
    }
    __device__ unsigned arow_off(const Unit& u, int r) const { int rr = u.pm * 256 + r; rr = rr < u.cnt ? rr : u.cnt - 1; return (unsigned)rowtab[(size_t)u.e * R + rr] * (unsigned)(D * 2); }
};
struct EpiStoreBf16 {
    static constexpr bool PERM = true; bf16* C; int ldc;
    __device__ __forceinline__ void operator()(const f32x4 (&acc)[2][2][4][2], const Unit& u, int wr, int wc, int fr, int fq) const {
        const int row0 = u.pm * BM + wr * 64 + fr, col0 = u.pn * BM + wc * 32 + 8 * fq;
#pragma unroll
        for (int ai = 0; ai < 2; ++ai)
#pragma unroll
            for (int m = 0; m < 4; ++m) { bf16* rowp = C + (size_t)(row0 + ai * HALF + m * 16) * ldc + col0;
#pragma unroll
                for (int bj = 0; bj < 2; ++bj) { const f32x4 v0 = acc[ai][bj][m][0], v1 = acc[ai][bj][m][1];
                    u32x4 w; w.x = cvt_pk_bf16(v0[0], v0[1]); w.y = cvt_pk_bf16(v0[2], v0[3]); w.z = cvt_pk_bf16(v1[0], v1[1]); w.w = cvt_pk_bf16(v1[2], v1[3]);
                    *(u32x4*)(rowp + bj * HALF) = w; } }
    }
};
struct EpiOut {
    static constexpr bool PERM = false; Ptrs P; int layer;
    __device__ __forceinline__ void operator()(const f32x4 (&acc)[2][2][4][2], const Unit& u, int wr, int wc, int fr, int fq) const {
        const int b = u.pm / 17, jt = u.pm % 17;
        const float* g1 = (const float*)(P.ws + WS_MOD) + (size_t)(layer * 5 + (jt == 0 ? 4 : b)) * 6144 + 2 * D;
        const float* in0; float* out0;
        if (jt == 0) { out0 = (float*)(P.ws + WS_XC) + (size_t)(b * CTX) * D; in0 = layer == 0 ? P.in[2] + (size_t)(b * CTX) * D : out0; }
        else { out0 = P.out + (size_t)(b * SEQ + (jt - 1) * 256) * D; in0 = layer == 0 ? P.in[0] + (size_t)(b * SEQ + (jt - 1) * 256) * D : out0; }
        const int col0 = u.pn * BM + wc * 32 + 4 * fq;
        f32x4 gv[2][2];
#pragma unroll
        for (int bj = 0; bj < 2; ++bj)
#pragma unroll
            for (int n = 0; n < 2; ++n) gv[bj][n] = *(const f32x4*)(g1 + col0 + bj * HALF + n * 16);
#pragma unroll
        for (int ai = 0; ai < 2; ++ai)
#pragma unroll
            for (int m = 0; m < 4; ++m) { const size_t off = (size_t)(ai * HALF + wr * 64 + m * 16 + fr) * D + col0;
#pragma unroll
                for (int bj = 0; bj < 2; ++bj)
#pragma unroll
                    for (int n = 0; n < 2; ++n) { const f32x4 xi = *(const f32x4*)(in0 + off + bj * HALF + n * 16); *(f32x4*)(out0 + off + bj * HALF + n * 16) = xi + gv[bj][n] * acc[ai][bj][m][n]; } }
    }
};
struct EpiMoe1 {
    static constexpr bool PERM = true; Ptrs P; int layer;
    __device__ __forceinline__ void operator()(const f32x4 (&acc)[2][2][4][2], const Unit& u, int wr, int wc, int fr, int fq) const {
        const float* bgu = P.in[35] + (size_t)(layer * NE + u.e) * 2048;
        const int cl = u.pn * 128 + wc * 32 + 8 * fq;
        f32x4 bg[2], bu[2];
#pragma unroll
        for (int n = 0; n < 2; ++n) { bg[n] = *(const f32x4*)(bgu + cl + 4 * n); bu[n] = *(const f32x4*)(bgu + 1024 + cl + 4 * n); }
        bf16* act = (bf16*)(P.ws + WS_ACT) + (size_t)(u.aux + u.pm * 256 + wr * 64 + fr) * 1024 + cl;
#pragma unroll
        for (int ai = 0; ai < 2; ++ai)
#pragma unroll
            for (int m = 0; m < 4; ++m) { float o[8];
#pragma unroll
                for (int n = 0; n < 2; ++n)
#pragma unroll
                    for (int j = 0; j < 4; ++j) { float g = acc[ai][0][m][n][j] + bg[n][j], uu = acc[ai][1][m][n][j] + bu[n][j];
                        g = fminf(g, 7.f); uu = fminf(fmaxf(uu, -7.f), 7.f);
                        const float sg = __builtin_amdgcn_rcpf(1.f + __expf(-1.702f * g)); o[n * 4 + j] = (uu + 1.f) * g * sg; }
                u32x4 w; w.x = cvt_pk_bf16(o[0], o[1]); w.y = cvt_pk_bf16(o[2], o[3]); w.z = cvt_pk_bf16(o[4], o[5]); w.w = cvt_pk_bf16(o[6], o[7]);
                *(u32x4*)(act + (size_t)(ai * HALF + m * 16) * 1024) = w; }
    }
};
struct EpiMoe2 {
    static constexpr bool PERM = true; Ptrs P; int layer;
    __device__ __forceinline__ void operator()(const f32x4 (&acc)[2][2][4][2], const Unit& u, int wr, int wc, int fr, int fq) const {
        const float* bd = P.in[37] + (size_t)(layer * NE + u.e) * 1024;
        const int col0 = u.pn * BM + wc * 32 + 8 * fq;
        f32x4 bv[2][2];
#pragma unroll
        for (int bj = 0; bj < 2; ++bj)
#pragma unroll
            for (int n = 0; n < 2; ++n) bv[bj][n] = *(const f32x4*)(bd + col0 + bj * HALF + 4 * n);
        const int* pair_of = (const int*)(P.ws + WS_PAIROF) + (size_t)u.e * R; const float* gate_of = (const float*)(P.ws + WS_GATEOF) + (size_t)u.e * R;
        bf16* Y = (bf16*)(P.ws + WS_Y);
#pragma unroll
        for (int ai = 0; ai < 2; ++ai)
#pragma unroll
            for (int m = 0; m < 4; ++m) { const int r = u.pm * 256 + ai * HALF + wr * 64 + m * 16 + fr;
                if (r < u.cnt) { const int pair = pair_of[r]; const float gw = gate_of[r]; bf16* rowp = Y + (size_t)pair * 1024 + col0;
#pragma unroll
                    for (int bj = 0; bj < 2; ++bj) { const f32x4 v0 = (acc[ai][bj][m][0] + bv[bj][0]) * gw, v1 = (acc[ai][bj][m][1] + bv[bj][1]) * gw;
                        u32x4 w; w.x = cvt_pk_bf16(v0[0], v0[1]); w.y = cvt_pk_bf16(v0[2], v0[3]); w.z = cvt_pk_bf16(v1[0], v1[1]); w.w = cvt_pk_bf16(v1[2], v1[3]);
                        *(u32x4*)(rowp + bj * HALF) = w; } } }
    }
};
}

__device__ __forceinline__ int bwd_pos(int c) { return c < 2 ? 1 - c : 2 + (NCH - 1 - c); }
__device__ __forceinline__ int bwd_chunk_at(int p) { return p < 2 ? 1 - p : NCH - 1 - (p - 2); }
__device__ __forceinline__ void lru_item(const Ptrs& P, unsigned char* lds, int mode, int n, int c, int b) {
    float* X = (float*)lds;
    float* A = X + CHUNK * 64;
    float* B = A + CHUNK * 64;
    bf16* wS = (bf16*)(B + CHUNK * 64);
    const int tid = threadIdx.x;
    const int j0 = c * CHUNK, seg_lo = (c < 2) ? 0 : CTX, seg_hi = (c < 2) ? CTX : SU;
    const bf16* Z = (const bf16*)(P.ws + WS_Z);
    const float* cw = P.in[10]; const float* cb = P.in[11];
    __syncthreads();
    for (int i = tid; i < CHUNK * 64; i += NT) {
        const int t = i >> 6, ch = i & 63, cg = n * 64 + ch; float acc = cb[cg];
#pragma unroll
        for (int k = 0; k < 4; ++k) { const int j = j0 + t - 2 + k; if (j >= seg_lo && j < seg_hi) acc += cw[k * LRU_W + cg] * bf2f(Z[(size_t)(b * SU + j) * EVEN_IN_P + 512 + cg]); }
        X[i] = acc;
    }
    float* agg = (float*)(P.ws + WS_AGG);
    for (int dir = 0; dir < 2; ++dir) {
        __syncthreads();
        const bf16* wl = (const bf16*)(P.ws + WS_WLRU) + (size_t)(dir * 2) * 8 * 4096;
        for (int i = tid; i < 2 * 4096; i += NT) { const int gate = i >> 12, e = (i >> 6) & 63, d = i & 63; wS[(gate * 64 + d) * 66 + e] = wl[((size_t)gate * 8 + n) * 4096 + e * 64 + d]; }
        __syncthreads();
        const float* ba = P.in[13] + dir * LRU_W + n * 64; const float* bx = P.in[15] + dir * LRU_W + n * 64; const float* lam = P.in[16] + dir * LRU_W + n * 64;
        float ra_[16], ru_[16];
#pragma unroll
        for (int q = 0; q < 16; ++q) {
            const int i = tid + q * NT, t = i >> 6, e = i & 63; float ra = ba[e], ri = bx[e];
            for (int d = 0; d < 64; ++d) { const float xv = bf2f(f2bf(X[t * 64 + d])); ra += xv * bf2f(wS[d * 66 + e]); ri += xv * bf2f(wS[(64 + d) * 66 + e]); }
            const float r = sigmoidf_(ra), ig = sigmoidf_(ri);
            const float sp = log1pf(__expf(-lam[e]));
            const float log_a = -8.f * r * sp;
            ra_[q] = __expf(log_a);
            ru_[q] = sqrtf(fmaxf(-expm1f(2.f * log_a), 0.f)) * ig * X[t * 64 + e];
        }
        __syncthreads();
        float* U = dir == 0 ? B : X;
#pragma unroll
        for (int q = 0; q < 16; ++q) { const int i = tid + q * NT; A[i] = ra_[q]; U[i] = ru_[q]; }
        __syncthreads();
        if (tid < 64) {
            const int ch = tid; float h = 0.f;
            if (mode == 1) {
                const int pos = dir == 0 ? c : bwd_pos(c);
                for (int p = 0; p < pos; ++p) { const int cc = dir == 0 ? p : bwd_chunk_at(p); const float* ag = agg + ((((size_t)b * NCH + cc) * 2 + dir) * 512 + n * 64 + ch) * 2; h = ag[0] * h + ag[1]; }
            }
            float ap = 1.f;
            if (dir == 0) { for (int t = 0; t < CHUNK; ++t) { const float a = A[t * 64 + ch]; h = a * h + U[t * 64 + ch]; ap *= a; U[t * 64 + ch] = h; } }
            else { for (int t = CHUNK - 1; t >= 0; --t) { const float a = A[t * 64 + ch]; h = a * h + U[t * 64 + ch]; ap *= a; U[t * 64 + ch] = h; } }
            if (mode == 0) { float* ag = agg + ((((size_t)b * NCH + c) * 2 + dir) * 512 + n * 64 + ch) * 2; ag[0] = ap; ag[1] = h; }
        }
    }
    if (mode == 1) {
        __syncthreads();
        bf16* mix = (bf16*)(P.ws + WS_MIX);
        for (int i = tid; i < CHUNK * 64; i += NT) { const int t = i >> 6, ch = i & 63; const size_t u = (size_t)b * SU + j0 + t;
            const float gl = bf2f(Z[u * EVEN_IN_P + n * 64 + ch]); mix[u * D + n * 64 + ch] = f2bf(gelu_tanh(gl) * (B[i] + X[i])); }
    }
}
__device__ __forceinline__ void ph_lru(const Ptrs& P, unsigned char* lds, int mode, int item0) {
    const int G = gridDim.x, total = 8 * NCH * NB;
    int first = ((int)blockIdx.x - item0 % G + G) % G;
    for (int it = first; it < total; it += G) lru_item(P, lds, mode, it % 8, (it / 8) % NCH, it / (8 * NCH));
    __syncthreads();
}

__device__ __forceinline__ void rope_angles(int t, int q, float& cr, float& sr, float& cc, float& scn) {
    const float f = exp2f(-(float)(2 * q) / 32.f * 13.287712379549449f);
    const float ar = (float)(t / GRID_W) * f, ac = (float)(t % GRID_W) * f;
    sincosf(ar, &sr, &cr); sincosf(ac, &scn, &cc);
}
__device__ __forceinline__ void ph_mla_prep(const Ptrs& P) {
    const int wave = threadIdx.x >> 6, lane = threadIdx.x & 63, G = gridDim.x;
    const float* qn = P.in[21]; const float* kn = P.in[22];
    for (int u = (int)blockIdx.x * 8 + wave; u < R; u += G * 8) {
        const int j = u % SU; const bool latent = j >= CTX; const int t = j - CTX;
        const bf16* z = (const bf16*)(P.ws + WS_Z) + (size_t)u * EVEN_IN_P;
        float sq = 0.f, sk = 0.f;
        for (int i = lane; i < 384; i += 64) { const float v = bf2f(z[1024 + i]); sq += v * v; }
        for (int i = lane; i < 256; i += 64) { const float v = bf2f(z[1408 + i]); sk += v * v; }
        const float rq = rsqrtf(wave_sum(sq) * (1.f / 384.f) + EPS), rk = rsqrtf(wave_sum(sk) * (1.f / 256.f) + EPS);
        const bf16* qp = (const bf16*)(P.ws + WS_QP) + (size_t)u * 768; const bf16* kvp = (const bf16*)(P.ws + WS_KVP) + (size_t)u * 1024;
        bf16* qm = (bf16*)(P.ws + WS_QM) + (size_t)u * 768; bf16* km = (bf16*)(P.ws + WS_KM) + (size_t)u * 768; bf16* vm = (bf16*)(P.ws + WS_VM) + (size_t)u * 512;
        float cs = 1.f, sn = 0.f;
        if (latent) { float cr, sr, cc, sc2; rope_angles(t, lane & 15, cr, sr, cc, sc2); cs = (lane >> 5) ? cc : cr; sn = (lane >> 5) ? sc2 : sr; }
        const float kr_raw = bf2f(z[1664 + lane]);
        for (int h = 0; h < MLA_H; ++h) {
            float q0 = bf2f(qp[h * 192 + lane]) * rq, q1 = bf2f(qp[h * 192 + 64 + lane]) * rq, q2 = bf2f(qp[h * 192 + 128 + lane]) * rq;
            float r = rsqrtf(wave_sum(q0 * q0 + q1 * q1 + q2 * q2) * (1.f / 192.f) + EPS);
            q0 *= r * qn[lane]; q1 *= r * qn[64 + lane]; q2 *= r * qn[128 + lane];
            { const float other = __shfl_xor(q2, 16); const float rot = ((lane >> 4) & 1) ? other : -other; q2 = q2 * cs + rot * sn; }
            { const float c2 = 0.07216878364870322f * LOG2E; qm[h * 192 + lane] = f2bf(q0 * c2); qm[h * 192 + 64 + lane] = f2bf(q1 * c2); qm[h * 192 + 128 + lane] = f2bf(q2 * c2); }
            float k0 = bf2f(kvp[h * 256 + lane]) * rk, k1 = bf2f(kvp[h * 256 + 64 + lane]) * rk, k2 = kr_raw;
            const float v0 = bf2f(kvp[h * 256 + 128 + lane]) * rk, v1 = bf2f(kvp[h * 256 + 192 + lane]) * rk;
            r = rsqrtf(wave_sum(k0 * k0 + k1 * k1 + k2 * k2) * (1.f / 192.f) + EPS);
            k0 *= r * kn[lane]; k1 *= r * kn[64 + lane]; k2 *= r * kn[128 + lane];
            { const float other = __shfl_xor(k2, 16); const float rot = ((lane >> 4) & 1) ? other : -other; k2 = k2 * cs + rot * sn; }
            km[h * 192 + lane] = f2bf(k0); km[h * 192 + 64 + lane] = f2bf(k1); km[h * 192 + 128 + lane] = f2bf(k2);
            vm[h * 128 + lane] = f2bf(v0); vm[h * 128 + 64 + lane] = f2bf(v1);
        }
    }
}
__device__ __forceinline__ void ph_diff_prep(const Ptrs& P) {
    const int wave = threadIdx.x >> 6, lane = threadIdx.x & 63, G = gridDim.x;
    for (int u = (int)blockIdx.x * 8 + wave; u < R; u += G * 8) {
        const int j = u % SU; const bool latent = j >= CTX; const int t = j - CTX;
        bf16* z = (bf16*)(P.ws + WS_Z) + (size_t)u * ODD_IN;
        float cs = 1.f, sn = 0.f;
        if (latent) { float cr, sr, cc, sc2; rope_angles(t, lane & 15, cr, sr, cc, sc2); cs = (lane >> 5) ? cc : cr; sn = (lane >> 5) ? sc2 : sr; }
        for (int qk = 0; qk < 2; ++qk) {
            const float* gn = (qk == 0 ? P.in[25] : P.in[26]);
            for (int g = 0; g < 16; ++g) {
                bf16* p = z + qk * 1024 + g * 64;
                float v = bf2f(p[lane]);
                const float r = rsqrtf(wave_sum(v * v) * (1.f / 64.f) + EPS);
                v *= r * gn[lane];
                const float other = __shfl_xor(v, 16); const float rot = ((lane >> 4) & 1) ? other : -other; v = v * cs + rot * sn;
                if (qk == 0) v *= 0.125f * LOG2E;
                p[lane] = f2bf(v);
            }
        }
    }
}

template <int DKH, int NSM, int MODE>
__device__ __forceinline__ void attn_naive_item(const Ptrs& P, float* sm, const bf16* Qb, int ldq, int qoff_h, const bf16* Kb, int ldk, int koff_h, const bf16* Vb, int ldv, int voff_h,
                                                int q_j0, int key_j0, int nkeys, float c2, int scal_idx, int qb, int h, int b) {
    constexpr int DK = DKH * NSM;
    float* Qs = sm; float* Ks = Qs + 64 * (DK + 1); float* Vs = Ks + 32 * (DK + 1); float* Ps = Vs + 32 * 128;
    const int tid = threadIdx.x, q = tid >> 3, part = tid & 7;
    const size_t uq0 = (size_t)b * SU + q_j0 + qb * 64, uk0 = (size_t)b * SU + key_j0;
    const float M = ((const float*)(P.ws + WS_SCAL))[scal_idx];
    __syncthreads();
    for (int i = tid; i < 64 * DK; i += NT) { const int r = i / DK, c = i % DK; Qs[r * (DK + 1) + c] = bf2f(Qb[(uq0 + r) * ldq + h * qoff_h + c]); }
    float o[NSM][16]; float l[NSM];
#pragma unroll
    for (int s = 0; s < NSM; ++s) { l[s] = 0.f;
#pragma unroll
        for (int d = 0; d < 16; ++d) o[s][d] = 0.f; }
    for (int k0 = 0; k0 < nkeys; k0 += 32) {
        __syncthreads();
        for (int i = tid; i < 32 * DK; i += NT) { const int r = i / DK, c = i % DK; Ks[r * (DK + 1) + c] = bf2f(Kb[(uk0 + k0 + r) * ldk + h * koff_h + c]); }
        for (int i = tid; i < 32 * 128; i += NT) { const int r = i >> 7, c = i & 127; Vs[r * 128 + c] = bf2f(Vb[(uk0 + k0 + r) * ldv + h * voff_h + c]); }
        __syncthreads();
#pragma unroll
        for (int s = 0; s < NSM; ++s) {
            float sc[4] = {0.f, 0.f, 0.f, 0.f};
            for (int d = 0; d < DKH; ++d) { const float qv = Qs[q * (DK + 1) + s * DKH + d];
#pragma unroll
                for (int kk = 0; kk < 4; ++kk) sc[kk] += qv * Ks[(part * 4 + kk) * (DK + 1) + s * DKH + d]; }
#pragma unroll
            for (int kk = 0; kk < 4; ++kk) { const float p = exp2f(sc[kk] * c2 - M); l[s] += p; Ps[(s * 64 + q) * 33 + part * 4 + kk] = p; }
        }
        __syncthreads();
#pragma unroll
        for (int s = 0; s < NSM; ++s)
            for (int kk = 0; kk < 32; ++kk) { const float p = Ps[(s * 64 + q) * 33 + kk];
#pragma unroll
                for (int d = 0; d < 16; ++d) o[s][d] += p * Vs[kk * 128 + d * 8 + part]; }
    }
#pragma unroll
    for (int s = 0; s < NSM; ++s) { l[s] += __shfl_xor(l[s], 1); l[s] += __shfl_xor(l[s], 2); l[s] += __shfl_xor(l[s], 4); }
    bf16* mix = (bf16*)(P.ws + WS_MIX) + (uq0 + q) * D;
    if (MODE == 0) {
        const float il = 1.f / l[0];
#pragma unroll
        for (int d = 0; d < 16; ++d) mix[512 + h * 128 + d * 8 + part] = f2bf(o[0][d] * il);
    } else {
        const float* scal = (const float*)(P.ws + WS_SCAL); const float lam = scal[2], oml = scal[3];
        const float il1 = 1.f / l[0], il2 = lam / l[NSM - 1];
        float v[16]; float ss = 0.f;
#pragma unroll
        for (int d = 0; d < 16; ++d) { v[d] = o[0][d] * il1 - o[NSM - 1][d] * il2; ss += v[d] * v[d]; }
        ss += __shfl_xor(ss, 1); ss += __shfl_xor(ss, 2); ss += __shfl_xor(ss, 4);
        const float r = rsqrtf(ss * (1.f / 128.f) + EPS) * oml; const float* sg = P.in[31];
#pragma unroll
        for (int d = 0; d < 16; ++d) mix[h * 128 + d * 8 + part] = f2bf(v[d] * r * sg[d * 8 + part]);
    }
}

namespace att {
using bf16x8 = __attribute__((ext_vector_type(8))) short;
using s16x4  = __attribute__((ext_vector_type(4))) short;
using f32x16 = __attribute__((ext_vector_type(16))) float;
#define SBAR() __builtin_amdgcn_sched_barrier(0)
__device__ __forceinline__ int crow(int r, int hi) { return (r & 3) + 8 * (r >> 2) + 4 * hi; }
__device__ __forceinline__ unsigned cvtpk(float lo, float hi) { unsigned r; asm volatile("v_cvt_pk_bf16_f32 %0, %1, %2" : "=v"(r) : "v"(lo), "v"(hi)); return r; }
template <int DK> __device__ __forceinline__ int kswz(int row, int chunk) { return row * (DK * 2) + ((chunk ^ ((row >> 1) & 7)) << 4); }
__device__ __forceinline__ int v_st(int k, int c) { const int kk = (k & ~0xC) | ((k & 4) << 1) | ((k & 8) >> 1); return ((kk >> 3) * 4 + (c >> 5)) * 512 + ((kk & 7) * 32 + (c & 31)) * 2; }
__device__ __forceinline__ int v_rd_base(int lane) { return ((lane & 3) << 3) | (((lane >> 2) & 3) << 6) | (((lane >> 4) & 1) << 5) | (((lane >> 5) & 1) << 8); }
constexpr int v_rd_off(int d0, int ks, int half) { return d0 * 512 + ks * 4096 + half * 2048; }
template <int OFF> __device__ __forceinline__ s16x4 tr_read(int vb) { s16x4 r; asm volatile("ds_read_b64_tr_b16 %0, %1 offset:%2" : "=&v"(r) : "v"(vb), "i"(OFF) : "memory"); return r; }
template <int D0> __device__ __forceinline__ void pv_one(f32x16& od, int vb, bf16x8 pa0, bf16x8 pa1, bf16x8 pa2, bf16x8 pa3) {
    const s16x4 l0 = tr_read<v_rd_off(D0, 0, 0)>(vb), h0 = tr_read<v_rd_off(D0, 0, 1)>(vb), l1 = tr_read<v_rd_off(D0, 1, 0)>(vb), h1 = tr_read<v_rd_off(D0, 1, 1)>(vb);
    const s16x4 l2 = tr_read<v_rd_off(D0, 2, 0)>(vb), h2 = tr_read<v_rd_off(D0, 2, 1)>(vb), l3 = tr_read<v_rd_off(D0, 3, 0)>(vb), h3 = tr_read<v_rd_off(D0, 3, 1)>(vb);
    asm volatile("s_waitcnt lgkmcnt(0)" ::: "memory"); SBAR();
#define PK(L, H) (bf16x8){L[0], L[1], L[2], L[3], H[0], H[1], H[2], H[3]}
    od = __builtin_amdgcn_mfma_f32_32x32x16_bf16(pa0, PK(l0, h0), od, 0, 0, 0);
    od = __builtin_amdgcn_mfma_f32_32x32x16_bf16(pa1, PK(l1, h1), od, 0, 0, 0);
    od = __builtin_amdgcn_mfma_f32_32x32x16_bf16(pa2, PK(l2, h2), od, 0, 0, 0);
    od = __builtin_amdgcn_mfma_f32_32x32x16_bf16(pa3, PK(l3, h3), od, 0, 0, 0);
#undef PK
}
constexpr int SHM_V = 64 * 128 * 2;
template <int DK>
__device__ __forceinline__ void attn_loop(const bf16* __restrict__ Qrow  , const bf16* __restrict__ Kh, int ldk, const bf16* __restrict__ Vh, int ldv,
                                          int nkeys, float negM, f32x16 (&o)[4], float& l_reg, char* lds_kv) {
    constexpr int NQ = DK / 16, CH = DK / 8, KP = (64 * CH) / NT, SHM_K = 64 * DK * 2;
    const int tid = threadIdx.x, lane = tid & 63, r32 = lane & 31, hi = lane >> 5;
    char* V_lds = lds_kv; char* K_lds = lds_kv + 2 * SHM_V;
    bf16x8 qr[NQ];
#pragma unroll
    for (int d0 = 0; d0 < NQ; ++d0) qr[d0] = *reinterpret_cast<const bf16x8*>(Qrow + d0 * 16);
    const __amdgpu_buffer_rsrc_t krs = __builtin_amdgcn_make_buffer_rsrc((void*)Kh, 0, nkeys * ldk * 2, 0x00020000);
    const __amdgpu_buffer_rsrc_t vrs = __builtin_amdgcn_make_buffer_rsrc((void*)Vh, 0, nkeys * ldv * 2, 0x00020000);
    unsigned kgo[KP]; int kst[KP];
#pragma unroll
    for (int i = 0; i < KP; ++i) { const int p = tid + i * NT, row = p / CH, ch = p % CH; kgo[i] = (unsigned)(row * ldk + ch * 8) * 2u; kst[i] = kswz<DK>(row, ch); }
    const int vrow0 = tid >> 4, vc = (tid & 15) * 8;
    const unsigned vgo = (unsigned)(vrow0 * ldv + vc) * 2u, vstep = (unsigned)(32 * ldv) * 2u;
    const int vst0 = v_st(vrow0, vc), vst1 = v_st(32 + vrow0, vc);
    const int vb0 = (int)(uintptr_t)V_lds + v_rd_base(lane);
    int kra[4];
#pragma unroll
    for (int q = 0; q < 4; ++q) kra[q] = r32 * (DK * 2) + (((2 * q + hi) ^ ((r32 >> 1) & 7)) << 4);
    u32x4 ks[KP], vs0, vs1;
#define SLOAD(k0) do { const unsigned so_k = (unsigned)((k0) * ldk) * 2u, so_v = (unsigned)((k0) * ldv) * 2u; \
        _Pragma("unroll") for (int i = 0; i < KP; ++i) ks[i] = __builtin_amdgcn_raw_buffer_load_b128(krs, kgo[i], so_k, 0); \
        vs0 = __builtin_amdgcn_raw_buffer_load_b128(vrs, vgo, so_v, 0); vs1 = __builtin_amdgcn_raw_buffer_load_b128(vrs, vgo + vstep, so_v, 0); } while (0)
#define SWRITE(b) do { _Pragma("unroll") for (int i = 0; i < KP; ++i) *reinterpret_cast<u32x4*>(K_lds + (b) * SHM_K + kst[i]) = ks[i]; \
        *reinterpret_cast<u32x4*>(V_lds + (b) * SHM_V + vst0) = vs0; *reinterpret_cast<u32x4*>(V_lds + (b) * SHM_V + vst1) = vs1; } while (0)
    const int ntile = nkeys / 64;
    SLOAD(0); SWRITE(0); __syncthreads();
    for (int j = 0; j < ntile; ++j) {
        const int cur = j & 1;
        f32x16 p0, p1;
#pragma unroll
        for (int r = 0; r < 16; ++r) { p0[r] = negM; p1[r] = negM; }
        const char* Kb = K_lds + cur * SHM_K;
#pragma unroll
        for (int d0 = 0; d0 < NQ; ++d0) {
            const bf16x8 b0 = *reinterpret_cast<const bf16x8*>(Kb + kra[d0 & 3] + (d0 >> 2) * 128);
            const bf16x8 b1 = *reinterpret_cast<const bf16x8*>(Kb + kra[d0 & 3] + (d0 >> 2) * 128 + 32 * DK * 2);
            p0 = __builtin_amdgcn_mfma_f32_32x32x16_bf16(b0, qr[d0], p0, 0, 0, 0);
            p1 = __builtin_amdgcn_mfma_f32_32x32x16_bf16(b1, qr[d0], p1, 0, 0, 0);
            if ((d0 & 3) == 3) SBAR();
        }
        if (j + 1 < ntile) SLOAD((j + 1) * 64);
        float ps = 0.f;
#pragma unroll
        for (int r = 0; r < 16; ++r) { p0[r] = __builtin_amdgcn_exp2f(p0[r]); p1[r] = __builtin_amdgcn_exp2f(p1[r]); ps += p0[r] + p1[r]; }
        l_reg += ps;
        bf16x8 pa0, pa1, pa2, pa3;
#define PK4(P, BASE, OUT) do { unsigned a0 = cvtpk(P[BASE + 0], P[BASE + 1]), a1 = cvtpk(P[BASE + 2], P[BASE + 3]);   \
        unsigned b0_ = cvtpk(P[BASE + 4], P[BASE + 5]), b1_ = cvtpk(P[BASE + 6], P[BASE + 7]);                              \
        auto r0 = __builtin_amdgcn_permlane32_swap(a0, b0_, false, false); auto r1 = __builtin_amdgcn_permlane32_swap(a1, b1_, false, false); \
        u32x4 w = {r0[0], r1[0], r0[1], r1[1]}; OUT = *reinterpret_cast<bf16x8*>(&w); } while (0)
        PK4(p0, 0, pa0); PK4(p0, 8, pa1); PK4(p1, 0, pa2); PK4(p1, 8, pa3);
#undef PK4
        const int vb = vb0 + cur * SHM_V;
        pv_one<0>(o[0], vb, pa0, pa1, pa2, pa3); pv_one<1>(o[1], vb, pa0, pa1, pa2, pa3); pv_one<2>(o[2], vb, pa0, pa1, pa2, pa3); pv_one<3>(o[3], vb, pa0, pa1, pa2, pa3);
        if (j + 1 < ntile) SWRITE(cur ^ 1);
        __syncthreads();
    }
#undef SLOAD
#undef SWRITE
}
__device__ __forceinline__ void row_recip(float l_reg, float* li_l  , int r32, int hi, float (&rli)[16]) {
    { auto rr = __builtin_amdgcn_permlane32_swap(__float_as_uint(l_reg), __float_as_uint(l_reg), false, false); l_reg = __uint_as_float(rr[0]) + __uint_as_float(rr[1]); }
    if (hi == 0) li_l[r32] = l_reg;
    asm volatile("s_waitcnt lgkmcnt(0)" ::: "memory");
#pragma unroll
    for (int r = 0; r < 16; ++r) rli[r] = __builtin_amdgcn_rcpf(li_l[crow(r, hi)]);
}
#undef SBAR
}

constexpr int ATT_SCR_OFF = RING_BYTES - 2048;
__device__ __forceinline__ void mla_attn_unit(const Ptrs& P, unsigned char* lds, int b, int h, int qb, int ctxq) {
    using namespace att;
    const int tid = threadIdx.x, wid = tid >> 6, lane = tid & 63, r32 = lane & 31, hi = lane >> 5;
    const bf16* Qm = (const bf16*)(P.ws + WS_QM); const bf16* Km = (const bf16*)(P.ws + WS_KM); const bf16* Vm = (const bf16*)(P.ws + WS_VM);
    const size_t u0 = (size_t)b * SU + (ctxq ? 0 : CTX) + qb * 256 + wid * 32;
    f32x16 o[4] = {}; float l_reg = 0.f;
    const float negM = -((const float*)(P.ws + WS_SCAL))[0];
    attn_loop<192>(Qm + (u0 + r32) * 768 + h * 192 + hi * 8, Km + (size_t)b * SU * 768 + h * 192, 768, Vm + (size_t)b * SU * 512 + h * 128, 512, ctxq ? CTX : SU, negM, o, l_reg, (char*)lds);
    float rli[16]; row_recip(l_reg, (float*)(lds + ATT_SCR_OFF) + wid * 64, r32, hi, rli);
    bf16* stg = (bf16*)lds + wid * 4096;
#pragma unroll
    for (int r = 0; r < 16; ++r) { const int orow = crow(r, hi);
#pragma unroll
        for (int d0 = 0; d0 < 4; ++d0) stg[orow * 128 + d0 * 32 + r32] = f2bf(o[d0][r] * rli[r]); }
    asm volatile("s_waitcnt lgkmcnt(0)" ::: "memory");
    bf16* mix = (bf16*)(P.ws + WS_MIX) + u0 * D + 512 + h * 128;
#pragma unroll
    for (int i = 0; i < 8; ++i) { const int row = i * 4 + (lane >> 4), ch = lane & 15; const u32x4 v = *(const u32x4*)(stg + row * 128 + ch * 8); *(u32x4*)(mix + (size_t)row * D + ch * 8) = v; }
    asm volatile("s_waitcnt lgkmcnt(0)" ::: "memory");
    __syncthreads();
}
__device__ __forceinline__ void diff_attn_unit(const Ptrs& P, unsigned char* lds, int b, int h, int qb) {
    using namespace att;
    const int tid = threadIdx.x, wid = tid >> 6, lane = tid & 63, r32 = lane & 31, hi = lane >> 5;
    const bf16* Z = (const bf16*)(P.ws + WS_Z);
    const size_t u0 = (size_t)b * SU + CTX + qb * 256 + wid * 32;
    const float* scal = (const float*)(P.ws + WS_SCAL); const float negM = -scal[1], lam = scal[2], oml = scal[3];
    bf16* stg = (bf16*)lds + wid * 4096;
    float* li_l = (float*)(lds + ATT_SCR_OFF) + wid * 64;
    for (int part = 0; part < 2; ++part) {
        f32x16 o[4] = {}; float l_reg = 0.f;
        attn_loop<64>(Z + (u0 + r32) * ODD_IN + h * 128 + part * 64 + hi * 8, Z + 1024 + (size_t)b * SU * ODD_IN + h * 128 + part * 64, ODD_IN, Z + 2048 + (size_t)b * SU * ODD_IN + h * 128, ODD_IN, SU, negM, o, l_reg, (char*)lds + 65536);
        float rli[16]; row_recip(l_reg, li_l, r32, hi, rli);
#pragma unroll
        for (int r = 0; r < 16; ++r) { const int orow = crow(r, hi);
#pragma unroll
            for (int d0 = 0; d0 < 4; ++d0) { bf16* s = stg + orow * 128 + d0 * 32 + r32; const float on = o[d0][r] * rli[r];
                if (part == 0) *s = f2bf(on); else *s = f2bf(bf2f(*s) - lam * on); } }
        asm volatile("s_waitcnt lgkmcnt(0)" ::: "memory");
    }
    const float* sg = P.in[31];
    bf16* mix = (bf16*)(P.ws + WS_MIX) + u0 * D + h * 128;
#pragma unroll
    for (int i = 0; i < 8; ++i) { const int row = i * 4 + (lane >> 4), ch = lane & 15; const u32x4 v = *(const u32x4*)(stg + row * 128 + ch * 8);
        float f[8]; float ss = 0.f;
#pragma unroll
        for (int e = 0; e < 4; ++e) { f[2 * e] = __uint_as_float(v[e] << 16); f[2 * e + 1] = __uint_as_float(v[e] & 0xffff0000u); ss += f[2 * e] * f[2 * e] + f[2 * e + 1] * f[2 * e + 1]; }
        ss += __shfl_xor(ss, 1); ss += __shfl_xor(ss, 2); ss += __shfl_xor(ss, 4); ss += __shfl_xor(ss, 8);
        const float rs = rsqrtf(ss * (1.f / 128.f) + EPS) * oml;
        const f32x4 g0 = *(const f32x4*)(sg + ch * 8), g1 = *(const f32x4*)(sg + ch * 8 + 4);
        u32x4 w; w.x = att::cvtpk(f[0] * rs * g0[0], f[1] * rs * g0[1]); w.y = att::cvtpk(f[2] * rs * g0[2], f[3] * rs * g0[3]); w.z = att::cvtpk(f[4] * rs * g1[0], f[5] * rs * g1[1]); w.w = att::cvtpk(f[6] * rs * g1[2], f[7] * rs * g1[3]);
        *(u32x4*)(mix + (size_t)row * D + ch * 8) = w; }
    asm volatile("s_waitcnt lgkmcnt(0)" ::: "memory");
    __syncthreads();
}

struct Args { Ptrs P; int ph_lo, ph_hi; };
constexpr int N_PHASES = 19;
__global__ void __launch_bounds__(NT, 2) mega(Args args) {
    extern __shared__ __attribute__((aligned(16))) unsigned char lds[];
    const Ptrs& P = args.P;
    unsigned char* ws = P.ws;
    const int tid = threadIdx.x, G = gridDim.x;
    const int vcu = (G % 8 == 0) ? ((int)blockIdx.x % 8) * (G / 8) + (int)blockIdx.x / 8 : (int)blockIdx.x;
    LAS unsigned char* LDSP = (LAS unsigned char*)lds;
    volatile LAS unsigned* MISC = (volatile LAS unsigned*)((LAS unsigned char*)lds + MISC_OFF);
    for (int u = tid; u < (LDS_BYTES - LDSCTL_OFF) / 4; u += NT) ((LAS unsigned*)((LAS unsigned char*)lds + LDSCTL_OFF))[u] = 0u;
    __syncthreads();
    XcdBarrier bar = xcd_barrier_post((unsigned*)(ws + WS_CTL) + CW_BAR, MISC + 8);
    const int lo = args.ph_lo, hi = args.ph_hi;
#define IN(k) (lo <= (k) && (k) < hi)
#define SEAM(k) do { if (IN(k) && IN((k) + 1)) xcd_barrier(bar); } while (0)
    const bf16* H = (const bf16*)(ws + WS_H); bf16* Z = (bf16*)(ws + WS_Z); const bf16* MIX = (const bf16*)(ws + WS_MIX);
    const bf16* Qm = (const bf16*)(ws + WS_QM); const bf16* Km = (const bf16*)(ws + WS_KM); const bf16* Vm = (const bf16*)(ws + WS_VM);

    if (IN(0)) { ph_prologue(P, lds); } SEAM(0);
    if (IN(1)) { ph_rows(P, 0, 0, 0, 0); } SEAM(1);
    if (IN(2)) { g8::DenseOrder S; S.init(H, D, (const bf16*)(ws + WS_WEVIN), D, R, EVEN_IN_P, G, (int)blockIdx.x, 0); g8::EpiStoreBf16 E{Z, EVEN_IN_P};
        g8::gemm_phase<g8::EpiStoreBf16, g8::DenseOrder, false, true>(LDSP, D, D, S, E); } SEAM(2);
    if (IN(3)) {
        { g8::DenseOrder S; S.init(Z + 1024, EVEN_IN_P, (const bf16*)(ws + WS_WUQ), 384, R, 768, G, (int)blockIdx.x, 0); g8::EpiStoreBf16 E{(bf16*)(ws + WS_QP), 768};
          g8::gemm_phase<g8::EpiStoreBf16, g8::DenseOrder, false, true>(LDSP, EVEN_IN_P, 384, S, E); }
        { g8::DenseOrder S; S.init(Z + 1408, EVEN_IN_P, (const bf16*)(ws + WS_WUKV), 256, R, 1024, G, (int)blockIdx.x, 0); g8::EpiStoreBf16 E{(bf16*)(ws + WS_KVP), 1024};
          g8::gemm_phase<g8::EpiStoreBf16, g8::DenseOrder, false, true>(LDSP, EVEN_IN_P, 256, S, E); }
        ph_lru(P, lds, 0, 0);
    } SEAM(3);
    if (IN(4)) { ph_mla_prep(P); } SEAM(4);
    if (IN(5)) {
        ph_lru(P, lds, 1, 0);
        for (int it = vcu; it < 256 + 16; it += G) {
            if (it < 256) mla_attn_unit(P, lds, it / 64, (it / 16) % 4, it % 16, 0);
            else { const int i2 = it - 256; mla_attn_unit(P, lds, i2 / 4, i2 % 4, 0, 1); }
        }
    } SEAM(5);
    if (IN(6)) { g8::DenseOrder S; S.init(MIX, D, (const bf16*)(ws + WS_WEVOUT), D, R, D, G, (int)blockIdx.x, 0); g8::EpiOut E{P, 0};
        g8::gemm_phase<g8::EpiOut, g8::DenseOrder, false, true>(LDSP, D, D, S, E); } SEAM(6);
    if (IN(7)) { ph_rows(P, 0, 1, 0, 0); } SEAM(7);
    if (IN(8)) { g8::MoeOrder S{(const unsigned*)(ws + WS_CTL) + CW_CNT + 0 * 64, (const char*)H, (const char*)(ws + WS_WGU) + (size_t)0 * NE * 2048 * 1024 * 2, (const int*)(ws + WS_TOKOF), (size_t)2048 * 1024 * 2, 8, D, G, vcu, 1};
        g8::EpiMoe1 E{P, 0}; g8::gemm_phase<g8::EpiMoe1, g8::MoeOrder, true, true>(LDSP, D, D, S, E); } SEAM(8);
    if (IN(9)) { g8::MoeOrder S{(const unsigned*)(ws + WS_CTL) + CW_CNT + 0 * 64, (const char*)(ws + WS_ACT), (const char*)(ws + WS_WDN) + (size_t)0 * NE * 1024 * 1024 * 2, nullptr, (size_t)1024 * 1024 * 2, 4, D, G, vcu, 0};
        g8::EpiMoe2 E{P, 0}; g8::gemm_phase<g8::EpiMoe2, g8::MoeOrder, false, true>(LDSP, D, D, S, E); } SEAM(9);
    if (IN(10)) { ph_rows(P, 0, 2, 0, 1); } SEAM(10);
    if (IN(11)) { g8::DenseOrder S; S.init(H, D, (const bf16*)(ws + WS_WODIN), D, R, ODD_IN, G, (int)blockIdx.x, 0); g8::EpiStoreBf16 E{Z, ODD_IN};
        g8::gemm_phase<g8::EpiStoreBf16, g8::DenseOrder, false, true>(LDSP, D, D, S, E); } SEAM(11);
    if (IN(12)) { ph_diff_prep(P); } SEAM(12);
    if (IN(13)) {
        for (int it = vcu; it < 512; it += G) diff_attn_unit(P, lds, it / 128, (it / 16) % 8, it % 16);
    } SEAM(13);
    if (IN(14)) { g8::DenseOrder S; S.init(MIX, D, (const bf16*)(ws + WS_WODOUT), D, R, D, G, (int)blockIdx.x, 1); g8::EpiOut E{P, 1};
        g8::gemm_phase<g8::EpiOut, g8::DenseOrder, false, true>(LDSP, D, D, S, E); } SEAM(14);
    if (IN(15)) { ph_rows(P, 1, 1, 1, 0); } SEAM(15);
    if (IN(16)) { g8::MoeOrder S{(const unsigned*)(ws + WS_CTL) + CW_CNT + 1 * 64, (const char*)H, (const char*)(ws + WS_WGU) + (size_t)1 * NE * 2048 * 1024 * 2, (const int*)(ws + WS_TOKOF), (size_t)2048 * 1024 * 2, 8, D, G, vcu, 1};
        g8::EpiMoe1 E{P, 1}; g8::gemm_phase<g8::EpiMoe1, g8::MoeOrder, true, true>(LDSP, D, D, S, E); } SEAM(16);
    if (IN(17)) { g8::MoeOrder S{(const unsigned*)(ws + WS_CTL) + CW_CNT + 1 * 64, (const char*)(ws + WS_ACT), (const char*)(ws + WS_WDN) + (size_t)1 * NE * 1024 * 1024 * 2, nullptr, (size_t)1024 * 1024 * 2, 4, D, G, vcu, 0};
        g8::EpiMoe2 E{P, 1}; g8::gemm_phase<g8::EpiMoe2, g8::MoeOrder, false, true>(LDSP, D, D, S, E); } SEAM(17);
    if (IN(18)) { ph_rows(P, 1, 2, 1, 0); }
#undef IN
#undef SEAM
}

#ifndef MK_PER_PHASE
#define MK_PER_PHASE 0
#endif
extern "C" void kernel_launch(void* const* d_in, const int* in_sizes, int n_in, void* d_out, int out_size, void* d_ws, size_t ws_size, hipStream_t stream) {
    static int grid = 0;
    if (grid == 0) {
        if (n_in != 38 || ws_size < WS_END) { fprintf(stderr, "kernel_launch: bad args n_in=%d ws=%zu need %zu\n", n_in, ws_size, (size_t)WS_END); grid = -1; return; }
        int dev = 0, cus = 0, per_cu = 0;
        if (hipGetDevice(&dev) != hipSuccess || hipDeviceGetAttribute(&cus, hipDeviceAttributeMultiprocessorCount, dev) != hipSuccess) { grid = -1; return; }
        if (hipFuncSetAttribute((const void*)mega, hipFuncAttributeMaxDynamicSharedMemorySize, LDS_BYTES) != hipSuccess) { fprintf(stderr, "kernel_launch: hipFuncSetAttribute failed\n"); grid = -1; return; }
        if (hipOccupancyMaxActiveBlocksPerMultiprocessor(&per_cu, (const void*)mega, NT, LDS_BYTES) != hipSuccess || per_cu < 1) { fprintf(stderr, "kernel_launch: occupancy query says %d blocks/CU\n", per_cu); grid = -1; return; }
        (void)hipGetLastError();
        grid = cus;
    }
    if (grid < 0) return;
    if (hipMemsetAsync((char*)d_ws + WS_CTL, 0, 1u << 20, stream) != hipSuccess) return;
    Args a; memset((void*)&a, 0, sizeof(a));
    for (int i = 0; i < 38; ++i) a.P.in[i] = (const float*)d_in[i];
    a.P.out = (float*)d_out; a.P.ws = (unsigned char*)d_ws;
#if MK_PER_PHASE
    for (int p = 0; p < N_PHASES; ++p) { a.ph_lo = p; a.ph_hi = p + 1; hipLaunchKernelGGL(mega, dim3(grid), dim3(NT), LDS_BYTES, stream, a); }
#else
    a.ph_lo = 0; a.ph_hi = N_PHASES;
    hipLaunchKernelGGL(mega, dim3(grid), dim3(NT), LDS_BYTES, stream, a);
#endif
    const hipError_t le = hipPeekAtLastError();
    if (le != hipSuccess) fprintf(stderr, "kernel_launch: launch failed: %s\n", hipGetErrorName(le));
}
```

```cpp
#include <hip/hip_runtime.h>
#include <cstdio>
#include <cstdint>
#include <cstring>

typedef unsigned short bf16;
typedef unsigned u32x4 __attribute__((ext_vector_type(4)));
typedef float f32x4 __attribute__((ext_vector_type(4)));

constexpr int D = 1024, NB = 4, SEQ = 4096, CTX = 256, SU = SEQ + CTX, R = NB * SU;
constexpr int GRID_W = 64;
constexpr int LRU_W = 512, LRU_NB = 8, LRU_BW = 64;
constexpr int MLA_H = 4, MLA_QR = 384, MLA_KVR = 256, MLA_NOPE = 128, MLA_ROPE = 64, MLA_V = 128, MLA_QK = 192;
constexpr int EVEN_IN = 1728, EVEN_IN_P = 1792;
constexpr int DIFF_H = 8, ODD_IN = 3072;
constexpr int NE = 32, TOPK = 4, DFF = 1024;
constexpr float EPS = 1e-6f;
constexpr int CHUNK = 128, NCH = SU / CHUNK;

constexpr size_t al256(size_t x) { return (x + 255) / 256 * 256; }
constexpr size_t WS_CTL = 0;
constexpr size_t WS_MOD = 1u << 20;
constexpr size_t WS_SCAL = WS_MOD + al256(2 * 5 * 6144 * 4);
constexpr size_t WS_WEVIN = WS_SCAL + 8192;
constexpr size_t WS_WEVOUT = WS_WEVIN + (size_t)EVEN_IN_P * D * 2;
constexpr size_t WS_WUQ = WS_WEVOUT + (size_t)D * D * 2;
constexpr size_t WS_WUKV = WS_WUQ + (size_t)768 * 384 * 2;
constexpr size_t WS_WLRU = WS_WUKV + (size_t)1024 * 384 * 2;
constexpr size_t WS_WODIN = WS_WLRU + (size_t)32 * 4096 * 2;
constexpr size_t WS_WODOUT = WS_WODIN + (size_t)ODD_IN * D * 2;
constexpr size_t WS_WGU = WS_WODOUT + (size_t)D * D * 2;
constexpr size_t WS_WDN = WS_WGU + (size_t)2 * NE * 2048 * 1024 * 2;
constexpr size_t WS_XC = WS_WDN + (size_t)2 * NE * 1024 * 1024 * 2;
constexpr size_t WS_H = WS_XC + (size_t)NB * CTX * D * 4;
constexpr size_t WS_Z = WS_H + (size_t)R * D * 2;
constexpr size_t WS_QP = WS_Z + (size_t)R * ODD_IN * 2;
constexpr size_t WS_KVP = WS_QP + (size_t)R * 768 * 2;
constexpr size_t WS_QM = WS_KVP + (size_t)R * 1024 * 2;
constexpr size_t WS_KM = WS_QM + (size_t)R * 768 * 2;
constexpr size_t WS_VM = WS_KM + (size_t)R * 768 * 2;
constexpr size_t WS_AGG = WS_VM + (size_t)R * 512 * 2;
constexpr size_t WS_MIX = WS_AGG + al256((size_t)NB * NCH * 2 * 512 * 2 * 4);
constexpr size_t WS_TOKOF = WS_MIX + (size_t)R * D * 2;
constexpr size_t WS_PAIROF = WS_TOKOF + (size_t)NE * R * 4;
constexpr size_t WS_GATEOF = WS_PAIROF + (size_t)NE * R * 4;
constexpr size_t ACT_ROWS = (size_t)R * TOPK + NE * 256;
constexpr size_t WS_ACT = WS_GATEOF + (size_t)NE * R * 4;
constexpr size_t WS_Y = WS_ACT + ACT_ROWS * 1024 * 2;
constexpr size_t WS_XB = WS_Y + (size_t)R * TOPK * 1024 * 2;
constexpr size_t WS_ROPE = WS_XB + (size_t)R * D * 2;
constexpr size_t WS_END = WS_ROPE + (size_t)2 * SEQ * 64 * 4;

constexpr int CW_CNT = 64;

__device__ __forceinline__ float bf2f(bf16 v) { return __uint_as_float((unsigned)v << 16); }
__device__ __forceinline__ bf16 f2bf(float f) { unsigned u = __float_as_uint(f); return (bf16)((u + 0x7fffu + ((u >> 16) & 1u)) >> 16); }
__device__ __forceinline__ float wave_sum(float v) {
#pragma unroll
    for (int o = 1; o < 64; o <<= 1) v += __shfl_xor(v, o);
    return v;
}
__device__ __forceinline__ unsigned g8_cvt_pk(float lo, float hi) { unsigned r; asm volatile("v_cvt_pk_bf16_f32 %0, %1, %2" : "=v"(r) : "v"(lo), "v"(hi)); return r; }
__device__ __forceinline__ float sigmoidf_(float x) { return 1.f / (1.f + __expf(-x)); }
__device__ __forceinline__ float gelu_tanh(float x) { const float t = tanhf(0.7978845608028654f * (x + 0.044715f * x * x * x)); return 0.5f * x * (1.f + t); }

struct Ptrs {
    const float* in[38];
    float* out;
    unsigned char* ws;
};

__device__ __forceinline__ const float* res_in_row(const Ptrs& P, int layer, int u) {
    const int b = u / SU, j = u % SU;
    if (layer == 0) return j < CTX ? P.in[2] + (size_t)(b * CTX + j) * D : P.in[0] + (size_t)(b * SEQ + j - CTX) * D;
    return j < CTX ? (const float*)(P.ws + WS_XC) + (size_t)(b * CTX + j) * D : P.out + (size_t)(b * SEQ + j - CTX) * D;
}
__device__ __forceinline__ float* res_out_row(const Ptrs& P, int u) {
    const int b = u / SU, j = u % SU;
    return j < CTX ? (float*)(P.ws + WS_XC) + (size_t)(b * CTX + j) * D : P.out + (size_t)(b * SEQ + j - CTX) * D;
}
__device__ __forceinline__ const float* mod_row(const Ptrs& P, int layer, int u) {
    const int b = u / SU, j = u % SU;
    return (const float*)(P.ws + WS_MOD) + (size_t)(layer * 5 + (j < CTX ? 4 : b)) * 6144;
}

constexpr float LOG2E = 1.4426950408889634f;
#define GAS __attribute__((address_space(1)))
#define LAS __attribute__((address_space(3)))
constexpr int NT = 512;
constexpr int LDS_BYTES = 147456;
constexpr int RING_BYTES = 131072, LDSCTL_OFF = RING_BYTES, MISC_OFF = LDSCTL_OFF + 320;
constexpr int CW_BAR = 4096;
constexpr int CW_TMO = 0;

#define XB_TMO      128
#define XB_XCNT(j)  (256  + 64 * (j))
#define XB_XSUB(j)  (1280 + 64 * (j))
#define XB_XGEN(j)  (2304 + 64 * (j))
#define XB_TOP      3328
#define XB_TOPGEN   3392
#define XCD_BAR_WORDS 3456
#define XB_SPIN_CAP (1u << 22)
__device__ __forceinline__ unsigned xb_ld(unsigned* p)              { return __hip_atomic_load(p, __ATOMIC_RELAXED, __HIP_MEMORY_SCOPE_AGENT); }
__device__ __forceinline__ unsigned xb_add(unsigned* p, unsigned v) { return __hip_atomic_fetch_add(p, v, __ATOMIC_RELAXED, __HIP_MEMORY_SCOPE_AGENT); }
__device__ __forceinline__ unsigned xb_xcc_id() { return (unsigned)__builtin_amdgcn_s_getreg((3 << 11) | 20) & 0xFu; }
#define XB_SPIN(cond, bar) do { unsigned _sp = 0; while (cond) { __builtin_amdgcn_s_sleep(1); \
    if ((++_sp & 255u) == 0u) { if (xb_ld(&(bar)[XB_TMO])) break; if (_sp > XB_SPIN_CAP) { atomicAdd(&(bar)[XB_TMO], 1u); break; } } } } while (0)
struct XcdBarrier { unsigned* bar; unsigned x; volatile LAS unsigned* st; };
__device__ __forceinline__ XcdBarrier xcd_barrier_post(unsigned* bar, volatile LAS unsigned* st) {
    XcdBarrier b; b.bar = bar; b.x = xb_xcc_id(); b.st = st;
    if (threadIdx.x == 0) (void)xb_add(&bar[XB_XCNT(b.x)], 1u);
    return b;
}
__device__ __forceinline__ void xcd_barrier_complete(unsigned* bar, unsigned x, unsigned& nloc, unsigned& nx) {
    const unsigned G = gridDim.x * gridDim.y * gridDim.z;
    unsigned sum, cnt, mine, sp = 0u;
    for (;;) {
        sum = 0u; cnt = 0u; mine = 0u;
#pragma unroll
        for (unsigned j = 0; j < 16; ++j) { const unsigned c = xb_ld(&bar[XB_XCNT(j)]); sum += c; cnt += (c > 0u) ? 1u : 0u; mine = (j == x) ? c : mine; }
        if (sum == G) break;
        __builtin_amdgcn_s_sleep(1);
        if ((++sp & 255u) == 0u) { if (xb_ld(&bar[XB_TMO])) break; if (sp > XB_SPIN_CAP) { atomicAdd(&bar[XB_TMO], 1u); break; } }
    }
    nloc = mine > 0u ? mine : 1u; nx = cnt > 0u ? cnt : 1u;
}
__device__ __forceinline__ void xcd_barrier(const XcdBarrier& b) {
    asm volatile("s_waitcnt vmcnt(0)" ::: "memory");
    __syncthreads();
    if (threadIdx.x == 0) {
        unsigned* bar = b.bar;
        __builtin_amdgcn_s_waitcnt(0);
        unsigned nloc = b.st[0], nx = b.st[1];
        if (nloc == 0u) { xcd_barrier_complete(bar, b.x, nloc, nx); b.st[0] = nloc; b.st[1] = nx; }
        const unsigned old = xb_add(&bar[XB_XSUB(b.x)], 1u);
        const unsigned gen = old / nloc;
        if (old + 1u == (gen + 1u) * nloc) {
            __builtin_amdgcn_fence(__ATOMIC_RELEASE, "agent");
            asm volatile("s_waitcnt vmcnt(0)" ::: "memory");
            const unsigned og = xb_add(&bar[XB_TOP], 1u);
            const unsigned tg = og / nx;
            if (og + 1u == (tg + 1u) * nx) xb_add(&bar[XB_TOPGEN], 1u);
            else XB_SPIN(xb_ld(&bar[XB_TOPGEN]) == tg, bar);
            __builtin_amdgcn_fence(__ATOMIC_ACQUIRE, "agent");
            xb_add(&bar[XB_XGEN(b.x)], 1u);
            asm volatile("s_waitcnt vmcnt(0)" ::: "memory");
        } else {
            XB_SPIN(xb_ld(&bar[XB_XGEN(b.x)]) == gen, bar);
            __builtin_amdgcn_fence(__ATOMIC_ACQUIRE, "agent");
            asm volatile("s_waitcnt vmcnt(0)" ::: "memory");
        }
    }
    __syncthreads();
}

struct TJob { const float* src; bf16* dst; const float* rs; int K, N, Npad, perm, batch; size_t sstr, dstr; int Ksrc; };
__device__ __forceinline__ void tt_load(const TJob& j, int it, int lane, f32x4 (&v)[16]) {
    const int tn = j.Npad / 64, per = tn * (j.K / 64), z = it / per, r = it % per, n0 = (r % tn) * 64, k0 = (r / tn) * 64;
    const float* src = j.src + z * j.sstr;
    const int n4 = (lane & 15) * 4, np = n0 + n4;
    int sc = np; if (j.perm == 1) sc = (np / 256) * 128 + (np % 128) + ((np % 256) / 128) * 1024;
#pragma unroll
    for (int i = 0; i < 16; ++i) { const int k = k0 + i * 4 + (lane >> 4); f32x4 t = {0.f, 0.f, 0.f, 0.f}; if (sc < j.N && k < j.Ksrc) { t = *(const f32x4*)(src + (size_t)k * j.N + sc); if (j.rs) t = t * j.rs[k]; } v[i] = t; }
}
__device__ __forceinline__ void tt_store(const TJob& j, int it, int lane, const f32x4 (&v)[16], float* wt) {
    const int tn = j.Npad / 64, per = tn * (j.K / 64), z = it / per, r = it % per, n0 = (r % tn) * 64, k0 = (r / tn) * 64;
    bf16* dst = j.dst + z * j.dstr + ((((size_t)(n0 >> 8) * (j.K >> 6) + (k0 >> 6)) << 14) + (((n0 & 255) + lane) << 6));
    const int n4 = (lane & 15) * 4;
#pragma unroll
    for (int half = 0; half < 2; ++half) {
#pragma unroll
        for (int i = 0; i < 8; ++i) *(f32x4*)(wt + (i * 4 + (lane >> 4)) * 68 + n4) = v[half * 8 + i];
        asm volatile("s_waitcnt lgkmcnt(0)" ::: "memory");
#pragma unroll
        for (int kc = 0; kc < 4; ++kc) { float f[8];
#pragma unroll
            for (int q = 0; q < 8; ++q) f[q] = wt[(kc * 8 + q) * 68 + lane];
            u32x4 w; w.x = f2bf(f[0]) | ((unsigned)f2bf(f[1]) << 16); w.y = f2bf(f[2]) | ((unsigned)f2bf(f[3]) << 16); w.z = f2bf(f[4]) | ((unsigned)f2bf(f[5]) << 16); w.w = f2bf(f[6]) | ((unsigned)f2bf(f[7]) << 16);
            *(u32x4*)(dst + half * 32 + kc * 8) = w; }
        asm volatile("s_waitcnt lgkmcnt(0)" ::: "memory");
    }
}
__device__ __forceinline__ void run_tjob(const TJob& j, float* wt, int& base, int NW, int gw, int lane) {
    const int total = (j.Npad / 64) * (j.K / 64) * j.batch;
    int it = (gw - base % NW + NW) % NW;
    if (it < total) {
        f32x4 cur[16], nxt[16];
        tt_load(j, it, lane, cur);
        for (; it < total; it += NW) {
            const bool more = it + NW < total;
            if (more) tt_load(j, it + NW, lane, nxt);
            tt_store(j, it, lane, cur, wt);
            if (more) {
#pragma unroll
                for (int i = 0; i < 16; ++i) cur[i] = nxt[i]; }
        }
    }
    base += total;
}
__device__ __forceinline__ void bt_load(const float* __restrict__ src, int N, int perm, int it, int ntn, f32x4 (&v)[8]) {
    const int wid = threadIdx.x >> 6, lane = threadIdx.x & 63;
    const int per = 16 * ntn, z = it / per, r = it % per, kt = r / ntn, nt = r % ntn;
    const int np = nt * 256 + lane * 4;
    const int sc = perm ? (nt * 128 + (lane & 31) * 4 + (lane >> 5) * 1024) : np;
    const float* p = src + (size_t)z * 1024 * N + (size_t)(kt * 64 + wid * 8) * N + sc;
#pragma unroll
    for (int i = 0; i < 8; ++i) v[i] = *(const f32x4*)(p + (size_t)i * N);
}
__device__ __forceinline__ void ph_big_transpose(const float* __restrict__ src, int N, int perm, int batch, bf16* __restrict__ dst, float* tile  , int G) {
    const int tid = threadIdx.x, wid = tid >> 6, lane = tid & 63, ntn = N / 256, total = batch * 16 * ntn;
    int it = (int)blockIdx.x;
    if (it >= total) return;
    f32x4 cur[8], nxt[8], nx2[8];
    bt_load(src, N, perm, it, ntn, cur);
    if (it + G < total) bt_load(src, N, perm, it + G, ntn, nxt);
    for (; it < total; it += G) {
        const bool more = it + G < total, more2 = it + 2 * G < total;
        if (more2) bt_load(src, N, perm, it + 2 * G, ntn, nx2);
        __syncthreads();
#pragma unroll
        for (int i = 0; i < 8; ++i) { float* t = tile + (wid * 8 + i) * 257 + lane * 4; t[0] = cur[i][0]; t[1] = cur[i][1]; t[2] = cur[i][2]; t[3] = cur[i][3]; }
        __syncthreads();
        const int per = 16 * ntn, z = it / per, r = it % per, kt = r / ntn, nt = r % ntn;
        bf16* d = dst + (size_t)z * N * 1024 + (((size_t)nt * 16 + kt) << 14);
        const int kc = lane & 7;
#pragma unroll
        for (int pss = 0; pss < 4; ++pss) {
            const int n = wid * 32 + pss * 8 + (lane >> 3); float f[8];
#pragma unroll
            for (int j = 0; j < 8; ++j) f[j] = tile[(kc * 8 + j) * 257 + n];
            u32x4 w; w.x = g8_cvt_pk(f[0], f[1]); w.y = g8_cvt_pk(f[2], f[3]); w.z = g8_cvt_pk(f[4], f[5]); w.w = g8_cvt_pk(f[6], f[7]);
            *(u32x4*)(d + n * 64 + kc * 8) = w;
        }
        if (more) {
#pragma unroll
            for (int i = 0; i < 8; ++i) { cur[i] = nxt[i]; nxt[i] = nx2[i]; } }
    }
    __syncthreads();
}
#ifndef PROBE_SUB
#define PROBE_SUB 0
#define PROBE_SUBDK 0
#endif
#define PSEC(k) do { if (PROBE_SUB == (k)) { const unsigned t_ = (unsigned)__builtin_readcyclecounter(); sacc += t_ - pt0; } if (PROBE_SUB >= 10) pt0 = (unsigned)__builtin_readcyclecounter(); } while (0)
__device__ __forceinline__ void ph_prologue(const Ptrs& P, unsigned char* lds, unsigned& sacc) {
    unsigned char* ws = P.ws; const int G = gridDim.x; int base = 0; unsigned pt0 = 0u; PSEC(-1);
    const int wave = threadIdx.x >> 6, lane = threadIdx.x & 63, NW = G * 8, gw = (int)blockIdx.x + G * wave;
    float* wt = (float*)lds + wave * (32 * 68);
    {
        float* s = (float*)lds + 8 * 32 * 68;
        float* part = s + 5 * 1024;
        for (int it = (int)blockIdx.x; it < 2 * 128; it += G) {
            const int layer = it / 128, cb = (it % 128) * 48;
            __syncthreads();
            for (int i = threadIdx.x; i < 5 * 1024; i += NT) { const int r = i / 1024, k = i % 1024; const float c = r < 4 ? P.in[1][r * 1024 + k] : P.in[3][k]; s[i] = c / (1.f + __expf(-c)); }
            __syncthreads();
            const int kr = lane >> 4, c4 = (lane & 15) < 12 ? (lane & 15) * 4 : 44;
            const float* w = P.in[4] + (size_t)layer * 1024 * 6144 + (size_t)(wave * 128 + kr) * 6144 + cb + c4;
            float a[5][4];
#pragma unroll
            for (int r = 0; r < 5; ++r) { a[r][0] = 0.f; a[r][1] = 0.f; a[r][2] = 0.f; a[r][3] = 0.f; }
#pragma unroll 1
            for (int hh = 0; hh < 2; ++hh) {
                f32x4 wv[16];
#pragma unroll
                for (int i = 0; i < 16; ++i) wv[i] = *(const f32x4*)(w + (size_t)(hh * 64 + i * 4) * 6144);
#pragma unroll
                for (int i = 0; i < 16; ++i) { const int k = wave * 128 + hh * 64 + i * 4 + kr;
#pragma unroll
                    for (int r = 0; r < 5; ++r) { const float sv = s[r * 1024 + k]; a[r][0] += sv * wv[i][0]; a[r][1] += sv * wv[i][1]; a[r][2] += sv * wv[i][2]; a[r][3] += sv * wv[i][3]; } }
            }
#pragma unroll
            for (int r = 0; r < 5; ++r)
#pragma unroll
                for (int e = 0; e < 4; ++e) { float t = a[r][e]; t += __shfl_xor(t, 16); t += __shfl_xor(t, 32); if (lane < 12) part[(wave * 5 + r) * 64 + c4 + e] = t; }
            __syncthreads();
            if (threadIdx.x < 320 && (threadIdx.x & 63) < 48) { const int r = threadIdx.x / 64, c = threadIdx.x % 64; float t = P.in[5][layer * 6144 + cb + c];
#pragma unroll
                for (int wv = 0; wv < 8; ++wv) t += part[(wv * 5 + r) * 64 + c];
                ((float*)(ws + WS_MOD))[(size_t)(layer * 5 + r) * 6144 + cb + c] = t; }
        }
        __syncthreads();
    }
    PSEC(10);
    TJob j;
    ph_big_transpose(P.in[34], 2048, 1, 2 * NE, (bf16*)(ws + WS_WGU), (float*)lds, G);
    PSEC(11);
    ph_big_transpose(P.in[36], 1024, 0, 2 * NE, (bf16*)(ws + WS_WDN), (float*)lds, G);
    PSEC(12);
    j = TJob{P.in[8], (bf16*)(ws + WS_WEVIN), nullptr, 1024, EVEN_IN, EVEN_IN_P, 0, 1, 0, 0, 1024}; run_tjob(j, wt, base, NW, gw, lane);
    j = TJob{P.in[9], (bf16*)(ws + WS_WEVOUT), nullptr, 1024, 1024, 1024, 0, 1, 0, 0, 1024}; run_tjob(j, wt, base, NW, gw, lane);
    j = TJob{P.in[18], (bf16*)(ws + WS_WUQ), P.in[17], 384, 768, 768, 0, 1, 0, 0, 384}; run_tjob(j, wt, base, NW, gw, lane);
    j = TJob{P.in[20], (bf16*)(ws + WS_WUKV), P.in[19], 384, 1024, 1024, 0, 1, 0, 0, 256}; run_tjob(j, wt, base, NW, gw, lane);
    j = TJob{P.in[12], (bf16*)(ws + WS_WLRU), nullptr, 64, 64, 64, 0, 8, 4096, 4096, 64}; run_tjob(j, wt, base, NW, gw, lane);
    j = TJob{P.in[14], (bf16*)(ws + WS_WLRU) + 8 * 4096, nullptr, 64, 64, 64, 0, 8, 4096, 4096, 64}; run_tjob(j, wt, base, NW, gw, lane);
    j = TJob{P.in[12] + 8 * 4096, (bf16*)(ws + WS_WLRU) + 16 * 4096, nullptr, 64, 64, 64, 0, 8, 4096, 4096, 64}; run_tjob(j, wt, base, NW, gw, lane);
    j = TJob{P.in[14] + 8 * 4096, (bf16*)(ws + WS_WLRU) + 24 * 4096, nullptr, 64, 64, 64, 0, 8, 4096, 4096, 64}; run_tjob(j, wt, base, NW, gw, lane);
    j = TJob{P.in[23], (bf16*)(ws + WS_WODIN), nullptr, 1024, ODD_IN, ODD_IN, 0, 1, 0, 0, 1024}; run_tjob(j, wt, base, NW, gw, lane);
    j = TJob{P.in[24], (bf16*)(ws + WS_WODOUT), nullptr, 1024, 1024, 1024, 0, 1, 0, 0, 1024}; run_tjob(j, wt, base, NW, gw, lane);
    __syncthreads();
    PSEC(13);
    {
        float* rc = (float*)(ws + WS_ROPE); float* rs = rc + SEQ * 64;
        for (int i = (int)blockIdx.x * NT + threadIdx.x; i < SEQ * 64; i += G * NT) {
            const int t = i >> 6, e = i & 63, q = e & 15;
            const float f = exp2f(-(float)(2 * q) / 32.f * 13.287712379549449f);
            const float ang = (float)((e >> 5) ? (t % GRID_W) : (t / GRID_W)) * f;
            float sv, cv; sincosf(ang, &sv, &cv); rc[i] = cv; rs[i] = sv;
        }
    }
    if ((int)blockIdx.x == G - 2) { float* c8t = (float*)(ws + WS_SCAL) + 1024; for (int i = threadIdx.x; i < 2 * LRU_W; i += NT) c8t[i] = 8.f * LOG2E * log1pf(__expf(-P.in[16][i])); }
    if ((int)blockIdx.x == G - 1 && threadIdx.x == 0) {
        float* sc = (float*)(ws + WS_SCAL);
        float mq = 0, mk = 0;
        for (int i = 0; i < 192; ++i) { mq = fmaxf(mq, fabsf(P.in[21][i])); mk = fmaxf(mk, fabsf(P.in[22][i])); }
        sc[0] = sqrtf(192.f) * mq * mk * LOG2E;
        mq = 0; mk = 0;
        for (int i = 0; i < 64; ++i) { mq = fmaxf(mq, fabsf(P.in[25][i])); mk = fmaxf(mk, fabsf(P.in[26][i])); }
        sc[1] = 8.f * mq * mk * LOG2E;
        float s1 = 0, s2 = 0;
        for (int i = 0; i < 64; ++i) { s1 += P.in[27][i] * P.in[28][i]; s2 += P.in[29][i] * P.in[30][i]; }
        const float lam_init = 0.8f - 0.6f * expf(-0.3f * 1.f);
        sc[2] = expf(s1) - expf(s2) + lam_init;
        sc[3] = 1.f - lam_init;
    }
}

__device__ __forceinline__ void norm_mod_store(const Ptrs& P, float (&v)[16], int lane, int u, int layer, int which) {
    const float* g = (which == 0 ? P.in[6] : P.in[7]) + layer * D;
    const float* md = mod_row(P, layer, u) + (which == 0 ? 0 : 3 * D);
    float ss = 0.f;
#pragma unroll
    for (int i = 0; i < 16; ++i) ss += v[i] * v[i];
    const float rstd = rsqrtf(wave_sum(ss) * (1.f / D) + EPS);
    bf16* h = (bf16*)(P.ws + WS_H) + (size_t)u * D;
#pragma unroll
    for (int j = 0; j < 4; ++j) {
        const int c = j * 256 + lane * 4;
        const f32x4 gv = *(const f32x4*)(g + c), scv = *(const f32x4*)(md + D + c), shv = *(const f32x4*)(md + c);
#pragma unroll
        for (int e = 0; e < 4; ++e) v[4 * j + e] = v[4 * j + e] * rstd * gv[e] * (1.f + scv[e]) + shv[e];
        const unsigned lo = f2bf(v[4 * j]) | ((unsigned)f2bf(v[4 * j + 1]) << 16), hi = f2bf(v[4 * j + 2]) | ((unsigned)f2bf(v[4 * j + 3]) << 16);
        *(uint2*)(h + c) = make_uint2(lo, hi);
    }
}
__device__ __forceinline__ void ph_rows(const Ptrs& P, int layer, int mode, int latent_only, int next_norm) {
    const int wave = threadIdx.x >> 6, lane = threadIdx.x & 63, G = gridDim.x;
    for (int u = (int)blockIdx.x * 8 + wave; u < R; u += G * 8) {
        if (latent_only && (u % SU) < CTX) continue;
        float v[16];
        if (mode == 0) { const float* x = res_in_row(P, layer, u);
#pragma unroll
            for (int j = 0; j < 4; ++j) { const f32x4 t = *(const f32x4*)(x + j * 256 + lane * 4); v[4 * j] = t[0]; v[4 * j + 1] = t[1]; v[4 * j + 2] = t[2]; v[4 * j + 3] = t[3]; } }
        else { const bf16* x = (const bf16*)(P.ws + WS_XB) + (size_t)u * D;
#pragma unroll
            for (int j = 0; j < 4; ++j) { const uint2 t = *(const uint2*)(x + j * 256 + lane * 4); v[4 * j] = __uint_as_float(t.x << 16); v[4 * j + 1] = __uint_as_float(t.x & 0xffff0000u); v[4 * j + 2] = __uint_as_float(t.y << 16); v[4 * j + 3] = __uint_as_float(t.y & 0xffff0000u); } }
        if (mode == 2) {
            const float* g2 = mod_row(P, layer, u) + 5 * D; float* xo = res_out_row(P, u); bf16* xbo = (bf16*)(P.ws + WS_XB) + (size_t)u * D;
            const bf16* y = (const bf16*)(P.ws + WS_Y) + (size_t)u * 4 * 1024;
#pragma unroll
            for (int j = 0; j < 4; ++j) { const int c = j * 256 + lane * 4; const f32x4 gv = *(const f32x4*)(g2 + c); f32x4 o;
#pragma unroll
                for (int e = 0; e < 4; ++e) { const float f = bf2f(y[c + e]) + bf2f(y[1024 + c + e]) + bf2f(y[2048 + c + e]) + bf2f(y[3072 + c + e]); v[4 * j + e] += gv[e] * f; o[e] = v[4 * j + e]; }
                if (next_norm) { uint2 w; w.x = g8_cvt_pk(o[0], o[1]); w.y = g8_cvt_pk(o[2], o[3]); *(uint2*)(xbo + c) = w; }
                else *(f32x4*)(xo + c) = o; }
            if (next_norm) norm_mod_store(P, v, lane, u, layer + 1, 0);
        } else {
            norm_mod_store(P, v, lane, u, layer, mode);
        }
    }
}

namespace g8 {
typedef short bf16x8 __attribute__((ext_vector_type(8)));
constexpr int BM = 256, BK = 64, HALF = 128, HTB = HALF * BK * 2, STAGE_BYTES = 8 * HTB, NXCD = 8, WGM = 8;
__host__ __device__ __forceinline__ int lds_byte(int r, int c) { const int st = (r >> 4) * 2 + (c >> 5), rr = r & 15, cc = c & 31, ob = rr * 64 + cc * 2; return st * 1024 + (ob ^ (((ob >> 9) & 1) << 5)); }
__host__ __device__ __forceinline__ void stage_rc(int b, int& R, int& C) { const int st = b / 1024, sb = b % 1024, swz = sb ^ (((sb >> 9) & 1) << 5); R = (st >> 1) * 16 + swz / 64; C = (st & 1) * 32 + (swz % 64) / 2; }
__host__ __device__ __forceinline__ int perm32(int rho) { const int n = rho >> 4, i = rho & 15; return 8 * (i >> 2) + 4 * n + (i & 3); }
struct Unit { const char* a; const char* b; int pm, pn, e, aux, cnt; };
__device__ __forceinline__ unsigned cvt_pk_bf16(float lo, float hi) { unsigned r; asm volatile("v_cvt_pk_bf16_f32 %0, %1, %2" : "=v"(r) : "v"(lo), "v"(hi)); return r; }

template <class Epi, class Sched, bool GATHER, bool ALIGN_EPI, bool PFB = false>
__device__ __forceinline__ void gemm_phase(LAS unsigned char* lds, const int lda, const int K, const Sched& S, const Epi& E) {
    const int tid = threadIdx.x, wid = __builtin_amdgcn_readfirstlane(tid >> 6), lane = tid & 63, wr = wid >> 2, wc = wid & 3, fr = lane & 15, fq = lane >> 4;
    const int nt = K / BK;
    int Rr[2], Cc[2]; unsigned voffB[2];
#pragma unroll
    for (int i = 0; i < 2; ++i) { stage_rc(tid * 16 + i * 8192, Rr[i], Cc[i]); const int Rb = Epi::PERM ? ((Rr[i] & ~31) + perm32(Rr[i] & 31)) : Rr[i]; voffB[i] = (unsigned)(Rb * BK + Cc[i]) * 2u; }
    const size_t kstep = (size_t)(BK * 2), kstepB = (size_t)BM * BK * 2;
    const size_t hstepB = (size_t)HALF * BK * 2;
    const unsigned ldsw = (unsigned)wid * 1024u;
    const int aoff = lds_byte(wr * 64 + fr, fq * 8), boff = lds_byte(wc * 32 + fr, fq * 8);
#define G8_SA(b, h) (((b) * 2 + (h)) * HTB)
#define G8_SB(b, h) ((4 + (b) * 2 + (h)) * HTB)
#define G8_STAGE(bufoff, gbase, v0, v1) do { \
        __builtin_amdgcn_global_load_lds((const unsigned*)((const char*)(gbase) + (v0)), (LAS unsigned*)(lds + (bufoff) + ldsw), 16, 0, 0); \
        __builtin_amdgcn_global_load_lds((const unsigned*)((const char*)(gbase) + (v1)), (LAS unsigned*)(lds + (bufoff) + ldsw + 8192), 16, 0, 0); } while (0)
#define G8_LDA(dst, b, h) do { _Pragma("unroll") for (int m = 0; m < 4; ++m) _Pragma("unroll") for (int k = 0; k < 2; ++k) dst[m][k] = *(const LAS bf16x8*)(lds + G8_SA(b, h) + aoff + m * 2048 + k * 1024); } while (0)
#define G8_LDB(dst, b, h) do { _Pragma("unroll") for (int n = 0; n < 2; ++n) _Pragma("unroll") for (int k = 0; k < 2; ++k) dst[n][k] = *(const LAS bf16x8*)(lds + G8_SB(b, h) + boff + n * 2048 + k * 1024); } while (0)
#define G8_MMA(ai, bj, At, Bt) do { __builtin_amdgcn_s_setprio(1); _Pragma("unroll") for (int m = 0; m < 4; ++m) _Pragma("unroll") for (int n = 0; n < 2; ++n) _Pragma("unroll") for (int k = 0; k < 2; ++k) \
        acc[ai][bj][m][n] = __builtin_amdgcn_mfma_f32_16x16x32_bf16(Bt[n][k], At[m][k], acc[ai][bj][m][n], 0, 0, 0); __builtin_amdgcn_s_setprio(0); } while (0)
#define G8_WAIT_V(n) asm volatile("s_waitcnt vmcnt(" #n ")" ::: "memory")
#define G8_WAIT_L(n) asm volatile("s_waitcnt lgkmcnt(" #n ")" ::: "memory")
#define G8_BAR __builtin_amdgcn_s_barrier()
#define G8_SCHED __builtin_amdgcn_sched_barrier(0)
    Unit cur, nxt; int ui = 0;
    if (!S.next(0, cur)) return;
    unsigned vA0[2], vA1[2], nA0[2], nA1[2];
#pragma unroll
    for (int i = 0; i < 2; ++i) {
        if (GATHER) { vA0[i] = S.arow_off(cur, Rr[i]) + (unsigned)Cc[i] * 2u; vA1[i] = S.arow_off(cur, HALF + Rr[i]) + (unsigned)Cc[i] * 2u; }
        else { vA0[i] = (unsigned)(Rr[i] * lda + Cc[i]) * 2u; vA1[i] = (unsigned)((HALF + Rr[i]) * lda + Cc[i]) * 2u; }
        nA0[i] = vA0[i]; nA1[i] = vA1[i];
    }
    f32x4 acc[2][2][4][2];
#pragma unroll
    for (int a = 0; a < 2; ++a)
#pragma unroll
        for (int b = 0; b < 2; ++b)
#pragma unroll
            for (int m = 0; m < 4; ++m)
#pragma unroll
                for (int n = 0; n < 2; ++n) acc[a][b][m][n] = (f32x4){0.f, 0.f, 0.f, 0.f};
    bf16x8 At[4][2], B0[2][2], B1[2][2];
    const char* cA = cur.a; const char* cB = cur.b;
    G8_STAGE(G8_SB(0, 0), cB, voffB[0], voffB[1]); G8_STAGE(G8_SB(0, 1), cB + hstepB, voffB[0], voffB[1]); G8_STAGE(G8_SA(0, 0), cA, vA0[0], vA0[1]); G8_STAGE(G8_SA(0, 1), cA, vA1[0], vA1[1]);
    if (wr == 1) G8_BAR;
    G8_WAIT_V(2); G8_BAR;
    G8_STAGE(G8_SB(1, 0), cB + kstepB, voffB[0], voffB[1]); G8_STAGE(G8_SA(1, 0), cA + kstep, vA0[0], vA0[1]); G8_STAGE(G8_SB(1, 1), cB + hstepB + kstepB, voffB[0], voffB[1]);
    G8_WAIT_V(6); G8_BAR;
    for (;;) {
        const bool has_next = S.next(ui + 1, nxt);
        const char* nA = has_next ? nxt.a : cA; const char* nB = has_next ? nxt.b : cB;
        unsigned pf_dummy = 0u;
        if (PFB && has_next && nB != cB) {
            const char* pb = nB + (size_t)tid * 128;
#pragma unroll
            for (int i = 0; i < 8; ++i) { if (i * NT * 128 < 256 * K * 2) asm volatile("global_load_dword %0, %1, off" : "+v"(pf_dummy) : "v"(pb + (size_t)i * NT * 128) : "memory"); }
        }
        if (GATHER) {
#pragma unroll
            for (int i = 0; i < 2; ++i) { if (has_next) { nA0[i] = S.arow_off(nxt, Rr[i]) + (unsigned)Cc[i] * 2u; nA1[i] = S.arow_off(nxt, HALF + Rr[i]) + (unsigned)Cc[i] * 2u; } else { nA0[i] = vA0[i]; nA1[i] = vA1[i]; } }
        }
#pragma unroll 1
        for (int t = 0; t < nt; t += 2) {
            const bool last = (t == nt - 2);
            const char* a1 = cA + (size_t)(t + 1) * kstep;
            const char* a2 = last ? nA : cA + (size_t)(t + 2) * kstep; const char* b2 = last ? nB : cB + (size_t)(t + 2) * kstepB;
            const char* a3 = a2 + kstep; const char* b3 = b2 + kstepB;
            unsigned x00 = vA0[0], x01 = vA0[1], x10 = vA1[0], x11 = vA1[1];
            if (GATHER) { x00 = last ? nA0[0] : vA0[0]; x01 = last ? nA0[1] : vA0[1]; x10 = last ? nA1[0] : vA1[0]; x11 = last ? nA1[1] : vA1[1]; }
            G8_LDB(B0, 0, 0); G8_LDB(B1, 0, 1); G8_SCHED; G8_LDA(At, 0, 0); G8_STAGE(G8_SA(1, 1), a1, vA1[0], vA1[1]);
            G8_WAIT_V(8); if (PFB) asm volatile("" : "+v"(pf_dummy)); G8_WAIT_L(0); G8_BAR; G8_MMA(0, 0, At, B0); G8_MMA(0, 1, At, B1); G8_BAR; G8_SCHED;
            G8_LDA(At, 0, 1); G8_STAGE(G8_SB(0, 0), b2, voffB[0], voffB[1]); G8_STAGE(G8_SB(0, 1), b2 + hstepB, voffB[0], voffB[1]); G8_STAGE(G8_SA(0, 0), a2, x00, x01);
            G8_WAIT_V(8); G8_WAIT_L(0); G8_BAR; G8_MMA(1, 0, At, B0); G8_MMA(1, 1, At, B1); G8_BAR; G8_SCHED;
            G8_LDB(B0, 1, 0); G8_LDB(B1, 1, 1); G8_SCHED; G8_LDA(At, 1, 0); G8_STAGE(G8_SA(0, 1), a2, x10, x11);
            G8_WAIT_V(8); G8_WAIT_L(0); G8_BAR; G8_MMA(0, 0, At, B0); G8_MMA(0, 1, At, B1); G8_BAR; G8_SCHED;
            G8_LDA(At, 1, 1); G8_STAGE(G8_SB(1, 0), b3, voffB[0], voffB[1]); G8_STAGE(G8_SB(1, 1), b3 + hstepB, voffB[0], voffB[1]); G8_STAGE(G8_SA(1, 0), a3, x00, x01);
            G8_WAIT_V(8); G8_WAIT_L(0); G8_BAR; G8_MMA(1, 0, At, B0); G8_MMA(1, 1, At, B1); G8_BAR; G8_SCHED;
        }
        if constexpr (ALIGN_EPI) { if (wr == 0) G8_BAR; }
        E(acc, cur, wr, wc, fr, fq);
        if (!has_next) break;
#pragma unroll
        for (int a = 0; a < 2; ++a)
#pragma unroll
            for (int b = 0; b < 2; ++b)
#pragma unroll
                for (int m = 0; m < 4; ++m)
#pragma unroll
                    for (int n = 0; n < 2; ++n) acc[a][b][m][n] = (f32x4){0.f, 0.f, 0.f, 0.f};
        cur = nxt; cA = nA; cB = nB; ++ui;
        if (GATHER) {
#pragma unroll
            for (int i = 0; i < 2; ++i) { vA0[i] = nA0[i]; vA1[i] = nA1[i]; }
        }
        if constexpr (ALIGN_EPI) { if (wr == 1) G8_BAR; }
    }
    G8_WAIT_V(0);
    if constexpr (!ALIGN_EPI) { if (wr == 0) G8_BAR; }
    G8_BAR;
#undef G8_SA
#undef G8_SB
#undef G8_STAGE
#undef G8_LDA
#undef G8_LDB
#undef G8_MMA
#undef G8_WAIT_V
#undef G8_WAIT_L
#undef G8_BAR
#undef G8_SCHED
}

struct DenseOrder {
    const char* A; const char* Bt; int lda, K, nM, nN, nwg, G, c, skip_ctx;
    __device__ __forceinline__ void init(const bf16* A_, int lda_, const bf16* Bt_, int K_, int M, int N, int G_, int c_, int skip_ctx_) {
        A = (const char*)A_; Bt = (const char*)Bt_; lda = lda_; K = K_; skip_ctx = skip_ctx_; nM = M / BM; if (skip_ctx) nM = nM / 17 * 16; nN = N / BM; nwg = nM * nN; G = G_; c = c_; }
    __device__ __forceinline__ bool next(int i, Unit& u) const {
        const long L = (long)i * G + c; if (L >= nwg) return false;
        int wgid = (int)L; { const int q = nwg / NXCD, r = nwg % NXCD, xcd = wgid % NXCD, off = wgid / NXCD; wgid = (xcd < r ? xcd * (q + 1) : r * (q + 1) + (xcd - r) * q) + off; }
        const int nig = WGM * nN, gid = wgid / nig, fm = gid * WGM, gsz = (nM - fm) < WGM ? (nM - fm) : WGM;
        int pm = fm + ((wgid % nig) % gsz); const int pn = (wgid % nig) / gsz;
        if (skip_ctx) pm = (pm / 16) * 17 + 1 + (pm % 16);
        u.pm = pm; u.pn = pn; u.e = 0; u.aux = 0; u.cnt = 0;
        u.a = A + (size_t)pm * BM * lda * 2; u.b = Bt + (size_t)pn * BM * K * 2; return true;
    }
    __device__ __forceinline__ unsigned arow_off(const Unit&, int) const { return 0u; }
};
}
namespace g8 {
struct MoeOrder {
    const char* Abase; const char* Bbase; const int* rowtab; size_t bstride; int nN, K, G, vcu, gather;
    LAS int* tab;
    __device__ __forceinline__ void init(const unsigned* cnt, LAS int* tab_) {
        tab = tab_;
        __syncthreads();
        if (threadIdx.x < 64) {
            const int lane = threadIdx.x, me = lane & 31;
            const int c = (int)cnt[me];
            int run = 0, ab = 0, ms = 0, mab = 0;
            for (int e = 0; e < NE; ++e) { const int ce = __builtin_amdgcn_readlane(c, e), mt = (ce + 255) >> 8; if (me == e) { ms = run; mab = ab; } run += mt * nN; ab += mt << 8; }
            if (lane < 32) { tab[lane] = ms; tab[32 + lane] = c; tab[64 + lane] = mab; }
            if (lane == 0) tab[96] = run;
        }
        __syncthreads();
    }
    __device__ __forceinline__ bool next(int i, Unit& u) const {
        const int L = i * G + vcu;
        if (L >= tab[96]) return false;
        const int me = threadIdx.x & 31;
        const int st_l = tab[me], c_l = tab[32 + me];
        const unsigned long long m = __ballot(L >= st_l && L < st_l + ((c_l + 255) >> 8) * nN);
        const int e = __builtin_amdgcn_readfirstlane(__builtin_ctzll(m) & 31);
        const int st = tab[e], c = tab[32 + e], ab = tab[64 + e];
        const int l = L - st;
        const int sh = nN == 8 ? 3 : 2;
        u.e = e; u.pm = l >> sh; u.pn = l & (nN - 1); u.aux = ab; u.cnt = c;
        u.a = gather ? Abase : Abase + (size_t)(ab + u.pm * 256) * 1024 * 2; u.b = Bbase + (size_t)e * bstride + (size_t)u.pn * 256 * K * 2; return true;
    }
    __device__ __forceinline__ unsigned arow_off(const Unit& u, int r) const { int rr = u.pm * 256 + r; rr = rr < u.cnt ? rr : u.cnt - 1; return (unsigned)rowtab[(size_t)u.e * R + rr] * (unsigned)(D * 2); }
};
struct UpOrder {
    const char* Z; const char* Wq; const char* Wkv; int G, c;
    __device__ __forceinline__ bool next(int i, Unit& u) const {
        const int L = i * G + c; if (L >= 476) return false;
        const int kv = L >= 204, l = kv ? L - 204 : L, pn = l / 68, pm = l % 68;
        u.pm = pm; u.pn = kv ? 3 + pn : pn; u.e = 0; u.aux = kv; u.cnt = 0;
        u.a = Z + ((size_t)pm * BM * EVEN_IN_P + 1024 + kv * 384) * 2; u.b = Wq + (size_t)u.pn * BM * 384 * 2; return true;
    }
    __device__ __forceinline__ unsigned arow_off(const Unit&, int) const { return 0u; }
};
struct EpiStoreBf16 {
    static constexpr bool PERM = true; bf16* C; int ldc;
    __device__ __forceinline__ void operator()(const f32x4 (&acc)[2][2][4][2], const Unit& u, int wr, int wc, int fr, int fq) const {
        const int row0 = u.pm * BM + wr * 64 + fr, col0 = u.pn * BM + wc * 32 + 8 * fq;
#pragma unroll
        for (int ai = 0; ai < 2; ++ai)
#pragma unroll
            for (int m = 0; m < 4; ++m) { bf16* rowp = C + (size_t)(row0 + ai * HALF + m * 16) * ldc + col0;
#pragma unroll
                for (int bj = 0; bj < 2; ++bj) { const f32x4 v0 = acc[ai][bj][m][0], v1 = acc[ai][bj][m][1];
                    u32x4 w; w.x = cvt_pk_bf16(v0[0], v0[1]); w.y = cvt_pk_bf16(v0[2], v0[3]); w.z = cvt_pk_bf16(v1[0], v1[1]); w.w = cvt_pk_bf16(v1[2], v1[3]);
                    *(u32x4*)(rowp + bj * HALF) = w; } }
    }
};
struct EpiDiffIn {
    static constexpr bool PERM = true; bf16* C; const float* qn; const float* kn; const float* rc; const float* rs; LAS float* xch  ;
    __device__ __forceinline__ void operator()(const f32x4 (&acc)[2][2][4][2], const Unit& u, int wr, int wc, int fr, int fq) const {
        const int row0 = u.pm * BM + wr * 64 + fr, col0 = u.pn * BM + wc * 32 + 8 * fq, wid = wr * 4 + wc;
        const bool isv = u.pn >= 8;
        float rstd[2][4][2];
#pragma unroll
        for (int ai = 0; ai < 2; ++ai)
#pragma unroll
            for (int m = 0; m < 4; ++m)
#pragma unroll
                for (int bj = 0; bj < 2; ++bj) { const f32x4 v0 = acc[ai][bj][m][0], v1 = acc[ai][bj][m][1];
                    float ss = v0[0] * v0[0] + v0[1] * v0[1] + v0[2] * v0[2] + v0[3] * v0[3] + v1[0] * v1[0] + v1[1] * v1[1] + v1[2] * v1[2] + v1[3] * v1[3];
                    ss += __shfl_xor(ss, 16); ss += __shfl_xor(ss, 32);
                    rstd[ai][m][bj] = ss;
                    if (fq == 0) xch[wid * 256 + ((ai * 4 + m) * 2 + bj) * 16 + fr] = ss; }
        asm volatile("s_waitcnt lgkmcnt(0)" ::: "memory"); __builtin_amdgcn_s_barrier(); asm volatile("" ::: "memory");
#pragma unroll
        for (int ai = 0; ai < 2; ++ai)
#pragma unroll
            for (int m = 0; m < 4; ++m)
#pragma unroll
                for (int bj = 0; bj < 2; ++bj) rstd[ai][m][bj] = rsqrtf((rstd[ai][m][bj] + xch[(wid ^ 1) * 256 + ((ai * 4 + m) * 2 + bj) * 16 + fr]) * (1.f / 64.f) + EPS);
        const int e0 = (wc & 1) * 32 + 8 * fq;
        const float* gn = u.pn < 4 ? qn : kn; const float qs = u.pn < 4 ? 0.125f * LOG2E : 1.f;
        f32x4 g0 = *(const f32x4*)(gn + e0), g1 = *(const f32x4*)(gn + e0 + 4);
        g0 = g0 * qs; g1 = g1 * qs;
        const float sgn = (fq & 2) ? 1.f : -1.f;
        const int jt = u.pm % 17; const bool latent = jt != 0;
#pragma unroll
        for (int ai = 0; ai < 2; ++ai)
#pragma unroll
            for (int m = 0; m < 4; ++m) { const int r = row0 + ai * HALF + m * 16; bf16* rowp = C + (size_t)r * ODD_IN + col0;
                f32x4 c0 = {1.f, 1.f, 1.f, 1.f}, c1 = c0, s0 = {0.f, 0.f, 0.f, 0.f}, s1 = s0;
                if (!isv && latent) { const int t = (jt - 1) * 256 + ai * HALF + wr * 64 + m * 16 + fr;
                    c0 = *(const f32x4*)(rc + t * 64 + e0); c1 = *(const f32x4*)(rc + t * 64 + e0 + 4); s0 = *(const f32x4*)(rs + t * 64 + e0); s1 = *(const f32x4*)(rs + t * 64 + e0 + 4); }
#pragma unroll
                for (int bj = 0; bj < 2; ++bj) { f32x4 v0 = acc[ai][bj][m][0], v1 = acc[ai][bj][m][1];
                    if (!isv) { const float rr = rstd[ai][m][bj]; v0 = v0 * rr * g0; v1 = v1 * rr * g1;
                        f32x4 o0, o1;
#pragma unroll
                        for (int j = 0; j < 4; ++j) { o0[j] = __shfl_xor(v0[j], 32); o1[j] = __shfl_xor(v1[j], 32); }
                        v0 = v0 * c0 + o0 * s0 * sgn; v1 = v1 * c1 + o1 * s1 * sgn; }
                    u32x4 w; w.x = cvt_pk_bf16(v0[0], v0[1]); w.y = cvt_pk_bf16(v0[2], v0[3]); w.z = cvt_pk_bf16(v1[0], v1[1]); w.w = cvt_pk_bf16(v1[2], v1[3]);
                    *(u32x4*)(rowp + bj * HALF) = w; } }
        asm volatile("s_waitcnt lgkmcnt(0)" ::: "memory"); __builtin_amdgcn_s_barrier(); asm volatile("" ::: "memory");
    }
};
struct EpiOut {
    static constexpr bool PERM = true; Ptrs P; int layer;
    __device__ __forceinline__ void operator()(const f32x4 (&acc)[2][2][4][2], const Unit& u, int wr, int wc, int fr, int fq) const {
        const int b = u.pm / 17, jt = u.pm % 17;
        const float* g1 = (const float*)(P.ws + WS_MOD) + (size_t)(layer * 5 + (jt == 0 ? 4 : b)) * 6144 + 2 * D;
        const float* in0 = jt == 0 ? P.in[2] + (size_t)(b * CTX) * D : P.in[0] + (size_t)(b * SEQ + (jt - 1) * 256) * D;
        bf16* xb0 = (bf16*)(P.ws + WS_XB) + (size_t)u.pm * BM * D;
        const int col0 = u.pn * BM + wc * 32 + 8 * fq;
        f32x4 gv[2][2];
#pragma unroll
        for (int bj = 0; bj < 2; ++bj)
#pragma unroll
            for (int n = 0; n < 2; ++n) gv[bj][n] = *(const f32x4*)(g1 + col0 + bj * HALF + 4 * n);
#pragma unroll
        for (int ai = 0; ai < 2; ++ai)
#pragma unroll
            for (int m = 0; m < 4; ++m) { const size_t off = (size_t)(ai * HALF + wr * 64 + m * 16 + fr) * D + col0;
#pragma unroll
                for (int bj = 0; bj < 2; ++bj) {
                    f32x4 x0, x1;
                    if (layer == 0) { x0 = *(const f32x4*)(in0 + off + bj * HALF); x1 = *(const f32x4*)(in0 + off + bj * HALF + 4); }
                    else { const u32x4 r = *(const u32x4*)(xb0 + off + bj * HALF);
                        x0 = (f32x4){__uint_as_float(r.x << 16), __uint_as_float(r.x & 0xffff0000u), __uint_as_float(r.y << 16), __uint_as_float(r.y & 0xffff0000u)};
                        x1 = (f32x4){__uint_as_float(r.z << 16), __uint_as_float(r.z & 0xffff0000u), __uint_as_float(r.w << 16), __uint_as_float(r.w & 0xffff0000u)}; }
                    const f32x4 v0 = x0 + gv[bj][0] * acc[ai][bj][m][0], v1 = x1 + gv[bj][1] * acc[ai][bj][m][1];
                    u32x4 w; w.x = cvt_pk_bf16(v0[0], v0[1]); w.y = cvt_pk_bf16(v0[2], v0[3]); w.z = cvt_pk_bf16(v1[0], v1[1]); w.w = cvt_pk_bf16(v1[2], v1[3]);
                    *(u32x4*)(xb0 + off + bj * HALF) = w; } }
    }
};
struct EpiMoe1 {
    static constexpr bool PERM = true; Ptrs P; int layer;
    __device__ __forceinline__ void operator()(const f32x4 (&acc)[2][2][4][2], const Unit& u, int wr, int wc, int fr, int fq) const {
        const float* bgu = P.in[35] + (size_t)(layer * NE + u.e) * 2048;
        const int cl = u.pn * 128 + wc * 32 + 8 * fq;
        f32x4 bg[2], bu[2];
#pragma unroll
        for (int n = 0; n < 2; ++n) { bg[n] = *(const f32x4*)(bgu + cl + 4 * n); bu[n] = *(const f32x4*)(bgu + 1024 + cl + 4 * n); }
        bf16* act = (bf16*)(P.ws + WS_ACT) + (size_t)(u.aux + u.pm * 256 + wr * 64 + fr) * 1024 + cl;
#pragma unroll
        for (int ai = 0; ai < 2; ++ai)
#pragma unroll
            for (int m = 0; m < 4; ++m) { float o[8];
#pragma unroll
                for (int n = 0; n < 2; ++n)
#pragma unroll
                    for (int j = 0; j < 4; ++j) { float g = acc[ai][0][m][n][j] + bg[n][j], uu = acc[ai][1][m][n][j] + bu[n][j];
                        g = fminf(g, 7.f); uu = fminf(fmaxf(uu, -7.f), 7.f);
                        const float sg = __builtin_amdgcn_rcpf(1.f + __expf(-1.702f * g)); o[n * 4 + j] = (uu + 1.f) * g * sg; }
                u32x4 w; w.x = cvt_pk_bf16(o[0], o[1]); w.y = cvt_pk_bf16(o[2], o[3]); w.z = cvt_pk_bf16(o[4], o[5]); w.w = cvt_pk_bf16(o[6], o[7]);
                *(u32x4*)(act + (size_t)(ai * HALF + m * 16) * 1024) = w; }
    }
};
struct EpiMoe2 {
    static constexpr bool PERM = true; Ptrs P; int layer;
    __device__ __forceinline__ void operator()(const f32x4 (&acc)[2][2][4][2], const Unit& u, int wr, int wc, int fr, int fq) const {
        const float* bd = P.in[37] + (size_t)(layer * NE + u.e) * 1024;
        const int col0 = u.pn * BM + wc * 32 + 8 * fq;
        f32x4 bv[2][2];
#pragma unroll
        for (int bj = 0; bj < 2; ++bj)
#pragma unroll
            for (int n = 0; n < 2; ++n) bv[bj][n] = *(const f32x4*)(bd + col0 + bj * HALF + 4 * n);
        const int* pair_of = (const int*)(P.ws + WS_PAIROF) + (size_t)u.e * R; const float* gate_of = (const float*)(P.ws + WS_GATEOF) + (size_t)u.e * R;
        bf16* Y = (bf16*)(P.ws + WS_Y);
#pragma unroll
        for (int ai = 0; ai < 2; ++ai)
#pragma unroll
            for (int m = 0; m < 4; ++m) { const int r = u.pm * 256 + ai * HALF + wr * 64 + m * 16 + fr;
                if (r < u.cnt) { const int pair = pair_of[r]; const float gw = gate_of[r]; bf16* rowp = Y + (size_t)pair * 1024 + col0;
#pragma unroll
                    for (int bj = 0; bj < 2; ++bj) { const f32x4 v0 = (acc[ai][bj][m][0] + bv[bj][0]) * gw, v1 = (acc[ai][bj][m][1] + bv[bj][1]) * gw;
                        u32x4 w; w.x = cvt_pk_bf16(v0[0], v0[1]); w.y = cvt_pk_bf16(v0[2], v0[3]); w.z = cvt_pk_bf16(v1[0], v1[1]); w.w = cvt_pk_bf16(v1[2], v1[3]);
                        *(u32x4*)(rowp + bj * HALF) = w; } } }
    }
};
}

__device__ __forceinline__ int bwd_pos(int c) { return c < 2 ? 1 - c : 2 + (NCH - 1 - c); }
__device__ __forceinline__ int bwd_chunk_at(int p) { return p < 2 ? 1 - p : NCH - 1 - (p - 2); }
__device__ __forceinline__ float fsigmoid(float x) { return __builtin_amdgcn_rcpf(1.f + __builtin_amdgcn_exp2f(-LOG2E * x)); }
__device__ __forceinline__ void lru_item_mfma(const Ptrs& P, unsigned char* lds, int mode, int n, int c, int b) {
    typedef short bf16x8 __attribute__((ext_vector_type(8)));
    float* X = (float*)lds;
    unsigned char* XB = lds + 128 * 68 * 4;
    float* SEG = (float*)(lds + 128 * 68 * 4 + 16384);
    float* CAR = SEG + 2 * 8 * 64 * 2;
    const int tid = threadIdx.x, wid = tid >> 6, lane = tid & 63, fr = lane & 15, fq = lane >> 4;
    const int j0 = c * CHUNK, seg_lo = (c < 2) ? 0 : CTX, seg_hi = (c < 2) ? CTX : SU;
    const bf16* Z = (const bf16*)(P.ws + WS_Z);
    const float* cw = P.in[10]; const float* cb = P.in[11];
    float* agg = (float*)(P.ws + WS_AGG);
    __syncthreads();
#pragma unroll
    for (int q = 0; q < 2; ++q) {
        const int p = tid + q * NT, t = p >> 3, c8 = (p & 7) * 8, cg = n * 64 + c8;
        float acc[8];
        { const f32x4 b0 = *(const f32x4*)(cb + cg), b1 = *(const f32x4*)(cb + cg + 4);
#pragma unroll
          for (int e = 0; e < 4; ++e) { acc[e] = b0[e]; acc[4 + e] = b1[e]; } }
#pragma unroll
        for (int k = 0; k < 4; ++k) {
            const int j = j0 + t - 2 + k; const bool ok = j >= seg_lo && j < seg_hi; const int jj = ok ? j : j0 + t;
            const u32x4 raw = *(const u32x4*)(Z + (size_t)(b * SU + jj) * EVEN_IN_P + 512 + cg);
            const f32x4 w0 = *(const f32x4*)(cw + k * LRU_W + cg), w1 = *(const f32x4*)(cw + k * LRU_W + cg + 4);
            const float m = ok ? 1.f : 0.f;
#pragma unroll
            for (int e = 0; e < 4; ++e) { const float lo = __uint_as_float(raw[e] << 16), hi = __uint_as_float(raw[e] & 0xffff0000u);
                const float wl = (e < 2 ? w0[2 * e] : w1[2 * e - 4]) * m, wh = (e < 2 ? w0[2 * e + 1] : w1[2 * e - 3]) * m;
                acc[2 * e] += wl * lo; acc[2 * e + 1] += wh * hi; }
        }
        *(f32x4*)(X + t * 68 + c8) = (f32x4){acc[0], acc[1], acc[2], acc[3]}; *(f32x4*)(X + t * 68 + c8 + 4) = (f32x4){acc[4], acc[5], acc[6], acc[7]};
        u32x4 w; w.x = g8::cvt_pk_bf16(acc[0], acc[1]); w.y = g8::cvt_pk_bf16(acc[2], acc[3]); w.z = g8::cvt_pk_bf16(acc[4], acc[5]); w.w = g8::cvt_pk_bf16(acc[6], acc[7]);
        *(u32x4*)(XB + t * 128 + (((c8 >> 3) ^ ((t >> 1) & 7)) << 4)) = w;
    }
    if (mode == 1 && wid < 2) {
        const int dir = wid, pos = dir == 0 ? c : bwd_pos(c); float h = 0.f;
        for (int p = 0; p < pos; ++p) { const int cc = dir == 0 ? p : bwd_chunk_at(p); const float2 ag = *(const float2*)(agg + ((((size_t)b * NCH + cc) * 2 + dir) * 512 + n * 64 + lane) * 2); h = ag.x * h + ag.y; }
        CAR[dir * 64 + lane] = h;
    }
    __syncthreads();
    const int trow = 16 * wid + fr;
    const bf16x8 af0 = *(const bf16x8*)(XB + trow * 128 + ((fq ^ ((trow >> 1) & 7)) << 4));
    const bf16x8 af1 = *(const bf16x8*)(XB + trow * 128 + (((4 + fq) ^ ((trow >> 1) & 7)) << 4));
    float av[2][4][4], uv[2][4][4], Ae[2][4], He[2][4];
#pragma unroll
    for (int dir = 0; dir < 2; ++dir) {
        const bf16* wa = (const bf16*)(P.ws + WS_WLRU) + ((size_t)(dir * 2 + 0) * 8 + n) * 4096;
        const bf16* wx = (const bf16*)(P.ws + WS_WLRU) + ((size_t)(dir * 2 + 1) * 8 + n) * 4096;
#pragma unroll
        for (int ct = 0; ct < 4; ++ct) {
            const int e = 16 * ct + fr;
            const bf16x8 wa0 = *(const bf16x8*)(wa + e * 64 + 8 * fq), wa1 = *(const bf16x8*)(wa + e * 64 + 32 + 8 * fq);
            const bf16x8 wx0 = *(const bf16x8*)(wx + e * 64 + 8 * fq), wx1 = *(const bf16x8*)(wx + e * 64 + 32 + 8 * fq);
            f32x4 ga = {0.f, 0.f, 0.f, 0.f}, gx = {0.f, 0.f, 0.f, 0.f};
            ga = __builtin_amdgcn_mfma_f32_16x16x32_bf16(af0, wa0, ga, 0, 0, 0); ga = __builtin_amdgcn_mfma_f32_16x16x32_bf16(af1, wa1, ga, 0, 0, 0);
            gx = __builtin_amdgcn_mfma_f32_16x16x32_bf16(af0, wx0, gx, 0, 0, 0); gx = __builtin_amdgcn_mfma_f32_16x16x32_bf16(af1, wx1, gx, 0, 0, 0);
            const int cgl = dir * LRU_W + n * 64 + e;
            const float bav = P.in[13][cgl], bxv = P.in[15][cgl], c8 = ((const float*)(P.ws + WS_SCAL))[1024 + cgl];
#pragma unroll
            for (int j = 0; j < 4; ++j) {
                const float r = fsigmoid(ga[j] + bav), ig = fsigmoid(gx[j] + bxv);
                const float a = __builtin_amdgcn_exp2f(-c8 * r);
                av[dir][ct][j] = a; uv[dir][ct][j] = sqrtf(fmaxf(1.f - a * a, 0.f)) * ig * X[(16 * wid + 4 * fq + j) * 68 + e];
            }
            float Al = av[dir][ct][0] * av[dir][ct][1] * av[dir][ct][2] * av[dir][ct][3], Hl;
            if (dir == 0) Hl = ((uv[dir][ct][0] * av[dir][ct][1] + uv[dir][ct][1]) * av[dir][ct][2] + uv[dir][ct][2]) * av[dir][ct][3] + uv[dir][ct][3];
            else Hl = ((uv[dir][ct][3] * av[dir][ct][2] + uv[dir][ct][2]) * av[dir][ct][1] + uv[dir][ct][1]) * av[dir][ct][0] + uv[dir][ct][0];
            const int pq = dir == 0 ? fq : 3 - fq;
            {
                const int src = dir == 0 ? lane - 16 : lane + 16; const float Ap = __shfl(Al, src & 63), Hp = __shfl(Hl, src & 63);
                if (pq >= 1) { Hl = Al * Hp + Hl; Al = Al * Ap; }
            }
            {
                const int src = dir == 0 ? lane - 32 : lane + 32; const float Ap = __shfl(Al, src & 63), Hp = __shfl(Hl, src & 63);
                if (pq >= 2) { Hl = Al * Hp + Hl; Al = Al * Ap; }
            }
            {
                const int src = dir == 0 ? lane - 16 : lane + 16; const float Ap = __shfl(Al, src & 63), Hp = __shfl(Hl, src & 63);
                Ae[dir][ct] = pq >= 1 ? Ap : 1.f; He[dir][ct] = pq >= 1 ? Hp : 0.f;
            }
            if (pq == 3) { float2 sv; sv.x = Al; sv.y = Hl; *(float2*)(SEG + ((dir * 8 + wid) * 64 + e) * 2) = sv; }
        }
    }
    __syncthreads();
    float hs[4][4];
#pragma unroll
    for (int ct = 0; ct < 4; ++ct)
#pragma unroll
        for (int j = 0; j < 4; ++j) hs[ct][j] = 0.f;
#pragma unroll
    for (int dir = 0; dir < 2; ++dir) {
#pragma unroll
        for (int ct = 0; ct < 4; ++ct) {
            const int e = 16 * ct + fr;
            if (mode == 0) {
                if (wid == 0 && fq == 0) {
                    float Ac = 1.f, Hc = 0.f;
                    for (int s = 0; s < 8; ++s) { const int sg = dir == 0 ? s : 7 - s; const float2 sv = *(const float2*)(SEG + ((dir * 8 + sg) * 64 + e) * 2); Hc = sv.x * Hc + sv.y; Ac *= sv.x; }
                    float2 o; o.x = Ac; o.y = Hc; *(float2*)(agg + ((((size_t)b * NCH + c) * 2 + dir) * 512 + n * 64 + e) * 2) = o;
                }
            } else {
                float h = CAR[dir * 64 + e];
                const int nprev = dir == 0 ? wid : 7 - wid;
                for (int s = 0; s < nprev; ++s) { const int sg = dir == 0 ? s : 7 - s; const float2 sv = *(const float2*)(SEG + ((dir * 8 + sg) * 64 + e) * 2); h = sv.x * h + sv.y; }
                h = Ae[dir][ct] * h + He[dir][ct];
                if (dir == 0) {
#pragma unroll
                    for (int j = 0; j < 4; ++j) { h = av[dir][ct][j] * h + uv[dir][ct][j]; hs[ct][j] += h; }
                } else {
#pragma unroll
                    for (int j = 3; j >= 0; --j) { h = av[dir][ct][j] * h + uv[dir][ct][j]; hs[ct][j] += h; }
                }
            }
        }
    }
    if (mode == 1) {
#pragma unroll
        for (int ct = 0; ct < 4; ++ct)
#pragma unroll
            for (int j = 0; j < 4; ++j) X[(16 * wid + 4 * fq + j) * 68 + 16 * ct + fr] = hs[ct][j];
        __syncthreads();
        bf16* mix = (bf16*)(P.ws + WS_MIX);
#pragma unroll
        for (int q = 0; q < 2; ++q) {
            const int p = tid + q * NT, t = p >> 3, c8 = (p & 7) * 8; const size_t u = (size_t)b * SU + j0 + t;
            const u32x4 gz = *(const u32x4*)(Z + u * EVEN_IN_P + n * 64 + c8);
            const f32x4 r0 = *(const f32x4*)(X + t * 68 + c8), r1 = *(const f32x4*)(X + t * 68 + c8 + 4);
            float o[8];
#pragma unroll
            for (int k = 0; k < 4; ++k) { const float g0 = __uint_as_float(gz[k] << 16), g1 = __uint_as_float(gz[k] & 0xffff0000u);
                const float s0 = fsigmoid(1.5957691216057308f * (g0 + 0.044715f * g0 * g0 * g0)), s1 = fsigmoid(1.5957691216057308f * (g1 + 0.044715f * g1 * g1 * g1));
                o[2 * k] = g0 * s0 * (k < 2 ? r0[2 * k] : r1[2 * k - 4]); o[2 * k + 1] = g1 * s1 * (k < 2 ? r0[2 * k + 1] : r1[2 * k - 3]); }
            u32x4 w; w.x = g8::cvt_pk_bf16(o[0], o[1]); w.y = g8::cvt_pk_bf16(o[2], o[3]); w.z = g8::cvt_pk_bf16(o[4], o[5]); w.w = g8::cvt_pk_bf16(o[6], o[7]);
            *(u32x4*)(mix + u * D + n * 64 + c8) = w;
        }
    }
}

__device__ __forceinline__ void ph_lru(const Ptrs& P, unsigned char* lds, int mode, int item0, int nheavy) {
    const int G = gridDim.x, total = 8 * NCH * NB, b = (int)blockIdx.x;
    if (nheavy > 0 && G == 256 && 4 * nheavy + 6 * (G - nheavy) >= total) {
        const int th = total - 6 * (G - nheavy);
        const int lo = b < nheavy ? b * 4 : th + (b - nheavy) * 6, hi0 = b < nheavy ? lo + 4 : lo + 6, cap = b < nheavy ? th : total, hi = hi0 < cap ? hi0 : cap;
        for (int it = lo; it < hi; ++it) lru_item_mfma(P, lds, mode, it % 8, (it / 8) % NCH, it / (8 * NCH));
    } else {
        int first = (b - item0 % G + G) % G;
        for (int it = first; it < total; it += G) lru_item_mfma(P, lds, mode, it % 8, (it / 8) % NCH, it / (8 * NCH));
    }
    __syncthreads();
}

__device__ __forceinline__ void unpack8(const u32x4 v, float (&f)[8]) {
#pragma unroll
    for (int i = 0; i < 4; ++i) { f[2 * i] = __uint_as_float(v[i] << 16); f[2 * i + 1] = __uint_as_float(v[i] & 0xffff0000u); }
}
__device__ __forceinline__ u32x4 pack8(const float (&f)[8]) {
    u32x4 w; w.x = g8::cvt_pk_bf16(f[0], f[1]); w.y = g8::cvt_pk_bf16(f[2], f[3]); w.z = g8::cvt_pk_bf16(f[4], f[5]); w.w = g8::cvt_pk_bf16(f[6], f[7]); return w;
}
__device__ __forceinline__ void ph_mla_prep(const Ptrs& P) {
    const int wave = threadIdx.x >> 6, lane = threadIdx.x & 63, G = gridDim.x;
    const int hl = lane & 31, hh = lane >> 5;
    const bool act = hl < 24, tail = hl >= 16 && hl < 24;
    const float* qn = P.in[21]; const float* kn = P.in[22];
    const float* rc = (const float*)(P.ws + WS_ROPE); const float* rs = rc + SEQ * 64;
    float gq[8], gk[8];
#pragma unroll
    for (int i = 0; i < 8; ++i) { gq[i] = act ? qn[hl * 8 + i] : 0.f; gk[i] = act ? kn[hl * 8 + i] : 0.f; }
    const float c2 = 0.07216878364870322f * LOG2E;
    for (int u = (int)blockIdx.x * 8 + wave; u < R; u += G * 8) {
        const int j = u % SU; const bool latent = j >= CTX; const int t = latent ? j - CTX : 0;
        const bf16* z = (const bf16*)(P.ws + WS_Z) + (size_t)u * EVEN_IN_P;
        float f[8]; float sq = 0.f, sk = 0.f;
        if (lane < 48) { unpack8(*(const u32x4*)(z + 1024 + lane * 8), f);
#pragma unroll
            for (int i = 0; i < 8; ++i) sq += f[i] * f[i]; }
        if (lane < 32) { unpack8(*(const u32x4*)(z + 1408 + lane * 8), f);
#pragma unroll
            for (int i = 0; i < 8; ++i) sk += f[i] * f[i]; }
        const float rq = rsqrtf(wave_sum(sq) * (1.f / 384.f) + EPS), rk = rsqrtf(wave_sum(sk) * (1.f / 256.f) + EPS);
        float cs[8], sn[8];
#pragma unroll
        for (int i = 0; i < 8; ++i) { cs[i] = 1.f; sn[i] = 0.f; }
        if (latent && tail) { const f32x4 c0 = *(const f32x4*)(rc + t * 64 + (hl - 16) * 8), c1 = *(const f32x4*)(rc + t * 64 + (hl - 16) * 8 + 4), s0 = *(const f32x4*)(rs + t * 64 + (hl - 16) * 8), s1 = *(const f32x4*)(rs + t * 64 + (hl - 16) * 8 + 4);
#pragma unroll
            for (int i = 0; i < 4; ++i) { cs[i] = c0[i]; cs[4 + i] = c1[i]; sn[i] = s0[i]; sn[4 + i] = s1[i]; } }
        const bf16* qp = (const bf16*)(P.ws + WS_QP) + (size_t)u * 1792; const bf16* kvp = qp + 768;
        bf16* qm = (bf16*)(P.ws + WS_QM) + (size_t)u * 768; bf16* km = (bf16*)(P.ws + WS_KM) + (size_t)u * 768; bf16* vm = (bf16*)(P.ws + WS_VM) + (size_t)u * 512;
        const float sgn = ((hl >> 1) & 1) ? 1.f : -1.f;
#pragma unroll
        for (int pass = 0; pass < 2; ++pass) {
            const int h = pass * 2 + hh;
            {
                float v[8]; float ss = 0.f;
                if (act) { unpack8(*(const u32x4*)(qp + h * 192 + hl * 8), v); } else {
#pragma unroll
                    for (int i = 0; i < 8; ++i) v[i] = 0.f; }
#pragma unroll
                for (int i = 0; i < 8; ++i) { v[i] *= rq; ss += v[i] * v[i]; }
                ss += __shfl_xor(ss, 1); ss += __shfl_xor(ss, 2); ss += __shfl_xor(ss, 4); ss += __shfl_xor(ss, 8); ss += __shfl_xor(ss, 16);
                const float r = rsqrtf(ss * (1.f / 192.f) + EPS);
#pragma unroll
                for (int i = 0; i < 8; ++i) { v[i] *= r * gq[i]; const float other = __shfl_xor(v[i], 2); v[i] = (v[i] * cs[i] + sgn * other * sn[i]) * c2; }
                if (act) *(u32x4*)(qm + h * 192 + hl * 8) = pack8(v);
            }
            {
                float v[8], w[8]; float ss = 0.f;
#pragma unroll
                for (int i = 0; i < 8; ++i) { v[i] = 0.f; w[i] = 0.f; }
                if (hl < 16) { unpack8(*(const u32x4*)(kvp + h * 256 + hl * 8), v); unpack8(*(const u32x4*)(kvp + h * 256 + 128 + hl * 8), w);
#pragma unroll
                    for (int i = 0; i < 8; ++i) { v[i] *= rk; w[i] *= rk; } }
                else if (tail) unpack8(*(const u32x4*)(z + 1664 + (hl - 16) * 8), v);
#pragma unroll
                for (int i = 0; i < 8; ++i) ss += v[i] * v[i];
                ss += __shfl_xor(ss, 1); ss += __shfl_xor(ss, 2); ss += __shfl_xor(ss, 4); ss += __shfl_xor(ss, 8); ss += __shfl_xor(ss, 16);
                const float r = rsqrtf(ss * (1.f / 192.f) + EPS);
#pragma unroll
                for (int i = 0; i < 8; ++i) { v[i] *= r * gk[i]; const float other = __shfl_xor(v[i], 2); v[i] = v[i] * cs[i] + sgn * other * sn[i]; }
                if (act) *(u32x4*)(km + h * 192 + hl * 8) = pack8(v);
                if (hl < 16) *(u32x4*)(vm + h * 128 + hl * 8) = pack8(w);
            }
        }
    }
}
#ifndef PROBE_SUB
#define PROBE_SUB 0
#define PROBE_SUBDK 0
#endif
#ifndef PROBE_SUBBLK
#define PROBE_SUBBLK 0
#endif
#define PSUB_T0() unsigned ps_t0_ = 0u; if (PROBE_SUB && DK == PROBE_SUBDK) ps_t0_ = __builtin_amdgcn_readfirstlane((unsigned)__builtin_readcyclecounter())
#define PSUB_AT(k) do { if (PROBE_SUB == (k) && DK == PROBE_SUBDK) sacc = __builtin_amdgcn_readfirstlane(sacc + ((unsigned)__builtin_readcyclecounter() - ps_t0_)); } while (0)
namespace att {
using bf16x8 = __attribute__((ext_vector_type(8))) short;
using s16x4  = __attribute__((ext_vector_type(4))) short;
using f32x16 = __attribute__((ext_vector_type(16))) float;
#define SBAR() __builtin_amdgcn_sched_barrier(0)
__device__ __forceinline__ int crow(int r, int hi) { return (r & 3) + 8 * (r >> 2) + 4 * hi; }
__device__ __forceinline__ unsigned cvtpk(float lo, float hi) { unsigned r; asm volatile("v_cvt_pk_bf16_f32 %0, %1, %2" : "=v"(r) : "v"(lo), "v"(hi)); return r; }
template <int DK> __device__ __forceinline__ int kswz(int row, int chunk) { return row * (DK * 2) + ((chunk ^ ((row >> 1) & 7)) << 4); }
__device__ __forceinline__ int v_st(int k, int c) { const int kk = (k & ~0xC) | ((k & 4) << 1) | ((k & 8) >> 1); return ((kk >> 3) * 4 + (c >> 5)) * 512 + ((kk & 7) * 32 + (c & 31)) * 2; }
__device__ __forceinline__ int v_rd_base(int lane) { return ((lane & 3) << 3) | (((lane >> 2) & 3) << 6) | (((lane >> 4) & 1) << 5) | (((lane >> 5) & 1) << 8); }
constexpr int v_rd_off(int d0, int ks, int half) { return d0 * 512 + ks * 4096 + half * 2048; }
template <int OFF> __device__ __forceinline__ s16x4 tr_read(int vb) { s16x4 r; asm volatile("ds_read_b64_tr_b16 %0, %1 offset:%2" : "=&v"(r) : "v"(vb), "i"(OFF) : "memory"); return r; }
template <int D0> __device__ __forceinline__ void pv_one(f32x16& od, int vb, bf16x8 pa0, bf16x8 pa1, bf16x8 pa2, bf16x8 pa3) {
    const s16x4 l0 = tr_read<v_rd_off(D0, 0, 0)>(vb), h0 = tr_read<v_rd_off(D0, 0, 1)>(vb), l1 = tr_read<v_rd_off(D0, 1, 0)>(vb), h1 = tr_read<v_rd_off(D0, 1, 1)>(vb);
    const s16x4 l2 = tr_read<v_rd_off(D0, 2, 0)>(vb), h2 = tr_read<v_rd_off(D0, 2, 1)>(vb), l3 = tr_read<v_rd_off(D0, 3, 0)>(vb), h3 = tr_read<v_rd_off(D0, 3, 1)>(vb);
    asm volatile("s_waitcnt lgkmcnt(0)" ::: "memory"); SBAR();
#define PK(L, H) (bf16x8){L[0], L[1], L[2], L[3], H[0], H[1], H[2], H[3]}
    od = __builtin_amdgcn_mfma_f32_32x32x16_bf16(pa0, PK(l0, h0), od, 0, 0, 0);
    od = __builtin_amdgcn_mfma_f32_32x32x16_bf16(pa1, PK(l1, h1), od, 0, 0, 0);
    od = __builtin_amdgcn_mfma_f32_32x32x16_bf16(pa2, PK(l2, h2), od, 0, 0, 0);
    od = __builtin_amdgcn_mfma_f32_32x32x16_bf16(pa3, PK(l3, h3), od, 0, 0, 0);
#undef PK
}
typedef short v4i16_t __attribute__((ext_vector_type(4)));
template <int OFF> __device__ __forceinline__ s16x4 tr_read_b(int vb) {
    return __builtin_bit_cast(s16x4, __builtin_amdgcn_ds_read_tr16_b64_v4i16((__attribute__((address_space(3))) v4i16_t*)(uintptr_t)(unsigned)(vb + OFF)));
}
template <int D0> __device__ __forceinline__ void pv_one_b(f32x16& od, int vb, bf16x8 pa0, bf16x8 pa1, bf16x8 pa2, bf16x8 pa3) {
    const s16x4 l0 = tr_read_b<v_rd_off(D0, 0, 0)>(vb), h0 = tr_read_b<v_rd_off(D0, 0, 1)>(vb), l1 = tr_read_b<v_rd_off(D0, 1, 0)>(vb), h1 = tr_read_b<v_rd_off(D0, 1, 1)>(vb);
    const s16x4 l2 = tr_read_b<v_rd_off(D0, 2, 0)>(vb), h2 = tr_read_b<v_rd_off(D0, 2, 1)>(vb), l3 = tr_read_b<v_rd_off(D0, 3, 0)>(vb), h3 = tr_read_b<v_rd_off(D0, 3, 1)>(vb);
#define PK(L, H) (bf16x8){L[0], L[1], L[2], L[3], H[0], H[1], H[2], H[3]}
    od = __builtin_amdgcn_mfma_f32_32x32x16_bf16(pa0, PK(l0, h0), od, 0, 0, 0);
    od = __builtin_amdgcn_mfma_f32_32x32x16_bf16(pa1, PK(l1, h1), od, 0, 0, 0);
    od = __builtin_amdgcn_mfma_f32_32x32x16_bf16(pa2, PK(l2, h2), od, 0, 0, 0);
    od = __builtin_amdgcn_mfma_f32_32x32x16_bf16(pa3, PK(l3, h3), od, 0, 0, 0);
#undef PK
}
constexpr int SHM_V = 64 * 128 * 2;
template <int DK, bool PF, bool EARLY>
__device__ __forceinline__ void attn_loop(const bf16* __restrict__ Qrow  , const bf16* __restrict__ Kh, int ldk, const bf16* __restrict__ Vh, int ldv,
                                          int nkeys, float negM, f32x16 (&o)[4], float& l_reg, char* lds_kv, unsigned& sacc) {
    constexpr int NQ = DK / 16, CH = DK / 8, KP = (64 * CH) / NT, SHM_K = 64 * DK * 2;
    const int tid = threadIdx.x, lane = tid & 63, r32 = lane & 31, hi = lane >> 5;
    char* V_lds = lds_kv; char* K_lds = lds_kv + 2 * SHM_V;
    bf16x8 qr[NQ];
#pragma unroll
    for (int d0 = 0; d0 < NQ; ++d0) qr[d0] = *reinterpret_cast<const bf16x8*>(Qrow + d0 * 16);
    const __amdgpu_buffer_rsrc_t krs = __builtin_amdgcn_make_buffer_rsrc((void*)Kh, 0, nkeys * ldk * 2, 0x00020000);
    const __amdgpu_buffer_rsrc_t vrs = __builtin_amdgcn_make_buffer_rsrc((void*)Vh, 0, nkeys * ldv * 2, 0x00020000);
    unsigned kgo[KP]; int kst[KP];
#pragma unroll
    for (int i = 0; i < KP; ++i) { const int p = tid + i * NT, row = p / CH, ch = p % CH; kgo[i] = (unsigned)(row * ldk + ch * 8) * 2u; kst[i] = kswz<DK>(row, ch); }
    const int vrow0 = tid >> 4, vc = (tid & 15) * 8;
    const unsigned vgo = (unsigned)(vrow0 * ldv + vc) * 2u, vstep = (unsigned)(32 * ldv) * 2u;
    const int vst0 = v_st(vrow0, vc); constexpr int vst1d = 8192;
    const int vb0 = (int)(uintptr_t)V_lds + v_rd_base(lane);
    const int kbase = r32 * (DK * 2), kt0 = (hi ^ ((r32 >> 1) & 7)) << 4;
#define kra_(q) (kbase + (kt0 ^ ((q) << 5)))
    u32x4 ks[KP], vs0, vs1;
#define SLOAD(k0) do { const unsigned so_k = (unsigned)((k0) * ldk) * 2u, so_v = (unsigned)((k0) * ldv) * 2u; \
        _Pragma("unroll") for (int i = 0; i < KP; ++i) ks[i] = __builtin_amdgcn_raw_buffer_load_b128(krs, kgo[i], so_k, 0); \
        vs0 = __builtin_amdgcn_raw_buffer_load_b128(vrs, vgo, so_v, 0); vs1 = __builtin_amdgcn_raw_buffer_load_b128(vrs, vgo + vstep, so_v, 0); } while (0)
#define SWRITE(b) do { _Pragma("unroll") for (int i = 0; i < KP; ++i) *reinterpret_cast<u32x4*>(K_lds + (b) * SHM_K + kst[i]) = ks[i]; \
        *reinterpret_cast<u32x4*>(V_lds + (b) * SHM_V + vst0) = vs0; *reinterpret_cast<u32x4*>(V_lds + (b) * SHM_V + vst0 + vst1d) = vs1; } while (0)
    constexpr int KLINES = (64 * DK * 2) / 128, VLINES = 128, LPR = DK / 64;
    unsigned pf_dummy = 0u;
#define PREFETCH(t) do { if (PF && tid < KLINES + VLINES) { const bool isk_ = tid < KLINES; const int l_ = isk_ ? tid : tid - KLINES; \
        const unsigned off_ = isk_ ? (unsigned)(((t) * 64 + l_ / LPR) * ldk + (l_ % LPR) * 64) * 2u : (unsigned)(((t) * 64 + (l_ >> 1)) * ldv + (l_ & 1) * 64) * 2u + (unsigned)((const char*)Vh - (const char*)Kh); \
        asm volatile("global_load_dword %0, %1, %2" : "+v"(pf_dummy) : "v"(off_), "s"(Kh) : "memory"); } } while (0)
    const int ntile = nkeys / 64;
    PREFETCH(1); PREFETCH(2);
    SLOAD(0); SWRITE(0); __syncthreads();
    for (int j = 0; j < ntile; ++j) {
        const int cur = j & 1;
        PSUB_T0();
        if (EARLY && j + 1 < ntile) SLOAD((j + 1) * 64);
        f32x16 p0, p1;
#pragma unroll
        for (int r = 0; r < 16; ++r) { p0[r] = negM; p1[r] = negM; }
        const char* Kb = K_lds + cur * SHM_K;
#pragma unroll
        for (int d0 = 0; d0 < NQ; ++d0) {
            const bf16x8 b0 = *reinterpret_cast<const bf16x8*>(Kb + kra_(d0 & 3) + (d0 >> 2) * 128);
            const bf16x8 b1 = *reinterpret_cast<const bf16x8*>(Kb + kra_(d0 & 3) + (d0 >> 2) * 128 + 32 * DK * 2);
            p0 = __builtin_amdgcn_mfma_f32_32x32x16_bf16(b0, qr[d0], p0, 0, 0, 0);
            p1 = __builtin_amdgcn_mfma_f32_32x32x16_bf16(b1, qr[d0], p1, 0, 0, 0);
            if ((d0 & 3) == 3) SBAR();
        }
        PSUB_AT(1);
        if (!EARLY && j + 1 < ntile) SLOAD((j + 1) * 64);
        float ps = 0.f;
#pragma unroll
        for (int r = 0; r < 16; ++r) { p0[r] = __builtin_amdgcn_exp2f(p0[r]); p1[r] = __builtin_amdgcn_exp2f(p1[r]); ps += p0[r] + p1[r]; }
        l_reg += ps;
        bf16x8 pa0, pa1, pa2, pa3;
#define PK4(P, BASE, OUT) do { unsigned a0 = cvtpk(P[BASE + 0], P[BASE + 1]), a1 = cvtpk(P[BASE + 2], P[BASE + 3]);   \
        unsigned b0_ = cvtpk(P[BASE + 4], P[BASE + 5]), b1_ = cvtpk(P[BASE + 6], P[BASE + 7]);                              \
        auto r0 = __builtin_amdgcn_permlane32_swap(a0, b0_, false, false); auto r1 = __builtin_amdgcn_permlane32_swap(a1, b1_, false, false); \
        u32x4 w = {r0[0], r1[0], r0[1], r1[1]}; OUT = *reinterpret_cast<bf16x8*>(&w); } while (0)
        PK4(p0, 0, pa0); PK4(p0, 8, pa1); PK4(p1, 0, pa2); PK4(p1, 8, pa3);
#undef PK4
        PSUB_AT(2);
        const int vb = vb0 + cur * SHM_V;
        pv_one<0>(o[0], vb, pa0, pa1, pa2, pa3); pv_one<1>(o[1], vb, pa0, pa1, pa2, pa3); pv_one<2>(o[2], vb, pa0, pa1, pa2, pa3); pv_one<3>(o[3], vb, pa0, pa1, pa2, pa3);
        PSUB_AT(3);
        if (j + 1 < ntile) SWRITE(cur ^ 1);
        if (j + 3 < ntile) PREFETCH(j + 3);
        __syncthreads();
        PSUB_AT(4);
    }
    if (PF) asm volatile("s_waitcnt vmcnt(0)" : "+v"(pf_dummy) :: "memory");
#undef PREFETCH
#undef kra_
#undef SLOAD
#undef SWRITE
}
__device__ __forceinline__ void row_recip(float l_reg, float* li_l  , int r32, int hi, float (&rli)[16]) {
    { auto rr = __builtin_amdgcn_permlane32_swap(__float_as_uint(l_reg), __float_as_uint(l_reg), false, false); l_reg = __uint_as_float(rr[0]) + __uint_as_float(rr[1]); }
    if (hi == 0) li_l[r32] = l_reg;
    asm volatile("s_waitcnt lgkmcnt(0)" ::: "memory");
#pragma unroll
    for (int r = 0; r < 16; ++r) rli[r] = __builtin_amdgcn_rcpf(li_l[crow(r, hi)]);
}
#undef SBAR
}

constexpr int ATT_SCR_OFF = RING_BYTES - 2048;
__device__ __forceinline__ void mla_attn_unit(const Ptrs& P, unsigned char* lds, int b, int h, int qb, int ctxq, unsigned& sacc) {
    using namespace att;
    const int tid = threadIdx.x, wid = tid >> 6, lane = tid & 63, r32 = lane & 31, hi = lane >> 5;
    const bf16* Qm = (const bf16*)(P.ws + WS_QM); const bf16* Km = (const bf16*)(P.ws + WS_KM); const bf16* Vm = (const bf16*)(P.ws + WS_VM);
    const size_t u0 = (size_t)b * SU + (ctxq ? 0 : CTX) + qb * 256 + wid * 32;
    f32x16 o[4] = {}; float l_reg = 0.f;
    const float negM = -((const float*)(P.ws + WS_SCAL))[0];
    attn_loop<192, false, false>(Qm + (u0 + r32) * 768 + h * 192 + hi * 8, Km + (size_t)b * SU * 768 + h * 192, 768, Vm + (size_t)b * SU * 512 + h * 128, 512, ctxq ? CTX : SU, negM, o, l_reg, (char*)lds, sacc);
    float rli[16]; row_recip(l_reg, (float*)(lds + ATT_SCR_OFF) + wid * 64, r32, hi, rli);
    bf16* stg = (bf16*)lds + wid * 4096;
#pragma unroll
    for (int r = 0; r < 16; ++r) { const int orow = crow(r, hi);
#pragma unroll
        for (int d0 = 0; d0 < 4; ++d0) stg[orow * 128 + d0 * 32 + r32] = f2bf(o[d0][r] * rli[r]); }
    asm volatile("s_waitcnt lgkmcnt(0)" ::: "memory");
    bf16* mix = (bf16*)(P.ws + WS_MIX) + u0 * D + 512 + h * 128;
#pragma unroll
    for (int i = 0; i < 8; ++i) { const int row = i * 4 + (lane >> 4), ch = lane & 15; const u32x4 v = *(const u32x4*)(stg + row * 128 + ch * 8); *(u32x4*)(mix + (size_t)row * D + ch * 8) = v; }
    asm volatile("s_waitcnt lgkmcnt(0)" ::: "memory");
    __syncthreads();
}
__device__ __forceinline__ void diff_attn_unit(const Ptrs& P, unsigned char* lds, int b, int h, int qb, unsigned& sacc) {
    using namespace att;
    const int tid = threadIdx.x, wid = tid >> 6, lane = tid & 63, r32 = lane & 31, hi = lane >> 5;
    const bf16* Z = (const bf16*)(P.ws + WS_Z);
    const size_t u0 = (size_t)b * SU + CTX + qb * 256 + wid * 32;
    const float* scal = (const float*)(P.ws + WS_SCAL); const float negM = -scal[1], lam = scal[2], oml = scal[3];
    bf16* stg = (bf16*)lds + wid * 4096;
    float* li_l = (float*)(lds + ATT_SCR_OFF) + wid * 64;
    for (int part = 0; part < 2; ++part) {
        f32x16 o[4] = {}; float l_reg = 0.f;
        attn_loop<64, true, false>(Z + (u0 + r32) * ODD_IN + h * 128 + part * 64 + hi * 8, Z + 1024 + (size_t)b * SU * ODD_IN + h * 128 + part * 64, ODD_IN, Z + 2048 + (size_t)b * SU * ODD_IN + h * 128, ODD_IN, SU, negM, o, l_reg, (char*)lds + 65536, sacc);
        float rli[16]; row_recip(l_reg, li_l, r32, hi, rli);
#pragma unroll
        for (int r = 0; r < 16; ++r) { const int orow = crow(r, hi);
#pragma unroll
            for (int d0 = 0; d0 < 4; ++d0) { bf16* s = stg + orow * 128 + d0 * 32 + r32; const float on = o[d0][r] * rli[r];
                if (part == 0) *s = f2bf(on); else *s = f2bf(bf2f(*s) - lam * on); } }
        asm volatile("s_waitcnt lgkmcnt(0)" ::: "memory");
    }
    const float* sg = P.in[31];
    bf16* mix = (bf16*)(P.ws + WS_MIX) + u0 * D + h * 128;
#pragma unroll
    for (int i = 0; i < 8; ++i) { const int row = i * 4 + (lane >> 4), ch = lane & 15; const u32x4 v = *(const u32x4*)(stg + row * 128 + ch * 8);
        float f[8]; float ss = 0.f;
#pragma unroll
        for (int e = 0; e < 4; ++e) { f[2 * e] = __uint_as_float(v[e] << 16); f[2 * e + 1] = __uint_as_float(v[e] & 0xffff0000u); ss += f[2 * e] * f[2 * e] + f[2 * e + 1] * f[2 * e + 1]; }
        ss += __shfl_xor(ss, 1); ss += __shfl_xor(ss, 2); ss += __shfl_xor(ss, 4); ss += __shfl_xor(ss, 8);
        const float rs = rsqrtf(ss * (1.f / 128.f) + EPS) * oml;
        const f32x4 g0 = *(const f32x4*)(sg + ch * 8), g1 = *(const f32x4*)(sg + ch * 8 + 4);
        u32x4 w; w.x = att::cvtpk(f[0] * rs * g0[0], f[1] * rs * g0[1]); w.y = att::cvtpk(f[2] * rs * g0[2], f[3] * rs * g0[3]); w.z = att::cvtpk(f[4] * rs * g1[0], f[5] * rs * g1[1]); w.w = att::cvtpk(f[6] * rs * g1[2], f[7] * rs * g1[3]);
        *(u32x4*)(mix + (size_t)row * D + ch * 8) = w; }
    asm volatile("s_waitcnt lgkmcnt(0)" ::: "memory");
    __syncthreads();
}

__device__ __forceinline__ void ph_norm2_router(const Ptrs& P, unsigned char* lds, int layer, int latent_only) {
    const int tid = threadIdx.x, wid = tid >> 6, lane = tid & 63, fr = lane & 15, fq = lane >> 4, G = gridDim.x;
    float* RS = (float*)lds;
    float* LGP = RS + 256;
    int* TOPE = (int*)(LGP + 2 * 4096);
    float* TOPW = (float*)(TOPE + 512);
    int* TOPR = (int*)(TOPW + 512);
    int* LCNT = TOPR + 512;
    int* LBASE = LCNT + 32;
    int* GU0 = LBASE + 32;
    const float* gn = P.in[7] + layer * D;
    const float* rw = P.in[32] + (size_t)layer * D * NE; const float* rb = P.in[33] + layer * NE;
    const int cw0 = 128 * wid + 8 * fq;
    float wv0[4][8], wv1[4][8];
#pragma unroll
    for (int ks = 0; ks < 4; ++ks) { const float* wr = rw + (size_t)(cw0 + 32 * ks) * NE + fr;
#pragma unroll
        for (int j = 0; j < 8; ++j) { wv0[ks][j] = wr[j * NE]; wv1[ks][j] = wr[j * NE + 16]; } }
    const int NG = latent_only ? NB * (SEQ / 16) : R / 16;
    const int q0 = (int)(((long long)blockIdx.x * NG) / G), q1 = (int)(((long long)(blockIdx.x + 1) * NG) / G);
#define N2_U0(q) (latent_only ? ((q) >> 8) * SU + CTX + ((q) & 255) * 16 : (q) * 16)
#define N2_XLOAD(XR, q) do { const bf16* x_ = (const bf16*)(P.ws + WS_XB) + (size_t)(N2_U0(q) + fr) * D + cw0; _Pragma("unroll") for (int ks = 0; ks < 4; ++ks) XR[ks] = *(const u32x4*)(x_ + 32 * ks); } while (0)
#define N2_LO(w) __uint_as_float((w) << 16)
#define N2_HI(w) __uint_as_float((w) & 0xffff0000u)
#define N2_SS(XR, par) do { float ss = 0.f; _Pragma("unroll") for (int ks = 0; ks < 4; ++ks) { const u32x4 r = XR[ks]; \
            ss += N2_LO(r.x) * N2_LO(r.x) + N2_HI(r.x) * N2_HI(r.x) + N2_LO(r.y) * N2_LO(r.y) + N2_HI(r.y) * N2_HI(r.y) + N2_LO(r.z) * N2_LO(r.z) + N2_HI(r.z) * N2_HI(r.z) + N2_LO(r.w) * N2_LO(r.w) + N2_HI(r.w) * N2_HI(r.w); } \
        ss += __shfl_xor(ss, 16); ss += __shfl_xor(ss, 32); if (fq == 0) RS[(par) * 128 + wid * 16 + fr] = ss; } while (0)
    float A[4][8], Hs[4][8]; int mi_cur = -1;
    for (int qs = q0; qs < q1; qs += 8) {
        const int qe = qs + 8 < q1 ? qs + 8 : q1;
        __syncthreads();
        if (tid < 32) LCNT[tid] = 0;
        u32x4 xr[4], xn[4];
        N2_XLOAD(xr, qs);
        N2_SS(xr, 0);
        __syncthreads();
        for (int q = qs; q < qe; ++q) {
            const int gi = q - qs, par = gi & 1, u0 = N2_U0(q), u = u0 + fr;
            { const int b_ = u0 / SU, mi = (u0 % SU) < CTX ? 4 : b_;
              if (mi != mi_cur) { mi_cur = mi; const float* md = (const float*)(P.ws + WS_MOD) + (size_t)(layer * 5 + mi) * 6144 + 3 * D;
#pragma unroll
                  for (int ks = 0; ks < 4; ++ks) { const int c0 = cw0 + 32 * ks;
                      const f32x4 g0 = *(const f32x4*)(gn + c0), g1 = *(const f32x4*)(gn + c0 + 4), s0 = *(const f32x4*)(md + D + c0), s1 = *(const f32x4*)(md + D + c0 + 4), h0 = *(const f32x4*)(md + c0), h1 = *(const f32x4*)(md + c0 + 4);
#pragma unroll
                      for (int j = 0; j < 4; ++j) { A[ks][j] = g0[j] * (1.f + s0[j]); A[ks][4 + j] = g1[j] * (1.f + s1[j]); Hs[ks][j] = h0[j]; Hs[ks][4 + j] = h1[j]; } } } }
            if (q + 1 < qe) N2_XLOAD(xn, q + 1);
            if (tid == 0) GU0[gi] = u0;
            float tot = 0.f;
#pragma unroll
            for (int w = 0; w < 8; ++w) tot += RS[par * 128 + w * 16 + fr];
            const float rstd = rsqrtf(tot * (1.f / D) + EPS);
            f32x4 acc0 = {0.f, 0.f, 0.f, 0.f}, acc1 = {0.f, 0.f, 0.f, 0.f};
            bf16* h = (bf16*)(P.ws + WS_H) + (size_t)u * D + cw0;
#pragma unroll
            for (int ks = 0; ks < 4; ++ks) {
                float y[8];
                const u32x4 r = xr[ks]; const float xv[8] = {N2_LO(r.x), N2_HI(r.x), N2_LO(r.y), N2_HI(r.y), N2_LO(r.z), N2_HI(r.z), N2_LO(r.w), N2_HI(r.w)};
#pragma unroll
                for (int j = 0; j < 8; ++j) y[j] = xv[j] * rstd * A[ks][j] + Hs[ks][j];
                u32x4 w; w.x = g8::cvt_pk_bf16(y[0], y[1]); w.y = g8::cvt_pk_bf16(y[2], y[3]); w.z = g8::cvt_pk_bf16(y[4], y[5]); w.w = g8::cvt_pk_bf16(y[6], y[7]);
                *(u32x4*)(h + 32 * ks) = w;
#pragma unroll
                for (int j = 0; j < 8; ++j) {
                    acc0 = __builtin_amdgcn_mfma_f32_16x16x4f32(y[j], wv0[ks][j], acc0, 0, 0, 0);
                    acc1 = __builtin_amdgcn_mfma_f32_16x16x4f32(y[j], wv1[ks][j], acc1, 0, 0, 0);
                }
            }
            float* lgp = LGP + par * 4096;
#pragma unroll
            for (int j = 0; j < 4; ++j) { lgp[(wid * 16 + 4 * fq + j) * 32 + fr] = acc0[j]; lgp[(wid * 16 + 4 * fq + j) * 32 + 16 + fr] = acc1[j]; }
            if (q + 1 < qe) { N2_SS(xn, par ^ 1);
#pragma unroll
                for (int ks = 0; ks < 4; ++ks) xr[ks] = xn[ks]; }
            __syncthreads();
            {
                const int e = lane & 31, row = 2 * wid + (lane >> 5);
                float lg = rb[e];
#pragma unroll
                for (int w = 0; w < 8; ++w) lg += lgp[(w * 16 + row) * 32 + e];
                int te[4]; float tv[4];
#pragma unroll
                for (int k = 0; k < 4; ++k) {
                    float bv = lg; int bi = e;
#pragma unroll
                    for (int m = 1; m < 32; m <<= 1) { const float ov = __shfl_xor(bv, m); const int oi = __shfl_xor(bi, m); const bool take = ov > bv || (ov == bv && oi < bi); bv = take ? ov : bv; bi = take ? oi : bi; }
                    te[k] = bi; tv[k] = bv; if (e == bi) lg = -3.4e38f;
                }
                float den = 0.f, w[4];
#pragma unroll
                for (int k = 0; k < 4; ++k) { w[k] = __expf(tv[k] - tv[0]); den += w[k]; }
                const float iden = 1.f / den;
                if (e < 4) { const int ek = e == 0 ? te[0] : e == 1 ? te[1] : e == 2 ? te[2] : te[3]; const float wk = (e == 0 ? w[0] : e == 1 ? w[1] : e == 2 ? w[2] : w[3]) * iden;
                    TOPE[gi * 64 + row * 4 + e] = ek; TOPW[gi * 64 + row * 4 + e] = wk; TOPR[gi * 64 + row * 4 + e] = atomicAdd(&LCNT[ek], 1); }
            }
        }
        __syncthreads();
        if (tid < 32) { int t2 = tid; asm volatile("" : "+v"(t2));
            const int c = LCNT[t2]; LBASE[t2] = c > 0 ? (int)atomicAdd((unsigned*)(P.ws + WS_CTL) + CW_CNT + layer * 64 + t2, (unsigned)c) : 0; }
        __syncthreads();
        int* tok_of = (int*)(P.ws + WS_TOKOF); int* pair_of = (int*)(P.ws + WS_PAIROF); float* gate_of = (float*)(P.ws + WS_GATEOF);
        for (int p = tid; p < (qe - qs) * 64; p += NT) {
            const int e = TOPE[p], rk = LBASE[e] + TOPR[p], ur = GU0[p >> 6] + ((p & 63) >> 2), k = p & 3;
            tok_of[(size_t)e * R + rk] = ur; pair_of[(size_t)e * R + rk] = ur * 4 + k; gate_of[(size_t)e * R + rk] = TOPW[p];
        }
    }
#undef N2_U0
#undef N2_XLOAD
#undef N2_SS
#undef N2_LO
#undef N2_HI
}

struct Args { Ptrs P; int ph_lo, ph_hi; };
constexpr int N_PHASES = 19;
__global__ void __launch_bounds__(NT, 2) mega(Args args) {
    extern __shared__ __attribute__((aligned(16))) unsigned char lds[];
    const Ptrs& P = args.P;
    unsigned char* ws = P.ws;
    const int tid = threadIdx.x, G = gridDim.x;
    const int vcu = (G % 8 == 0) ? ((int)blockIdx.x % 8) * (G / 8) + (int)blockIdx.x / 8 : (int)blockIdx.x;
    LAS unsigned char* LDSP = (LAS unsigned char*)lds;
    volatile LAS unsigned* MISC = (volatile LAS unsigned*)((LAS unsigned char*)lds + MISC_OFF);
    for (int u = tid; u < (LDS_BYTES - LDSCTL_OFF) / 4; u += NT) ((LAS unsigned*)((LAS unsigned char*)lds + LDSCTL_OFF))[u] = 0u;
    __syncthreads();
    XcdBarrier bar = xcd_barrier_post((unsigned*)(ws + WS_CTL) + CW_BAR, MISC + 8);
    const int lo = args.ph_lo, hi = args.ph_hi;
#ifndef PROBE_MASK
#define PROBE_MASK 0u
#endif
    unsigned long long pr_acc = 0ull, pr_t0 = 0ull; unsigned sub_acc = 0u;
#define IN(k) (lo <= (k) && (k) < hi)
#define SEAM(k) do { if (IN(k) && IN((k) + 1)) xcd_barrier(bar); \
        if (PROBE_MASK) { const unsigned long long t_ = __builtin_amdgcn_s_memrealtime(); if ((PROBE_MASK >> (k)) & 1u) pr_acc += t_ - pr_t0; pr_t0 = t_; } } while (0)
    if (PROBE_MASK) pr_t0 = __builtin_amdgcn_s_memrealtime();
    const bf16* H = (const bf16*)(ws + WS_H); bf16* Z = (bf16*)(ws + WS_Z); const bf16* MIX = (const bf16*)(ws + WS_MIX);
    const bf16* Qm = (const bf16*)(ws + WS_QM); const bf16* Km = (const bf16*)(ws + WS_KM); const bf16* Vm = (const bf16*)(ws + WS_VM);

    if (IN(0)) { ph_prologue(P, lds, sub_acc); } SEAM(0);
    if (IN(1)) { ph_rows(P, 0, 0, 0, 0); } SEAM(1);
    if (IN(2)) { g8::DenseOrder S; S.init(H, D, (const bf16*)(ws + WS_WEVIN), D, R, EVEN_IN_P, G, (int)blockIdx.x, 0); g8::EpiStoreBf16 E{Z, EVEN_IN_P};
        g8::gemm_phase<g8::EpiStoreBf16, g8::DenseOrder, false, true>(LDSP, D, D, S, E); } SEAM(2);
    if (IN(3)) {
        { g8::UpOrder S{(const char*)Z, (const char*)(ws + WS_WUQ), (const char*)(ws + WS_WUKV), G, (int)blockIdx.x}; g8::EpiStoreBf16 E{(bf16*)(ws + WS_QP), 1792};
          g8::gemm_phase<g8::EpiStoreBf16, g8::UpOrder, false, true>(LDSP, EVEN_IN_P, 384, S, E); }
        ph_lru(P, lds, 0, 0, 0);
    } SEAM(3);
    if (IN(4)) { ph_mla_prep(P); } SEAM(4);
    if (IN(5)) {
        ph_lru(P, lds, 1, 128, 0);
        for (int it = vcu; it < 256 + 16; it += G) {
            if (it < 256) mla_attn_unit(P, lds, it / 64, (it / 16) % 4, it % 16, 0, sub_acc);
            else { const int i2 = it - 256; mla_attn_unit(P, lds, i2 / 4, i2 % 4, 0, 1, sub_acc); }
        }
    } SEAM(5);
    if (IN(6)) { g8::DenseOrder S; S.init(MIX, D, (const bf16*)(ws + WS_WEVOUT), D, R, D, G, (int)blockIdx.x, 0); g8::EpiOut E{P, 0};
        g8::gemm_phase<g8::EpiOut, g8::DenseOrder, false, true>(LDSP, D, D, S, E); } SEAM(6);
    if (IN(7)) { ph_norm2_router(P, lds, 0, 0); } SEAM(7);
    if (IN(8)) { g8::MoeOrder S{(const char*)H, (const char*)(ws + WS_WGU) + (size_t)0 * NE * 2048 * 1024 * 2, (const int*)(ws + WS_TOKOF), (size_t)2048 * 1024 * 2, 8, D, G, vcu, 1, nullptr};
        S.init((const unsigned*)(ws + WS_CTL) + CW_CNT + 0 * 64, (LAS int*)(LDSP + MISC_OFF + 256)); g8::EpiMoe1 E{P, 0}; g8::gemm_phase<g8::EpiMoe1, g8::MoeOrder, true, true>(LDSP, D, D, S, E); } SEAM(8);
    if (IN(9)) { g8::MoeOrder S{(const char*)(ws + WS_ACT), (const char*)(ws + WS_WDN) + (size_t)0 * NE * 1024 * 1024 * 2, nullptr, (size_t)1024 * 1024 * 2, 4, D, G, vcu, 0, nullptr};
        S.init((const unsigned*)(ws + WS_CTL) + CW_CNT + 0 * 64, (LAS int*)(LDSP + MISC_OFF + 256)); g8::EpiMoe2 E{P, 0}; g8::gemm_phase<g8::EpiMoe2, g8::MoeOrder, false, true>(LDSP, D, D, S, E); } SEAM(9);
    if (IN(10)) { ph_rows(P, 0, 2, 0, 1); } SEAM(10);
    if (IN(11)) { g8::DenseOrder S; S.init(H, D, (const bf16*)(ws + WS_WODIN), D, R, ODD_IN, G, (int)blockIdx.x, 0);
        g8::EpiDiffIn E{Z, P.in[25], P.in[26], (const float*)(ws + WS_ROPE), (const float*)(ws + WS_ROPE) + SEQ * 64, (LAS float*)(LDSP + MISC_OFF + 1024)};
        g8::gemm_phase<g8::EpiDiffIn, g8::DenseOrder, false, true>(LDSP, D, D, S, E); } SEAM(11);
    if (IN(13)) {
        for (int it = vcu; it < 512; it += G) { unsigned tq0 = 0u; if (PROBE_SUB == 5 && PROBE_SUBDK == 64) tq0 = (unsigned)__builtin_readcyclecounter();
            diff_attn_unit(P, lds, it / 128, (it / 16) % 8, it % 16, sub_acc);
            if (PROBE_SUB == 5 && PROBE_SUBDK == 64) sub_acc += (unsigned)__builtin_readcyclecounter() - tq0; }
    } SEAM(13);
    if (IN(14)) { g8::DenseOrder S; S.init(MIX, D, (const bf16*)(ws + WS_WODOUT), D, R, D, G, (int)blockIdx.x, 1); g8::EpiOut E{P, 1};
        g8::gemm_phase<g8::EpiOut, g8::DenseOrder, false, true>(LDSP, D, D, S, E); } SEAM(14);
    if (IN(15)) { ph_norm2_router(P, lds, 1, 1); } SEAM(15);
    if (IN(16)) { g8::MoeOrder S{(const char*)H, (const char*)(ws + WS_WGU) + (size_t)1 * NE * 2048 * 1024 * 2, (const int*)(ws + WS_TOKOF), (size_t)2048 * 1024 * 2, 8, D, G, vcu, 1, nullptr};
        S.init((const unsigned*)(ws + WS_CTL) + CW_CNT + 1 * 64, (LAS int*)(LDSP + MISC_OFF + 256)); g8::EpiMoe1 E{P, 1}; g8::gemm_phase<g8::EpiMoe1, g8::MoeOrder, true, true>(LDSP, D, D, S, E); } SEAM(16);
    if (IN(17)) { g8::MoeOrder S{(const char*)(ws + WS_ACT), (const char*)(ws + WS_WDN) + (size_t)1 * NE * 1024 * 1024 * 2, nullptr, (size_t)1024 * 1024 * 2, 4, D, G, vcu, 0, nullptr};
        S.init((const unsigned*)(ws + WS_CTL) + CW_CNT + 1 * 64, (LAS int*)(LDSP + MISC_OFF + 256)); g8::EpiMoe2 E{P, 1}; g8::gemm_phase<g8::EpiMoe2, g8::MoeOrder, false, true>(LDSP, D, D, S, E); } SEAM(17);
    if (IN(18)) { ph_rows(P, 1, 2, 1, 0); }
    if (PROBE_MASK) { const unsigned long long t_ = __builtin_amdgcn_s_memrealtime(); if ((PROBE_MASK >> 18) & 1u) pr_acc += t_ - pr_t0;
        if (blockIdx.x == 0) { const unsigned long long t1 = t_ + 8ull * pr_acc; while (__builtin_amdgcn_s_memrealtime() < t1) __builtin_amdgcn_s_sleep(8); } }
    if (PROBE_SUB && (PROBE_SUBBLK < 0 || (int)blockIdx.x == PROBE_SUBBLK)) { const unsigned long long t1 = __builtin_readcyclecounter() + 8ull * (unsigned long long)sub_acc; while (__builtin_readcyclecounter() < t1) __builtin_amdgcn_s_sleep(8); }
#undef IN
#undef SEAM
}

#ifndef MK_PER_PHASE
#define MK_PER_PHASE 0
#endif
extern "C" void kernel_launch(void* const* d_in, const int* in_sizes, int n_in, void* d_out, int out_size, void* d_ws, size_t ws_size, hipStream_t stream) {
    static int grid = 0;
    if (grid == 0) {
        if (n_in != 38 || ws_size < WS_END) { fprintf(stderr, "kernel_launch: bad args n_in=%d ws=%zu need %zu\n", n_in, ws_size, (size_t)WS_END); grid = -1; return; }
        int dev = 0, cus = 0, per_cu = 0;
        if (hipGetDevice(&dev) != hipSuccess || hipDeviceGetAttribute(&cus, hipDeviceAttributeMultiprocessorCount, dev) != hipSuccess) { grid = -1; return; }
        if (hipFuncSetAttribute((const void*)mega, hipFuncAttributeMaxDynamicSharedMemorySize, LDS_BYTES) != hipSuccess) { fprintf(stderr, "kernel_launch: hipFuncSetAttribute failed\n"); grid = -1; return; }
        if (hipOccupancyMaxActiveBlocksPerMultiprocessor(&per_cu, (const void*)mega, NT, LDS_BYTES) != hipSuccess || per_cu < 1) { fprintf(stderr, "kernel_launch: occupancy query says %d blocks/CU\n", per_cu); grid = -1; return; }
        (void)hipGetLastError();
        grid = cus;
    }
    if (grid < 0) return;
    if (hipMemsetAsync((char*)d_ws + WS_CTL, 0, 1u << 20, stream) != hipSuccess) return;
    Args a; memset((void*)&a, 0, sizeof(a));
    for (int i = 0; i < 38; ++i) a.P.in[i] = (const float*)d_in[i];
    a.P.out = (float*)d_out; a.P.ws = (unsigned char*)d_ws;
#if MK_PER_PHASE
    for (int p = 0; p < N_PHASES; ++p) { a.ph_lo = p; a.ph_hi = p + 1; hipLaunchKernelGGL(mega, dim3(grid), dim3(NT), LDS_BYTES, stream, a); }
#else
    a.ph_lo = 0; a.ph_hi = N_PHASES;
    hipLaunchKernelGGL(mega, dim3(grid), dim3(NT), LDS_BYTES, stream, a);
#endif
    const hipError_t le = hipPeekAtLastError();
    if (le != hipSuccess) fprintf(stderr, "kernel_launch: launch failed: %s\n", hipGetErrorName(le));
}
```

```cpp
#include <hip/hip_runtime.h>
#include <cstdio>
#include <cstdint>
#include <cstring>

typedef unsigned short bf16;
typedef unsigned u32x4 __attribute__((ext_vector_type(4)));
typedef float f32x4 __attribute__((ext_vector_type(4)));

constexpr int D = 1024, NB = 4, SEQ = 4096, CTX = 256, SU = SEQ + CTX, R = NB * SU;
constexpr int GRID_W = 64;
constexpr int LRU_W = 512, LRU_NB = 8, LRU_BW = 64;
constexpr int MLA_H = 4, MLA_QR = 384, MLA_KVR = 256, MLA_NOPE = 128, MLA_ROPE = 64, MLA_V = 128, MLA_QK = 192;
constexpr int EVEN_IN = 1728, EVEN_IN_P = 1792;
constexpr int DIFF_H = 8, ODD_IN = 3072;
constexpr int NE = 32, TOPK = 4, DFF = 1024;
constexpr float EPS = 1e-6f;
constexpr int CHUNK = 128, NCH = SU / CHUNK;

constexpr size_t al256(size_t x) { return (x + 255) / 256 * 256; }
constexpr size_t WS_CTL = 0;
constexpr size_t WS_MOD = 1u << 20;
constexpr size_t WS_SCAL = WS_MOD + al256(2 * 5 * 6144 * 4);
constexpr size_t WS_WEVIN = WS_SCAL + 8192;
constexpr size_t WS_WEVOUT = WS_WEVIN + (size_t)EVEN_IN_P * D * 2;
constexpr size_t WS_WUQ = WS_WEVOUT + (size_t)D * D * 2;
constexpr size_t WS_WUKV = WS_WUQ + (size_t)768 * 384 * 2;
constexpr size_t WS_WLRU = WS_WUKV + (size_t)1024 * 384 * 2;
constexpr size_t WS_WODIN = WS_WLRU + (size_t)32 * 4096 * 2;
constexpr size_t WS_WODOUT = WS_WODIN + (size_t)ODD_IN * D * 2;
constexpr size_t WS_WGU = WS_WODOUT + (size_t)D * D * 2;
constexpr size_t WS_WDN = WS_WGU + (size_t)2 * NE * 2048 * 1024 * 2;
constexpr size_t WS_XC = WS_WDN + (size_t)2 * NE * 1024 * 1024 * 2;
constexpr size_t WS_H = WS_XC + (size_t)NB * CTX * D * 4;
constexpr size_t WS_Z = WS_H + (size_t)R * D * 2;
constexpr size_t WS_QP = WS_Z + (size_t)R * ODD_IN * 2;
constexpr size_t WS_KVP = WS_QP + (size_t)R * 768 * 2;
constexpr size_t WS_QM = WS_KVP + (size_t)R * 1024 * 2;
constexpr size_t WS_KM = WS_QM + (size_t)R * 768 * 2;
constexpr size_t WS_VM = WS_KM + (size_t)R * 768 * 2;
constexpr size_t WS_AGG = WS_VM + (size_t)R * 512 * 2;
constexpr size_t WS_MIX = WS_AGG + al256((size_t)NB * NCH * 2 * 512 * 2 * 4);
constexpr size_t WS_TOKOF = WS_MIX + (size_t)R * D * 2;
constexpr size_t WS_PAIROF = WS_TOKOF + (size_t)NE * R * 4;
constexpr size_t WS_GATEOF = WS_PAIROF + (size_t)NE * R * 4;
constexpr size_t ACT_ROWS = (size_t)R * TOPK + NE * 256;
constexpr size_t WS_ACT = WS_GATEOF + (size_t)NE * R * 4;
constexpr size_t WS_Y = WS_ACT + ACT_ROWS * 1024 * 2;
constexpr size_t WS_XB = WS_Y + (size_t)R * TOPK * 1024 * 2;
constexpr size_t WS_ROPE = WS_XB + (size_t)R * D * 2;
constexpr size_t WS_END = WS_ROPE + (size_t)2 * SEQ * 64 * 4;

constexpr int CW_CNT = 64;

__device__ __forceinline__ float bf2f(bf16 v) { return __uint_as_float((unsigned)v << 16); }
__device__ __forceinline__ bf16 f2bf(float f) { unsigned u = __float_as_uint(f); return (bf16)((u + 0x7fffu + ((u >> 16) & 1u)) >> 16); }
__device__ __forceinline__ float wave_sum(float v) {
#pragma unroll
    for (int o = 1; o < 64; o <<= 1) v += __shfl_xor(v, o);
    return v;
}
__device__ __forceinline__ unsigned g8_cvt_pk(float lo, float hi) { unsigned r; asm volatile("v_cvt_pk_bf16_f32 %0, %1, %2" : "=v"(r) : "v"(lo), "v"(hi)); return r; }
__device__ __forceinline__ float sigmoidf_(float x) { return 1.f / (1.f + __expf(-x)); }
__device__ __forceinline__ float gelu_tanh(float x) { const float t = tanhf(0.7978845608028654f * (x + 0.044715f * x * x * x)); return 0.5f * x * (1.f + t); }

struct Ptrs {
    const float* in[38];
    float* out;
    unsigned char* ws;
};

__device__ __forceinline__ const float* res_in_row(const Ptrs& P, int layer, int u) {
    const int b = u / SU, j = u % SU;
    if (layer == 0) return j < CTX ? P.in[2] + (size_t)(b * CTX + j) * D : P.in[0] + (size_t)(b * SEQ + j - CTX) * D;
    return j < CTX ? (const float*)(P.ws + WS_XC) + (size_t)(b * CTX + j) * D : P.out + (size_t)(b * SEQ + j - CTX) * D;
}
__device__ __forceinline__ float* res_out_row(const Ptrs& P, int u) {
    const int b = u / SU, j = u % SU;
    return j < CTX ? (float*)(P.ws + WS_XC) + (size_t)(b * CTX + j) * D : P.out + (size_t)(b * SEQ + j - CTX) * D;
}
__device__ __forceinline__ const float* mod_row(const Ptrs& P, int layer, int u) {
    const int b = u / SU, j = u % SU;
    return (const float*)(P.ws + WS_MOD) + (size_t)(layer * 5 + (j < CTX ? 4 : b)) * 6144;
}

constexpr float LOG2E = 1.4426950408889634f;
#define GAS __attribute__((address_space(1)))
#define LAS __attribute__((address_space(3)))
constexpr int NT = 512;
constexpr int LDS_BYTES = 147456;
constexpr int RING_BYTES = 131072, LDSCTL_OFF = RING_BYTES, MISC_OFF = LDSCTL_OFF + 320;
constexpr int CW_BAR = 4096;
constexpr int CW_TMO = 0;

#define XB_TMO      128
#define XB_XCNT(j)  (256  + 64 * (j))
#define XB_XSUB(j)  (1280 + 64 * (j))
#define XB_XGEN(j)  (2304 + 64 * (j))
#define XB_TOP      3328
#define XB_TOPGEN   3392
#define XCD_BAR_WORDS 3456
#define XB_SPIN_CAP (1u << 22)
__device__ __forceinline__ unsigned xb_ld(unsigned* p)              { return __hip_atomic_load(p, __ATOMIC_RELAXED, __HIP_MEMORY_SCOPE_AGENT); }
__device__ __forceinline__ unsigned xb_add(unsigned* p, unsigned v) { return __hip_atomic_fetch_add(p, v, __ATOMIC_RELAXED, __HIP_MEMORY_SCOPE_AGENT); }
__device__ __forceinline__ unsigned xb_xcc_id() { return (unsigned)__builtin_amdgcn_s_getreg((3 << 11) | 20) & 0xFu; }
#define XB_SPIN(cond, bar) do { unsigned _sp = 0; while (cond) { __builtin_amdgcn_s_sleep(1); \
    if ((++_sp & 255u) == 0u) { if (xb_ld(&(bar)[XB_TMO])) break; if (_sp > XB_SPIN_CAP) { atomicAdd(&(bar)[XB_TMO], 1u); break; } } } } while (0)
struct XcdBarrier { unsigned* bar; unsigned x; volatile LAS unsigned* st; };
__device__ __forceinline__ XcdBarrier xcd_barrier_post(unsigned* bar, volatile LAS unsigned* st) {
    XcdBarrier b; b.bar = bar; b.x = xb_xcc_id(); b.st = st;
    if (threadIdx.x == 0) (void)xb_add(&bar[XB_XCNT(b.x)], 1u);
    return b;
}
__device__ __forceinline__ void xcd_barrier_complete(unsigned* bar, unsigned x, unsigned& nloc, unsigned& nx) {
    const unsigned G = gridDim.x * gridDim.y * gridDim.z;
    unsigned sum, cnt, mine, sp = 0u;
    for (;;) {
        sum = 0u; cnt = 0u; mine = 0u;
#pragma unroll
        for (unsigned j = 0; j < 16; ++j) { const unsigned c = xb_ld(&bar[XB_XCNT(j)]); sum += c; cnt += (c > 0u) ? 1u : 0u; mine = (j == x) ? c : mine; }
        if (sum == G) break;
        __builtin_amdgcn_s_sleep(1);
        if ((++sp & 255u) == 0u) { if (xb_ld(&bar[XB_TMO])) break; if (sp > XB_SPIN_CAP) { atomicAdd(&bar[XB_TMO], 1u); break; } }
    }
    nloc = mine > 0u ? mine : 1u; nx = cnt > 0u ? cnt : 1u;
}
__device__ __forceinline__ void xcd_barrier(const XcdBarrier& b) {
    asm volatile("s_waitcnt vmcnt(0)" ::: "memory");
    __syncthreads();
    if (threadIdx.x == 0) {
        unsigned* bar = b.bar;
        __builtin_amdgcn_s_waitcnt(0);
        unsigned nloc = b.st[0], nx = b.st[1];
        if (nloc == 0u) { xcd_barrier_complete(bar, b.x, nloc, nx); b.st[0] = nloc; b.st[1] = nx; }
        const unsigned old = xb_add(&bar[XB_XSUB(b.x)], 1u);
        const unsigned gen = old / nloc;
        if (old + 1u == (gen + 1u) * nloc) {
            __builtin_amdgcn_fence(__ATOMIC_RELEASE, "agent");
            asm volatile("s_waitcnt vmcnt(0)" ::: "memory");
            const unsigned og = xb_add(&bar[XB_TOP], 1u);
            const unsigned tg = og / nx;
            if (og + 1u == (tg + 1u) * nx) xb_add(&bar[XB_TOPGEN], 1u);
            else XB_SPIN(xb_ld(&bar[XB_TOPGEN]) == tg, bar);
            __builtin_amdgcn_fence(__ATOMIC_ACQUIRE, "agent");
            xb_add(&bar[XB_XGEN(b.x)], 1u);
            asm volatile("s_waitcnt vmcnt(0)" ::: "memory");
        } else {
            XB_SPIN(xb_ld(&bar[XB_XGEN(b.x)]) == gen, bar);
            __builtin_amdgcn_fence(__ATOMIC_ACQUIRE, "agent");
            asm volatile("s_waitcnt vmcnt(0)" ::: "memory");
        }
    }
    __syncthreads();
}

struct TJob { const float* src; bf16* dst; const float* rs; int K, N, Npad, perm, batch; size_t sstr, dstr; int Ksrc; };
__device__ __forceinline__ void tt_load(const TJob& j, int it, int lane, f32x4 (&v)[16]) {
    const int tn = j.Npad / 64, per = tn * (j.K / 64), z = it / per, r = it % per, n0 = (r % tn) * 64, k0 = (r / tn) * 64;
    const float* src = j.src + z * j.sstr;
    const int n4 = (lane & 15) * 4, np = n0 + n4;
    int sc = np; if (j.perm == 1) sc = (np / 256) * 128 + (np % 128) + ((np % 256) / 128) * 1024;
#pragma unroll
    for (int i = 0; i < 16; ++i) { const int k = k0 + i * 4 + (lane >> 4); f32x4 t = {0.f, 0.f, 0.f, 0.f}; if (sc < j.N && k < j.Ksrc) { t = *(const f32x4*)(src + (size_t)k * j.N + sc); if (j.rs) t = t * j.rs[k]; } v[i] = t; }
}
__device__ __forceinline__ void tt_store(const TJob& j, int it, int lane, const f32x4 (&v)[16], float* wt) {
    const int tn = j.Npad / 64, per = tn * (j.K / 64), z = it / per, r = it % per, n0 = (r % tn) * 64, k0 = (r / tn) * 64;
    bf16* dst = j.dst + z * j.dstr + ((((size_t)(n0 >> 8) * (j.K >> 6) + (k0 >> 6)) << 14) + (((n0 & 255) + lane) << 6));
    const int n4 = (lane & 15) * 4;
#pragma unroll
    for (int half = 0; half < 2; ++half) {
#pragma unroll
        for (int i = 0; i < 8; ++i) *(f32x4*)(wt + (i * 4 + (lane >> 4)) * 68 + n4) = v[half * 8 + i];
        asm volatile("s_waitcnt lgkmcnt(0)" ::: "memory");
#pragma unroll
        for (int kc = 0; kc < 4; ++kc) { float f[8];
#pragma unroll
            for (int q = 0; q < 8; ++q) f[q] = wt[(kc * 8 + q) * 68 + lane];
            u32x4 w; w.x = f2bf(f[0]) | ((unsigned)f2bf(f[1]) << 16); w.y = f2bf(f[2]) | ((unsigned)f2bf(f[3]) << 16); w.z = f2bf(f[4]) | ((unsigned)f2bf(f[5]) << 16); w.w = f2bf(f[6]) | ((unsigned)f2bf(f[7]) << 16);
            *(u32x4*)(dst + half * 32 + kc * 8) = w; }
        asm volatile("s_waitcnt lgkmcnt(0)" ::: "memory");
    }
}
__device__ __forceinline__ void run_tjob(const TJob& j, float* wt, int& base, int NW, int gw, int lane) {
    const int total = (j.Npad / 64) * (j.K / 64) * j.batch;
    int it = (gw - base % NW + NW) % NW;
    if (it < total) {
        f32x4 cur[16], nxt[16];
        tt_load(j, it, lane, cur);
        for (; it < total; it += NW) {
            const bool more = it + NW < total;
            if (more) tt_load(j, it + NW, lane, nxt);
            tt_store(j, it, lane, cur, wt);
            if (more) {
#pragma unroll
                for (int i = 0; i < 16; ++i) cur[i] = nxt[i]; }
        }
    }
    base += total;
}
__device__ __forceinline__ void bt_load(const float* __restrict__ src, int N, int perm, int it, int ntn, f32x4 (&v)[8]) {
    const int wid = threadIdx.x >> 6, lane = threadIdx.x & 63;
    const int per = 16 * ntn, z = it / per, r = it % per, kt = r / ntn, nt = r % ntn;
    const int np = nt * 256 + lane * 4;
    const int sc = perm ? (nt * 128 + (lane & 31) * 4 + (lane >> 5) * 1024) : np;
    const float* p = src + (size_t)z * 1024 * N + (size_t)(kt * 64 + wid * 8) * N + sc;
#pragma unroll
    for (int i = 0; i < 8; ++i) v[i] = *(const f32x4*)(p + (size_t)i * N);
}
__device__ __forceinline__ void ph_big_transpose(const float* __restrict__ src, int N, int perm, int batch, bf16* __restrict__ dst, float* tile  , int G) {
    const int tid = threadIdx.x, wid = tid >> 6, lane = tid & 63, ntn = N / 256, total = batch * 16 * ntn;
    int it = (int)blockIdx.x;
    if (it >= total) return;
    f32x4 cur[8], nxt[8], nx2[8];
    bt_load(src, N, perm, it, ntn, cur);
    if (it + G < total) bt_load(src, N, perm, it + G, ntn, nxt);
    for (; it < total; it += G) {
        const bool more = it + G < total, more2 = it + 2 * G < total;
        if (more2) bt_load(src, N, perm, it + 2 * G, ntn, nx2);
        __syncthreads();
#pragma unroll
        for (int i = 0; i < 8; ++i) { float* t = tile + (wid * 8 + i) * 257 + lane * 4; t[0] = cur[i][0]; t[1] = cur[i][1]; t[2] = cur[i][2]; t[3] = cur[i][3]; }
        __syncthreads();
        const int per = 16 * ntn, z = it / per, r = it % per, kt = r / ntn, nt = r % ntn;
        bf16* d = dst + (size_t)z * N * 1024 + (((size_t)nt * 16 + kt) << 14);
        const int kc = lane & 7;
#pragma unroll
        for (int pss = 0; pss < 4; ++pss) {
            const int n = wid * 32 + pss * 8 + (lane >> 3); float f[8];
#pragma unroll
            for (int j = 0; j < 8; ++j) f[j] = tile[(kc * 8 + j) * 257 + n];
            u32x4 w; w.x = g8_cvt_pk(f[0], f[1]); w.y = g8_cvt_pk(f[2], f[3]); w.z = g8_cvt_pk(f[4], f[5]); w.w = g8_cvt_pk(f[6], f[7]);
            *(u32x4*)(d + n * 64 + kc * 8) = w;
        }
        if (more) {
#pragma unroll
            for (int i = 0; i < 8; ++i) { cur[i] = nxt[i]; nxt[i] = nx2[i]; } }
    }
    __syncthreads();
}
#ifndef PROBE_SUB
#define PROBE_SUB 0
#define PROBE_SUBDK 0
#endif
#define PSEC(k) do { if (PROBE_SUB == (k)) { const unsigned t_ = (unsigned)__builtin_readcyclecounter(); sacc += t_ - pt0; } if (PROBE_SUB >= 10) pt0 = (unsigned)__builtin_readcyclecounter(); } while (0)
__device__ __forceinline__ void ph_prologue(const Ptrs& P, unsigned char* lds, unsigned& sacc) {
    unsigned char* ws = P.ws; const int G = gridDim.x; int base = 0; unsigned pt0 = 0u; PSEC(-1);
    const int wave = threadIdx.x >> 6, lane = threadIdx.x & 63, NW = G * 8, gw = (int)blockIdx.x + G * wave;
    float* wt = (float*)lds + wave * (32 * 68);
    {
        float* s = (float*)lds + 8 * 32 * 68;
        float* part = s + 5 * 1024;
        for (int it = (int)blockIdx.x; it < 2 * 128; it += G) {
            const int layer = it / 128, cb = (it % 128) * 48;
            __syncthreads();
            for (int i = threadIdx.x; i < 5 * 1024; i += NT) { const int r = i / 1024, k = i % 1024; const float c = r < 4 ? P.in[1][r * 1024 + k] : P.in[3][k]; s[i] = c / (1.f + __expf(-c)); }
            __syncthreads();
            const int kr = lane >> 4, c4 = (lane & 15) < 12 ? (lane & 15) * 4 : 44;
            const float* w = P.in[4] + (size_t)layer * 1024 * 6144 + (size_t)(wave * 128 + kr) * 6144 + cb + c4;
            float a[5][4];
#pragma unroll
            for (int r = 0; r < 5; ++r) { a[r][0] = 0.f; a[r][1] = 0.f; a[r][2] = 0.f; a[r][3] = 0.f; }
#pragma unroll 1
            for (int hh = 0; hh < 2; ++hh) {
                f32x4 wv[16];
#pragma unroll
                for (int i = 0; i < 16; ++i) wv[i] = *(const f32x4*)(w + (size_t)(hh * 64 + i * 4) * 6144);
#pragma unroll
                for (int i = 0; i < 16; ++i) { const int k = wave * 128 + hh * 64 + i * 4 + kr;
#pragma unroll
                    for (int r = 0; r < 5; ++r) { const float sv = s[r * 1024 + k]; a[r][0] += sv * wv[i][0]; a[r][1] += sv * wv[i][1]; a[r][2] += sv * wv[i][2]; a[r][3] += sv * wv[i][3]; } }
            }
#pragma unroll
            for (int r = 0; r < 5; ++r)
#pragma unroll
                for (int e = 0; e < 4; ++e) { float t = a[r][e]; t += __shfl_xor(t, 16); t += __shfl_xor(t, 32); if (lane < 12) part[(wave * 5 + r) * 64 + c4 + e] = t; }
            __syncthreads();
            if (threadIdx.x < 320 && (threadIdx.x & 63) < 48) { const int r = threadIdx.x / 64, c = threadIdx.x % 64; float t = P.in[5][layer * 6144 + cb + c];
#pragma unroll
                for (int wv = 0; wv < 8; ++wv) t += part[(wv * 5 + r) * 64 + c];
                ((float*)(ws + WS_MOD))[(size_t)(layer * 5 + r) * 6144 + cb + c] = t; }
        }
        __syncthreads();
    }
    PSEC(10);
    TJob j;
    ph_big_transpose(P.in[34], 2048, 1, 2 * NE, (bf16*)(ws + WS_WGU), (float*)lds, G);
    PSEC(11);
    ph_big_transpose(P.in[36], 1024, 0, 2 * NE, (bf16*)(ws + WS_WDN), (float*)lds, G);
    PSEC(12);
    j = TJob{P.in[8], (bf16*)(ws + WS_WEVIN), nullptr, 1024, EVEN_IN, EVEN_IN_P, 0, 1, 0, 0, 1024}; run_tjob(j, wt, base, NW, gw, lane);
    j = TJob{P.in[9], (bf16*)(ws + WS_WEVOUT), nullptr, 1024, 1024, 1024, 0, 1, 0, 0, 1024}; run_tjob(j, wt, base, NW, gw, lane);
    j = TJob{P.in[18], (bf16*)(ws + WS_WUQ), P.in[17], 384, 768, 768, 0, 1, 0, 0, 384}; run_tjob(j, wt, base, NW, gw, lane);
    j = TJob{P.in[20], (bf16*)(ws + WS_WUKV), P.in[19], 384, 1024, 1024, 0, 1, 0, 0, 256}; run_tjob(j, wt, base, NW, gw, lane);
    j = TJob{P.in[12], (bf16*)(ws + WS_WLRU), nullptr, 64, 64, 64, 0, 8, 4096, 4096, 64}; run_tjob(j, wt, base, NW, gw, lane);
    j = TJob{P.in[14], (bf16*)(ws + WS_WLRU) + 8 * 4096, nullptr, 64, 64, 64, 0, 8, 4096, 4096, 64}; run_tjob(j, wt, base, NW, gw, lane);
    j = TJob{P.in[12] + 8 * 4096, (bf16*)(ws + WS_WLRU) + 16 * 4096, nullptr, 64, 64, 64, 0, 8, 4096, 4096, 64}; run_tjob(j, wt, base, NW, gw, lane);
    j = TJob{P.in[14] + 8 * 4096, (bf16*)(ws + WS_WLRU) + 24 * 4096, nullptr, 64, 64, 64, 0, 8, 4096, 4096, 64}; run_tjob(j, wt, base, NW, gw, lane);
    j = TJob{P.in[23], (bf16*)(ws + WS_WODIN), nullptr, 1024, ODD_IN, ODD_IN, 0, 1, 0, 0, 1024}; run_tjob(j, wt, base, NW, gw, lane);
    j = TJob{P.in[24], (bf16*)(ws + WS_WODOUT), nullptr, 1024, 1024, 1024, 0, 1, 0, 0, 1024}; run_tjob(j, wt, base, NW, gw, lane);
    __syncthreads();
    PSEC(13);
    {
        float* rc = (float*)(ws + WS_ROPE); float* rs = rc + SEQ * 64;
        for (int i = (int)blockIdx.x * NT + threadIdx.x; i < SEQ * 64; i += G * NT) {
            const int t = i >> 6, e = i & 63, q = e & 15;
            const float f = exp2f(-(float)(2 * q) / 32.f * 13.287712379549449f);
            const float ang = (float)((e >> 5) ? (t % GRID_W) : (t / GRID_W)) * f;
            float sv, cv; sincosf(ang, &sv, &cv); rc[i] = cv; rs[i] = sv;
        }
    }
    if ((int)blockIdx.x == G - 2) { float* c8t = (float*)(ws + WS_SCAL) + 1024; for (int i = threadIdx.x; i < 2 * LRU_W; i += NT) c8t[i] = 8.f * LOG2E * log1pf(__expf(-P.in[16][i])); }
    if ((int)blockIdx.x == G - 1 && threadIdx.x == 0) {
        float* sc = (float*)(ws + WS_SCAL);
        float mq = 0, mk = 0;
        for (int i = 0; i < 192; ++i) { mq = fmaxf(mq, fabsf(P.in[21][i])); mk = fmaxf(mk, fabsf(P.in[22][i])); }
        sc[0] = sqrtf(192.f) * mq * mk * LOG2E;
        mq = 0; mk = 0;
        for (int i = 0; i < 64; ++i) { mq = fmaxf(mq, fabsf(P.in[25][i])); mk = fmaxf(mk, fabsf(P.in[26][i])); }
        sc[1] = 8.f * mq * mk * LOG2E;
        float s1 = 0, s2 = 0;
        for (int i = 0; i < 64; ++i) { s1 += P.in[27][i] * P.in[28][i]; s2 += P.in[29][i] * P.in[30][i]; }
        const float lam_init = 0.8f - 0.6f * expf(-0.3f * 1.f);
        sc[2] = expf(s1) - expf(s2) + lam_init;
        sc[3] = 1.f - lam_init;
    }
}

__device__ __forceinline__ void norm_mod_store(const Ptrs& P, float (&v)[16], int lane, int u, int layer, int which) {
    const float* g = (which == 0 ? P.in[6] : P.in[7]) + layer * D;
    const float* md = mod_row(P, layer, u) + (which == 0 ? 0 : 3 * D);
    float ss = 0.f;
#pragma unroll
    for (int i = 0; i < 16; ++i) ss += v[i] * v[i];
    const float rstd = rsqrtf(wave_sum(ss) * (1.f / D) + EPS);
    bf16* h = (bf16*)(P.ws + WS_H) + (size_t)u * D;
#pragma unroll
    for (int j = 0; j < 4; ++j) {
        const int c = j * 256 + lane * 4;
        const f32x4 gv = *(const f32x4*)(g + c), scv = *(const f32x4*)(md + D + c), shv = *(const f32x4*)(md + c);
#pragma unroll
        for (int e = 0; e < 4; ++e) v[4 * j + e] = v[4 * j + e] * rstd * gv[e] * (1.f + scv[e]) + shv[e];
        const unsigned lo = f2bf(v[4 * j]) | ((unsigned)f2bf(v[4 * j + 1]) << 16), hi = f2bf(v[4 * j + 2]) | ((unsigned)f2bf(v[4 * j + 3]) << 16);
        *(uint2*)(h + c) = make_uint2(lo, hi);
    }
}
__device__ __forceinline__ void ph_rows(const Ptrs& P, int layer, int mode, int latent_only, int next_norm) {
    const int wave = threadIdx.x >> 6, lane = threadIdx.x & 63, G = gridDim.x;
    for (int u = (int)blockIdx.x * 8 + wave; u < R; u += G * 8) {
        if (latent_only && (u % SU) < CTX) continue;
        float v[16];
        if (mode == 0) { const float* x = res_in_row(P, layer, u);
#pragma unroll
            for (int j = 0; j < 4; ++j) { const f32x4 t = *(const f32x4*)(x + j * 256 + lane * 4); v[4 * j] = t[0]; v[4 * j + 1] = t[1]; v[4 * j + 2] = t[2]; v[4 * j + 3] = t[3]; } }
        else { const bf16* x = (const bf16*)(P.ws + WS_XB) + (size_t)u * D;
#pragma unroll
            for (int j = 0; j < 4; ++j) { const uint2 t = *(const uint2*)(x + j * 256 + lane * 4); v[4 * j] = __uint_as_float(t.x << 16); v[4 * j + 1] = __uint_as_float(t.x & 0xffff0000u); v[4 * j + 2] = __uint_as_float(t.y << 16); v[4 * j + 3] = __uint_as_float(t.y & 0xffff0000u); } }
        if (mode == 2) {
            const float* g2 = mod_row(P, layer, u) + 5 * D; float* xo = res_out_row(P, u); bf16* xbo = (bf16*)(P.ws + WS_XB) + (size_t)u * D;
            const bf16* y = (const bf16*)(P.ws + WS_Y) + (size_t)u * 4 * 1024;
#pragma unroll
            for (int j = 0; j < 4; ++j) { const int c = j * 256 + lane * 4; const f32x4 gv = *(const f32x4*)(g2 + c); f32x4 o;
#pragma unroll
                for (int e = 0; e < 4; ++e) { const float f = bf2f(y[c + e]) + bf2f(y[1024 + c + e]) + bf2f(y[2048 + c + e]) + bf2f(y[3072 + c + e]); v[4 * j + e] += gv[e] * f; o[e] = v[4 * j + e]; }
                if (next_norm) { uint2 w; w.x = g8_cvt_pk(o[0], o[1]); w.y = g8_cvt_pk(o[2], o[3]); *(uint2*)(xbo + c) = w; }
                else *(f32x4*)(xo + c) = o; }
            if (next_norm) norm_mod_store(P, v, lane, u, layer + 1, 0);
        } else {
            norm_mod_store(P, v, lane, u, layer, mode);
        }
    }
}

namespace g8 {
typedef short bf16x8 __attribute__((ext_vector_type(8)));
constexpr int BM = 256, BK = 64, HALF = 128, HTB = HALF * BK * 2, STAGE_BYTES = 8 * HTB, NXCD = 8, WGM = 8;
__host__ __device__ __forceinline__ int lds_byte(int r, int c) { const int st = (r >> 4) * 2 + (c >> 5), rr = r & 15, cc = c & 31, ob = rr * 64 + cc * 2; return st * 1024 + (ob ^ (((ob >> 9) & 1) << 5)); }
__host__ __device__ __forceinline__ void stage_rc(int b, int& R, int& C) { const int st = b / 1024, sb = b % 1024, swz = sb ^ (((sb >> 9) & 1) << 5); R = (st >> 1) * 16 + swz / 64; C = (st & 1) * 32 + (swz % 64) / 2; }
__host__ __device__ __forceinline__ int perm32(int rho) { const int n = rho >> 4, i = rho & 15; return 8 * (i >> 2) + 4 * n + (i & 3); }
struct Unit { const char* a; const char* b; int pm, pn, e, aux, cnt; };
__device__ __forceinline__ unsigned cvt_pk_bf16(float lo, float hi) { unsigned r; asm volatile("v_cvt_pk_bf16_f32 %0, %1, %2" : "=v"(r) : "v"(lo), "v"(hi)); return r; }

template <class Epi, class Sched, bool GATHER, bool ALIGN_EPI, bool PFB = false>
__device__ __forceinline__ void gemm_phase(LAS unsigned char* lds, const int lda, const int K, const Sched& S, const Epi& E) {
    const int tid = threadIdx.x, wid = __builtin_amdgcn_readfirstlane(tid >> 6), lane = tid & 63, wr = wid >> 2, wc = wid & 3, fr = lane & 15, fq = lane >> 4;
    const int nt = K / BK;
    int Rr[2], Cc[2]; unsigned voffB[2];
#pragma unroll
    for (int i = 0; i < 2; ++i) { stage_rc(tid * 16 + i * 8192, Rr[i], Cc[i]); const int Rb = Epi::PERM ? ((Rr[i] & ~31) + perm32(Rr[i] & 31)) : Rr[i]; voffB[i] = (unsigned)(Rb * BK + Cc[i]) * 2u; }
    const size_t kstep = (size_t)(BK * 2), kstepB = (size_t)BM * BK * 2;
    const size_t hstepB = (size_t)HALF * BK * 2;
    const unsigned ldsw = (unsigned)wid * 1024u;
    const int aoff = lds_byte(wr * 64 + fr, fq * 8), boff = lds_byte(wc * 32 + fr, fq * 8);
#define G8_SA(b, h) (((b) * 2 + (h)) * HTB)
#define G8_SB(b, h) ((4 + (b) * 2 + (h)) * HTB)
#define G8_STAGE(bufoff, gbase, v0, v1) do { \
        __builtin_amdgcn_global_load_lds((const unsigned*)((const char*)(gbase) + (v0)), (LAS unsigned*)(lds + (bufoff) + ldsw), 16, 0, 0); \
        __builtin_amdgcn_global_load_lds((const unsigned*)((const char*)(gbase) + (v1)), (LAS unsigned*)(lds + (bufoff) + ldsw + 8192), 16, 0, 0); } while (0)
#define G8_LDA(dst, b, h) do { _Pragma("unroll") for (int m = 0; m < 4; ++m) _Pragma("unroll") for (int k = 0; k < 2; ++k) dst[m][k] = *(const LAS bf16x8*)(lds + G8_SA(b, h) + aoff + m * 2048 + k * 1024); } while (0)
#define G8_LDB(dst, b, h) do { _Pragma("unroll") for (int n = 0; n < 2; ++n) _Pragma("unroll") for (int k = 0; k < 2; ++k) dst[n][k] = *(const LAS bf16x8*)(lds + G8_SB(b, h) + boff + n * 2048 + k * 1024); } while (0)
#define G8_MMA(ai, bj, At, Bt) do { __builtin_amdgcn_s_setprio(1); _Pragma("unroll") for (int m = 0; m < 4; ++m) _Pragma("unroll") for (int n = 0; n < 2; ++n) _Pragma("unroll") for (int k = 0; k < 2; ++k) \
        acc[ai][bj][m][n] = __builtin_amdgcn_mfma_f32_16x16x32_bf16(Bt[n][k], At[m][k], acc[ai][bj][m][n], 0, 0, 0); __builtin_amdgcn_s_setprio(0); } while (0)
#define G8_WAIT_V(n) asm volatile("s_waitcnt vmcnt(" #n ")" ::: "memory")
#define G8_WAIT_L(n) asm volatile("s_waitcnt lgkmcnt(" #n ")" ::: "memory")
#define G8_BAR __builtin_amdgcn_s_barrier()
#define G8_SCHED __builtin_amdgcn_sched_barrier(0)
    Unit cur, nxt; int ui = 0;
    if (!S.next(0, cur)) return;
    unsigned vA0[2], vA1[2], nA0[2], nA1[2];
#pragma unroll
    for (int i = 0; i < 2; ++i) {
        if (GATHER) { vA0[i] = S.arow_off(cur, Rr[i]) + (unsigned)Cc[i] * 2u; vA1[i] = S.arow_off(cur, HALF + Rr[i]) + (unsigned)Cc[i] * 2u; }
        else { vA0[i] = (unsigned)(Rr[i] * lda + Cc[i]) * 2u; vA1[i] = (unsigned)((HALF + Rr[i]) * lda + Cc[i]) * 2u; }
        nA0[i] = vA0[i]; nA1[i] = vA1[i];
    }
    f32x4 acc[2][2][4][2];
#pragma unroll
    for (int a = 0; a < 2; ++a)
#pragma unroll
        for (int b = 0; b < 2; ++b)
#pragma unroll
            for (int m = 0; m < 4; ++m)
#pragma unroll
                for (int n = 0; n < 2; ++n) acc[a][b][m][n] = (f32x4){0.f, 0.f, 0.f, 0.f};
    bf16x8 At[4][2], B0[2][2], B1[2][2];
    const char* cA = cur.a; const char* cB = cur.b;
    G8_STAGE(G8_SB(0, 0), cB, voffB[0], voffB[1]); G8_STAGE(G8_SB(0, 1), cB + hstepB, voffB[0], voffB[1]); G8_STAGE(G8_SA(0, 0), cA, vA0[0], vA0[1]); G8_STAGE(G8_SA(0, 1), cA, vA1[0], vA1[1]);
    if (wr == 1) G8_BAR;
    G8_WAIT_V(2); G8_BAR;
    G8_STAGE(G8_SB(1, 0), cB + kstepB, voffB[0], voffB[1]); G8_STAGE(G8_SA(1, 0), cA + kstep, vA0[0], vA0[1]); G8_STAGE(G8_SB(1, 1), cB + hstepB + kstepB, voffB[0], voffB[1]);
    G8_WAIT_V(6); G8_BAR;
    for (;;) {
        const bool has_next = S.next(ui + 1, nxt);
        const char* nA = has_next ? nxt.a : cA; const char* nB = has_next ? nxt.b : cB;
        unsigned pf_dummy = 0u;
        if (PFB && has_next && nB != cB) {
            const char* pb = nB + (size_t)tid * 128;
#pragma unroll
            for (int i = 0; i < 8; ++i) { if (i * NT * 128 < 256 * K * 2) asm volatile("global_load_dword %0, %1, off" : "+v"(pf_dummy) : "v"(pb + (size_t)i * NT * 128) : "memory"); }
        }
        if (GATHER) {
#pragma unroll
            for (int i = 0; i < 2; ++i) { if (has_next) { nA0[i] = S.arow_off(nxt, Rr[i]) + (unsigned)Cc[i] * 2u; nA1[i] = S.arow_off(nxt, HALF + Rr[i]) + (unsigned)Cc[i] * 2u; } else { nA0[i] = vA0[i]; nA1[i] = vA1[i]; } }
        }
#pragma unroll 1
        for (int t = 0; t < nt; t += 2) {
            const bool last = (t == nt - 2);
            const char* a1 = cA + (size_t)(t + 1) * kstep;
            const char* a2 = last ? nA : cA + (size_t)(t + 2) * kstep; const char* b2 = last ? nB : cB + (size_t)(t + 2) * kstepB;
            const char* a3 = a2 + kstep; const char* b3 = b2 + kstepB;
            unsigned x00 = vA0[0], x01 = vA0[1], x10 = vA1[0], x11 = vA1[1];
            if (GATHER) { x00 = last ? nA0[0] : vA0[0]; x01 = last ? nA0[1] : vA0[1]; x10 = last ? nA1[0] : vA1[0]; x11 = last ? nA1[1] : vA1[1]; }
            G8_LDB(B0, 0, 0); G8_LDB(B1, 0, 1); G8_SCHED; G8_LDA(At, 0, 0); G8_STAGE(G8_SA(1, 1), a1, vA1[0], vA1[1]);
            G8_WAIT_V(8); if (PFB) asm volatile("" : "+v"(pf_dummy)); G8_WAIT_L(0); G8_BAR; G8_MMA(0, 0, At, B0); G8_MMA(0, 1, At, B1); G8_BAR; G8_SCHED;
            G8_LDA(At, 0, 1); G8_STAGE(G8_SB(0, 0), b2, voffB[0], voffB[1]); G8_STAGE(G8_SB(0, 1), b2 + hstepB, voffB[0], voffB[1]); G8_STAGE(G8_SA(0, 0), a2, x00, x01);
            G8_WAIT_V(8); G8_WAIT_L(0); G8_BAR; G8_MMA(1, 0, At, B0); G8_MMA(1, 1, At, B1); G8_BAR; G8_SCHED;
            G8_LDB(B0, 1, 0); G8_LDB(B1, 1, 1); G8_SCHED; G8_LDA(At, 1, 0); G8_STAGE(G8_SA(0, 1), a2, x10, x11);
            G8_WAIT_V(8); G8_WAIT_L(0); G8_BAR; G8_MMA(0, 0, At, B0); G8_MMA(0, 1, At, B1); G8_BAR; G8_SCHED;
            G8_LDA(At, 1, 1); G8_STAGE(G8_SB(1, 0), b3, voffB[0], voffB[1]); G8_STAGE(G8_SB(1, 1), b3 + hstepB, voffB[0], voffB[1]); G8_STAGE(G8_SA(1, 0), a3, x00, x01);
            G8_WAIT_V(8); G8_WAIT_L(0); G8_BAR; G8_MMA(1, 0, At, B0); G8_MMA(1, 1, At, B1); G8_BAR; G8_SCHED;
        }
        if constexpr (ALIGN_EPI) { if (wr == 0) G8_BAR; }
        E(acc, cur, wr, wc, fr, fq);
        if (!has_next) break;
#pragma unroll
        for (int a = 0; a < 2; ++a)
#pragma unroll
            for (int b = 0; b < 2; ++b)
#pragma unroll
                for (int m = 0; m < 4; ++m)
#pragma unroll
                    for (int n = 0; n < 2; ++n) acc[a][b][m][n] = (f32x4){0.f, 0.f, 0.f, 0.f};
        cur = nxt; cA = nA; cB = nB; ++ui;
        if (GATHER) {
#pragma unroll
            for (int i = 0; i < 2; ++i) { vA0[i] = nA0[i]; vA1[i] = nA1[i]; }
        }
        if constexpr (ALIGN_EPI) { if (wr == 1) G8_BAR; }
    }
    G8_WAIT_V(0);
    if constexpr (!ALIGN_EPI) { if (wr == 0) G8_BAR; }
    G8_BAR;
#undef G8_SA
#undef G8_SB
#undef G8_STAGE
#undef G8_LDA
#undef G8_LDB
#undef G8_MMA
#undef G8_WAIT_V
#undef G8_WAIT_L
#undef G8_BAR
#undef G8_SCHED
}

struct DenseOrder {
    const char* A; const char* Bt; int lda, K, nM, nN, nwg, G, c, skip_ctx;
    __device__ __forceinline__ void init(const bf16* A_, int lda_, const bf16* Bt_, int K_, int M, int N, int G_, int c_, int skip_ctx_) {
        A = (const char*)A_; Bt = (const char*)Bt_; lda = lda_; K = K_; skip_ctx = skip_ctx_; nM = M / BM; if (skip_ctx) nM = nM / 17 * 16; nN = N / BM; nwg = nM * nN; G = G_; c = c_; }
    __device__ __forceinline__ bool next(int i, Unit& u) const {
        const long L = (long)i * G + c; if (L >= nwg) return false;
        int wgid = (int)L; { const int q = nwg / NXCD, r = nwg % NXCD, xcd = wgid % NXCD, off = wgid / NXCD; wgid = (xcd < r ? xcd * (q + 1) : r * (q + 1) + (xcd - r) * q) + off; }
        const int nig = WGM * nN, gid = wgid / nig, fm = gid * WGM, gsz = (nM - fm) < WGM ? (nM - fm) : WGM;
        int pm = fm + ((wgid % nig) % gsz); const int pn = (wgid % nig) / gsz;
        if (skip_ctx) pm = (pm / 16) * 17 + 1 + (pm % 16);
        u.pm = pm; u.pn = pn; u.e = 0; u.aux = 0; u.cnt = 0;
        u.a = A + (size_t)pm * BM * lda * 2; u.b = Bt + (size_t)pn * BM * K * 2; return true;
    }
    __device__ __forceinline__ unsigned arow_off(const Unit&, int) const { return 0u; }
};
}
namespace g8 {
struct MoeOrder {
    const char* Abase; const char* Bbase; const int* rowtab; size_t bstride; int nN, K, G, vcu, gather;
    LAS int* tab;
    __device__ __forceinline__ void init(const unsigned* cnt, LAS int* tab_) {
        tab = tab_;
        __syncthreads();
        if (threadIdx.x < 64) {
            const int lane = threadIdx.x, me = lane & 31;
            const int c = (int)cnt[me];
            int run = 0, ab = 0, ms = 0, mab = 0;
            for (int e = 0; e < NE; ++e) { const int ce = __builtin_amdgcn_readlane(c, e), mt = (ce + 255) >> 8; if (me == e) { ms = run; mab = ab; } run += mt * nN; ab += mt << 8; }
            if (lane < 32) { tab[lane] = ms; tab[32 + lane] = c; tab[64 + lane] = mab; }
            if (lane == 0) tab[96] = run;
        }
        __syncthreads();
    }
    __device__ __forceinline__ bool next(int i, Unit& u) const {
        const int L = i * G + vcu;
        if (L >= tab[96]) return false;
        const int me = threadIdx.x & 31;
        const int st_l = tab[me], c_l = tab[32 + me];
        const unsigned long long m = __ballot(L >= st_l && L < st_l + ((c_l + 255) >> 8) * nN);
        const int e = __builtin_amdgcn_readfirstlane(__builtin_ctzll(m) & 31);
        const int st = tab[e], c = tab[32 + e], ab = tab[64 + e];
        const int l = L - st;
        const int sh = nN == 8 ? 3 : 2;
        u.e = e; u.pm = l >> sh; u.pn = l & (nN - 1); u.aux = ab; u.cnt = c;
        u.a = gather ? Abase : Abase + (size_t)(ab + u.pm * 256) * 1024 * 2; u.b = Bbase + (size_t)e * bstride + (size_t)u.pn * 256 * K * 2; return true;
    }
    __device__ __forceinline__ unsigned arow_off(const Unit& u, int r) const { int rr = u.pm * 256 + r; rr = rr < u.cnt ? rr : u.cnt - 1; return (unsigned)rowtab[(size_t)u.e * R + rr] * (unsigned)(D * 2); }
};
struct UpOrder {
    const char* Z; const char* Wq; const char* Wkv; int G, c;
    __device__ __forceinline__ bool next(int i, Unit& u) const {
        const int L = i * G + c; if (L >= 476) return false;
        const int kv = L >= 204, l = kv ? L - 204 : L, pn = l / 68, pm = l % 68;
        u.pm = pm; u.pn = kv ? 3 + pn : pn; u.e = 0; u.aux = kv; u.cnt = 0;
        u.a = Z + ((size_t)pm * BM * EVEN_IN_P + 1024 + kv * 384) * 2; u.b = Wq + (size_t)u.pn * BM * 384 * 2; return true;
    }
    __device__ __forceinline__ unsigned arow_off(const Unit&, int) const { return 0u; }
};
struct EpiStoreBf16 {
    static constexpr bool PERM = true; bf16* C; int ldc;
    __device__ __forceinline__ void operator()(const f32x4 (&acc)[2][2][4][2], const Unit& u, int wr, int wc, int fr, int fq) const {
        const int row0 = u.pm * BM + wr * 64 + fr, col0 = u.pn * BM + wc * 32 + 8 * fq;
#pragma unroll
        for (int ai = 0; ai < 2; ++ai)
#pragma unroll
            for (int m = 0; m < 4; ++m) { bf16* rowp = C + (size_t)(row0 + ai * HALF + m * 16) * ldc + col0;
#pragma unroll
                for (int bj = 0; bj < 2; ++bj) { const f32x4 v0 = acc[ai][bj][m][0], v1 = acc[ai][bj][m][1];
                    u32x4 w; w.x = cvt_pk_bf16(v0[0], v0[1]); w.y = cvt_pk_bf16(v0[2], v0[3]); w.z = cvt_pk_bf16(v1[0], v1[1]); w.w = cvt_pk_bf16(v1[2], v1[3]);
                    *(u32x4*)(rowp + bj * HALF) = w; } }
    }
};
struct EpiDiffIn {
    static constexpr bool PERM = true; bf16* C; const float* qn; const float* kn; const float* rc; const float* rs; LAS float* xch  ;
    __device__ __forceinline__ void operator()(const f32x4 (&acc)[2][2][4][2], const Unit& u, int wr, int wc, int fr, int fq) const {
        const int row0 = u.pm * BM + wr * 64 + fr, col0 = u.pn * BM + wc * 32 + 8 * fq, wid = wr * 4 + wc;
        const bool isv = u.pn >= 8;
        float rstd[2][4][2];
#pragma unroll
        for (int ai = 0; ai < 2; ++ai)
#pragma unroll
            for (int m = 0; m < 4; ++m)
#pragma unroll
                for (int bj = 0; bj < 2; ++bj) { const f32x4 v0 = acc[ai][bj][m][0], v1 = acc[ai][bj][m][1];
                    float ss = v0[0] * v0[0] + v0[1] * v0[1] + v0[2] * v0[2] + v0[3] * v0[3] + v1[0] * v1[0] + v1[1] * v1[1] + v1[2] * v1[2] + v1[3] * v1[3];
                    ss += __shfl_xor(ss, 16); ss += __shfl_xor(ss, 32);
                    rstd[ai][m][bj] = ss;
                    if (fq == 0) xch[wid * 256 + ((ai * 4 + m) * 2 + bj) * 16 + fr] = ss; }
        asm volatile("s_waitcnt lgkmcnt(0)" ::: "memory"); __builtin_amdgcn_s_barrier(); asm volatile("" ::: "memory");
#pragma unroll
        for (int ai = 0; ai < 2; ++ai)
#pragma unroll
            for (int m = 0; m < 4; ++m)
#pragma unroll
                for (int bj = 0; bj < 2; ++bj) rstd[ai][m][bj] = rsqrtf((rstd[ai][m][bj] + xch[(wid ^ 1) * 256 + ((ai * 4 + m) * 2 + bj) * 16 + fr]) * (1.f / 64.f) + EPS);
        const int e0 = (wc & 1) * 32 + 8 * fq;
        const float* gn = u.pn < 4 ? qn : kn; const float qs = u.pn < 4 ? 0.125f * LOG2E : 1.f;
        f32x4 g0 = *(const f32x4*)(gn + e0), g1 = *(const f32x4*)(gn + e0 + 4);
        g0 = g0 * qs; g1 = g1 * qs;
        const float sgn = (fq & 2) ? 1.f : -1.f;
        const int jt = u.pm % 17; const bool latent = jt != 0;
#pragma unroll
        for (int ai = 0; ai < 2; ++ai)
#pragma unroll
            for (int m = 0; m < 4; ++m) { const int r = row0 + ai * HALF + m * 16; bf16* rowp = C + (size_t)r * ODD_IN + col0;
                f32x4 c0 = {1.f, 1.f, 1.f, 1.f}, c1 = c0, s0 = {0.f, 0.f, 0.f, 0.f}, s1 = s0;
                if (!isv && latent) { const int t = (jt - 1) * 256 + ai * HALF + wr * 64 + m * 16 + fr;
                    c0 = *(const f32x4*)(rc + t * 64 + e0); c1 = *(const f32x4*)(rc + t * 64 + e0 + 4); s0 = *(const f32x4*)(rs + t * 64 + e0); s1 = *(const f32x4*)(rs + t * 64 + e0 + 4); }
#pragma unroll
                for (int bj = 0; bj < 2; ++bj) { f32x4 v0 = acc[ai][bj][m][0], v1 = acc[ai][bj][m][1];
                    if (!isv) { const float rr = rstd[ai][m][bj]; v0 = v0 * rr * g0; v1 = v1 * rr * g1;
                        f32x4 o0, o1;
#pragma unroll
                        for (int j = 0; j < 4; ++j) { o0[j] = __shfl_xor(v0[j], 32); o1[j] = __shfl_xor(v1[j], 32); }
                        v0 = v0 * c0 + o0 * s0 * sgn; v1 = v1 * c1 + o1 * s1 * sgn; }
                    u32x4 w; w.x = cvt_pk_bf16(v0[0], v0[1]); w.y = cvt_pk_bf16(v0[2], v0[3]); w.z = cvt_pk_bf16(v1[0], v1[1]); w.w = cvt_pk_bf16(v1[2], v1[3]);
                    *(u32x4*)(rowp + bj * HALF) = w; } }
        asm volatile("s_waitcnt lgkmcnt(0)" ::: "memory"); __builtin_amdgcn_s_barrier(); asm volatile("" ::: "memory");
    }
};
struct EpiOut {
    static constexpr bool PERM = true; Ptrs P; int layer;
    __device__ __forceinline__ void operator()(const f32x4 (&acc)[2][2][4][2], const Unit& u, int wr, int wc, int fr, int fq) const {
        const int b = u.pm / 17, jt = u.pm % 17;
        const float* g1 = (const float*)(P.ws + WS_MOD) + (size_t)(layer * 5 + (jt == 0 ? 4 : b)) * 6144 + 2 * D;
        const float* in0 = jt == 0 ? P.in[2] + (size_t)(b * CTX) * D : P.in[0] + (size_t)(b * SEQ + (jt - 1) * 256) * D;
        bf16* xb0 = (bf16*)(P.ws + WS_XB) + (size_t)u.pm * BM * D;
        const int col0 = u.pn * BM + wc * 32 + 8 * fq;
        f32x4 gv[2][2];
#pragma unroll
        for (int bj = 0; bj < 2; ++bj)
#pragma unroll
            for (int n = 0; n < 2; ++n) gv[bj][n] = *(const f32x4*)(g1 + col0 + bj * HALF + 4 * n);
#pragma unroll
        for (int ai = 0; ai < 2; ++ai)
#pragma unroll
            for (int m = 0; m < 4; ++m) { const size_t off = (size_t)(ai * HALF + wr * 64 + m * 16 + fr) * D + col0;
#pragma unroll
                for (int bj = 0; bj < 2; ++bj) {
                    f32x4 x0, x1;
                    if (layer == 0) { x0 = *(const f32x4*)(in0 + off + bj * HALF); x1 = *(const f32x4*)(in0 + off + bj * HALF + 4); }
                    else { const u32x4 r = *(const u32x4*)(xb0 + off + bj * HALF);
                        x0 = (f32x4){__uint_as_float(r.x << 16), __uint_as_float(r.x & 0xffff0000u), __uint_as_float(r.y << 16), __uint_as_float(r.y & 0xffff0000u)};
                        x1 = (f32x4){__uint_as_float(r.z << 16), __uint_as_float(r.z & 0xffff0000u), __uint_as_float(r.w << 16), __uint_as_float(r.w & 0xffff0000u)}; }
                    const f32x4 v0 = x0 + gv[bj][0] * acc[ai][bj][m][0], v1 = x1 + gv[bj][1] * acc[ai][bj][m][1];
                    u32x4 w; w.x = cvt_pk_bf16(v0[0], v0[1]); w.y = cvt_pk_bf16(v0[2], v0[3]); w.z = cvt_pk_bf16(v1[0], v1[1]); w.w = cvt_pk_bf16(v1[2], v1[3]);
                    *(u32x4*)(xb0 + off + bj * HALF) = w; } }
    }
};
struct EpiMoe1 {
    static constexpr bool PERM = true; Ptrs P; int layer;
    __device__ __forceinline__ void operator()(const f32x4 (&acc)[2][2][4][2], const Unit& u, int wr, int wc, int fr, int fq) const {
        const float* bgu = P.in[35] + (size_t)(layer * NE + u.e) * 2048;
        const int cl = u.pn * 128 + wc * 32 + 8 * fq;
        f32x4 bg[2], bu[2];
#pragma unroll
        for (int n = 0; n < 2; ++n) { bg[n] = *(const f32x4*)(bgu + cl + 4 * n); bu[n] = *(const f32x4*)(bgu + 1024 + cl + 4 * n); }
        bf16* act = (bf16*)(P.ws + WS_ACT) + (size_t)(u.aux + u.pm * 256 + wr * 64 + fr) * 1024 + cl;
#pragma unroll
        for (int ai = 0; ai < 2; ++ai)
#pragma unroll
            for (int m = 0; m < 4; ++m) { float o[8];
#pragma unroll
                for (int n = 0; n < 2; ++n)
#pragma unroll
                    for (int j = 0; j < 4; ++j) { float g = acc[ai][0][m][n][j] + bg[n][j], uu = acc[ai][1][m][n][j] + bu[n][j];
                        g = fminf(g, 7.f); uu = fminf(fmaxf(uu, -7.f), 7.f);
                        const float sg = __builtin_amdgcn_rcpf(1.f + __expf(-1.702f * g)); o[n * 4 + j] = (uu + 1.f) * g * sg; }
                u32x4 w; w.x = cvt_pk_bf16(o[0], o[1]); w.y = cvt_pk_bf16(o[2], o[3]); w.z = cvt_pk_bf16(o[4], o[5]); w.w = cvt_pk_bf16(o[6], o[7]);
                *(u32x4*)(act + (size_t)(ai * HALF + m * 16) * 1024) = w; }
    }
};
struct EpiMoe2 {
    static constexpr bool PERM = true; Ptrs P; int layer;
    __device__ __forceinline__ void operator()(const f32x4 (&acc)[2][2][4][2], const Unit& u, int wr, int wc, int fr, int fq) const {
        const float* bd = P.in[37] + (size_t)(layer * NE + u.e) * 1024;
        const int col0 = u.pn * BM + wc * 32 + 8 * fq;
        f32x4 bv[2][2];
#pragma unroll
        for (int bj = 0; bj < 2; ++bj)
#pragma unroll
            for (int n = 0; n < 2; ++n) bv[bj][n] = *(const f32x4*)(bd + col0 + bj * HALF + 4 * n);
        const int* pair_of = (const int*)(P.ws + WS_PAIROF) + (size_t)u.e * R; const float* gate_of = (const float*)(P.ws + WS_GATEOF) + (size_t)u.e * R;
        bf16* Y = (bf16*)(P.ws + WS_Y);
#pragma unroll
        for (int ai = 0; ai < 2; ++ai)
#pragma unroll
            for (int m = 0; m < 4; ++m) { const int r = u.pm * 256 + ai * HALF + wr * 64 + m * 16 + fr;
                if (r < u.cnt) { const int pair = pair_of[r]; const float gw = gate_of[r]; bf16* rowp = Y + (size_t)pair * 1024 + col0;
#pragma unroll
                    for (int bj = 0; bj < 2; ++bj) { const f32x4 v0 = (acc[ai][bj][m][0] + bv[bj][0]) * gw, v1 = (acc[ai][bj][m][1] + bv[bj][1]) * gw;
                        u32x4 w; w.x = cvt_pk_bf16(v0[0], v0[1]); w.y = cvt_pk_bf16(v0[2], v0[3]); w.z = cvt_pk_bf16(v1[0], v1[1]); w.w = cvt_pk_bf16(v1[2], v1[3]);
                        *(u32x4*)(rowp + bj * HALF) = w; } } }
    }
};
}

__device__ __forceinline__ int bwd_pos(int c) { return c < 2 ? 1 - c : 2 + (NCH - 1 - c); }
__device__ __forceinline__ int bwd_chunk_at(int p) { return p < 2 ? 1 - p : NCH - 1 - (p - 2); }
__device__ __forceinline__ float fsigmoid(float x) { return __builtin_amdgcn_rcpf(1.f + __builtin_amdgcn_exp2f(-LOG2E * x)); }
__device__ __forceinline__ void lru_item_mfma(const Ptrs& P, unsigned char* lds, int mode, int n, int c, int b) {
    typedef short bf16x8 __attribute__((ext_vector_type(8)));
    float* X = (float*)lds;
    unsigned char* XB = lds + 128 * 68 * 4;
    float* SEG = (float*)(lds + 128 * 68 * 4 + 16384);
    float* CAR = SEG + 2 * 8 * 64 * 2;
    const int tid = threadIdx.x, wid = tid >> 6, lane = tid & 63, fr = lane & 15, fq = lane >> 4;
    const int j0 = c * CHUNK, seg_lo = (c < 2) ? 0 : CTX, seg_hi = (c < 2) ? CTX : SU;
    const bf16* Z = (const bf16*)(P.ws + WS_Z);
    const float* cw = P.in[10]; const float* cb = P.in[11];
    float* agg = (float*)(P.ws + WS_AGG);
    __syncthreads();
#pragma unroll
    for (int q = 0; q < 2; ++q) {
        const int p = tid + q * NT, t = p >> 3, c8 = (p & 7) * 8, cg = n * 64 + c8;
        float acc[8];
        { const f32x4 b0 = *(const f32x4*)(cb + cg), b1 = *(const f32x4*)(cb + cg + 4);
#pragma unroll
          for (int e = 0; e < 4; ++e) { acc[e] = b0[e]; acc[4 + e] = b1[e]; } }
#pragma unroll
        for (int k = 0; k < 4; ++k) {
            const int j = j0 + t - 2 + k; const bool ok = j >= seg_lo && j < seg_hi; const int jj = ok ? j : j0 + t;
            const u32x4 raw = *(const u32x4*)(Z + (size_t)(b * SU + jj) * EVEN_IN_P + 512 + cg);
            const f32x4 w0 = *(const f32x4*)(cw + k * LRU_W + cg), w1 = *(const f32x4*)(cw + k * LRU_W + cg + 4);
            const float m = ok ? 1.f : 0.f;
#pragma unroll
            for (int e = 0; e < 4; ++e) { const float lo = __uint_as_float(raw[e] << 16), hi = __uint_as_float(raw[e] & 0xffff0000u);
                const float wl = (e < 2 ? w0[2 * e] : w1[2 * e - 4]) * m, wh = (e < 2 ? w0[2 * e + 1] : w1[2 * e - 3]) * m;
                acc[2 * e] += wl * lo; acc[2 * e + 1] += wh * hi; }
        }
        *(f32x4*)(X + t * 68 + c8) = (f32x4){acc[0], acc[1], acc[2], acc[3]}; *(f32x4*)(X + t * 68 + c8 + 4) = (f32x4){acc[4], acc[5], acc[6], acc[7]};
        u32x4 w; w.x = g8::cvt_pk_bf16(acc[0], acc[1]); w.y = g8::cvt_pk_bf16(acc[2], acc[3]); w.z = g8::cvt_pk_bf16(acc[4], acc[5]); w.w = g8::cvt_pk_bf16(acc[6], acc[7]);
        *(u32x4*)(XB + t * 128 + (((c8 >> 3) ^ ((t >> 1) & 7)) << 4)) = w;
    }
    if (mode == 1 && wid < 2) {
        const int dir = wid, pos = dir == 0 ? c : bwd_pos(c); float h = 0.f;
        for (int p = 0; p < pos; ++p) { const int cc = dir == 0 ? p : bwd_chunk_at(p); const float2 ag = *(const float2*)(agg + ((((size_t)b * NCH + cc) * 2 + dir) * 512 + n * 64 + lane) * 2); h = ag.x * h + ag.y; }
        CAR[dir * 64 + lane] = h;
    }
    __syncthreads();
    const int trow = 16 * wid + fr;
    const bf16x8 af0 = *(const bf16x8*)(XB + trow * 128 + ((fq ^ ((trow >> 1) & 7)) << 4));
    const bf16x8 af1 = *(const bf16x8*)(XB + trow * 128 + (((4 + fq) ^ ((trow >> 1) & 7)) << 4));
    float av[2][4][4], uv[2][4][4], Ae[2][4], He[2][4];
#pragma unroll
    for (int dir = 0; dir < 2; ++dir) {
        const bf16* wa = (const bf16*)(P.ws + WS_WLRU) + ((size_t)(dir * 2 + 0) * 8 + n) * 4096;
        const bf16* wx = (const bf16*)(P.ws + WS_WLRU) + ((size_t)(dir * 2 + 1) * 8 + n) * 4096;
#pragma unroll
        for (int ct = 0; ct < 4; ++ct) {
            const int e = 16 * ct + fr;
            const bf16x8 wa0 = *(const bf16x8*)(wa + e * 64 + 8 * fq), wa1 = *(const bf16x8*)(wa + e * 64 + 32 + 8 * fq);
            const bf16x8 wx0 = *(const bf16x8*)(wx + e * 64 + 8 * fq), wx1 = *(const bf16x8*)(wx + e * 64 + 32 + 8 * fq);
            f32x4 ga = {0.f, 0.f, 0.f, 0.f}, gx = {0.f, 0.f, 0.f, 0.f};
            ga = __builtin_amdgcn_mfma_f32_16x16x32_bf16(af0, wa0, ga, 0, 0, 0); ga = __builtin_amdgcn_mfma_f32_16x16x32_bf16(af1, wa1, ga, 0, 0, 0);
            gx = __builtin_amdgcn_mfma_f32_16x16x32_bf16(af0, wx0, gx, 0, 0, 0); gx = __builtin_amdgcn_mfma_f32_16x16x32_bf16(af1, wx1, gx, 0, 0, 0);
            const int cgl = dir * LRU_W + n * 64 + e;
            const float bav = P.in[13][cgl], bxv = P.in[15][cgl], c8 = ((const float*)(P.ws + WS_SCAL))[1024 + cgl];
#pragma unroll
            for (int j = 0; j < 4; ++j) {
                const float r = fsigmoid(ga[j] + bav), ig = fsigmoid(gx[j] + bxv);
                const float a = __builtin_amdgcn_exp2f(-c8 * r);
                av[dir][ct][j] = a; uv[dir][ct][j] = sqrtf(fmaxf(1.f - a * a, 0.f)) * ig * X[(16 * wid + 4 * fq + j) * 68 + e];
            }
            float Al = av[dir][ct][0] * av[dir][ct][1] * av[dir][ct][2] * av[dir][ct][3], Hl;
            if (dir == 0) Hl = ((uv[dir][ct][0] * av[dir][ct][1] + uv[dir][ct][1]) * av[dir][ct][2] + uv[dir][ct][2]) * av[dir][ct][3] + uv[dir][ct][3];
            else Hl = ((uv[dir][ct][3] * av[dir][ct][2] + uv[dir][ct][2]) * av[dir][ct][1] + uv[dir][ct][1]) * av[dir][ct][0] + uv[dir][ct][0];
            const int pq = dir == 0 ? fq : 3 - fq;
            {
                const int src = dir == 0 ? lane - 16 : lane + 16; const float Ap = __shfl(Al, src & 63), Hp = __shfl(Hl, src & 63);
                if (pq >= 1) { Hl = Al * Hp + Hl; Al = Al * Ap; }
            }
            {
                const int src = dir == 0 ? lane - 32 : lane + 32; const float Ap = __shfl(Al, src & 63), Hp = __shfl(Hl, src & 63);
                if (pq >= 2) { Hl = Al * Hp + Hl; Al = Al * Ap; }
            }
            {
                const int src = dir == 0 ? lane - 16 : lane + 16; const float Ap = __shfl(Al, src & 63), Hp = __shfl(Hl, src & 63);
                Ae[dir][ct] = pq >= 1 ? Ap : 1.f; He[dir][ct] = pq >= 1 ? Hp : 0.f;
            }
            if (pq == 3) { float2 sv; sv.x = Al; sv.y = Hl; *(float2*)(SEG + ((dir * 8 + wid) * 64 + e) * 2) = sv; }
        }
    }
    __syncthreads();
    float hs[4][4];
#pragma unroll
    for (int ct = 0; ct < 4; ++ct)
#pragma unroll
        for (int j = 0; j < 4; ++j) hs[ct][j] = 0.f;
#pragma unroll
    for (int dir = 0; dir < 2; ++dir) {
#pragma unroll
        for (int ct = 0; ct < 4; ++ct) {
            const int e = 16 * ct + fr;
            if (mode == 0) {
                if (wid == 0 && fq == 0) {
                    float Ac = 1.f, Hc = 0.f;
                    for (int s = 0; s < 8; ++s) { const int sg = dir == 0 ? s : 7 - s; const float2 sv = *(const float2*)(SEG + ((dir * 8 + sg) * 64 + e) * 2); Hc = sv.x * Hc + sv.y; Ac *= sv.x; }
                    float2 o; o.x = Ac; o.y = Hc; *(float2*)(agg + ((((size_t)b * NCH + c) * 2 + dir) * 512 + n * 64 + e) * 2) = o;
                }
            } else {
                float h = CAR[dir * 64 + e];
                const int nprev = dir == 0 ? wid : 7 - wid;
                for (int s = 0; s < nprev; ++s) { const int sg = dir == 0 ? s : 7 - s; const float2 sv = *(const float2*)(SEG + ((dir * 8 + sg) * 64 + e) * 2); h = sv.x * h + sv.y; }
                h = Ae[dir][ct] * h + He[dir][ct];
                if (dir == 0) {
#pragma unroll
                    for (int j = 0; j < 4; ++j) { h = av[dir][ct][j] * h + uv[dir][ct][j]; hs[ct][j] += h; }
                } else {
#pragma unroll
                    for (int j = 3; j >= 0; --j) { h = av[dir][ct][j] * h + uv[dir][ct][j]; hs[ct][j] += h; }
                }
            }
        }
    }
    if (mode == 1) {
#pragma unroll
        for (int ct = 0; ct < 4; ++ct)
#pragma unroll
            for (int j = 0; j < 4; ++j) X[(16 * wid + 4 * fq + j) * 68 + 16 * ct + fr] = hs[ct][j];
        __syncthreads();
        bf16* mix = (bf16*)(P.ws + WS_MIX);
#pragma unroll
        for (int q = 0; q < 2; ++q) {
            const int p = tid + q * NT, t = p >> 3, c8 = (p & 7) * 8; const size_t u = (size_t)b * SU + j0 + t;
            const u32x4 gz = *(const u32x4*)(Z + u * EVEN_IN_P + n * 64 + c8);
            const f32x4 r0 = *(const f32x4*)(X + t * 68 + c8), r1 = *(const f32x4*)(X + t * 68 + c8 + 4);
            float o[8];
#pragma unroll
            for (int k = 0; k < 4; ++k) { const float g0 = __uint_as_float(gz[k] << 16), g1 = __uint_as_float(gz[k] & 0xffff0000u);
                const float s0 = fsigmoid(1.5957691216057308f * (g0 + 0.044715f * g0 * g0 * g0)), s1 = fsigmoid(1.5957691216057308f * (g1 + 0.044715f * g1 * g1 * g1));
                o[2 * k] = g0 * s0 * (k < 2 ? r0[2 * k] : r1[2 * k - 4]); o[2 * k + 1] = g1 * s1 * (k < 2 ? r0[2 * k + 1] : r1[2 * k - 3]); }
            u32x4 w; w.x = g8::cvt_pk_bf16(o[0], o[1]); w.y = g8::cvt_pk_bf16(o[2], o[3]); w.z = g8::cvt_pk_bf16(o[4], o[5]); w.w = g8::cvt_pk_bf16(o[6], o[7]);
            *(u32x4*)(mix + u * D + n * 64 + c8) = w;
        }
    }
}

__device__ __forceinline__ void ph_lru(const Ptrs& P, unsigned char* lds, int mode, int item0, int nheavy) {
    const int G = gridDim.x, total = 8 * NCH * NB, b = (int)blockIdx.x;
    if (nheavy > 0 && G == 256 && 4 * nheavy + 6 * (G - nheavy) >= total) {
        const int th = total - 6 * (G - nheavy);
        const int lo = b < nheavy ? b * 4 : th + (b - nheavy) * 6, hi0 = b < nheavy ? lo + 4 : lo + 6, cap = b < nheavy ? th : total, hi = hi0 < cap ? hi0 : cap;
        for (int it = lo; it < hi; ++it) lru_item_mfma(P, lds, mode, it % 8, (it / 8) % NCH, it / (8 * NCH));
    } else {
        int first = (b - item0 % G + G) % G;
        for (int it = first; it < total; it += G) lru_item_mfma(P, lds, mode, it % 8, (it / 8) % NCH, it / (8 * NCH));
    }
    __syncthreads();
}

__device__ __forceinline__ void unpack8(const u32x4 v, float (&f)[8]) {
#pragma unroll
    for (int i = 0; i < 4; ++i) { f[2 * i] = __uint_as_float(v[i] << 16); f[2 * i + 1] = __uint_as_float(v[i] & 0xffff0000u); }
}
__device__ __forceinline__ u32x4 pack8(const float (&f)[8]) {
    u32x4 w; w.x = g8::cvt_pk_bf16(f[0], f[1]); w.y = g8::cvt_pk_bf16(f[2], f[3]); w.z = g8::cvt_pk_bf16(f[4], f[5]); w.w = g8::cvt_pk_bf16(f[6], f[7]); return w;
}
struct MlaRow { u32x4 zq, zk, zr, q0, q1, kv0, kw0, kv1, kw1; f32x4 c0, c1, s0, s1; };
__device__ __forceinline__ MlaRow mla_row_load(const Ptrs& P, int u, int lane) {
    const int hl = lane & 31, hh = lane >> 5; const bool act = hl < 24, tail = hl >= 16 && hl < 24;
    const int j = u % SU; const bool latent = j >= CTX; const int t = latent ? j - CTX : 0;
    const bf16* z = (const bf16*)(P.ws + WS_Z) + (size_t)u * EVEN_IN_P;
    const bf16* qp = (const bf16*)(P.ws + WS_QP) + (size_t)u * 1792; const bf16* kvp = qp + 768;
    const float* rc = (const float*)(P.ws + WS_ROPE); const float* rs = rc + SEQ * 64;
    const u32x4 z4 = {0u, 0u, 0u, 0u}; const f32x4 one4 = {1.f, 1.f, 1.f, 1.f}, zero4 = {0.f, 0.f, 0.f, 0.f};
    MlaRow r;
    r.zq = lane < 48 ? *(const u32x4*)(z + 1024 + lane * 8) : z4;
    r.zk = lane < 32 ? *(const u32x4*)(z + 1408 + lane * 8) : z4;
    r.zr = tail ? *(const u32x4*)(z + 1664 + (hl - 16) * 8) : z4;
    r.q0 = act ? *(const u32x4*)(qp + hh * 192 + hl * 8) : z4;
    r.q1 = act ? *(const u32x4*)(qp + (2 + hh) * 192 + hl * 8) : z4;
    r.kv0 = hl < 16 ? *(const u32x4*)(kvp + hh * 256 + hl * 8) : z4;
    r.kw0 = hl < 16 ? *(const u32x4*)(kvp + hh * 256 + 128 + hl * 8) : z4;
    r.kv1 = hl < 16 ? *(const u32x4*)(kvp + (2 + hh) * 256 + hl * 8) : z4;
    r.kw1 = hl < 16 ? *(const u32x4*)(kvp + (2 + hh) * 256 + 128 + hl * 8) : z4;
    const bool rp = latent && tail; const int ro = t * 64 + (hl - 16) * 8;
    r.c0 = rp ? *(const f32x4*)(rc + ro) : one4; r.c1 = rp ? *(const f32x4*)(rc + ro + 4) : one4;
    r.s0 = rp ? *(const f32x4*)(rs + ro) : zero4; r.s1 = rp ? *(const f32x4*)(rs + ro + 4) : zero4;
    return r;
}
__device__ __forceinline__ void ph_mla_prep(const Ptrs& P) {
    const int wave = threadIdx.x >> 6, lane = threadIdx.x & 63, G = gridDim.x;
    const int hl = lane & 31, hh = lane >> 5;
    const bool act = hl < 24, tail = hl >= 16 && hl < 24;
    const float* qn = P.in[21]; const float* kn = P.in[22];
    float gq[8], gk[8];
#pragma unroll
    for (int i = 0; i < 8; ++i) { gq[i] = act ? qn[hl * 8 + i] : 0.f; gk[i] = act ? kn[hl * 8 + i] : 0.f; }
    const float c2 = 0.07216878364870322f * LOG2E;
    const float sgn = ((hl >> 1) & 1) ? 1.f : -1.f;
    int u = (int)blockIdx.x * 8 + wave;
    if (u >= R) return;
    MlaRow cur = mla_row_load(P, u, lane);
    for (; u < R; u += G * 8) {
        const int un = u + G * 8;
        MlaRow nxt = cur;
        if (un < R) nxt = mla_row_load(P, un, lane);
        float f[8]; float sq = 0.f, sk = 0.f;
        unpack8(cur.zq, f);
#pragma unroll
        for (int i = 0; i < 8; ++i) sq += f[i] * f[i];
        unpack8(cur.zk, f);
#pragma unroll
        for (int i = 0; i < 8; ++i) sk += f[i] * f[i];
        const float rq = rsqrtf(wave_sum(sq) * (1.f / 384.f) + EPS), rk = rsqrtf(wave_sum(sk) * (1.f / 256.f) + EPS);
        float cs[8], sn[8];
#pragma unroll
        for (int i = 0; i < 4; ++i) { cs[i] = cur.c0[i]; cs[4 + i] = cur.c1[i]; sn[i] = cur.s0[i]; sn[4 + i] = cur.s1[i]; }
        bf16* qm = (bf16*)(P.ws + WS_QM) + (size_t)u * 768; bf16* km = (bf16*)(P.ws + WS_KM) + (size_t)u * 768; bf16* vm = (bf16*)(P.ws + WS_VM) + (size_t)u * 512;
#pragma unroll
        for (int pass = 0; pass < 2; ++pass) {
            const int h = pass * 2 + hh;
            {
                float v[8]; float ss = 0.f;
                unpack8(pass ? cur.q1 : cur.q0, v);
#pragma unroll
                for (int i = 0; i < 8; ++i) { v[i] *= rq; ss += v[i] * v[i]; }
                ss += __shfl_xor(ss, 1); ss += __shfl_xor(ss, 2); ss += __shfl_xor(ss, 4); ss += __shfl_xor(ss, 8); ss += __shfl_xor(ss, 16);
                const float r = rsqrtf(ss * (1.f / 192.f) + EPS);
#pragma unroll
                for (int i = 0; i < 8; ++i) { v[i] *= r * gq[i]; const float other = __shfl_xor(v[i], 2); v[i] = (v[i] * cs[i] + sgn * other * sn[i]) * c2; }
                if (act) *(u32x4*)(qm + h * 192 + hl * 8) = pack8(v);
            }
            {
                float v[8], w[8]; float ss = 0.f;
                if (hl < 16) { unpack8(pass ? cur.kv1 : cur.kv0, v); unpack8(pass ? cur.kw1 : cur.kw0, w);
#pragma unroll
                    for (int i = 0; i < 8; ++i) { v[i] *= rk; w[i] *= rk; } }
                else { unpack8(cur.zr, v);
#pragma unroll
                    for (int i = 0; i < 8; ++i) w[i] = 0.f; }
#pragma unroll
                for (int i = 0; i < 8; ++i) ss += v[i] * v[i];
                ss += __shfl_xor(ss, 1); ss += __shfl_xor(ss, 2); ss += __shfl_xor(ss, 4); ss += __shfl_xor(ss, 8); ss += __shfl_xor(ss, 16);
                const float r = rsqrtf(ss * (1.f / 192.f) + EPS);
#pragma unroll
                for (int i = 0; i < 8; ++i) { v[i] *= r * gk[i]; const float other = __shfl_xor(v[i], 2); v[i] = v[i] * cs[i] + sgn * other * sn[i]; }
                if (act) *(u32x4*)(km + h * 192 + hl * 8) = pack8(v);
                if (hl < 16) *(u32x4*)(vm + h * 128 + hl * 8) = pack8(w);
            }
        }
        cur = nxt;
    }
}
#ifndef PROBE_SUB
#define PROBE_SUB 0
#define PROBE_SUBDK 0
#endif
#ifndef PROBE_SUBBLK
#define PROBE_SUBBLK 0
#endif
#define PSUB_T0() unsigned ps_t0_ = 0u; if (PROBE_SUB && DK == PROBE_SUBDK) ps_t0_ = __builtin_amdgcn_readfirstlane((unsigned)__builtin_readcyclecounter())
#define PSUB_AT(k) do { if (PROBE_SUB == (k) && DK == PROBE_SUBDK) sacc = __builtin_amdgcn_readfirstlane(sacc + ((unsigned)__builtin_readcyclecounter() - ps_t0_)); } while (0)
namespace att {
using bf16x8 = __attribute__((ext_vector_type(8))) short;
using s16x4  = __attribute__((ext_vector_type(4))) short;
using f32x16 = __attribute__((ext_vector_type(16))) float;
#define SBAR() __builtin_amdgcn_sched_barrier(0)
__device__ __forceinline__ int crow(int r, int hi) { return (r & 3) + 8 * (r >> 2) + 4 * hi; }
__device__ __forceinline__ unsigned cvtpk(float lo, float hi) { unsigned r; asm volatile("v_cvt_pk_bf16_f32 %0, %1, %2" : "=v"(r) : "v"(lo), "v"(hi)); return r; }
template <int DK> __device__ __forceinline__ int kswz(int row, int chunk) { return row * (DK * 2) + ((chunk ^ ((row >> 1) & 7)) << 4); }
__device__ __forceinline__ int v_st(int k, int c) { const int kk = (k & ~0xC) | ((k & 4) << 1) | ((k & 8) >> 1); return ((kk >> 3) * 4 + (c >> 5)) * 512 + ((kk & 7) * 32 + (c & 31)) * 2; }
__device__ __forceinline__ int v_rd_base(int lane) { return ((lane & 3) << 3) | (((lane >> 2) & 3) << 6) | (((lane >> 4) & 1) << 5) | (((lane >> 5) & 1) << 8); }
constexpr int v_rd_off(int d0, int ks, int half) { return d0 * 512 + ks * 4096 + half * 2048; }
template <int OFF> __device__ __forceinline__ s16x4 tr_read(int vb) { s16x4 r; asm volatile("ds_read_b64_tr_b16 %0, %1 offset:%2" : "=&v"(r) : "v"(vb), "i"(OFF) : "memory"); return r; }
template <int D0> __device__ __forceinline__ void pv_one(f32x16& od, int vb, bf16x8 pa0, bf16x8 pa1, bf16x8 pa2, bf16x8 pa3) {
    const s16x4 l0 = tr_read<v_rd_off(D0, 0, 0)>(vb), h0 = tr_read<v_rd_off(D0, 0, 1)>(vb), l1 = tr_read<v_rd_off(D0, 1, 0)>(vb), h1 = tr_read<v_rd_off(D0, 1, 1)>(vb);
    const s16x4 l2 = tr_read<v_rd_off(D0, 2, 0)>(vb), h2 = tr_read<v_rd_off(D0, 2, 1)>(vb), l3 = tr_read<v_rd_off(D0, 3, 0)>(vb), h3 = tr_read<v_rd_off(D0, 3, 1)>(vb);
    asm volatile("s_waitcnt lgkmcnt(0)" ::: "memory"); SBAR();
#define PK(L, H) (bf16x8){L[0], L[1], L[2], L[3], H[0], H[1], H[2], H[3]}
    od = __builtin_amdgcn_mfma_f32_32x32x16_bf16(pa0, PK(l0, h0), od, 0, 0, 0);
    od = __builtin_amdgcn_mfma_f32_32x32x16_bf16(pa1, PK(l1, h1), od, 0, 0, 0);
    od = __builtin_amdgcn_mfma_f32_32x32x16_bf16(pa2, PK(l2, h2), od, 0, 0, 0);
    od = __builtin_amdgcn_mfma_f32_32x32x16_bf16(pa3, PK(l3, h3), od, 0, 0, 0);
#undef PK
}
typedef short v4i16_t __attribute__((ext_vector_type(4)));
template <int OFF> __device__ __forceinline__ s16x4 tr_read_b(int vb) {
    return __builtin_bit_cast(s16x4, __builtin_amdgcn_ds_read_tr16_b64_v4i16((__attribute__((address_space(3))) v4i16_t*)(uintptr_t)(unsigned)(vb + OFF)));
}
template <int D0> __device__ __forceinline__ void pv_one_b(f32x16& od, int vb, bf16x8 pa0, bf16x8 pa1, bf16x8 pa2, bf16x8 pa3) {
    const s16x4 l0 = tr_read_b<v_rd_off(D0, 0, 0)>(vb), h0 = tr_read_b<v_rd_off(D0, 0, 1)>(vb), l1 = tr_read_b<v_rd_off(D0, 1, 0)>(vb), h1 = tr_read_b<v_rd_off(D0, 1, 1)>(vb);
    const s16x4 l2 = tr_read_b<v_rd_off(D0, 2, 0)>(vb), h2 = tr_read_b<v_rd_off(D0, 2, 1)>(vb), l3 = tr_read_b<v_rd_off(D0, 3, 0)>(vb), h3 = tr_read_b<v_rd_off(D0, 3, 1)>(vb);
#define PK(L, H) (bf16x8){L[0], L[1], L[2], L[3], H[0], H[1], H[2], H[3]}
    od = __builtin_amdgcn_mfma_f32_32x32x16_bf16(pa0, PK(l0, h0), od, 0, 0, 0);
    od = __builtin_amdgcn_mfma_f32_32x32x16_bf16(pa1, PK(l1, h1), od, 0, 0, 0);
    od = __builtin_amdgcn_mfma_f32_32x32x16_bf16(pa2, PK(l2, h2), od, 0, 0, 0);
    od = __builtin_amdgcn_mfma_f32_32x32x16_bf16(pa3, PK(l3, h3), od, 0, 0, 0);
#undef PK
}
constexpr int SHM_V = 64 * 128 * 2;
template <int DK, bool PF, bool EARLY>
__device__ __forceinline__ void attn_loop(const bf16* __restrict__ Qrow  , const bf16* __restrict__ Kh, int ldk, const bf16* __restrict__ Vh, int ldv,
                                          int nkeys, float negM, f32x16 (&o)[4], float& l_reg, char* lds_kv, unsigned& sacc) {
    constexpr int NQ = DK / 16, CH = DK / 8, KP = (64 * CH) / NT, SHM_K = 64 * DK * 2;
    const int tid = threadIdx.x, lane = tid & 63, r32 = lane & 31, hi = lane >> 5;
    char* V_lds = lds_kv; char* K_lds = lds_kv + 2 * SHM_V;
    bf16x8 qr[NQ];
#pragma unroll
    for (int d0 = 0; d0 < NQ; ++d0) qr[d0] = *reinterpret_cast<const bf16x8*>(Qrow + d0 * 16);
    const __amdgpu_buffer_rsrc_t krs = __builtin_amdgcn_make_buffer_rsrc((void*)Kh, 0, nkeys * ldk * 2, 0x00020000);
    const __amdgpu_buffer_rsrc_t vrs = __builtin_amdgcn_make_buffer_rsrc((void*)Vh, 0, nkeys * ldv * 2, 0x00020000);
    unsigned kgo[KP]; int kst[KP];
#pragma unroll
    for (int i = 0; i < KP; ++i) { const int p = tid + i * NT, row = p / CH, ch = p % CH; kgo[i] = (unsigned)(row * ldk + ch * 8) * 2u; kst[i] = kswz<DK>(row, ch); }
    const int vrow0 = tid >> 4, vc = (tid & 15) * 8;
    const unsigned vgo = (unsigned)(vrow0 * ldv + vc) * 2u, vstep = (unsigned)(32 * ldv) * 2u;
    const int vst0 = v_st(vrow0, vc); constexpr int vst1d = 8192;
    const int vb0 = (int)(uintptr_t)V_lds + v_rd_base(lane);
    const int kbase = r32 * (DK * 2), kt0 = (hi ^ ((r32 >> 1) & 7)) << 4;
#define kra_(q) (kbase + (kt0 ^ ((q) << 5)))
    u32x4 ks[KP], vs0, vs1;
#define SLOAD(k0) do { const unsigned so_k = (unsigned)((k0) * ldk) * 2u, so_v = (unsigned)((k0) * ldv) * 2u; \
        _Pragma("unroll") for (int i = 0; i < KP; ++i) ks[i] = __builtin_amdgcn_raw_buffer_load_b128(krs, kgo[i], so_k, 0); \
        vs0 = __builtin_amdgcn_raw_buffer_load_b128(vrs, vgo, so_v, 0); vs1 = __builtin_amdgcn_raw_buffer_load_b128(vrs, vgo + vstep, so_v, 0); } while (0)
#define SWRITE(b) do { _Pragma("unroll") for (int i = 0; i < KP; ++i) *reinterpret_cast<u32x4*>(K_lds + (b) * SHM_K + kst[i]) = ks[i]; \
        *reinterpret_cast<u32x4*>(V_lds + (b) * SHM_V + vst0) = vs0; *reinterpret_cast<u32x4*>(V_lds + (b) * SHM_V + vst0 + vst1d) = vs1; } while (0)
    constexpr int KLINES = (64 * DK * 2) / 128, VLINES = 128, LPR = DK / 64;
    unsigned pf_dummy = 0u;
#define PREFETCH(t) do { if (PF && tid < KLINES + VLINES) { const bool isk_ = tid < KLINES; const int l_ = isk_ ? tid : tid - KLINES; \
        const unsigned off_ = isk_ ? (unsigned)(((t) * 64 + l_ / LPR) * ldk + (l_ % LPR) * 64) * 2u : (unsigned)(((t) * 64 + (l_ >> 1)) * ldv + (l_ & 1) * 64) * 2u + (unsigned)((const char*)Vh - (const char*)Kh); \
        asm volatile("global_load_dword %0, %1, %2" : "+v"(pf_dummy) : "v"(off_), "s"(Kh) : "memory"); } } while (0)
    const int ntile = nkeys / 64;
    PREFETCH(1); PREFETCH(2);
    SLOAD(0); SWRITE(0); __syncthreads();
    for (int j = 0; j < ntile; ++j) {
        const int cur = j & 1;
        PSUB_T0();
        if (EARLY && j + 1 < ntile) SLOAD((j + 1) * 64);
        f32x16 p0, p1;
#pragma unroll
        for (int r = 0; r < 16; ++r) { p0[r] = negM; p1[r] = negM; }
        const char* Kb = K_lds + cur * SHM_K;
#pragma unroll
        for (int d0 = 0; d0 < NQ; ++d0) {
            const bf16x8 b0 = *reinterpret_cast<const bf16x8*>(Kb + kra_(d0 & 3) + (d0 >> 2) * 128);
            const bf16x8 b1 = *reinterpret_cast<const bf16x8*>(Kb + kra_(d0 & 3) + (d0 >> 2) * 128 + 32 * DK * 2);
            p0 = __builtin_amdgcn_mfma_f32_32x32x16_bf16(b0, qr[d0], p0, 0, 0, 0);
            p1 = __builtin_amdgcn_mfma_f32_32x32x16_bf16(b1, qr[d0], p1, 0, 0, 0);
            if ((d0 & 3) == 3) SBAR();
        }
        PSUB_AT(1);
        if (!EARLY && j + 1 < ntile) SLOAD((j + 1) * 64);
        float ps = 0.f;
#pragma unroll
        for (int r = 0; r < 16; ++r) { p0[r] = __builtin_amdgcn_exp2f(p0[r]); p1[r] = __builtin_amdgcn_exp2f(p1[r]); ps += p0[r] + p1[r]; }
        l_reg += ps;
        bf16x8 pa0, pa1, pa2, pa3;
#define PK4(P, BASE, OUT) do { unsigned a0 = cvtpk(P[BASE + 0], P[BASE + 1]), a1 = cvtpk(P[BASE + 2], P[BASE + 3]);   \
        unsigned b0_ = cvtpk(P[BASE + 4], P[BASE + 5]), b1_ = cvtpk(P[BASE + 6], P[BASE + 7]);                              \
        auto r0 = __builtin_amdgcn_permlane32_swap(a0, b0_, false, false); auto r1 = __builtin_amdgcn_permlane32_swap(a1, b1_, false, false); \
        u32x4 w = {r0[0], r1[0], r0[1], r1[1]}; OUT = *reinterpret_cast<bf16x8*>(&w); } while (0)
        PK4(p0, 0, pa0); PK4(p0, 8, pa1); PK4(p1, 0, pa2); PK4(p1, 8, pa3);
#undef PK4
        PSUB_AT(2);
        const int vb = vb0 + cur * SHM_V;
        pv_one<0>(o[0], vb, pa0, pa1, pa2, pa3); pv_one<1>(o[1], vb, pa0, pa1, pa2, pa3); pv_one<2>(o[2], vb, pa0, pa1, pa2, pa3); pv_one<3>(o[3], vb, pa0, pa1, pa2, pa3);
        PSUB_AT(3);
        if (j + 1 < ntile) SWRITE(cur ^ 1);
        if (j + 3 < ntile) PREFETCH(j + 3);
        __syncthreads();
        PSUB_AT(4);
    }
    if (PF) asm volatile("s_waitcnt vmcnt(0)" : "+v"(pf_dummy) :: "memory");
#undef PREFETCH
#undef kra_
#undef SLOAD
#undef SWRITE
}
__device__ __forceinline__ void row_recip(float l_reg, float* li_l  , int r32, int hi, float (&rli)[16]) {
    { auto rr = __builtin_amdgcn_permlane32_swap(__float_as_uint(l_reg), __float_as_uint(l_reg), false, false); l_reg = __uint_as_float(rr[0]) + __uint_as_float(rr[1]); }
    if (hi == 0) li_l[r32] = l_reg;
    asm volatile("s_waitcnt lgkmcnt(0)" ::: "memory");
#pragma unroll
    for (int r = 0; r < 16; ++r) rli[r] = __builtin_amdgcn_rcpf(li_l[crow(r, hi)]);
}
#undef SBAR
}

constexpr int ATT_SCR_OFF = RING_BYTES - 2048;
__device__ __forceinline__ void mla_attn_unit(const Ptrs& P, unsigned char* lds, int b, int h, int qb, int ctxq, unsigned& sacc) {
    using namespace att;
    const int tid = threadIdx.x, wid = tid >> 6, lane = tid & 63, r32 = lane & 31, hi = lane >> 5;
    const bf16* Qm = (const bf16*)(P.ws + WS_QM); const bf16* Km = (const bf16*)(P.ws + WS_KM); const bf16* Vm = (const bf16*)(P.ws + WS_VM);
    const size_t u0 = (size_t)b * SU + (ctxq ? 0 : CTX) + qb * 256 + wid * 32;
    f32x16 o[4] = {}; float l_reg = 0.f;
    const float negM = -((const float*)(P.ws + WS_SCAL))[0];
    attn_loop<192, false, false>(Qm + (u0 + r32) * 768 + h * 192 + hi * 8, Km + (size_t)b * SU * 768 + h * 192, 768, Vm + (size_t)b * SU * 512 + h * 128, 512, ctxq ? CTX : SU, negM, o, l_reg, (char*)lds, sacc);
    float rli[16]; row_recip(l_reg, (float*)(lds + ATT_SCR_OFF) + wid * 64, r32, hi, rli);
    bf16* stg = (bf16*)lds + wid * 4096;
#pragma unroll
    for (int r = 0; r < 16; ++r) { const int orow = crow(r, hi);
#pragma unroll
        for (int d0 = 0; d0 < 4; ++d0) stg[orow * 128 + d0 * 32 + r32] = f2bf(o[d0][r] * rli[r]); }
    asm volatile("s_waitcnt lgkmcnt(0)" ::: "memory");
    bf16* mix = (bf16*)(P.ws + WS_MIX) + u0 * D + 512 + h * 128;
#pragma unroll
    for (int i = 0; i < 8; ++i) { const int row = i * 4 + (lane >> 4), ch = lane & 15; const u32x4 v = *(const u32x4*)(stg + row * 128 + ch * 8); *(u32x4*)(mix + (size_t)row * D + ch * 8) = v; }
    asm volatile("s_waitcnt lgkmcnt(0)" ::: "memory");
    __syncthreads();
}
__device__ __forceinline__ void diff_attn_unit(const Ptrs& P, unsigned char* lds, int b, int h, int qb, unsigned& sacc) {
    using namespace att;
    const int tid = threadIdx.x, wid = tid >> 6, lane = tid & 63, r32 = lane & 31, hi = lane >> 5;
    const bf16* Z = (const bf16*)(P.ws + WS_Z);
    const size_t u0 = (size_t)b * SU + CTX + qb * 256 + wid * 32;
    const float* scal = (const float*)(P.ws + WS_SCAL); const float negM = -scal[1], lam = scal[2], oml = scal[3];
    bf16* stg = (bf16*)lds + wid * 4096;
    float* li_l = (float*)(lds + ATT_SCR_OFF) + wid * 64;
    for (int part = 0; part < 2; ++part) {
        f32x16 o[4] = {}; float l_reg = 0.f;
        attn_loop<64, true, true>(Z + (u0 + r32) * ODD_IN + h * 128 + part * 64 + hi * 8, Z + 1024 + (size_t)b * SU * ODD_IN + h * 128 + part * 64, ODD_IN, Z + 2048 + (size_t)b * SU * ODD_IN + h * 128, ODD_IN, SU, negM, o, l_reg, (char*)lds + 65536, sacc);
        float rli[16]; row_recip(l_reg, li_l, r32, hi, rli);
#pragma unroll
        for (int r = 0; r < 16; ++r) { const int orow = crow(r, hi);
#pragma unroll
            for (int d0 = 0; d0 < 4; ++d0) { bf16* s = stg + orow * 128 + d0 * 32 + r32; const float on = o[d0][r] * rli[r];
                if (part == 0) *s = f2bf(on); else *s = f2bf(bf2f(*s) - lam * on); } }
        asm volatile("s_waitcnt lgkmcnt(0)" ::: "memory");
    }
    const float* sg = P.in[31];
    bf16* mix = (bf16*)(P.ws + WS_MIX) + u0 * D + h * 128;
#pragma unroll
    for (int i = 0; i < 8; ++i) { const int row = i * 4 + (lane >> 4), ch = lane & 15; const u32x4 v = *(const u32x4*)(stg + row * 128 + ch * 8);
        float f[8]; float ss = 0.f;
#pragma unroll
        for (int e = 0; e < 4; ++e) { f[2 * e] = __uint_as_float(v[e] << 16); f[2 * e + 1] = __uint_as_float(v[e] & 0xffff0000u); ss += f[2 * e] * f[2 * e] + f[2 * e + 1] * f[2 * e + 1]; }
        ss += __shfl_xor(ss, 1); ss += __shfl_xor(ss, 2); ss += __shfl_xor(ss, 4); ss += __shfl_xor(ss, 8);
        const float rs = rsqrtf(ss * (1.f / 128.f) + EPS) * oml;
        const f32x4 g0 = *(const f32x4*)(sg + ch * 8), g1 = *(const f32x4*)(sg + ch * 8 + 4);
        u32x4 w; w.x = att::cvtpk(f[0] * rs * g0[0], f[1] * rs * g0[1]); w.y = att::cvtpk(f[2] * rs * g0[2], f[3] * rs * g0[3]); w.z = att::cvtpk(f[4] * rs * g1[0], f[5] * rs * g1[1]); w.w = att::cvtpk(f[6] * rs * g1[2], f[7] * rs * g1[3]);
        *(u32x4*)(mix + (size_t)row * D + ch * 8) = w; }
    asm volatile("s_waitcnt lgkmcnt(0)" ::: "memory");
    __syncthreads();
}

__device__ __forceinline__ void ph_norm2_router(const Ptrs& P, unsigned char* lds, int layer, int latent_only) {
    const int tid = threadIdx.x, wid = tid >> 6, lane = tid & 63, fr = lane & 15, fq = lane >> 4, G = gridDim.x;
    float* RS = (float*)lds;
    float* LGP = RS + 256;
    int* TOPE = (int*)(LGP + 2 * 4096);
    float* TOPW = (float*)(TOPE + 512);
    int* TOPR = (int*)(TOPW + 512);
    int* LCNT = TOPR + 512;
    int* LBASE = LCNT + 32;
    int* GU0 = LBASE + 32;
    const float* gn = P.in[7] + layer * D;
    const float* rw = P.in[32] + (size_t)layer * D * NE; const float* rb = P.in[33] + layer * NE;
    const int cw0 = 128 * wid + 8 * fq;
    float wv0[4][8], wv1[4][8];
#pragma unroll
    for (int ks = 0; ks < 4; ++ks) { const float* wr = rw + (size_t)(cw0 + 32 * ks) * NE + fr;
#pragma unroll
        for (int j = 0; j < 8; ++j) { wv0[ks][j] = wr[j * NE]; wv1[ks][j] = wr[j * NE + 16]; } }
    const int NG = latent_only ? NB * (SEQ / 16) : R / 16;
    const int q0 = (int)(((long long)blockIdx.x * NG) / G), q1 = (int)(((long long)(blockIdx.x + 1) * NG) / G);
#define N2_U0(q) (latent_only ? ((q) >> 8) * SU + CTX + ((q) & 255) * 16 : (q) * 16)
#define N2_XLOAD(XR, q) do { const bf16* x_ = (const bf16*)(P.ws + WS_XB) + (size_t)(N2_U0(q) + fr) * D + cw0; _Pragma("unroll") for (int ks = 0; ks < 4; ++ks) XR[ks] = *(const u32x4*)(x_ + 32 * ks); } while (0)
#define N2_LO(w) __uint_as_float((w) << 16)
#define N2_HI(w) __uint_as_float((w) & 0xffff0000u)
#define N2_SS(XR, par) do { float ss = 0.f; _Pragma("unroll") for (int ks = 0; ks < 4; ++ks) { const u32x4 r = XR[ks]; \
            ss += N2_LO(r.x) * N2_LO(r.x) + N2_HI(r.x) * N2_HI(r.x) + N2_LO(r.y) * N2_LO(r.y) + N2_HI(r.y) * N2_HI(r.y) + N2_LO(r.z) * N2_LO(r.z) + N2_HI(r.z) * N2_HI(r.z) + N2_LO(r.w) * N2_LO(r.w) + N2_HI(r.w) * N2_HI(r.w); } \
        ss += __shfl_xor(ss, 16); ss += __shfl_xor(ss, 32); if (fq == 0) RS[(par) * 128 + wid * 16 + fr] = ss; } while (0)
    float A[4][8], Hs[4][8]; int mi_cur = -1;
    for (int qs = q0; qs < q1; qs += 8) {
        const int qe = qs + 8 < q1 ? qs + 8 : q1;
        __syncthreads();
        if (tid < 32) LCNT[tid] = 0;
        u32x4 xr[4], xn[4];
        N2_XLOAD(xr, qs);
        N2_SS(xr, 0);
        __syncthreads();
        for (int q = qs; q < qe; ++q) {
            const int gi = q - qs, par = gi & 1, u0 = N2_U0(q), u = u0 + fr;
            { const int b_ = u0 / SU, mi = (u0 % SU) < CTX ? 4 : b_;
              if (mi != mi_cur) { mi_cur = mi; const float* md = (const float*)(P.ws + WS_MOD) + (size_t)(layer * 5 + mi) * 6144 + 3 * D;
#pragma unroll
                  for (int ks = 0; ks < 4; ++ks) { const int c0 = cw0 + 32 * ks;
                      const f32x4 g0 = *(const f32x4*)(gn + c0), g1 = *(const f32x4*)(gn + c0 + 4), s0 = *(const f32x4*)(md + D + c0), s1 = *(const f32x4*)(md + D + c0 + 4), h0 = *(const f32x4*)(md + c0), h1 = *(const f32x4*)(md + c0 + 4);
#pragma unroll
                      for (int j = 0; j < 4; ++j) { A[ks][j] = g0[j] * (1.f + s0[j]); A[ks][4 + j] = g1[j] * (1.f + s1[j]); Hs[ks][j] = h0[j]; Hs[ks][4 + j] = h1[j]; } } } }
            if (q + 1 < qe) N2_XLOAD(xn, q + 1);
            if (tid == 0) GU0[gi] = u0;
            float tot = 0.f;
#pragma unroll
            for (int w = 0; w < 8; ++w) tot += RS[par * 128 + w * 16 + fr];
            const float rstd = rsqrtf(tot * (1.f / D) + EPS);
            f32x4 acc0 = {0.f, 0.f, 0.f, 0.f}, acc1 = {0.f, 0.f, 0.f, 0.f};
            bf16* h = (bf16*)(P.ws + WS_H) + (size_t)u * D + cw0;
#pragma unroll
            for (int ks = 0; ks < 4; ++ks) {
                float y[8];
                const u32x4 r = xr[ks]; const float xv[8] = {N2_LO(r.x), N2_HI(r.x), N2_LO(r.y), N2_HI(r.y), N2_LO(r.z), N2_HI(r.z), N2_LO(r.w), N2_HI(r.w)};
#pragma unroll
                for (int j = 0; j < 8; ++j) y[j] = xv[j] * rstd * A[ks][j] + Hs[ks][j];
                u32x4 w; w.x = g8::cvt_pk_bf16(y[0], y[1]); w.y = g8::cvt_pk_bf16(y[2], y[3]); w.z = g8::cvt_pk_bf16(y[4], y[5]); w.w = g8::cvt_pk_bf16(y[6], y[7]);
                *(u32x4*)(h + 32 * ks) = w;
#pragma unroll
                for (int j = 0; j < 8; ++j) {
                    acc0 = __builtin_amdgcn_mfma_f32_16x16x4f32(y[j], wv0[ks][j], acc0, 0, 0, 0);
                    acc1 = __builtin_amdgcn_mfma_f32_16x16x4f32(y[j], wv1[ks][j], acc1, 0, 0, 0);
                }
            }
            float* lgp = LGP + par * 4096;
#pragma unroll
            for (int j = 0; j < 4; ++j) { lgp[(wid * 16 + 4 * fq + j) * 32 + fr] = acc0[j]; lgp[(wid * 16 + 4 * fq + j) * 32 + 16 + fr] = acc1[j]; }
            if (q + 1 < qe) { N2_SS(xn, par ^ 1);
#pragma unroll
                for (int ks = 0; ks < 4; ++ks) xr[ks] = xn[ks]; }
            __syncthreads();
            {
                const int e = lane & 31, row = 2 * wid + (lane >> 5);
                float lg = rb[e];
#pragma unroll
                for (int w = 0; w < 8; ++w) lg += lgp[(w * 16 + row) * 32 + e];
                int te[4]; float tv[4];
#pragma unroll
                for (int k = 0; k < 4; ++k) {
                    float bv = lg; int bi = e;
#pragma unroll
                    for (int m = 1; m < 32; m <<= 1) { const float ov = __shfl_xor(bv, m); const int oi = __shfl_xor(bi, m); const bool take = ov > bv || (ov == bv && oi < bi); bv = take ? ov : bv; bi = take ? oi : bi; }
                    te[k] = bi; tv[k] = bv; if (e == bi) lg = -3.4e38f;
                }
                float den = 0.f, w[4];
#pragma unroll
                for (int k = 0; k < 4; ++k) { w[k] = __expf(tv[k] - tv[0]); den += w[k]; }
                const float iden = 1.f / den;
                if (e < 4) { const int ek = e == 0 ? te[0] : e == 1 ? te[1] : e == 2 ? te[2] : te[3]; const float wk = (e == 0 ? w[0] : e == 1 ? w[1] : e == 2 ? w[2] : w[3]) * iden;
                    TOPE[gi * 64 + row * 4 + e] = ek; TOPW[gi * 64 + row * 4 + e] = wk; TOPR[gi * 64 + row * 4 + e] = atomicAdd(&LCNT[ek], 1); }
            }
        }
        __syncthreads();
        if (tid < 32) { int t2 = tid; asm volatile("" : "+v"(t2));
            const int c = LCNT[t2]; LBASE[t2] = c > 0 ? (int)atomicAdd((unsigned*)(P.ws + WS_CTL) + CW_CNT + layer * 64 + t2, (unsigned)c) : 0; }
        __syncthreads();
        int* tok_of = (int*)(P.ws + WS_TOKOF); int* pair_of = (int*)(P.ws + WS_PAIROF); float* gate_of = (float*)(P.ws + WS_GATEOF);
        for (int p = tid; p < (qe - qs) * 64; p += NT) {
            const int e = TOPE[p], rk = LBASE[e] + TOPR[p], ur = GU0[p >> 6] + ((p & 63) >> 2), k = p & 3;
            tok_of[(size_t)e * R + rk] = ur; pair_of[(size_t)e * R + rk] = ur * 4 + k; gate_of[(size_t)e * R + rk] = TOPW[p];
        }
    }
#undef N2_U0
#undef N2_XLOAD
#undef N2_SS
#undef N2_LO
#undef N2_HI
}

struct Args { Ptrs P; int ph_lo, ph_hi; };
constexpr int N_PHASES = 19;
__global__ void __launch_bounds__(NT, 2) mega(Args args) {
    extern __shared__ __attribute__((aligned(16))) unsigned char lds[];
    const Ptrs& P = args.P;
    unsigned char* ws = P.ws;
    const int tid = threadIdx.x, G = gridDim.x;
    const int vcu = (G % 8 == 0) ? ((int)blockIdx.x % 8) * (G / 8) + (int)blockIdx.x / 8 : (int)blockIdx.x;
    LAS unsigned char* LDSP = (LAS unsigned char*)lds;
    volatile LAS unsigned* MISC = (volatile LAS unsigned*)((LAS unsigned char*)lds + MISC_OFF);
    for (int u = tid; u < (LDS_BYTES - LDSCTL_OFF) / 4; u += NT) ((LAS unsigned*)((LAS unsigned char*)lds + LDSCTL_OFF))[u] = 0u;
    __syncthreads();
    XcdBarrier bar = xcd_barrier_post((unsigned*)(ws + WS_CTL) + CW_BAR, MISC + 8);
    const int lo = args.ph_lo, hi = args.ph_hi;
#ifndef PROBE_MASK
#define PROBE_MASK 0u
#endif
    unsigned long long pr_acc = 0ull, pr_t0 = 0ull; unsigned sub_acc = 0u;
#define IN(k) (lo <= (k) && (k) < hi)
#define SEAM(k) do { if (IN(k) && IN((k) + 1)) xcd_barrier(bar); \
        if (PROBE_MASK) { const unsigned long long t_ = __builtin_amdgcn_s_memrealtime(); if ((PROBE_MASK >> (k)) & 1u) pr_acc += t_ - pr_t0; pr_t0 = t_; } } while (0)
    if (PROBE_MASK) pr_t0 = __builtin_amdgcn_s_memrealtime();
    const bf16* H = (const bf16*)(ws + WS_H); bf16* Z = (bf16*)(ws + WS_Z); const bf16* MIX = (const bf16*)(ws + WS_MIX);
    const bf16* Qm = (const bf16*)(ws + WS_QM); const bf16* Km = (const bf16*)(ws + WS_KM); const bf16* Vm = (const bf16*)(ws + WS_VM);

    if (IN(0)) { ph_prologue(P, lds, sub_acc); } SEAM(0);
    if (IN(1)) { ph_rows(P, 0, 0, 0, 0); } SEAM(1);
    if (IN(2)) { g8::DenseOrder S; S.init(H, D, (const bf16*)(ws + WS_WEVIN), D, R, EVEN_IN_P, G, (int)blockIdx.x, 0); g8::EpiStoreBf16 E{Z, EVEN_IN_P};
        g8::gemm_phase<g8::EpiStoreBf16, g8::DenseOrder, false, true>(LDSP, D, D, S, E); } SEAM(2);
    if (IN(3)) {
        { g8::UpOrder S{(const char*)Z, (const char*)(ws + WS_WUQ), (const char*)(ws + WS_WUKV), G, (int)blockIdx.x}; g8::EpiStoreBf16 E{(bf16*)(ws + WS_QP), 1792};
          g8::gemm_phase<g8::EpiStoreBf16, g8::UpOrder, false, true>(LDSP, EVEN_IN_P, 384, S, E); }
        ph_lru(P, lds, 0, 0, 0);
    } SEAM(3);
    if (IN(4)) { ph_mla_prep(P); } SEAM(4);
    if (IN(5)) {
        ph_lru(P, lds, 1, 128, 0);
        for (int it = vcu; it < 256 + 16; it += G) {
            if (it < 256) mla_attn_unit(P, lds, it / 64, (it / 16) % 4, it % 16, 0, sub_acc);
            else { const int i2 = it - 256; mla_attn_unit(P, lds, i2 / 4, i2 % 4, 0, 1, sub_acc); }
        }
    } SEAM(5);
    if (IN(6)) { g8::DenseOrder S; S.init(MIX, D, (const bf16*)(ws + WS_WEVOUT), D, R, D, G, (int)blockIdx.x, 0); g8::EpiOut E{P, 0};
        g8::gemm_phase<g8::EpiOut, g8::DenseOrder, false, true>(LDSP, D, D, S, E); } SEAM(6);
    if (IN(7)) { ph_norm2_router(P, lds, 0, 0); } SEAM(7);
    if (IN(8)) { g8::MoeOrder S{(const char*)H, (const char*)(ws + WS_WGU) + (size_t)0 * NE * 2048 * 1024 * 2, (const int*)(ws + WS_TOKOF), (size_t)2048 * 1024 * 2, 8, D, G, vcu, 1, nullptr};
        S.init((const unsigned*)(ws + WS_CTL) + CW_CNT + 0 * 64, (LAS int*)(LDSP + MISC_OFF + 256)); g8::EpiMoe1 E{P, 0}; g8::gemm_phase<g8::EpiMoe1, g8::MoeOrder, true, true>(LDSP, D, D, S, E); } SEAM(8);
    if (IN(9)) { g8::MoeOrder S{(const char*)(ws + WS_ACT), (const char*)(ws + WS_WDN) + (size_t)0 * NE * 1024 * 1024 * 2, nullptr, (size_t)1024 * 1024 * 2, 4, D, G, vcu, 0, nullptr};
        S.init((const unsigned*)(ws + WS_CTL) + CW_CNT + 0 * 64, (LAS int*)(LDSP + MISC_OFF + 256)); g8::EpiMoe2 E{P, 0}; g8::gemm_phase<g8::EpiMoe2, g8::MoeOrder, false, true>(LDSP, D, D, S, E); } SEAM(9);
    if (IN(10)) { ph_rows(P, 0, 2, 0, 1); } SEAM(10);
    if (IN(11)) { g8::DenseOrder S; S.init(H, D, (const bf16*)(ws + WS_WODIN), D, R, ODD_IN, G, (int)blockIdx.x, 0);
        g8::EpiDiffIn E{Z, P.in[25], P.in[26], (const float*)(ws + WS_ROPE), (const float*)(ws + WS_ROPE) + SEQ * 64, (LAS float*)(LDSP + MISC_OFF + 1024)};
        g8::gemm_phase<g8::EpiDiffIn, g8::DenseOrder, false, true>(LDSP, D, D, S, E); } SEAM(11);
    if (IN(13)) {
        for (int it = vcu; it < 512; it += G) { unsigned tq0 = 0u; if (PROBE_SUB == 5 && PROBE_SUBDK == 64) tq0 = (unsigned)__builtin_readcyclecounter();
            diff_attn_unit(P, lds, it / 128, (it / 16) % 8, it % 16, sub_acc);
            if (PROBE_SUB == 5 && PROBE_SUBDK == 64) sub_acc += (unsigned)__builtin_readcyclecounter() - tq0; }
    } SEAM(13);
    if (IN(14)) { g8::DenseOrder S; S.init(MIX, D, (const bf16*)(ws + WS_WODOUT), D, R, D, G, (int)blockIdx.x, 1); g8::EpiOut E{P, 1};
        g8::gemm_phase<g8::EpiOut, g8::DenseOrder, false, true>(LDSP, D, D, S, E); } SEAM(14);
    if (IN(15)) { ph_norm2_router(P, lds, 1, 1); } SEAM(15);
    if (IN(16)) { g8::MoeOrder S{(const char*)H, (const char*)(ws + WS_WGU) + (size_t)1 * NE * 2048 * 1024 * 2, (const int*)(ws + WS_TOKOF), (size_t)2048 * 1024 * 2, 8, D, G, vcu, 1, nullptr};
        S.init((const unsigned*)(ws + WS_CTL) + CW_CNT + 1 * 64, (LAS int*)(LDSP + MISC_OFF + 256)); g8::EpiMoe1 E{P, 1}; g8::gemm_phase<g8::EpiMoe1, g8::MoeOrder, true, true>(LDSP, D, D, S, E); } SEAM(16);
    if (IN(17)) { g8::MoeOrder S{(const char*)(ws + WS_ACT), (const char*)(ws + WS_WDN) + (size_t)1 * NE * 1024 * 1024 * 2, nullptr, (size_t)1024 * 1024 * 2, 4, D, G, vcu, 0, nullptr};
        S.init((const unsigned*)(ws + WS_CTL) + CW_CNT + 1 * 64, (LAS int*)(LDSP + MISC_OFF + 256)); g8::EpiMoe2 E{P, 1}; g8::gemm_phase<g8::EpiMoe2, g8::MoeOrder, false, true>(LDSP, D, D, S, E); } SEAM(17);
    if (IN(18)) { ph_rows(P, 1, 2, 1, 0); }
    if (PROBE_MASK) { const unsigned long long t_ = __builtin_amdgcn_s_memrealtime(); if ((PROBE_MASK >> 18) & 1u) pr_acc += t_ - pr_t0;
        if (blockIdx.x == 0) { const unsigned long long t1 = t_ + 8ull * pr_acc; while (__builtin_amdgcn_s_memrealtime() < t1) __builtin_amdgcn_s_sleep(8); } }
    if (PROBE_SUB && (PROBE_SUBBLK < 0 || (int)blockIdx.x == PROBE_SUBBLK)) { const unsigned long long t1 = __builtin_readcyclecounter() + 8ull * (unsigned long long)sub_acc; while (__builtin_readcyclecounter() < t1) __builtin_amdgcn_s_sleep(8); }
#undef IN
#undef SEAM
}

#ifndef MK_PER_PHASE
#define MK_PER_PHASE 0
#endif
extern "C" void kernel_launch(void* const* d_in, const int* in_sizes, int n_in, void* d_out, int out_size, void* d_ws, size_t ws_size, hipStream_t stream) {
    static int grid = 0;
    if (grid == 0) {
        if (n_in != 38 || ws_size < WS_END) { fprintf(stderr, "kernel_launch: bad args n_in=%d ws=%zu need %zu\n", n_in, ws_size, (size_t)WS_END); grid = -1; return; }
        int dev = 0, cus = 0, per_cu = 0;
        if (hipGetDevice(&dev) != hipSuccess || hipDeviceGetAttribute(&cus, hipDeviceAttributeMultiprocessorCount, dev) != hipSuccess) { grid = -1; return; }
        if (hipFuncSetAttribute((const void*)mega, hipFuncAttributeMaxDynamicSharedMemorySize, LDS_BYTES) != hipSuccess) { fprintf(stderr, "kernel_launch: hipFuncSetAttribute failed\n"); grid = -1; return; }
        if (hipOccupancyMaxActiveBlocksPerMultiprocessor(&per_cu, (const void*)mega, NT, LDS_BYTES) != hipSuccess || per_cu < 1) { fprintf(stderr, "kernel_launch: occupancy query says %d blocks/CU\n", per_cu); grid = -1; return; }
        (void)hipGetLastError();
        grid = cus;
    }
    if (grid < 0) return;
    if (hipMemsetAsync((char*)d_ws + WS_CTL, 0, 1u << 20, stream) != hipSuccess) return;
    Args a; memset((void*)&a, 0, sizeof(a));
    for (int i = 0; i < 38; ++i) a.P.in[i] = (const float*)d_in[i];
    a.P.out = (float*)d_out; a.P.ws = (unsigned char*)d_ws;
#if MK_PER_PHASE
    for (int p = 0; p < N_PHASES; ++p) { a.ph_lo = p; a.ph_hi = p + 1; hipLaunchKernelGGL(mega, dim3(grid), dim3(NT), LDS_BYTES, stream, a); }
#else
    a.ph_lo = 0; a.ph_hi = N_PHASES;
    hipLaunchKernelGGL(mega, dim3(grid), dim3(NT), LDS_BYTES, stream, a);
#endif
    const hipError_t le = hipPeekAtLastError();
    if (le != hipSuccess) fprintf(stderr, "kernel_launch: launch failed: %s\n", hipGetErrorName(le));
}
```

```cpp
#include <hip/hip_runtime.h>
#include <cstdio>
#include <cstdint>
#include <cstring>

typedef unsigned short bf16;
typedef unsigned u32x4 __attribute__((ext_vector_type(4)));
typedef float f32x4 __attribute__((ext_vector_type(4)));

constexpr int D = 1024, NB = 4, SEQ = 4096, CTX = 256, SU = SEQ + CTX, R = NB * SU;
constexpr int GRID_W = 64;
constexpr int LRU_W = 512, LRU_NB = 8, LRU_BW = 64;
constexpr int MLA_H = 4, MLA_QR = 384, MLA_KVR = 256, MLA_NOPE = 128, MLA_ROPE = 64, MLA_V = 128, MLA_QK = 192;
constexpr int EVEN_IN = 1728, EVEN_IN_P = 1792;
constexpr int DIFF_H = 8, ODD_IN = 3072;
constexpr int NE = 32, TOPK = 4, DFF = 1024;
constexpr float EPS = 1e-6f;
constexpr int CHUNK = 128, NCH = SU / CHUNK;

constexpr size_t al256(size_t x) { return (x + 255) / 256 * 256; }
constexpr size_t WS_CTL = 0;
constexpr size_t WS_MOD = 1u << 20;
constexpr size_t WS_SCAL = WS_MOD + al256(2 * 5 * 6144 * 4);
constexpr size_t WS_WEVIN = WS_SCAL + 8192;
constexpr size_t WS_WEVOUT = WS_WEVIN + (size_t)EVEN_IN_P * D * 2;
constexpr size_t WS_WUQ = WS_WEVOUT + (size_t)D * D * 2;
constexpr size_t WS_WUKV = WS_WUQ + (size_t)768 * 384 * 2;
constexpr size_t WS_WLRU = WS_WUKV + (size_t)1024 * 384 * 2;
constexpr size_t WS_WODIN = WS_WLRU + (size_t)32 * 4096 * 2;
constexpr size_t WS_WODOUT = WS_WODIN + (size_t)ODD_IN * D * 2;
constexpr size_t WS_WGU = WS_WODOUT + (size_t)D * D * 2;
constexpr size_t WS_WDN = WS_WGU + (size_t)2 * NE * 2048 * 1024 * 2;
constexpr size_t WS_XC = WS_WDN + (size_t)2 * NE * 1024 * 1024 * 2;
constexpr size_t WS_H = WS_XC + (size_t)NB * CTX * D * 4;
constexpr size_t WS_Z = WS_H + (size_t)R * D * 2;
constexpr size_t WS_QP = WS_Z + (size_t)R * ODD_IN * 2;
constexpr size_t WS_KVP = WS_QP + (size_t)R * 768 * 2;
constexpr size_t WS_QM = WS_KVP + (size_t)R * 1024 * 2;
constexpr size_t WS_KM = WS_QM + (size_t)R * 768 * 2;
constexpr size_t WS_VM = WS_KM + (size_t)R * 768 * 2;
constexpr size_t WS_AGG = WS_VM + (size_t)R * 512 * 2;
constexpr size_t WS_MIX = WS_AGG + al256((size_t)NB * NCH * 2 * 512 * 2 * 4);
constexpr size_t WS_TOKOF = WS_MIX + (size_t)R * D * 2;
constexpr size_t WS_PAIROF = WS_TOKOF + (size_t)NE * R * 4;
constexpr size_t WS_GATEOF = WS_PAIROF + (size_t)NE * R * 4;
constexpr size_t ACT_ROWS = (size_t)R * TOPK + NE * 256;
constexpr size_t WS_ACT = WS_GATEOF + (size_t)NE * R * 4;
constexpr size_t WS_Y = WS_ACT + ACT_ROWS * 1024 * 2;
constexpr size_t WS_XB = WS_Y + (size_t)R * TOPK * 1024 * 2;
constexpr size_t WS_ROPE = WS_XB + (size_t)R * D * 2;
constexpr size_t WS_END = WS_ROPE + (size_t)2 * SEQ * 64 * 4;

constexpr int CW_CNT = 64;

__device__ __forceinline__ float bf2f(bf16 v) { return __uint_as_float((unsigned)v << 16); }
__device__ __forceinline__ bf16 f2bf(float f) { unsigned u = __float_as_uint(f); return (bf16)((u + 0x7fffu + ((u >> 16) & 1u)) >> 16); }
__device__ __forceinline__ float wave_sum(float v) {
#pragma unroll
    for (int o = 1; o < 64; o <<= 1) v += __shfl_xor(v, o);
    return v;
}
__device__ __forceinline__ unsigned g8_cvt_pk(float lo, float hi) { unsigned r; asm volatile("v_cvt_pk_bf16_f32 %0, %1, %2" : "=v"(r) : "v"(lo), "v"(hi)); return r; }
__device__ __forceinline__ float sigmoidf_(float x) { return 1.f / (1.f + __expf(-x)); }
__device__ __forceinline__ float gelu_tanh(float x) { const float t = tanhf(0.7978845608028654f * (x + 0.044715f * x * x * x)); return 0.5f * x * (1.f + t); }

struct Ptrs {
    const float* in[38];
    float* out;
    unsigned char* ws;
};

__device__ __forceinline__ const float* res_in_row(const Ptrs& P, int layer, int u) {
    const int b = u / SU, j = u % SU;
    if (layer == 0) return j < CTX ? P.in[2] + (size_t)(b * CTX + j) * D : P.in[0] + (size_t)(b * SEQ + j - CTX) * D;
    return j < CTX ? (const float*)(P.ws + WS_XC) + (size_t)(b * CTX + j) * D : P.out + (size_t)(b * SEQ + j - CTX) * D;
}
__device__ __forceinline__ float* res_out_row(const Ptrs& P, int u) {
    const int b = u / SU, j = u % SU;
    return j < CTX ? (float*)(P.ws + WS_XC) + (size_t)(b * CTX + j) * D : P.out + (size_t)(b * SEQ + j - CTX) * D;
}
__device__ __forceinline__ const float* mod_row(const Ptrs& P, int layer, int u) {
    const int b = u / SU, j = u % SU;
    return (const float*)(P.ws + WS_MOD) + (size_t)(layer * 5 + (j < CTX ? 4 : b)) * 6144;
}

constexpr float LOG2E = 1.4426950408889634f;
#define GAS __attribute__((address_space(1)))
#define LAS __attribute__((address_space(3)))
constexpr int NT = 512;
constexpr int LDS_BYTES = 147456;
constexpr int RING_BYTES = 131072, LDSCTL_OFF = RING_BYTES, MISC_OFF = LDSCTL_OFF + 320;
constexpr int CW_BAR = 4096;
constexpr int CW_TMO = 0;

#define XB_TMO      128
#define XB_XCNT(j)  (256  + 64 * (j))
#define XB_XSUB(j)  (1280 + 64 * (j))
#define XB_XGEN(j)  (2304 + 64 * (j))
#define XB_TOP      3328
#define XB_TOPGEN   3392
#define XCD_BAR_WORDS 3456
#define XB_SPIN_CAP (1u << 22)
__device__ __forceinline__ unsigned xb_ld(unsigned* p)              { return __hip_atomic_load(p, __ATOMIC_RELAXED, __HIP_MEMORY_SCOPE_AGENT); }
__device__ __forceinline__ unsigned xb_add(unsigned* p, unsigned v) { return __hip_atomic_fetch_add(p, v, __ATOMIC_RELAXED, __HIP_MEMORY_SCOPE_AGENT); }
__device__ __forceinline__ unsigned xb_xcc_id() { return (unsigned)__builtin_amdgcn_s_getreg((3 << 11) | 20) & 0xFu; }
#define XB_SPIN(cond, bar) do { unsigned _sp = 0; while (cond) { __builtin_amdgcn_s_sleep(1); \
    if ((++_sp & 255u) == 0u) { if (xb_ld(&(bar)[XB_TMO])) break; if (_sp > XB_SPIN_CAP) { atomicAdd(&(bar)[XB_TMO], 1u); break; } } } } while (0)
struct XcdBarrier { unsigned* bar; unsigned x; volatile LAS unsigned* st; };
__device__ __forceinline__ XcdBarrier xcd_barrier_post(unsigned* bar, volatile LAS unsigned* st) {
    XcdBarrier b; b.bar = bar; b.x = xb_xcc_id(); b.st = st;
    if (threadIdx.x == 0) (void)xb_add(&bar[XB_XCNT(b.x)], 1u);
    return b;
}
__device__ __forceinline__ void xcd_barrier_complete(unsigned* bar, unsigned x, unsigned& nloc, unsigned& nx) {
    const unsigned G = gridDim.x * gridDim.y * gridDim.z;
    unsigned sum, cnt, mine, sp = 0u;
    for (;;) {
        sum = 0u; cnt = 0u; mine = 0u;
#pragma unroll
        for (unsigned j = 0; j < 16; ++j) { const unsigned c = xb_ld(&bar[XB_XCNT(j)]); sum += c; cnt += (c > 0u) ? 1u : 0u; mine = (j == x) ? c : mine; }
        if (sum == G) break;
        __builtin_amdgcn_s_sleep(1);
        if ((++sp & 255u) == 0u) { if (xb_ld(&bar[XB_TMO])) break; if (sp > XB_SPIN_CAP) { atomicAdd(&bar[XB_TMO], 1u); break; } }
    }
    nloc = mine > 0u ? mine : 1u; nx = cnt > 0u ? cnt : 1u;
}
__device__ __forceinline__ void xcd_barrier(const XcdBarrier& b) {
    asm volatile("s_waitcnt vmcnt(0)" ::: "memory");
    __syncthreads();
    if (threadIdx.x == 0) {
        unsigned* bar = b.bar;
        __builtin_amdgcn_s_waitcnt(0);
        unsigned nloc = b.st[0], nx = b.st[1];
        if (nloc == 0u) { xcd_barrier_complete(bar, b.x, nloc, nx); b.st[0] = nloc; b.st[1] = nx; }
        const unsigned old = xb_add(&bar[XB_XSUB(b.x)], 1u);
        const unsigned gen = old / nloc;
        if (old + 1u == (gen + 1u) * nloc) {
            __builtin_amdgcn_fence(__ATOMIC_RELEASE, "agent");
            asm volatile("s_waitcnt vmcnt(0)" ::: "memory");
            const unsigned og = xb_add(&bar[XB_TOP], 1u);
            const unsigned tg = og / nx;
            if (og + 1u == (tg + 1u) * nx) xb_add(&bar[XB_TOPGEN], 1u);
            else XB_SPIN(xb_ld(&bar[XB_TOPGEN]) == tg, bar);
            __builtin_amdgcn_fence(__ATOMIC_ACQUIRE, "agent");
            xb_add(&bar[XB_XGEN(b.x)], 1u);
            asm volatile("s_waitcnt vmcnt(0)" ::: "memory");
        } else {
            XB_SPIN(xb_ld(&bar[XB_XGEN(b.x)]) == gen, bar);
            __builtin_amdgcn_fence(__ATOMIC_ACQUIRE, "agent");
            asm volatile("s_waitcnt vmcnt(0)" ::: "memory");
        }
    }
    __syncthreads();
}

struct TJob { const float* src; bf16* dst; const float* rs; int K, N, Npad, perm, batch; size_t sstr, dstr; int Ksrc; };
__device__ __forceinline__ void tt_load(const TJob& j, int it, int lane, f32x4 (&v)[16]) {
    const int tn = j.Npad / 64, per = tn * (j.K / 64), z = it / per, r = it % per, n0 = (r % tn) * 64, k0 = (r / tn) * 64;
    const float* src = j.src + z * j.sstr;
    const int n4 = (lane & 15) * 4, np = n0 + n4;
    int sc = np; if (j.perm == 1) sc = (np / 256) * 128 + (np % 128) + ((np % 256) / 128) * 1024;
#pragma unroll
    for (int i = 0; i < 16; ++i) { const int k = k0 + i * 4 + (lane >> 4); f32x4 t = {0.f, 0.f, 0.f, 0.f}; if (sc < j.N && k < j.Ksrc) { t = *(const f32x4*)(src + (size_t)k * j.N + sc); if (j.rs) t = t * j.rs[k]; } v[i] = t; }
}
__device__ __forceinline__ void tt_store(const TJob& j, int it, int lane, const f32x4 (&v)[16], float* wt) {
    const int tn = j.Npad / 64, per = tn * (j.K / 64), z = it / per, r = it % per, n0 = (r % tn) * 64, k0 = (r / tn) * 64;
    bf16* dst = j.dst + z * j.dstr + ((((size_t)(n0 >> 8) * (j.K >> 6) + (k0 >> 6)) << 14) + (((n0 & 255) + lane) << 6));
    const int n4 = (lane & 15) * 4;
#pragma unroll
    for (int half = 0; half < 2; ++half) {
#pragma unroll
        for (int i = 0; i < 8; ++i) *(f32x4*)(wt + (i * 4 + (lane >> 4)) * 68 + n4) = v[half * 8 + i];
        asm volatile("s_waitcnt lgkmcnt(0)" ::: "memory");
#pragma unroll
        for (int kc = 0; kc < 4; ++kc) { float f[8];
#pragma unroll
            for (int q = 0; q < 8; ++q) f[q] = wt[(kc * 8 + q) * 68 + lane];
            u32x4 w; w.x = f2bf(f[0]) | ((unsigned)f2bf(f[1]) << 16); w.y = f2bf(f[2]) | ((unsigned)f2bf(f[3]) << 16); w.z = f2bf(f[4]) | ((unsigned)f2bf(f[5]) << 16); w.w = f2bf(f[6]) | ((unsigned)f2bf(f[7]) << 16);
            *(u32x4*)(dst + half * 32 + kc * 8) = w; }
        asm volatile("s_waitcnt lgkmcnt(0)" ::: "memory");
    }
}
__device__ __forceinline__ void run_tjob(const TJob& j, float* wt, int& base, int NW, int gw, int lane) {
    const int total = (j.Npad / 64) * (j.K / 64) * j.batch;
    int it = (gw - base % NW + NW) % NW;
    if (it < total) {
        f32x4 cur[16], nxt[16];
        tt_load(j, it, lane, cur);
        for (; it < total; it += NW) {
            const bool more = it + NW < total;
            if (more) tt_load(j, it + NW, lane, nxt);
            tt_store(j, it, lane, cur, wt);
            if (more) {
#pragma unroll
                for (int i = 0; i < 16; ++i) cur[i] = nxt[i]; }
        }
    }
    base += total;
}
__device__ __forceinline__ void bt_load(const float* __restrict__ src, int N, int perm, int it, int ntn, f32x4 (&v)[8]) {
    const int wid = threadIdx.x >> 6, lane = threadIdx.x & 63;
    const int per = 16 * ntn, z = it / per, r = it % per, kt = r / ntn, nt = r % ntn;
    const int np = nt * 256 + lane * 4;
    const int sc = perm ? (nt * 128 + (lane & 31) * 4 + (lane >> 5) * 1024) : np;
    const float* p = src + (size_t)z * 1024 * N + (size_t)(kt * 64 + wid * 8) * N + sc;
#pragma unroll
    for (int i = 0; i < 8; ++i) v[i] = *(const f32x4*)(p + (size_t)i * N);
}
__device__ __forceinline__ void ph_big_transpose(const float* __restrict__ src, int N, int perm, int batch, bf16* __restrict__ dst, float* tile  , int G) {
    const int tid = threadIdx.x, wid = tid >> 6, lane = tid & 63, ntn = N / 256, total = batch * 16 * ntn;
    int it = (int)blockIdx.x;
    if (it >= total) return;
    f32x4 cur[8], nxt[8], nx2[8];
    bt_load(src, N, perm, it, ntn, cur);
    if (it + G < total) bt_load(src, N, perm, it + G, ntn, nxt);
    for (; it < total; it += G) {
        const bool more = it + G < total, more2 = it + 2 * G < total;
        if (more2) bt_load(src, N, perm, it + 2 * G, ntn, nx2);
        __syncthreads();
#pragma unroll
        for (int i = 0; i < 8; ++i) { float* t = tile + (wid * 8 + i) * 257 + lane * 4; t[0] = cur[i][0]; t[1] = cur[i][1]; t[2] = cur[i][2]; t[3] = cur[i][3]; }
        __syncthreads();
        const int per = 16 * ntn, z = it / per, r = it % per, kt = r / ntn, nt = r % ntn;
        bf16* d = dst + (size_t)z * N * 1024 + (((size_t)nt * 16 + kt) << 14);
        const int kc = lane & 7;
#pragma unroll
        for (int pss = 0; pss < 4; ++pss) {
            const int n = wid * 32 + pss * 8 + (lane >> 3); float f[8];
#pragma unroll
            for (int j = 0; j < 8; ++j) f[j] = tile[(kc * 8 + j) * 257 + n];
            u32x4 w; w.x = g8_cvt_pk(f[0], f[1]); w.y = g8_cvt_pk(f[2], f[3]); w.z = g8_cvt_pk(f[4], f[5]); w.w = g8_cvt_pk(f[6], f[7]);
            *(u32x4*)(d + n * 64 + kc * 8) = w;
        }
        if (more) {
#pragma unroll
            for (int i = 0; i < 8; ++i) { cur[i] = nxt[i]; nxt[i] = nx2[i]; } }
    }
    __syncthreads();
}
#ifndef PROBE_SUB
#define PROBE_SUB 0
#define PROBE_SUBDK 0
#endif
#define PSEC(k) do { if (PROBE_SUB == (k)) { const unsigned t_ = (unsigned)__builtin_readcyclecounter(); sacc += t_ - pt0; } if (PROBE_SUB >= 10) pt0 = (unsigned)__builtin_readcyclecounter(); } while (0)
__device__ __forceinline__ void ph_prologue(const Ptrs& P, unsigned char* lds, unsigned& sacc) {
    unsigned char* ws = P.ws; const int G = gridDim.x; int base = 0; unsigned pt0 = 0u; PSEC(-1);
    const int wave = threadIdx.x >> 6, lane = threadIdx.x & 63, NW = G * 8, gw = (int)blockIdx.x + G * wave;
    float* wt = (float*)lds + wave * (32 * 68);
    {
        float* s = (float*)lds + 8 * 32 * 68;
        float* part = s + 5 * 1024;
        for (int it = (int)blockIdx.x; it < 2 * 128; it += G) {
            const int layer = it / 128, cb = (it % 128) * 48;
            __syncthreads();
            for (int i = threadIdx.x; i < 5 * 1024; i += NT) { const int r = i / 1024, k = i % 1024; const float c = r < 4 ? P.in[1][r * 1024 + k] : P.in[3][k]; s[i] = c / (1.f + __expf(-c)); }
            __syncthreads();
            const int kr = lane >> 4, c4 = (lane & 15) < 12 ? (lane & 15) * 4 : 44;
            const float* w = P.in[4] + (size_t)layer * 1024 * 6144 + (size_t)(wave * 128 + kr) * 6144 + cb + c4;
            float a[5][4];
#pragma unroll
            for (int r = 0; r < 5; ++r) { a[r][0] = 0.f; a[r][1] = 0.f; a[r][2] = 0.f; a[r][3] = 0.f; }
#pragma unroll 1
            for (int hh = 0; hh < 2; ++hh) {
                f32x4 wv[16];
#pragma unroll
                for (int i = 0; i < 16; ++i) wv[i] = *(const f32x4*)(w + (size_t)(hh * 64 + i * 4) * 6144);
#pragma unroll
                for (int i = 0; i < 16; ++i) { const int k = wave * 128 + hh * 64 + i * 4 + kr;
#pragma unroll
                    for (int r = 0; r < 5; ++r) { const float sv = s[r * 1024 + k]; a[r][0] += sv * wv[i][0]; a[r][1] += sv * wv[i][1]; a[r][2] += sv * wv[i][2]; a[r][3] += sv * wv[i][3]; } }
            }
#pragma unroll
            for (int r = 0; r < 5; ++r)
#pragma unroll
                for (int e = 0; e < 4; ++e) { float t = a[r][e]; t += __shfl_xor(t, 16); t += __shfl_xor(t, 32); if (lane < 12) part[(wave * 5 + r) * 64 + c4 + e] = t; }
            __syncthreads();
            if (threadIdx.x < 320 && (threadIdx.x & 63) < 48) { const int r = threadIdx.x / 64, c = threadIdx.x % 64; float t = P.in[5][layer * 6144 + cb + c];
#pragma unroll
                for (int wv = 0; wv < 8; ++wv) t += part[(wv * 5 + r) * 64 + c];
                ((float*)(ws + WS_MOD))[(size_t)(layer * 5 + r) * 6144 + cb + c] = t; }
        }
        __syncthreads();
    }
    PSEC(10);
    TJob j;
    ph_big_transpose(P.in[34], 2048, 1, 2 * NE, (bf16*)(ws + WS_WGU), (float*)lds, G);
    PSEC(11);
    ph_big_transpose(P.in[36], 1024, 0, 2 * NE, (bf16*)(ws + WS_WDN), (float*)lds, G);
    PSEC(12);
    j = TJob{P.in[8], (bf16*)(ws + WS_WEVIN), nullptr, 1024, EVEN_IN, EVEN_IN_P, 0, 1, 0, 0, 1024}; run_tjob(j, wt, base, NW, gw, lane);
    j = TJob{P.in[9], (bf16*)(ws + WS_WEVOUT), nullptr, 1024, 1024, 1024, 0, 1, 0, 0, 1024}; run_tjob(j, wt, base, NW, gw, lane);
    j = TJob{P.in[18], (bf16*)(ws + WS_WUQ), P.in[17], 384, 768, 768, 0, 1, 0, 0, 384}; run_tjob(j, wt, base, NW, gw, lane);
    j = TJob{P.in[20], (bf16*)(ws + WS_WUKV), P.in[19], 384, 1024, 1024, 0, 1, 0, 0, 256}; run_tjob(j, wt, base, NW, gw, lane);
    j = TJob{P.in[12], (bf16*)(ws + WS_WLRU), nullptr, 64, 64, 64, 0, 8, 4096, 4096, 64}; run_tjob(j, wt, base, NW, gw, lane);
    j = TJob{P.in[14], (bf16*)(ws + WS_WLRU) + 8 * 4096, nullptr, 64, 64, 64, 0, 8, 4096, 4096, 64}; run_tjob(j, wt, base, NW, gw, lane);
    j = TJob{P.in[12] + 8 * 4096, (bf16*)(ws + WS_WLRU) + 16 * 4096, nullptr, 64, 64, 64, 0, 8, 4096, 4096, 64}; run_tjob(j, wt, base, NW, gw, lane);
    j = TJob{P.in[14] + 8 * 4096, (bf16*)(ws + WS_WLRU) + 24 * 4096, nullptr, 64, 64, 64, 0, 8, 4096, 4096, 64}; run_tjob(j, wt, base, NW, gw, lane);
    j = TJob{P.in[23], (bf16*)(ws + WS_WODIN), nullptr, 1024, ODD_IN, ODD_IN, 0, 1, 0, 0, 1024}; run_tjob(j, wt, base, NW, gw, lane);
    j = TJob{P.in[24], (bf16*)(ws + WS_WODOUT), nullptr, 1024, 1024, 1024, 0, 1, 0, 0, 1024}; run_tjob(j, wt, base, NW, gw, lane);
    __syncthreads();
    PSEC(13);
    {
        float* rc = (float*)(ws + WS_ROPE); float* rs = rc + SEQ * 64;
        for (int i = (int)blockIdx.x * NT + threadIdx.x; i < SEQ * 64; i += G * NT) {
            const int t = i >> 6, e = i & 63, q = e & 15;
            const float f = exp2f(-(float)(2 * q) / 32.f * 13.287712379549449f);
            const float ang = (float)((e >> 5) ? (t % GRID_W) : (t / GRID_W)) * f;
            float sv, cv; sincosf(ang, &sv, &cv); rc[i] = cv; rs[i] = sv;
        }
    }
    if ((int)blockIdx.x == G - 2) { float* c8t = (float*)(ws + WS_SCAL) + 1024; for (int i = threadIdx.x; i < 2 * LRU_W; i += NT) c8t[i] = 8.f * LOG2E * log1pf(__expf(-P.in[16][i])); }
    if ((int)blockIdx.x == G - 1 && threadIdx.x == 0) {
        float* sc = (float*)(ws + WS_SCAL);
        float mq = 0, mk = 0;
        for (int i = 0; i < 192; ++i) { mq = fmaxf(mq, fabsf(P.in[21][i])); mk = fmaxf(mk, fabsf(P.in[22][i])); }
        sc[0] = sqrtf(192.f) * mq * mk * LOG2E;
        mq = 0; mk = 0;
        for (int i = 0; i < 64; ++i) { mq = fmaxf(mq, fabsf(P.in[25][i])); mk = fmaxf(mk, fabsf(P.in[26][i])); }
        sc[1] = 8.f * mq * mk * LOG2E;
        float s1 = 0, s2 = 0;
        for (int i = 0; i < 64; ++i) { s1 += P.in[27][i] * P.in[28][i]; s2 += P.in[29][i] * P.in[30][i]; }
        const float lam_init = 0.8f - 0.6f * expf(-0.3f * 1.f);
        sc[2] = expf(s1) - expf(s2) + lam_init;
        sc[3] = 1.f - lam_init;
    }
}

__device__ __forceinline__ void norm_mod_store(const Ptrs& P, float (&v)[16], int lane, int u, int layer, int which) {
    const float* g = (which == 0 ? P.in[6] : P.in[7]) + layer * D;
    const float* md = mod_row(P, layer, u) + (which == 0 ? 0 : 3 * D);
    f32x4 gv[4], scv[4], shv[4];
#pragma unroll
    for (int j = 0; j < 4; ++j) { const int c = j * 256 + lane * 4; gv[j] = *(const f32x4*)(g + c); scv[j] = *(const f32x4*)(md + D + c); shv[j] = *(const f32x4*)(md + c); }
    float ss = 0.f;
#pragma unroll
    for (int i = 0; i < 16; ++i) ss += v[i] * v[i];
    const float rstd = rsqrtf(wave_sum(ss) * (1.f / D) + EPS);
    bf16* h = (bf16*)(P.ws + WS_H) + (size_t)u * D;
#pragma unroll
    for (int j = 0; j < 4; ++j) {
        const int c = j * 256 + lane * 4;
#pragma unroll
        for (int e = 0; e < 4; ++e) v[4 * j + e] = v[4 * j + e] * rstd * gv[j][e] * (1.f + scv[j][e]) + shv[j][e];
        const unsigned lo = f2bf(v[4 * j]) | ((unsigned)f2bf(v[4 * j + 1]) << 16), hi = f2bf(v[4 * j + 2]) | ((unsigned)f2bf(v[4 * j + 3]) << 16);
        *(uint2*)(h + c) = make_uint2(lo, hi);
    }
}
struct RowIn { f32x4 xf[4]; uint2 xb[4]; uint2 y[4][4]; };
__device__ __forceinline__ RowIn rows_load(const Ptrs& P, int layer, int mode, int u, int lane) {
    RowIn r{};
    if (mode == 0) { const float* x = res_in_row(P, layer, u);
#pragma unroll
        for (int j = 0; j < 4; ++j) r.xf[j] = *(const f32x4*)(x + j * 256 + lane * 4); }
    else { const bf16* x = (const bf16*)(P.ws + WS_XB) + (size_t)u * D; const bf16* y = (const bf16*)(P.ws + WS_Y) + (size_t)u * 4 * 1024;
#pragma unroll
        for (int j = 0; j < 4; ++j) { const int c = j * 256 + lane * 4; r.xb[j] = *(const uint2*)(x + c);
#pragma unroll
            for (int k = 0; k < 4; ++k) r.y[k][j] = *(const uint2*)(y + k * 1024 + c); } }
    return r;
}
__device__ __forceinline__ void ph_rows(const Ptrs& P, int layer, int mode, int latent_only, int next_norm) {
    const int wave = threadIdx.x >> 6, lane = threadIdx.x & 63, G = gridDim.x;
    const int NR = latent_only ? NB * SEQ : R;
#define ROW_U(q) (latent_only ? ((q) / SEQ) * SU + CTX + (q) % SEQ : (q))
    int q = (int)blockIdx.x * 8 + wave;
    if (q >= NR) return;
    RowIn cur = rows_load(P, layer, mode, ROW_U(q), lane);
    for (; q < NR; q += G * 8) {
        const int u = ROW_U(q), qn = q + G * 8;
        RowIn nxt = cur;
        if (qn < NR) nxt = rows_load(P, layer, mode, ROW_U(qn), lane);
        float v[16];
        if (mode == 0) {
#pragma unroll
            for (int j = 0; j < 4; ++j) { v[4 * j] = cur.xf[j][0]; v[4 * j + 1] = cur.xf[j][1]; v[4 * j + 2] = cur.xf[j][2]; v[4 * j + 3] = cur.xf[j][3]; }
            norm_mod_store(P, v, lane, u, layer, 0);
        } else {
            const float* g2 = mod_row(P, layer, u) + 5 * D; float* xo = res_out_row(P, u); bf16* xbo = (bf16*)(P.ws + WS_XB) + (size_t)u * D;
            f32x4 gv[4];
#pragma unroll
            for (int j = 0; j < 4; ++j) gv[j] = *(const f32x4*)(g2 + j * 256 + lane * 4);
#pragma unroll
            for (int j = 0; j < 4; ++j) { const int c = j * 256 + lane * 4; f32x4 o;
                const uint2 t = cur.xb[j];
                v[4 * j] = __uint_as_float(t.x << 16); v[4 * j + 1] = __uint_as_float(t.x & 0xffff0000u); v[4 * j + 2] = __uint_as_float(t.y << 16); v[4 * j + 3] = __uint_as_float(t.y & 0xffff0000u);
                float f[4] = {0.f, 0.f, 0.f, 0.f};
#pragma unroll
                for (int k = 0; k < 4; ++k) { const uint2 w = cur.y[k][j]; f[0] += __uint_as_float(w.x << 16); f[1] += __uint_as_float(w.x & 0xffff0000u); f[2] += __uint_as_float(w.y << 16); f[3] += __uint_as_float(w.y & 0xffff0000u); }
#pragma unroll
                for (int e = 0; e < 4; ++e) { v[4 * j + e] += gv[j][e] * f[e]; o[e] = v[4 * j + e]; }
                if (next_norm) { uint2 w; w.x = g8_cvt_pk(o[0], o[1]); w.y = g8_cvt_pk(o[2], o[3]); *(uint2*)(xbo + c) = w; }
                else *(f32x4*)(xo + c) = o; }
            if (next_norm) norm_mod_store(P, v, lane, u, layer + 1, 0);
        }
        cur = nxt;
    }
#undef ROW_U
}

namespace g8 {
typedef short bf16x8 __attribute__((ext_vector_type(8)));
constexpr int BM = 256, BK = 64, HALF = 128, HTB = HALF * BK * 2, STAGE_BYTES = 8 * HTB, NXCD = 8, WGM = 8;
__host__ __device__ __forceinline__ int lds_byte(int r, int c) { const int st = (r >> 4) * 2 + (c >> 5), rr = r & 15, cc = c & 31, ob = rr * 64 + cc * 2; return st * 1024 + (ob ^ (((ob >> 9) & 1) << 5)); }
__host__ __device__ __forceinline__ void stage_rc(int b, int& R, int& C) { const int st = b / 1024, sb = b % 1024, swz = sb ^ (((sb >> 9) & 1) << 5); R = (st >> 1) * 16 + swz / 64; C = (st & 1) * 32 + (swz % 64) / 2; }
__host__ __device__ __forceinline__ int perm32(int rho) { const int n = rho >> 4, i = rho & 15; return 8 * (i >> 2) + 4 * n + (i & 3); }
struct Unit { const char* a; const char* b; int pm, pn, e, aux, cnt; };
__device__ __forceinline__ unsigned cvt_pk_bf16(float lo, float hi) { unsigned r; asm volatile("v_cvt_pk_bf16_f32 %0, %1, %2" : "=v"(r) : "v"(lo), "v"(hi)); return r; }

template <class Epi, class Sched, bool GATHER, bool ALIGN_EPI, bool PFB = false>
__device__ __forceinline__ void gemm_phase(LAS unsigned char* lds, const int lda, const int K, const Sched& S, const Epi& E) {
    const int tid = threadIdx.x, wid = __builtin_amdgcn_readfirstlane(tid >> 6), lane = tid & 63, wr = wid >> 2, wc = wid & 3, fr = lane & 15, fq = lane >> 4;
    const int nt = K / BK;
    int Rr[2], Cc[2]; unsigned voffB[2];
#pragma unroll
    for (int i = 0; i < 2; ++i) { stage_rc(tid * 16 + i * 8192, Rr[i], Cc[i]); const int Rb = Epi::PERM ? ((Rr[i] & ~31) + perm32(Rr[i] & 31)) : Rr[i]; voffB[i] = (unsigned)(Rb * BK + Cc[i]) * 2u; }
    const size_t kstep = (size_t)(BK * 2), kstepB = (size_t)BM * BK * 2;
    const size_t hstepB = (size_t)HALF * BK * 2;
    const unsigned ldsw = (unsigned)wid * 1024u;
    const int aoff = lds_byte(wr * 64 + fr, fq * 8), boff = lds_byte(wc * 32 + fr, fq * 8);
#define G8_SA(b, h) (((b) * 2 + (h)) * HTB)
#define G8_SB(b, h) ((4 + (b) * 2 + (h)) * HTB)
#define G8_STAGE(bufoff, gbase, v0, v1) do { \
        __builtin_amdgcn_global_load_lds((const unsigned*)((const char*)(gbase) + (v0)), (LAS unsigned*)(lds + (bufoff) + ldsw), 16, 0, 0); \
        __builtin_amdgcn_global_load_lds((const unsigned*)((const char*)(gbase) + (v1)), (LAS unsigned*)(lds + (bufoff) + ldsw + 8192), 16, 0, 0); } while (0)
#define G8_LDA(dst, b, h) do { _Pragma("unroll") for (int m = 0; m < 4; ++m) _Pragma("unroll") for (int k = 0; k < 2; ++k) dst[m][k] = *(const LAS bf16x8*)(lds + G8_SA(b, h) + aoff + m * 2048 + k * 1024); } while (0)
#define G8_LDB(dst, b, h) do { _Pragma("unroll") for (int n = 0; n < 2; ++n) _Pragma("unroll") for (int k = 0; k < 2; ++k) dst[n][k] = *(const LAS bf16x8*)(lds + G8_SB(b, h) + boff + n * 2048 + k * 1024); } while (0)
#define G8_MMA(ai, bj, At, Bt) do { __builtin_amdgcn_s_setprio(1); _Pragma("unroll") for (int m = 0; m < 4; ++m) _Pragma("unroll") for (int n = 0; n < 2; ++n) _Pragma("unroll") for (int k = 0; k < 2; ++k) \
        acc[ai][bj][m][n] = __builtin_amdgcn_mfma_f32_16x16x32_bf16(Bt[n][k], At[m][k], acc[ai][bj][m][n], 0, 0, 0); __builtin_amdgcn_s_setprio(0); } while (0)
#define G8_WAIT_V(n) asm volatile("s_waitcnt vmcnt(" #n ")" ::: "memory")
#define G8_WAIT_L(n) asm volatile("s_waitcnt lgkmcnt(" #n ")" ::: "memory")
#define G8_BAR __builtin_amdgcn_s_barrier()
#define G8_SCHED __builtin_amdgcn_sched_barrier(0)
    Unit cur, nxt; int ui = 0;
    if (!S.next(0, cur)) return;
    unsigned vA0[2], vA1[2], nA0[2], nA1[2];
#pragma unroll
    for (int i = 0; i < 2; ++i) {
        if (GATHER) { vA0[i] = S.arow_off(cur, Rr[i]) + (unsigned)Cc[i] * 2u; vA1[i] = S.arow_off(cur, HALF + Rr[i]) + (unsigned)Cc[i] * 2u; }
        else { vA0[i] = (unsigned)(Rr[i] * lda + Cc[i]) * 2u; vA1[i] = (unsigned)((HALF + Rr[i]) * lda + Cc[i]) * 2u; }
        nA0[i] = vA0[i]; nA1[i] = vA1[i];
    }
    f32x4 acc[2][2][4][2];
#pragma unroll
    for (int a = 0; a < 2; ++a)
#pragma unroll
        for (int b = 0; b < 2; ++b)
#pragma unroll
            for (int m = 0; m < 4; ++m)
#pragma unroll
                for (int n = 0; n < 2; ++n) acc[a][b][m][n] = (f32x4){0.f, 0.f, 0.f, 0.f};
    bf16x8 At[4][2], B0[2][2], B1[2][2];
    const char* cA = cur.a; const char* cB = cur.b;
    G8_STAGE(G8_SB(0, 0), cB, voffB[0], voffB[1]); G8_STAGE(G8_SB(0, 1), cB + hstepB, voffB[0], voffB[1]); G8_STAGE(G8_SA(0, 0), cA, vA0[0], vA0[1]); G8_STAGE(G8_SA(0, 1), cA, vA1[0], vA1[1]);
    if (wr == 1) G8_BAR;
    G8_WAIT_V(2); G8_BAR;
    G8_STAGE(G8_SB(1, 0), cB + kstepB, voffB[0], voffB[1]); G8_STAGE(G8_SA(1, 0), cA + kstep, vA0[0], vA0[1]); G8_STAGE(G8_SB(1, 1), cB + hstepB + kstepB, voffB[0], voffB[1]);
    G8_WAIT_V(6); G8_BAR;
    for (;;) {
        const bool has_next = S.next(ui + 1, nxt);
        const char* nA = has_next ? nxt.a : cA; const char* nB = has_next ? nxt.b : cB;
        unsigned pf_dummy = 0u;
        if (PFB && has_next && nB != cB) {
            const char* pb = nB + (size_t)tid * 128;
#pragma unroll
            for (int i = 0; i < 8; ++i) { if (i * NT * 128 < 256 * K * 2) asm volatile("global_load_dword %0, %1, off" : "+v"(pf_dummy) : "v"(pb + (size_t)i * NT * 128) : "memory"); }
        }
        if (GATHER) {
#pragma unroll
            for (int i = 0; i < 2; ++i) { if (has_next) { nA0[i] = S.arow_off(nxt, Rr[i]) + (unsigned)Cc[i] * 2u; nA1[i] = S.arow_off(nxt, HALF + Rr[i]) + (unsigned)Cc[i] * 2u; } else { nA0[i] = vA0[i]; nA1[i] = vA1[i]; } }
        }
#pragma unroll 1
        for (int t = 0; t < nt; t += 2) {
            const bool last = (t == nt - 2);
            const char* a1 = cA + (size_t)(t + 1) * kstep;
            const char* a2 = last ? nA : cA + (size_t)(t + 2) * kstep; const char* b2 = last ? nB : cB + (size_t)(t + 2) * kstepB;
            const char* a3 = a2 + kstep; const char* b3 = b2 + kstepB;
            unsigned x00 = vA0[0], x01 = vA0[1], x10 = vA1[0], x11 = vA1[1];
            if (GATHER) { x00 = last ? nA0[0] : vA0[0]; x01 = last ? nA0[1] : vA0[1]; x10 = last ? nA1[0] : vA1[0]; x11 = last ? nA1[1] : vA1[1]; }
            G8_LDB(B0, 0, 0); G8_LDB(B1, 0, 1); G8_SCHED; G8_LDA(At, 0, 0); G8_STAGE(G8_SA(1, 1), a1, vA1[0], vA1[1]);
            G8_WAIT_V(8); if (PFB) asm volatile("" : "+v"(pf_dummy)); G8_WAIT_L(0); G8_BAR; G8_MMA(0, 0, At, B0); G8_MMA(0, 1, At, B1); G8_BAR; G8_SCHED;
            G8_LDA(At, 0, 1); G8_STAGE(G8_SB(0, 0), b2, voffB[0], voffB[1]); G8_STAGE(G8_SB(0, 1), b2 + hstepB, voffB[0], voffB[1]); G8_STAGE(G8_SA(0, 0), a2, x00, x01);
            G8_WAIT_V(8); G8_WAIT_L(0); G8_BAR; G8_MMA(1, 0, At, B0); G8_MMA(1, 1, At, B1); G8_BAR; G8_SCHED;
            G8_LDB(B0, 1, 0); G8_LDB(B1, 1, 1); G8_SCHED; G8_LDA(At, 1, 0); G8_STAGE(G8_SA(0, 1), a2, x10, x11);
            G8_WAIT_V(8); G8_WAIT_L(0); G8_BAR; G8_MMA(0, 0, At, B0); G8_MMA(0, 1, At, B1); G8_BAR; G8_SCHED;
            G8_LDA(At, 1, 1); G8_STAGE(G8_SB(1, 0), b3, voffB[0], voffB[1]); G8_STAGE(G8_SB(1, 1), b3 + hstepB, voffB[0], voffB[1]); G8_STAGE(G8_SA(1, 0), a3, x00, x01);
            G8_WAIT_V(8); G8_WAIT_L(0); G8_BAR; G8_MMA(1, 0, At, B0); G8_MMA(1, 1, At, B1); G8_BAR; G8_SCHED;
        }
        if constexpr (ALIGN_EPI) { if (wr == 0) G8_BAR; }
        E(acc, cur, wr, wc, fr, fq);
        if (!has_next) break;
#pragma unroll
        for (int a = 0; a < 2; ++a)
#pragma unroll
            for (int b = 0; b < 2; ++b)
#pragma unroll
                for (int m = 0; m < 4; ++m)
#pragma unroll
                    for (int n = 0; n < 2; ++n) acc[a][b][m][n] = (f32x4){0.f, 0.f, 0.f, 0.f};
        cur = nxt; cA = nA; cB = nB; ++ui;
        if (GATHER) {
#pragma unroll
            for (int i = 0; i < 2; ++i) { vA0[i] = nA0[i]; vA1[i] = nA1[i]; }
        }
        if constexpr (ALIGN_EPI) { if (wr == 1) G8_BAR; }
    }
    G8_WAIT_V(0);
    if constexpr (!ALIGN_EPI) { if (wr == 0) G8_BAR; }
    G8_BAR;
#undef G8_SA
#undef G8_SB
#undef G8_STAGE
#undef G8_LDA
#undef G8_LDB
#undef G8_MMA
#undef G8_WAIT_V
#undef G8_WAIT_L
#undef G8_BAR
#undef G8_SCHED
}

struct DenseOrder {
    const char* A; const char* Bt; int lda, K, nM, nN, nwg, G, c, skip_ctx;
    __device__ __forceinline__ void init(const bf16* A_, int lda_, const bf16* Bt_, int K_, int M, int N, int G_, int c_, int skip_ctx_) {
        A = (const char*)A_; Bt = (const char*)Bt_; lda = lda_; K = K_; skip_ctx = skip_ctx_; nM = M / BM; if (skip_ctx) nM = nM / 17 * 16; nN = N / BM; nwg = nM * nN; G = G_; c = c_; }
    __device__ __forceinline__ bool next(int i, Unit& u) const {
        const long L = (long)i * G + c; if (L >= nwg) return false;
        int wgid = (int)L; { const int q = nwg / NXCD, r = nwg % NXCD, xcd = wgid % NXCD, off = wgid / NXCD; wgid = (xcd < r ? xcd * (q + 1) : r * (q + 1) + (xcd - r) * q) + off; }
        const int nig = WGM * nN, gid = wgid / nig, fm = gid * WGM, gsz = (nM - fm) < WGM ? (nM - fm) : WGM;
        int pm = fm + ((wgid % nig) % gsz); const int pn = (wgid % nig) / gsz;
        if (skip_ctx) pm = (pm / 16) * 17 + 1 + (pm % 16);
        u.pm = pm; u.pn = pn; u.e = 0; u.aux = 0; u.cnt = 0;
        u.a = A + (size_t)pm * BM * lda * 2; u.b = Bt + (size_t)pn * BM * K * 2; return true;
    }
    __device__ __forceinline__ unsigned arow_off(const Unit&, int) const { return 0u; }
};
}
namespace g8 {
struct MoeOrder {
    const char* Abase; const char* Bbase; const int* rowtab; size_t bstride; int nN, K, G, vcu, gather;
    LAS int* tab;
    __device__ __forceinline__ void init(const unsigned* cnt, LAS int* tab_) {
        tab = tab_;
        __syncthreads();
        if (threadIdx.x < 64) {
            const int lane = threadIdx.x, me = lane & 31;
            const int c = (int)cnt[me];
            int run = 0, ab = 0, ms = 0, mab = 0;
            for (int e = 0; e < NE; ++e) { const int ce = __builtin_amdgcn_readlane(c, e), mt = (ce + 255) >> 8; if (me == e) { ms = run; mab = ab; } run += mt * nN; ab += mt << 8; }
            if (lane < 32) { tab[lane] = ms; tab[32 + lane] = c; tab[64 + lane] = mab; }
            if (lane == 0) tab[96] = run;
        }
        __syncthreads();
    }
    __device__ __forceinline__ bool next(int i, Unit& u) const {
        const int L = i * G + vcu;
        if (L >= tab[96]) return false;
        const int me = threadIdx.x & 31;
        const int st_l = tab[me], c_l = tab[32 + me];
        const unsigned long long m = __ballot(L >= st_l && L < st_l + ((c_l + 255) >> 8) * nN);
        const int e = __builtin_amdgcn_readfirstlane(__builtin_ctzll(m) & 31);
        const int st = tab[e], c = tab[32 + e], ab = tab[64 + e];
        const int l = L - st;
        const int sh = nN == 8 ? 3 : 2;
        u.e = e; u.pm = l >> sh; u.pn = l & (nN - 1); u.aux = ab; u.cnt = c;
        u.a = gather ? Abase : Abase + (size_t)(ab + u.pm * 256) * 1024 * 2; u.b = Bbase + (size_t)e * bstride + (size_t)u.pn * 256 * K * 2; return true;
    }
    __device__ __forceinline__ unsigned arow_off(const Unit& u, int r) const { int rr = u.pm * 256 + r; rr = rr < u.cnt ? rr : u.cnt - 1; return (unsigned)rowtab[(size_t)u.e * R + rr] * (unsigned)(D * 2); }
};
struct UpOrder {
    const char* Z; const char* Wq; const char* Wkv; int G, c;
    __device__ __forceinline__ bool next(int i, Unit& u) const {
        const int L = i * G + c; if (L >= 476) return false;
        const int kv = L >= 204, l = kv ? L - 204 : L, pn = l / 68, pm = l % 68;
        u.pm = pm; u.pn = kv ? 3 + pn : pn; u.e = 0; u.aux = kv; u.cnt = 0;
        u.a = Z + ((size_t)pm * BM * EVEN_IN_P + 1024 + kv * 384) * 2; u.b = Wq + (size_t)u.pn * BM * 384 * 2; return true;
    }
    __device__ __forceinline__ unsigned arow_off(const Unit&, int) const { return 0u; }
};
struct EpiStoreBf16 {
    static constexpr bool PERM = true; bf16* C; int ldc;
    __device__ __forceinline__ void operator()(const f32x4 (&acc)[2][2][4][2], const Unit& u, int wr, int wc, int fr, int fq) const {
        const int row0 = u.pm * BM + wr * 64 + fr, col0 = u.pn * BM + wc * 32 + 8 * fq;
#pragma unroll
        for (int ai = 0; ai < 2; ++ai)
#pragma unroll
            for (int m = 0; m < 4; ++m) { bf16* rowp = C + (size_t)(row0 + ai * HALF + m * 16) * ldc + col0;
#pragma unroll
                for (int bj = 0; bj < 2; ++bj) { const f32x4 v0 = acc[ai][bj][m][0], v1 = acc[ai][bj][m][1];
                    u32x4 w; w.x = cvt_pk_bf16(v0[0], v0[1]); w.y = cvt_pk_bf16(v0[2], v0[3]); w.z = cvt_pk_bf16(v1[0], v1[1]); w.w = cvt_pk_bf16(v1[2], v1[3]);
                    *(u32x4*)(rowp + bj * HALF) = w; } }
    }
};
struct EpiDiffIn {
    static constexpr bool PERM = true; bf16* C; const float* qn; const float* kn; const float* rc; const float* rs; LAS float* xch  ;
    __device__ __forceinline__ void operator()(const f32x4 (&acc)[2][2][4][2], const Unit& u, int wr, int wc, int fr, int fq) const {
        const int row0 = u.pm * BM + wr * 64 + fr, col0 = u.pn * BM + wc * 32 + 8 * fq, wid = wr * 4 + wc;
        const bool isv = u.pn >= 8;
        float rstd[2][4][2];
#pragma unroll
        for (int ai = 0; ai < 2; ++ai)
#pragma unroll
            for (int m = 0; m < 4; ++m)
#pragma unroll
                for (int bj = 0; bj < 2; ++bj) { const f32x4 v0 = acc[ai][bj][m][0], v1 = acc[ai][bj][m][1];
                    float ss = v0[0] * v0[0] + v0[1] * v0[1] + v0[2] * v0[2] + v0[3] * v0[3] + v1[0] * v1[0] + v1[1] * v1[1] + v1[2] * v1[2] + v1[3] * v1[3];
                    ss += __shfl_xor(ss, 16); ss += __shfl_xor(ss, 32);
                    rstd[ai][m][bj] = ss;
                    if (fq == 0) xch[wid * 256 + ((ai * 4 + m) * 2 + bj) * 16 + fr] = ss; }
        asm volatile("s_waitcnt lgkmcnt(0)" ::: "memory"); __builtin_amdgcn_s_barrier(); asm volatile("" ::: "memory");
#pragma unroll
        for (int ai = 0; ai < 2; ++ai)
#pragma unroll
            for (int m = 0; m < 4; ++m)
#pragma unroll
                for (int bj = 0; bj < 2; ++bj) rstd[ai][m][bj] = rsqrtf((rstd[ai][m][bj] + xch[(wid ^ 1) * 256 + ((ai * 4 + m) * 2 + bj) * 16 + fr]) * (1.f / 64.f) + EPS);
        const int e0 = (wc & 1) * 32 + 8 * fq;
        const float* gn = u.pn < 4 ? qn : kn; const float qs = u.pn < 4 ? 0.125f * LOG2E : 1.f;
        f32x4 g0 = *(const f32x4*)(gn + e0), g1 = *(const f32x4*)(gn + e0 + 4);
        g0 = g0 * qs; g1 = g1 * qs;
        const float sgn = (fq & 2) ? 1.f : -1.f;
        const int jt = u.pm % 17; const bool latent = jt != 0;
#pragma unroll
        for (int ai = 0; ai < 2; ++ai)
#pragma unroll
            for (int m = 0; m < 4; ++m) { const int r = row0 + ai * HALF + m * 16; bf16* rowp = C + (size_t)r * ODD_IN + col0;
                f32x4 c0 = {1.f, 1.f, 1.f, 1.f}, c1 = c0, s0 = {0.f, 0.f, 0.f, 0.f}, s1 = s0;
                if (!isv && latent) { const int t = (jt - 1) * 256 + ai * HALF + wr * 64 + m * 16 + fr;
                    c0 = *(const f32x4*)(rc + t * 64 + e0); c1 = *(const f32x4*)(rc + t * 64 + e0 + 4); s0 = *(const f32x4*)(rs + t * 64 + e0); s1 = *(const f32x4*)(rs + t * 64 + e0 + 4); }
#pragma unroll
                for (int bj = 0; bj < 2; ++bj) { f32x4 v0 = acc[ai][bj][m][0], v1 = acc[ai][bj][m][1];
                    if (!isv) { const float rr = rstd[ai][m][bj]; v0 = v0 * rr * g0; v1 = v1 * rr * g1;
                        f32x4 o0, o1;
#pragma unroll
                        for (int j = 0; j < 4; ++j) { o0[j] = __shfl_xor(v0[j], 32); o1[j] = __shfl_xor(v1[j], 32); }
                        v0 = v0 * c0 + o0 * s0 * sgn; v1 = v1 * c1 + o1 * s1 * sgn; }
                    u32x4 w; w.x = cvt_pk_bf16(v0[0], v0[1]); w.y = cvt_pk_bf16(v0[2], v0[3]); w.z = cvt_pk_bf16(v1[0], v1[1]); w.w = cvt_pk_bf16(v1[2], v1[3]);
                    *(u32x4*)(rowp + bj * HALF) = w; } }
        asm volatile("s_waitcnt lgkmcnt(0)" ::: "memory"); __builtin_amdgcn_s_barrier(); asm volatile("" ::: "memory");
    }
};
struct EpiOut {
    static constexpr bool PERM = true; Ptrs P; int layer;
    __device__ __forceinline__ void operator()(const f32x4 (&acc)[2][2][4][2], const Unit& u, int wr, int wc, int fr, int fq) const {
        const int b = u.pm / 17, jt = u.pm % 17;
        const float* g1 = (const float*)(P.ws + WS_MOD) + (size_t)(layer * 5 + (jt == 0 ? 4 : b)) * 6144 + 2 * D;
        const float* in0 = jt == 0 ? P.in[2] + (size_t)(b * CTX) * D : P.in[0] + (size_t)(b * SEQ + (jt - 1) * 256) * D;
        bf16* xb0 = (bf16*)(P.ws + WS_XB) + (size_t)u.pm * BM * D;
        const int col0 = u.pn * BM + wc * 32 + 8 * fq;
        f32x4 gv[2][2];
#pragma unroll
        for (int bj = 0; bj < 2; ++bj)
#pragma unroll
            for (int n = 0; n < 2; ++n) gv[bj][n] = *(const f32x4*)(g1 + col0 + bj * HALF + 4 * n);
#pragma unroll
        for (int ai = 0; ai < 2; ++ai)
#pragma unroll
            for (int m = 0; m < 4; ++m) { const size_t off = (size_t)(ai * HALF + wr * 64 + m * 16 + fr) * D + col0;
#pragma unroll
                for (int bj = 0; bj < 2; ++bj) {
                    f32x4 x0, x1;
                    if (layer == 0) { x0 = *(const f32x4*)(in0 + off + bj * HALF); x1 = *(const f32x4*)(in0 + off + bj * HALF + 4); }
                    else { const u32x4 r = *(const u32x4*)(xb0 + off + bj * HALF);
                        x0 = (f32x4){__uint_as_float(r.x << 16), __uint_as_float(r.x & 0xffff0000u), __uint_as_float(r.y << 16), __uint_as_float(r.y & 0xffff0000u)};
                        x1 = (f32x4){__uint_as_float(r.z << 16), __uint_as_float(r.z & 0xffff0000u), __uint_as_float(r.w << 16), __uint_as_float(r.w & 0xffff0000u)}; }
                    const f32x4 v0 = x0 + gv[bj][0] * acc[ai][bj][m][0], v1 = x1 + gv[bj][1] * acc[ai][bj][m][1];
                    u32x4 w; w.x = cvt_pk_bf16(v0[0], v0[1]); w.y = cvt_pk_bf16(v0[2], v0[3]); w.z = cvt_pk_bf16(v1[0], v1[1]); w.w = cvt_pk_bf16(v1[2], v1[3]);
                    *(u32x4*)(xb0 + off + bj * HALF) = w; } }
    }
};
struct EpiMoe1 {
    static constexpr bool PERM = true; Ptrs P; int layer;
    __device__ __forceinline__ void operator()(const f32x4 (&acc)[2][2][4][2], const Unit& u, int wr, int wc, int fr, int fq) const {
        const float* bgu = P.in[35] + (size_t)(layer * NE + u.e) * 2048;
        const int cl = u.pn * 128 + wc * 32 + 8 * fq;
        f32x4 bg[2], bu[2];
#pragma unroll
        for (int n = 0; n < 2; ++n) { bg[n] = *(const f32x4*)(bgu + cl + 4 * n); bu[n] = *(const f32x4*)(bgu + 1024 + cl + 4 * n); }
        bf16* act = (bf16*)(P.ws + WS_ACT) + (size_t)(u.aux + u.pm * 256 + wr * 64 + fr) * 1024 + cl;
#pragma unroll
        for (int ai = 0; ai < 2; ++ai)
#pragma unroll
            for (int m = 0; m < 4; ++m) { float o[8];
#pragma unroll
                for (int n = 0; n < 2; ++n)
#pragma unroll
                    for (int j = 0; j < 4; ++j) { float g = acc[ai][0][m][n][j] + bg[n][j], uu = acc[ai][1][m][n][j] + bu[n][j];
                        g = fminf(g, 7.f); uu = fminf(fmaxf(uu, -7.f), 7.f);
                        const float sg = __builtin_amdgcn_rcpf(1.f + __expf(-1.702f * g)); o[n * 4 + j] = (uu + 1.f) * g * sg; }
                u32x4 w; w.x = cvt_pk_bf16(o[0], o[1]); w.y = cvt_pk_bf16(o[2], o[3]); w.z = cvt_pk_bf16(o[4], o[5]); w.w = cvt_pk_bf16(o[6], o[7]);
                *(u32x4*)(act + (size_t)(ai * HALF + m * 16) * 1024) = w; }
    }
};
struct EpiMoe2 {
    static constexpr bool PERM = true; Ptrs P; int layer;
    __device__ __forceinline__ void operator()(const f32x4 (&acc)[2][2][4][2], const Unit& u, int wr, int wc, int fr, int fq) const {
        const float* bd = P.in[37] + (size_t)(layer * NE + u.e) * 1024;
        const int col0 = u.pn * BM + wc * 32 + 8 * fq;
        f32x4 bv[2][2];
#pragma unroll
        for (int bj = 0; bj < 2; ++bj)
#pragma unroll
            for (int n = 0; n < 2; ++n) bv[bj][n] = *(const f32x4*)(bd + col0 + bj * HALF + 4 * n);
        const int* pair_of = (const int*)(P.ws + WS_PAIROF) + (size_t)u.e * R; const float* gate_of = (const float*)(P.ws + WS_GATEOF) + (size_t)u.e * R;
        bf16* Y = (bf16*)(P.ws + WS_Y);
#pragma unroll
        for (int ai = 0; ai < 2; ++ai)
#pragma unroll
            for (int m = 0; m < 4; ++m) { const int r = u.pm * 256 + ai * HALF + wr * 64 + m * 16 + fr;
                if (r < u.cnt) { const int pair = pair_of[r]; const float gw = gate_of[r]; bf16* rowp = Y + (size_t)pair * 1024 + col0;
#pragma unroll
                    for (int bj = 0; bj < 2; ++bj) { const f32x4 v0 = (acc[ai][bj][m][0] + bv[bj][0]) * gw, v1 = (acc[ai][bj][m][1] + bv[bj][1]) * gw;
                        u32x4 w; w.x = cvt_pk_bf16(v0[0], v0[1]); w.y = cvt_pk_bf16(v0[2], v0[3]); w.z = cvt_pk_bf16(v1[0], v1[1]); w.w = cvt_pk_bf16(v1[2], v1[3]);
                        *(u32x4*)(rowp + bj * HALF) = w; } } }
    }
};
}

__device__ __forceinline__ int bwd_pos(int c) { return c < 2 ? 1 - c : 2 + (NCH - 1 - c); }
__device__ __forceinline__ int bwd_chunk_at(int p) { return p < 2 ? 1 - p : NCH - 1 - (p - 2); }
__device__ __forceinline__ float fsigmoid(float x) { return __builtin_amdgcn_rcpf(1.f + __builtin_amdgcn_exp2f(-LOG2E * x)); }
__device__ __forceinline__ void lru_item_mfma(const Ptrs& P, unsigned char* lds, int mode, int n, int c, int b) {
    typedef short bf16x8 __attribute__((ext_vector_type(8)));
    float* X = (float*)lds;
    unsigned char* XB = lds + 128 * 68 * 4;
    float* SEG = (float*)(lds + 128 * 68 * 4 + 16384);
    float* CAR = SEG + 2 * 8 * 64 * 2;
    const int tid = threadIdx.x, wid = tid >> 6, lane = tid & 63, fr = lane & 15, fq = lane >> 4;
    const int j0 = c * CHUNK, seg_lo = (c < 2) ? 0 : CTX, seg_hi = (c < 2) ? CTX : SU;
    const bf16* Z = (const bf16*)(P.ws + WS_Z);
    const float* cw = P.in[10]; const float* cb = P.in[11];
    float* agg = (float*)(P.ws + WS_AGG);
    __syncthreads();
#pragma unroll
    for (int q = 0; q < 2; ++q) {
        const int p = tid + q * NT, t = p >> 3, c8 = (p & 7) * 8, cg = n * 64 + c8;
        float acc[8];
        { const f32x4 b0 = *(const f32x4*)(cb + cg), b1 = *(const f32x4*)(cb + cg + 4);
#pragma unroll
          for (int e = 0; e < 4; ++e) { acc[e] = b0[e]; acc[4 + e] = b1[e]; } }
#pragma unroll
        for (int k = 0; k < 4; ++k) {
            const int j = j0 + t - 2 + k; const bool ok = j >= seg_lo && j < seg_hi; const int jj = ok ? j : j0 + t;
            const u32x4 raw = *(const u32x4*)(Z + (size_t)(b * SU + jj) * EVEN_IN_P + 512 + cg);
            const f32x4 w0 = *(const f32x4*)(cw + k * LRU_W + cg), w1 = *(const f32x4*)(cw + k * LRU_W + cg + 4);
            const float m = ok ? 1.f : 0.f;
#pragma unroll
            for (int e = 0; e < 4; ++e) { const float lo = __uint_as_float(raw[e] << 16), hi = __uint_as_float(raw[e] & 0xffff0000u);
                const float wl = (e < 2 ? w0[2 * e] : w1[2 * e - 4]) * m, wh = (e < 2 ? w0[2 * e + 1] : w1[2 * e - 3]) * m;
                acc[2 * e] += wl * lo; acc[2 * e + 1] += wh * hi; }
        }
        *(f32x4*)(X + t * 68 + c8) = (f32x4){acc[0], acc[1], acc[2], acc[3]}; *(f32x4*)(X + t * 68 + c8 + 4) = (f32x4){acc[4], acc[5], acc[6], acc[7]};
        u32x4 w; w.x = g8::cvt_pk_bf16(acc[0], acc[1]); w.y = g8::cvt_pk_bf16(acc[2], acc[3]); w.z = g8::cvt_pk_bf16(acc[4], acc[5]); w.w = g8::cvt_pk_bf16(acc[6], acc[7]);
        *(u32x4*)(XB + t * 128 + (((c8 >> 3) ^ ((t >> 1) & 7)) << 4)) = w;
    }
    if (mode == 1 && wid < 2) {
        const int dir = wid, pos = dir == 0 ? c : bwd_pos(c); float h = 0.f;
        for (int p = 0; p < pos; ++p) { const int cc = dir == 0 ? p : bwd_chunk_at(p); const float2 ag = *(const float2*)(agg + ((((size_t)b * NCH + cc) * 2 + dir) * 512 + n * 64 + lane) * 2); h = ag.x * h + ag.y; }
        CAR[dir * 64 + lane] = h;
    }
    __syncthreads();
    const int trow = 16 * wid + fr;
    const bf16x8 af0 = *(const bf16x8*)(XB + trow * 128 + ((fq ^ ((trow >> 1) & 7)) << 4));
    const bf16x8 af1 = *(const bf16x8*)(XB + trow * 128 + (((4 + fq) ^ ((trow >> 1) & 7)) << 4));
    float av[2][4][4], uv[2][4][4], Ae[2][4], He[2][4];
#pragma unroll
    for (int dir = 0; dir < 2; ++dir) {
        const bf16* wa = (const bf16*)(P.ws + WS_WLRU) + ((size_t)(dir * 2 + 0) * 8 + n) * 4096;
        const bf16* wx = (const bf16*)(P.ws + WS_WLRU) + ((size_t)(dir * 2 + 1) * 8 + n) * 4096;
#pragma unroll
        for (int ct = 0; ct < 4; ++ct) {
            const int e = 16 * ct + fr;
            const bf16x8 wa0 = *(const bf16x8*)(wa + e * 64 + 8 * fq), wa1 = *(const bf16x8*)(wa + e * 64 + 32 + 8 * fq);
            const bf16x8 wx0 = *(const bf16x8*)(wx + e * 64 + 8 * fq), wx1 = *(const bf16x8*)(wx + e * 64 + 32 + 8 * fq);
            f32x4 ga = {0.f, 0.f, 0.f, 0.f}, gx = {0.f, 0.f, 0.f, 0.f};
            ga = __builtin_amdgcn_mfma_f32_16x16x32_bf16(af0, wa0, ga, 0, 0, 0); ga = __builtin_amdgcn_mfma_f32_16x16x32_bf16(af1, wa1, ga, 0, 0, 0);
            gx = __builtin_amdgcn_mfma_f32_16x16x32_bf16(af0, wx0, gx, 0, 0, 0); gx = __builtin_amdgcn_mfma_f32_16x16x32_bf16(af1, wx1, gx, 0, 0, 0);
            const int cgl = dir * LRU_W + n * 64 + e;
            const float bav = P.in[13][cgl], bxv = P.in[15][cgl], c8 = ((const float*)(P.ws + WS_SCAL))[1024 + cgl];
#pragma unroll
            for (int j = 0; j < 4; ++j) {
                const float r = fsigmoid(ga[j] + bav), ig = fsigmoid(gx[j] + bxv);
                const float a = __builtin_amdgcn_exp2f(-c8 * r);
                av[dir][ct][j] = a; uv[dir][ct][j] = sqrtf(fmaxf(1.f - a * a, 0.f)) * ig * X[(16 * wid + 4 * fq + j) * 68 + e];
            }
            float Al = av[dir][ct][0] * av[dir][ct][1] * av[dir][ct][2] * av[dir][ct][3], Hl;
            if (dir == 0) Hl = ((uv[dir][ct][0] * av[dir][ct][1] + uv[dir][ct][1]) * av[dir][ct][2] + uv[dir][ct][2]) * av[dir][ct][3] + uv[dir][ct][3];
            else Hl = ((uv[dir][ct][3] * av[dir][ct][2] + uv[dir][ct][2]) * av[dir][ct][1] + uv[dir][ct][1]) * av[dir][ct][0] + uv[dir][ct][0];
            const int pq = dir == 0 ? fq : 3 - fq;
            {
                const int src = dir == 0 ? lane - 16 : lane + 16; const float Ap = __shfl(Al, src & 63), Hp = __shfl(Hl, src & 63);
                if (pq >= 1) { Hl = Al * Hp + Hl; Al = Al * Ap; }
            }
            {
                const int src = dir == 0 ? lane - 32 : lane + 32; const float Ap = __shfl(Al, src & 63), Hp = __shfl(Hl, src & 63);
                if (pq >= 2) { Hl = Al * Hp + Hl; Al = Al * Ap; }
            }
            {
                const int src = dir == 0 ? lane - 16 : lane + 16; const float Ap = __shfl(Al, src & 63), Hp = __shfl(Hl, src & 63);
                Ae[dir][ct] = pq >= 1 ? Ap : 1.f; He[dir][ct] = pq >= 1 ? Hp : 0.f;
            }
            if (pq == 3) { float2 sv; sv.x = Al; sv.y = Hl; *(float2*)(SEG + ((dir * 8 + wid) * 64 + e) * 2) = sv; }
        }
    }
    __syncthreads();
    float hs[4][4];
#pragma unroll
    for (int ct = 0; ct < 4; ++ct)
#pragma unroll
        for (int j = 0; j < 4; ++j) hs[ct][j] = 0.f;
#pragma unroll
    for (int dir = 0; dir < 2; ++dir) {
#pragma unroll
        for (int ct = 0; ct < 4; ++ct) {
            const int e = 16 * ct + fr;
            if (mode == 0) {
                if (wid == 0 && fq == 0) {
                    float Ac = 1.f, Hc = 0.f;
                    for (int s = 0; s < 8; ++s) { const int sg = dir == 0 ? s : 7 - s; const float2 sv = *(const float2*)(SEG + ((dir * 8 + sg) * 64 + e) * 2); Hc = sv.x * Hc + sv.y; Ac *= sv.x; }
                    float2 o; o.x = Ac; o.y = Hc; *(float2*)(agg + ((((size_t)b * NCH + c) * 2 + dir) * 512 + n * 64 + e) * 2) = o;
                }
            } else {
                float h = CAR[dir * 64 + e];
                const int nprev = dir == 0 ? wid : 7 - wid;
                for (int s = 0; s < nprev; ++s) { const int sg = dir == 0 ? s : 7 - s; const float2 sv = *(const float2*)(SEG + ((dir * 8 + sg) * 64 + e) * 2); h = sv.x * h + sv.y; }
                h = Ae[dir][ct] * h + He[dir][ct];
                if (dir == 0) {
#pragma unroll
                    for (int j = 0; j < 4; ++j) { h = av[dir][ct][j] * h + uv[dir][ct][j]; hs[ct][j] += h; }
                } else {
#pragma unroll
                    for (int j = 3; j >= 0; --j) { h = av[dir][ct][j] * h + uv[dir][ct][j]; hs[ct][j] += h; }
                }
            }
        }
    }
    if (mode == 1) {
#pragma unroll
        for (int ct = 0; ct < 4; ++ct)
#pragma unroll
            for (int j = 0; j < 4; ++j) X[(16 * wid + 4 * fq + j) * 68 + 16 * ct + fr] = hs[ct][j];
        __syncthreads();
        bf16* mix = (bf16*)(P.ws + WS_MIX);
#pragma unroll
        for (int q = 0; q < 2; ++q) {
            const int p = tid + q * NT, t = p >> 3, c8 = (p & 7) * 8; const size_t u = (size_t)b * SU + j0 + t;
            const u32x4 gz = *(const u32x4*)(Z + u * EVEN_IN_P + n * 64 + c8);
            const f32x4 r0 = *(const f32x4*)(X + t * 68 + c8), r1 = *(const f32x4*)(X + t * 68 + c8 + 4);
            float o[8];
#pragma unroll
            for (int k = 0; k < 4; ++k) { const float g0 = __uint_as_float(gz[k] << 16), g1 = __uint_as_float(gz[k] & 0xffff0000u);
                const float s0 = fsigmoid(1.5957691216057308f * (g0 + 0.044715f * g0 * g0 * g0)), s1 = fsigmoid(1.5957691216057308f * (g1 + 0.044715f * g1 * g1 * g1));
                o[2 * k] = g0 * s0 * (k < 2 ? r0[2 * k] : r1[2 * k - 4]); o[2 * k + 1] = g1 * s1 * (k < 2 ? r0[2 * k + 1] : r1[2 * k - 3]); }
            u32x4 w; w.x = g8::cvt_pk_bf16(o[0], o[1]); w.y = g8::cvt_pk_bf16(o[2], o[3]); w.z = g8::cvt_pk_bf16(o[4], o[5]); w.w = g8::cvt_pk_bf16(o[6], o[7]);
            *(u32x4*)(mix + u * D + n * 64 + c8) = w;
        }
    }
}

__device__ __forceinline__ void ph_lru(const Ptrs& P, unsigned char* lds, int mode, int item0, int nheavy) {
    const int G = gridDim.x, total = 8 * NCH * NB, b = (int)blockIdx.x;
    if (nheavy > 0 && G == 256 && 4 * nheavy + 6 * (G - nheavy) >= total) {
        const int th = total - 6 * (G - nheavy);
        const int lo = b < nheavy ? b * 4 : th + (b - nheavy) * 6, hi0 = b < nheavy ? lo + 4 : lo + 6, cap = b < nheavy ? th : total, hi = hi0 < cap ? hi0 : cap;
        for (int it = lo; it < hi; ++it) lru_item_mfma(P, lds, mode, it % 8, (it / 8) % NCH, it / (8 * NCH));
    } else {
        int first = (b - item0 % G + G) % G;
        for (int it = first; it < total; it += G) lru_item_mfma(P, lds, mode, it % 8, (it / 8) % NCH, it / (8 * NCH));
    }
    __syncthreads();
}

__device__ __forceinline__ void unpack8(const u32x4 v, float (&f)[8]) {
#pragma unroll
    for (int i = 0; i < 4; ++i) { f[2 * i] = __uint_as_float(v[i] << 16); f[2 * i + 1] = __uint_as_float(v[i] & 0xffff0000u); }
}
__device__ __forceinline__ u32x4 pack8(const float (&f)[8]) {
    u32x4 w; w.x = g8::cvt_pk_bf16(f[0], f[1]); w.y = g8::cvt_pk_bf16(f[2], f[3]); w.z = g8::cvt_pk_bf16(f[4], f[5]); w.w = g8::cvt_pk_bf16(f[6], f[7]); return w;
}
struct MlaRow { u32x4 zq, zk, zr, q0, q1, kv0, kw0, kv1, kw1; f32x4 c0, c1, s0, s1; };
__device__ __forceinline__ MlaRow mla_row_load(const Ptrs& P, int u, int lane) {
    const int hl = lane & 31, hh = lane >> 5; const bool act = hl < 24, tail = hl >= 16 && hl < 24;
    const int j = u % SU; const bool latent = j >= CTX; const int t = latent ? j - CTX : 0;
    const bf16* z = (const bf16*)(P.ws + WS_Z) + (size_t)u * EVEN_IN_P;
    const bf16* qp = (const bf16*)(P.ws + WS_QP) + (size_t)u * 1792; const bf16* kvp = qp + 768;
    const float* rc = (const float*)(P.ws + WS_ROPE); const float* rs = rc + SEQ * 64;
    const u32x4 z4 = {0u, 0u, 0u, 0u}; const f32x4 one4 = {1.f, 1.f, 1.f, 1.f}, zero4 = {0.f, 0.f, 0.f, 0.f};
    MlaRow r;
    r.zq = lane < 48 ? *(const u32x4*)(z + 1024 + lane * 8) : z4;
    r.zk = lane < 32 ? *(const u32x4*)(z + 1408 + lane * 8) : z4;
    r.zr = tail ? *(const u32x4*)(z + 1664 + (hl - 16) * 8) : z4;
    r.q0 = act ? *(const u32x4*)(qp + hh * 192 + hl * 8) : z4;
    r.q1 = act ? *(const u32x4*)(qp + (2 + hh) * 192 + hl * 8) : z4;
    r.kv0 = hl < 16 ? *(const u32x4*)(kvp + hh * 256 + hl * 8) : z4;
    r.kw0 = hl < 16 ? *(const u32x4*)(kvp + hh * 256 + 128 + hl * 8) : z4;
    r.kv1 = hl < 16 ? *(const u32x4*)(kvp + (2 + hh) * 256 + hl * 8) : z4;
    r.kw1 = hl < 16 ? *(const u32x4*)(kvp + (2 + hh) * 256 + 128 + hl * 8) : z4;
    const bool rp = latent && tail; const int ro = t * 64 + (hl - 16) * 8;
    r.c0 = rp ? *(const f32x4*)(rc + ro) : one4; r.c1 = rp ? *(const f32x4*)(rc + ro + 4) : one4;
    r.s0 = rp ? *(const f32x4*)(rs + ro) : zero4; r.s1 = rp ? *(const f32x4*)(rs + ro + 4) : zero4;
    return r;
}
__device__ __forceinline__ void ph_mla_prep(const Ptrs& P) {
    const int wave = threadIdx.x >> 6, lane = threadIdx.x & 63, G = gridDim.x;
    const int hl = lane & 31, hh = lane >> 5;
    const bool act = hl < 24, tail = hl >= 16 && hl < 24;
    const float* qn = P.in[21]; const float* kn = P.in[22];
    float gq[8], gk[8];
#pragma unroll
    for (int i = 0; i < 8; ++i) { gq[i] = act ? qn[hl * 8 + i] : 0.f; gk[i] = act ? kn[hl * 8 + i] : 0.f; }
    const float c2 = 0.07216878364870322f * LOG2E;
    const float sgn = ((hl >> 1) & 1) ? 1.f : -1.f;
    int u = (int)blockIdx.x * 8 + wave;
    if (u >= R) return;
    MlaRow cur = mla_row_load(P, u, lane);
    for (; u < R; u += G * 8) {
        const int un = u + G * 8;
        MlaRow nxt = cur;
        if (un < R) nxt = mla_row_load(P, un, lane);
        float f[8]; float sq = 0.f, sk = 0.f;
        unpack8(cur.zq, f);
#pragma unroll
        for (int i = 0; i < 8; ++i) sq += f[i] * f[i];
        unpack8(cur.zk, f);
#pragma unroll
        for (int i = 0; i < 8; ++i) sk += f[i] * f[i];
        const float rq = rsqrtf(wave_sum(sq) * (1.f / 384.f) + EPS), rk = rsqrtf(wave_sum(sk) * (1.f / 256.f) + EPS);
        float cs[8], sn[8];
#pragma unroll
        for (int i = 0; i < 4; ++i) { cs[i] = cur.c0[i]; cs[4 + i] = cur.c1[i]; sn[i] = cur.s0[i]; sn[4 + i] = cur.s1[i]; }
        bf16* qm = (bf16*)(P.ws + WS_QM) + (size_t)u * 768; bf16* km = (bf16*)(P.ws + WS_KM) + (size_t)u * 768; bf16* vm = (bf16*)(P.ws + WS_VM) + (size_t)u * 512;
#pragma unroll
        for (int pass = 0; pass < 2; ++pass) {
            const int h = pass * 2 + hh;
            {
                float v[8]; float ss = 0.f;
                unpack8(pass ? cur.q1 : cur.q0, v);
#pragma unroll
                for (int i = 0; i < 8; ++i) { v[i] *= rq; ss += v[i] * v[i]; }
                ss += __shfl_xor(ss, 1); ss += __shfl_xor(ss, 2); ss += __shfl_xor(ss, 4); ss += __shfl_xor(ss, 8); ss += __shfl_xor(ss, 16);
                const float r = rsqrtf(ss * (1.f / 192.f) + EPS);
#pragma unroll
                for (int i = 0; i < 8; ++i) { v[i] *= r * gq[i]; const float other = __shfl_xor(v[i], 2); v[i] = (v[i] * cs[i] + sgn * other * sn[i]) * c2; }
                if (act) *(u32x4*)(qm + h * 192 + hl * 8) = pack8(v);
            }
            {
                float v[8], w[8]; float ss = 0.f;
                if (hl < 16) { unpack8(pass ? cur.kv1 : cur.kv0, v); unpack8(pass ? cur.kw1 : cur.kw0, w);
#pragma unroll
                    for (int i = 0; i < 8; ++i) { v[i] *= rk; w[i] *= rk; } }
                else { unpack8(cur.zr, v);
#pragma unroll
                    for (int i = 0; i < 8; ++i) w[i] = 0.f; }
#pragma unroll
                for (int i = 0; i < 8; ++i) ss += v[i] * v[i];
                ss += __shfl_xor(ss, 1); ss += __shfl_xor(ss, 2); ss += __shfl_xor(ss, 4); ss += __shfl_xor(ss, 8); ss += __shfl_xor(ss, 16);
                const float r = rsqrtf(ss * (1.f / 192.f) + EPS);
#pragma unroll
                for (int i = 0; i < 8; ++i) { v[i] *= r * gk[i]; const float other = __shfl_xor(v[i], 2); v[i] = v[i] * cs[i] + sgn * other * sn[i]; }
                if (act) *(u32x4*)(km + h * 192 + hl * 8) = pack8(v);
                if (hl < 16) *(u32x4*)(vm + h * 128 + hl * 8) = pack8(w);
            }
        }
        cur = nxt;
    }
}
#ifndef PROBE_SUB
#define PROBE_SUB 0
#define PROBE_SUBDK 0
#endif
#ifndef PROBE_SUBBLK
#define PROBE_SUBBLK 0
#endif
#define PSUB_T0() unsigned ps_t0_ = 0u; if (PROBE_SUB && DK == PROBE_SUBDK) ps_t0_ = __builtin_amdgcn_readfirstlane((unsigned)__builtin_readcyclecounter())
#define PSUB_AT(k) do { if (PROBE_SUB == (k) && DK == PROBE_SUBDK) sacc = __builtin_amdgcn_readfirstlane(sacc + ((unsigned)__builtin_readcyclecounter() - ps_t0_)); } while (0)
namespace att {
using bf16x8 = __attribute__((ext_vector_type(8))) short;
using s16x4  = __attribute__((ext_vector_type(4))) short;
using f32x16 = __attribute__((ext_vector_type(16))) float;
#define SBAR() __builtin_amdgcn_sched_barrier(0)
__device__ __forceinline__ int crow(int r, int hi) { return (r & 3) + 8 * (r >> 2) + 4 * hi; }
__device__ __forceinline__ unsigned cvtpk(float lo, float hi) { unsigned r; asm volatile("v_cvt_pk_bf16_f32 %0, %1, %2" : "=v"(r) : "v"(lo), "v"(hi)); return r; }
template <int DK> __device__ __forceinline__ int kswz(int row, int chunk) { return row * (DK * 2) + ((chunk ^ ((row >> 1) & 7)) << 4); }
__device__ __forceinline__ int v_st(int k, int c) { const int kk = (k & ~0xC) | ((k & 4) << 1) | ((k & 8) >> 1); return ((kk >> 3) * 4 + (c >> 5)) * 512 + ((kk & 7) * 32 + (c & 31)) * 2; }
__device__ __forceinline__ int v_rd_base(int lane) { return ((lane & 3) << 3) | (((lane >> 2) & 3) << 6) | (((lane >> 4) & 1) << 5) | (((lane >> 5) & 1) << 8); }
constexpr int v_rd_off(int d0, int ks, int half) { return d0 * 512 + ks * 4096 + half * 2048; }
template <int OFF> __device__ __forceinline__ s16x4 tr_read(int vb) { s16x4 r; asm volatile("ds_read_b64_tr_b16 %0, %1 offset:%2" : "=&v"(r) : "v"(vb), "i"(OFF) : "memory"); return r; }
template <int D0> __device__ __forceinline__ void pv_one(f32x16& od, int vb, bf16x8 pa0, bf16x8 pa1, bf16x8 pa2, bf16x8 pa3) {
    const s16x4 l0 = tr_read<v_rd_off(D0, 0, 0)>(vb), h0 = tr_read<v_rd_off(D0, 0, 1)>(vb), l1 = tr_read<v_rd_off(D0, 1, 0)>(vb), h1 = tr_read<v_rd_off(D0, 1, 1)>(vb);
    const s16x4 l2 = tr_read<v_rd_off(D0, 2, 0)>(vb), h2 = tr_read<v_rd_off(D0, 2, 1)>(vb), l3 = tr_read<v_rd_off(D0, 3, 0)>(vb), h3 = tr_read<v_rd_off(D0, 3, 1)>(vb);
    asm volatile("s_waitcnt lgkmcnt(0)" ::: "memory"); SBAR();
#define PK(L, H) (bf16x8){L[0], L[1], L[2], L[3], H[0], H[1], H[2], H[3]}
    od = __builtin_amdgcn_mfma_f32_32x32x16_bf16(pa0, PK(l0, h0), od, 0, 0, 0);
    od = __builtin_amdgcn_mfma_f32_32x32x16_bf16(pa1, PK(l1, h1), od, 0, 0, 0);
    od = __builtin_amdgcn_mfma_f32_32x32x16_bf16(pa2, PK(l2, h2), od, 0, 0, 0);
    od = __builtin_amdgcn_mfma_f32_32x32x16_bf16(pa3, PK(l3, h3), od, 0, 0, 0);
#undef PK
}
typedef short v4i16_t __attribute__((ext_vector_type(4)));
template <int OFF> __device__ __forceinline__ s16x4 tr_read_b(int vb) {
    return __builtin_bit_cast(s16x4, __builtin_amdgcn_ds_read_tr16_b64_v4i16((__attribute__((address_space(3))) v4i16_t*)(uintptr_t)(unsigned)(vb + OFF)));
}
template <int D0> __device__ __forceinline__ void pv_one_b(f32x16& od, int vb, bf16x8 pa0, bf16x8 pa1, bf16x8 pa2, bf16x8 pa3) {
    const s16x4 l0 = tr_read_b<v_rd_off(D0, 0, 0)>(vb), h0 = tr_read_b<v_rd_off(D0, 0, 1)>(vb), l1 = tr_read_b<v_rd_off(D0, 1, 0)>(vb), h1 = tr_read_b<v_rd_off(D0, 1, 1)>(vb);
    const s16x4 l2 = tr_read_b<v_rd_off(D0, 2, 0)>(vb), h2 = tr_read_b<v_rd_off(D0, 2, 1)>(vb), l3 = tr_read_b<v_rd_off(D0, 3, 0)>(vb), h3 = tr_read_b<v_rd_off(D0, 3, 1)>(vb);
#define PK(L, H) (bf16x8){L[0], L[1], L[2], L[3], H[0], H[1], H[2], H[3]}
    od = __builtin_amdgcn_mfma_f32_32x32x16_bf16(pa0, PK(l0, h0), od, 0, 0, 0);
    od = __builtin_amdgcn_mfma_f32_32x32x16_bf16(pa1, PK(l1, h1), od, 0, 0, 0);
    od = __builtin_amdgcn_mfma_f32_32x32x16_bf16(pa2, PK(l2, h2), od, 0, 0, 0);
    od = __builtin_amdgcn_mfma_f32_32x32x16_bf16(pa3, PK(l3, h3), od, 0, 0, 0);
#undef PK
}
constexpr int SHM_V = 64 * 128 * 2;
template <int DK, bool PF, bool EARLY>
__device__ __forceinline__ void attn_loop(const bf16* __restrict__ Qrow  , const bf16* __restrict__ Kh, int ldk, const bf16* __restrict__ Vh, int ldv,
                                          int nkeys, float negM, f32x16 (&o)[4], float& l_reg, char* lds_kv, unsigned& sacc) {
    constexpr int NQ = DK / 16, CH = DK / 8, KP = (64 * CH) / NT, SHM_K = 64 * DK * 2;
    const int tid = threadIdx.x, lane = tid & 63, r32 = lane & 31, hi = lane >> 5;
    char* V_lds = lds_kv; char* K_lds = lds_kv + 2 * SHM_V;
    bf16x8 qr[NQ];
#pragma unroll
    for (int d0 = 0; d0 < NQ; ++d0) qr[d0] = *reinterpret_cast<const bf16x8*>(Qrow + d0 * 16);
    const __amdgpu_buffer_rsrc_t krs = __builtin_amdgcn_make_buffer_rsrc((void*)Kh, 0, nkeys * ldk * 2, 0x00020000);
    const __amdgpu_buffer_rsrc_t vrs = __builtin_amdgcn_make_buffer_rsrc((void*)Vh, 0, nkeys * ldv * 2, 0x00020000);
    unsigned kgo[KP]; int kst[KP];
#pragma unroll
    for (int i = 0; i < KP; ++i) { const int p = tid + i * NT, row = p / CH, ch = p % CH; kgo[i] = (unsigned)(row * ldk + ch * 8) * 2u; kst[i] = kswz<DK>(row, ch); }
    const int vrow0 = tid >> 4, vc = (tid & 15) * 8;
    const unsigned vgo = (unsigned)(vrow0 * ldv + vc) * 2u, vstep = (unsigned)(32 * ldv) * 2u;
    const int vst0 = v_st(vrow0, vc); constexpr int vst1d = 8192;
    const int vb0 = (int)(uintptr_t)V_lds + v_rd_base(lane);
    const int kbase = r32 * (DK * 2), kt0 = (hi ^ ((r32 >> 1) & 7)) << 4;
#define kra_(q) (kbase + (kt0 ^ ((q) << 5)))
    u32x4 ks[KP], vs0, vs1;
#define SLOAD(k0) do { const unsigned so_k = (unsigned)((k0) * ldk) * 2u, so_v = (unsigned)((k0) * ldv) * 2u; \
        _Pragma("unroll") for (int i = 0; i < KP; ++i) ks[i] = __builtin_amdgcn_raw_buffer_load_b128(krs, kgo[i], so_k, 0); \
        vs0 = __builtin_amdgcn_raw_buffer_load_b128(vrs, vgo, so_v, 0); vs1 = __builtin_amdgcn_raw_buffer_load_b128(vrs, vgo + vstep, so_v, 0); } while (0)
#define SWRITE(b) do { _Pragma("unroll") for (int i = 0; i < KP; ++i) *reinterpret_cast<u32x4*>(K_lds + (b) * SHM_K + kst[i]) = ks[i]; \
        *reinterpret_cast<u32x4*>(V_lds + (b) * SHM_V + vst0) = vs0; *reinterpret_cast<u32x4*>(V_lds + (b) * SHM_V + vst0 + vst1d) = vs1; } while (0)
    constexpr int KLINES = (64 * DK * 2) / 128, VLINES = 128, LPR = DK / 64;
    unsigned pf_dummy = 0u;
#define PREFETCH(t) do { if (PF && tid < KLINES + VLINES) { const bool isk_ = tid < KLINES; const int l_ = isk_ ? tid : tid - KLINES; \
        const unsigned off_ = isk_ ? (unsigned)(((t) * 64 + l_ / LPR) * ldk + (l_ % LPR) * 64) * 2u : (unsigned)(((t) * 64 + (l_ >> 1)) * ldv + (l_ & 1) * 64) * 2u + (unsigned)((const char*)Vh - (const char*)Kh); \
        asm volatile("global_load_dword %0, %1, %2" : "+v"(pf_dummy) : "v"(off_), "s"(Kh) : "memory"); } } while (0)
    const int ntile = nkeys / 64;
    PREFETCH(1); PREFETCH(2);
    SLOAD(0); SWRITE(0); __syncthreads();
    for (int j = 0; j < ntile; ++j) {
        const int cur = j & 1;
        PSUB_T0();
        if (EARLY && j + 1 < ntile) SLOAD((j + 1) * 64);
        f32x16 p0, p1;
#pragma unroll
        for (int r = 0; r < 16; ++r) { p0[r] = negM; p1[r] = negM; }
        const char* Kb = K_lds + cur * SHM_K;
#pragma unroll
        for (int d0 = 0; d0 < NQ; ++d0) {
            const bf16x8 b0 = *reinterpret_cast<const bf16x8*>(Kb + kra_(d0 & 3) + (d0 >> 2) * 128);
            const bf16x8 b1 = *reinterpret_cast<const bf16x8*>(Kb + kra_(d0 & 3) + (d0 >> 2) * 128 + 32 * DK * 2);
            p0 = __builtin_amdgcn_mfma_f32_32x32x16_bf16(b0, qr[d0], p0, 0, 0, 0);
            p1 = __builtin_amdgcn_mfma_f32_32x32x16_bf16(b1, qr[d0], p1, 0, 0, 0);
            if ((d0 & 3) == 3) SBAR();
        }
        PSUB_AT(1);
        if (!EARLY && j + 1 < ntile) SLOAD((j + 1) * 64);
        float ps = 0.f;
#pragma unroll
        for (int r = 0; r < 16; ++r) { p0[r] = __builtin_amdgcn_exp2f(p0[r]); p1[r] = __builtin_amdgcn_exp2f(p1[r]); ps += p0[r] + p1[r]; }
        l_reg += ps;
        bf16x8 pa0, pa1, pa2, pa3;
#define PK4(P, BASE, OUT) do { unsigned a0 = cvtpk(P[BASE + 0], P[BASE + 1]), a1 = cvtpk(P[BASE + 2], P[BASE + 3]);   \
        unsigned b0_ = cvtpk(P[BASE + 4], P[BASE + 5]), b1_ = cvtpk(P[BASE + 6], P[BASE + 7]);                              \
        auto r0 = __builtin_amdgcn_permlane32_swap(a0, b0_, false, false); auto r1 = __builtin_amdgcn_permlane32_swap(a1, b1_, false, false); \
        u32x4 w = {r0[0], r1[0], r0[1], r1[1]}; OUT = *reinterpret_cast<bf16x8*>(&w); } while (0)
        PK4(p0, 0, pa0); PK4(p0, 8, pa1); PK4(p1, 0, pa2); PK4(p1, 8, pa3);
#undef PK4
        PSUB_AT(2);
        const int vb = vb0 + cur * SHM_V;
        pv_one<0>(o[0], vb, pa0, pa1, pa2, pa3); pv_one<1>(o[1], vb, pa0, pa1, pa2, pa3); pv_one<2>(o[2], vb, pa0, pa1, pa2, pa3); pv_one<3>(o[3], vb, pa0, pa1, pa2, pa3);
        PSUB_AT(3);
        if (j + 1 < ntile) SWRITE(cur ^ 1);
        if (j + 3 < ntile) PREFETCH(j + 3);
        __syncthreads();
        PSUB_AT(4);
    }
    if (PF) asm volatile("s_waitcnt vmcnt(0)" : "+v"(pf_dummy) :: "memory");
#undef PREFETCH
#undef kra_
#undef SLOAD
#undef SWRITE
}
__device__ __forceinline__ void row_recip(float l_reg, float* li_l  , int r32, int hi, float (&rli)[16]) {
    { auto rr = __builtin_amdgcn_permlane32_swap(__float_as_uint(l_reg), __float_as_uint(l_reg), false, false); l_reg = __uint_as_float(rr[0]) + __uint_as_float(rr[1]); }
    if (hi == 0) li_l[r32] = l_reg;
    asm volatile("s_waitcnt lgkmcnt(0)" ::: "memory");
#pragma unroll
    for (int r = 0; r < 16; ++r) rli[r] = __builtin_amdgcn_rcpf(li_l[crow(r, hi)]);
}
#undef SBAR
}

constexpr int ATT_SCR_OFF = RING_BYTES - 2048;
__device__ __forceinline__ void mla_attn_unit(const Ptrs& P, unsigned char* lds, int b, int h, int qb, int ctxq, unsigned& sacc) {
    using namespace att;
    const int tid = threadIdx.x, wid = tid >> 6, lane = tid & 63, r32 = lane & 31, hi = lane >> 5;
    const bf16* Qm = (const bf16*)(P.ws + WS_QM); const bf16* Km = (const bf16*)(P.ws + WS_KM); const bf16* Vm = (const bf16*)(P.ws + WS_VM);
    const size_t u0 = (size_t)b * SU + (ctxq ? 0 : CTX) + qb * 256 + wid * 32;
    f32x16 o[4] = {}; float l_reg = 0.f;
    const float negM = -((const float*)(P.ws + WS_SCAL))[0];
    attn_loop<192, false, false>(Qm + (u0 + r32) * 768 + h * 192 + hi * 8, Km + (size_t)b * SU * 768 + h * 192, 768, Vm + (size_t)b * SU * 512 + h * 128, 512, ctxq ? CTX : SU, negM, o, l_reg, (char*)lds, sacc);
    float rli[16]; row_recip(l_reg, (float*)(lds + ATT_SCR_OFF) + wid * 64, r32, hi, rli);
    bf16* stg = (bf16*)lds + wid * 4096;
#pragma unroll
    for (int r = 0; r < 16; ++r) { const int orow = crow(r, hi);
#pragma unroll
        for (int d0 = 0; d0 < 4; ++d0) stg[orow * 128 + d0 * 32 + r32] = f2bf(o[d0][r] * rli[r]); }
    asm volatile("s_waitcnt lgkmcnt(0)" ::: "memory");
    bf16* mix = (bf16*)(P.ws + WS_MIX) + u0 * D + 512 + h * 128;
#pragma unroll
    for (int i = 0; i < 8; ++i) { const int row = i * 4 + (lane >> 4), ch = lane & 15; const u32x4 v = *(const u32x4*)(stg + row * 128 + ch * 8); *(u32x4*)(mix + (size_t)row * D + ch * 8) = v; }
    asm volatile("s_waitcnt lgkmcnt(0)" ::: "memory");
    __syncthreads();
}
__device__ __forceinline__ void diff_attn_unit(const Ptrs& P, unsigned char* lds, int b, int h, int qb, unsigned& sacc) {
    using namespace att;
    const int tid = threadIdx.x, wid = tid >> 6, lane = tid & 63, r32 = lane & 31, hi = lane >> 5;
    const bf16* Z = (const bf16*)(P.ws + WS_Z);
    const size_t u0 = (size_t)b * SU + CTX + qb * 256 + wid * 32;
    const float* scal = (const float*)(P.ws + WS_SCAL); const float negM = -scal[1], lam = scal[2], oml = scal[3];
    bf16* stg = (bf16*)lds + wid * 4096;
    float* li_l = (float*)(lds + ATT_SCR_OFF) + wid * 64;
    for (int part = 0; part < 2; ++part) {
        f32x16 o[4] = {}; float l_reg = 0.f;
        attn_loop<64, true, true>(Z + (u0 + r32) * ODD_IN + h * 128 + part * 64 + hi * 8, Z + 1024 + (size_t)b * SU * ODD_IN + h * 128 + part * 64, ODD_IN, Z + 2048 + (size_t)b * SU * ODD_IN + h * 128, ODD_IN, SU, negM, o, l_reg, (char*)lds + 65536, sacc);
        float rli[16]; row_recip(l_reg, li_l, r32, hi, rli);
#pragma unroll
        for (int r = 0; r < 16; ++r) { const int orow = crow(r, hi);
#pragma unroll
            for (int d0 = 0; d0 < 4; ++d0) { bf16* s = stg + orow * 128 + d0 * 32 + r32; const float on = o[d0][r] * rli[r];
                if (part == 0) *s = f2bf(on); else *s = f2bf(bf2f(*s) - lam * on); } }
        asm volatile("s_waitcnt lgkmcnt(0)" ::: "memory");
    }
    const float* sg = P.in[31];
    bf16* mix = (bf16*)(P.ws + WS_MIX) + u0 * D + h * 128;
#pragma unroll
    for (int i = 0; i < 8; ++i) { const int row = i * 4 + (lane >> 4), ch = lane & 15; const u32x4 v = *(const u32x4*)(stg + row * 128 + ch * 8);
        float f[8]; float ss = 0.f;
#pragma unroll
        for (int e = 0; e < 4; ++e) { f[2 * e] = __uint_as_float(v[e] << 16); f[2 * e + 1] = __uint_as_float(v[e] & 0xffff0000u); ss += f[2 * e] * f[2 * e] + f[2 * e + 1] * f[2 * e + 1]; }
        ss += __shfl_xor(ss, 1); ss += __shfl_xor(ss, 2); ss += __shfl_xor(ss, 4); ss += __shfl_xor(ss, 8);
        const float rs = rsqrtf(ss * (1.f / 128.f) + EPS) * oml;
        const f32x4 g0 = *(const f32x4*)(sg + ch * 8), g1 = *(const f32x4*)(sg + ch * 8 + 4);
        u32x4 w; w.x = att::cvtpk(f[0] * rs * g0[0], f[1] * rs * g0[1]); w.y = att::cvtpk(f[2] * rs * g0[2], f[3] * rs * g0[3]); w.z = att::cvtpk(f[4] * rs * g1[0], f[5] * rs * g1[1]); w.w = att::cvtpk(f[6] * rs * g1[2], f[7] * rs * g1[3]);
        *(u32x4*)(mix + (size_t)row * D + ch * 8) = w; }
    asm volatile("s_waitcnt lgkmcnt(0)" ::: "memory");
    __syncthreads();
}

__device__ __forceinline__ void ph_norm2_router(const Ptrs& P, unsigned char* lds, int layer, int latent_only) {
    const int tid = threadIdx.x, wid = tid >> 6, lane = tid & 63, fr = lane & 15, fq = lane >> 4, G = gridDim.x;
    float* RS = (float*)lds;
    float* LGP = RS + 256;
    int* TOPE = (int*)(LGP + 2 * 4096);
    float* TOPW = (float*)(TOPE + 512);
    int* TOPR = (int*)(TOPW + 512);
    int* LCNT = TOPR + 512;
    int* LBASE = LCNT + 32;
    int* GU0 = LBASE + 32;
    const float* gn = P.in[7] + layer * D;
    const float* rw = P.in[32] + (size_t)layer * D * NE; const float* rb = P.in[33] + layer * NE;
    const int cw0 = 128 * wid + 8 * fq;
    float wv0[4][8], wv1[4][8];
#pragma unroll
    for (int ks = 0; ks < 4; ++ks) { const float* wr = rw + (size_t)(cw0 + 32 * ks) * NE + fr;
#pragma unroll
        for (int j = 0; j < 8; ++j) { wv0[ks][j] = wr[j * NE]; wv1[ks][j] = wr[j * NE + 16]; } }
    const int NG = latent_only ? NB * (SEQ / 16) : R / 16;
    const int q0 = (int)(((long long)blockIdx.x * NG) / G), q1 = (int)(((long long)(blockIdx.x + 1) * NG) / G);
#define N2_U0(q) (latent_only ? ((q) >> 8) * SU + CTX + ((q) & 255) * 16 : (q) * 16)
#define N2_XLOAD(XR, q) do { const bf16* x_ = (const bf16*)(P.ws + WS_XB) + (size_t)(N2_U0(q) + fr) * D + cw0; _Pragma("unroll") for (int ks = 0; ks < 4; ++ks) XR[ks] = *(const u32x4*)(x_ + 32 * ks); } while (0)
#define N2_LO(w) __uint_as_float((w) << 16)
#define N2_HI(w) __uint_as_float((w) & 0xffff0000u)
#define N2_SS(XR, par) do { float ss = 0.f; _Pragma("unroll") for (int ks = 0; ks < 4; ++ks) { const u32x4 r = XR[ks]; \
            ss += N2_LO(r.x) * N2_LO(r.x) + N2_HI(r.x) * N2_HI(r.x) + N2_LO(r.y) * N2_LO(r.y) + N2_HI(r.y) * N2_HI(r.y) + N2_LO(r.z) * N2_LO(r.z) + N2_HI(r.z) * N2_HI(r.z) + N2_LO(r.w) * N2_LO(r.w) + N2_HI(r.w) * N2_HI(r.w); } \
        ss += __shfl_xor(ss, 16); ss += __shfl_xor(ss, 32); if (fq == 0) RS[(par) * 128 + wid * 16 + fr] = ss; } while (0)
    float A[4][8], Hs[4][8]; int mi_cur = -1;
    for (int qs = q0; qs < q1; qs += 8) {
        const int qe = qs + 8 < q1 ? qs + 8 : q1;
        __syncthreads();
        if (tid < 32) LCNT[tid] = 0;
        u32x4 xr[4], xn[4];
        N2_XLOAD(xr, qs);
        N2_SS(xr, 0);
        __syncthreads();
        for (int q = qs; q < qe; ++q) {
            const int gi = q - qs, par = gi & 1, u0 = N2_U0(q), u = u0 + fr;
            { const int b_ = u0 / SU, mi = (u0 % SU) < CTX ? 4 : b_;
              if (mi != mi_cur) { mi_cur = mi; const float* md = (const float*)(P.ws + WS_MOD) + (size_t)(layer * 5 + mi) * 6144 + 3 * D;
#pragma unroll
                  for (int ks = 0; ks < 4; ++ks) { const int c0 = cw0 + 32 * ks;
                      const f32x4 g0 = *(const f32x4*)(gn + c0), g1 = *(const f32x4*)(gn + c0 + 4), s0 = *(const f32x4*)(md + D + c0), s1 = *(const f32x4*)(md + D + c0 + 4), h0 = *(const f32x4*)(md + c0), h1 = *(const f32x4*)(md + c0 + 4);
#pragma unroll
                      for (int j = 0; j < 4; ++j) { A[ks][j] = g0[j] * (1.f + s0[j]); A[ks][4 + j] = g1[j] * (1.f + s1[j]); Hs[ks][j] = h0[j]; Hs[ks][4 + j] = h1[j]; } } } }
            if (q + 1 < qe) N2_XLOAD(xn, q + 1);
            if (tid == 0) GU0[gi] = u0;
            float tot = 0.f;
#pragma unroll
            for (int w = 0; w < 8; ++w) tot += RS[par * 128 + w * 16 + fr];
            const float rstd = rsqrtf(tot * (1.f / D) + EPS);
            f32x4 acc0 = {0.f, 0.f, 0.f, 0.f}, acc1 = {0.f, 0.f, 0.f, 0.f};
            bf16* h = (bf16*)(P.ws + WS_H) + (size_t)u * D + cw0;
#pragma unroll
            for (int ks = 0; ks < 4; ++ks) {
                float y[8];
                const u32x4 r = xr[ks]; const float xv[8] = {N2_LO(r.x), N2_HI(r.x), N2_LO(r.y), N2_HI(r.y), N2_LO(r.z), N2_HI(r.z), N2_LO(r.w), N2_HI(r.w)};
#pragma unroll
                for (int j = 0; j < 8; ++j) y[j] = xv[j] * rstd * A[ks][j] + Hs[ks][j];
                u32x4 w; w.x = g8::cvt_pk_bf16(y[0], y[1]); w.y = g8::cvt_pk_bf16(y[2], y[3]); w.z = g8::cvt_pk_bf16(y[4], y[5]); w.w = g8::cvt_pk_bf16(y[6], y[7]);
                *(u32x4*)(h + 32 * ks) = w;
#pragma unroll
                for (int j = 0; j < 8; ++j) {
                    acc0 = __builtin_amdgcn_mfma_f32_16x16x4f32(y[j], wv0[ks][j], acc0, 0, 0, 0);
                    acc1 = __builtin_amdgcn_mfma_f32_16x16x4f32(y[j], wv1[ks][j], acc1, 0, 0, 0);
                }
            }
            float* lgp = LGP + par * 4096;
#pragma unroll
            for (int j = 0; j < 4; ++j) { lgp[(wid * 16 + 4 * fq + j) * 32 + fr] = acc0[j]; lgp[(wid * 16 + 4 * fq + j) * 32 + 16 + fr] = acc1[j]; }
            if (q + 1 < qe) { N2_SS(xn, par ^ 1);
#pragma unroll
                for (int ks = 0; ks < 4; ++ks) xr[ks] = xn[ks]; }
            __syncthreads();
            {
                const int e = lane & 31, row = 2 * wid + (lane >> 5);
                float lg = rb[e];
#pragma unroll
                for (int w = 0; w < 8; ++w) lg += lgp[(w * 16 + row) * 32 + e];
                int te[4]; float tv[4];
#pragma unroll
                for (int k = 0; k < 4; ++k) {
                    float bv = lg; int bi = e;
#pragma unroll
                    for (int m = 1; m < 32; m <<= 1) { const float ov = __shfl_xor(bv, m); const int oi = __shfl_xor(bi, m); const bool take = ov > bv || (ov == bv && oi < bi); bv = take ? ov : bv; bi = take ? oi : bi; }
                    te[k] = bi; tv[k] = bv; if (e == bi) lg = -3.4e38f;
                }
                float den = 0.f, w[4];
#pragma unroll
                for (int k = 0; k < 4; ++k) { w[k] = __expf(tv[k] - tv[0]); den += w[k]; }
                const float iden = 1.f / den;
                if (e < 4) { const int ek = e == 0 ? te[0] : e == 1 ? te[1] : e == 2 ? te[2] : te[3]; const float wk = (e == 0 ? w[0] : e == 1 ? w[1] : e == 2 ? w[2] : w[3]) * iden;
                    TOPE[gi * 64 + row * 4 + e] = ek; TOPW[gi * 64 + row * 4 + e] = wk; TOPR[gi * 64 + row * 4 + e] = atomicAdd(&LCNT[ek], 1); }
            }
        }
        __syncthreads();
        if (tid < 32) { int t2 = tid; asm volatile("" : "+v"(t2));
            const int c = LCNT[t2]; LBASE[t2] = c > 0 ? (int)atomicAdd((unsigned*)(P.ws + WS_CTL) + CW_CNT + layer * 64 + t2, (unsigned)c) : 0; }
        __syncthreads();
        int* tok_of = (int*)(P.ws + WS_TOKOF); int* pair_of = (int*)(P.ws + WS_PAIROF); float* gate_of = (float*)(P.ws + WS_GATEOF);
        for (int p = tid; p < (qe - qs) * 64; p += NT) {
            const int e = TOPE[p], rk = LBASE[e] + TOPR[p], ur = GU0[p >> 6] + ((p & 63) >> 2), k = p & 3;
            tok_of[(size_t)e * R + rk] = ur; pair_of[(size_t)e * R + rk] = ur * 4 + k; gate_of[(size_t)e * R + rk] = TOPW[p];
        }
    }
#undef N2_U0
#undef N2_XLOAD
#undef N2_SS
#undef N2_LO
#undef N2_HI
}

struct Args { Ptrs P; int ph_lo, ph_hi; };
constexpr int N_PHASES = 19;
__global__ void __launch_bounds__(NT, 2) mega(Args args) {
    extern __shared__ __attribute__((aligned(16))) unsigned char lds[];
    const Ptrs& P = args.P;
    unsigned char* ws = P.ws;
    const int tid = threadIdx.x, G = gridDim.x;
    const int vcu = (G % 8 == 0) ? ((int)blockIdx.x % 8) * (G / 8) + (int)blockIdx.x / 8 : (int)blockIdx.x;
    LAS unsigned char* LDSP = (LAS unsigned char*)lds;
    volatile LAS unsigned* MISC = (volatile LAS unsigned*)((LAS unsigned char*)lds + MISC_OFF);
    for (int u = tid; u < (LDS_BYTES - LDSCTL_OFF) / 4; u += NT) ((LAS unsigned*)((LAS unsigned char*)lds + LDSCTL_OFF))[u] = 0u;
    __syncthreads();
    XcdBarrier bar = xcd_barrier_post((unsigned*)(ws + WS_CTL) + CW_BAR, MISC + 8);
    const int lo = args.ph_lo, hi = args.ph_hi;
#ifndef PROBE_MASK
#define PROBE_MASK 0u
#endif
    unsigned long long pr_acc = 0ull, pr_t0 = 0ull; unsigned sub_acc = 0u;
#define IN(k) (lo <= (k) && (k) < hi)
#define SEAM(k) do { if (IN(k) && IN((k) + 1)) xcd_barrier(bar); \
        if (PROBE_MASK) { const unsigned long long t_ = __builtin_amdgcn_s_memrealtime(); if ((PROBE_MASK >> (k)) & 1u) pr_acc += t_ - pr_t0; pr_t0 = t_; } } while (0)
    if (PROBE_MASK) pr_t0 = __builtin_amdgcn_s_memrealtime();
    const bf16* H = (const bf16*)(ws + WS_H); bf16* Z = (bf16*)(ws + WS_Z); const bf16* MIX = (const bf16*)(ws + WS_MIX);
    const bf16* Qm = (const bf16*)(ws + WS_QM); const bf16* Km = (const bf16*)(ws + WS_KM); const bf16* Vm = (const bf16*)(ws + WS_VM);

    if (IN(0)) { ph_prologue(P, lds, sub_acc); } SEAM(0);
    if (IN(1)) { ph_rows(P, 0, 0, 0, 0); } SEAM(1);
    if (IN(2)) { g8::DenseOrder S; S.init(H, D, (const bf16*)(ws + WS_WEVIN), D, R, EVEN_IN_P, G, (int)blockIdx.x, 0); g8::EpiStoreBf16 E{Z, EVEN_IN_P};
        g8::gemm_phase<g8::EpiStoreBf16, g8::DenseOrder, false, true>(LDSP, D, D, S, E); } SEAM(2);
    if (IN(3)) {
        { g8::UpOrder S{(const char*)Z, (const char*)(ws + WS_WUQ), (const char*)(ws + WS_WUKV), G, (int)blockIdx.x}; g8::EpiStoreBf16 E{(bf16*)(ws + WS_QP), 1792};
          g8::gemm_phase<g8::EpiStoreBf16, g8::UpOrder, false, true>(LDSP, EVEN_IN_P, 384, S, E); }
        ph_lru(P, lds, 0, 0, 0);
    } SEAM(3);
    if (IN(4)) { ph_mla_prep(P); } SEAM(4);
    if (IN(5)) {
        ph_lru(P, lds, 1, 128, 0);
        for (int it = vcu; it < 256 + 16; it += G) {
            if (it < 256) mla_attn_unit(P, lds, it / 64, (it / 16) % 4, it % 16, 0, sub_acc);
            else { const int i2 = it - 256; mla_attn_unit(P, lds, i2 / 4, i2 % 4, 0, 1, sub_acc); }
        }
    } SEAM(5);
    if (IN(6)) { g8::DenseOrder S; S.init(MIX, D, (const bf16*)(ws + WS_WEVOUT), D, R, D, G, (int)blockIdx.x, 0); g8::EpiOut E{P, 0};
        g8::gemm_phase<g8::EpiOut, g8::DenseOrder, false, true>(LDSP, D, D, S, E); } SEAM(6);
    if (IN(7)) { ph_norm2_router(P, lds, 0, 0); } SEAM(7);
    if (IN(8)) { g8::MoeOrder S{(const char*)H, (const char*)(ws + WS_WGU) + (size_t)0 * NE * 2048 * 1024 * 2, (const int*)(ws + WS_TOKOF), (size_t)2048 * 1024 * 2, 8, D, G, vcu, 1, nullptr};
        S.init((const unsigned*)(ws + WS_CTL) + CW_CNT + 0 * 64, (LAS int*)(LDSP + MISC_OFF + 256)); g8::EpiMoe1 E{P, 0}; g8::gemm_phase<g8::EpiMoe1, g8::MoeOrder, true, true>(LDSP, D, D, S, E); } SEAM(8);
    if (IN(9)) { g8::MoeOrder S{(const char*)(ws + WS_ACT), (const char*)(ws + WS_WDN) + (size_t)0 * NE * 1024 * 1024 * 2, nullptr, (size_t)1024 * 1024 * 2, 4, D, G, vcu, 0, nullptr};
        S.init((const unsigned*)(ws + WS_CTL) + CW_CNT + 0 * 64, (LAS int*)(LDSP + MISC_OFF + 256)); g8::EpiMoe2 E{P, 0}; g8::gemm_phase<g8::EpiMoe2, g8::MoeOrder, false, true>(LDSP, D, D, S, E); } SEAM(9);
    if (IN(10)) { ph_rows(P, 0, 2, 0, 1); } SEAM(10);
    if (IN(11)) { g8::DenseOrder S; S.init(H, D, (const bf16*)(ws + WS_WODIN), D, R, ODD_IN, G, (int)blockIdx.x, 0);
        g8::EpiDiffIn E{Z, P.in[25], P.in[26], (const float*)(ws + WS_ROPE), (const float*)(ws + WS_ROPE) + SEQ * 64, (LAS float*)(LDSP + MISC_OFF + 1024)};
        g8::gemm_phase<g8::EpiDiffIn, g8::DenseOrder, false, true>(LDSP, D, D, S, E); } SEAM(11);
    if (IN(13)) {
        for (int it = vcu; it < 512; it += G) { unsigned tq0 = 0u; if (PROBE_SUB == 5 && PROBE_SUBDK == 64) tq0 = (unsigned)__builtin_readcyclecounter();
            diff_attn_unit(P, lds, it / 128, (it / 16) % 8, it % 16, sub_acc);
            if (PROBE_SUB == 5 && PROBE_SUBDK == 64) sub_acc += (unsigned)__builtin_readcyclecounter() - tq0; }
    } SEAM(13);
    if (IN(14)) { g8::DenseOrder S; S.init(MIX, D, (const bf16*)(ws + WS_WODOUT), D, R, D, G, (int)blockIdx.x, 1); g8::EpiOut E{P, 1};
        g8::gemm_phase<g8::EpiOut, g8::DenseOrder, false, true>(LDSP, D, D, S, E); } SEAM(14);
    if (IN(15)) { ph_norm2_router(P, lds, 1, 1); } SEAM(15);
    if (IN(16)) { g8::MoeOrder S{(const char*)H, (const char*)(ws + WS_WGU) + (size_t)1 * NE * 2048 * 1024 * 2, (const int*)(ws + WS_TOKOF), (size_t)2048 * 1024 * 2, 8, D, G, vcu, 1, nullptr};
        S.init((const unsigned*)(ws + WS_CTL) + CW_CNT + 1 * 64, (LAS int*)(LDSP + MISC_OFF + 256)); g8::EpiMoe1 E{P, 1}; g8::gemm_phase<g8::EpiMoe1, g8::MoeOrder, true, true>(LDSP, D, D, S, E); } SEAM(16);
    if (IN(17)) { g8::MoeOrder S{(const char*)(ws + WS_ACT), (const char*)(ws + WS_WDN) + (size_t)1 * NE * 1024 * 1024 * 2, nullptr, (size_t)1024 * 1024 * 2, 4, D, G, vcu, 0, nullptr};
        S.init((const unsigned*)(ws + WS_CTL) + CW_CNT + 1 * 64, (LAS int*)(LDSP + MISC_OFF + 256)); g8::EpiMoe2 E{P, 1}; g8::gemm_phase<g8::EpiMoe2, g8::MoeOrder, false, true>(LDSP, D, D, S, E); } SEAM(17);
    if (IN(18)) { ph_rows(P, 1, 2, 1, 0); }
    if (PROBE_MASK) { const unsigned long long t_ = __builtin_amdgcn_s_memrealtime(); if ((PROBE_MASK >> 18) & 1u) pr_acc += t_ - pr_t0;
        if (blockIdx.x == 0) { const unsigned long long t1 = t_ + 8ull * pr_acc; while (__builtin_amdgcn_s_memrealtime() < t1) __builtin_amdgcn_s_sleep(8); } }
    if (PROBE_SUB && (PROBE_SUBBLK < 0 || (int)blockIdx.x == PROBE_SUBBLK)) { const unsigned long long t1 = __builtin_readcyclecounter() + 8ull * (unsigned long long)sub_acc; while (__builtin_readcyclecounter() < t1) __builtin_amdgcn_s_sleep(8); }
#undef IN
#undef SEAM
}

#ifndef MK_PER_PHASE
#define MK_PER_PHASE 0
#endif
extern "C" void kernel_launch(void* const* d_in, const int* in_sizes, int n_in, void* d_out, int out_size, void* d_ws, size_t ws_size, hipStream_t stream) {
    static int grid = 0;
    if (grid == 0) {
        if (n_in != 38 || ws_size < WS_END) { fprintf(stderr, "kernel_launch: bad args n_in=%d ws=%zu need %zu\n", n_in, ws_size, (size_t)WS_END); grid = -1; return; }
        int dev = 0, cus = 0, per_cu = 0;
        if (hipGetDevice(&dev) != hipSuccess || hipDeviceGetAttribute(&cus, hipDeviceAttributeMultiprocessorCount, dev) != hipSuccess) { grid = -1; return; }
        if (hipFuncSetAttribute((const void*)mega, hipFuncAttributeMaxDynamicSharedMemorySize, LDS_BYTES) != hipSuccess) { fprintf(stderr, "kernel_launch: hipFuncSetAttribute failed\n"); grid = -1; return; }
        if (hipOccupancyMaxActiveBlocksPerMultiprocessor(&per_cu, (const void*)mega, NT, LDS_BYTES) != hipSuccess || per_cu < 1) { fprintf(stderr, "kernel_launch: occupancy query says %d blocks/CU\n", per_cu); grid = -1; return; }
        (void)hipGetLastError();
        grid = cus;
    }
    if (grid < 0) return;
    if (hipMemsetAsync((char*)d_ws + WS_CTL, 0, 1u << 20, stream) != hipSuccess) return;
    Args a; memset((void*)&a, 0, sizeof(a));
    for (int i = 0; i < 38; ++i) a.P.in[i] = (const float*)d_in[i];
    a.P.out = (float*)d_out; a.P.ws = (unsigned char*)d_ws;
#if MK_PER_PHASE
    for (int p = 0; p < N_PHASES; ++p) { a.ph_lo = p; a.ph_hi = p + 1; hipLaunchKernelGGL(mega, dim3(grid), dim3(NT), LDS_BYTES, stream, a); }
#else
    a.ph_lo = 0; a.ph_hi = N_PHASES;
    hipLaunchKernelGGL(mega, dim3(grid), dim3(NT), LDS_BYTES, stream, a);
#endif
    const hipError_t le = hipPeekAtLastError();
    if (le != hipSuccess) fprintf(stderr, "kernel_launch: launch failed: %s\n", hipGetErrorName(le));
}
```

```cpp
#include <hip/hip_runtime.h>
#include <cstdio>
#include <cstdint>
#include <cstring>

typedef unsigned short bf16;
typedef unsigned u32x4 __attribute__((ext_vector_type(4)));
typedef float f32x4 __attribute__((ext_vector_type(4)));

constexpr int D = 1024, NB = 4, SEQ = 4096, CTX = 256, SU = SEQ + CTX, R = NB * SU;
constexpr int GRID_W = 64;
constexpr int LRU_W = 512, LRU_NB = 8, LRU_BW = 64;
constexpr int MLA_H = 4, MLA_QR = 384, MLA_KVR = 256, MLA_NOPE = 128, MLA_ROPE = 64, MLA_V = 128, MLA_QK = 192;
constexpr int EVEN_IN = 1728, EVEN_IN_P = 1792;
constexpr int DIFF_H = 8, ODD_IN = 3072;
constexpr int NE = 32, TOPK = 4, DFF = 1024;
constexpr float EPS = 1e-6f;
constexpr int CHUNK = 128, NCH = SU / CHUNK;

constexpr size_t al256(size_t x) { return (x + 255) / 256 * 256; }
constexpr size_t WS_CTL = 0;
constexpr size_t WS_MOD = 1u << 20;
constexpr size_t WS_SCAL = WS_MOD + al256(2 * 5 * 6144 * 4);
constexpr size_t WS_WEVIN = WS_SCAL + 8192;
constexpr size_t WS_WEVOUT = WS_WEVIN + (size_t)EVEN_IN_P * D * 2;
constexpr size_t WS_WUQ = WS_WEVOUT + (size_t)D * D * 2;
constexpr size_t WS_WUKV = WS_WUQ + (size_t)768 * 384 * 2;
constexpr size_t WS_WLRU = WS_WUKV + (size_t)1024 * 384 * 2;
constexpr size_t WS_WODIN = WS_WLRU + (size_t)32 * 4096 * 2;
constexpr size_t WS_WODOUT = WS_WODIN + (size_t)ODD_IN * D * 2;
constexpr size_t WS_WGU = WS_WODOUT + (size_t)D * D * 2;
constexpr size_t WS_WDN = WS_WGU + (size_t)2 * NE * 2048 * 1024 * 2;
constexpr size_t WS_XC = WS_WDN + (size_t)2 * NE * 1024 * 1024 * 2;
constexpr size_t WS_H = WS_XC + (size_t)NB * CTX * D * 4;
constexpr size_t WS_Z = WS_H + (size_t)R * D * 2;
constexpr size_t WS_QP = WS_Z + (size_t)R * ODD_IN * 2;
constexpr size_t WS_KVP = WS_QP + (size_t)R * 768 * 2;
constexpr size_t WS_QM = WS_KVP + (size_t)R * 1024 * 2;
constexpr size_t WS_KM = WS_QM + (size_t)R * 768 * 2;
constexpr size_t WS_VM = WS_KM + (size_t)R * 768 * 2;
constexpr size_t WS_AGG = WS_VM + (size_t)R * 512 * 2;
constexpr size_t WS_MIX = WS_AGG + al256((size_t)NB * NCH * 2 * 512 * 2 * 4);
constexpr size_t WS_TOKOF = WS_MIX + (size_t)R * D * 2;
constexpr size_t WS_PAIROF = WS_TOKOF + (size_t)NE * R * 4;
constexpr size_t WS_GATEOF = WS_PAIROF + (size_t)NE * R * 4;
constexpr size_t ACT_ROWS = (size_t)R * TOPK + NE * 256;
constexpr size_t WS_ACT = WS_GATEOF + (size_t)NE * R * 4;
constexpr size_t WS_Y = WS_ACT + ACT_ROWS * 1024 * 2;
constexpr size_t WS_XB = WS_Y + (size_t)R * TOPK * 1024 * 2;
constexpr size_t WS_ROPE = WS_XB + (size_t)R * D * 2;
constexpr size_t WS_END = WS_ROPE + (size_t)2 * SEQ * 64 * 4;

constexpr int CW_CNT = 64;

__device__ __forceinline__ float bf2f(bf16 v) { return __uint_as_float((unsigned)v << 16); }
__device__ __forceinline__ bf16 f2bf(float f) { unsigned u = __float_as_uint(f); return (bf16)((u + 0x7fffu + ((u >> 16) & 1u)) >> 16); }
__device__ __forceinline__ float wave_sum(float v) {
#pragma unroll
    for (int o = 1; o < 64; o <<= 1) v += __shfl_xor(v, o);
    return v;
}
__device__ __forceinline__ unsigned g8_cvt_pk(float lo, float hi) { unsigned r; asm volatile("v_cvt_pk_bf16_f32 %0, %1, %2" : "=v"(r) : "v"(lo), "v"(hi)); return r; }
__device__ __forceinline__ float sigmoidf_(float x) { return 1.f / (1.f + __expf(-x)); }
__device__ __forceinline__ float gelu_tanh(float x) { const float t = tanhf(0.7978845608028654f * (x + 0.044715f * x * x * x)); return 0.5f * x * (1.f + t); }

struct Ptrs {
    const float* in[38];
    float* out;
    unsigned char* ws;
};

__device__ __forceinline__ const float* res_in_row(const Ptrs& P, int layer, int u) {
    const int b = u / SU, j = u % SU;
    if (layer == 0) return j < CTX ? P.in[2] + (size_t)(b * CTX + j) * D : P.in[0] + (size_t)(b * SEQ + j - CTX) * D;
    return j < CTX ? (const float*)(P.ws + WS_XC) + (size_t)(b * CTX + j) * D : P.out + (size_t)(b * SEQ + j - CTX) * D;
}
__device__ __forceinline__ float* res_out_row(const Ptrs& P, int u) {
    const int b = u / SU, j = u % SU;
    return j < CTX ? (float*)(P.ws + WS_XC) + (size_t)(b * CTX + j) * D : P.out + (size_t)(b * SEQ + j - CTX) * D;
}
__device__ __forceinline__ const float* mod_row(const Ptrs& P, int layer, int u) {
    const int b = u / SU, j = u % SU;
    return (const float*)(P.ws + WS_MOD) + (size_t)(layer * 5 + (j < CTX ? 4 : b)) * 6144;
}

constexpr float LOG2E = 1.4426950408889634f;
#define GAS __attribute__((address_space(1)))
#define LAS __attribute__((address_space(3)))
constexpr int NT = 512;
constexpr int LDS_BYTES = 147456;
constexpr int RING_BYTES = 131072, LDSCTL_OFF = RING_BYTES, MISC_OFF = LDSCTL_OFF + 320;
constexpr int CW_BAR = 4096;
constexpr int CW_TMO = 0;

#define XB_TMO      128
#define XB_XCNT(j)  (256  + 64 * (j))
#define XB_XSUB(j)  (1280 + 64 * (j))
#define XB_XGEN(j)  (2304 + 64 * (j))
#define XB_TOP      3328
#define XB_TOPGEN   3392
#define XCD_BAR_WORDS 3456
#define XB_SPIN_CAP (1u << 22)
__device__ __forceinline__ unsigned xb_ld(unsigned* p)              { return __hip_atomic_load(p, __ATOMIC_RELAXED, __HIP_MEMORY_SCOPE_AGENT); }
__device__ __forceinline__ unsigned xb_add(unsigned* p, unsigned v) { return __hip_atomic_fetch_add(p, v, __ATOMIC_RELAXED, __HIP_MEMORY_SCOPE_AGENT); }
__device__ __forceinline__ unsigned xb_xcc_id() { return (unsigned)__builtin_amdgcn_s_getreg((3 << 11) | 20) & 0xFu; }
#define XB_SPIN(cond, bar) do { unsigned _sp = 0; while (cond) { __builtin_amdgcn_s_sleep(1); \
    if ((++_sp & 255u) == 0u) { if (xb_ld(&(bar)[XB_TMO])) break; if (_sp > XB_SPIN_CAP) { atomicAdd(&(bar)[XB_TMO], 1u); break; } } } } while (0)
struct XcdBarrier { unsigned* bar; unsigned x; volatile LAS unsigned* st; };
__device__ __forceinline__ XcdBarrier xcd_barrier_post(unsigned* bar, volatile LAS unsigned* st) {
    XcdBarrier b; b.bar = bar; b.x = xb_xcc_id(); b.st = st;
    if (threadIdx.x == 0) (void)xb_add(&bar[XB_XCNT(b.x)], 1u);
    return b;
}
__device__ __forceinline__ void xcd_barrier_complete(unsigned* bar, unsigned x, unsigned& nloc, unsigned& nx) {
    const unsigned G = gridDim.x * gridDim.y * gridDim.z;
    unsigned sum, cnt, mine, sp = 0u;
    for (;;) {
        sum = 0u; cnt = 0u; mine = 0u;
#pragma unroll
        for (unsigned j = 0; j < 16; ++j) { const unsigned c = xb_ld(&bar[XB_XCNT(j)]); sum += c; cnt += (c > 0u) ? 1u : 0u; mine = (j == x) ? c : mine; }
        if (sum == G) break;
        __builtin_amdgcn_s_sleep(1);
        if ((++sp & 255u) == 0u) { if (xb_ld(&bar[XB_TMO])) break; if (sp > XB_SPIN_CAP) { atomicAdd(&bar[XB_TMO], 1u); break; } }
    }
    nloc = mine > 0u ? mine : 1u; nx = cnt > 0u ? cnt : 1u;
}
__device__ __forceinline__ void xcd_barrier(const XcdBarrier& b) {
    asm volatile("s_waitcnt vmcnt(0)" ::: "memory");
    __syncthreads();
    if (threadIdx.x == 0) {
        unsigned* bar = b.bar;
        __builtin_amdgcn_s_waitcnt(0);
        unsigned nloc = b.st[0], nx = b.st[1];
        if (nloc == 0u) { xcd_barrier_complete(bar, b.x, nloc, nx); b.st[0] = nloc; b.st[1] = nx; }
        const unsigned old = xb_add(&bar[XB_XSUB(b.x)], 1u);
        const unsigned gen = old / nloc;
        if (old + 1u == (gen + 1u) * nloc) {
            __builtin_amdgcn_fence(__ATOMIC_RELEASE, "agent");
            asm volatile("s_waitcnt vmcnt(0)" ::: "memory");
            const unsigned og = xb_add(&bar[XB_TOP], 1u);
            const unsigned tg = og / nx;
            if (og + 1u == (tg + 1u) * nx) xb_add(&bar[XB_TOPGEN], 1u);
            else XB_SPIN(xb_ld(&bar[XB_TOPGEN]) == tg, bar);
            __builtin_amdgcn_fence(__ATOMIC_ACQUIRE, "agent");
            xb_add(&bar[XB_XGEN(b.x)], 1u);
            asm volatile("s_waitcnt vmcnt(0)" ::: "memory");
        } else {
            XB_SPIN(xb_ld(&bar[XB_XGEN(b.x)]) == gen, bar);
            __builtin_amdgcn_fence(__ATOMIC_ACQUIRE, "agent");
            asm volatile("s_waitcnt vmcnt(0)" ::: "memory");
        }
    }
    __syncthreads();
}

struct TJob { const float* src; bf16* dst; const float* rs; int K, N, Npad, perm, batch; size_t sstr, dstr; int Ksrc; };
__device__ __forceinline__ void tt_load(const TJob& j, int it, int lane, f32x4 (&v)[16]) {
    const int tn = j.Npad / 64, per = tn * (j.K / 64), z = it / per, r = it % per, n0 = (r % tn) * 64, k0 = (r / tn) * 64;
    const float* src = j.src + z * j.sstr;
    const int n4 = (lane & 15) * 4, np = n0 + n4;
    int sc = np; if (j.perm == 1) sc = (np / 256) * 128 + (np % 128) + ((np % 256) / 128) * 1024;
#pragma unroll
    for (int i = 0; i < 16; ++i) { const int k = k0 + i * 4 + (lane >> 4); f32x4 t = {0.f, 0.f, 0.f, 0.f}; if (sc < j.N && k < j.Ksrc) { t = *(const f32x4*)(src + (size_t)k * j.N + sc); if (j.rs) t = t * j.rs[k]; } v[i] = t; }
}
__device__ __forceinline__ void tt_store(const TJob& j, int it, int lane, const f32x4 (&v)[16], float* wt) {
    const int tn = j.Npad / 64, per = tn * (j.K / 64), z = it / per, r = it % per, n0 = (r % tn) * 64, k0 = (r / tn) * 64;
    bf16* dst = j.dst + z * j.dstr + ((((size_t)(n0 >> 8) * (j.K >> 6) + (k0 >> 6)) << 14) + (((n0 & 255) + lane) << 6));
    const int n4 = (lane & 15) * 4;
#pragma unroll
    for (int half = 0; half < 2; ++half) {
#pragma unroll
        for (int i = 0; i < 8; ++i) *(f32x4*)(wt + (i * 4 + (lane >> 4)) * 68 + n4) = v[half * 8 + i];
        asm volatile("s_waitcnt lgkmcnt(0)" ::: "memory");
#pragma unroll
        for (int kc = 0; kc < 4; ++kc) { float f[8];
#pragma unroll
            for (int q = 0; q < 8; ++q) f[q] = wt[(kc * 8 + q) * 68 + lane];
            u32x4 w; w.x = f2bf(f[0]) | ((unsigned)f2bf(f[1]) << 16); w.y = f2bf(f[2]) | ((unsigned)f2bf(f[3]) << 16); w.z = f2bf(f[4]) | ((unsigned)f2bf(f[5]) << 16); w.w = f2bf(f[6]) | ((unsigned)f2bf(f[7]) << 16);
            *(u32x4*)(dst + half * 32 + kc * 8) = w; }
        asm volatile("s_waitcnt lgkmcnt(0)" ::: "memory");
    }
}
__device__ __forceinline__ void run_tjob(const TJob& j, float* wt, int& base, int NW, int gw, int lane) {
    const int total = (j.Npad / 64) * (j.K / 64) * j.batch;
    int it = (gw - base % NW + NW) % NW;
    if (it < total) {
        f32x4 cur[16], nxt[16];
        tt_load(j, it, lane, cur);
        for (; it < total; it += NW) {
            const bool more = it + NW < total;
            if (more) tt_load(j, it + NW, lane, nxt);
            tt_store(j, it, lane, cur, wt);
            if (more) {
#pragma unroll
                for (int i = 0; i < 16; ++i) cur[i] = nxt[i]; }
        }
    }
    base += total;
}
__device__ __forceinline__ void bt_load(const float* __restrict__ src, int N, int perm, int it, int ntn, f32x4 (&v)[8]) {
    const int wid = threadIdx.x >> 6, lane = threadIdx.x & 63;
    const int per = 16 * ntn, z = it / per, r = it % per, kt = r / ntn, nt = r % ntn;
    const int np = nt * 256 + lane * 4;
    const int sc = perm ? (nt * 128 + (lane & 31) * 4 + (lane >> 5) * 1024) : np;
    const float* p = src + (size_t)z * 1024 * N + (size_t)(kt * 64 + wid * 8) * N + sc;
#pragma unroll
    for (int i = 0; i < 8; ++i) v[i] = *(const f32x4*)(p + (size_t)i * N);
}
__device__ __forceinline__ void ph_big_transpose(const float* __restrict__ src, int N, int perm, int batch, bf16* __restrict__ dst, float* tile  , int G) {
    const int tid = threadIdx.x, wid = tid >> 6, lane = tid & 63, ntn = N / 256, total = batch * 16 * ntn;
    int it = (int)blockIdx.x;
    if (it >= total) return;
    f32x4 cur[8], nxt[8], nx2[8];
    bt_load(src, N, perm, it, ntn, cur);
    if (it + G < total) bt_load(src, N, perm, it + G, ntn, nxt);
    for (; it < total; it += G) {
        const bool more = it + G < total, more2 = it + 2 * G < total;
        if (more2) bt_load(src, N, perm, it + 2 * G, ntn, nx2);
        __syncthreads();
#pragma unroll
        for (int i = 0; i < 8; ++i) { float* t = tile + (wid * 8 + i) * 257 + lane * 4; t[0] = cur[i][0]; t[1] = cur[i][1]; t[2] = cur[i][2]; t[3] = cur[i][3]; }
        __syncthreads();
        const int per = 16 * ntn, z = it / per, r = it % per, kt = r / ntn, nt = r % ntn;
        bf16* d = dst + (size_t)z * N * 1024 + (((size_t)nt * 16 + kt) << 14);
        const int kc = lane & 7;
#pragma unroll
        for (int pss = 0; pss < 4; ++pss) {
            const int n = wid * 32 + pss * 8 + (lane >> 3); float f[8];
#pragma unroll
            for (int j = 0; j < 8; ++j) f[j] = tile[(kc * 8 + j) * 257 + n];
            u32x4 w; w.x = g8_cvt_pk(f[0], f[1]); w.y = g8_cvt_pk(f[2], f[3]); w.z = g8_cvt_pk(f[4], f[5]); w.w = g8_cvt_pk(f[6], f[7]);
            *(u32x4*)(d + n * 64 + kc * 8) = w;
        }
        if (more) {
#pragma unroll
            for (int i = 0; i < 8; ++i) { cur[i] = nxt[i]; nxt[i] = nx2[i]; } }
    }
    __syncthreads();
}
#ifndef PROBE_SUB
#define PROBE_SUB 0
#define PROBE_SUBDK 0
#endif
#define PSEC(k) do { if (PROBE_SUB == (k)) { const unsigned t_ = (unsigned)__builtin_readcyclecounter(); sacc += t_ - pt0; } if (PROBE_SUB >= 10) pt0 = (unsigned)__builtin_readcyclecounter(); } while (0)
__device__ __forceinline__ void ph_prologue(const Ptrs& P, unsigned char* lds, unsigned& sacc) {
    unsigned char* ws = P.ws; const int G = gridDim.x; int base = 0; unsigned pt0 = 0u; PSEC(-1);
    const int wave = threadIdx.x >> 6, lane = threadIdx.x & 63, NW = G * 8, gw = (int)blockIdx.x + G * wave;
    float* wt = (float*)lds + wave * (32 * 68);
    {
        float* s = (float*)lds + 8 * 32 * 68;
        float* part = s + 5 * 1024;
        for (int it = (int)blockIdx.x; it < 2 * 128; it += G) {
            const int layer = it / 128, cb = (it % 128) * 48;
            __syncthreads();
            for (int i = threadIdx.x; i < 5 * 1024; i += NT) { const int r = i / 1024, k = i % 1024; const float c = r < 4 ? P.in[1][r * 1024 + k] : P.in[3][k]; s[i] = c / (1.f + __expf(-c)); }
            __syncthreads();
            const int kr = lane >> 4, c4 = (lane & 15) < 12 ? (lane & 15) * 4 : 44;
            const float* w = P.in[4] + (size_t)layer * 1024 * 6144 + (size_t)(wave * 128 + kr) * 6144 + cb + c4;
            float a[5][4];
#pragma unroll
            for (int r = 0; r < 5; ++r) { a[r][0] = 0.f; a[r][1] = 0.f; a[r][2] = 0.f; a[r][3] = 0.f; }
#pragma unroll 1
            for (int hh = 0; hh < 2; ++hh) {
                f32x4 wv[16];
#pragma unroll
                for (int i = 0; i < 16; ++i) wv[i] = *(const f32x4*)(w + (size_t)(hh * 64 + i * 4) * 6144);
#pragma unroll
                for (int i = 0; i < 16; ++i) { const int k = wave * 128 + hh * 64 + i * 4 + kr;
#pragma unroll
                    for (int r = 0; r < 5; ++r) { const float sv = s[r * 1024 + k]; a[r][0] += sv * wv[i][0]; a[r][1] += sv * wv[i][1]; a[r][2] += sv * wv[i][2]; a[r][3] += sv * wv[i][3]; } }
            }
#pragma unroll
            for (int r = 0; r < 5; ++r)
#pragma unroll
                for (int e = 0; e < 4; ++e) { float t = a[r][e]; t += __shfl_xor(t, 16); t += __shfl_xor(t, 32); if (lane < 12) part[(wave * 5 + r) * 64 + c4 + e] = t; }
            __syncthreads();
            if (threadIdx.x < 320 && (threadIdx.x & 63) < 48) { const int r = threadIdx.x / 64, c = threadIdx.x % 64; float t = P.in[5][layer * 6144 + cb + c];
#pragma unroll
                for (int wv = 0; wv < 8; ++wv) t += part[(wv * 5 + r) * 64 + c];
                ((float*)(ws + WS_MOD))[(size_t)(layer * 5 + r) * 6144 + cb + c] = t; }
        }
        __syncthreads();
    }
    PSEC(10);
    TJob j;
    ph_big_transpose(P.in[34], 2048, 1, 2 * NE, (bf16*)(ws + WS_WGU), (float*)lds, G);
    PSEC(11);
    ph_big_transpose(P.in[36], 1024, 0, 2 * NE, (bf16*)(ws + WS_WDN), (float*)lds, G);
    PSEC(12);
    j = TJob{P.in[8], (bf16*)(ws + WS_WEVIN), nullptr, 1024, EVEN_IN, EVEN_IN_P, 0, 1, 0, 0, 1024}; run_tjob(j, wt, base, NW, gw, lane);
    j = TJob{P.in[9], (bf16*)(ws + WS_WEVOUT), nullptr, 1024, 1024, 1024, 0, 1, 0, 0, 1024}; run_tjob(j, wt, base, NW, gw, lane);
    j = TJob{P.in[18], (bf16*)(ws + WS_WUQ), P.in[17], 384, 768, 768, 0, 1, 0, 0, 384}; run_tjob(j, wt, base, NW, gw, lane);
    j = TJob{P.in[20], (bf16*)(ws + WS_WUKV), P.in[19], 384, 1024, 1024, 0, 1, 0, 0, 256}; run_tjob(j, wt, base, NW, gw, lane);
    j = TJob{P.in[12], (bf16*)(ws + WS_WLRU), nullptr, 64, 64, 64, 0, 8, 4096, 4096, 64}; run_tjob(j, wt, base, NW, gw, lane);
    j = TJob{P.in[14], (bf16*)(ws + WS_WLRU) + 8 * 4096, nullptr, 64, 64, 64, 0, 8, 4096, 4096, 64}; run_tjob(j, wt, base, NW, gw, lane);
    j = TJob{P.in[12] + 8 * 4096, (bf16*)(ws + WS_WLRU) + 16 * 4096, nullptr, 64, 64, 64, 0, 8, 4096, 4096, 64}; run_tjob(j, wt, base, NW, gw, lane);
    j = TJob{P.in[14] + 8 * 4096, (bf16*)(ws + WS_WLRU) + 24 * 4096, nullptr, 64, 64, 64, 0, 8, 4096, 4096, 64}; run_tjob(j, wt, base, NW, gw, lane);
    j = TJob{P.in[23], (bf16*)(ws + WS_WODIN), nullptr, 1024, ODD_IN, ODD_IN, 0, 1, 0, 0, 1024}; run_tjob(j, wt, base, NW, gw, lane);
    j = TJob{P.in[24], (bf16*)(ws + WS_WODOUT), nullptr, 1024, 1024, 1024, 0, 1, 0, 0, 1024}; run_tjob(j, wt, base, NW, gw, lane);
    __syncthreads();
    PSEC(13);
    {
        float* rc = (float*)(ws + WS_ROPE); float* rs = rc + SEQ * 64;
        for (int i = (int)blockIdx.x * NT + threadIdx.x; i < SEQ * 64; i += G * NT) {
            const int t = i >> 6, e = i & 63, q = e & 15;
            const float f = exp2f(-(float)(2 * q) / 32.f * 13.287712379549449f);
            const float ang = (float)((e >> 5) ? (t % GRID_W) : (t / GRID_W)) * f;
            float sv, cv; sincosf(ang, &sv, &cv); rc[i] = cv; rs[i] = sv;
        }
    }
    if ((int)blockIdx.x == G - 2) { float* c8t = (float*)(ws + WS_SCAL) + 1024; for (int i = threadIdx.x; i < 2 * LRU_W; i += NT) c8t[i] = 8.f * LOG2E * log1pf(__expf(-P.in[16][i])); }
    if ((int)blockIdx.x == G - 1 && threadIdx.x == 0) {
        float* sc = (float*)(ws + WS_SCAL);
        float mq = 0, mk = 0;
        for (int i = 0; i < 192; ++i) { mq = fmaxf(mq, fabsf(P.in[21][i])); mk = fmaxf(mk, fabsf(P.in[22][i])); }
        sc[0] = sqrtf(192.f) * mq * mk * LOG2E;
        mq = 0; mk = 0;
        for (int i = 0; i < 64; ++i) { mq = fmaxf(mq, fabsf(P.in[25][i])); mk = fmaxf(mk, fabsf(P.in[26][i])); }
        sc[1] = 8.f * mq * mk * LOG2E;
        float s1 = 0, s2 = 0;
        for (int i = 0; i < 64; ++i) { s1 += P.in[27][i] * P.in[28][i]; s2 += P.in[29][i] * P.in[30][i]; }
        const float lam_init = 0.8f - 0.6f * expf(-0.3f * 1.f);
        sc[2] = expf(s1) - expf(s2) + lam_init;
        sc[3] = 1.f - lam_init;
    }
}

__device__ __forceinline__ void norm_mod_store(const Ptrs& P, float (&v)[16], int lane, int u, int layer, int which) {
    const float* g = (which == 0 ? P.in[6] : P.in[7]) + layer * D;
    const float* md = mod_row(P, layer, u) + (which == 0 ? 0 : 3 * D);
    f32x4 gv[4], scv[4], shv[4];
#pragma unroll
    for (int j = 0; j < 4; ++j) { const int c = j * 256 + lane * 4; gv[j] = *(const f32x4*)(g + c); scv[j] = *(const f32x4*)(md + D + c); shv[j] = *(const f32x4*)(md + c); }
    float ss = 0.f;
#pragma unroll
    for (int i = 0; i < 16; ++i) ss += v[i] * v[i];
    const float rstd = rsqrtf(wave_sum(ss) * (1.f / D) + EPS);
    bf16* h = (bf16*)(P.ws + WS_H) + (size_t)u * D;
#pragma unroll
    for (int j = 0; j < 4; ++j) {
        const int c = j * 256 + lane * 4;
#pragma unroll
        for (int e = 0; e < 4; ++e) v[4 * j + e] = v[4 * j + e] * rstd * gv[j][e] * (1.f + scv[j][e]) + shv[j][e];
        const unsigned lo = f2bf(v[4 * j]) | ((unsigned)f2bf(v[4 * j + 1]) << 16), hi = f2bf(v[4 * j + 2]) | ((unsigned)f2bf(v[4 * j + 3]) << 16);
        *(uint2*)(h + c) = make_uint2(lo, hi);
    }
}
struct RowIn { f32x4 xf[4]; uint2 xb[4]; uint2 y[4][4]; };
__device__ __forceinline__ RowIn rows_load(const Ptrs& P, int layer, int mode, int u, int lane) {
    RowIn r{};
    if (mode == 0) { const float* x = res_in_row(P, layer, u);
#pragma unroll
        for (int j = 0; j < 4; ++j) r.xf[j] = *(const f32x4*)(x + j * 256 + lane * 4); }
    else { const bf16* x = (const bf16*)(P.ws + WS_XB) + (size_t)u * D; const bf16* y = (const bf16*)(P.ws + WS_Y) + (size_t)u * 4 * 1024;
#pragma unroll
        for (int j = 0; j < 4; ++j) { const int c = j * 256 + lane * 4; r.xb[j] = *(const uint2*)(x + c);
#pragma unroll
            for (int k = 0; k < 4; ++k) r.y[k][j] = *(const uint2*)(y + k * 1024 + c); } }
    return r;
}
__device__ __forceinline__ void ph_rows(const Ptrs& P, int layer, int mode, int latent_only, int next_norm) {
    const int wave = threadIdx.x >> 6, lane = threadIdx.x & 63, G = gridDim.x;
    const int NR = latent_only ? NB * SEQ : R;
#define ROW_U(q) (latent_only ? ((q) / SEQ) * SU + CTX + (q) % SEQ : (q))
    int q = (int)blockIdx.x * 8 + wave;
    if (q >= NR) return;
    RowIn cur = rows_load(P, layer, mode, ROW_U(q), lane);
    for (; q < NR; q += G * 8) {
        const int u = ROW_U(q), qn = q + G * 8;
        RowIn nxt = cur;
        if (qn < NR) nxt = rows_load(P, layer, mode, ROW_U(qn), lane);
        float v[16];
        if (mode == 0) {
#pragma unroll
            for (int j = 0; j < 4; ++j) { v[4 * j] = cur.xf[j][0]; v[4 * j + 1] = cur.xf[j][1]; v[4 * j + 2] = cur.xf[j][2]; v[4 * j + 3] = cur.xf[j][3]; }
            norm_mod_store(P, v, lane, u, layer, 0);
        } else {
            const float* g2 = mod_row(P, layer, u) + 5 * D; float* xo = res_out_row(P, u); bf16* xbo = (bf16*)(P.ws + WS_XB) + (size_t)u * D;
            f32x4 gv[4];
#pragma unroll
            for (int j = 0; j < 4; ++j) gv[j] = *(const f32x4*)(g2 + j * 256 + lane * 4);
#pragma unroll
            for (int j = 0; j < 4; ++j) { const int c = j * 256 + lane * 4; f32x4 o;
                const uint2 t = cur.xb[j];
                v[4 * j] = __uint_as_float(t.x << 16); v[4 * j + 1] = __uint_as_float(t.x & 0xffff0000u); v[4 * j + 2] = __uint_as_float(t.y << 16); v[4 * j + 3] = __uint_as_float(t.y & 0xffff0000u);
                float f[4] = {0.f, 0.f, 0.f, 0.f};
#pragma unroll
                for (int k = 0; k < 4; ++k) { const uint2 w = cur.y[k][j]; f[0] += __uint_as_float(w.x << 16); f[1] += __uint_as_float(w.x & 0xffff0000u); f[2] += __uint_as_float(w.y << 16); f[3] += __uint_as_float(w.y & 0xffff0000u); }
#pragma unroll
                for (int e = 0; e < 4; ++e) { v[4 * j + e] += gv[j][e] * f[e]; o[e] = v[4 * j + e]; }
                if (next_norm) { uint2 w; w.x = g8_cvt_pk(o[0], o[1]); w.y = g8_cvt_pk(o[2], o[3]); *(uint2*)(xbo + c) = w; }
                else *(f32x4*)(xo + c) = o; }
            if (next_norm) norm_mod_store(P, v, lane, u, layer + 1, 0);
        }
        cur = nxt;
    }
#undef ROW_U
}

namespace g8 {
typedef short bf16x8 __attribute__((ext_vector_type(8)));
constexpr int BM = 256, BK = 64, HALF = 128, HTB = HALF * BK * 2, STAGE_BYTES = 8 * HTB, NXCD = 8, WGM = 8;
__host__ __device__ __forceinline__ int lds_byte(int r, int c) { const int st = (r >> 4) * 2 + (c >> 5), rr = r & 15, cc = c & 31, ob = rr * 64 + cc * 2; return st * 1024 + (ob ^ (((ob >> 9) & 1) << 5)); }
__host__ __device__ __forceinline__ void stage_rc(int b, int& R, int& C) { const int st = b / 1024, sb = b % 1024, swz = sb ^ (((sb >> 9) & 1) << 5); R = (st >> 1) * 16 + swz / 64; C = (st & 1) * 32 + (swz % 64) / 2; }
__host__ __device__ __forceinline__ int perm32(int rho) { const int n = rho >> 4, i = rho & 15; return 8 * (i >> 2) + 4 * n + (i & 3); }
struct Unit { const char* a; const char* b; int pm, pn, e, aux, cnt; };
__device__ __forceinline__ unsigned cvt_pk_bf16(float lo, float hi) { unsigned r; asm volatile("v_cvt_pk_bf16_f32 %0, %1, %2" : "=v"(r) : "v"(lo), "v"(hi)); return r; }

template <class Epi, class Sched, bool GATHER, bool ALIGN_EPI, bool PFB = false>
__device__ __forceinline__ void gemm_phase(LAS unsigned char* lds, const int lda, const int K, const Sched& S, const Epi& E) {
    const int tid = threadIdx.x, wid = __builtin_amdgcn_readfirstlane(tid >> 6), lane = tid & 63, wr = wid >> 2, wc = wid & 3, fr = lane & 15, fq = lane >> 4;
    const int nt = K / BK;
    int Rr[2], Cc[2]; unsigned voffB[2];
#pragma unroll
    for (int i = 0; i < 2; ++i) { stage_rc(tid * 16 + i * 8192, Rr[i], Cc[i]); const int Rb = Epi::PERM ? ((Rr[i] & ~31) + perm32(Rr[i] & 31)) : Rr[i]; voffB[i] = (unsigned)(Rb * BK + Cc[i]) * 2u; }
    const size_t kstep = (size_t)(BK * 2), kstepB = (size_t)BM * BK * 2;
    const size_t hstepB = (size_t)HALF * BK * 2;
    const unsigned ldsw = (unsigned)wid * 1024u;
    const int aoff = lds_byte(wr * 64 + fr, fq * 8), boff = lds_byte(wc * 32 + fr, fq * 8);
#define G8_SA(b, h) (((b) * 2 + (h)) * HTB)
#define G8_SB(b, h) ((4 + (b) * 2 + (h)) * HTB)
#define G8_STAGE(bufoff, gbase, v0, v1) do { \
        __builtin_amdgcn_global_load_lds((const unsigned*)((const char*)(gbase) + (v0)), (LAS unsigned*)(lds + (bufoff) + ldsw), 16, 0, 0); \
        __builtin_amdgcn_global_load_lds((const unsigned*)((const char*)(gbase) + (v1)), (LAS unsigned*)(lds + (bufoff) + ldsw + 8192), 16, 0, 0); } while (0)
#define G8_LDA(dst, b, h) do { _Pragma("unroll") for (int m = 0; m < 4; ++m) _Pragma("unroll") for (int k = 0; k < 2; ++k) dst[m][k] = *(const LAS bf16x8*)(lds + G8_SA(b, h) + aoff + m * 2048 + k * 1024); } while (0)
#define G8_LDB(dst, b, h) do { _Pragma("unroll") for (int n = 0; n < 2; ++n) _Pragma("unroll") for (int k = 0; k < 2; ++k) dst[n][k] = *(const LAS bf16x8*)(lds + G8_SB(b, h) + boff + n * 2048 + k * 1024); } while (0)
#define G8_MMA(ai, bj, At, Bt) do { __builtin_amdgcn_s_setprio(1); _Pragma("unroll") for (int m = 0; m < 4; ++m) _Pragma("unroll") for (int n = 0; n < 2; ++n) _Pragma("unroll") for (int k = 0; k < 2; ++k) \
        acc[ai][bj][m][n] = __builtin_amdgcn_mfma_f32_16x16x32_bf16(Bt[n][k], At[m][k], acc[ai][bj][m][n], 0, 0, 0); __builtin_amdgcn_s_setprio(0); } while (0)
#define G8_WAIT_V(n) asm volatile("s_waitcnt vmcnt(" #n ")" ::: "memory")
#define G8_WAIT_L(n) asm volatile("s_waitcnt lgkmcnt(" #n ")" ::: "memory")
#define G8_BAR __builtin_amdgcn_s_barrier()
#define G8_SCHED __builtin_amdgcn_sched_barrier(0)
    Unit cur, nxt; int ui = 0;
    if (!S.next(0, cur)) return;
    unsigned vA0[2], vA1[2], nA0[2], nA1[2];
#pragma unroll
    for (int i = 0; i < 2; ++i) {
        if (GATHER) { vA0[i] = S.arow_off(cur, Rr[i]) + (unsigned)Cc[i] * 2u; vA1[i] = S.arow_off(cur, HALF + Rr[i]) + (unsigned)Cc[i] * 2u; }
        else { vA0[i] = (unsigned)(Rr[i] * lda + Cc[i]) * 2u; vA1[i] = (unsigned)((HALF + Rr[i]) * lda + Cc[i]) * 2u; }
        nA0[i] = vA0[i]; nA1[i] = vA1[i];
    }
    f32x4 acc[2][2][4][2];
#pragma unroll
    for (int a = 0; a < 2; ++a)
#pragma unroll
        for (int b = 0; b < 2; ++b)
#pragma unroll
            for (int m = 0; m < 4; ++m)
#pragma unroll
                for (int n = 0; n < 2; ++n) acc[a][b][m][n] = (f32x4){0.f, 0.f, 0.f, 0.f};
    bf16x8 At[4][2], B0[2][2], B1[2][2];
    const char* cA = cur.a; const char* cB = cur.b;
    G8_STAGE(G8_SB(0, 0), cB, voffB[0], voffB[1]); G8_STAGE(G8_SB(0, 1), cB + hstepB, voffB[0], voffB[1]); G8_STAGE(G8_SA(0, 0), cA, vA0[0], vA0[1]); G8_STAGE(G8_SA(0, 1), cA, vA1[0], vA1[1]);
    if (wr == 1) G8_BAR;
    G8_WAIT_V(2); G8_BAR;
    G8_STAGE(G8_SB(1, 0), cB + kstepB, voffB[0], voffB[1]); G8_STAGE(G8_SA(1, 0), cA + kstep, vA0[0], vA0[1]); G8_STAGE(G8_SB(1, 1), cB + hstepB + kstepB, voffB[0], voffB[1]);
    G8_WAIT_V(6); G8_BAR;
    for (;;) {
        const bool has_next = S.next(ui + 1, nxt);
        const char* nA = has_next ? nxt.a : cA; const char* nB = has_next ? nxt.b : cB;
        unsigned pf_dummy = 0u;
        if (PFB && has_next && nB != cB) {
            const char* pb = nB + (size_t)tid * 128;
#pragma unroll
            for (int i = 0; i < 8; ++i) { if (i * NT * 128 < 256 * K * 2) asm volatile("global_load_dword %0, %1, off" : "+v"(pf_dummy) : "v"(pb + (size_t)i * NT * 128) : "memory"); }
        }
        if (GATHER) {
#pragma unroll
            for (int i = 0; i < 2; ++i) { if (has_next) { nA0[i] = S.arow_off(nxt, Rr[i]) + (unsigned)Cc[i] * 2u; nA1[i] = S.arow_off(nxt, HALF + Rr[i]) + (unsigned)Cc[i] * 2u; } else { nA0[i] = vA0[i]; nA1[i] = vA1[i]; } }
        }
#pragma unroll 1
        for (int t = 0; t < nt; t += 2) {
            const bool last = (t == nt - 2);
            const char* a1 = cA + (size_t)(t + 1) * kstep;
            const char* a2 = last ? nA : cA + (size_t)(t + 2) * kstep; const char* b2 = last ? nB : cB + (size_t)(t + 2) * kstepB;
            const char* a3 = a2 + kstep; const char* b3 = b2 + kstepB;
            unsigned x00 = vA0[0], x01 = vA0[1], x10 = vA1[0], x11 = vA1[1];
            if (GATHER) { x00 = last ? nA0[0] : vA0[0]; x01 = last ? nA0[1] : vA0[1]; x10 = last ? nA1[0] : vA1[0]; x11 = last ? nA1[1] : vA1[1]; }
            G8_LDB(B0, 0, 0); G8_LDB(B1, 0, 1); G8_SCHED; G8_LDA(At, 0, 0); G8_STAGE(G8_SA(1, 1), a1, vA1[0], vA1[1]);
            G8_WAIT_V(8); if (PFB) asm volatile("" : "+v"(pf_dummy)); G8_WAIT_L(0); G8_BAR; G8_MMA(0, 0, At, B0); G8_MMA(0, 1, At, B1); G8_BAR; G8_SCHED;
            G8_LDA(At, 0, 1); G8_STAGE(G8_SB(0, 0), b2, voffB[0], voffB[1]); G8_STAGE(G8_SB(0, 1), b2 + hstepB, voffB[0], voffB[1]); G8_STAGE(G8_SA(0, 0), a2, x00, x01);
            G8_WAIT_V(8); G8_WAIT_L(0); G8_BAR; G8_MMA(1, 0, At, B0); G8_MMA(1, 1, At, B1); G8_BAR; G8_SCHED;
            G8_LDB(B0, 1, 0); G8_LDB(B1, 1, 1); G8_SCHED; G8_LDA(At, 1, 0); G8_STAGE(G8_SA(0, 1), a2, x10, x11);
            G8_WAIT_V(8); G8_WAIT_L(0); G8_BAR; G8_MMA(0, 0, At, B0); G8_MMA(0, 1, At, B1); G8_BAR; G8_SCHED;
            G8_LDA(At, 1, 1); G8_STAGE(G8_SB(1, 0), b3, voffB[0], voffB[1]); G8_STAGE(G8_SB(1, 1), b3 + hstepB, voffB[0], voffB[1]); G8_STAGE(G8_SA(1, 0), a3, x00, x01);
            G8_WAIT_V(8); G8_WAIT_L(0); G8_BAR; G8_MMA(1, 0, At, B0); G8_MMA(1, 1, At, B1); G8_BAR; G8_SCHED;
        }
        if constexpr (ALIGN_EPI) { if (wr == 0) G8_BAR; }
        E(acc, cur, wr, wc, fr, fq);
        if (!has_next) break;
#pragma unroll
        for (int a = 0; a < 2; ++a)
#pragma unroll
            for (int b = 0; b < 2; ++b)
#pragma unroll
                for (int m = 0; m < 4; ++m)
#pragma unroll
                    for (int n = 0; n < 2; ++n) acc[a][b][m][n] = (f32x4){0.f, 0.f, 0.f, 0.f};
        cur = nxt; cA = nA; cB = nB; ++ui;
        if (GATHER) {
#pragma unroll
            for (int i = 0; i < 2; ++i) { vA0[i] = nA0[i]; vA1[i] = nA1[i]; }
        }
        if constexpr (ALIGN_EPI) { if (wr == 1) G8_BAR; }
    }
    G8_WAIT_V(0);
    if constexpr (!ALIGN_EPI) { if (wr == 0) G8_BAR; }
    G8_BAR;
#undef G8_SA
#undef G8_SB
#undef G8_STAGE
#undef G8_LDA
#undef G8_LDB
#undef G8_MMA
#undef G8_WAIT_V
#undef G8_WAIT_L
#undef G8_BAR
#undef G8_SCHED
}

struct DenseOrder {
    const char* A; const char* Bt; int lda, K, nM, nN, nwg, G, c, skip_ctx;
    __device__ __forceinline__ void init(const bf16* A_, int lda_, const bf16* Bt_, int K_, int M, int N, int G_, int c_, int skip_ctx_) {
        A = (const char*)A_; Bt = (const char*)Bt_; lda = lda_; K = K_; skip_ctx = skip_ctx_; nM = M / BM; if (skip_ctx) nM = nM / 17 * 16; nN = N / BM; nwg = nM * nN; G = G_; c = c_; }
    __device__ __forceinline__ bool next(int i, Unit& u) const {
        const long L = (long)i * G + c; if (L >= nwg) return false;
        int wgid = (int)L; { const int q = nwg / NXCD, r = nwg % NXCD, xcd = wgid % NXCD, off = wgid / NXCD; wgid = (xcd < r ? xcd * (q + 1) : r * (q + 1) + (xcd - r) * q) + off; }
        const int nig = WGM * nN, gid = wgid / nig, fm = gid * WGM, gsz = (nM - fm) < WGM ? (nM - fm) : WGM;
        int pm = fm + ((wgid % nig) % gsz); const int pn = (wgid % nig) / gsz;
        if (skip_ctx) pm = (pm / 16) * 17 + 1 + (pm % 16);
        u.pm = pm; u.pn = pn; u.e = 0; u.aux = 0; u.cnt = 0;
        u.a = A + (size_t)pm * BM * lda * 2; u.b = Bt + (size_t)pn * BM * K * 2; return true;
    }
    __device__ __forceinline__ unsigned arow_off(const Unit&, int) const { return 0u; }
};
}
namespace g8 {
struct MoeOrder {
    const char* Abase; const char* Bbase; const int* rowtab; size_t bstride; int nN, K, G, vcu, gather;
    LAS int* tab;
    __device__ __forceinline__ void init(const unsigned* cnt, LAS int* tab_) {
        tab = tab_;
        __syncthreads();
        if (threadIdx.x < 64) {
            const int lane = threadIdx.x, me = lane & 31;
            const int c = (int)cnt[me];
            int run = 0, ab = 0, ms = 0, mab = 0;
            for (int e = 0; e < NE; ++e) { const int ce = __builtin_amdgcn_readlane(c, e), mt = (ce + 255) >> 8; if (me == e) { ms = run; mab = ab; } run += mt * nN; ab += mt << 8; }
            if (lane < 32) { tab[lane] = ms; tab[32 + lane] = c; tab[64 + lane] = mab; }
            if (lane == 0) tab[96] = run;
        }
        __syncthreads();
    }
    __device__ __forceinline__ bool next(int i, Unit& u) const {
        const int L = i * G + vcu;
        if (L >= tab[96]) return false;
        const int me = threadIdx.x & 31;
        const int st_l = tab[me], c_l = tab[32 + me];
        const unsigned long long m = __ballot(L >= st_l && L < st_l + ((c_l + 255) >> 8) * nN);
        const int e = __builtin_amdgcn_readfirstlane(__builtin_ctzll(m) & 31);
        const int st = tab[e], c = tab[32 + e], ab = tab[64 + e];
        const int l = L - st;
        const int sh = nN == 8 ? 3 : 2;
        u.e = e; u.pm = l >> sh; u.pn = l & (nN - 1); u.aux = ab; u.cnt = c;
        u.a = gather ? Abase : Abase + (size_t)(ab + u.pm * 256) * 1024 * 2; u.b = Bbase + (size_t)e * bstride + (size_t)u.pn * 256 * K * 2; return true;
    }
    __device__ __forceinline__ unsigned arow_off(const Unit& u, int r) const { int rr = u.pm * 256 + r; rr = rr < u.cnt ? rr : u.cnt - 1; return (unsigned)rowtab[(size_t)u.e * R + rr] * (unsigned)(D * 2); }
};
struct UpOrder {
    const char* Z; const char* Wq; const char* Wkv; int G, c;
    __device__ __forceinline__ bool next(int i, Unit& u) const {
        const int L = i * G + c; if (L >= 476) return false;
        const int kv = L >= 204, l = kv ? L - 204 : L, pn = l / 68, pm = l % 68;
        u.pm = pm; u.pn = kv ? 3 + pn : pn; u.e = 0; u.aux = kv; u.cnt = 0;
        u.a = Z + ((size_t)pm * BM * EVEN_IN_P + 1024 + kv * 384) * 2; u.b = Wq + (size_t)u.pn * BM * 384 * 2; return true;
    }
    __device__ __forceinline__ unsigned arow_off(const Unit&, int) const { return 0u; }
};
struct EpiStoreBf16 {
    static constexpr bool PERM = true; bf16* C; int ldc;
    __device__ __forceinline__ void operator()(const f32x4 (&acc)[2][2][4][2], const Unit& u, int wr, int wc, int fr, int fq) const {
        const int row0 = u.pm * BM + wr * 64 + fr, col0 = u.pn * BM + wc * 32 + 8 * fq;
#pragma unroll
        for (int ai = 0; ai < 2; ++ai)
#pragma unroll
            for (int m = 0; m < 4; ++m) { bf16* rowp = C + (size_t)(row0 + ai * HALF + m * 16) * ldc + col0;
#pragma unroll
                for (int bj = 0; bj < 2; ++bj) { const f32x4 v0 = acc[ai][bj][m][0], v1 = acc[ai][bj][m][1];
                    u32x4 w; w.x = cvt_pk_bf16(v0[0], v0[1]); w.y = cvt_pk_bf16(v0[2], v0[3]); w.z = cvt_pk_bf16(v1[0], v1[1]); w.w = cvt_pk_bf16(v1[2], v1[3]);
                    *(u32x4*)(rowp + bj * HALF) = w; } }
    }
};
struct EpiDiffIn {
    static constexpr bool PERM = true; bf16* C; const float* qn; const float* kn; const float* rc; const float* rs; LAS float* xch  ;
    __device__ __forceinline__ void operator()(const f32x4 (&acc)[2][2][4][2], const Unit& u, int wr, int wc, int fr, int fq) const {
        const int row0 = u.pm * BM + wr * 64 + fr, col0 = u.pn * BM + wc * 32 + 8 * fq, wid = wr * 4 + wc;
        const bool isv = u.pn >= 8;
        float rstd[2][4][2];
#pragma unroll
        for (int ai = 0; ai < 2; ++ai)
#pragma unroll
            for (int m = 0; m < 4; ++m)
#pragma unroll
                for (int bj = 0; bj < 2; ++bj) { const f32x4 v0 = acc[ai][bj][m][0], v1 = acc[ai][bj][m][1];
                    float ss = v0[0] * v0[0] + v0[1] * v0[1] + v0[2] * v0[2] + v0[3] * v0[3] + v1[0] * v1[0] + v1[1] * v1[1] + v1[2] * v1[2] + v1[3] * v1[3];
                    ss += __shfl_xor(ss, 16); ss += __shfl_xor(ss, 32);
                    rstd[ai][m][bj] = ss;
                    if (fq == 0) xch[wid * 256 + ((ai * 4 + m) * 2 + bj) * 16 + fr] = ss; }
        asm volatile("s_waitcnt lgkmcnt(0)" ::: "memory"); __builtin_amdgcn_s_barrier(); asm volatile("" ::: "memory");
#pragma unroll
        for (int ai = 0; ai < 2; ++ai)
#pragma unroll
            for (int m = 0; m < 4; ++m)
#pragma unroll
                for (int bj = 0; bj < 2; ++bj) rstd[ai][m][bj] = rsqrtf((rstd[ai][m][bj] + xch[(wid ^ 1) * 256 + ((ai * 4 + m) * 2 + bj) * 16 + fr]) * (1.f / 64.f) + EPS);
        const int e0 = (wc & 1) * 32 + 8 * fq;
        const float* gn = u.pn < 4 ? qn : kn; const float qs = u.pn < 4 ? 0.125f * LOG2E : 1.f;
        f32x4 g0 = *(const f32x4*)(gn + e0), g1 = *(const f32x4*)(gn + e0 + 4);
        g0 = g0 * qs; g1 = g1 * qs;
        const float sgn = (fq & 2) ? 1.f : -1.f;
        const int jt = u.pm % 17; const bool latent = jt != 0;
#pragma unroll
        for (int ai = 0; ai < 2; ++ai)
#pragma unroll
            for (int m = 0; m < 4; ++m) { const int r = row0 + ai * HALF + m * 16; bf16* rowp = C + (size_t)r * ODD_IN + col0;
                f32x4 c0 = {1.f, 1.f, 1.f, 1.f}, c1 = c0, s0 = {0.f, 0.f, 0.f, 0.f}, s1 = s0;
                if (!isv && latent) { const int t = (jt - 1) * 256 + ai * HALF + wr * 64 + m * 16 + fr;
                    c0 = *(const f32x4*)(rc + t * 64 + e0); c1 = *(const f32x4*)(rc + t * 64 + e0 + 4); s0 = *(const f32x4*)(rs + t * 64 + e0); s1 = *(const f32x4*)(rs + t * 64 + e0 + 4); }
#pragma unroll
                for (int bj = 0; bj < 2; ++bj) { f32x4 v0 = acc[ai][bj][m][0], v1 = acc[ai][bj][m][1];
                    if (!isv) { const float rr = rstd[ai][m][bj]; v0 = v0 * rr * g0; v1 = v1 * rr * g1;
                        f32x4 o0, o1;
#pragma unroll
                        for (int j = 0; j < 4; ++j) { o0[j] = __shfl_xor(v0[j], 32); o1[j] = __shfl_xor(v1[j], 32); }
                        v0 = v0 * c0 + o0 * s0 * sgn; v1 = v1 * c1 + o1 * s1 * sgn; }
                    u32x4 w; w.x = cvt_pk_bf16(v0[0], v0[1]); w.y = cvt_pk_bf16(v0[2], v0[3]); w.z = cvt_pk_bf16(v1[0], v1[1]); w.w = cvt_pk_bf16(v1[2], v1[3]);
                    *(u32x4*)(rowp + bj * HALF) = w; } }
        asm volatile("s_waitcnt lgkmcnt(0)" ::: "memory"); __builtin_amdgcn_s_barrier(); asm volatile("" ::: "memory");
    }
};
struct EpiOut {
    static constexpr bool PERM = true; Ptrs P; int layer;
    __device__ __forceinline__ void operator()(const f32x4 (&acc)[2][2][4][2], const Unit& u, int wr, int wc, int fr, int fq) const {
        const int b = u.pm / 17, jt = u.pm % 17;
        const float* g1 = (const float*)(P.ws + WS_MOD) + (size_t)(layer * 5 + (jt == 0 ? 4 : b)) * 6144 + 2 * D;
        const float* in0 = jt == 0 ? P.in[2] + (size_t)(b * CTX) * D : P.in[0] + (size_t)(b * SEQ + (jt - 1) * 256) * D;
        bf16* xb0 = (bf16*)(P.ws + WS_XB) + (size_t)u.pm * BM * D;
        const int col0 = u.pn * BM + wc * 32 + 8 * fq;
        f32x4 gv[2][2];
#pragma unroll
        for (int bj = 0; bj < 2; ++bj)
#pragma unroll
            for (int n = 0; n < 2; ++n) gv[bj][n] = *(const f32x4*)(g1 + col0 + bj * HALF + 4 * n);
#pragma unroll
        for (int ai = 0; ai < 2; ++ai)
#pragma unroll
            for (int m = 0; m < 4; ++m) { const size_t off = (size_t)(ai * HALF + wr * 64 + m * 16 + fr) * D + col0;
#pragma unroll
                for (int bj = 0; bj < 2; ++bj) {
                    f32x4 x0, x1;
                    if (layer == 0) { x0 = *(const f32x4*)(in0 + off + bj * HALF); x1 = *(const f32x4*)(in0 + off + bj * HALF + 4); }
                    else { const u32x4 r = *(const u32x4*)(xb0 + off + bj * HALF);
                        x0 = (f32x4){__uint_as_float(r.x << 16), __uint_as_float(r.x & 0xffff0000u), __uint_as_float(r.y << 16), __uint_as_float(r.y & 0xffff0000u)};
                        x1 = (f32x4){__uint_as_float(r.z << 16), __uint_as_float(r.z & 0xffff0000u), __uint_as_float(r.w << 16), __uint_as_float(r.w & 0xffff0000u)}; }
                    const f32x4 v0 = x0 + gv[bj][0] * acc[ai][bj][m][0], v1 = x1 + gv[bj][1] * acc[ai][bj][m][1];
                    u32x4 w; w.x = cvt_pk_bf16(v0[0], v0[1]); w.y = cvt_pk_bf16(v0[2], v0[3]); w.z = cvt_pk_bf16(v1[0], v1[1]); w.w = cvt_pk_bf16(v1[2], v1[3]);
                    *(u32x4*)(xb0 + off + bj * HALF) = w; } }
    }
};
struct EpiMoe1 {
    static constexpr bool PERM = true; Ptrs P; int layer;
    __device__ __forceinline__ void operator()(const f32x4 (&acc)[2][2][4][2], const Unit& u, int wr, int wc, int fr, int fq) const {
        const float* bgu = P.in[35] + (size_t)(layer * NE + u.e) * 2048;
        const int cl = u.pn * 128 + wc * 32 + 8 * fq;
        f32x4 bg[2], bu[2];
#pragma unroll
        for (int n = 0; n < 2; ++n) { bg[n] = *(const f32x4*)(bgu + cl + 4 * n); bu[n] = *(const f32x4*)(bgu + 1024 + cl + 4 * n); }
        bf16* act = (bf16*)(P.ws + WS_ACT) + (size_t)(u.aux + u.pm * 256 + wr * 64 + fr) * 1024 + cl;
#pragma unroll
        for (int ai = 0; ai < 2; ++ai)
#pragma unroll
            for (int m = 0; m < 4; ++m) { float o[8];
#pragma unroll
                for (int n = 0; n < 2; ++n)
#pragma unroll
                    for (int j = 0; j < 4; ++j) { float g = acc[ai][0][m][n][j] + bg[n][j], uu = acc[ai][1][m][n][j] + bu[n][j];
                        g = fminf(g, 7.f); uu = fminf(fmaxf(uu, -7.f), 7.f);
                        const float sg = __builtin_amdgcn_rcpf(1.f + __expf(-1.702f * g)); o[n * 4 + j] = (uu + 1.f) * g * sg; }
                u32x4 w; w.x = cvt_pk_bf16(o[0], o[1]); w.y = cvt_pk_bf16(o[2], o[3]); w.z = cvt_pk_bf16(o[4], o[5]); w.w = cvt_pk_bf16(o[6], o[7]);
                *(u32x4*)(act + (size_t)(ai * HALF + m * 16) * 1024) = w; }
    }
};
struct EpiMoe2 {
    static constexpr bool PERM = true; Ptrs P; int layer;
    __device__ __forceinline__ void operator()(const f32x4 (&acc)[2][2][4][2], const Unit& u, int wr, int wc, int fr, int fq) const {
        const float* bd = P.in[37] + (size_t)(layer * NE + u.e) * 1024;
        const int col0 = u.pn * BM + wc * 32 + 8 * fq;
        f32x4 bv[2][2];
#pragma unroll
        for (int bj = 0; bj < 2; ++bj)
#pragma unroll
            for (int n = 0; n < 2; ++n) bv[bj][n] = *(const f32x4*)(bd + col0 + bj * HALF + 4 * n);
        const int* pair_of = (const int*)(P.ws + WS_PAIROF) + (size_t)u.e * R; const float* gate_of = (const float*)(P.ws + WS_GATEOF) + (size_t)u.e * R;
        bf16* Y = (bf16*)(P.ws + WS_Y);
#pragma unroll
        for (int ai = 0; ai < 2; ++ai)
#pragma unroll
            for (int m = 0; m < 4; ++m) { const int r = u.pm * 256 + ai * HALF + wr * 64 + m * 16 + fr;
                if (r < u.cnt) { const int pair = pair_of[r]; const float gw = gate_of[r]; bf16* rowp = Y + (size_t)pair * 1024 + col0;
#pragma unroll
                    for (int bj = 0; bj < 2; ++bj) { const f32x4 v0 = (acc[ai][bj][m][0] + bv[bj][0]) * gw, v1 = (acc[ai][bj][m][1] + bv[bj][1]) * gw;
                        u32x4 w; w.x = cvt_pk_bf16(v0[0], v0[1]); w.y = cvt_pk_bf16(v0[2], v0[3]); w.z = cvt_pk_bf16(v1[0], v1[1]); w.w = cvt_pk_bf16(v1[2], v1[3]);
                        *(u32x4*)(rowp + bj * HALF) = w; } } }
    }
};
}

__device__ __forceinline__ int bwd_pos(int c) { return c < 2 ? 1 - c : 2 + (NCH - 1 - c); }
__device__ __forceinline__ int bwd_chunk_at(int p) { return p < 2 ? 1 - p : NCH - 1 - (p - 2); }
__device__ __forceinline__ float fsigmoid(float x) { return __builtin_amdgcn_rcpf(1.f + __builtin_amdgcn_exp2f(-LOG2E * x)); }
__device__ __forceinline__ void ph_lru(const Ptrs& P, unsigned char* lds, int mode, int item0) {
    typedef short bf16x8 __attribute__((ext_vector_type(8)));
    float* X = (float*)lds;
    unsigned char* XB = lds + 128 * 68 * 4;
    float* SEG = (float*)(lds + 128 * 68 * 4 + 16384);
    float* CAR = SEG + 2 * 8 * 64 * 2;
    unsigned char* WL = (unsigned char*)(CAR + 128);
    float* CWL = (float*)(WL + 32768);
    float* GBL = CWL + 320;
    const int tid = threadIdx.x, wid = tid >> 6, lane = tid & 63, fr = lane & 15, fq = lane >> 4;
    const int G = gridDim.x, total = 8 * NCH * NB;
    const bf16* Z = (const bf16*)(P.ws + WS_Z);
    float* agg = (float*)(P.ws + WS_AGG);
    const int first = ((int)blockIdx.x - item0 % G + G) % G;
    int n_cur = -1;
    u32x4 raw[2][4], gz[2];
#define LRU_LOADS(it_) do { const int n_ = (it_) % 8, c_ = ((it_) / 8) % NCH, b_ = (it_) / (8 * NCH); const int j0_ = c_ * CHUNK, lo_ = (c_ < 2) ? 0 : CTX, hi_ = (c_ < 2) ? CTX : SU; \
        _Pragma("unroll") for (int q = 0; q < 2; ++q) { const int p = tid + q * NT, t = p >> 3, cg = n_ * 64 + (p & 7) * 8; \
            _Pragma("unroll") for (int k = 0; k < 4; ++k) { const int j = j0_ + t - 2 + k; const int jj = (j >= lo_ && j < hi_) ? j : j0_ + t; raw[q][k] = *(const u32x4*)(Z + (size_t)(b_ * SU + jj) * EVEN_IN_P + 512 + cg); } \
            if (mode == 1) gz[q] = *(const u32x4*)(Z + (size_t)(b_ * SU + j0_ + t) * EVEN_IN_P + cg); } } while (0)
    if (first < total) LRU_LOADS(first);
    for (int it = first; it < total; it += G) {
        const int n = it % 8, c = (it / 8) % NCH, b = it / (8 * NCH);
        const int j0 = c * CHUNK, seg_lo = (c < 2) ? 0 : CTX, seg_hi = (c < 2) ? CTX : SU;
        __syncthreads();
        if (n != n_cur) {
            n_cur = n;
#pragma unroll
            for (int i = 0; i < 4; ++i) { const int idx = tid + i * NT, mm = idx >> 9, r = (idx & 511) >> 3, ch = idx & 7;
                *(u32x4*)(WL + mm * 8192 + r * 128 + ((ch ^ ((r >> 1) & 7)) << 4)) = *(const u32x4*)((const bf16*)(P.ws + WS_WLRU) + ((size_t)mm * 8 + n) * 4096 + r * 64 + ch * 8); }
            if (tid < 256) CWL[tid] = P.in[10][(tid >> 6) * LRU_W + n * 64 + (tid & 63)]; else if (tid < 320) CWL[tid] = P.in[11][n * 64 + (tid - 256)];
            if (tid < 384) { const int a = tid >> 7, dl = tid & 127, cgl = (dl >> 6) * LRU_W + n * 64 + (dl & 63);
                GBL[tid] = a == 0 ? P.in[13][cgl] : a == 1 ? P.in[15][cgl] : ((const float*)(P.ws + WS_SCAL))[1024 + cgl]; }
            __syncthreads();
        }
        u32x4 gzc[2];
#pragma unroll
        for (int q = 0; q < 2; ++q) {
            const int p = tid + q * NT, t = p >> 3, c8 = (p & 7) * 8;
            float acc[8];
            { const f32x4 b0 = *(const f32x4*)(CWL + 256 + c8), b1 = *(const f32x4*)(CWL + 256 + c8 + 4);
#pragma unroll
              for (int e = 0; e < 4; ++e) { acc[e] = b0[e]; acc[4 + e] = b1[e]; } }
#pragma unroll
            for (int k = 0; k < 4; ++k) {
                const int j = j0 + t - 2 + k; const bool ok = j >= seg_lo && j < seg_hi;
                const u32x4 rw = raw[q][k];
                const f32x4 w0 = *(const f32x4*)(CWL + k * 64 + c8), w1 = *(const f32x4*)(CWL + k * 64 + c8 + 4);
                const float m = ok ? 1.f : 0.f;
#pragma unroll
                for (int e = 0; e < 4; ++e) { const float lo = __uint_as_float(rw[e] << 16), hi = __uint_as_float(rw[e] & 0xffff0000u);
                    const float wl = (e < 2 ? w0[2 * e] : w1[2 * e - 4]) * m, wh = (e < 2 ? w0[2 * e + 1] : w1[2 * e - 3]) * m;
                    acc[2 * e] += wl * lo; acc[2 * e + 1] += wh * hi; }
            }
            *(f32x4*)(X + t * 68 + c8) = (f32x4){acc[0], acc[1], acc[2], acc[3]}; *(f32x4*)(X + t * 68 + c8 + 4) = (f32x4){acc[4], acc[5], acc[6], acc[7]};
            u32x4 w; w.x = g8::cvt_pk_bf16(acc[0], acc[1]); w.y = g8::cvt_pk_bf16(acc[2], acc[3]); w.z = g8::cvt_pk_bf16(acc[4], acc[5]); w.w = g8::cvt_pk_bf16(acc[6], acc[7]);
            *(u32x4*)(XB + t * 128 + (((c8 >> 3) ^ ((t >> 1) & 7)) << 4)) = w;
            gzc[q] = gz[q];
        }
        if (it + G < total) LRU_LOADS(it + G);
        if (mode == 1 && wid < 2) {
            const int dir = wid, pos = dir == 0 ? c : bwd_pos(c); float h = 0.f;
            for (int p0 = 0; p0 < pos; p0 += 8) {
                float2 ag[8];
#pragma unroll
                for (int i = 0; i < 8; ++i) { const int p = p0 + i, pc = p < pos ? p : p0, cc = dir == 0 ? pc : bwd_chunk_at(pc);
                    ag[i] = *(const float2*)(agg + ((((size_t)b * NCH + cc) * 2 + dir) * 512 + n * 64 + lane) * 2); if (p >= pos) { ag[i].x = 1.f; ag[i].y = 0.f; } }
#pragma unroll
                for (int i = 0; i < 8; ++i) h = ag[i].x * h + ag[i].y;
            }
            CAR[dir * 64 + lane] = h;
        }
        __syncthreads();
        const int trow = 16 * wid + fr;
        const bf16x8 af0 = *(const bf16x8*)(XB + trow * 128 + ((fq ^ ((trow >> 1) & 7)) << 4));
        const bf16x8 af1 = *(const bf16x8*)(XB + trow * 128 + (((4 + fq) ^ ((trow >> 1) & 7)) << 4));
        float av[2][4][4], uv[2][4][4], Ae[2][4], He[2][4];
#pragma unroll
        for (int dir = 0; dir < 2; ++dir) {
            const unsigned char* wa = WL + (dir * 2 + 0) * 8192; const unsigned char* wx = WL + (dir * 2 + 1) * 8192;
#pragma unroll
            for (int ct = 0; ct < 4; ++ct) {
                const int e = 16 * ct + fr, ky = (e >> 1) & 7;
                const bf16x8 wa0 = *(const bf16x8*)(wa + e * 128 + ((fq ^ ky) << 4)), wa1 = *(const bf16x8*)(wa + e * 128 + (((4 + fq) ^ ky) << 4));
                const bf16x8 wx0 = *(const bf16x8*)(wx + e * 128 + ((fq ^ ky) << 4)), wx1 = *(const bf16x8*)(wx + e * 128 + (((4 + fq) ^ ky) << 4));
                f32x4 ga = {0.f, 0.f, 0.f, 0.f}, gx = {0.f, 0.f, 0.f, 0.f};
                ga = __builtin_amdgcn_mfma_f32_16x16x32_bf16(af0, wa0, ga, 0, 0, 0); ga = __builtin_amdgcn_mfma_f32_16x16x32_bf16(af1, wa1, ga, 0, 0, 0);
                gx = __builtin_amdgcn_mfma_f32_16x16x32_bf16(af0, wx0, gx, 0, 0, 0); gx = __builtin_amdgcn_mfma_f32_16x16x32_bf16(af1, wx1, gx, 0, 0, 0);
                const float bav = GBL[dir * 64 + e], bxv = GBL[128 + dir * 64 + e], c8 = GBL[256 + dir * 64 + e];
#pragma unroll
                for (int j = 0; j < 4; ++j) {
                    const float r = fsigmoid(ga[j] + bav), ig = fsigmoid(gx[j] + bxv);
                    const float a = __builtin_amdgcn_exp2f(-c8 * r);
                    av[dir][ct][j] = a; uv[dir][ct][j] = sqrtf(fmaxf(1.f - a * a, 0.f)) * ig * X[(16 * wid + 4 * fq + j) * 68 + e];
                }
                float Al = av[dir][ct][0] * av[dir][ct][1] * av[dir][ct][2] * av[dir][ct][3], Hl;
                if (dir == 0) Hl = ((uv[dir][ct][0] * av[dir][ct][1] + uv[dir][ct][1]) * av[dir][ct][2] + uv[dir][ct][2]) * av[dir][ct][3] + uv[dir][ct][3];
                else Hl = ((uv[dir][ct][3] * av[dir][ct][2] + uv[dir][ct][2]) * av[dir][ct][1] + uv[dir][ct][1]) * av[dir][ct][0] + uv[dir][ct][0];
                const int pq = dir == 0 ? fq : 3 - fq;
                {
                    const int src = dir == 0 ? lane - 16 : lane + 16; const float Ap = __shfl(Al, src & 63), Hp = __shfl(Hl, src & 63);
                    if (pq >= 1) { Hl = Al * Hp + Hl; Al = Al * Ap; }
                }
                {
                    const int src = dir == 0 ? lane - 32 : lane + 32; const float Ap = __shfl(Al, src & 63), Hp = __shfl(Hl, src & 63);
                    if (pq >= 2) { Hl = Al * Hp + Hl; Al = Al * Ap; }
                }
                {
                    const int src = dir == 0 ? lane - 16 : lane + 16; const float Ap = __shfl(Al, src & 63), Hp = __shfl(Hl, src & 63);
                    Ae[dir][ct] = pq >= 1 ? Ap : 1.f; He[dir][ct] = pq >= 1 ? Hp : 0.f;
                }
                if (pq == 3) { float2 sv; sv.x = Al; sv.y = Hl; *(float2*)(SEG + ((dir * 8 + wid) * 64 + e) * 2) = sv; }
            }
        }
        __syncthreads();
        float hs[4][4];
#pragma unroll
        for (int ct = 0; ct < 4; ++ct)
#pragma unroll
            for (int j = 0; j < 4; ++j) hs[ct][j] = 0.f;
#pragma unroll
        for (int dir = 0; dir < 2; ++dir) {
#pragma unroll
            for (int ct = 0; ct < 4; ++ct) {
                const int e = 16 * ct + fr;
                if (mode == 0) {
                    if (wid == 0 && fq == 0) {
                        float Ac = 1.f, Hc = 0.f;
                        for (int sI = 0; sI < 8; ++sI) { const int sg = dir == 0 ? sI : 7 - sI; const float2 sv = *(const float2*)(SEG + ((dir * 8 + sg) * 64 + e) * 2); Hc = sv.x * Hc + sv.y; Ac *= sv.x; }
                        float2 o; o.x = Ac; o.y = Hc; *(float2*)(agg + ((((size_t)b * NCH + c) * 2 + dir) * 512 + n * 64 + e) * 2) = o;
                    }
                } else {
                    float h = CAR[dir * 64 + e];
                    const int nprev = dir == 0 ? wid : 7 - wid;
                    for (int sI = 0; sI < nprev; ++sI) { const int sg = dir == 0 ? sI : 7 - sI; const float2 sv = *(const float2*)(SEG + ((dir * 8 + sg) * 64 + e) * 2); h = sv.x * h + sv.y; }
                    h = Ae[dir][ct] * h + He[dir][ct];
                    if (dir == 0) {
#pragma unroll
                        for (int j = 0; j < 4; ++j) { h = av[dir][ct][j] * h + uv[dir][ct][j]; hs[ct][j] += h; }
                    } else {
#pragma unroll
                        for (int j = 3; j >= 0; --j) { h = av[dir][ct][j] * h + uv[dir][ct][j]; hs[ct][j] += h; }
                    }
                }
            }
        }
        if (mode == 1) {
#pragma unroll
            for (int ct = 0; ct < 4; ++ct)
#pragma unroll
                for (int j = 0; j < 4; ++j) X[(16 * wid + 4 * fq + j) * 68 + 16 * ct + fr] = hs[ct][j];
            __syncthreads();
            bf16* mix = (bf16*)(P.ws + WS_MIX);
#pragma unroll
            for (int q = 0; q < 2; ++q) {
                const int p = tid + q * NT, t = p >> 3, c8 = (p & 7) * 8; const size_t u = (size_t)b * SU + j0 + t;
                const u32x4 gzv = gzc[q];
                const f32x4 r0 = *(const f32x4*)(X + t * 68 + c8), r1 = *(const f32x4*)(X + t * 68 + c8 + 4);
                float o[8];
#pragma unroll
                for (int k = 0; k < 4; ++k) { const float g0 = __uint_as_float(gzv[k] << 16), g1 = __uint_as_float(gzv[k] & 0xffff0000u);
                    const float s0 = fsigmoid(1.5957691216057308f * (g0 + 0.044715f * g0 * g0 * g0)), s1 = fsigmoid(1.5957691216057308f * (g1 + 0.044715f * g1 * g1 * g1));
                    o[2 * k] = g0 * s0 * (k < 2 ? r0[2 * k] : r1[2 * k - 4]); o[2 * k + 1] = g1 * s1 * (k < 2 ? r0[2 * k + 1] : r1[2 * k - 3]); }
                u32x4 w; w.x = g8::cvt_pk_bf16(o[0], o[1]); w.y = g8::cvt_pk_bf16(o[2], o[3]); w.z = g8::cvt_pk_bf16(o[4], o[5]); w.w = g8::cvt_pk_bf16(o[6], o[7]);
                *(u32x4*)(mix + u * D + n * 64 + c8) = w;
            }
        }
    }
#undef LRU_LOADS
    __syncthreads();
}

__device__ __forceinline__ void unpack8(const u32x4 v, float (&f)[8]) {
#pragma unroll
    for (int i = 0; i < 4; ++i) { f[2 * i] = __uint_as_float(v[i] << 16); f[2 * i + 1] = __uint_as_float(v[i] & 0xffff0000u); }
}
__device__ __forceinline__ u32x4 pack8(const float (&f)[8]) {
    u32x4 w; w.x = g8::cvt_pk_bf16(f[0], f[1]); w.y = g8::cvt_pk_bf16(f[2], f[3]); w.z = g8::cvt_pk_bf16(f[4], f[5]); w.w = g8::cvt_pk_bf16(f[6], f[7]); return w;
}
struct MlaRow { u32x4 zq, zk, zr, q0, q1, kv0, kw0, kv1, kw1; f32x4 c0, c1, s0, s1; };
__device__ __forceinline__ MlaRow mla_row_load(const Ptrs& P, int u, int lane) {
    const int hl = lane & 31, hh = lane >> 5; const bool act = hl < 24, tail = hl >= 16 && hl < 24;
    const int j = u % SU; const bool latent = j >= CTX; const int t = latent ? j - CTX : 0;
    const bf16* z = (const bf16*)(P.ws + WS_Z) + (size_t)u * EVEN_IN_P;
    const bf16* qp = (const bf16*)(P.ws + WS_QP) + (size_t)u * 1792; const bf16* kvp = qp + 768;
    const float* rc = (const float*)(P.ws + WS_ROPE); const float* rs = rc + SEQ * 64;
    const u32x4 z4 = {0u, 0u, 0u, 0u}; const f32x4 one4 = {1.f, 1.f, 1.f, 1.f}, zero4 = {0.f, 0.f, 0.f, 0.f};
    MlaRow r;
    r.zq = lane < 48 ? *(const u32x4*)(z + 1024 + lane * 8) : z4;
    r.zk = lane < 32 ? *(const u32x4*)(z + 1408 + lane * 8) : z4;
    r.zr = tail ? *(const u32x4*)(z + 1664 + (hl - 16) * 8) : z4;
    r.q0 = act ? *(const u32x4*)(qp + hh * 192 + hl * 8) : z4;
    r.q1 = act ? *(const u32x4*)(qp + (2 + hh) * 192 + hl * 8) : z4;
    r.kv0 = hl < 16 ? *(const u32x4*)(kvp + hh * 256 + hl * 8) : z4;
    r.kw0 = hl < 16 ? *(const u32x4*)(kvp + hh * 256 + 128 + hl * 8) : z4;
    r.kv1 = hl < 16 ? *(const u32x4*)(kvp + (2 + hh) * 256 + hl * 8) : z4;
    r.kw1 = hl < 16 ? *(const u32x4*)(kvp + (2 + hh) * 256 + 128 + hl * 8) : z4;
    const bool rp = latent && tail; const int ro = t * 64 + (hl - 16) * 8;
    r.c0 = rp ? *(const f32x4*)(rc + ro) : one4; r.c1 = rp ? *(const f32x4*)(rc + ro + 4) : one4;
    r.s0 = rp ? *(const f32x4*)(rs + ro) : zero4; r.s1 = rp ? *(const f32x4*)(rs + ro + 4) : zero4;
    return r;
}
__device__ __forceinline__ void ph_mla_prep(const Ptrs& P) {
    const int wave = threadIdx.x >> 6, lane = threadIdx.x & 63, G = gridDim.x;
    const int hl = lane & 31, hh = lane >> 5;
    const bool act = hl < 24, tail = hl >= 16 && hl < 24;
    const float* qn = P.in[21]; const float* kn = P.in[22];
    float gq[8], gk[8];
#pragma unroll
    for (int i = 0; i < 8; ++i) { gq[i] = act ? qn[hl * 8 + i] : 0.f; gk[i] = act ? kn[hl * 8 + i] : 0.f; }
    const float c2 = 0.07216878364870322f * LOG2E;
    const float sgn = ((hl >> 1) & 1) ? 1.f : -1.f;
    int u = (int)blockIdx.x * 8 + wave;
    if (u >= R) return;
    MlaRow cur = mla_row_load(P, u, lane);
    for (; u < R; u += G * 8) {
        const int un = u + G * 8;
        MlaRow nxt = cur;
        if (un < R) nxt = mla_row_load(P, un, lane);
        float f[8]; float sq = 0.f, sk = 0.f;
        unpack8(cur.zq, f);
#pragma unroll
        for (int i = 0; i < 8; ++i) sq += f[i] * f[i];
        unpack8(cur.zk, f);
#pragma unroll
        for (int i = 0; i < 8; ++i) sk += f[i] * f[i];
        const float rq = rsqrtf(wave_sum(sq) * (1.f / 384.f) + EPS), rk = rsqrtf(wave_sum(sk) * (1.f / 256.f) + EPS);
        float cs[8], sn[8];
#pragma unroll
        for (int i = 0; i < 4; ++i) { cs[i] = cur.c0[i]; cs[4 + i] = cur.c1[i]; sn[i] = cur.s0[i]; sn[4 + i] = cur.s1[i]; }
        bf16* qm = (bf16*)(P.ws + WS_QM) + (size_t)u * 768; bf16* km = (bf16*)(P.ws + WS_KM) + (size_t)u * 768; bf16* vm = (bf16*)(P.ws + WS_VM) + (size_t)u * 512;
#pragma unroll
        for (int pass = 0; pass < 2; ++pass) {
            const int h = pass * 2 + hh;
            {
                float v[8]; float ss = 0.f;
                unpack8(pass ? cur.q1 : cur.q0, v);
#pragma unroll
                for (int i = 0; i < 8; ++i) { v[i] *= rq; ss += v[i] * v[i]; }
                ss += __shfl_xor(ss, 1); ss += __shfl_xor(ss, 2); ss += __shfl_xor(ss, 4); ss += __shfl_xor(ss, 8); ss += __shfl_xor(ss, 16);
                const float r = rsqrtf(ss * (1.f / 192.f) + EPS);
#pragma unroll
                for (int i = 0; i < 8; ++i) { v[i] *= r * gq[i]; const float other = __shfl_xor(v[i], 2); v[i] = (v[i] * cs[i] + sgn * other * sn[i]) * c2; }
                if (act) *(u32x4*)(qm + h * 192 + hl * 8) = pack8(v);
            }
            {
                float v[8], w[8]; float ss = 0.f;
                if (hl < 16) { unpack8(pass ? cur.kv1 : cur.kv0, v); unpack8(pass ? cur.kw1 : cur.kw0, w);
#pragma unroll
                    for (int i = 0; i < 8; ++i) { v[i] *= rk; w[i] *= rk; } }
                else { unpack8(cur.zr, v);
#pragma unroll
                    for (int i = 0; i < 8; ++i) w[i] = 0.f; }
#pragma unroll
                for (int i = 0; i < 8; ++i) ss += v[i] * v[i];
                ss += __shfl_xor(ss, 1); ss += __shfl_xor(ss, 2); ss += __shfl_xor(ss, 4); ss += __shfl_xor(ss, 8); ss += __shfl_xor(ss, 16);
                const float r = rsqrtf(ss * (1.f / 192.f) + EPS);
#pragma unroll
                for (int i = 0; i < 8; ++i) { v[i] *= r * gk[i]; const float other = __shfl_xor(v[i], 2); v[i] = v[i] * cs[i] + sgn * other * sn[i]; }
                if (act) *(u32x4*)(km + h * 192 + hl * 8) = pack8(v);
                if (hl < 16) *(u32x4*)(vm + h * 128 + hl * 8) = pack8(w);
            }
        }
        cur = nxt;
    }
}
#ifndef PROBE_SUB
#define PROBE_SUB 0
#define PROBE_SUBDK 0
#endif
#ifndef PROBE_SUBBLK
#define PROBE_SUBBLK 0
#endif
#define PSUB_T0() unsigned ps_t0_ = 0u; if (PROBE_SUB && DK == PROBE_SUBDK) ps_t0_ = __builtin_amdgcn_readfirstlane((unsigned)__builtin_readcyclecounter())
#define PSUB_AT(k) do { if (PROBE_SUB == (k) && DK == PROBE_SUBDK) sacc = __builtin_amdgcn_readfirstlane(sacc + ((unsigned)__builtin_readcyclecounter() - ps_t0_)); } while (0)
namespace att {
using bf16x8 = __attribute__((ext_vector_type(8))) short;
using s16x4  = __attribute__((ext_vector_type(4))) short;
using f32x16 = __attribute__((ext_vector_type(16))) float;
#define SBAR() __builtin_amdgcn_sched_barrier(0)
__device__ __forceinline__ int crow(int r, int hi) { return (r & 3) + 8 * (r >> 2) + 4 * hi; }
__device__ __forceinline__ unsigned cvtpk(float lo, float hi) { unsigned r; asm volatile("v_cvt_pk_bf16_f32 %0, %1, %2" : "=v"(r) : "v"(lo), "v"(hi)); return r; }
template <int DK> __device__ __forceinline__ int kswz(int row, int chunk) { return row * (DK * 2) + ((chunk ^ ((row >> 1) & 7)) << 4); }
__device__ __forceinline__ int v_st(int k, int c) { const int kk = (k & ~0xC) | ((k & 4) << 1) | ((k & 8) >> 1); return ((kk >> 3) * 4 + (c >> 5)) * 512 + ((kk & 7) * 32 + (c & 31)) * 2; }
__device__ __forceinline__ int v_rd_base(int lane) { return ((lane & 3) << 3) | (((lane >> 2) & 3) << 6) | (((lane >> 4) & 1) << 5) | (((lane >> 5) & 1) << 8); }
constexpr int v_rd_off(int d0, int ks, int half) { return d0 * 512 + ks * 4096 + half * 2048; }
template <int OFF> __device__ __forceinline__ s16x4 tr_read(int vb) { s16x4 r; asm volatile("ds_read_b64_tr_b16 %0, %1 offset:%2" : "=&v"(r) : "v"(vb), "i"(OFF) : "memory"); return r; }
template <int D0> __device__ __forceinline__ void pv_one(f32x16& od, int vb, bf16x8 pa0, bf16x8 pa1, bf16x8 pa2, bf16x8 pa3) {
    const s16x4 l0 = tr_read<v_rd_off(D0, 0, 0)>(vb), h0 = tr_read<v_rd_off(D0, 0, 1)>(vb), l1 = tr_read<v_rd_off(D0, 1, 0)>(vb), h1 = tr_read<v_rd_off(D0, 1, 1)>(vb);
    const s16x4 l2 = tr_read<v_rd_off(D0, 2, 0)>(vb), h2 = tr_read<v_rd_off(D0, 2, 1)>(vb), l3 = tr_read<v_rd_off(D0, 3, 0)>(vb), h3 = tr_read<v_rd_off(D0, 3, 1)>(vb);
    asm volatile("s_waitcnt lgkmcnt(0)" ::: "memory"); SBAR();
#define PK(L, H) (bf16x8){L[0], L[1], L[2], L[3], H[0], H[1], H[2], H[3]}
    od = __builtin_amdgcn_mfma_f32_32x32x16_bf16(pa0, PK(l0, h0), od, 0, 0, 0);
    od = __builtin_amdgcn_mfma_f32_32x32x16_bf16(pa1, PK(l1, h1), od, 0, 0, 0);
    od = __builtin_amdgcn_mfma_f32_32x32x16_bf16(pa2, PK(l2, h2), od, 0, 0, 0);
    od = __builtin_amdgcn_mfma_f32_32x32x16_bf16(pa3, PK(l3, h3), od, 0, 0, 0);
#undef PK
}
typedef short v4i16_t __attribute__((ext_vector_type(4)));
template <int OFF> __device__ __forceinline__ s16x4 tr_read_b(int vb) {
    return __builtin_bit_cast(s16x4, __builtin_amdgcn_ds_read_tr16_b64_v4i16((__attribute__((address_space(3))) v4i16_t*)(uintptr_t)(unsigned)(vb + OFF)));
}
template <int D0> __device__ __forceinline__ void pv_one_b(f32x16& od, int vb, bf16x8 pa0, bf16x8 pa1, bf16x8 pa2, bf16x8 pa3) {
    const s16x4 l0 = tr_read_b<v_rd_off(D0, 0, 0)>(vb), h0 = tr_read_b<v_rd_off(D0, 0, 1)>(vb), l1 = tr_read_b<v_rd_off(D0, 1, 0)>(vb), h1 = tr_read_b<v_rd_off(D0, 1, 1)>(vb);
    const s16x4 l2 = tr_read_b<v_rd_off(D0, 2, 0)>(vb), h2 = tr_read_b<v_rd_off(D0, 2, 1)>(vb), l3 = tr_read_b<v_rd_off(D0, 3, 0)>(vb), h3 = tr_read_b<v_rd_off(D0, 3, 1)>(vb);
#define PK(L, H) (bf16x8){L[0], L[1], L[2], L[3], H[0], H[1], H[2], H[3]}
    od = __builtin_amdgcn_mfma_f32_32x32x16_bf16(pa0, PK(l0, h0), od, 0, 0, 0);
    od = __builtin_amdgcn_mfma_f32_32x32x16_bf16(pa1, PK(l1, h1), od, 0, 0, 0);
    od = __builtin_amdgcn_mfma_f32_32x32x16_bf16(pa2, PK(l2, h2), od, 0, 0, 0);
    od = __builtin_amdgcn_mfma_f32_32x32x16_bf16(pa3, PK(l3, h3), od, 0, 0, 0);
#undef PK
}
constexpr int SHM_V = 64 * 128 * 2;
template <int DK, bool PF, bool EARLY>
__device__ __forceinline__ void attn_loop(const bf16* __restrict__ Qrow  , const bf16* __restrict__ Kh, int ldk, const bf16* __restrict__ Vh, int ldv,
                                          int nkeys, float negM, f32x16 (&o)[4], float& l_reg, char* lds_kv, unsigned& sacc) {
    constexpr int NQ = DK / 16, CH = DK / 8, KP = (64 * CH) / NT, SHM_K = 64 * DK * 2;
    const int tid = threadIdx.x, lane = tid & 63, r32 = lane & 31, hi = lane >> 5;
    char* V_lds = lds_kv; char* K_lds = lds_kv + 2 * SHM_V;
    bf16x8 qr[NQ];
#pragma unroll
    for (int d0 = 0; d0 < NQ; ++d0) qr[d0] = *reinterpret_cast<const bf16x8*>(Qrow + d0 * 16);
    const __amdgpu_buffer_rsrc_t krs = __builtin_amdgcn_make_buffer_rsrc((void*)Kh, 0, nkeys * ldk * 2, 0x00020000);
    const __amdgpu_buffer_rsrc_t vrs = __builtin_amdgcn_make_buffer_rsrc((void*)Vh, 0, nkeys * ldv * 2, 0x00020000);
    unsigned kgo[KP]; int kst[KP];
#pragma unroll
    for (int i = 0; i < KP; ++i) { const int p = tid + i * NT, row = p / CH, ch = p % CH; kgo[i] = (unsigned)(row * ldk + ch * 8) * 2u; kst[i] = kswz<DK>(row, ch); }
    const int vrow0 = tid >> 4, vc = (tid & 15) * 8;
    const unsigned vgo = (unsigned)(vrow0 * ldv + vc) * 2u, vstep = (unsigned)(32 * ldv) * 2u;
    const int vst0 = v_st(vrow0, vc); constexpr int vst1d = 8192;
    const int vb0 = (int)(uintptr_t)V_lds + v_rd_base(lane);
    const int kbase = r32 * (DK * 2), kt0 = (hi ^ ((r32 >> 1) & 7)) << 4;
#define kra_(q) (kbase + (kt0 ^ ((q) << 5)))
    u32x4 ks[KP], vs0, vs1;
#define SLOAD(k0) do { const unsigned so_k = (unsigned)((k0) * ldk) * 2u, so_v = (unsigned)((k0) * ldv) * 2u; \
        _Pragma("unroll") for (int i = 0; i < KP; ++i) ks[i] = __builtin_amdgcn_raw_buffer_load_b128(krs, kgo[i], so_k, 0); \
        vs0 = __builtin_amdgcn_raw_buffer_load_b128(vrs, vgo, so_v, 0); vs1 = __builtin_amdgcn_raw_buffer_load_b128(vrs, vgo + vstep, so_v, 0); } while (0)
#define SWRITE(b) do { _Pragma("unroll") for (int i = 0; i < KP; ++i) *reinterpret_cast<u32x4*>(K_lds + (b) * SHM_K + kst[i]) = ks[i]; \
        *reinterpret_cast<u32x4*>(V_lds + (b) * SHM_V + vst0) = vs0; *reinterpret_cast<u32x4*>(V_lds + (b) * SHM_V + vst0 + vst1d) = vs1; } while (0)
    constexpr int KLINES = (64 * DK * 2) / 128, VLINES = 128, LPR = DK / 64;
    unsigned pf_dummy = 0u;
#define PREFETCH(t) do { if (PF && tid < KLINES + VLINES) { const bool isk_ = tid < KLINES; const int l_ = isk_ ? tid : tid - KLINES; \
        const unsigned off_ = isk_ ? (unsigned)(((t) * 64 + l_ / LPR) * ldk + (l_ % LPR) * 64) * 2u : (unsigned)(((t) * 64 + (l_ >> 1)) * ldv + (l_ & 1) * 64) * 2u + (unsigned)((const char*)Vh - (const char*)Kh); \
        asm volatile("global_load_dword %0, %1, %2" : "+v"(pf_dummy) : "v"(off_), "s"(Kh) : "memory"); } } while (0)
    const int ntile = nkeys / 64;
    PREFETCH(1); PREFETCH(2);
    SLOAD(0); SWRITE(0); __syncthreads();
    for (int j = 0; j < ntile; ++j) {
        const int cur = j & 1;
        PSUB_T0();
        if (EARLY && j + 1 < ntile) SLOAD((j + 1) * 64);
        f32x16 p0, p1;
#pragma unroll
        for (int r = 0; r < 16; ++r) { p0[r] = negM; p1[r] = negM; }
        const char* Kb = K_lds + cur * SHM_K;
#pragma unroll
        for (int d0 = 0; d0 < NQ; ++d0) {
            const bf16x8 b0 = *reinterpret_cast<const bf16x8*>(Kb + kra_(d0 & 3) + (d0 >> 2) * 128);
            const bf16x8 b1 = *reinterpret_cast<const bf16x8*>(Kb + kra_(d0 & 3) + (d0 >> 2) * 128 + 32 * DK * 2);
            p0 = __builtin_amdgcn_mfma_f32_32x32x16_bf16(b0, qr[d0], p0, 0, 0, 0);
            p1 = __builtin_amdgcn_mfma_f32_32x32x16_bf16(b1, qr[d0], p1, 0, 0, 0);
            if ((d0 & 3) == 3) SBAR();
        }
        PSUB_AT(1);
        if (!EARLY && j + 1 < ntile) SLOAD((j + 1) * 64);
        float ps = 0.f;
#pragma unroll
        for (int r = 0; r < 16; ++r) { p0[r] = __builtin_amdgcn_exp2f(p0[r]); p1[r] = __builtin_amdgcn_exp2f(p1[r]); ps += p0[r] + p1[r]; }
        l_reg += ps;
        bf16x8 pa0, pa1, pa2, pa3;
#define PK4(P, BASE, OUT) do { unsigned a0 = cvtpk(P[BASE + 0], P[BASE + 1]), a1 = cvtpk(P[BASE + 2], P[BASE + 3]);   \
        unsigned b0_ = cvtpk(P[BASE + 4], P[BASE + 5]), b1_ = cvtpk(P[BASE + 6], P[BASE + 7]);                              \
        auto r0 = __builtin_amdgcn_permlane32_swap(a0, b0_, false, false); auto r1 = __builtin_amdgcn_permlane32_swap(a1, b1_, false, false); \
        u32x4 w = {r0[0], r1[0], r0[1], r1[1]}; OUT = *reinterpret_cast<bf16x8*>(&w); } while (0)
        PK4(p0, 0, pa0); PK4(p0, 8, pa1); PK4(p1, 0, pa2); PK4(p1, 8, pa3);
#undef PK4
        PSUB_AT(2);
        const int vb = vb0 + cur * SHM_V;
        pv_one<0>(o[0], vb, pa0, pa1, pa2, pa3); pv_one<1>(o[1], vb, pa0, pa1, pa2, pa3); pv_one<2>(o[2], vb, pa0, pa1, pa2, pa3); pv_one<3>(o[3], vb, pa0, pa1, pa2, pa3);
        PSUB_AT(3);
        if (j + 1 < ntile) SWRITE(cur ^ 1);
        if (j + 3 < ntile) PREFETCH(j + 3);
        __syncthreads();
        PSUB_AT(4);
    }
    if (PF) asm volatile("s_waitcnt vmcnt(0)" : "+v"(pf_dummy) :: "memory");
#undef PREFETCH
#undef kra_
#undef SLOAD
#undef SWRITE
}
__device__ __forceinline__ void row_recip(float l_reg, float* li_l  , int r32, int hi, float (&rli)[16]) {
    { auto rr = __builtin_amdgcn_permlane32_swap(__float_as_uint(l_reg), __float_as_uint(l_reg), false, false); l_reg = __uint_as_float(rr[0]) + __uint_as_float(rr[1]); }
    if (hi == 0) li_l[r32] = l_reg;
    asm volatile("s_waitcnt lgkmcnt(0)" ::: "memory");
#pragma unroll
    for (int r = 0; r < 16; ++r) rli[r] = __builtin_amdgcn_rcpf(li_l[crow(r, hi)]);
}
#undef SBAR
}

constexpr int ATT_SCR_OFF = RING_BYTES - 2048;
__device__ __forceinline__ void mla_attn_unit(const Ptrs& P, unsigned char* lds, int b, int h, int qb, int ctxq, unsigned& sacc) {
    using namespace att;
    const int tid = threadIdx.x, wid = tid >> 6, lane = tid & 63, r32 = lane & 31, hi = lane >> 5;
    const bf16* Qm = (const bf16*)(P.ws + WS_QM); const bf16* Km = (const bf16*)(P.ws + WS_KM); const bf16* Vm = (const bf16*)(P.ws + WS_VM);
    const size_t u0 = (size_t)b * SU + (ctxq ? 0 : CTX) + qb * 256 + wid * 32;
    f32x16 o[4] = {}; float l_reg = 0.f;
    const float negM = -((const float*)(P.ws + WS_SCAL))[0];
    attn_loop<192, false, false>(Qm + (u0 + r32) * 768 + h * 192 + hi * 8, Km + (size_t)b * SU * 768 + h * 192, 768, Vm + (size_t)b * SU * 512 + h * 128, 512, ctxq ? CTX : SU, negM, o, l_reg, (char*)lds, sacc);
    float rli[16]; row_recip(l_reg, (float*)(lds + ATT_SCR_OFF) + wid * 64, r32, hi, rli);
    bf16* stg = (bf16*)lds + wid * 4096;
#pragma unroll
    for (int r = 0; r < 16; ++r) { const int orow = crow(r, hi);
#pragma unroll
        for (int d0 = 0; d0 < 4; ++d0) stg[orow * 128 + d0 * 32 + r32] = f2bf(o[d0][r] * rli[r]); }
    asm volatile("s_waitcnt lgkmcnt(0)" ::: "memory");
    bf16* mix = (bf16*)(P.ws + WS_MIX) + u0 * D + 512 + h * 128;
#pragma unroll
    for (int i = 0; i < 8; ++i) { const int row = i * 4 + (lane >> 4), ch = lane & 15; const u32x4 v = *(const u32x4*)(stg + row * 128 + ch * 8); *(u32x4*)(mix + (size_t)row * D + ch * 8) = v; }
    asm volatile("s_waitcnt lgkmcnt(0)" ::: "memory");
    __syncthreads();
}
__device__ __forceinline__ void diff_attn_unit(const Ptrs& P, unsigned char* lds, int b, int h, int qb, unsigned& sacc) {
    using namespace att;
    const int tid = threadIdx.x, wid = tid >> 6, lane = tid & 63, r32 = lane & 31, hi = lane >> 5;
    const bf16* Z = (const bf16*)(P.ws + WS_Z);
    const size_t u0 = (size_t)b * SU + CTX + qb * 256 + wid * 32;
    const float* scal = (const float*)(P.ws + WS_SCAL); const float negM = -scal[1], lam = scal[2], oml = scal[3];
    bf16* stg = (bf16*)lds + wid * 4096;
    float* li_l = (float*)(lds + ATT_SCR_OFF) + wid * 64;
    for (int part = 0; part < 2; ++part) {
        f32x16 o[4] = {}; float l_reg = 0.f;
        attn_loop<64, true, true>(Z + (u0 + r32) * ODD_IN + h * 128 + part * 64 + hi * 8, Z + 1024 + (size_t)b * SU * ODD_IN + h * 128 + part * 64, ODD_IN, Z + 2048 + (size_t)b * SU * ODD_IN + h * 128, ODD_IN, SU, negM, o, l_reg, (char*)lds + 65536, sacc);
        float rli[16]; row_recip(l_reg, li_l, r32, hi, rli);
#pragma unroll
        for (int r = 0; r < 16; ++r) { const int orow = crow(r, hi);
#pragma unroll
            for (int d0 = 0; d0 < 4; ++d0) { bf16* s = stg + orow * 128 + d0 * 32 + r32; const float on = o[d0][r] * rli[r];
                if (part == 0) *s = f2bf(on); else *s = f2bf(bf2f(*s) - lam * on); } }
        asm volatile("s_waitcnt lgkmcnt(0)" ::: "memory");
    }
    const float* sg = P.in[31];
    bf16* mix = (bf16*)(P.ws + WS_MIX) + u0 * D + h * 128;
#pragma unroll
    for (int i = 0; i < 8; ++i) { const int row = i * 4 + (lane >> 4), ch = lane & 15; const u32x4 v = *(const u32x4*)(stg + row * 128 + ch * 8);
        float f[8]; float ss = 0.f;
#pragma unroll
        for (int e = 0; e < 4; ++e) { f[2 * e] = __uint_as_float(v[e] << 16); f[2 * e + 1] = __uint_as_float(v[e] & 0xffff0000u); ss += f[2 * e] * f[2 * e] + f[2 * e + 1] * f[2 * e + 1]; }
        ss += __shfl_xor(ss, 1); ss += __shfl_xor(ss, 2); ss += __shfl_xor(ss, 4); ss += __shfl_xor(ss, 8);
        const float rs = rsqrtf(ss * (1.f / 128.f) + EPS) * oml;
        const f32x4 g0 = *(const f32x4*)(sg + ch * 8), g1 = *(const f32x4*)(sg + ch * 8 + 4);
        u32x4 w; w.x = att::cvtpk(f[0] * rs * g0[0], f[1] * rs * g0[1]); w.y = att::cvtpk(f[2] * rs * g0[2], f[3] * rs * g0[3]); w.z = att::cvtpk(f[4] * rs * g1[0], f[5] * rs * g1[1]); w.w = att::cvtpk(f[6] * rs * g1[2], f[7] * rs * g1[3]);
        *(u32x4*)(mix + (size_t)row * D + ch * 8) = w; }
    asm volatile("s_waitcnt lgkmcnt(0)" ::: "memory");
    __syncthreads();
}

__device__ __forceinline__ void ph_norm2_router(const Ptrs& P, unsigned char* lds, int layer, int latent_only) {
    const int tid = threadIdx.x, wid = tid >> 6, lane = tid & 63, fr = lane & 15, fq = lane >> 4, G = gridDim.x;
    float* RS = (float*)lds;
    float* LGP = RS + 256;
    int* TOPE = (int*)(LGP + 2 * 4096);
    float* TOPW = (float*)(TOPE + 512);
    int* TOPR = (int*)(TOPW + 512);
    int* LCNT = TOPR + 512;
    int* LBASE = LCNT + 32;
    int* GU0 = LBASE + 32;
    const float* gn = P.in[7] + layer * D;
    const float* rw = P.in[32] + (size_t)layer * D * NE; const float* rb = P.in[33] + layer * NE;
    const int cw0 = 128 * wid + 8 * fq;
    float wv0[4][8], wv1[4][8];
#pragma unroll
    for (int ks = 0; ks < 4; ++ks) { const float* wr = rw + (size_t)(cw0 + 32 * ks) * NE + fr;
#pragma unroll
        for (int j = 0; j < 8; ++j) { wv0[ks][j] = wr[j * NE]; wv1[ks][j] = wr[j * NE + 16]; } }
    const int NG = latent_only ? NB * (SEQ / 16) : R / 16;
    const int q0 = (int)(((long long)blockIdx.x * NG) / G), q1 = (int)(((long long)(blockIdx.x + 1) * NG) / G);
#define N2_U0(q) (latent_only ? ((q) >> 8) * SU + CTX + ((q) & 255) * 16 : (q) * 16)
#define N2_XLOAD(XR, q) do { const bf16* x_ = (const bf16*)(P.ws + WS_XB) + (size_t)(N2_U0(q) + fr) * D + cw0; _Pragma("unroll") for (int ks = 0; ks < 4; ++ks) XR[ks] = *(const u32x4*)(x_ + 32 * ks); } while (0)
#define N2_LO(w) __uint_as_float((w) << 16)
#define N2_HI(w) __uint_as_float((w) & 0xffff0000u)
#define N2_SS(XR, par) do { float ss = 0.f; _Pragma("unroll") for (int ks = 0; ks < 4; ++ks) { const u32x4 r = XR[ks]; \
            ss += N2_LO(r.x) * N2_LO(r.x) + N2_HI(r.x) * N2_HI(r.x) + N2_LO(r.y) * N2_LO(r.y) + N2_HI(r.y) * N2_HI(r.y) + N2_LO(r.z) * N2_LO(r.z) + N2_HI(r.z) * N2_HI(r.z) + N2_LO(r.w) * N2_LO(r.w) + N2_HI(r.w) * N2_HI(r.w); } \
        ss += __shfl_xor(ss, 16); ss += __shfl_xor(ss, 32); if (fq == 0) RS[(par) * 128 + wid * 16 + fr] = ss; } while (0)
    float A[4][8], Hs[4][8]; int mi_cur = -1;
    for (int qs = q0; qs < q1; qs += 8) {
        const int qe = qs + 8 < q1 ? qs + 8 : q1;
        __syncthreads();
        if (tid < 32) LCNT[tid] = 0;
        u32x4 xr[4], xn[4];
        N2_XLOAD(xr, qs);
        N2_SS(xr, 0);
        __syncthreads();
        for (int q = qs; q < qe; ++q) {
            const int gi = q - qs, par = gi & 1, u0 = N2_U0(q), u = u0 + fr;
            { const int b_ = u0 / SU, mi = (u0 % SU) < CTX ? 4 : b_;
              if (mi != mi_cur) { mi_cur = mi; const float* md = (const float*)(P.ws + WS_MOD) + (size_t)(layer * 5 + mi) * 6144 + 3 * D;
#pragma unroll
                  for (int ks = 0; ks < 4; ++ks) { const int c0 = cw0 + 32 * ks;
                      const f32x4 g0 = *(const f32x4*)(gn + c0), g1 = *(const f32x4*)(gn + c0 + 4), s0 = *(const f32x4*)(md + D + c0), s1 = *(const f32x4*)(md + D + c0 + 4), h0 = *(const f32x4*)(md + c0), h1 = *(const f32x4*)(md + c0 + 4);
#pragma unroll
                      for (int j = 0; j < 4; ++j) { A[ks][j] = g0[j] * (1.f + s0[j]); A[ks][4 + j] = g1[j] * (1.f + s1[j]); Hs[ks][j] = h0[j]; Hs[ks][4 + j] = h1[j]; } } } }
            if (q + 1 < qe) N2_XLOAD(xn, q + 1);
            if (tid == 0) GU0[gi] = u0;
            float tot = 0.f;
#pragma unroll
            for (int w = 0; w < 8; ++w) tot += RS[par * 128 + w * 16 + fr];
            const float rstd = rsqrtf(tot * (1.f / D) + EPS);
            f32x4 acc0 = {0.f, 0.f, 0.f, 0.f}, acc1 = {0.f, 0.f, 0.f, 0.f};
            bf16* h = (bf16*)(P.ws + WS_H) + (size_t)u * D + cw0;
#pragma unroll
            for (int ks = 0; ks < 4; ++ks) {
                float y[8];
                const u32x4 r = xr[ks]; const float xv[8] = {N2_LO(r.x), N2_HI(r.x), N2_LO(r.y), N2_HI(r.y), N2_LO(r.z), N2_HI(r.z), N2_LO(r.w), N2_HI(r.w)};
#pragma unroll
                for (int j = 0; j < 8; ++j) y[j] = xv[j] * rstd * A[ks][j] + Hs[ks][j];
                u32x4 w; w.x = g8::cvt_pk_bf16(y[0], y[1]); w.y = g8::cvt_pk_bf16(y[2], y[3]); w.z = g8::cvt_pk_bf16(y[4], y[5]); w.w = g8::cvt_pk_bf16(y[6], y[7]);
                *(u32x4*)(h + 32 * ks) = w;
#pragma unroll
                for (int j = 0; j < 8; ++j) {
                    acc0 = __builtin_amdgcn_mfma_f32_16x16x4f32(y[j], wv0[ks][j], acc0, 0, 0, 0);
                    acc1 = __builtin_amdgcn_mfma_f32_16x16x4f32(y[j], wv1[ks][j], acc1, 0, 0, 0);
                }
            }
            float* lgp = LGP + par * 4096;
#pragma unroll
            for (int j = 0; j < 4; ++j) { lgp[(wid * 16 + 4 * fq + j) * 32 + fr] = acc0[j]; lgp[(wid * 16 + 4 * fq + j) * 32 + 16 + fr] = acc1[j]; }
            if (q + 1 < qe) { N2_SS(xn, par ^ 1);
#pragma unroll
                for (int ks = 0; ks < 4; ++ks) xr[ks] = xn[ks]; }
            __syncthreads();
            {
                const int e = lane & 31, row = 2 * wid + (lane >> 5);
                float lg = rb[e];
#pragma unroll
                for (int w = 0; w < 8; ++w) lg += lgp[(w * 16 + row) * 32 + e];
                int te[4]; float tv[4];
#pragma unroll
                for (int k = 0; k < 4; ++k) {
                    float bv = lg; int bi = e;
#pragma unroll
                    for (int m = 1; m < 32; m <<= 1) { const float ov = __shfl_xor(bv, m); const int oi = __shfl_xor(bi, m); const bool take = ov > bv || (ov == bv && oi < bi); bv = take ? ov : bv; bi = take ? oi : bi; }
                    te[k] = bi; tv[k] = bv; if (e == bi) lg = -3.4e38f;
                }
                float den = 0.f, w[4];
#pragma unroll
                for (int k = 0; k < 4; ++k) { w[k] = __expf(tv[k] - tv[0]); den += w[k]; }
                const float iden = 1.f / den;
                if (e < 4) { const int ek = e == 0 ? te[0] : e == 1 ? te[1] : e == 2 ? te[2] : te[3]; const float wk = (e == 0 ? w[0] : e == 1 ? w[1] : e == 2 ? w[2] : w[3]) * iden;
                    TOPE[gi * 64 + row * 4 + e] = ek; TOPW[gi * 64 + row * 4 + e] = wk; TOPR[gi * 64 + row * 4 + e] = atomicAdd(&LCNT[ek], 1); }
            }
        }
        __syncthreads();
        if (tid < 32) { int t2 = tid; asm volatile("" : "+v"(t2));
            const int c = LCNT[t2]; LBASE[t2] = c > 0 ? (int)atomicAdd((unsigned*)(P.ws + WS_CTL) + CW_CNT + layer * 64 + t2, (unsigned)c) : 0; }
        __syncthreads();
        int* tok_of = (int*)(P.ws + WS_TOKOF); int* pair_of = (int*)(P.ws + WS_PAIROF); float* gate_of = (float*)(P.ws + WS_GATEOF);
        for (int p = tid; p < (qe - qs) * 64; p += NT) {
            const int e = TOPE[p], rk = LBASE[e] + TOPR[p], ur = GU0[p >> 6] + ((p & 63) >> 2), k = p & 3;
            tok_of[(size_t)e * R + rk] = ur; pair_of[(size_t)e * R + rk] = ur * 4 + k; gate_of[(size_t)e * R + rk] = TOPW[p];
        }
    }
#undef N2_U0
#undef N2_XLOAD
#undef N2_SS
#undef N2_LO
#undef N2_HI
}

struct Args { Ptrs P; int ph_lo, ph_hi; };
constexpr int N_PHASES = 19;
__global__ void __launch_bounds__(NT, 2) mega(Args args) {
    extern __shared__ __attribute__((aligned(16))) unsigned char lds[];
    const Ptrs& P = args.P;
    unsigned char* ws = P.ws;
    const int tid = threadIdx.x, G = gridDim.x;
    const int vcu = (G % 8 == 0) ? ((int)blockIdx.x % 8) * (G / 8) + (int)blockIdx.x / 8 : (int)blockIdx.x;
    LAS unsigned char* LDSP = (LAS unsigned char*)lds;
    volatile LAS unsigned* MISC = (volatile LAS unsigned*)((LAS unsigned char*)lds + MISC_OFF);
    for (int u = tid; u < (LDS_BYTES - LDSCTL_OFF) / 4; u += NT) ((LAS unsigned*)((LAS unsigned char*)lds + LDSCTL_OFF))[u] = 0u;
    __syncthreads();
    XcdBarrier bar = xcd_barrier_post((unsigned*)(ws + WS_CTL) + CW_BAR, MISC + 8);
    const int lo = args.ph_lo, hi = args.ph_hi;
#ifndef PROBE_MASK
#define PROBE_MASK 0u
#endif
    unsigned long long pr_acc = 0ull, pr_t0 = 0ull; unsigned sub_acc = 0u;
#define IN(k) (lo <= (k) && (k) < hi)
#define SEAM(k) do { if (IN(k) && IN((k) + 1)) xcd_barrier(bar); \
        if (PROBE_MASK) { const unsigned long long t_ = __builtin_amdgcn_s_memrealtime(); if ((PROBE_MASK >> (k)) & 1u) pr_acc += t_ - pr_t0; pr_t0 = t_; } } while (0)
    if (PROBE_MASK) pr_t0 = __builtin_amdgcn_s_memrealtime();
    const bf16* H = (const bf16*)(ws + WS_H); bf16* Z = (bf16*)(ws + WS_Z); const bf16* MIX = (const bf16*)(ws + WS_MIX);
    const bf16* Qm = (const bf16*)(ws + WS_QM); const bf16* Km = (const bf16*)(ws + WS_KM); const bf16* Vm = (const bf16*)(ws + WS_VM);

    if (IN(0)) { ph_prologue(P, lds, sub_acc); } SEAM(0);
    if (IN(1)) { ph_rows(P, 0, 0, 0, 0); } SEAM(1);
    if (IN(2)) { g8::DenseOrder S; S.init(H, D, (const bf16*)(ws + WS_WEVIN), D, R, EVEN_IN_P, G, (int)blockIdx.x, 0); g8::EpiStoreBf16 E{Z, EVEN_IN_P};
        g8::gemm_phase<g8::EpiStoreBf16, g8::DenseOrder, false, true>(LDSP, D, D, S, E); } SEAM(2);
    if (IN(3)) {
        { g8::UpOrder S{(const char*)Z, (const char*)(ws + WS_WUQ), (const char*)(ws + WS_WUKV), G, (int)blockIdx.x}; g8::EpiStoreBf16 E{(bf16*)(ws + WS_QP), 1792};
          g8::gemm_phase<g8::EpiStoreBf16, g8::UpOrder, false, true>(LDSP, EVEN_IN_P, 384, S, E); }
        ph_lru(P, lds, 0, 0);
    } SEAM(3);
    if (IN(4)) { ph_mla_prep(P); } SEAM(4);
    if (IN(5)) {
        ph_lru(P, lds, 1, 128);
        for (int it = vcu; it < 256 + 16; it += G) {
            if (it < 256) mla_attn_unit(P, lds, it / 64, (it / 16) % 4, it % 16, 0, sub_acc);
            else { const int i2 = it - 256; mla_attn_unit(P, lds, i2 / 4, i2 % 4, 0, 1, sub_acc); }
        }
    } SEAM(5);
    if (IN(6)) { g8::DenseOrder S; S.init(MIX, D, (const bf16*)(ws + WS_WEVOUT), D, R, D, G, (int)blockIdx.x, 0); g8::EpiOut E{P, 0};
        g8::gemm_phase<g8::EpiOut, g8::DenseOrder, false, true>(LDSP, D, D, S, E); } SEAM(6);
    if (IN(7)) { ph_norm2_router(P, lds, 0, 0); } SEAM(7);
    if (IN(8)) { g8::MoeOrder S{(const char*)H, (const char*)(ws + WS_WGU) + (size_t)0 * NE * 2048 * 1024 * 2, (const int*)(ws + WS_TOKOF), (size_t)2048 * 1024 * 2, 8, D, G, vcu, 1, nullptr};
        S.init((const unsigned*)(ws + WS_CTL) + CW_CNT + 0 * 64, (LAS int*)(LDSP + MISC_OFF + 256)); g8::EpiMoe1 E{P, 0}; g8::gemm_phase<g8::EpiMoe1, g8::MoeOrder, true, true>(LDSP, D, D, S, E); } SEAM(8);
    if (IN(9)) { g8::MoeOrder S{(const char*)(ws + WS_ACT), (const char*)(ws + WS_WDN) + (size_t)0 * NE * 1024 * 1024 * 2, nullptr, (size_t)1024 * 1024 * 2, 4, D, G, vcu, 0, nullptr};
        S.init((const unsigned*)(ws + WS_CTL) + CW_CNT + 0 * 64, (LAS int*)(LDSP + MISC_OFF + 256)); g8::EpiMoe2 E{P, 0}; g8::gemm_phase<g8::EpiMoe2, g8::MoeOrder, false, true>(LDSP, D, D, S, E); } SEAM(9);
    if (IN(10)) { ph_rows(P, 0, 2, 0, 1); } SEAM(10);
    if (IN(11)) { g8::DenseOrder S; S.init(H, D, (const bf16*)(ws + WS_WODIN), D, R, ODD_IN, G, (int)blockIdx.x, 0);
        g8::EpiDiffIn E{Z, P.in[25], P.in[26], (const float*)(ws + WS_ROPE), (const float*)(ws + WS_ROPE) + SEQ * 64, (LAS float*)(LDSP + MISC_OFF + 1024)};
        g8::gemm_phase<g8::EpiDiffIn, g8::DenseOrder, false, true>(LDSP, D, D, S, E); } SEAM(11);
    if (IN(13)) {
        for (int it = vcu; it < 512; it += G) { unsigned tq0 = 0u; if (PROBE_SUB == 5 && PROBE_SUBDK == 64) tq0 = (unsigned)__builtin_readcyclecounter();
            diff_attn_unit(P, lds, it / 128, (it / 16) % 8, it % 16, sub_acc);
            if (PROBE_SUB == 5 && PROBE_SUBDK == 64) sub_acc += (unsigned)__builtin_readcyclecounter() - tq0; }
    } SEAM(13);
    if (IN(14)) { g8::DenseOrder S; S.init(MIX, D, (const bf16*)(ws + WS_WODOUT), D, R, D, G, (int)blockIdx.x, 1); g8::EpiOut E{P, 1};
        g8::gemm_phase<g8::EpiOut, g8::DenseOrder, false, true>(LDSP, D, D, S, E); } SEAM(14);
    if (IN(15)) { ph_norm2_router(P, lds, 1, 1); } SEAM(15);
    if (IN(16)) { g8::MoeOrder S{(const char*)H, (const char*)(ws + WS_WGU) + (size_t)1 * NE * 2048 * 1024 * 2, (const int*)(ws + WS_TOKOF), (size_t)2048 * 1024 * 2, 8, D, G, vcu, 1, nullptr};
        S.init((const unsigned*)(ws + WS_CTL) + CW_CNT + 1 * 64, (LAS int*)(LDSP + MISC_OFF + 256)); g8::EpiMoe1 E{P, 1}; g8::gemm_phase<g8::EpiMoe1, g8::MoeOrder, true, true>(LDSP, D, D, S, E); } SEAM(16);
    if (IN(17)) { g8::MoeOrder S{(const char*)(ws + WS_ACT), (const char*)(ws + WS_WDN) + (size_t)1 * NE * 1024 * 1024 * 2, nullptr, (size_t)1024 * 1024 * 2, 4, D, G, vcu, 0, nullptr};
        S.init((const unsigned*)(ws + WS_CTL) + CW_CNT + 1 * 64, (LAS int*)(LDSP + MISC_OFF + 256)); g8::EpiMoe2 E{P, 1}; g8::gemm_phase<g8::EpiMoe2, g8::MoeOrder, false, true>(LDSP, D, D, S, E); } SEAM(17);
    if (IN(18)) { ph_rows(P, 1, 2, 1, 0); }
    if (PROBE_MASK) { const unsigned long long t_ = __builtin_amdgcn_s_memrealtime(); if ((PROBE_MASK >> 18) & 1u) pr_acc += t_ - pr_t0;
        if (blockIdx.x == 0) { const unsigned long long t1 = t_ + 8ull * pr_acc; while (__builtin_amdgcn_s_memrealtime() < t1) __builtin_amdgcn_s_sleep(8); } }
    if (PROBE_SUB && (PROBE_SUBBLK < 0 || (int)blockIdx.x == PROBE_SUBBLK)) { const unsigned long long t1 = __builtin_readcyclecounter() + 8ull * (unsigned long long)sub_acc; while (__builtin_readcyclecounter() < t1) __builtin_amdgcn_s_sleep(8); }
#undef IN
#undef SEAM
}

#ifndef MK_PER_PHASE
#define MK_PER_PHASE 0
#endif
extern "C" void kernel_launch(void* const* d_in, const int* in_sizes, int n_in, void* d_out, int out_size, void* d_ws, size_t ws_size, hipStream_t stream) {
    static int grid = 0;
    if (grid == 0) {
        if (n_in != 38 || ws_size < WS_END) { fprintf(stderr, "kernel_launch: bad args n_in=%d ws=%zu need %zu\n", n_in, ws_size, (size_t)WS_END); grid = -1; return; }
        int dev = 0, cus = 0, per_cu = 0;
        if (hipGetDevice(&dev) != hipSuccess || hipDeviceGetAttribute(&cus, hipDeviceAttributeMultiprocessorCount, dev) != hipSuccess) { grid = -1; return; }
        if (hipFuncSetAttribute((const void*)mega, hipFuncAttributeMaxDynamicSharedMemorySize, LDS_BYTES) != hipSuccess) { fprintf(stderr, "kernel_launch: hipFuncSetAttribute failed\n"); grid = -1; return; }
        if (hipOccupancyMaxActiveBlocksPerMultiprocessor(&per_cu, (const void*)mega, NT, LDS_BYTES) != hipSuccess || per_cu < 1) { fprintf(stderr, "kernel_launch: occupancy query says %d blocks/CU\n", per_cu); grid = -1; return; }
        (void)hipGetLastError();
        grid = cus;
    }
    if (grid < 0) return;
    if (hipMemsetAsync((char*)d_ws + WS_CTL, 0, 1u << 20, stream) != hipSuccess) return;
    Args a; memset((void*)&a, 0, sizeof(a));
    for (int i = 0; i < 38; ++i) a.P.in[i] = (const float*)d_in[i];
    a.P.out = (float*)d_out; a.P.ws = (unsigned char*)d_ws;
#if MK_PER_PHASE
    for (int p = 0; p < N_PHASES; ++p) { a.ph_lo = p; a.ph_hi = p + 1; hipLaunchKernelGGL(mega, dim3(grid), dim3(NT), LDS_BYTES, stream, a); }
#else
    a.ph_lo = 0; a.ph_hi = N_PHASES;
    hipLaunchKernelGGL(mega, dim3(grid), dim3(NT), LDS_BYTES, stream, a);
#endif
    const hipError_t le = hipPeekAtLastError();
    if (le != hipSuccess) fprintf(stderr, "kernel_launch: launch failed: %s\n", hipGetErrorName(le));
}
```

```cpp
#include <hip/hip_runtime.h>
#include <cstdio>
#include <cstdint>
#include <cstring>

typedef unsigned short bf16;
typedef unsigned u32x4 __attribute__((ext_vector_type(4)));
typedef float f32x4 __attribute__((ext_vector_type(4)));

constexpr int D = 1024, NB = 4, SEQ = 4096, CTX = 256, SU = SEQ + CTX, R = NB * SU;
constexpr int GRID_W = 64;
constexpr int LRU_W = 512, LRU_NB = 8, LRU_BW = 64;
constexpr int MLA_H = 4, MLA_QR = 384, MLA_KVR = 256, MLA_NOPE = 128, MLA_ROPE = 64, MLA_V = 128, MLA_QK = 192;
constexpr int EVEN_IN = 1728, EVEN_IN_P = 1792;
constexpr int DIFF_H = 8, ODD_IN = 3072;
constexpr int NE = 32, TOPK = 4, DFF = 1024;
constexpr float EPS = 1e-6f;
constexpr int CHUNK = 128, NCH = SU / CHUNK;

constexpr size_t al256(size_t x) { return (x + 255) / 256 * 256; }
constexpr size_t WS_CTL = 0;
constexpr size_t WS_MOD = 1u << 20;
constexpr size_t WS_SCAL = WS_MOD + al256(2 * 5 * 6144 * 4);
constexpr size_t WS_WEVIN = WS_SCAL + 8192;
constexpr size_t WS_WEVOUT = WS_WEVIN + (size_t)EVEN_IN_P * D * 2;
constexpr size_t WS_WUQ = WS_WEVOUT + (size_t)D * D * 2;
constexpr size_t WS_WUKV = WS_WUQ + (size_t)768 * 384 * 2;
constexpr size_t WS_WLRU = WS_WUKV + (size_t)1024 * 384 * 2;
constexpr size_t WS_WODIN = WS_WLRU + (size_t)32 * 4096 * 2;
constexpr size_t WS_WODOUT = WS_WODIN + (size_t)ODD_IN * D * 2;
constexpr size_t WS_WGU = WS_WODOUT + (size_t)D * D * 2;
constexpr size_t WS_WDN = WS_WGU + (size_t)2 * NE * 2048 * 1024 * 2;
constexpr size_t WS_XC = WS_WDN + (size_t)2 * NE * 1024 * 1024 * 2;
constexpr size_t WS_H = WS_XC + (size_t)NB * CTX * D * 4;
constexpr size_t WS_Z = WS_H + (size_t)R * D * 2;
constexpr size_t WS_QP = WS_Z + (size_t)R * ODD_IN * 2;
constexpr size_t WS_KVP = WS_QP + (size_t)R * 768 * 2;
constexpr size_t WS_QM = WS_KVP + (size_t)R * 1024 * 2;
constexpr size_t WS_KM = WS_QM + (size_t)R * 768 * 2;
constexpr size_t WS_VM = WS_KM + (size_t)R * 768 * 2;
constexpr size_t WS_AGG = WS_VM + (size_t)R * 512 * 2;
constexpr size_t WS_MIX = WS_AGG + al256((size_t)NB * NCH * 2 * 512 * 2 * 4);
constexpr size_t WS_TOKOF = WS_MIX + (size_t)R * D * 2;
constexpr size_t WS_PAIROF = WS_TOKOF + (size_t)NE * R * 4;
constexpr size_t WS_GATEOF = WS_PAIROF + (size_t)NE * R * 4;
constexpr size_t ACT_ROWS = (size_t)R * TOPK + NE * 256;
constexpr size_t WS_ACT = WS_GATEOF + (size_t)NE * R * 4;
constexpr size_t WS_Y = WS_ACT + ACT_ROWS * 1024 * 2;
constexpr size_t WS_XB = WS_Y + (size_t)R * TOPK * 1024 * 2;
constexpr size_t WS_ROPE = WS_XB + (size_t)R * D * 2;
constexpr size_t WS_END = WS_ROPE + (size_t)2 * SEQ * 64 * 4;

constexpr int CW_CNT = 64;

__device__ __forceinline__ float bf2f(bf16 v) { return __uint_as_float((unsigned)v << 16); }
__device__ __forceinline__ bf16 f2bf(float f) { unsigned u = __float_as_uint(f); return (bf16)((u + 0x7fffu + ((u >> 16) & 1u)) >> 16); }
__device__ __forceinline__ float wave_sum(float v) {
#pragma unroll
    for (int o = 1; o < 64; o <<= 1) v += __shfl_xor(v, o);
    return v;
}
__device__ __forceinline__ unsigned g8_cvt_pk(float lo, float hi) { unsigned r; asm volatile("v_cvt_pk_bf16_f32 %0, %1, %2" : "=v"(r) : "v"(lo), "v"(hi)); return r; }
__device__ __forceinline__ float sigmoidf_(float x) { return 1.f / (1.f + __expf(-x)); }
__device__ __forceinline__ float gelu_tanh(float x) { const float t = tanhf(0.7978845608028654f * (x + 0.044715f * x * x * x)); return 0.5f * x * (1.f + t); }

struct Ptrs {
    const float* in[38];
    float* out;
    unsigned char* ws;
};

__device__ __forceinline__ const float* res_in_row(const Ptrs& P, int layer, int u) {
    const int b = u / SU, j = u % SU;
    if (layer == 0) return j < CTX ? P.in[2] + (size_t)(b * CTX + j) * D : P.in[0] + (size_t)(b * SEQ + j - CTX) * D;
    return j < CTX ? (const float*)(P.ws + WS_XC) + (size_t)(b * CTX + j) * D : P.out + (size_t)(b * SEQ + j - CTX) * D;
}
__device__ __forceinline__ float* res_out_row(const Ptrs& P, int u) {
    const int b = u / SU, j = u % SU;
    return j < CTX ? (float*)(P.ws + WS_XC) + (size_t)(b * CTX + j) * D : P.out + (size_t)(b * SEQ + j - CTX) * D;
}
__device__ __forceinline__ const float* mod_row(const Ptrs& P, int layer, int u) {
    const int b = u / SU, j = u % SU;
    return (const float*)(P.ws + WS_MOD) + (size_t)(layer * 5 + (j < CTX ? 4 : b)) * 6144;
}

constexpr float LOG2E = 1.4426950408889634f;
#define GAS __attribute__((address_space(1)))
#define LAS __attribute__((address_space(3)))
constexpr int NT = 512;
constexpr int LDS_BYTES = 147456;
constexpr int RING_BYTES = 131072, LDSCTL_OFF = RING_BYTES, MISC_OFF = LDSCTL_OFF + 320;
constexpr int CW_BAR = 4096;
constexpr int CW_TMO = 0;

#define XB_TMO      128
#define XB_XCNT(j)  (256  + 64 * (j))
#define XB_XSUB(j)  (1280 + 64 * (j))
#define XB_XGEN(j)  (2304 + 64 * (j))
#define XB_TOP      3328
#define XB_TOPGEN   3392
#define XCD_BAR_WORDS 3456
#define XB_SPIN_CAP (1u << 22)
__device__ __forceinline__ unsigned xb_ld(unsigned* p)              { return __hip_atomic_load(p, __ATOMIC_RELAXED, __HIP_MEMORY_SCOPE_AGENT); }
__device__ __forceinline__ unsigned xb_add(unsigned* p, unsigned v) { return __hip_atomic_fetch_add(p, v, __ATOMIC_RELAXED, __HIP_MEMORY_SCOPE_AGENT); }
__device__ __forceinline__ unsigned xb_xcc_id() { return (unsigned)__builtin_amdgcn_s_getreg((3 << 11) | 20) & 0xFu; }
#define XB_SPIN(cond, bar) do { unsigned _sp = 0; while (cond) { __builtin_amdgcn_s_sleep(1); \
    if ((++_sp & 255u) == 0u) { if (xb_ld(&(bar)[XB_TMO])) break; if (_sp > XB_SPIN_CAP) { atomicAdd(&(bar)[XB_TMO], 1u); break; } } } } while (0)
struct XcdBarrier { unsigned* bar; unsigned x; volatile LAS unsigned* st; };
__device__ __forceinline__ XcdBarrier xcd_barrier_post(unsigned* bar, volatile LAS unsigned* st) {
    XcdBarrier b; b.bar = bar; b.x = xb_xcc_id(); b.st = st;
    if (threadIdx.x == 0) (void)xb_add(&bar[XB_XCNT(b.x)], 1u);
    return b;
}
__device__ __forceinline__ void xcd_barrier_complete(unsigned* bar, unsigned x, unsigned& nloc, unsigned& nx) {
    const unsigned G = gridDim.x * gridDim.y * gridDim.z;
    unsigned sum, cnt, mine, sp = 0u;
    for (;;) {
        sum = 0u; cnt = 0u; mine = 0u;
#pragma unroll
        for (unsigned j = 0; j < 16; ++j) { const unsigned c = xb_ld(&bar[XB_XCNT(j)]); sum += c; cnt += (c > 0u) ? 1u : 0u; mine = (j == x) ? c : mine; }
        if (sum == G) break;
        __builtin_amdgcn_s_sleep(1);
        if ((++sp & 255u) == 0u) { if (xb_ld(&bar[XB_TMO])) break; if (sp > XB_SPIN_CAP) { atomicAdd(&bar[XB_TMO], 1u); break; } }
    }
    nloc = mine > 0u ? mine : 1u; nx = cnt > 0u ? cnt : 1u;
}
__device__ __forceinline__ void xcd_barrier(const XcdBarrier& b) {
    asm volatile("s_waitcnt vmcnt(0)" ::: "memory");
    __syncthreads();
    if (threadIdx.x == 0) {
        unsigned* bar = b.bar;
        __builtin_amdgcn_s_waitcnt(0);
        unsigned nloc = b.st[0], nx = b.st[1];
        if (nloc == 0u) { xcd_barrier_complete(bar, b.x, nloc, nx); b.st[0] = nloc; b.st[1] = nx; }
        const unsigned old = xb_add(&bar[XB_XSUB(b.x)], 1u);
        const unsigned gen = old / nloc;
        if (old + 1u == (gen + 1u) * nloc) {
            __builtin_amdgcn_fence(__ATOMIC_RELEASE, "agent");
            asm volatile("s_waitcnt vmcnt(0)" ::: "memory");
            const unsigned og = xb_add(&bar[XB_TOP], 1u);
            const unsigned tg = og / nx;
            if (og + 1u == (tg + 1u) * nx) xb_add(&bar[XB_TOPGEN], 1u);
            else XB_SPIN(xb_ld(&bar[XB_TOPGEN]) == tg, bar);
            __builtin_amdgcn_fence(__ATOMIC_ACQUIRE, "agent");
            xb_add(&bar[XB_XGEN(b.x)], 1u);
            asm volatile("s_waitcnt vmcnt(0)" ::: "memory");
        } else {
            XB_SPIN(xb_ld(&bar[XB_XGEN(b.x)]) == gen, bar);
            __builtin_amdgcn_fence(__ATOMIC_ACQUIRE, "agent");
            asm volatile("s_waitcnt vmcnt(0)" ::: "memory");
        }
    }
    __syncthreads();
}

struct TJob { const float* src; bf16* dst; const float* rs; int K, N, Npad, perm, batch; size_t sstr, dstr; int Ksrc; };
__device__ __forceinline__ void tt_load(const TJob& j, int it, int lane, f32x4 (&v)[16]) {
    const int tn = j.Npad / 64, per = tn * (j.K / 64), z = it / per, r = it % per, n0 = (r % tn) * 64, k0 = (r / tn) * 64;
    const float* src = j.src + z * j.sstr;
    const int n4 = (lane & 15) * 4, np = n0 + n4;
    int sc = np; if (j.perm == 1) sc = (np / 256) * 128 + (np % 128) + ((np % 256) / 128) * 1024;
#pragma unroll
    for (int i = 0; i < 16; ++i) { const int k = k0 + i * 4 + (lane >> 4); f32x4 t = {0.f, 0.f, 0.f, 0.f}; if (sc < j.N && k < j.Ksrc) { t = *(const f32x4*)(src + (size_t)k * j.N + sc); if (j.rs) t = t * j.rs[k]; } v[i] = t; }
}
__device__ __forceinline__ void tt_store(const TJob& j, int it, int lane, const f32x4 (&v)[16], float* wt) {
    const int tn = j.Npad / 64, per = tn * (j.K / 64), z = it / per, r = it % per, n0 = (r % tn) * 64, k0 = (r / tn) * 64;
    bf16* dst = j.dst + z * j.dstr + ((((size_t)(n0 >> 8) * (j.K >> 6) + (k0 >> 6)) << 14) + (((n0 & 255) + lane) << 6));
    const int n4 = (lane & 15) * 4;
#pragma unroll
    for (int half = 0; half < 2; ++half) {
#pragma unroll
        for (int i = 0; i < 8; ++i) *(f32x4*)(wt + (i * 4 + (lane >> 4)) * 68 + n4) = v[half * 8 + i];
        asm volatile("s_waitcnt lgkmcnt(0)" ::: "memory");
#pragma unroll
        for (int kc = 0; kc < 4; ++kc) { float f[8];
#pragma unroll
            for (int q = 0; q < 8; ++q) f[q] = wt[(kc * 8 + q) * 68 + lane];
            u32x4 w; w.x = f2bf(f[0]) | ((unsigned)f2bf(f[1]) << 16); w.y = f2bf(f[2]) | ((unsigned)f2bf(f[3]) << 16); w.z = f2bf(f[4]) | ((unsigned)f2bf(f[5]) << 16); w.w = f2bf(f[6]) | ((unsigned)f2bf(f[7]) << 16);
            *(u32x4*)(dst + half * 32 + kc * 8) = w; }
        asm volatile("s_waitcnt lgkmcnt(0)" ::: "memory");
    }
}
__device__ __forceinline__ void run_tjob(const TJob& j, float* wt, int& base, int NW, int gw, int lane) {
    const int total = (j.Npad / 64) * (j.K / 64) * j.batch;
    int it = (gw - base % NW + NW) % NW;
    if (it < total) {
        f32x4 cur[16], nxt[16];
        tt_load(j, it, lane, cur);
        for (; it < total; it += NW) {
            const bool more = it + NW < total;
            if (more) tt_load(j, it + NW, lane, nxt);
            tt_store(j, it, lane, cur, wt);
            if (more) {
#pragma unroll
                for (int i = 0; i < 16; ++i) cur[i] = nxt[i]; }
        }
    }
    base += total;
}
__device__ __forceinline__ void bt_load(const float* __restrict__ src, int N, int perm, int it, int ntn, f32x4 (&v)[8]) {
    const int wid = threadIdx.x >> 6, lane = threadIdx.x & 63;
    const int per = 16 * ntn, z = it / per, r = it % per, kt = r / ntn, nt = r % ntn;
    const int np = nt * 256 + lane * 4;
    const int sc = perm ? (nt * 128 + (lane & 31) * 4 + (lane >> 5) * 1024) : np;
    const float* p = src + (size_t)z * 1024 * N + (size_t)(kt * 64 + wid * 8) * N + sc;
#pragma unroll
    for (int i = 0; i < 8; ++i) v[i] = *(const f32x4*)(p + (size_t)i * N);
}
__device__ __forceinline__ void ph_big_transpose(const float* __restrict__ src, int N, int perm, int batch, bf16* __restrict__ dst, float* tile  , int G) {
    const int tid = threadIdx.x, wid = tid >> 6, lane = tid & 63, ntn = N / 256, total = batch * 16 * ntn;
    int it = (int)blockIdx.x;
    if (it >= total) return;
    f32x4 cur[8], nxt[8], nx2[8];
    bt_load(src, N, perm, it, ntn, cur);
    if (it + G < total) bt_load(src, N, perm, it + G, ntn, nxt);
    for (; it < total; it += G) {
        const bool more = it + G < total, more2 = it + 2 * G < total;
        if (more2) bt_load(src, N, perm, it + 2 * G, ntn, nx2);
        __syncthreads();
#pragma unroll
        for (int i = 0; i < 8; ++i) { float* t = tile + (wid * 8 + i) * 257 + lane * 4; t[0] = cur[i][0]; t[1] = cur[i][1]; t[2] = cur[i][2]; t[3] = cur[i][3]; }
        __syncthreads();
        const int per = 16 * ntn, z = it / per, r = it % per, kt = r / ntn, nt = r % ntn;
        bf16* d = dst + (size_t)z * N * 1024 + (((size_t)nt * 16 + kt) << 14);
        const int kc = lane & 7;
#pragma unroll
        for (int pss = 0; pss < 4; ++pss) {
            const int n = wid * 32 + pss * 8 + (lane >> 3); float f[8];
#pragma unroll
            for (int j = 0; j < 8; ++j) f[j] = tile[(kc * 8 + j) * 257 + n];
            u32x4 w; w.x = g8_cvt_pk(f[0], f[1]); w.y = g8_cvt_pk(f[2], f[3]); w.z = g8_cvt_pk(f[4], f[5]); w.w = g8_cvt_pk(f[6], f[7]);
            *(u32x4*)(d + n * 64 + kc * 8) = w;
        }
        if (more) {
#pragma unroll
            for (int i = 0; i < 8; ++i) { cur[i] = nxt[i]; nxt[i] = nx2[i]; } }
    }
    __syncthreads();
}
#ifndef PROBE_SUB
#define PROBE_SUB 0
#define PROBE_SUBDK 0
#endif
#define PSEC(k) do { if (PROBE_SUB == (k)) { const unsigned t_ = (unsigned)__builtin_readcyclecounter(); sacc += t_ - pt0; } if (PROBE_SUB >= 10) pt0 = (unsigned)__builtin_readcyclecounter(); } while (0)
__device__ __forceinline__ void ph_prologue(const Ptrs& P, unsigned char* lds, unsigned& sacc) {
    unsigned char* ws = P.ws; const int G = gridDim.x; int base = 0; unsigned pt0 = 0u; PSEC(-1);
    const int wave = threadIdx.x >> 6, lane = threadIdx.x & 63, NW = G * 8, gw = (int)blockIdx.x + G * wave;
    float* wt = (float*)lds + wave * (32 * 68);
    {
        float* s = (float*)lds + 8 * 32 * 68;
        float* part = s + 5 * 1024;
        for (int it = (int)blockIdx.x; it < 2 * 128; it += G) {
            const int layer = it / 128, cb = (it % 128) * 48;
            __syncthreads();
            for (int i = threadIdx.x; i < 5 * 1024; i += NT) { const int r = i / 1024, k = i % 1024; const float c = r < 4 ? P.in[1][r * 1024 + k] : P.in[3][k]; s[i] = c / (1.f + __expf(-c)); }
            __syncthreads();
            const int kr = lane >> 4, c4 = (lane & 15) < 12 ? (lane & 15) * 4 : 44;
            const float* w = P.in[4] + (size_t)layer * 1024 * 6144 + (size_t)(wave * 128 + kr) * 6144 + cb + c4;
            float a[5][4];
#pragma unroll
            for (int r = 0; r < 5; ++r) { a[r][0] = 0.f; a[r][1] = 0.f; a[r][2] = 0.f; a[r][3] = 0.f; }
#pragma unroll 1
            for (int hh = 0; hh < 2; ++hh) {
                f32x4 wv[16];
#pragma unroll
                for (int i = 0; i < 16; ++i) wv[i] = *(const f32x4*)(w + (size_t)(hh * 64 + i * 4) * 6144);
#pragma unroll
                for (int i = 0; i < 16; ++i) { const int k = wave * 128 + hh * 64 + i * 4 + kr;
#pragma unroll
                    for (int r = 0; r < 5; ++r) { const float sv = s[r * 1024 + k]; a[r][0] += sv * wv[i][0]; a[r][1] += sv * wv[i][1]; a[r][2] += sv * wv[i][2]; a[r][3] += sv * wv[i][3]; } }
            }
#pragma unroll
            for (int r = 0; r < 5; ++r)
#pragma unroll
                for (int e = 0; e < 4; ++e) { float t = a[r][e]; t += __shfl_xor(t, 16); t += __shfl_xor(t, 32); if (lane < 12) part[(wave * 5 + r) * 64 + c4 + e] = t; }
            __syncthreads();
            if (threadIdx.x < 320 && (threadIdx.x & 63) < 48) { const int r = threadIdx.x / 64, c = threadIdx.x % 64; float t = P.in[5][layer * 6144 + cb + c];
#pragma unroll
                for (int wv = 0; wv < 8; ++wv) t += part[(wv * 5 + r) * 64 + c];
                ((float*)(ws + WS_MOD))[(size_t)(layer * 5 + r) * 6144 + cb + c] = t; }
        }
        __syncthreads();
    }
    PSEC(10);
    TJob j;
    ph_big_transpose(P.in[34], 2048, 1, 2 * NE, (bf16*)(ws + WS_WGU), (float*)lds, G);
    PSEC(11);
    ph_big_transpose(P.in[36], 1024, 0, 2 * NE, (bf16*)(ws + WS_WDN), (float*)lds, G);
    PSEC(12);
    j = TJob{P.in[8], (bf16*)(ws + WS_WEVIN), nullptr, 1024, EVEN_IN, EVEN_IN_P, 0, 1, 0, 0, 1024}; run_tjob(j, wt, base, NW, gw, lane);
    j = TJob{P.in[9], (bf16*)(ws + WS_WEVOUT), nullptr, 1024, 1024, 1024, 0, 1, 0, 0, 1024}; run_tjob(j, wt, base, NW, gw, lane);
    j = TJob{P.in[18], (bf16*)(ws + WS_WUQ), P.in[17], 384, 768, 768, 0, 1, 0, 0, 384}; run_tjob(j, wt, base, NW, gw, lane);
    j = TJob{P.in[20], (bf16*)(ws + WS_WUKV), P.in[19], 384, 1024, 1024, 0, 1, 0, 0, 256}; run_tjob(j, wt, base, NW, gw, lane);
    j = TJob{P.in[12], (bf16*)(ws + WS_WLRU), nullptr, 64, 64, 64, 0, 8, 4096, 4096, 64}; run_tjob(j, wt, base, NW, gw, lane);
    j = TJob{P.in[14], (bf16*)(ws + WS_WLRU) + 8 * 4096, nullptr, 64, 64, 64, 0, 8, 4096, 4096, 64}; run_tjob(j, wt, base, NW, gw, lane);
    j = TJob{P.in[12] + 8 * 4096, (bf16*)(ws + WS_WLRU) + 16 * 4096, nullptr, 64, 64, 64, 0, 8, 4096, 4096, 64}; run_tjob(j, wt, base, NW, gw, lane);
    j = TJob{P.in[14] + 8 * 4096, (bf16*)(ws + WS_WLRU) + 24 * 4096, nullptr, 64, 64, 64, 0, 8, 4096, 4096, 64}; run_tjob(j, wt, base, NW, gw, lane);
    j = TJob{P.in[23], (bf16*)(ws + WS_WODIN), nullptr, 1024, ODD_IN, ODD_IN, 0, 1, 0, 0, 1024}; run_tjob(j, wt, base, NW, gw, lane);
    j = TJob{P.in[24], (bf16*)(ws + WS_WODOUT), nullptr, 1024, 1024, 1024, 0, 1, 0, 0, 1024}; run_tjob(j, wt, base, NW, gw, lane);
    __syncthreads();
    PSEC(13);
    {
        float* rc = (float*)(ws + WS_ROPE); float* rs = rc + SEQ * 64;
        for (int i = (int)blockIdx.x * NT + threadIdx.x; i < SEQ * 64; i += G * NT) {
            const int t = i >> 6, e = i & 63, q = e & 15;
            const float f = exp2f(-(float)(2 * q) / 32.f * 13.287712379549449f);
            const float ang = (float)((e >> 5) ? (t % GRID_W) : (t / GRID_W)) * f;
            float sv, cv; sincosf(ang, &sv, &cv); rc[i] = cv; rs[i] = sv;
        }
    }
    if ((int)blockIdx.x == G - 2) { float* c8t = (float*)(ws + WS_SCAL) + 1024; for (int i = threadIdx.x; i < 2 * LRU_W; i += NT) c8t[i] = 8.f * LOG2E * log1pf(__expf(-P.in[16][i])); }
    if ((int)blockIdx.x == G - 1 && threadIdx.x == 0) {
        float* sc = (float*)(ws + WS_SCAL);
        float mq = 0, mk = 0;
        for (int i = 0; i < 192; ++i) { mq = fmaxf(mq, fabsf(P.in[21][i])); mk = fmaxf(mk, fabsf(P.in[22][i])); }
        sc[0] = sqrtf(192.f) * mq * mk * LOG2E;
        mq = 0; mk = 0;
        for (int i = 0; i < 64; ++i) { mq = fmaxf(mq, fabsf(P.in[25][i])); mk = fmaxf(mk, fabsf(P.in[26][i])); }
        sc[1] = 8.f * mq * mk * LOG2E;
        float s1 = 0, s2 = 0;
        for (int i = 0; i < 64; ++i) { s1 += P.in[27][i] * P.in[28][i]; s2 += P.in[29][i] * P.in[30][i]; }
        const float lam_init = 0.8f - 0.6f * expf(-0.3f * 1.f);
        sc[2] = expf(s1) - expf(s2) + lam_init;
        sc[3] = 1.f - lam_init;
    }
}

__device__ __forceinline__ void norm_mod_store(const Ptrs& P, float (&v)[16], int lane, int u, int layer, int which) {
    const float* g = (which == 0 ? P.in[6] : P.in[7]) + layer * D;
    const float* md = mod_row(P, layer, u) + (which == 0 ? 0 : 3 * D);
    f32x4 gv[4], scv[4], shv[4];
#pragma unroll
    for (int j = 0; j < 4; ++j) { const int c = j * 256 + lane * 4; gv[j] = *(const f32x4*)(g + c); scv[j] = *(const f32x4*)(md + D + c); shv[j] = *(const f32x4*)(md + c); }
    float ss = 0.f;
#pragma unroll
    for (int i = 0; i < 16; ++i) ss += v[i] * v[i];
    const float rstd = rsqrtf(wave_sum(ss) * (1.f / D) + EPS);
    bf16* h = (bf16*)(P.ws + WS_H) + (size_t)u * D;
#pragma unroll
    for (int j = 0; j < 4; ++j) {
        const int c = j * 256 + lane * 4;
#pragma unroll
        for (int e = 0; e < 4; ++e) v[4 * j + e] = v[4 * j + e] * rstd * gv[j][e] * (1.f + scv[j][e]) + shv[j][e];
        const unsigned lo = f2bf(v[4 * j]) | ((unsigned)f2bf(v[4 * j + 1]) << 16), hi = f2bf(v[4 * j + 2]) | ((unsigned)f2bf(v[4 * j + 3]) << 16);
        *(uint2*)(h + c) = make_uint2(lo, hi);
    }
}
struct RowIn { f32x4 xf[4]; uint2 xb[4]; uint2 y[4][4]; };
__device__ __forceinline__ RowIn rows_load(const Ptrs& P, int layer, int mode, int u, int lane) {
    RowIn r{};
    if (mode == 0) { const float* x = res_in_row(P, layer, u);
#pragma unroll
        for (int j = 0; j < 4; ++j) r.xf[j] = *(const f32x4*)(x + j * 256 + lane * 4); }
    else { const bf16* x = (const bf16*)(P.ws + WS_XB) + (size_t)u * D; const bf16* y = (const bf16*)(P.ws + WS_Y) + (size_t)u * 4 * 1024;
#pragma unroll
        for (int j = 0; j < 4; ++j) { const int c = j * 256 + lane * 4; r.xb[j] = *(const uint2*)(x + c);
#pragma unroll
            for (int k = 0; k < 4; ++k) r.y[k][j] = *(const uint2*)(y + k * 1024 + c); } }
    return r;
}
__device__ __forceinline__ void ph_rows(const Ptrs& P, int layer, int mode, int latent_only, int next_norm) {
    const int wave = threadIdx.x >> 6, lane = threadIdx.x & 63, G = gridDim.x;
    const int NR = latent_only ? NB * SEQ : R;
#define ROW_U(q) (latent_only ? ((q) / SEQ) * SU + CTX + (q) % SEQ : (q))
    int q = (int)blockIdx.x * 8 + wave;
    if (q >= NR) return;
    RowIn cur = rows_load(P, layer, mode, ROW_U(q), lane);
    for (; q < NR; q += G * 8) {
        const int u = ROW_U(q), qn = q + G * 8;
        RowIn nxt = cur;
        if (qn < NR) nxt = rows_load(P, layer, mode, ROW_U(qn), lane);
        float v[16];
        if (mode == 0) {
#pragma unroll
            for (int j = 0; j < 4; ++j) { v[4 * j] = cur.xf[j][0]; v[4 * j + 1] = cur.xf[j][1]; v[4 * j + 2] = cur.xf[j][2]; v[4 * j + 3] = cur.xf[j][3]; }
            norm_mod_store(P, v, lane, u, layer, 0);
        } else {
            const float* g2 = mod_row(P, layer, u) + 5 * D; float* xo = res_out_row(P, u); bf16* xbo = (bf16*)(P.ws + WS_XB) + (size_t)u * D;
            f32x4 gv[4];
#pragma unroll
            for (int j = 0; j < 4; ++j) gv[j] = *(const f32x4*)(g2 + j * 256 + lane * 4);
#pragma unroll
            for (int j = 0; j < 4; ++j) { const int c = j * 256 + lane * 4; f32x4 o;
                const uint2 t = cur.xb[j];
                v[4 * j] = __uint_as_float(t.x << 16); v[4 * j + 1] = __uint_as_float(t.x & 0xffff0000u); v[4 * j + 2] = __uint_as_float(t.y << 16); v[4 * j + 3] = __uint_as_float(t.y & 0xffff0000u);
                float f[4] = {0.f, 0.f, 0.f, 0.f};
#pragma unroll
                for (int k = 0; k < 4; ++k) { const uint2 w = cur.y[k][j]; f[0] += __uint_as_float(w.x << 16); f[1] += __uint_as_float(w.x & 0xffff0000u); f[2] += __uint_as_float(w.y << 16); f[3] += __uint_as_float(w.y & 0xffff0000u); }
#pragma unroll
                for (int e = 0; e < 4; ++e) { v[4 * j + e] += gv[j][e] * f[e]; o[e] = v[4 * j + e]; }
                if (next_norm) { uint2 w; w.x = g8_cvt_pk(o[0], o[1]); w.y = g8_cvt_pk(o[2], o[3]); *(uint2*)(xbo + c) = w; }
                else *(f32x4*)(xo + c) = o; }
            if (next_norm) norm_mod_store(P, v, lane, u, layer + 1, 0);
        }
        cur = nxt;
    }
#undef ROW_U
}

namespace g8 {
typedef short bf16x8 __attribute__((ext_vector_type(8)));
constexpr int BM = 256, BK = 64, HALF = 128, HTB = HALF * BK * 2, STAGE_BYTES = 8 * HTB, NXCD = 8, WGM = 8;
__host__ __device__ __forceinline__ int lds_byte(int r, int c) { const int st = (r >> 4) * 2 + (c >> 5), rr = r & 15, cc = c & 31, ob = rr * 64 + cc * 2; return st * 1024 + (ob ^ (((ob >> 9) & 1) << 5)); }
__host__ __device__ __forceinline__ void stage_rc(int b, int& R, int& C) { const int st = b / 1024, sb = b % 1024, swz = sb ^ (((sb >> 9) & 1) << 5); R = (st >> 1) * 16 + swz / 64; C = (st & 1) * 32 + (swz % 64) / 2; }
__host__ __device__ __forceinline__ int perm32(int rho) { const int n = rho >> 4, i = rho & 15; return 8 * (i >> 2) + 4 * n + (i & 3); }
struct Unit { const char* a; const char* b; int pm, pn, e, aux, cnt; };
__device__ __forceinline__ unsigned cvt_pk_bf16(float lo, float hi) { unsigned r; asm volatile("v_cvt_pk_bf16_f32 %0, %1, %2" : "=v"(r) : "v"(lo), "v"(hi)); return r; }

template <class Epi, class Sched, bool GATHER, bool ALIGN_EPI, bool PFB = false>
__device__ __forceinline__ void gemm_phase(LAS unsigned char* lds, const int lda, const int K, const Sched& S, const Epi& E) {
    const int tid = threadIdx.x, wid = __builtin_amdgcn_readfirstlane(tid >> 6), lane = tid & 63, wr = wid >> 2, wc = wid & 3, fr = lane & 15, fq = lane >> 4;
    const int nt = K / BK;
    int Rr[2], Cc[2]; unsigned voffB[2];
#pragma unroll
    for (int i = 0; i < 2; ++i) { stage_rc(tid * 16 + i * 8192, Rr[i], Cc[i]); const int Rb = Epi::PERM ? ((Rr[i] & ~31) + perm32(Rr[i] & 31)) : Rr[i]; voffB[i] = (unsigned)(Rb * BK + Cc[i]) * 2u; }
    const size_t kstep = (size_t)(BK * 2), kstepB = (size_t)BM * BK * 2;
    const size_t hstepB = (size_t)HALF * BK * 2;
    const unsigned ldsw = (unsigned)wid * 1024u;
    const int aoff = lds_byte(wr * 64 + fr, fq * 8), boff = lds_byte(wc * 32 + fr, fq * 8);
#define G8_SA(b, h) (((b) * 2 + (h)) * HTB)
#define G8_SB(b, h) ((4 + (b) * 2 + (h)) * HTB)
#define G8_STAGE(bufoff, gbase, v0, v1) do { \
        __builtin_amdgcn_global_load_lds((const unsigned*)((const char*)(gbase) + (v0)), (LAS unsigned*)(lds + (bufoff) + ldsw), 16, 0, 0); \
        __builtin_amdgcn_global_load_lds((const unsigned*)((const char*)(gbase) + (v1)), (LAS unsigned*)(lds + (bufoff) + ldsw + 8192), 16, 0, 0); } while (0)
#define G8_LDA(dst, b, h) do { _Pragma("unroll") for (int m = 0; m < 4; ++m) _Pragma("unroll") for (int k = 0; k < 2; ++k) dst[m][k] = *(const LAS bf16x8*)(lds + G8_SA(b, h) + aoff + m * 2048 + k * 1024); } while (0)
#define G8_LDB(dst, b, h) do { _Pragma("unroll") for (int n = 0; n < 2; ++n) _Pragma("unroll") for (int k = 0; k < 2; ++k) dst[n][k] = *(const LAS bf16x8*)(lds + G8_SB(b, h) + boff + n * 2048 + k * 1024); } while (0)
#define G8_MMA(ai, bj, At, Bt) do { __builtin_amdgcn_s_setprio(1); _Pragma("unroll") for (int m = 0; m < 4; ++m) _Pragma("unroll") for (int n = 0; n < 2; ++n) _Pragma("unroll") for (int k = 0; k < 2; ++k) \
        acc[ai][bj][m][n] = __builtin_amdgcn_mfma_f32_16x16x32_bf16(Bt[n][k], At[m][k], acc[ai][bj][m][n], 0, 0, 0); __builtin_amdgcn_s_setprio(0); } while (0)
#define G8_WAIT_V(n) asm volatile("s_waitcnt vmcnt(" #n ")" ::: "memory")
#define G8_WAIT_L(n) asm volatile("s_waitcnt lgkmcnt(" #n ")" ::: "memory")
#define G8_BAR __builtin_amdgcn_s_barrier()
#define G8_SCHED __builtin_amdgcn_sched_barrier(0)
    Unit cur, nxt; int ui = 0;
    if (!S.next(0, cur)) return;
    unsigned vA0[2], vA1[2], nA0[2], nA1[2];
#pragma unroll
    for (int i = 0; i < 2; ++i) {
        if (GATHER) { vA0[i] = S.arow_off(cur, Rr[i]) + (unsigned)Cc[i] * 2u; vA1[i] = S.arow_off(cur, HALF + Rr[i]) + (unsigned)Cc[i] * 2u; }
        else { vA0[i] = (unsigned)(Rr[i] * lda + Cc[i]) * 2u; vA1[i] = (unsigned)((HALF + Rr[i]) * lda + Cc[i]) * 2u; }
        nA0[i] = vA0[i]; nA1[i] = vA1[i];
    }
    f32x4 acc[2][2][4][2];
#pragma unroll
    for (int a = 0; a < 2; ++a)
#pragma unroll
        for (int b = 0; b < 2; ++b)
#pragma unroll
            for (int m = 0; m < 4; ++m)
#pragma unroll
                for (int n = 0; n < 2; ++n) acc[a][b][m][n] = (f32x4){0.f, 0.f, 0.f, 0.f};
    bf16x8 At[4][2], B0[2][2], B1[2][2];
    const char* cA = cur.a; const char* cB = cur.b;
    G8_STAGE(G8_SB(0, 0), cB, voffB[0], voffB[1]); G8_STAGE(G8_SB(0, 1), cB + hstepB, voffB[0], voffB[1]); G8_STAGE(G8_SA(0, 0), cA, vA0[0], vA0[1]); G8_STAGE(G8_SA(0, 1), cA, vA1[0], vA1[1]);
    if (wr == 1) G8_BAR;
    G8_WAIT_V(2); G8_BAR;
    G8_STAGE(G8_SB(1, 0), cB + kstepB, voffB[0], voffB[1]); G8_STAGE(G8_SA(1, 0), cA + kstep, vA0[0], vA0[1]); G8_STAGE(G8_SB(1, 1), cB + hstepB + kstepB, voffB[0], voffB[1]);
    G8_WAIT_V(6); G8_BAR;
    for (;;) {
        const bool has_next = S.next(ui + 1, nxt);
        const char* nA = has_next ? nxt.a : cA; const char* nB = has_next ? nxt.b : cB;
        unsigned pf_dummy = 0u;
        if (PFB && has_next && nB != cB) {
            const char* pb = nB + (size_t)tid * 128;
#pragma unroll
            for (int i = 0; i < 8; ++i) { if (i * NT * 128 < 256 * K * 2) asm volatile("global_load_dword %0, %1, off" : "+v"(pf_dummy) : "v"(pb + (size_t)i * NT * 128) : "memory"); }
        }
        if (GATHER) {
#pragma unroll
            for (int i = 0; i < 2; ++i) { if (has_next) { nA0[i] = S.arow_off(nxt, Rr[i]) + (unsigned)Cc[i] * 2u; nA1[i] = S.arow_off(nxt, HALF + Rr[i]) + (unsigned)Cc[i] * 2u; } else { nA0[i] = vA0[i]; nA1[i] = vA1[i]; } }
        }
#pragma unroll 1
        for (int t = 0; t < nt; t += 2) {
            const bool last = (t == nt - 2);
            const char* a1 = cA + (size_t)(t + 1) * kstep;
            const char* a2 = last ? nA : cA + (size_t)(t + 2) * kstep; const char* b2 = last ? nB : cB + (size_t)(t + 2) * kstepB;
            const char* a3 = a2 + kstep; const char* b3 = b2 + kstepB;
            unsigned x00 = vA0[0], x01 = vA0[1], x10 = vA1[0], x11 = vA1[1];
            if (GATHER) { x00 = last ? nA0[0] : vA0[0]; x01 = last ? nA0[1] : vA0[1]; x10 = last ? nA1[0] : vA1[0]; x11 = last ? nA1[1] : vA1[1]; }
            G8_LDB(B0, 0, 0); G8_LDB(B1, 0, 1); G8_SCHED; G8_LDA(At, 0, 0); G8_STAGE(G8_SA(1, 1), a1, vA1[0], vA1[1]);
            G8_WAIT_V(8); if (PFB) asm volatile("" : "+v"(pf_dummy)); G8_WAIT_L(0); G8_BAR; G8_MMA(0, 0, At, B0); G8_MMA(0, 1, At, B1); G8_BAR; G8_SCHED;
            G8_LDA(At, 0, 1); G8_STAGE(G8_SB(0, 0), b2, voffB[0], voffB[1]); G8_STAGE(G8_SB(0, 1), b2 + hstepB, voffB[0], voffB[1]); G8_STAGE(G8_SA(0, 0), a2, x00, x01);
            G8_WAIT_V(8); G8_WAIT_L(0); G8_BAR; G8_MMA(1, 0, At, B0); G8_MMA(1, 1, At, B1); G8_BAR; G8_SCHED;
            G8_LDB(B0, 1, 0); G8_LDB(B1, 1, 1); G8_SCHED; G8_LDA(At, 1, 0); G8_STAGE(G8_SA(0, 1), a2, x10, x11);
            G8_WAIT_V(8); G8_WAIT_L(0); G8_BAR; G8_MMA(0, 0, At, B0); G8_MMA(0, 1, At, B1); G8_BAR; G8_SCHED;
            G8_LDA(At, 1, 1); G8_STAGE(G8_SB(1, 0), b3, voffB[0], voffB[1]); G8_STAGE(G8_SB(1, 1), b3 + hstepB, voffB[0], voffB[1]); G8_STAGE(G8_SA(1, 0), a3, x00, x01);
            G8_WAIT_V(8); G8_WAIT_L(0); G8_BAR; G8_MMA(1, 0, At, B0); G8_MMA(1, 1, At, B1); G8_BAR; G8_SCHED;
        }
        if constexpr (ALIGN_EPI) { if (wr == 0) G8_BAR; }
        E(acc, cur, wr, wc, fr, fq);
        if (!has_next) break;
#pragma unroll
        for (int a = 0; a < 2; ++a)
#pragma unroll
            for (int b = 0; b < 2; ++b)
#pragma unroll
                for (int m = 0; m < 4; ++m)
#pragma unroll
                    for (int n = 0; n < 2; ++n) acc[a][b][m][n] = (f32x4){0.f, 0.f, 0.f, 0.f};
        cur = nxt; cA = nA; cB = nB; ++ui;
        if (GATHER) {
#pragma unroll
            for (int i = 0; i < 2; ++i) { vA0[i] = nA0[i]; vA1[i] = nA1[i]; }
        }
        if constexpr (ALIGN_EPI) { if (wr == 1) G8_BAR; }
    }
    G8_WAIT_V(0);
    if constexpr (!ALIGN_EPI) { if (wr == 0) G8_BAR; }
    G8_BAR;
#undef G8_SA
#undef G8_SB
#undef G8_STAGE
#undef G8_LDA
#undef G8_LDB
#undef G8_MMA
#undef G8_WAIT_V
#undef G8_WAIT_L
#undef G8_BAR
#undef G8_SCHED
}

struct DenseOrder {
    const char* A; const char* Bt; int lda, K, nM, nN, nwg, G, c, skip_ctx;
    __device__ __forceinline__ void init(const bf16* A_, int lda_, const bf16* Bt_, int K_, int M, int N, int G_, int c_, int skip_ctx_) {
        A = (const char*)A_; Bt = (const char*)Bt_; lda = lda_; K = K_; skip_ctx = skip_ctx_; nM = M / BM; if (skip_ctx) nM = nM / 17 * 16; nN = N / BM; nwg = nM * nN; G = G_; c = c_; }
    __device__ __forceinline__ bool next(int i, Unit& u) const {
        const long L = (long)i * G + c; if (L >= nwg) return false;
        int wgid = (int)L; { const int q = nwg / NXCD, r = nwg % NXCD, xcd = wgid % NXCD, off = wgid / NXCD; wgid = (xcd < r ? xcd * (q + 1) : r * (q + 1) + (xcd - r) * q) + off; }
        const int nig = WGM * nN, gid = wgid / nig, fm = gid * WGM, gsz = (nM - fm) < WGM ? (nM - fm) : WGM;
        int pm = fm + ((wgid % nig) % gsz); const int pn = (wgid % nig) / gsz;
        if (skip_ctx) pm = (pm / 16) * 17 + 1 + (pm % 16);
        u.pm = pm; u.pn = pn; u.e = 0; u.aux = 0; u.cnt = 0;
        u.a = A + (size_t)pm * BM * lda * 2; u.b = Bt + (size_t)pn * BM * K * 2; return true;
    }
    __device__ __forceinline__ unsigned arow_off(const Unit&, int) const { return 0u; }
};
}
namespace g8 {
struct MoeOrder {
    const char* Abase; const char* Bbase; const int* rowtab; size_t bstride; int nN, K, G, vcu, gather;
    LAS int* tab;
    __device__ __forceinline__ void init(const unsigned* cnt, LAS int* tab_) {
        tab = tab_;
        __syncthreads();
        if (threadIdx.x < 64) {
            const int lane = threadIdx.x, me = lane & 31;
            const int c = (int)cnt[me];
            int run = 0, ab = 0, ms = 0, mab = 0;
            for (int e = 0; e < NE; ++e) { const int ce = __builtin_amdgcn_readlane(c, e), mt = (ce + 255) >> 8; if (me == e) { ms = run; mab = ab; } run += mt * nN; ab += mt << 8; }
            if (lane < 32) { tab[lane] = ms; tab[32 + lane] = c; tab[64 + lane] = mab; }
            if (lane == 0) tab[96] = run;
        }
        __syncthreads();
    }
    __device__ __forceinline__ bool next(int i, Unit& u) const {
        const int L = i * G + vcu;
        if (L >= tab[96]) return false;
        const int me = threadIdx.x & 31;
        const int st_l = tab[me], c_l = tab[32 + me];
        const unsigned long long m = __ballot(L >= st_l && L < st_l + ((c_l + 255) >> 8) * nN);
        const int e = __builtin_amdgcn_readfirstlane(__builtin_ctzll(m) & 31);
        const int st = tab[e], c = tab[32 + e], ab = tab[64 + e];
        const int l = L - st;
        const int sh = nN == 8 ? 3 : 2;
        u.e = e; u.pm = l >> sh; u.pn = l & (nN - 1); u.aux = ab; u.cnt = c;
        u.a = gather ? Abase : Abase + (size_t)(ab + u.pm * 256) * 1024 * 2; u.b = Bbase + (size_t)e * bstride + (size_t)u.pn * 256 * K * 2; return true;
    }
    __device__ __forceinline__ unsigned arow_off(const Unit& u, int r) const { int rr = u.pm * 256 + r; rr = rr < u.cnt ? rr : u.cnt - 1; return (unsigned)rowtab[(size_t)u.e * R + rr] * (unsigned)(D * 2); }
};
struct UpOrder {
    const char* Z; const char* Wq; const char* Wkv; int G, c;
    __device__ __forceinline__ bool next(int i, Unit& u) const {
        const int L = i * G + c; if (L >= 476) return false;
        const int kv = L >= 204, l = kv ? L - 204 : L, pn = l / 68, pm = l % 68;
        u.pm = pm; u.pn = kv ? 3 + pn : pn; u.e = 0; u.aux = kv; u.cnt = 0;
        u.a = Z + ((size_t)pm * BM * EVEN_IN_P + 1024 + kv * 384) * 2; u.b = Wq + (size_t)u.pn * BM * 384 * 2; return true;
    }
    __device__ __forceinline__ unsigned arow_off(const Unit&, int) const { return 0u; }
};
struct EpiStoreBf16 {
    static constexpr bool PERM = true; bf16* C; int ldc;
    __device__ __forceinline__ void operator()(const f32x4 (&acc)[2][2][4][2], const Unit& u, int wr, int wc, int fr, int fq) const {
        const int row0 = u.pm * BM + wr * 64 + fr, col0 = u.pn * BM + wc * 32 + 8 * fq;
#pragma unroll
        for (int ai = 0; ai < 2; ++ai)
#pragma unroll
            for (int m = 0; m < 4; ++m) { bf16* rowp = C + (size_t)(row0 + ai * HALF + m * 16) * ldc + col0;
#pragma unroll
                for (int bj = 0; bj < 2; ++bj) { const f32x4 v0 = acc[ai][bj][m][0], v1 = acc[ai][bj][m][1];
                    u32x4 w; w.x = cvt_pk_bf16(v0[0], v0[1]); w.y = cvt_pk_bf16(v0[2], v0[3]); w.z = cvt_pk_bf16(v1[0], v1[1]); w.w = cvt_pk_bf16(v1[2], v1[3]);
                    *(u32x4*)(rowp + bj * HALF) = w; } }
    }
};
struct EpiDiffIn {
    static constexpr bool PERM = true; bf16* C; const float* qn; const float* kn; const float* rc; const float* rs; LAS float* xch  ;
    __device__ __forceinline__ void operator()(const f32x4 (&acc)[2][2][4][2], const Unit& u, int wr, int wc, int fr, int fq) const {
        const int row0 = u.pm * BM + wr * 64 + fr, col0 = u.pn * BM + wc * 32 + 8 * fq, wid = wr * 4 + wc;
        const bool isv = u.pn >= 8;
        float rstd[2][4][2];
#pragma unroll
        for (int ai = 0; ai < 2; ++ai)
#pragma unroll
            for (int m = 0; m < 4; ++m)
#pragma unroll
                for (int bj = 0; bj < 2; ++bj) { const f32x4 v0 = acc[ai][bj][m][0], v1 = acc[ai][bj][m][1];
                    float ss = v0[0] * v0[0] + v0[1] * v0[1] + v0[2] * v0[2] + v0[3] * v0[3] + v1[0] * v1[0] + v1[1] * v1[1] + v1[2] * v1[2] + v1[3] * v1[3];
                    ss += __shfl_xor(ss, 16); ss += __shfl_xor(ss, 32);
                    rstd[ai][m][bj] = ss;
                    if (fq == 0) xch[wid * 256 + ((ai * 4 + m) * 2 + bj) * 16 + fr] = ss; }
        asm volatile("s_waitcnt lgkmcnt(0)" ::: "memory"); __builtin_amdgcn_s_barrier(); asm volatile("" ::: "memory");
#pragma unroll
        for (int ai = 0; ai < 2; ++ai)
#pragma unroll
            for (int m = 0; m < 4; ++m)
#pragma unroll
                for (int bj = 0; bj < 2; ++bj) rstd[ai][m][bj] = rsqrtf((rstd[ai][m][bj] + xch[(wid ^ 1) * 256 + ((ai * 4 + m) * 2 + bj) * 16 + fr]) * (1.f / 64.f) + EPS);
        const int e0 = (wc & 1) * 32 + 8 * fq;
        const float* gn = u.pn < 4 ? qn : kn; const float qs = u.pn < 4 ? 0.125f * LOG2E : 1.f;
        f32x4 g0 = *(const f32x4*)(gn + e0), g1 = *(const f32x4*)(gn + e0 + 4);
        g0 = g0 * qs; g1 = g1 * qs;
        const float sgn = (fq & 2) ? 1.f : -1.f;
        const int jt = u.pm % 17; const bool latent = jt != 0;
#pragma unroll
        for (int ai = 0; ai < 2; ++ai)
#pragma unroll
            for (int m = 0; m < 4; ++m) { const int r = row0 + ai * HALF + m * 16; bf16* rowp = C + (size_t)r * ODD_IN + col0;
                f32x4 c0 = {1.f, 1.f, 1.f, 1.f}, c1 = c0, s0 = {0.f, 0.f, 0.f, 0.f}, s1 = s0;
                if (!isv && latent) { const int t = (jt - 1) * 256 + ai * HALF + wr * 64 + m * 16 + fr;
                    c0 = *(const f32x4*)(rc + t * 64 + e0); c1 = *(const f32x4*)(rc + t * 64 + e0 + 4); s0 = *(const f32x4*)(rs + t * 64 + e0); s1 = *(const f32x4*)(rs + t * 64 + e0 + 4); }
#pragma unroll
                for (int bj = 0; bj < 2; ++bj) { f32x4 v0 = acc[ai][bj][m][0], v1 = acc[ai][bj][m][1];
                    if (!isv) { const float rr = rstd[ai][m][bj]; v0 = v0 * rr * g0; v1 = v1 * rr * g1;
                        f32x4 o0, o1;
#pragma unroll
                        for (int j = 0; j < 4; ++j) { o0[j] = __shfl_xor(v0[j], 32); o1[j] = __shfl_xor(v1[j], 32); }
                        v0 = v0 * c0 + o0 * s0 * sgn; v1 = v1 * c1 + o1 * s1 * sgn; }
                    u32x4 w; w.x = cvt_pk_bf16(v0[0], v0[1]); w.y = cvt_pk_bf16(v0[2], v0[3]); w.z = cvt_pk_bf16(v1[0], v1[1]); w.w = cvt_pk_bf16(v1[2], v1[3]);
                    *(u32x4*)(rowp + bj * HALF) = w; } }
        asm volatile("s_waitcnt lgkmcnt(0)" ::: "memory"); __builtin_amdgcn_s_barrier(); asm volatile("" ::: "memory");
    }
};
struct EpiOut {
    static constexpr bool PERM = true; Ptrs P; int layer;
    __device__ __forceinline__ void operator()(const f32x4 (&acc)[2][2][4][2], const Unit& u, int wr, int wc, int fr, int fq) const {
        const int b = u.pm / 17, jt = u.pm % 17;
        const float* g1 = (const float*)(P.ws + WS_MOD) + (size_t)(layer * 5 + (jt == 0 ? 4 : b)) * 6144 + 2 * D;
        const float* in0 = jt == 0 ? P.in[2] + (size_t)(b * CTX) * D : P.in[0] + (size_t)(b * SEQ + (jt - 1) * 256) * D;
        bf16* xb0 = (bf16*)(P.ws + WS_XB) + (size_t)u.pm * BM * D;
        const int col0 = u.pn * BM + wc * 32 + 8 * fq;
        f32x4 gv[2][2];
#pragma unroll
        for (int bj = 0; bj < 2; ++bj)
#pragma unroll
            for (int n = 0; n < 2; ++n) gv[bj][n] = *(const f32x4*)(g1 + col0 + bj * HALF + 4 * n);
#pragma unroll
        for (int ai = 0; ai < 2; ++ai)
#pragma unroll
            for (int m = 0; m < 4; ++m) { const size_t off = (size_t)(ai * HALF + wr * 64 + m * 16 + fr) * D + col0;
#pragma unroll
                for (int bj = 0; bj < 2; ++bj) {
                    f32x4 x0, x1;
                    if (layer == 0) { x0 = *(const f32x4*)(in0 + off + bj * HALF); x1 = *(const f32x4*)(in0 + off + bj * HALF + 4); }
                    else { const u32x4 r = *(const u32x4*)(xb0 + off + bj * HALF);
                        x0 = (f32x4){__uint_as_float(r.x << 16), __uint_as_float(r.x & 0xffff0000u), __uint_as_float(r.y << 16), __uint_as_float(r.y & 0xffff0000u)};
                        x1 = (f32x4){__uint_as_float(r.z << 16), __uint_as_float(r.z & 0xffff0000u), __uint_as_float(r.w << 16), __uint_as_float(r.w & 0xffff0000u)}; }
                    const f32x4 v0 = x0 + gv[bj][0] * acc[ai][bj][m][0], v1 = x1 + gv[bj][1] * acc[ai][bj][m][1];
                    u32x4 w; w.x = cvt_pk_bf16(v0[0], v0[1]); w.y = cvt_pk_bf16(v0[2], v0[3]); w.z = cvt_pk_bf16(v1[0], v1[1]); w.w = cvt_pk_bf16(v1[2], v1[3]);
                    *(u32x4*)(xb0 + off + bj * HALF) = w; } }
    }
};
struct EpiMoe1 {
    static constexpr bool PERM = true; Ptrs P; int layer;
    __device__ __forceinline__ void operator()(const f32x4 (&acc)[2][2][4][2], const Unit& u, int wr, int wc, int fr, int fq) const {
        const float* bgu = P.in[35] + (size_t)(layer * NE + u.e) * 2048;
        const int cl = u.pn * 128 + wc * 32 + 8 * fq;
        f32x4 bg[2], bu[2];
#pragma unroll
        for (int n = 0; n < 2; ++n) { bg[n] = *(const f32x4*)(bgu + cl + 4 * n); bu[n] = *(const f32x4*)(bgu + 1024 + cl + 4 * n); }
        bf16* act = (bf16*)(P.ws + WS_ACT) + (size_t)(u.aux + u.pm * 256 + wr * 64 + fr) * 1024 + cl;
#pragma unroll
        for (int ai = 0; ai < 2; ++ai)
#pragma unroll
            for (int m = 0; m < 4; ++m) { float o[8];
#pragma unroll
                for (int n = 0; n < 2; ++n)
#pragma unroll
                    for (int j = 0; j < 4; ++j) { float g = acc[ai][0][m][n][j] + bg[n][j], uu = acc[ai][1][m][n][j] + bu[n][j];
                        g = fminf(g, 7.f); uu = fminf(fmaxf(uu, -7.f), 7.f);
                        const float sg = __builtin_amdgcn_rcpf(1.f + __expf(-1.702f * g)); o[n * 4 + j] = (uu + 1.f) * g * sg; }
                u32x4 w; w.x = cvt_pk_bf16(o[0], o[1]); w.y = cvt_pk_bf16(o[2], o[3]); w.z = cvt_pk_bf16(o[4], o[5]); w.w = cvt_pk_bf16(o[6], o[7]);
                *(u32x4*)(act + (size_t)(ai * HALF + m * 16) * 1024) = w; }
    }
};
struct EpiMoe2 {
    static constexpr bool PERM = true; Ptrs P; int layer;
    __device__ __forceinline__ void operator()(const f32x4 (&acc)[2][2][4][2], const Unit& u, int wr, int wc, int fr, int fq) const {
        const float* bd = P.in[37] + (size_t)(layer * NE + u.e) * 1024;
        const int col0 = u.pn * BM + wc * 32 + 8 * fq;
        f32x4 bv[2][2];
#pragma unroll
        for (int bj = 0; bj < 2; ++bj)
#pragma unroll
            for (int n = 0; n < 2; ++n) bv[bj][n] = *(const f32x4*)(bd + col0 + bj * HALF + 4 * n);
        const int* pair_of = (const int*)(P.ws + WS_PAIROF) + (size_t)u.e * R; const float* gate_of = (const float*)(P.ws + WS_GATEOF) + (size_t)u.e * R;
        bf16* Y = (bf16*)(P.ws + WS_Y);
        int pr[2][4]; float gwv[2][4];
#pragma unroll
        for (int ai = 0; ai < 2; ++ai)
#pragma unroll
            for (int m = 0; m < 4; ++m) { const int r = u.pm * 256 + ai * HALF + wr * 64 + m * 16 + fr, rc = r < u.cnt ? r : u.cnt - 1; pr[ai][m] = pair_of[rc]; gwv[ai][m] = gate_of[rc]; }
#pragma unroll
        for (int ai = 0; ai < 2; ++ai)
#pragma unroll
            for (int m = 0; m < 4; ++m) { const int r = u.pm * 256 + ai * HALF + wr * 64 + m * 16 + fr;
                if (r < u.cnt) { const float gw = gwv[ai][m]; bf16* rowp = Y + (size_t)pr[ai][m] * 1024 + col0;
#pragma unroll
                    for (int bj = 0; bj < 2; ++bj) { const f32x4 v0 = (acc[ai][bj][m][0] + bv[bj][0]) * gw, v1 = (acc[ai][bj][m][1] + bv[bj][1]) * gw;
                        u32x4 w; w.x = cvt_pk_bf16(v0[0], v0[1]); w.y = cvt_pk_bf16(v0[2], v0[3]); w.z = cvt_pk_bf16(v1[0], v1[1]); w.w = cvt_pk_bf16(v1[2], v1[3]);
                        *(u32x4*)(rowp + bj * HALF) = w; } } }
    }
};
}

__device__ __forceinline__ int bwd_pos(int c) { return c < 2 ? 1 - c : 2 + (NCH - 1 - c); }
__device__ __forceinline__ int bwd_chunk_at(int p) { return p < 2 ? 1 - p : NCH - 1 - (p - 2); }
__device__ __forceinline__ float fsigmoid(float x) { return __builtin_amdgcn_rcpf(1.f + __builtin_amdgcn_exp2f(-LOG2E * x)); }
__device__ __forceinline__ void ph_lru(const Ptrs& P, unsigned char* lds, int mode, int item0) {
    typedef short bf16x8 __attribute__((ext_vector_type(8)));
    float* X = (float*)lds;
    unsigned char* XB = lds + 128 * 68 * 4;
    float* SEG = (float*)(lds + 128 * 68 * 4 + 16384);
    float* CAR = SEG + 2 * 8 * 64 * 2;
    unsigned char* WL = (unsigned char*)(CAR + 128);
    float* CWL = (float*)(WL + 32768);
    float* GBL = CWL + 320;
    const int tid = threadIdx.x, wid = tid >> 6, lane = tid & 63, fr = lane & 15, fq = lane >> 4;
    const int G = gridDim.x, total = 8 * NCH * NB;
    const bf16* Z = (const bf16*)(P.ws + WS_Z);
    float* agg = (float*)(P.ws + WS_AGG);
    const int first = ((int)blockIdx.x - item0 % G + G) % G;
    int n_cur = -1;
    u32x4 raw[2][4], gz[2];
#define LRU_LOADS(it_) do { const int n_ = (it_) % 8, c_ = ((it_) / 8) % NCH, b_ = (it_) / (8 * NCH); const int j0_ = c_ * CHUNK, lo_ = (c_ < 2) ? 0 : CTX, hi_ = (c_ < 2) ? CTX : SU; \
        _Pragma("unroll") for (int q = 0; q < 2; ++q) { const int p = tid + q * NT, t = p >> 3, cg = n_ * 64 + (p & 7) * 8; \
            _Pragma("unroll") for (int k = 0; k < 4; ++k) { const int j = j0_ + t - 2 + k; const int jj = (j >= lo_ && j < hi_) ? j : j0_ + t; raw[q][k] = *(const u32x4*)(Z + (size_t)(b_ * SU + jj) * EVEN_IN_P + 512 + cg); } \
            if (mode == 1) gz[q] = *(const u32x4*)(Z + (size_t)(b_ * SU + j0_ + t) * EVEN_IN_P + cg); } } while (0)
    if (first < total) LRU_LOADS(first);
    for (int it = first; it < total; it += G) {
        const int n = it % 8, c = (it / 8) % NCH, b = it / (8 * NCH);
        const int j0 = c * CHUNK, seg_lo = (c < 2) ? 0 : CTX, seg_hi = (c < 2) ? CTX : SU;
        __syncthreads();
        if (n != n_cur) {
            n_cur = n;
#pragma unroll
            for (int i = 0; i < 4; ++i) { const int idx = tid + i * NT, mm = idx >> 9, r = (idx & 511) >> 3, ch = idx & 7;
                *(u32x4*)(WL + mm * 8192 + r * 128 + ((ch ^ ((r >> 1) & 7)) << 4)) = *(const u32x4*)((const bf16*)(P.ws + WS_WLRU) + ((size_t)mm * 8 + n) * 4096 + r * 64 + ch * 8); }
            if (tid < 256) CWL[tid] = P.in[10][(tid >> 6) * LRU_W + n * 64 + (tid & 63)]; else if (tid < 320) CWL[tid] = P.in[11][n * 64 + (tid - 256)];
            if (tid < 384) { const int a = tid >> 7, dl = tid & 127, cgl = (dl >> 6) * LRU_W + n * 64 + (dl & 63);
                GBL[tid] = a == 0 ? P.in[13][cgl] : a == 1 ? P.in[15][cgl] : ((const float*)(P.ws + WS_SCAL))[1024 + cgl]; }
            __syncthreads();
        }
        u32x4 gzc[2];
#pragma unroll
        for (int q = 0; q < 2; ++q) {
            const int p = tid + q * NT, t = p >> 3, c8 = (p & 7) * 8;
            float acc[8];
            { const f32x4 b0 = *(const f32x4*)(CWL + 256 + c8), b1 = *(const f32x4*)(CWL + 256 + c8 + 4);
#pragma unroll
              for (int e = 0; e < 4; ++e) { acc[e] = b0[e]; acc[4 + e] = b1[e]; } }
#pragma unroll
            for (int k = 0; k < 4; ++k) {
                const int j = j0 + t - 2 + k; const bool ok = j >= seg_lo && j < seg_hi;
                const u32x4 rw = raw[q][k];
                const f32x4 w0 = *(const f32x4*)(CWL + k * 64 + c8), w1 = *(const f32x4*)(CWL + k * 64 + c8 + 4);
                const float m = ok ? 1.f : 0.f;
#pragma unroll
                for (int e = 0; e < 4; ++e) { const float lo = __uint_as_float(rw[e] << 16), hi = __uint_as_float(rw[e] & 0xffff0000u);
                    const float wl = (e < 2 ? w0[2 * e] : w1[2 * e - 4]) * m, wh = (e < 2 ? w0[2 * e + 1] : w1[2 * e - 3]) * m;
                    acc[2 * e] += wl * lo; acc[2 * e + 1] += wh * hi; }
            }
            *(f32x4*)(X + t * 68 + c8) = (f32x4){acc[0], acc[1], acc[2], acc[3]}; *(f32x4*)(X + t * 68 + c8 + 4) = (f32x4){acc[4], acc[5], acc[6], acc[7]};
            u32x4 w; w.x = g8::cvt_pk_bf16(acc[0], acc[1]); w.y = g8::cvt_pk_bf16(acc[2], acc[3]); w.z = g8::cvt_pk_bf16(acc[4], acc[5]); w.w = g8::cvt_pk_bf16(acc[6], acc[7]);
            *(u32x4*)(XB + t * 128 + (((c8 >> 3) ^ ((t >> 1) & 7)) << 4)) = w;
            gzc[q] = gz[q];
        }
        if (it + G < total) LRU_LOADS(it + G);
        if (mode == 1 && wid < 2) {
            const int dir = wid, pos = dir == 0 ? c : bwd_pos(c); float h = 0.f;
            for (int p0 = 0; p0 < pos; p0 += 8) {
                float2 ag[8];
#pragma unroll
                for (int i = 0; i < 8; ++i) { const int p = p0 + i, pc = p < pos ? p : p0, cc = dir == 0 ? pc : bwd_chunk_at(pc);
                    ag[i] = *(const float2*)(agg + ((((size_t)b * NCH + cc) * 2 + dir) * 512 + n * 64 + lane) * 2); if (p >= pos) { ag[i].x = 1.f; ag[i].y = 0.f; } }
#pragma unroll
                for (int i = 0; i < 8; ++i) h = ag[i].x * h + ag[i].y;
            }
            CAR[dir * 64 + lane] = h;
        }
        __syncthreads();
        const int trow = 16 * wid + fr;
        const bf16x8 af0 = *(const bf16x8*)(XB + trow * 128 + ((fq ^ ((trow >> 1) & 7)) << 4));
        const bf16x8 af1 = *(const bf16x8*)(XB + trow * 128 + (((4 + fq) ^ ((trow >> 1) & 7)) << 4));
        float av[2][4][4], uv[2][4][4], Ae[2][4], He[2][4];
#pragma unroll
        for (int dir = 0; dir < 2; ++dir) {
            const unsigned char* wa = WL + (dir * 2 + 0) * 8192; const unsigned char* wx = WL + (dir * 2 + 1) * 8192;
#pragma unroll
            for (int ct = 0; ct < 4; ++ct) {
                const int e = 16 * ct + fr, ky = (e >> 1) & 7;
                const bf16x8 wa0 = *(const bf16x8*)(wa + e * 128 + ((fq ^ ky) << 4)), wa1 = *(const bf16x8*)(wa + e * 128 + (((4 + fq) ^ ky) << 4));
                const bf16x8 wx0 = *(const bf16x8*)(wx + e * 128 + ((fq ^ ky) << 4)), wx1 = *(const bf16x8*)(wx + e * 128 + (((4 + fq) ^ ky) << 4));
                f32x4 ga = {0.f, 0.f, 0.f, 0.f}, gx = {0.f, 0.f, 0.f, 0.f};
                ga = __builtin_amdgcn_mfma_f32_16x16x32_bf16(af0, wa0, ga, 0, 0, 0); ga = __builtin_amdgcn_mfma_f32_16x16x32_bf16(af1, wa1, ga, 0, 0, 0);
                gx = __builtin_amdgcn_mfma_f32_16x16x32_bf16(af0, wx0, gx, 0, 0, 0); gx = __builtin_amdgcn_mfma_f32_16x16x32_bf16(af1, wx1, gx, 0, 0, 0);
                const float bav = GBL[dir * 64 + e], bxv = GBL[128 + dir * 64 + e], c8 = GBL[256 + dir * 64 + e];
#pragma unroll
                for (int j = 0; j < 4; ++j) {
                    const float r = fsigmoid(ga[j] + bav), ig = fsigmoid(gx[j] + bxv);
                    const float a = __builtin_amdgcn_exp2f(-c8 * r);
                    av[dir][ct][j] = a; uv[dir][ct][j] = sqrtf(fmaxf(1.f - a * a, 0.f)) * ig * X[(16 * wid + 4 * fq + j) * 68 + e];
                }
                float Al = av[dir][ct][0] * av[dir][ct][1] * av[dir][ct][2] * av[dir][ct][3], Hl;
                if (dir == 0) Hl = ((uv[dir][ct][0] * av[dir][ct][1] + uv[dir][ct][1]) * av[dir][ct][2] + uv[dir][ct][2]) * av[dir][ct][3] + uv[dir][ct][3];
                else Hl = ((uv[dir][ct][3] * av[dir][ct][2] + uv[dir][ct][2]) * av[dir][ct][1] + uv[dir][ct][1]) * av[dir][ct][0] + uv[dir][ct][0];
                const int pq = dir == 0 ? fq : 3 - fq;
                {
                    const int src = dir == 0 ? lane - 16 : lane + 16; const float Ap = __shfl(Al, src & 63), Hp = __shfl(Hl, src & 63);
                    if (pq >= 1) { Hl = Al * Hp + Hl; Al = Al * Ap; }
                }
                {
                    const int src = dir == 0 ? lane - 32 : lane + 32; const float Ap = __shfl(Al, src & 63), Hp = __shfl(Hl, src & 63);
                    if (pq >= 2) { Hl = Al * Hp + Hl; Al = Al * Ap; }
                }
                {
                    const int src = dir == 0 ? lane - 16 : lane + 16; const float Ap = __shfl(Al, src & 63), Hp = __shfl(Hl, src & 63);
                    Ae[dir][ct] = pq >= 1 ? Ap : 1.f; He[dir][ct] = pq >= 1 ? Hp : 0.f;
                }
                if (pq == 3) { float2 sv; sv.x = Al; sv.y = Hl; *(float2*)(SEG + ((dir * 8 + wid) * 64 + e) * 2) = sv; }
            }
        }
        __syncthreads();
        float hs[4][4];
#pragma unroll
        for (int ct = 0; ct < 4; ++ct)
#pragma unroll
            for (int j = 0; j < 4; ++j) hs[ct][j] = 0.f;
#pragma unroll
        for (int dir = 0; dir < 2; ++dir) {
#pragma unroll
            for (int ct = 0; ct < 4; ++ct) {
                const int e = 16 * ct + fr;
                if (mode == 0) {
                    if (wid == 0 && fq == 0) {
                        float Ac = 1.f, Hc = 0.f;
                        for (int sI = 0; sI < 8; ++sI) { const int sg = dir == 0 ? sI : 7 - sI; const float2 sv = *(const float2*)(SEG + ((dir * 8 + sg) * 64 + e) * 2); Hc = sv.x * Hc + sv.y; Ac *= sv.x; }
                        float2 o; o.x = Ac; o.y = Hc; *(float2*)(agg + ((((size_t)b * NCH + c) * 2 + dir) * 512 + n * 64 + e) * 2) = o;
                    }
                } else {
                    float h = CAR[dir * 64 + e];
                    const int nprev = dir == 0 ? wid : 7 - wid;
                    for (int sI = 0; sI < nprev; ++sI) { const int sg = dir == 0 ? sI : 7 - sI; const float2 sv = *(const float2*)(SEG + ((dir * 8 + sg) * 64 + e) * 2); h = sv.x * h + sv.y; }
                    h = Ae[dir][ct] * h + He[dir][ct];
                    if (dir == 0) {
#pragma unroll
                        for (int j = 0; j < 4; ++j) { h = av[dir][ct][j] * h + uv[dir][ct][j]; hs[ct][j] += h; }
                    } else {
#pragma unroll
                        for (int j = 3; j >= 0; --j) { h = av[dir][ct][j] * h + uv[dir][ct][j]; hs[ct][j] += h; }
                    }
                }
            }
        }
        if (mode == 1) {
#pragma unroll
            for (int ct = 0; ct < 4; ++ct)
#pragma unroll
                for (int j = 0; j < 4; ++j) X[(16 * wid + 4 * fq + j) * 68 + 16 * ct + fr] = hs[ct][j];
            __syncthreads();
            bf16* mix = (bf16*)(P.ws + WS_MIX);
#pragma unroll
            for (int q = 0; q < 2; ++q) {
                const int p = tid + q * NT, t = p >> 3, c8 = (p & 7) * 8; const size_t u = (size_t)b * SU + j0 + t;
                const u32x4 gzv = gzc[q];
                const f32x4 r0 = *(const f32x4*)(X + t * 68 + c8), r1 = *(const f32x4*)(X + t * 68 + c8 + 4);
                float o[8];
#pragma unroll
                for (int k = 0; k < 4; ++k) { const float g0 = __uint_as_float(gzv[k] << 16), g1 = __uint_as_float(gzv[k] & 0xffff0000u);
                    const float s0 = fsigmoid(1.5957691216057308f * (g0 + 0.044715f * g0 * g0 * g0)), s1 = fsigmoid(1.5957691216057308f * (g1 + 0.044715f * g1 * g1 * g1));
                    o[2 * k] = g0 * s0 * (k < 2 ? r0[2 * k] : r1[2 * k - 4]); o[2 * k + 1] = g1 * s1 * (k < 2 ? r0[2 * k + 1] : r1[2 * k - 3]); }
                u32x4 w; w.x = g8::cvt_pk_bf16(o[0], o[1]); w.y = g8::cvt_pk_bf16(o[2], o[3]); w.z = g8::cvt_pk_bf16(o[4], o[5]); w.w = g8::cvt_pk_bf16(o[6], o[7]);
                *(u32x4*)(mix + u * D + n * 64 + c8) = w;
            }
        }
    }
#undef LRU_LOADS
    __syncthreads();
}

__device__ __forceinline__ void unpack8(const u32x4 v, float (&f)[8]) {
#pragma unroll
    for (int i = 0; i < 4; ++i) { f[2 * i] = __uint_as_float(v[i] << 16); f[2 * i + 1] = __uint_as_float(v[i] & 0xffff0000u); }
}
__device__ __forceinline__ u32x4 pack8(const float (&f)[8]) {
    u32x4 w; w.x = g8::cvt_pk_bf16(f[0], f[1]); w.y = g8::cvt_pk_bf16(f[2], f[3]); w.z = g8::cvt_pk_bf16(f[4], f[5]); w.w = g8::cvt_pk_bf16(f[6], f[7]); return w;
}
struct MlaRow { u32x4 zq, zk, zr, q0, q1, kv0, kw0, kv1, kw1; f32x4 c0, c1, s0, s1; };
__device__ __forceinline__ MlaRow mla_row_load(const Ptrs& P, int u, int lane) {
    const int hl = lane & 31, hh = lane >> 5; const bool act = hl < 24, tail = hl >= 16 && hl < 24;
    const int j = u % SU; const bool latent = j >= CTX; const int t = latent ? j - CTX : 0;
    const bf16* z = (const bf16*)(P.ws + WS_Z) + (size_t)u * EVEN_IN_P;
    const bf16* qp = (const bf16*)(P.ws + WS_QP) + (size_t)u * 1792; const bf16* kvp = qp + 768;
    const float* rc = (const float*)(P.ws + WS_ROPE); const float* rs = rc + SEQ * 64;
    const u32x4 z4 = {0u, 0u, 0u, 0u}; const f32x4 one4 = {1.f, 1.f, 1.f, 1.f}, zero4 = {0.f, 0.f, 0.f, 0.f};
    MlaRow r;
    r.zq = lane < 48 ? *(const u32x4*)(z + 1024 + lane * 8) : z4;
    r.zk = lane < 32 ? *(const u32x4*)(z + 1408 + lane * 8) : z4;
    r.zr = tail ? *(const u32x4*)(z + 1664 + (hl - 16) * 8) : z4;
    r.q0 = act ? *(const u32x4*)(qp + hh * 192 + hl * 8) : z4;
    r.q1 = act ? *(const u32x4*)(qp + (2 + hh) * 192 + hl * 8) : z4;
    r.kv0 = hl < 16 ? *(const u32x4*)(kvp + hh * 256 + hl * 8) : z4;
    r.kw0 = hl < 16 ? *(const u32x4*)(kvp + hh * 256 + 128 + hl * 8) : z4;
    r.kv1 = hl < 16 ? *(const u32x4*)(kvp + (2 + hh) * 256 + hl * 8) : z4;
    r.kw1 = hl < 16 ? *(const u32x4*)(kvp + (2 + hh) * 256 + 128 + hl * 8) : z4;
    const bool rp = latent && tail; const int ro = t * 64 + (hl - 16) * 8;
    r.c0 = rp ? *(const f32x4*)(rc + ro) : one4; r.c1 = rp ? *(const f32x4*)(rc + ro + 4) : one4;
    r.s0 = rp ? *(const f32x4*)(rs + ro) : zero4; r.s1 = rp ? *(const f32x4*)(rs + ro + 4) : zero4;
    return r;
}
__device__ __forceinline__ void ph_mla_prep(const Ptrs& P) {
    const int wave = threadIdx.x >> 6, lane = threadIdx.x & 63, G = gridDim.x;
    const int hl = lane & 31, hh = lane >> 5;
    const bool act = hl < 24, tail = hl >= 16 && hl < 24;
    const float* qn = P.in[21]; const float* kn = P.in[22];
    float gq[8], gk[8];
#pragma unroll
    for (int i = 0; i < 8; ++i) { gq[i] = act ? qn[hl * 8 + i] : 0.f; gk[i] = act ? kn[hl * 8 + i] : 0.f; }
    const float c2 = 0.07216878364870322f * LOG2E;
    const float sgn = ((hl >> 1) & 1) ? 1.f : -1.f;
    int u = (int)blockIdx.x * 8 + wave;
    if (u >= R) return;
    MlaRow cur = mla_row_load(P, u, lane);
    for (; u < R; u += G * 8) {
        const int un = u + G * 8;
        MlaRow nxt = cur;
        if (un < R) nxt = mla_row_load(P, un, lane);
        float f[8]; float sq = 0.f, sk = 0.f;
        unpack8(cur.zq, f);
#pragma unroll
        for (int i = 0; i < 8; ++i) sq += f[i] * f[i];
        unpack8(cur.zk, f);
#pragma unroll
        for (int i = 0; i < 8; ++i) sk += f[i] * f[i];
        const float rq = rsqrtf(wave_sum(sq) * (1.f / 384.f) + EPS), rk = rsqrtf(wave_sum(sk) * (1.f / 256.f) + EPS);
        float cs[8], sn[8];
#pragma unroll
        for (int i = 0; i < 4; ++i) { cs[i] = cur.c0[i]; cs[4 + i] = cur.c1[i]; sn[i] = cur.s0[i]; sn[4 + i] = cur.s1[i]; }
        bf16* qm = (bf16*)(P.ws + WS_QM) + (size_t)u * 768; bf16* km = (bf16*)(P.ws + WS_KM) + (size_t)u * 768; bf16* vm = (bf16*)(P.ws + WS_VM) + (size_t)u * 512;
#pragma unroll
        for (int pass = 0; pass < 2; ++pass) {
            const int h = pass * 2 + hh;
            {
                float v[8]; float ss = 0.f;
                unpack8(pass ? cur.q1 : cur.q0, v);
#pragma unroll
                for (int i = 0; i < 8; ++i) { v[i] *= rq; ss += v[i] * v[i]; }
                ss += __shfl_xor(ss, 1); ss += __shfl_xor(ss, 2); ss += __shfl_xor(ss, 4); ss += __shfl_xor(ss, 8); ss += __shfl_xor(ss, 16);
                const float r = rsqrtf(ss * (1.f / 192.f) + EPS);
#pragma unroll
                for (int i = 0; i < 8; ++i) { v[i] *= r * gq[i]; const float other = __shfl_xor(v[i], 2); v[i] = (v[i] * cs[i] + sgn * other * sn[i]) * c2; }
                if (act) *(u32x4*)(qm + h * 192 + hl * 8) = pack8(v);
            }
            {
                float v[8], w[8]; float ss = 0.f;
                if (hl < 16) { unpack8(pass ? cur.kv1 : cur.kv0, v); unpack8(pass ? cur.kw1 : cur.kw0, w);
#pragma unroll
                    for (int i = 0; i < 8; ++i) { v[i] *= rk; w[i] *= rk; } }
                else { unpack8(cur.zr, v);
#pragma unroll
                    for (int i = 0; i < 8; ++i) w[i] = 0.f; }
#pragma unroll
                for (int i = 0; i < 8; ++i) ss += v[i] * v[i];
                ss += __shfl_xor(ss, 1); ss += __shfl_xor(ss, 2); ss += __shfl_xor(ss, 4); ss += __shfl_xor(ss, 8); ss += __shfl_xor(ss, 16);
                const float r = rsqrtf(ss * (1.f / 192.f) + EPS);
#pragma unroll
                for (int i = 0; i < 8; ++i) { v[i] *= r * gk[i]; const float other = __shfl_xor(v[i], 2); v[i] = v[i] * cs[i] + sgn * other * sn[i]; }
                if (act) *(u32x4*)(km + h * 192 + hl * 8) = pack8(v);
                if (hl < 16) *(u32x4*)(vm + h * 128 + hl * 8) = pack8(w);
            }
        }
        cur = nxt;
    }
}
#ifndef PROBE_SUB
#define PROBE_SUB 0
#define PROBE_SUBDK 0
#endif
#ifndef PROBE_SUBBLK
#define PROBE_SUBBLK 0
#endif
#define PSUB_T0() unsigned ps_t0_ = 0u; if (PROBE_SUB && DK == PROBE_SUBDK) ps_t0_ = __builtin_amdgcn_readfirstlane((unsigned)__builtin_readcyclecounter())
#define PSUB_AT(k) do { if (PROBE_SUB == (k) && DK == PROBE_SUBDK) sacc = __builtin_amdgcn_readfirstlane(sacc + ((unsigned)__builtin_readcyclecounter() - ps_t0_)); } while (0)
namespace att {
using bf16x8 = __attribute__((ext_vector_type(8))) short;
using s16x4  = __attribute__((ext_vector_type(4))) short;
using f32x16 = __attribute__((ext_vector_type(16))) float;
#define SBAR() __builtin_amdgcn_sched_barrier(0)
__device__ __forceinline__ int crow(int r, int hi) { return (r & 3) + 8 * (r >> 2) + 4 * hi; }
__device__ __forceinline__ unsigned cvtpk(float lo, float hi) { unsigned r; asm volatile("v_cvt_pk_bf16_f32 %0, %1, %2" : "=v"(r) : "v"(lo), "v"(hi)); return r; }
template <int DK> __device__ __forceinline__ int kswz(int row, int chunk) { return row * (DK * 2) + ((chunk ^ ((row >> 1) & 7)) << 4); }
__device__ __forceinline__ int v_st(int k, int c) { const int kk = (k & ~0xC) | ((k & 4) << 1) | ((k & 8) >> 1); return ((kk >> 3) * 4 + (c >> 5)) * 512 + ((kk & 7) * 32 + (c & 31)) * 2; }
__device__ __forceinline__ int v_rd_base(int lane) { return ((lane & 3) << 3) | (((lane >> 2) & 3) << 6) | (((lane >> 4) & 1) << 5) | (((lane >> 5) & 1) << 8); }
constexpr int v_rd_off(int d0, int ks, int half) { return d0 * 512 + ks * 4096 + half * 2048; }
template <int OFF> __device__ __forceinline__ s16x4 tr_read(int vb) { s16x4 r; asm volatile("ds_read_b64_tr_b16 %0, %1 offset:%2" : "=&v"(r) : "v"(vb), "i"(OFF) : "memory"); return r; }
template <int D0> __device__ __forceinline__ void pv_one(f32x16& od, int vb, bf16x8 pa0, bf16x8 pa1, bf16x8 pa2, bf16x8 pa3) {
    const s16x4 l0 = tr_read<v_rd_off(D0, 0, 0)>(vb), h0 = tr_read<v_rd_off(D0, 0, 1)>(vb), l1 = tr_read<v_rd_off(D0, 1, 0)>(vb), h1 = tr_read<v_rd_off(D0, 1, 1)>(vb);
    const s16x4 l2 = tr_read<v_rd_off(D0, 2, 0)>(vb), h2 = tr_read<v_rd_off(D0, 2, 1)>(vb), l3 = tr_read<v_rd_off(D0, 3, 0)>(vb), h3 = tr_read<v_rd_off(D0, 3, 1)>(vb);
    asm volatile("s_waitcnt lgkmcnt(0)" ::: "memory"); SBAR();
#define PK(L, H) (bf16x8){L[0], L[1], L[2], L[3], H[0], H[1], H[2], H[3]}
    od = __builtin_amdgcn_mfma_f32_32x32x16_bf16(pa0, PK(l0, h0), od, 0, 0, 0);
    od = __builtin_amdgcn_mfma_f32_32x32x16_bf16(pa1, PK(l1, h1), od, 0, 0, 0);
    od = __builtin_amdgcn_mfma_f32_32x32x16_bf16(pa2, PK(l2, h2), od, 0, 0, 0);
    od = __builtin_amdgcn_mfma_f32_32x32x16_bf16(pa3, PK(l3, h3), od, 0, 0, 0);
#undef PK
}
typedef short v4i16_t __attribute__((ext_vector_type(4)));
template <int OFF> __device__ __forceinline__ s16x4 tr_read_b(int vb) {
    return __builtin_bit_cast(s16x4, __builtin_amdgcn_ds_read_tr16_b64_v4i16((__attribute__((address_space(3))) v4i16_t*)(uintptr_t)(unsigned)(vb + OFF)));
}
template <int D0> __device__ __forceinline__ void pv_one_b(f32x16& od, int vb, bf16x8 pa0, bf16x8 pa1, bf16x8 pa2, bf16x8 pa3) {
    const s16x4 l0 = tr_read_b<v_rd_off(D0, 0, 0)>(vb), h0 = tr_read_b<v_rd_off(D0, 0, 1)>(vb), l1 = tr_read_b<v_rd_off(D0, 1, 0)>(vb), h1 = tr_read_b<v_rd_off(D0, 1, 1)>(vb);
    const s16x4 l2 = tr_read_b<v_rd_off(D0, 2, 0)>(vb), h2 = tr_read_b<v_rd_off(D0, 2, 1)>(vb), l3 = tr_read_b<v_rd_off(D0, 3, 0)>(vb), h3 = tr_read_b<v_rd_off(D0, 3, 1)>(vb);
#define PK(L, H) (bf16x8){L[0], L[1], L[2], L[3], H[0], H[1], H[2], H[3]}
    od = __builtin_amdgcn_mfma_f32_32x32x16_bf16(pa0, PK(l0, h0), od, 0, 0, 0);
    od = __builtin_amdgcn_mfma_f32_32x32x16_bf16(pa1, PK(l1, h1), od, 0, 0, 0);
    od = __builtin_amdgcn_mfma_f32_32x32x16_bf16(pa2, PK(l2, h2), od, 0, 0, 0);
    od = __builtin_amdgcn_mfma_f32_32x32x16_bf16(pa3, PK(l3, h3), od, 0, 0, 0);
#undef PK
}
constexpr int SHM_V = 64 * 128 * 2;
template <int DK, bool PF, bool EARLY>
__device__ __forceinline__ void attn_loop(const bf16* __restrict__ Qrow  , const bf16* __restrict__ Kh, int ldk, const bf16* __restrict__ Vh, int ldv,
                                          int nkeys, float negM, f32x16 (&o)[4], float& l_reg, char* lds_kv, unsigned& sacc) {
    constexpr int NQ = DK / 16, CH = DK / 8, KP = (64 * CH) / NT, SHM_K = 64 * DK * 2;
    const int tid = threadIdx.x, lane = tid & 63, r32 = lane & 31, hi = lane >> 5;
    char* V_lds = lds_kv; char* K_lds = lds_kv + 2 * SHM_V;
    bf16x8 qr[NQ];
#pragma unroll
    for (int d0 = 0; d0 < NQ; ++d0) qr[d0] = *reinterpret_cast<const bf16x8*>(Qrow + d0 * 16);
    const __amdgpu_buffer_rsrc_t krs = __builtin_amdgcn_make_buffer_rsrc((void*)Kh, 0, nkeys * ldk * 2, 0x00020000);
    const __amdgpu_buffer_rsrc_t vrs = __builtin_amdgcn_make_buffer_rsrc((void*)Vh, 0, nkeys * ldv * 2, 0x00020000);
    unsigned kgo[KP]; int kst[KP];
#pragma unroll
    for (int i = 0; i < KP; ++i) { const int p = tid + i * NT, row = p / CH, ch = p % CH; kgo[i] = (unsigned)(row * ldk + ch * 8) * 2u; kst[i] = kswz<DK>(row, ch); }
    const int vrow0 = tid >> 4, vc = (tid & 15) * 8;
    const unsigned vgo = (unsigned)(vrow0 * ldv + vc) * 2u, vstep = (unsigned)(32 * ldv) * 2u;
    const int vst0 = v_st(vrow0, vc); constexpr int vst1d = 8192;
    const int vb0 = (int)(uintptr_t)V_lds + v_rd_base(lane);
    const int kbase = r32 * (DK * 2), kt0 = (hi ^ ((r32 >> 1) & 7)) << 4;
#define kra_(q) (kbase + (kt0 ^ ((q) << 5)))
    u32x4 ks[KP], vs0, vs1;
#define SLOAD(k0) do { const unsigned so_k = (unsigned)((k0) * ldk) * 2u, so_v = (unsigned)((k0) * ldv) * 2u; \
        _Pragma("unroll") for (int i = 0; i < KP; ++i) ks[i] = __builtin_amdgcn_raw_buffer_load_b128(krs, kgo[i], so_k, 0); \
        vs0 = __builtin_amdgcn_raw_buffer_load_b128(vrs, vgo, so_v, 0); vs1 = __builtin_amdgcn_raw_buffer_load_b128(vrs, vgo + vstep, so_v, 0); } while (0)
#define SWRITE(b) do { _Pragma("unroll") for (int i = 0; i < KP; ++i) *reinterpret_cast<u32x4*>(K_lds + (b) * SHM_K + kst[i]) = ks[i]; \
        *reinterpret_cast<u32x4*>(V_lds + (b) * SHM_V + vst0) = vs0; *reinterpret_cast<u32x4*>(V_lds + (b) * SHM_V + vst0 + vst1d) = vs1; } while (0)
    constexpr int KLINES = (64 * DK * 2) / 128, VLINES = 128, LPR = DK / 64;
    unsigned pf_dummy = 0u;
#define PREFETCH(t) do { if (PF && tid < KLINES + VLINES) { const bool isk_ = tid < KLINES; const int l_ = isk_ ? tid : tid - KLINES; \
        const unsigned off_ = isk_ ? (unsigned)(((t) * 64 + l_ / LPR) * ldk + (l_ % LPR) * 64) * 2u : (unsigned)(((t) * 64 + (l_ >> 1)) * ldv + (l_ & 1) * 64) * 2u + (unsigned)((const char*)Vh - (const char*)Kh); \
        asm volatile("global_load_dword %0, %1, %2" : "+v"(pf_dummy) : "v"(off_), "s"(Kh) : "memory"); } } while (0)
    const int ntile = nkeys / 64;
    PREFETCH(1); PREFETCH(2);
    SLOAD(0); SWRITE(0); __syncthreads();
    for (int j = 0; j < ntile; ++j) {
        const int cur = j & 1;
        PSUB_T0();
        if (EARLY && j + 1 < ntile) SLOAD((j + 1) * 64);
        f32x16 p0, p1;
#pragma unroll
        for (int r = 0; r < 16; ++r) { p0[r] = negM; p1[r] = negM; }
        const char* Kb = K_lds + cur * SHM_K;
#pragma unroll
        for (int d0 = 0; d0 < NQ; ++d0) {
            const bf16x8 b0 = *reinterpret_cast<const bf16x8*>(Kb + kra_(d0 & 3) + (d0 >> 2) * 128);
            const bf16x8 b1 = *reinterpret_cast<const bf16x8*>(Kb + kra_(d0 & 3) + (d0 >> 2) * 128 + 32 * DK * 2);
            p0 = __builtin_amdgcn_mfma_f32_32x32x16_bf16(b0, qr[d0], p0, 0, 0, 0);
            p1 = __builtin_amdgcn_mfma_f32_32x32x16_bf16(b1, qr[d0], p1, 0, 0, 0);
            if ((d0 & 3) == 3) SBAR();
        }
        PSUB_AT(1);
        if (!EARLY && j + 1 < ntile) SLOAD((j + 1) * 64);
        float ps = 0.f;
#pragma unroll
        for (int r = 0; r < 16; ++r) { p0[r] = __builtin_amdgcn_exp2f(p0[r]); p1[r] = __builtin_amdgcn_exp2f(p1[r]); ps += p0[r] + p1[r]; }
        l_reg += ps;
        bf16x8 pa0, pa1, pa2, pa3;
#define PK4(P, BASE, OUT) do { unsigned a0 = cvtpk(P[BASE + 0], P[BASE + 1]), a1 = cvtpk(P[BASE + 2], P[BASE + 3]);   \
        unsigned b0_ = cvtpk(P[BASE + 4], P[BASE + 5]), b1_ = cvtpk(P[BASE + 6], P[BASE + 7]);                              \
        auto r0 = __builtin_amdgcn_permlane32_swap(a0, b0_, false, false); auto r1 = __builtin_amdgcn_permlane32_swap(a1, b1_, false, false); \
        u32x4 w = {r0[0], r1[0], r0[1], r1[1]}; OUT = *reinterpret_cast<bf16x8*>(&w); } while (0)
        PK4(p0, 0, pa0); PK4(p0, 8, pa1); PK4(p1, 0, pa2); PK4(p1, 8, pa3);
#undef PK4
        PSUB_AT(2);
        const int vb = vb0 + cur * SHM_V;
        pv_one<0>(o[0], vb, pa0, pa1, pa2, pa3); pv_one<1>(o[1], vb, pa0, pa1, pa2, pa3); pv_one<2>(o[2], vb, pa0, pa1, pa2, pa3); pv_one<3>(o[3], vb, pa0, pa1, pa2, pa3);
        PSUB_AT(3);
        if (j + 1 < ntile) SWRITE(cur ^ 1);
        if (j + 3 < ntile) PREFETCH(j + 3);
        __syncthreads();
        PSUB_AT(4);
    }
    if (PF) asm volatile("s_waitcnt vmcnt(0)" : "+v"(pf_dummy) :: "memory");
#undef PREFETCH
#undef kra_
#undef SLOAD
#undef SWRITE
}
__device__ __forceinline__ void row_recip(float l_reg, float* li_l  , int r32, int hi, float (&rli)[16]) {
    { auto rr = __builtin_amdgcn_permlane32_swap(__float_as_uint(l_reg), __float_as_uint(l_reg), false, false); l_reg = __uint_as_float(rr[0]) + __uint_as_float(rr[1]); }
    if (hi == 0) li_l[r32] = l_reg;
    asm volatile("s_waitcnt lgkmcnt(0)" ::: "memory");
#pragma unroll
    for (int r = 0; r < 16; ++r) rli[r] = __builtin_amdgcn_rcpf(li_l[crow(r, hi)]);
}
#undef SBAR
}

constexpr int ATT_SCR_OFF = RING_BYTES - 2048;
__device__ __forceinline__ void mla_attn_unit(const Ptrs& P, unsigned char* lds, int b, int h, int qb, int ctxq, unsigned& sacc) {
    using namespace att;
    const int tid = threadIdx.x, wid = tid >> 6, lane = tid & 63, r32 = lane & 31, hi = lane >> 5;
    const bf16* Qm = (const bf16*)(P.ws + WS_QM); const bf16* Km = (const bf16*)(P.ws + WS_KM); const bf16* Vm = (const bf16*)(P.ws + WS_VM);
    const size_t u0 = (size_t)b * SU + (ctxq ? 0 : CTX) + qb * 256 + wid * 32;
    f32x16 o[4] = {}; float l_reg = 0.f;
    const float negM = -((const float*)(P.ws + WS_SCAL))[0];
    attn_loop<192, false, false>(Qm + (u0 + r32) * 768 + h * 192 + hi * 8, Km + (size_t)b * SU * 768 + h * 192, 768, Vm + (size_t)b * SU * 512 + h * 128, 512, ctxq ? CTX : SU, negM, o, l_reg, (char*)lds, sacc);
    float rli[16]; row_recip(l_reg, (float*)(lds + ATT_SCR_OFF) + wid * 64, r32, hi, rli);
    bf16* stg = (bf16*)lds + wid * 4096;
#pragma unroll
    for (int r = 0; r < 16; ++r) { const int orow = crow(r, hi);
#pragma unroll
        for (int d0 = 0; d0 < 4; ++d0) stg[orow * 128 + d0 * 32 + r32] = f2bf(o[d0][r] * rli[r]); }
    asm volatile("s_waitcnt lgkmcnt(0)" ::: "memory");
    bf16* mix = (bf16*)(P.ws + WS_MIX) + u0 * D + 512 + h * 128;
#pragma unroll
    for (int i = 0; i < 8; ++i) { const int row = i * 4 + (lane >> 4), ch = lane & 15; const u32x4 v = *(const u32x4*)(stg + row * 128 + ch * 8); *(u32x4*)(mix + (size_t)row * D + ch * 8) = v; }
    asm volatile("s_waitcnt lgkmcnt(0)" ::: "memory");
    __syncthreads();
}
__device__ __forceinline__ void diff_attn_unit(const Ptrs& P, unsigned char* lds, int b, int h, int qb, unsigned& sacc) {
    using namespace att;
    const int tid = threadIdx.x, wid = tid >> 6, lane = tid & 63, r32 = lane & 31, hi = lane >> 5;
    const bf16* Z = (const bf16*)(P.ws + WS_Z);
    const size_t u0 = (size_t)b * SU + CTX + qb * 256 + wid * 32;
    const float* scal = (const float*)(P.ws + WS_SCAL); const float negM = -scal[1], lam = scal[2], oml = scal[3];
    bf16* stg = (bf16*)lds + wid * 4096;
    float* li_l = (float*)(lds + ATT_SCR_OFF) + wid * 64;
    for (int part = 0; part < 2; ++part) {
        f32x16 o[4] = {}; float l_reg = 0.f;
        attn_loop<64, true, true>(Z + (u0 + r32) * ODD_IN + h * 128 + part * 64 + hi * 8, Z + 1024 + (size_t)b * SU * ODD_IN + h * 128 + part * 64, ODD_IN, Z + 2048 + (size_t)b * SU * ODD_IN + h * 128, ODD_IN, SU, negM, o, l_reg, (char*)lds + 65536, sacc);
        float rli[16]; row_recip(l_reg, li_l, r32, hi, rli);
#pragma unroll
        for (int r = 0; r < 16; ++r) { const int orow = crow(r, hi);
#pragma unroll
            for (int d0 = 0; d0 < 4; ++d0) { bf16* s = stg + orow * 128 + d0 * 32 + r32; const float on = o[d0][r] * rli[r];
                if (part == 0) *s = f2bf(on); else *s = f2bf(bf2f(*s) - lam * on); } }
        asm volatile("s_waitcnt lgkmcnt(0)" ::: "memory");
    }
    const float* sg = P.in[31];
    bf16* mix = (bf16*)(P.ws + WS_MIX) + u0 * D + h * 128;
#pragma unroll
    for (int i = 0; i < 8; ++i) { const int row = i * 4 + (lane >> 4), ch = lane & 15; const u32x4 v = *(const u32x4*)(stg + row * 128 + ch * 8);
        float f[8]; float ss = 0.f;
#pragma unroll
        for (int e = 0; e < 4; ++e) { f[2 * e] = __uint_as_float(v[e] << 16); f[2 * e + 1] = __uint_as_float(v[e] & 0xffff0000u); ss += f[2 * e] * f[2 * e] + f[2 * e + 1] * f[2 * e + 1]; }
        ss += __shfl_xor(ss, 1); ss += __shfl_xor(ss, 2); ss += __shfl_xor(ss, 4); ss += __shfl_xor(ss, 8);
        const float rs = rsqrtf(ss * (1.f / 128.f) + EPS) * oml;
        const f32x4 g0 = *(const f32x4*)(sg + ch * 8), g1 = *(const f32x4*)(sg + ch * 8 + 4);
        u32x4 w; w.x = att::cvtpk(f[0] * rs * g0[0], f[1] * rs * g0[1]); w.y = att::cvtpk(f[2] * rs * g0[2], f[3] * rs * g0[3]); w.z = att::cvtpk(f[4] * rs * g1[0], f[5] * rs * g1[1]); w.w = att::cvtpk(f[6] * rs * g1[2], f[7] * rs * g1[3]);
        *(u32x4*)(mix + (size_t)row * D + ch * 8) = w; }
    asm volatile("s_waitcnt lgkmcnt(0)" ::: "memory");
    __syncthreads();
}

__device__ __forceinline__ void ph_norm2_router(const Ptrs& P, unsigned char* lds, int layer, int latent_only) {
    const int tid = threadIdx.x, wid = tid >> 6, lane = tid & 63, fr = lane & 15, fq = lane >> 4, G = gridDim.x;
    float* RS = (float*)lds;
    float* LGP = RS + 256;
    int* TOPE = (int*)(LGP + 2 * 4096);
    float* TOPW = (float*)(TOPE + 512);
    int* TOPR = (int*)(TOPW + 512);
    int* LCNT = TOPR + 512;
    int* LBASE = LCNT + 32;
    int* GU0 = LBASE + 32;
    const float* gn = P.in[7] + layer * D;
    const float* rw = P.in[32] + (size_t)layer * D * NE; const float* rb = P.in[33] + layer * NE;
    const int cw0 = 128 * wid + 8 * fq;
    float wv0[4][8], wv1[4][8];
#pragma unroll
    for (int ks = 0; ks < 4; ++ks) { const float* wr = rw + (size_t)(cw0 + 32 * ks) * NE + fr;
#pragma unroll
        for (int j = 0; j < 8; ++j) { wv0[ks][j] = wr[j * NE]; wv1[ks][j] = wr[j * NE + 16]; } }
    const int NG = latent_only ? NB * (SEQ / 16) : R / 16;
    const int q0 = (int)(((long long)blockIdx.x * NG) / G), q1 = (int)(((long long)(blockIdx.x + 1) * NG) / G);
#define N2_U0(q) (latent_only ? ((q) >> 8) * SU + CTX + ((q) & 255) * 16 : (q) * 16)
#define N2_XLOAD(XR, q) do { const bf16* x_ = (const bf16*)(P.ws + WS_XB) + (size_t)(N2_U0(q) + fr) * D + cw0; _Pragma("unroll") for (int ks = 0; ks < 4; ++ks) XR[ks] = *(const u32x4*)(x_ + 32 * ks); } while (0)
#define N2_LO(w) __uint_as_float((w) << 16)
#define N2_HI(w) __uint_as_float((w) & 0xffff0000u)
#define N2_SS(XR, par) do { float ss = 0.f; _Pragma("unroll") for (int ks = 0; ks < 4; ++ks) { const u32x4 r = XR[ks]; \
            ss += N2_LO(r.x) * N2_LO(r.x) + N2_HI(r.x) * N2_HI(r.x) + N2_LO(r.y) * N2_LO(r.y) + N2_HI(r.y) * N2_HI(r.y) + N2_LO(r.z) * N2_LO(r.z) + N2_HI(r.z) * N2_HI(r.z) + N2_LO(r.w) * N2_LO(r.w) + N2_HI(r.w) * N2_HI(r.w); } \
        ss += __shfl_xor(ss, 16); ss += __shfl_xor(ss, 32); if (fq == 0) RS[(par) * 128 + wid * 16 + fr] = ss; } while (0)
    float A[4][8], Hs[4][8]; int mi_cur = -1;
    for (int qs = q0; qs < q1; qs += 8) {
        const int qe = qs + 8 < q1 ? qs + 8 : q1;
        __syncthreads();
        if (tid < 32) LCNT[tid] = 0;
        u32x4 xr[4], xn[4];
        N2_XLOAD(xr, qs);
        N2_SS(xr, 0);
        __syncthreads();
        for (int q = qs; q < qe; ++q) {
            const int gi = q - qs, par = gi & 1, u0 = N2_U0(q), u = u0 + fr;
            { const int b_ = u0 / SU, mi = (u0 % SU) < CTX ? 4 : b_;
              if (mi != mi_cur) { mi_cur = mi; const float* md = (const float*)(P.ws + WS_MOD) + (size_t)(layer * 5 + mi) * 6144 + 3 * D;
#pragma unroll
                  for (int ks = 0; ks < 4; ++ks) { const int c0 = cw0 + 32 * ks;
                      const f32x4 g0 = *(const f32x4*)(gn + c0), g1 = *(const f32x4*)(gn + c0 + 4), s0 = *(const f32x4*)(md + D + c0), s1 = *(const f32x4*)(md + D + c0 + 4), h0 = *(const f32x4*)(md + c0), h1 = *(const f32x4*)(md + c0 + 4);
#pragma unroll
                      for (int j = 0; j < 4; ++j) { A[ks][j] = g0[j] * (1.f + s0[j]); A[ks][4 + j] = g1[j] * (1.f + s1[j]); Hs[ks][j] = h0[j]; Hs[ks][4 + j] = h1[j]; } } } }
            if (q + 1 < qe) N2_XLOAD(xn, q + 1);
            if (tid == 0) GU0[gi] = u0;
            float tot = 0.f;
#pragma unroll
            for (int w = 0; w < 8; ++w) tot += RS[par * 128 + w * 16 + fr];
            const float rstd = rsqrtf(tot * (1.f / D) + EPS);
            f32x4 acc0 = {0.f, 0.f, 0.f, 0.f}, acc1 = {0.f, 0.f, 0.f, 0.f};
            bf16* h = (bf16*)(P.ws + WS_H) + (size_t)u * D + cw0;
#pragma unroll
            for (int ks = 0; ks < 4; ++ks) {
                float y[8];
                const u32x4 r = xr[ks]; const float xv[8] = {N2_LO(r.x), N2_HI(r.x), N2_LO(r.y), N2_HI(r.y), N2_LO(r.z), N2_HI(r.z), N2_LO(r.w), N2_HI(r.w)};
#pragma unroll
                for (int j = 0; j < 8; ++j) y[j] = xv[j] * rstd * A[ks][j] + Hs[ks][j];
                u32x4 w; w.x = g8::cvt_pk_bf16(y[0], y[1]); w.y = g8::cvt_pk_bf16(y[2], y[3]); w.z = g8::cvt_pk_bf16(y[4], y[5]); w.w = g8::cvt_pk_bf16(y[6], y[7]);
                *(u32x4*)(h + 32 * ks) = w;
#pragma unroll
                for (int j = 0; j < 8; ++j) {
                    acc0 = __builtin_amdgcn_mfma_f32_16x16x4f32(y[j], wv0[ks][j], acc0, 0, 0, 0);
                    acc1 = __builtin_amdgcn_mfma_f32_16x16x4f32(y[j], wv1[ks][j], acc1, 0, 0, 0);
                }
            }
            float* lgp = LGP + par * 4096;
#pragma unroll
            for (int j = 0; j < 4; ++j) { lgp[(wid * 16 + 4 * fq + j) * 32 + fr] = acc0[j]; lgp[(wid * 16 + 4 * fq + j) * 32 + 16 + fr] = acc1[j]; }
            if (q + 1 < qe) { N2_SS(xn, par ^ 1);
#pragma unroll
                for (int ks = 0; ks < 4; ++ks) xr[ks] = xn[ks]; }
            __syncthreads();
            {
                const int e = lane & 31, row = 2 * wid + (lane >> 5);
                float lg = rb[e];
#pragma unroll
                for (int w = 0; w < 8; ++w) lg += lgp[(w * 16 + row) * 32 + e];
                int te[4]; float tv[4];
#pragma unroll
                for (int k = 0; k < 4; ++k) {
                    float bv = lg; int bi = e;
#pragma unroll
                    for (int m = 1; m < 32; m <<= 1) { const float ov = __shfl_xor(bv, m); const int oi = __shfl_xor(bi, m); const bool take = ov > bv || (ov == bv && oi < bi); bv = take ? ov : bv; bi = take ? oi : bi; }
                    te[k] = bi; tv[k] = bv; if (e == bi) lg = -3.4e38f;
                }
                float den = 0.f, w[4];
#pragma unroll
                for (int k = 0; k < 4; ++k) { w[k] = __expf(tv[k] - tv[0]); den += w[k]; }
                const float iden = 1.f / den;
                if (e < 4) { const int ek = e == 0 ? te[0] : e == 1 ? te[1] : e == 2 ? te[2] : te[3]; const float wk = (e == 0 ? w[0] : e == 1 ? w[1] : e == 2 ? w[2] : w[3]) * iden;
                    TOPE[gi * 64 + row * 4 + e] = ek; TOPW[gi * 64 + row * 4 + e] = wk; TOPR[gi * 64 + row * 4 + e] = atomicAdd(&LCNT[ek], 1); }
            }
        }
        __syncthreads();
        if (tid < 32) { int t2 = tid; asm volatile("" : "+v"(t2));
            const int c = LCNT[t2]; LBASE[t2] = c > 0 ? (int)atomicAdd((unsigned*)(P.ws + WS_CTL) + CW_CNT + layer * 64 + t2, (unsigned)c) : 0; }
        __syncthreads();
        int* tok_of = (int*)(P.ws + WS_TOKOF); int* pair_of = (int*)(P.ws + WS_PAIROF); float* gate_of = (float*)(P.ws + WS_GATEOF);
        for (int p = tid; p < (qe - qs) * 64; p += NT) {
            const int e = TOPE[p], rk = LBASE[e] + TOPR[p], ur = GU0[p >> 6] + ((p & 63) >> 2), k = p & 3;
            tok_of[(size_t)e * R + rk] = ur; pair_of[(size_t)e * R + rk] = ur * 4 + k; gate_of[(size_t)e * R + rk] = TOPW[p];
        }
    }
#undef N2_U0
#undef N2_XLOAD
#undef N2_SS
#undef N2_LO
#undef N2_HI
}

__device__ __forceinline__ void prefetch_resid(const Ptrs& P, int layer) {
    g8::DenseOrder S; S.init((const bf16*)P.ws, D, (const bf16*)P.ws, D, R, D, (int)gridDim.x, (int)blockIdx.x, layer);
    const int tid = threadIdx.x; unsigned dummy = 0u;
#pragma unroll 1
    for (int i = 0; i < 2; ++i) {
        g8::Unit u; if (!S.next(i, u)) break;
        if (layer == 0) { const int b = u.pm / 17, jt = u.pm % 17;
            const char* t0 = (const char*)(jt == 0 ? P.in[2] + (size_t)(b * CTX) * D : P.in[0] + (size_t)(b * SEQ + (jt - 1) * 256) * D) + u.pn * 1024;
#pragma unroll
            for (int k = 0; k < 4; ++k) { const int l = tid + k * NT; const char* a = t0 + (size_t)(l >> 3) * 4096 + (l & 7) * 128; asm volatile("global_load_dword %0, %1, off" : "+v"(dummy) : "v"(a) : "memory"); } }
        else { const char* t0 = (const char*)((const bf16*)(P.ws + WS_XB) + (size_t)u.pm * 256 * D) + u.pn * 512;
#pragma unroll
            for (int k = 0; k < 2; ++k) { const int l = tid + k * NT; const char* a = t0 + (size_t)(l >> 2) * 2048 + (l & 3) * 128; asm volatile("global_load_dword %0, %1, off" : "+v"(dummy) : "v"(a) : "memory"); } }
    }
    asm volatile("s_waitcnt vmcnt(0)" : "+v"(dummy) :: "memory");
}

struct Args { Ptrs P; int ph_lo, ph_hi; };
constexpr int N_PHASES = 19;
__global__ void __launch_bounds__(NT, 2) mega(Args args) {
    extern __shared__ __attribute__((aligned(16))) unsigned char lds[];
    const Ptrs& P = args.P;
    unsigned char* ws = P.ws;
    const int tid = threadIdx.x, G = gridDim.x;
    const int vcu = (G % 8 == 0) ? ((int)blockIdx.x % 8) * (G / 8) + (int)blockIdx.x / 8 : (int)blockIdx.x;
    LAS unsigned char* LDSP = (LAS unsigned char*)lds;
    volatile LAS unsigned* MISC = (volatile LAS unsigned*)((LAS unsigned char*)lds + MISC_OFF);
    for (int u = tid; u < (LDS_BYTES - LDSCTL_OFF) / 4; u += NT) ((LAS unsigned*)((LAS unsigned char*)lds + LDSCTL_OFF))[u] = 0u;
    __syncthreads();
    XcdBarrier bar = xcd_barrier_post((unsigned*)(ws + WS_CTL) + CW_BAR, MISC + 8);
    const int lo = args.ph_lo, hi = args.ph_hi;
#ifndef PROBE_MASK
#define PROBE_MASK 0u
#endif
    unsigned long long pr_acc = 0ull, pr_t0 = 0ull; unsigned sub_acc = 0u;
#define IN(k) (lo <= (k) && (k) < hi)
#define SEAM(k) do { if (IN(k) && IN((k) + 1)) xcd_barrier(bar); \
        if (PROBE_MASK) { const unsigned long long t_ = __builtin_amdgcn_s_memrealtime(); if ((PROBE_MASK >> (k)) & 1u) pr_acc += t_ - pr_t0; pr_t0 = t_; } } while (0)
    if (PROBE_MASK) pr_t0 = __builtin_amdgcn_s_memrealtime();
    const bf16* H = (const bf16*)(ws + WS_H); bf16* Z = (bf16*)(ws + WS_Z); const bf16* MIX = (const bf16*)(ws + WS_MIX);
    const bf16* Qm = (const bf16*)(ws + WS_QM); const bf16* Km = (const bf16*)(ws + WS_KM); const bf16* Vm = (const bf16*)(ws + WS_VM);

    if (IN(0)) { ph_prologue(P, lds, sub_acc); } SEAM(0);
    if (IN(1)) { ph_rows(P, 0, 0, 0, 0); } SEAM(1);
    if (IN(2)) { g8::DenseOrder S; S.init(H, D, (const bf16*)(ws + WS_WEVIN), D, R, EVEN_IN_P, G, (int)blockIdx.x, 0); g8::EpiStoreBf16 E{Z, EVEN_IN_P};
        g8::gemm_phase<g8::EpiStoreBf16, g8::DenseOrder, false, true>(LDSP, D, D, S, E); } SEAM(2);
    if (IN(3)) {
        { g8::UpOrder S{(const char*)Z, (const char*)(ws + WS_WUQ), (const char*)(ws + WS_WUKV), G, (int)blockIdx.x}; g8::EpiStoreBf16 E{(bf16*)(ws + WS_QP), 1792};
          g8::gemm_phase<g8::EpiStoreBf16, g8::UpOrder, false, true>(LDSP, EVEN_IN_P, 384, S, E); }
        ph_lru(P, lds, 0, 0);
    } SEAM(3);
    if (IN(4)) { ph_mla_prep(P); } SEAM(4);
    if (IN(5)) {
        ph_lru(P, lds, 1, 128);
        for (int it = vcu; it < 256 + 16; it += G) {
            if (it < 256) mla_attn_unit(P, lds, it / 64, (it / 16) % 4, it % 16, 0, sub_acc);
            else { const int i2 = it - 256; mla_attn_unit(P, lds, i2 / 4, i2 % 4, 0, 1, sub_acc); }
        }
        prefetch_resid(P, 0);
    } SEAM(5);
    if (IN(6)) { g8::DenseOrder S; S.init(MIX, D, (const bf16*)(ws + WS_WEVOUT), D, R, D, G, (int)blockIdx.x, 0); g8::EpiOut E{P, 0};
        g8::gemm_phase<g8::EpiOut, g8::DenseOrder, false, true>(LDSP, D, D, S, E); } SEAM(6);
    if (IN(7)) { ph_norm2_router(P, lds, 0, 0); } SEAM(7);
    if (IN(8)) { g8::MoeOrder S{(const char*)H, (const char*)(ws + WS_WGU) + (size_t)0 * NE * 2048 * 1024 * 2, (const int*)(ws + WS_TOKOF), (size_t)2048 * 1024 * 2, 8, D, G, vcu, 1, nullptr};
        S.init((const unsigned*)(ws + WS_CTL) + CW_CNT + 0 * 64, (LAS int*)(LDSP + MISC_OFF + 256)); g8::EpiMoe1 E{P, 0}; g8::gemm_phase<g8::EpiMoe1, g8::MoeOrder, true, true>(LDSP, D, D, S, E); } SEAM(8);
    if (IN(9)) { g8::MoeOrder S{(const char*)(ws + WS_ACT), (const char*)(ws + WS_WDN) + (size_t)0 * NE * 1024 * 1024 * 2, nullptr, (size_t)1024 * 1024 * 2, 4, D, G, vcu, 0, nullptr};
        S.init((const unsigned*)(ws + WS_CTL) + CW_CNT + 0 * 64, (LAS int*)(LDSP + MISC_OFF + 256)); g8::EpiMoe2 E{P, 0}; g8::gemm_phase<g8::EpiMoe2, g8::MoeOrder, false, true>(LDSP, D, D, S, E); } SEAM(9);
    if (IN(10)) { ph_rows(P, 0, 2, 0, 1); } SEAM(10);
    if (IN(11)) { g8::DenseOrder S; S.init(H, D, (const bf16*)(ws + WS_WODIN), D, R, ODD_IN, G, (int)blockIdx.x, 0);
        g8::EpiDiffIn E{Z, P.in[25], P.in[26], (const float*)(ws + WS_ROPE), (const float*)(ws + WS_ROPE) + SEQ * 64, (LAS float*)(LDSP + MISC_OFF + 1024)};
        g8::gemm_phase<g8::EpiDiffIn, g8::DenseOrder, false, true>(LDSP, D, D, S, E); } SEAM(11);
    if (IN(13)) {
        for (int it = vcu; it < 512; it += G) { unsigned tq0 = 0u; if (PROBE_SUB == 5 && PROBE_SUBDK == 64) tq0 = (unsigned)__builtin_readcyclecounter();
            diff_attn_unit(P, lds, it / 128, (it / 16) % 8, it % 16, sub_acc);
            if (PROBE_SUB == 5 && PROBE_SUBDK == 64) sub_acc += (unsigned)__builtin_readcyclecounter() - tq0; }
        prefetch_resid(P, 1);
    } SEAM(13);
    if (IN(14)) { g8::DenseOrder S; S.init(MIX, D, (const bf16*)(ws + WS_WODOUT), D, R, D, G, (int)blockIdx.x, 1); g8::EpiOut E{P, 1};
        g8::gemm_phase<g8::EpiOut, g8::DenseOrder, false, true>(LDSP, D, D, S, E); } SEAM(14);
    if (IN(15)) { ph_norm2_router(P, lds, 1, 1); } SEAM(15);
    if (IN(16)) { g8::MoeOrder S{(const char*)H, (const char*)(ws + WS_WGU) + (size_t)1 * NE * 2048 * 1024 * 2, (const int*)(ws + WS_TOKOF), (size_t)2048 * 1024 * 2, 8, D, G, vcu, 1, nullptr};
        S.init((const unsigned*)(ws + WS_CTL) + CW_CNT + 1 * 64, (LAS int*)(LDSP + MISC_OFF + 256)); g8::EpiMoe1 E{P, 1}; g8::gemm_phase<g8::EpiMoe1, g8::MoeOrder, true, true>(LDSP, D, D, S, E); } SEAM(16);
    if (IN(17)) { g8::MoeOrder S{(const char*)(ws + WS_ACT), (const char*)(ws + WS_WDN) + (size_t)1 * NE * 1024 * 1024 * 2, nullptr, (size_t)1024 * 1024 * 2, 4, D, G, vcu, 0, nullptr};
        S.init((const unsigned*)(ws + WS_CTL) + CW_CNT + 1 * 64, (LAS int*)(LDSP + MISC_OFF + 256)); g8::EpiMoe2 E{P, 1}; g8::gemm_phase<g8::EpiMoe2, g8::MoeOrder, false, true>(LDSP, D, D, S, E); } SEAM(17);
    if (IN(18)) { ph_rows(P, 1, 2, 1, 0); }
    if (PROBE_MASK) { const unsigned long long t_ = __builtin_amdgcn_s_memrealtime(); if ((PROBE_MASK >> 18) & 1u) pr_acc += t_ - pr_t0;
        if (blockIdx.x == 0) { const unsigned long long t1 = t_ + 8ull * pr_acc; while (__builtin_amdgcn_s_memrealtime() < t1) __builtin_amdgcn_s_sleep(8); } }
    if (PROBE_SUB && (PROBE_SUBBLK < 0 || (int)blockIdx.x == PROBE_SUBBLK)) { const unsigned long long t1 = __builtin_readcyclecounter() + 8ull * (unsigned long long)sub_acc; while (__builtin_readcyclecounter() < t1) __builtin_amdgcn_s_sleep(8); }
#undef IN
#undef SEAM
}

#ifndef MK_PER_PHASE
#define MK_PER_PHASE 0
#endif
extern "C" void kernel_launch(void* const* d_in, const int* in_sizes, int n_in, void* d_out, int out_size, void* d_ws, size_t ws_size, hipStream_t stream) {
    static int grid = 0;
    if (grid == 0) {
        if (n_in != 38 || ws_size < WS_END) { fprintf(stderr, "kernel_launch: bad args n_in=%d ws=%zu need %zu\n", n_in, ws_size, (size_t)WS_END); grid = -1; return; }
        int dev = 0, cus = 0, per_cu = 0;
        if (hipGetDevice(&dev) != hipSuccess || hipDeviceGetAttribute(&cus, hipDeviceAttributeMultiprocessorCount, dev) != hipSuccess) { grid = -1; return; }
        if (hipFuncSetAttribute((const void*)mega, hipFuncAttributeMaxDynamicSharedMemorySize, LDS_BYTES) != hipSuccess) { fprintf(stderr, "kernel_launch: hipFuncSetAttribute failed\n"); grid = -1; return; }
        if (hipOccupancyMaxActiveBlocksPerMultiprocessor(&per_cu, (const void*)mega, NT, LDS_BYTES) != hipSuccess || per_cu < 1) { fprintf(stderr, "kernel_launch: occupancy query says %d blocks/CU\n", per_cu); grid = -1; return; }
        (void)hipGetLastError();
        grid = cus;
    }
    if (grid < 0) return;
    if (hipMemsetAsync((char*)d_ws + WS_CTL, 0, 1u << 20, stream) != hipSuccess) return;
    Args a; memset((void*)&a, 0, sizeof(a));
    for (int i = 0; i < 38; ++i) a.P.in[i] = (const float*)d_in[i];
    a.P.out = (float*)d_out; a.P.ws = (unsigned char*)d_ws;
#if MK_PER_PHASE
    for (int p = 0; p < N_PHASES; ++p) { a.ph_lo = p; a.ph_hi = p + 1; hipLaunchKernelGGL(mega, dim3(grid), dim3(NT), LDS_BYTES, stream, a); }
#else
    a.ph_lo = 0; a.ph_hi = N_PHASES;
    hipLaunchKernelGGL(mega, dim3(grid), dim3(NT), LDS_BYTES, stream, a);
#endif
    const hipError_t le = hipPeekAtLastError();
    if (le != hipSuccess) fprintf(stderr, "kernel_launch: launch failed: %s\n", hipGetErrorName(le));
}
```

```cpp
#include <hip/hip_runtime.h>
#include <cstdio>
#include <cstdint>
#include <cstring>

typedef unsigned short bf16;
typedef unsigned u32x4 __attribute__((ext_vector_type(4)));
typedef float f32x4 __attribute__((ext_vector_type(4)));

constexpr int D = 1024, NB = 4, SEQ = 4096, CTX = 256, SU = SEQ + CTX, R = NB * SU;
constexpr int GRID_W = 64;
constexpr int LRU_W = 512, LRU_NB = 8, LRU_BW = 64;
constexpr int MLA_H = 4, MLA_QR = 384, MLA_KVR = 256, MLA_NOPE = 128, MLA_ROPE = 64, MLA_V = 128, MLA_QK = 192;
constexpr int EVEN_IN = 1728, EVEN_IN_P = 1792;
constexpr int DIFF_H = 8, ODD_IN = 3072;
constexpr int NE = 32, TOPK = 4, DFF = 1024;
constexpr float EPS = 1e-6f;
constexpr int CHUNK = 128, NCH = SU / CHUNK;

constexpr size_t al256(size_t x) { return (x + 255) / 256 * 256; }
constexpr size_t WS_CTL = 0;
constexpr size_t WS_MOD = 1u << 20;
constexpr size_t WS_SCAL = WS_MOD + al256(2 * 5 * 6144 * 4);
constexpr size_t WS_WEVIN = WS_SCAL + 8192;
constexpr size_t WS_WEVOUT = WS_WEVIN + (size_t)EVEN_IN_P * D * 2;
constexpr size_t WS_WUQ = WS_WEVOUT + (size_t)D * D * 2;
constexpr size_t WS_WUKV = WS_WUQ + (size_t)768 * 384 * 2;
constexpr size_t WS_WLRU = WS_WUKV + (size_t)1024 * 384 * 2;
constexpr size_t WS_WODIN = WS_WLRU + (size_t)32 * 4096 * 2;
constexpr size_t WS_WODOUT = WS_WODIN + (size_t)ODD_IN * D * 2;
constexpr size_t WS_WGU = WS_WODOUT + (size_t)D * D * 2;
constexpr size_t WS_WDN = WS_WGU + (size_t)2 * NE * 2048 * 1024 * 2;
constexpr size_t WS_XC = WS_WDN + (size_t)2 * NE * 1024 * 1024 * 2;
constexpr size_t WS_H = WS_XC + (size_t)NB * CTX * D * 4;
constexpr size_t WS_Z = WS_H + (size_t)R * D * 2;
constexpr size_t WS_QP = WS_Z + (size_t)R * ODD_IN * 2;
constexpr size_t WS_KVP = WS_QP + (size_t)R * 768 * 2;
constexpr size_t WS_QM = WS_KVP + (size_t)R * 1024 * 2;
constexpr size_t WS_KM = WS_QM + (size_t)R * 768 * 2;
constexpr size_t WS_VM = WS_KM + (size_t)R * 768 * 2;
constexpr size_t WS_AGG = WS_VM + (size_t)R * 512 * 2;
constexpr size_t WS_MIX = WS_AGG + al256((size_t)NB * NCH * 2 * 512 * 2 * 4);
constexpr size_t WS_TOKOF = WS_MIX + (size_t)R * D * 2;
constexpr size_t WS_PAIROF = WS_TOKOF + (size_t)NE * R * 4;
constexpr size_t WS_GATEOF = WS_PAIROF + (size_t)NE * R * 4;
constexpr size_t ACT_ROWS = (size_t)R * TOPK + NE * 256;
constexpr size_t WS_ACT = WS_GATEOF + (size_t)NE * R * 4;
constexpr size_t WS_Y = WS_ACT + ACT_ROWS * 1024 * 2;
constexpr size_t WS_XB = WS_Y + (size_t)R * TOPK * 1024 * 2;
constexpr size_t WS_ROPE = WS_XB + (size_t)R * D * 2;
constexpr size_t WS_END = WS_ROPE + (size_t)2 * SEQ * 64 * 4;

constexpr int CW_CNT = 64;

__device__ __forceinline__ float bf2f(bf16 v) { return __uint_as_float((unsigned)v << 16); }
__device__ __forceinline__ bf16 f2bf(float f) { unsigned u = __float_as_uint(f); return (bf16)((u + 0x7fffu + ((u >> 16) & 1u)) >> 16); }
template <int CTRL> __device__ __forceinline__ float dpp_f(float x) { return __uint_as_float((unsigned)__builtin_amdgcn_update_dpp(0, (int)__float_as_uint(x), CTRL, 0xf, 0xf, false)); }
template <int CTRL> __device__ __forceinline__ int dpp_i(int x) { return __builtin_amdgcn_update_dpp(0, x, CTRL, 0xf, 0xf, false); }
constexpr int DPP_X1 = 0xB1, DPP_X2 = 0x4E, DPP_HM = 0x141, DPP_RM = 0x140;
__device__ __forceinline__ float lane_xor32(float x) { const auto r = __builtin_amdgcn_permlane32_swap(__float_as_uint(x), __float_as_uint(x), false, false); return __uint_as_float((threadIdx.x & 32) ? r[0] : r[1]); }
__device__ __forceinline__ float lane_xor16(float x) { const auto r = __builtin_amdgcn_permlane16_swap(__float_as_uint(x), __float_as_uint(x), false, false); return __uint_as_float((threadIdx.x & 16) ? r[0] : r[1]); }
__device__ __forceinline__ int lane_xor16i(int x) { const auto r = __builtin_amdgcn_permlane16_swap((unsigned)x, (unsigned)x, false, false); return (int)((threadIdx.x & 16) ? r[0] : r[1]); }
__device__ __forceinline__ float lane_shift16(float x, bool down) { const float y = lane_xor16(x), z = lane_xor32(y); const bool odd = (threadIdx.x & 16) != 0; return (odd == down) ? y : z; }
__device__ __forceinline__ float sum16(float v) { v += dpp_f<DPP_X1>(v); v += dpp_f<DPP_X2>(v); v += dpp_f<DPP_HM>(v); v += dpp_f<DPP_RM>(v); return v; }
__device__ __forceinline__ float sum32(float v) { v = sum16(v); v += lane_xor16(v); return v; }
__device__ __forceinline__ float wave_sum(float v) { v = sum32(v); v += lane_xor32(v); return v; }
__device__ __forceinline__ unsigned g8_cvt_pk(float lo, float hi) { unsigned r; asm volatile("v_cvt_pk_bf16_f32 %0, %1, %2" : "=v"(r) : "v"(lo), "v"(hi)); return r; }
__device__ __forceinline__ float sigmoidf_(float x) { return 1.f / (1.f + __expf(-x)); }
__device__ __forceinline__ float gelu_tanh(float x) { const float t = tanhf(0.7978845608028654f * (x + 0.044715f * x * x * x)); return 0.5f * x * (1.f + t); }

struct Ptrs {
    const float* in[38];
    float* out;
    unsigned char* ws;
};

__device__ __forceinline__ const float* res_in_row(const Ptrs& P, int layer, int u) {
    const int b = u / SU, j = u % SU;
    if (layer == 0) return j < CTX ? P.in[2] + (size_t)(b * CTX + j) * D : P.in[0] + (size_t)(b * SEQ + j - CTX) * D;
    return j < CTX ? (const float*)(P.ws + WS_XC) + (size_t)(b * CTX + j) * D : P.out + (size_t)(b * SEQ + j - CTX) * D;
}
__device__ __forceinline__ float* res_out_row(const Ptrs& P, int u) {
    const int b = u / SU, j = u % SU;
    return j < CTX ? (float*)(P.ws + WS_XC) + (size_t)(b * CTX + j) * D : P.out + (size_t)(b * SEQ + j - CTX) * D;
}
__device__ __forceinline__ const float* mod_row(const Ptrs& P, int layer, int u) {
    const int b = u / SU, j = u % SU;
    return (const float*)(P.ws + WS_MOD) + (size_t)(layer * 5 + (j < CTX ? 4 : b)) * 6144;
}

constexpr float LOG2E = 1.4426950408889634f;
#define GAS __attribute__((address_space(1)))
#define LAS __attribute__((address_space(3)))
constexpr int NT = 512;
constexpr int LDS_BYTES = 147456;
constexpr int RING_BYTES = 131072, LDSCTL_OFF = RING_BYTES, MISC_OFF = LDSCTL_OFF + 320;
constexpr int CW_BAR = 4096;
constexpr int CW_TMO = 0;

#define XB_TMO      128
#define XB_XCNT(j)  (256  + 64 * (j))
#define XB_XSUB(j)  (1280 + 64 * (j))
#define XB_XGEN(j)  (2304 + 64 * (j))
#define XB_TOP      3328
#define XB_TOPGEN   3392
#define XCD_BAR_WORDS 3456
#define XB_SPIN_CAP (1u << 22)
__device__ __forceinline__ unsigned xb_ld(unsigned* p)              { return __hip_atomic_load(p, __ATOMIC_RELAXED, __HIP_MEMORY_SCOPE_AGENT); }
__device__ __forceinline__ unsigned xb_add(unsigned* p, unsigned v) { return __hip_atomic_fetch_add(p, v, __ATOMIC_RELAXED, __HIP_MEMORY_SCOPE_AGENT); }
__device__ __forceinline__ unsigned xb_xcc_id() { return (unsigned)__builtin_amdgcn_s_getreg((3 << 11) | 20) & 0xFu; }
#define XB_SPIN(cond, bar) do { unsigned _sp = 0; while (cond) { __builtin_amdgcn_s_sleep(1); \
    if ((++_sp & 255u) == 0u) { if (xb_ld(&(bar)[XB_TMO])) break; if (_sp > XB_SPIN_CAP) { atomicAdd(&(bar)[XB_TMO], 1u); break; } } } } while (0)
struct XcdBarrier { unsigned* bar; unsigned x; volatile LAS unsigned* st; };
__device__ __forceinline__ XcdBarrier xcd_barrier_post(unsigned* bar, volatile LAS unsigned* st) {
    XcdBarrier b; b.bar = bar; b.x = xb_xcc_id(); b.st = st;
    if (threadIdx.x == 0) (void)xb_add(&bar[XB_XCNT(b.x)], 1u);
    return b;
}
__device__ __forceinline__ void xcd_barrier_complete(unsigned* bar, unsigned x, unsigned& nloc, unsigned& nx) {
    const unsigned G = gridDim.x * gridDim.y * gridDim.z;
    unsigned sum, cnt, mine, sp = 0u;
    for (;;) {
        sum = 0u; cnt = 0u; mine = 0u;
#pragma unroll
        for (unsigned j = 0; j < 16; ++j) { const unsigned c = xb_ld(&bar[XB_XCNT(j)]); sum += c; cnt += (c > 0u) ? 1u : 0u; mine = (j == x) ? c : mine; }
        if (sum == G) break;
        __builtin_amdgcn_s_sleep(1);
        if ((++sp & 255u) == 0u) { if (xb_ld(&bar[XB_TMO])) break; if (sp > XB_SPIN_CAP) { atomicAdd(&bar[XB_TMO], 1u); break; } }
    }
    nloc = mine > 0u ? mine : 1u; nx = cnt > 0u ? cnt : 1u;
}
__device__ __forceinline__ void xcd_barrier(const XcdBarrier& b) {
    asm volatile("s_waitcnt vmcnt(0)" ::: "memory");
    __syncthreads();
    if (threadIdx.x == 0) {
        unsigned* bar = b.bar;
        __builtin_amdgcn_s_waitcnt(0);
        unsigned nloc = b.st[0], nx = b.st[1];
        if (nloc == 0u) { xcd_barrier_complete(bar, b.x, nloc, nx); b.st[0] = nloc; b.st[1] = nx; }
        const unsigned old = xb_add(&bar[XB_XSUB(b.x)], 1u);
        const unsigned gen = old / nloc;
        if (old + 1u == (gen + 1u) * nloc) {
            __builtin_amdgcn_fence(__ATOMIC_RELEASE, "agent");
            asm volatile("s_waitcnt vmcnt(0)" ::: "memory");
            const unsigned og = xb_add(&bar[XB_TOP], 1u);
            const unsigned tg = og / nx;
            if (og + 1u == (tg + 1u) * nx) xb_add(&bar[XB_TOPGEN], 1u);
            else XB_SPIN(xb_ld(&bar[XB_TOPGEN]) == tg, bar);
            __builtin_amdgcn_fence(__ATOMIC_ACQUIRE, "agent");
            xb_add(&bar[XB_XGEN(b.x)], 1u);
            asm volatile("s_waitcnt vmcnt(0)" ::: "memory");
        } else {
            XB_SPIN(xb_ld(&bar[XB_XGEN(b.x)]) == gen, bar);
            __builtin_amdgcn_fence(__ATOMIC_ACQUIRE, "agent");
            asm volatile("s_waitcnt vmcnt(0)" ::: "memory");
        }
    }
    __syncthreads();
}

struct TJob { const float* src; bf16* dst; const float* rs; int K, N, Npad, perm, batch; size_t sstr, dstr; int Ksrc; };
__device__ __forceinline__ void tt_load(const TJob& j, int it, int lane, f32x4 (&v)[16]) {
    const int tn = j.Npad / 64, per = tn * (j.K / 64), z = it / per, r = it % per, n0 = (r % tn) * 64, k0 = (r / tn) * 64;
    const float* src = j.src + z * j.sstr;
    const int n4 = (lane & 15) * 4, np = n0 + n4;
    int sc = np; if (j.perm == 1) sc = (np / 256) * 128 + (np % 128) + ((np % 256) / 128) * 1024;
#pragma unroll
    for (int i = 0; i < 16; ++i) { const int k = k0 + i * 4 + (lane >> 4); f32x4 t = {0.f, 0.f, 0.f, 0.f}; if (sc < j.N && k < j.Ksrc) { t = *(const f32x4*)(src + (size_t)k * j.N + sc); if (j.rs) t = t * j.rs[k]; } v[i] = t; }
}
__device__ __forceinline__ void tt_store(const TJob& j, int it, int lane, const f32x4 (&v)[16], float* wt) {
    const int tn = j.Npad / 64, per = tn * (j.K / 64), z = it / per, r = it % per, n0 = (r % tn) * 64, k0 = (r / tn) * 64;
    bf16* dst = j.dst + z * j.dstr + ((((size_t)(n0 >> 8) * (j.K >> 6) + (k0 >> 6)) << 14) + (((n0 & 255) + lane) << 6));
    const int n4 = (lane & 15) * 4;
#pragma unroll
    for (int half = 0; half < 2; ++half) {
#pragma unroll
        for (int i = 0; i < 8; ++i) *(f32x4*)(wt + (i * 4 + (lane >> 4)) * 68 + n4) = v[half * 8 + i];
        asm volatile("s_waitcnt lgkmcnt(0)" ::: "memory");
#pragma unroll
        for (int kc = 0; kc < 4; ++kc) { float f[8];
#pragma unroll
            for (int q = 0; q < 8; ++q) f[q] = wt[(kc * 8 + q) * 68 + lane];
            u32x4 w; w.x = f2bf(f[0]) | ((unsigned)f2bf(f[1]) << 16); w.y = f2bf(f[2]) | ((unsigned)f2bf(f[3]) << 16); w.z = f2bf(f[4]) | ((unsigned)f2bf(f[5]) << 16); w.w = f2bf(f[6]) | ((unsigned)f2bf(f[7]) << 16);
            *(u32x4*)(dst + half * 32 + kc * 8) = w; }
        asm volatile("s_waitcnt lgkmcnt(0)" ::: "memory");
    }
}
__device__ __forceinline__ void run_tjob(const TJob& j, float* wt, int& base, int NW, int gw, int lane) {
    const int total = (j.Npad / 64) * (j.K / 64) * j.batch;
    int it = (gw - base % NW + NW) % NW;
    if (it < total) {
        f32x4 cur[16], nxt[16];
        tt_load(j, it, lane, cur);
        for (; it < total; it += NW) {
            const bool more = it + NW < total;
            if (more) tt_load(j, it + NW, lane, nxt);
            tt_store(j, it, lane, cur, wt);
            if (more) {
#pragma unroll
                for (int i = 0; i < 16; ++i) cur[i] = nxt[i]; }
        }
    }
    base += total;
}
__device__ __forceinline__ void bt_load(const float* __restrict__ src, int N, int perm, int it, int ntn, f32x4 (&v)[8]) {
    const int wid = threadIdx.x >> 6, lane = threadIdx.x & 63;
    const int per = 16 * ntn, z = it / per, r = it % per, kt = r / ntn, nt = r % ntn;
    const int np = nt * 256 + lane * 4;
    const int sc = perm ? (nt * 128 + (lane & 31) * 4 + (lane >> 5) * 1024) : np;
    const float* p = src + (size_t)z * 1024 * N + (size_t)(kt * 64 + wid * 8) * N + sc;
#pragma unroll
    for (int i = 0; i < 8; ++i) v[i] = *(const f32x4*)(p + (size_t)i * N);
}
__device__ __forceinline__ void ph_big_transpose(const float* __restrict__ src, int N, int perm, int batch, bf16* __restrict__ dst, float* tile  , int G) {
    const int tid = threadIdx.x, wid = tid >> 6, lane = tid & 63, ntn = N / 256, total = batch * 16 * ntn;
    int it = (int)blockIdx.x;
    if (it >= total) return;
    f32x4 cur[8], nxt[8], nx2[8];
    bt_load(src, N, perm, it, ntn, cur);
    if (it + G < total) bt_load(src, N, perm, it + G, ntn, nxt);
    for (; it < total; it += G) {
        const bool more = it + G < total, more2 = it + 2 * G < total;
        if (more2) bt_load(src, N, perm, it + 2 * G, ntn, nx2);
        __syncthreads();
#pragma unroll
        for (int i = 0; i < 8; ++i) { float* t = tile + (wid * 8 + i) * 257 + lane * 4; t[0] = cur[i][0]; t[1] = cur[i][1]; t[2] = cur[i][2]; t[3] = cur[i][3]; }
        __syncthreads();
        const int per = 16 * ntn, z = it / per, r = it % per, kt = r / ntn, nt = r % ntn;
        bf16* d = dst + (size_t)z * N * 1024 + (((size_t)nt * 16 + kt) << 14);
        const int kc = lane & 7;
#pragma unroll
        for (int pss = 0; pss < 4; ++pss) {
            const int n = wid * 32 + pss * 8 + (lane >> 3); float f[8];
#pragma unroll
            for (int j = 0; j < 8; ++j) f[j] = tile[(kc * 8 + j) * 257 + n];
            u32x4 w; w.x = g8_cvt_pk(f[0], f[1]); w.y = g8_cvt_pk(f[2], f[3]); w.z = g8_cvt_pk(f[4], f[5]); w.w = g8_cvt_pk(f[6], f[7]);
            *(u32x4*)(d + n * 64 + kc * 8) = w;
        }
        if (more) {
#pragma unroll
            for (int i = 0; i < 8; ++i) { cur[i] = nxt[i]; nxt[i] = nx2[i]; } }
    }
    __syncthreads();
}
#ifndef PROBE_SUB
#define PROBE_SUB 0
#define PROBE_SUBDK 0
#endif
#define PSEC(k) do { if (PROBE_SUB == (k)) { const unsigned t_ = (unsigned)__builtin_readcyclecounter(); sacc += t_ - pt0; } if (PROBE_SUB >= 10) pt0 = (unsigned)__builtin_readcyclecounter(); } while (0)
__device__ __forceinline__ void ph_prologue(const Ptrs& P, unsigned char* lds, unsigned& sacc) {
    unsigned char* ws = P.ws; const int G = gridDim.x; int base = 0; unsigned pt0 = 0u; PSEC(-1);
    const int wave = threadIdx.x >> 6, lane = threadIdx.x & 63, NW = G * 8, gw = (int)blockIdx.x + G * wave;
    float* wt = (float*)lds + wave * (32 * 68);
    {
        float* s = (float*)lds + 8 * 32 * 68;
        float* part = s + 5 * 1024;
        for (int it = (int)blockIdx.x; it < 2 * 128; it += G) {
            const int layer = it / 128, cb = (it % 128) * 48;
            __syncthreads();
            for (int i = threadIdx.x; i < 5 * 1024; i += NT) { const int r = i / 1024, k = i % 1024; const float c = r < 4 ? P.in[1][r * 1024 + k] : P.in[3][k]; s[i] = c / (1.f + __expf(-c)); }
            __syncthreads();
            const int kr = lane >> 4, c4 = (lane & 15) < 12 ? (lane & 15) * 4 : 44;
            const float* w = P.in[4] + (size_t)layer * 1024 * 6144 + (size_t)(wave * 128 + kr) * 6144 + cb + c4;
            float a[5][4];
#pragma unroll
            for (int r = 0; r < 5; ++r) { a[r][0] = 0.f; a[r][1] = 0.f; a[r][2] = 0.f; a[r][3] = 0.f; }
#pragma unroll 1
            for (int hh = 0; hh < 2; ++hh) {
                f32x4 wv[16];
#pragma unroll
                for (int i = 0; i < 16; ++i) wv[i] = *(const f32x4*)(w + (size_t)(hh * 64 + i * 4) * 6144);
#pragma unroll
                for (int i = 0; i < 16; ++i) { const int k = wave * 128 + hh * 64 + i * 4 + kr;
#pragma unroll
                    for (int r = 0; r < 5; ++r) { const float sv = s[r * 1024 + k]; a[r][0] += sv * wv[i][0]; a[r][1] += sv * wv[i][1]; a[r][2] += sv * wv[i][2]; a[r][3] += sv * wv[i][3]; } }
            }
#pragma unroll
            for (int r = 0; r < 5; ++r)
#pragma unroll
                for (int e = 0; e < 4; ++e) { float t = a[r][e]; t += lane_xor16(t); t += lane_xor32(t); if (lane < 12) part[(wave * 5 + r) * 64 + c4 + e] = t; }
            __syncthreads();
            if (threadIdx.x < 320 && (threadIdx.x & 63) < 48) { const int r = threadIdx.x / 64, c = threadIdx.x % 64; float t = P.in[5][layer * 6144 + cb + c];
#pragma unroll
                for (int wv = 0; wv < 8; ++wv) t += part[(wv * 5 + r) * 64 + c];
                ((float*)(ws + WS_MOD))[(size_t)(layer * 5 + r) * 6144 + cb + c] = t; }
        }
        __syncthreads();
    }
    PSEC(10);
    TJob j;
    ph_big_transpose(P.in[34], 2048, 1, 2 * NE, (bf16*)(ws + WS_WGU), (float*)lds, G);
    PSEC(11);
    ph_big_transpose(P.in[36], 1024, 0, 2 * NE, (bf16*)(ws + WS_WDN), (float*)lds, G);
    PSEC(12);
    j = TJob{P.in[8], (bf16*)(ws + WS_WEVIN), nullptr, 1024, EVEN_IN, EVEN_IN_P, 0, 1, 0, 0, 1024}; run_tjob(j, wt, base, NW, gw, lane);
    j = TJob{P.in[9], (bf16*)(ws + WS_WEVOUT), nullptr, 1024, 1024, 1024, 0, 1, 0, 0, 1024}; run_tjob(j, wt, base, NW, gw, lane);
    j = TJob{P.in[18], (bf16*)(ws + WS_WUQ), P.in[17], 384, 768, 768, 0, 1, 0, 0, 384}; run_tjob(j, wt, base, NW, gw, lane);
    j = TJob{P.in[20], (bf16*)(ws + WS_WUKV), P.in[19], 384, 1024, 1024, 0, 1, 0, 0, 256}; run_tjob(j, wt, base, NW, gw, lane);
    j = TJob{P.in[12], (bf16*)(ws + WS_WLRU), nullptr, 64, 64, 64, 0, 8, 4096, 4096, 64}; run_tjob(j, wt, base, NW, gw, lane);
    j = TJob{P.in[14], (bf16*)(ws + WS_WLRU) + 8 * 4096, nullptr, 64, 64, 64, 0, 8, 4096, 4096, 64}; run_tjob(j, wt, base, NW, gw, lane);
    j = TJob{P.in[12] + 8 * 4096, (bf16*)(ws + WS_WLRU) + 16 * 4096, nullptr, 64, 64, 64, 0, 8, 4096, 4096, 64}; run_tjob(j, wt, base, NW, gw, lane);
    j = TJob{P.in[14] + 8 * 4096, (bf16*)(ws + WS_WLRU) + 24 * 4096, nullptr, 64, 64, 64, 0, 8, 4096, 4096, 64}; run_tjob(j, wt, base, NW, gw, lane);
    j = TJob{P.in[23], (bf16*)(ws + WS_WODIN), nullptr, 1024, ODD_IN, ODD_IN, 0, 1, 0, 0, 1024}; run_tjob(j, wt, base, NW, gw, lane);
    j = TJob{P.in[24], (bf16*)(ws + WS_WODOUT), nullptr, 1024, 1024, 1024, 0, 1, 0, 0, 1024}; run_tjob(j, wt, base, NW, gw, lane);
    __syncthreads();
    PSEC(13);
    {
        float* rc = (float*)(ws + WS_ROPE); float* rs = rc + SEQ * 64;
        for (int i = (int)blockIdx.x * NT + threadIdx.x; i < SEQ * 64; i += G * NT) {
            const int t = i >> 6, e = i & 63, q = e & 15;
            const float f = exp2f(-(float)(2 * q) / 32.f * 13.287712379549449f);
            const float ang = (float)((e >> 5) ? (t % GRID_W) : (t / GRID_W)) * f;
            float sv, cv; sincosf(ang, &sv, &cv); rc[i] = cv; rs[i] = sv;
        }
    }
    if ((int)blockIdx.x == G - 2) { float* c8t = (float*)(ws + WS_SCAL) + 1024; for (int i = threadIdx.x; i < 2 * LRU_W; i += NT) c8t[i] = 8.f * LOG2E * log1pf(__expf(-P.in[16][i])); }
    if ((int)blockIdx.x == G - 1 && threadIdx.x == 0) {
        float* sc = (float*)(ws + WS_SCAL);
        float mq = 0, mk = 0;
        for (int i = 0; i < 192; ++i) { mq = fmaxf(mq, fabsf(P.in[21][i])); mk = fmaxf(mk, fabsf(P.in[22][i])); }
        sc[0] = sqrtf(192.f) * mq * mk * LOG2E;
        mq = 0; mk = 0;
        for (int i = 0; i < 64; ++i) { mq = fmaxf(mq, fabsf(P.in[25][i])); mk = fmaxf(mk, fabsf(P.in[26][i])); }
        sc[1] = 8.f * mq * mk * LOG2E;
        float s1 = 0, s2 = 0;
        for (int i = 0; i < 64; ++i) { s1 += P.in[27][i] * P.in[28][i]; s2 += P.in[29][i] * P.in[30][i]; }
        const float lam_init = 0.8f - 0.6f * expf(-0.3f * 1.f);
        sc[2] = expf(s1) - expf(s2) + lam_init;
        sc[3] = 1.f - lam_init;
    }
}

__device__ __forceinline__ void norm_mod_store(const Ptrs& P, float (&v)[16], int lane, int u, int layer, int which) {
    const float* g = (which == 0 ? P.in[6] : P.in[7]) + layer * D;
    const float* md = mod_row(P, layer, u) + (which == 0 ? 0 : 3 * D);
    f32x4 gv[4], scv[4], shv[4];
#pragma unroll
    for (int j = 0; j < 4; ++j) { const int c = j * 256 + lane * 4; gv[j] = *(const f32x4*)(g + c); scv[j] = *(const f32x4*)(md + D + c); shv[j] = *(const f32x4*)(md + c); }
    float ss = 0.f;
#pragma unroll
    for (int i = 0; i < 16; ++i) ss += v[i] * v[i];
    const float rstd = rsqrtf(wave_sum(ss) * (1.f / D) + EPS);
    bf16* h = (bf16*)(P.ws + WS_H) + (size_t)u * D;
#pragma unroll
    for (int j = 0; j < 4; ++j) {
        const int c = j * 256 + lane * 4;
#pragma unroll
        for (int e = 0; e < 4; ++e) v[4 * j + e] = v[4 * j + e] * rstd * gv[j][e] * (1.f + scv[j][e]) + shv[j][e];
        const unsigned lo = f2bf(v[4 * j]) | ((unsigned)f2bf(v[4 * j + 1]) << 16), hi = f2bf(v[4 * j + 2]) | ((unsigned)f2bf(v[4 * j + 3]) << 16);
        *(uint2*)(h + c) = make_uint2(lo, hi);
    }
}
struct RowIn { f32x4 xf[4]; uint2 xb[4]; uint2 y[4][4]; };
__device__ __forceinline__ RowIn rows_load(const Ptrs& P, int layer, int mode, int u, int lane) {
    RowIn r{};
    if (mode == 0) { const float* x = res_in_row(P, layer, u);
#pragma unroll
        for (int j = 0; j < 4; ++j) r.xf[j] = *(const f32x4*)(x + j * 256 + lane * 4); }
    else { const bf16* x = (const bf16*)(P.ws + WS_XB) + (size_t)u * D; const bf16* y = (const bf16*)(P.ws + WS_Y) + (size_t)u * 4 * 1024;
#pragma unroll
        for (int j = 0; j < 4; ++j) { const int c = j * 256 + lane * 4; r.xb[j] = *(const uint2*)(x + c);
#pragma unroll
            for (int k = 0; k < 4; ++k) r.y[k][j] = *(const uint2*)(y + k * 1024 + c); } }
    return r;
}
__device__ __forceinline__ void ph_rows(const Ptrs& P, int layer, int mode, int latent_only, int next_norm) {
    const int wave = threadIdx.x >> 6, lane = threadIdx.x & 63, G = gridDim.x;
    const int NR = latent_only ? NB * SEQ : R;
#define ROW_U(q) (latent_only ? ((q) / SEQ) * SU + CTX + (q) % SEQ : (q))
    int q = (int)blockIdx.x * 8 + wave;
    if (q >= NR) return;
    RowIn cur = rows_load(P, layer, mode, ROW_U(q), lane);
    for (; q < NR; q += G * 8) {
        const int u = ROW_U(q), qn = q + G * 8;
        RowIn nxt = cur;
        if (qn < NR) nxt = rows_load(P, layer, mode, ROW_U(qn), lane);
        float v[16];
        if (mode == 0) {
#pragma unroll
            for (int j = 0; j < 4; ++j) { v[4 * j] = cur.xf[j][0]; v[4 * j + 1] = cur.xf[j][1]; v[4 * j + 2] = cur.xf[j][2]; v[4 * j + 3] = cur.xf[j][3]; }
            norm_mod_store(P, v, lane, u, layer, 0);
        } else {
            const float* g2 = mod_row(P, layer, u) + 5 * D; float* xo = res_out_row(P, u); bf16* xbo = (bf16*)(P.ws + WS_XB) + (size_t)u * D;
            f32x4 gv[4];
#pragma unroll
            for (int j = 0; j < 4; ++j) gv[j] = *(const f32x4*)(g2 + j * 256 + lane * 4);
#pragma unroll
            for (int j = 0; j < 4; ++j) { const int c = j * 256 + lane * 4; f32x4 o;
                const uint2 t = cur.xb[j];
                v[4 * j] = __uint_as_float(t.x << 16); v[4 * j + 1] = __uint_as_float(t.x & 0xffff0000u); v[4 * j + 2] = __uint_as_float(t.y << 16); v[4 * j + 3] = __uint_as_float(t.y & 0xffff0000u);
                float f[4] = {0.f, 0.f, 0.f, 0.f};
#pragma unroll
                for (int k = 0; k < 4; ++k) { const uint2 w = cur.y[k][j]; f[0] += __uint_as_float(w.x << 16); f[1] += __uint_as_float(w.x & 0xffff0000u); f[2] += __uint_as_float(w.y << 16); f[3] += __uint_as_float(w.y & 0xffff0000u); }
#pragma unroll
                for (int e = 0; e < 4; ++e) { v[4 * j + e] += gv[j][e] * f[e]; o[e] = v[4 * j + e]; }
                if (next_norm) { uint2 w; w.x = g8_cvt_pk(o[0], o[1]); w.y = g8_cvt_pk(o[2], o[3]); *(uint2*)(xbo + c) = w; }
                else *(f32x4*)(xo + c) = o; }
            if (next_norm) norm_mod_store(P, v, lane, u, layer + 1, 0);
        }
        cur = nxt;
    }
#undef ROW_U
}

namespace g8 {
typedef short bf16x8 __attribute__((ext_vector_type(8)));
constexpr int BM = 256, BK = 64, HALF = 128, HTB = HALF * BK * 2, STAGE_BYTES = 8 * HTB, NXCD = 8, WGM = 8;
__host__ __device__ __forceinline__ int lds_byte(int r, int c) { const int st = (r >> 4) * 2 + (c >> 5), rr = r & 15, cc = c & 31, ob = rr * 64 + cc * 2; return st * 1024 + (ob ^ (((ob >> 9) & 1) << 5)); }
__host__ __device__ __forceinline__ void stage_rc(int b, int& R, int& C) { const int st = b / 1024, sb = b % 1024, swz = sb ^ (((sb >> 9) & 1) << 5); R = (st >> 1) * 16 + swz / 64; C = (st & 1) * 32 + (swz % 64) / 2; }
__host__ __device__ __forceinline__ int perm32(int rho) { const int n = rho >> 4, i = rho & 15; return 8 * (i >> 2) + 4 * n + (i & 3); }
struct Unit { const char* a; const char* b; int pm, pn, e, aux, cnt; };
__device__ __forceinline__ unsigned cvt_pk_bf16(float lo, float hi) { unsigned r; asm volatile("v_cvt_pk_bf16_f32 %0, %1, %2" : "=v"(r) : "v"(lo), "v"(hi)); return r; }

template <class Epi, class Sched, bool GATHER, bool ALIGN_EPI, bool PFB = false>
__device__ __forceinline__ void gemm_phase(LAS unsigned char* lds, const int lda, const int K, const Sched& S, const Epi& E) {
    const int tid = threadIdx.x, wid = __builtin_amdgcn_readfirstlane(tid >> 6), lane = tid & 63, wr = wid >> 2, wc = wid & 3, fr = lane & 15, fq = lane >> 4;
    const int nt = K / BK;
    int Rr[2], Cc[2]; unsigned voffB[2];
#pragma unroll
    for (int i = 0; i < 2; ++i) { stage_rc(tid * 16 + i * 8192, Rr[i], Cc[i]); const int Rb = Epi::PERM ? ((Rr[i] & ~31) + perm32(Rr[i] & 31)) : Rr[i]; voffB[i] = (unsigned)(Rb * BK + Cc[i]) * 2u; }
    const size_t kstep = (size_t)(BK * 2), kstepB = (size_t)BM * BK * 2;
    const size_t hstepB = (size_t)HALF * BK * 2;
    const unsigned ldsw = (unsigned)wid * 1024u;
    const int aoff = lds_byte(wr * 64 + fr, fq * 8), boff = lds_byte(wc * 32 + fr, fq * 8);
#define G8_SA(b, h) (((b) * 2 + (h)) * HTB)
#define G8_SB(b, h) ((4 + (b) * 2 + (h)) * HTB)
#define G8_STAGE(bufoff, gbase, v0, v1) do { \
        __builtin_amdgcn_global_load_lds((const unsigned*)((const char*)(gbase) + (v0)), (LAS unsigned*)(lds + (bufoff) + ldsw), 16, 0, 0); \
        __builtin_amdgcn_global_load_lds((const unsigned*)((const char*)(gbase) + (v1)), (LAS unsigned*)(lds + (bufoff) + ldsw + 8192), 16, 0, 0); } while (0)
#define G8_LDA(dst, b, h) do { _Pragma("unroll") for (int m = 0; m < 4; ++m) _Pragma("unroll") for (int k = 0; k < 2; ++k) dst[m][k] = *(const LAS bf16x8*)(lds + G8_SA(b, h) + aoff + m * 2048 + k * 1024); } while (0)
#define G8_LDB(dst, b, h) do { _Pragma("unroll") for (int n = 0; n < 2; ++n) _Pragma("unroll") for (int k = 0; k < 2; ++k) dst[n][k] = *(const LAS bf16x8*)(lds + G8_SB(b, h) + boff + n * 2048 + k * 1024); } while (0)
#define G8_MMA(ai, bj, At, Bt) do { __builtin_amdgcn_s_setprio(1); _Pragma("unroll") for (int m = 0; m < 4; ++m) _Pragma("unroll") for (int n = 0; n < 2; ++n) _Pragma("unroll") for (int k = 0; k < 2; ++k) \
        acc[ai][bj][m][n] = __builtin_amdgcn_mfma_f32_16x16x32_bf16(Bt[n][k], At[m][k], acc[ai][bj][m][n], 0, 0, 0); __builtin_amdgcn_s_setprio(0); } while (0)
#define G8_WAIT_V(n) asm volatile("s_waitcnt vmcnt(" #n ")" ::: "memory")
#define G8_WAIT_L(n) asm volatile("s_waitcnt lgkmcnt(" #n ")" ::: "memory")
#define G8_BAR __builtin_amdgcn_s_barrier()
#define G8_SCHED __builtin_amdgcn_sched_barrier(0)
    Unit cur, nxt; int ui = 0;
    if (!S.next(0, cur)) return;
    unsigned vA0[2], vA1[2], nA0[2], nA1[2];
#pragma unroll
    for (int i = 0; i < 2; ++i) {
        if (GATHER) { vA0[i] = S.arow_off(cur, Rr[i]) + (unsigned)Cc[i] * 2u; vA1[i] = S.arow_off(cur, HALF + Rr[i]) + (unsigned)Cc[i] * 2u; }
        else { vA0[i] = (unsigned)(Rr[i] * lda + Cc[i]) * 2u; vA1[i] = (unsigned)((HALF + Rr[i]) * lda + Cc[i]) * 2u; }
        nA0[i] = vA0[i]; nA1[i] = vA1[i];
    }
    f32x4 acc[2][2][4][2];
#pragma unroll
    for (int a = 0; a < 2; ++a)
#pragma unroll
        for (int b = 0; b < 2; ++b)
#pragma unroll
            for (int m = 0; m < 4; ++m)
#pragma unroll
                for (int n = 0; n < 2; ++n) acc[a][b][m][n] = (f32x4){0.f, 0.f, 0.f, 0.f};
    bf16x8 At[4][2], B0[2][2], B1[2][2];
    const char* cA = cur.a; const char* cB = cur.b;
    G8_STAGE(G8_SB(0, 0), cB, voffB[0], voffB[1]); G8_STAGE(G8_SB(0, 1), cB + hstepB, voffB[0], voffB[1]); G8_STAGE(G8_SA(0, 0), cA, vA0[0], vA0[1]); G8_STAGE(G8_SA(0, 1), cA, vA1[0], vA1[1]);
    if (wr == 1) G8_BAR;
    G8_WAIT_V(2); G8_BAR;
    G8_STAGE(G8_SB(1, 0), cB + kstepB, voffB[0], voffB[1]); G8_STAGE(G8_SA(1, 0), cA + kstep, vA0[0], vA0[1]); G8_STAGE(G8_SB(1, 1), cB + hstepB + kstepB, voffB[0], voffB[1]);
    G8_WAIT_V(6); G8_BAR;
    for (;;) {
        const bool has_next = S.next(ui + 1, nxt);
        const char* nA = has_next ? nxt.a : cA; const char* nB = has_next ? nxt.b : cB;
        unsigned pf_dummy = 0u;
        if (PFB && has_next && nB != cB) {
            const char* pb = nB + (size_t)tid * 128;
#pragma unroll
            for (int i = 0; i < 8; ++i) { if (i * NT * 128 < 256 * K * 2) asm volatile("global_load_dword %0, %1, off" : "+v"(pf_dummy) : "v"(pb + (size_t)i * NT * 128) : "memory"); }
        }
        if (GATHER) {
#pragma unroll
            for (int i = 0; i < 2; ++i) { if (has_next) { nA0[i] = S.arow_off(nxt, Rr[i]) + (unsigned)Cc[i] * 2u; nA1[i] = S.arow_off(nxt, HALF + Rr[i]) + (unsigned)Cc[i] * 2u; } else { nA0[i] = vA0[i]; nA1[i] = vA1[i]; } }
        }
#pragma unroll 1
        for (int t = 0; t < nt; t += 2) {
            const bool last = (t == nt - 2);
            const char* a1 = cA + (size_t)(t + 1) * kstep;
            const char* a2 = last ? nA : cA + (size_t)(t + 2) * kstep; const char* b2 = last ? nB : cB + (size_t)(t + 2) * kstepB;
            const char* a3 = a2 + kstep; const char* b3 = b2 + kstepB;
            unsigned x00 = vA0[0], x01 = vA0[1], x10 = vA1[0], x11 = vA1[1];
            if (GATHER) { x00 = last ? nA0[0] : vA0[0]; x01 = last ? nA0[1] : vA0[1]; x10 = last ? nA1[0] : vA1[0]; x11 = last ? nA1[1] : vA1[1]; }
            G8_LDB(B0, 0, 0); G8_LDB(B1, 0, 1); G8_SCHED; G8_LDA(At, 0, 0); G8_STAGE(G8_SA(1, 1), a1, vA1[0], vA1[1]);
            G8_WAIT_V(8); if (PFB) asm volatile("" : "+v"(pf_dummy)); G8_WAIT_L(0); G8_BAR; G8_MMA(0, 0, At, B0); G8_MMA(0, 1, At, B1); G8_BAR; G8_SCHED;
            G8_LDA(At, 0, 1); G8_STAGE(G8_SB(0, 0), b2, voffB[0], voffB[1]); G8_STAGE(G8_SB(0, 1), b2 + hstepB, voffB[0], voffB[1]); G8_STAGE(G8_SA(0, 0), a2, x00, x01);
            G8_WAIT_V(8); G8_WAIT_L(0); G8_BAR; G8_MMA(1, 0, At, B0); G8_MMA(1, 1, At, B1); G8_BAR; G8_SCHED;
            G8_LDB(B0, 1, 0); G8_LDB(B1, 1, 1); G8_SCHED; G8_LDA(At, 1, 0); G8_STAGE(G8_SA(0, 1), a2, x10, x11);
            G8_WAIT_V(8); G8_WAIT_L(0); G8_BAR; G8_MMA(0, 0, At, B0); G8_MMA(0, 1, At, B1); G8_BAR; G8_SCHED;
            G8_LDA(At, 1, 1); G8_STAGE(G8_SB(1, 0), b3, voffB[0], voffB[1]); G8_STAGE(G8_SB(1, 1), b3 + hstepB, voffB[0], voffB[1]); G8_STAGE(G8_SA(1, 0), a3, x00, x01);
            G8_WAIT_V(8); G8_WAIT_L(0); G8_BAR; G8_MMA(1, 0, At, B0); G8_MMA(1, 1, At, B1); G8_BAR; G8_SCHED;
        }
        if constexpr (ALIGN_EPI) { if (wr == 0) G8_BAR; }
        E(acc, cur, wr, wc, fr, fq);
        if (!has_next) break;
#pragma unroll
        for (int a = 0; a < 2; ++a)
#pragma unroll
            for (int b = 0; b < 2; ++b)
#pragma unroll
                for (int m = 0; m < 4; ++m)
#pragma unroll
                    for (int n = 0; n < 2; ++n) acc[a][b][m][n] = (f32x4){0.f, 0.f, 0.f, 0.f};
        cur = nxt; cA = nA; cB = nB; ++ui;
        if (GATHER) {
#pragma unroll
            for (int i = 0; i < 2; ++i) { vA0[i] = nA0[i]; vA1[i] = nA1[i]; }
        }
        if constexpr (ALIGN_EPI) { if (wr == 1) G8_BAR; }
    }
    G8_WAIT_V(0);
    if constexpr (!ALIGN_EPI) { if (wr == 0) G8_BAR; }
    G8_BAR;
#undef G8_SA
#undef G8_SB
#undef G8_STAGE
#undef G8_LDA
#undef G8_LDB
#undef G8_MMA
#undef G8_WAIT_V
#undef G8_WAIT_L
#undef G8_BAR
#undef G8_SCHED
}

struct DenseOrder {
    const char* A; const char* Bt; int lda, K, nM, nN, nwg, G, c, skip_ctx;
    __device__ __forceinline__ void init(const bf16* A_, int lda_, const bf16* Bt_, int K_, int M, int N, int G_, int c_, int skip_ctx_) {
        A = (const char*)A_; Bt = (const char*)Bt_; lda = lda_; K = K_; skip_ctx = skip_ctx_; nM = M / BM; if (skip_ctx) nM = nM / 17 * 16; nN = N / BM; nwg = nM * nN; G = G_; c = c_; }
    __device__ __forceinline__ bool next(int i, Unit& u) const {
        const long L = (long)i * G + c; if (L >= nwg) return false;
        int wgid = (int)L; { const int q = nwg / NXCD, r = nwg % NXCD, xcd = wgid % NXCD, off = wgid / NXCD; wgid = (xcd < r ? xcd * (q + 1) : r * (q + 1) + (xcd - r) * q) + off; }
        const int nig = WGM * nN, gid = wgid / nig, fm = gid * WGM, gsz = (nM - fm) < WGM ? (nM - fm) : WGM;
        int pm = fm + ((wgid % nig) % gsz); const int pn = (wgid % nig) / gsz;
        if (skip_ctx) pm = (pm / 16) * 17 + 1 + (pm % 16);
        u.pm = pm; u.pn = pn; u.e = 0; u.aux = 0; u.cnt = 0;
        u.a = A + (size_t)pm * BM * lda * 2; u.b = Bt + (size_t)pn * BM * K * 2; return true;
    }
    __device__ __forceinline__ unsigned arow_off(const Unit&, int) const { return 0u; }
};
}
namespace g8 {
struct MoeOrder {
    const char* Abase; const char* Bbase; const int* rowtab; size_t bstride; int nN, K, G, vcu, gather;
    LAS int* tab;
    __device__ __forceinline__ void init(const unsigned* cnt, LAS int* tab_) {
        tab = tab_;
        __syncthreads();
        if (threadIdx.x < 64) {
            const int lane = threadIdx.x, me = lane & 31;
            const int c = (int)cnt[me];
            int run = 0, ab = 0, ms = 0, mab = 0;
            for (int e = 0; e < NE; ++e) { const int ce = __builtin_amdgcn_readlane(c, e), mt = (ce + 255) >> 8; if (me == e) { ms = run; mab = ab; } run += mt * nN; ab += mt << 8; }
            if (lane < 32) { tab[lane] = ms; tab[32 + lane] = c; tab[64 + lane] = mab; }
            if (lane == 0) tab[96] = run;
        }
        __syncthreads();
    }
    __device__ __forceinline__ bool next(int i, Unit& u) const {
        const int L = i * G + vcu;
        if (L >= tab[96]) return false;
        const int me = threadIdx.x & 31;
        const int st_l = tab[me], c_l = tab[32 + me];
        const unsigned long long m = __ballot(L >= st_l && L < st_l + ((c_l + 255) >> 8) * nN);
        const int e = __builtin_amdgcn_readfirstlane(__builtin_ctzll(m) & 31);
        const int st = tab[e], c = tab[32 + e], ab = tab[64 + e];
        const int l = L - st;
        const int sh = nN == 8 ? 3 : 2;
        u.e = e; u.pm = l >> sh; u.pn = l & (nN - 1); u.aux = ab; u.cnt = c;
        u.a = gather ? Abase : Abase + (size_t)(ab + u.pm * 256) * 1024 * 2; u.b = Bbase + (size_t)e * bstride + (size_t)u.pn * 256 * K * 2; return true;
    }
    __device__ __forceinline__ unsigned arow_off(const Unit& u, int r) const { int rr = u.pm * 256 + r; rr = rr < u.cnt ? rr : u.cnt - 1; return (unsigned)rowtab[(size_t)u.e * R + rr] * (unsigned)(D * 2); }
};
struct UpOrder {
    const char* Z; const char* Wq; const char* Wkv; int G, c;
    __device__ __forceinline__ bool next(int i, Unit& u) const {
        const int L = i * G + c; if (L >= 476) return false;
        const int kv = L >= 204, l = kv ? L - 204 : L, pn = l / 68, pm = l % 68;
        u.pm = pm; u.pn = kv ? 3 + pn : pn; u.e = 0; u.aux = kv; u.cnt = 0;
        u.a = Z + ((size_t)pm * BM * EVEN_IN_P + 1024 + kv * 384) * 2; u.b = Wq + (size_t)u.pn * BM * 384 * 2; return true;
    }
    __device__ __forceinline__ unsigned arow_off(const Unit&, int) const { return 0u; }
};
struct EpiStoreBf16 {
    static constexpr bool PERM = true; bf16* C; int ldc;
    __device__ __forceinline__ void operator()(const f32x4 (&acc)[2][2][4][2], const Unit& u, int wr, int wc, int fr, int fq) const {
        const int row0 = u.pm * BM + wr * 64 + fr, col0 = u.pn * BM + wc * 32 + 8 * fq;
#pragma unroll
        for (int ai = 0; ai < 2; ++ai)
#pragma unroll
            for (int m = 0; m < 4; ++m) { bf16* rowp = C + (size_t)(row0 + ai * HALF + m * 16) * ldc + col0;
#pragma unroll
                for (int bj = 0; bj < 2; ++bj) { const f32x4 v0 = acc[ai][bj][m][0], v1 = acc[ai][bj][m][1];
                    u32x4 w; w.x = cvt_pk_bf16(v0[0], v0[1]); w.y = cvt_pk_bf16(v0[2], v0[3]); w.z = cvt_pk_bf16(v1[0], v1[1]); w.w = cvt_pk_bf16(v1[2], v1[3]);
                    *(u32x4*)(rowp + bj * HALF) = w; } }
    }
};
struct EpiDiffIn {
    static constexpr bool PERM = true; bf16* C; const float* qn; const float* kn; const float* rc; const float* rs; LAS float* xch  ;
    __device__ __forceinline__ void operator()(const f32x4 (&acc)[2][2][4][2], const Unit& u, int wr, int wc, int fr, int fq) const {
        const int row0 = u.pm * BM + wr * 64 + fr, col0 = u.pn * BM + wc * 32 + 8 * fq, wid = wr * 4 + wc;
        const bool isv = u.pn >= 8;
        float rstd[2][4][2];
#pragma unroll
        for (int ai = 0; ai < 2; ++ai)
#pragma unroll
            for (int m = 0; m < 4; ++m)
#pragma unroll
                for (int bj = 0; bj < 2; ++bj) { const f32x4 v0 = acc[ai][bj][m][0], v1 = acc[ai][bj][m][1];
                    float ss = v0[0] * v0[0] + v0[1] * v0[1] + v0[2] * v0[2] + v0[3] * v0[3] + v1[0] * v1[0] + v1[1] * v1[1] + v1[2] * v1[2] + v1[3] * v1[3];
                    ss += lane_xor16(ss); ss += lane_xor32(ss);
                    rstd[ai][m][bj] = ss;
                    if (fq == 0) xch[wid * 256 + ((ai * 4 + m) * 2 + bj) * 16 + fr] = ss; }
        asm volatile("s_waitcnt lgkmcnt(0)" ::: "memory"); __builtin_amdgcn_s_barrier(); asm volatile("" ::: "memory");
#pragma unroll
        for (int ai = 0; ai < 2; ++ai)
#pragma unroll
            for (int m = 0; m < 4; ++m)
#pragma unroll
                for (int bj = 0; bj < 2; ++bj) rstd[ai][m][bj] = rsqrtf((rstd[ai][m][bj] + xch[(wid ^ 1) * 256 + ((ai * 4 + m) * 2 + bj) * 16 + fr]) * (1.f / 64.f) + EPS);
        const int e0 = (wc & 1) * 32 + 8 * fq;
        const float* gn = u.pn < 4 ? qn : kn; const float qs = u.pn < 4 ? 0.125f * LOG2E : 1.f;
        f32x4 g0 = *(const f32x4*)(gn + e0), g1 = *(const f32x4*)(gn + e0 + 4);
        g0 = g0 * qs; g1 = g1 * qs;
        const float sgn = (fq & 2) ? 1.f : -1.f;
        const int jt = u.pm % 17; const bool latent = jt != 0;
#pragma unroll
        for (int ai = 0; ai < 2; ++ai)
#pragma unroll
            for (int m = 0; m < 4; ++m) { const int r = row0 + ai * HALF + m * 16; bf16* rowp = C + (size_t)r * ODD_IN + col0;
                f32x4 c0 = {1.f, 1.f, 1.f, 1.f}, c1 = c0, s0 = {0.f, 0.f, 0.f, 0.f}, s1 = s0;
                if (!isv && latent) { const int t = (jt - 1) * 256 + ai * HALF + wr * 64 + m * 16 + fr;
                    c0 = *(const f32x4*)(rc + t * 64 + e0); c1 = *(const f32x4*)(rc + t * 64 + e0 + 4); s0 = *(const f32x4*)(rs + t * 64 + e0); s1 = *(const f32x4*)(rs + t * 64 + e0 + 4); }
#pragma unroll
                for (int bj = 0; bj < 2; ++bj) { f32x4 v0 = acc[ai][bj][m][0], v1 = acc[ai][bj][m][1];
                    if (!isv) { const float rr = rstd[ai][m][bj]; v0 = v0 * rr * g0; v1 = v1 * rr * g1;
                        f32x4 o0, o1;
#pragma unroll
                        for (int j = 0; j < 4; ++j) { o0[j] = lane_xor32(v0[j]); o1[j] = lane_xor32(v1[j]); }
                        v0 = v0 * c0 + o0 * s0 * sgn; v1 = v1 * c1 + o1 * s1 * sgn; }
                    u32x4 w; w.x = cvt_pk_bf16(v0[0], v0[1]); w.y = cvt_pk_bf16(v0[2], v0[3]); w.z = cvt_pk_bf16(v1[0], v1[1]); w.w = cvt_pk_bf16(v1[2], v1[3]);
                    *(u32x4*)(rowp + bj * HALF) = w; } }
        asm volatile("s_waitcnt lgkmcnt(0)" ::: "memory"); __builtin_amdgcn_s_barrier(); asm volatile("" ::: "memory");
    }
};
struct EpiOut {
    static constexpr bool PERM = true; Ptrs P; int layer;
    __device__ __forceinline__ void operator()(const f32x4 (&acc)[2][2][4][2], const Unit& u, int wr, int wc, int fr, int fq) const {
        const int b = u.pm / 17, jt = u.pm % 17;
        const float* g1 = (const float*)(P.ws + WS_MOD) + (size_t)(layer * 5 + (jt == 0 ? 4 : b)) * 6144 + 2 * D;
        const float* in0 = jt == 0 ? P.in[2] + (size_t)(b * CTX) * D : P.in[0] + (size_t)(b * SEQ + (jt - 1) * 256) * D;
        bf16* xb0 = (bf16*)(P.ws + WS_XB) + (size_t)u.pm * BM * D;
        const int col0 = u.pn * BM + wc * 32 + 8 * fq;
        f32x4 gv[2][2];
#pragma unroll
        for (int bj = 0; bj < 2; ++bj)
#pragma unroll
            for (int n = 0; n < 2; ++n) gv[bj][n] = *(const f32x4*)(g1 + col0 + bj * HALF + 4 * n);
#pragma unroll
        for (int ai = 0; ai < 2; ++ai)
#pragma unroll
            for (int m = 0; m < 4; ++m) { const size_t off = (size_t)(ai * HALF + wr * 64 + m * 16 + fr) * D + col0;
#pragma unroll
                for (int bj = 0; bj < 2; ++bj) {
                    f32x4 x0, x1;
                    if (layer == 0) { x0 = *(const f32x4*)(in0 + off + bj * HALF); x1 = *(const f32x4*)(in0 + off + bj * HALF + 4); }
                    else { const u32x4 r = *(const u32x4*)(xb0 + off + bj * HALF);
                        x0 = (f32x4){__uint_as_float(r.x << 16), __uint_as_float(r.x & 0xffff0000u), __uint_as_float(r.y << 16), __uint_as_float(r.y & 0xffff0000u)};
                        x1 = (f32x4){__uint_as_float(r.z << 16), __uint_as_float(r.z & 0xffff0000u), __uint_as_float(r.w << 16), __uint_as_float(r.w & 0xffff0000u)}; }
                    const f32x4 v0 = x0 + gv[bj][0] * acc[ai][bj][m][0], v1 = x1 + gv[bj][1] * acc[ai][bj][m][1];
                    u32x4 w; w.x = cvt_pk_bf16(v0[0], v0[1]); w.y = cvt_pk_bf16(v0[2], v0[3]); w.z = cvt_pk_bf16(v1[0], v1[1]); w.w = cvt_pk_bf16(v1[2], v1[3]);
                    *(u32x4*)(xb0 + off + bj * HALF) = w; } }
    }
};
struct EpiMoe1 {
    static constexpr bool PERM = true; Ptrs P; int layer;
    __device__ __forceinline__ void operator()(const f32x4 (&acc)[2][2][4][2], const Unit& u, int wr, int wc, int fr, int fq) const {
        const float* bgu = P.in[35] + (size_t)(layer * NE + u.e) * 2048;
        const int cl = u.pn * 128 + wc * 32 + 8 * fq;
        f32x4 bg[2], bu[2];
#pragma unroll
        for (int n = 0; n < 2; ++n) { bg[n] = *(const f32x4*)(bgu + cl + 4 * n); bu[n] = *(const f32x4*)(bgu + 1024 + cl + 4 * n); }
        bf16* act = (bf16*)(P.ws + WS_ACT) + (size_t)(u.aux + u.pm * 256 + wr * 64 + fr) * 1024 + cl;
#pragma unroll
        for (int ai = 0; ai < 2; ++ai)
#pragma unroll
            for (int m = 0; m < 4; ++m) { float o[8];
#pragma unroll
                for (int n = 0; n < 2; ++n)
#pragma unroll
                    for (int j = 0; j < 4; ++j) { float g = acc[ai][0][m][n][j] + bg[n][j], uu = acc[ai][1][m][n][j] + bu[n][j];
                        g = fminf(g, 7.f); uu = fminf(fmaxf(uu, -7.f), 7.f);
                        const float sg = __builtin_amdgcn_rcpf(1.f + __expf(-1.702f * g)); o[n * 4 + j] = (uu + 1.f) * g * sg; }
                u32x4 w; w.x = cvt_pk_bf16(o[0], o[1]); w.y = cvt_pk_bf16(o[2], o[3]); w.z = cvt_pk_bf16(o[4], o[5]); w.w = cvt_pk_bf16(o[6], o[7]);
                *(u32x4*)(act + (size_t)(ai * HALF + m * 16) * 1024) = w; }
    }
};
struct EpiMoe2 {
    static constexpr bool PERM = true; Ptrs P; int layer;
    __device__ __forceinline__ void operator()(const f32x4 (&acc)[2][2][4][2], const Unit& u, int wr, int wc, int fr, int fq) const {
        const float* bd = P.in[37] + (size_t)(layer * NE + u.e) * 1024;
        const int col0 = u.pn * BM + wc * 32 + 8 * fq;
        f32x4 bv[2][2];
#pragma unroll
        for (int bj = 0; bj < 2; ++bj)
#pragma unroll
            for (int n = 0; n < 2; ++n) bv[bj][n] = *(const f32x4*)(bd + col0 + bj * HALF + 4 * n);
        const int* pair_of = (const int*)(P.ws + WS_PAIROF) + (size_t)u.e * R; const float* gate_of = (const float*)(P.ws + WS_GATEOF) + (size_t)u.e * R;
        bf16* Y = (bf16*)(P.ws + WS_Y);
        int pr[2][4]; float gwv[2][4];
#pragma unroll
        for (int ai = 0; ai < 2; ++ai)
#pragma unroll
            for (int m = 0; m < 4; ++m) { const int r = u.pm * 256 + ai * HALF + wr * 64 + m * 16 + fr, rc = r < u.cnt ? r : u.cnt - 1; pr[ai][m] = pair_of[rc]; gwv[ai][m] = gate_of[rc]; }
#pragma unroll
        for (int ai = 0; ai < 2; ++ai)
#pragma unroll
            for (int m = 0; m < 4; ++m) { const int r = u.pm * 256 + ai * HALF + wr * 64 + m * 16 + fr;
                if (r < u.cnt) { const float gw = gwv[ai][m]; bf16* rowp = Y + (size_t)pr[ai][m] * 1024 + col0;
#pragma unroll
                    for (int bj = 0; bj < 2; ++bj) { const f32x4 v0 = (acc[ai][bj][m][0] + bv[bj][0]) * gw, v1 = (acc[ai][bj][m][1] + bv[bj][1]) * gw;
                        u32x4 w; w.x = cvt_pk_bf16(v0[0], v0[1]); w.y = cvt_pk_bf16(v0[2], v0[3]); w.z = cvt_pk_bf16(v1[0], v1[1]); w.w = cvt_pk_bf16(v1[2], v1[3]);
                        *(u32x4*)(rowp + bj * HALF) = w; } } }
    }
};
}

__device__ __forceinline__ int bwd_pos(int c) { return c < 2 ? 1 - c : 2 + (NCH - 1 - c); }
__device__ __forceinline__ int bwd_chunk_at(int p) { return p < 2 ? 1 - p : NCH - 1 - (p - 2); }
__device__ __forceinline__ float fsigmoid(float x) { return __builtin_amdgcn_rcpf(1.f + __builtin_amdgcn_exp2f(-LOG2E * x)); }
__device__ __forceinline__ void ph_lru(const Ptrs& P, unsigned char* lds, int mode, int item0) {
    typedef short bf16x8 __attribute__((ext_vector_type(8)));
    float* X = (float*)lds;
    unsigned char* XB = lds + 128 * 68 * 4;
    float* SEG = (float*)(lds + 128 * 68 * 4 + 16384);
    float* CAR = SEG + 2 * 8 * 64 * 2;
    unsigned char* WL = (unsigned char*)(CAR + 128);
    float* CWL = (float*)(WL + 32768);
    float* GBL = CWL + 320;
    const int tid = threadIdx.x, wid = tid >> 6, lane = tid & 63, fr = lane & 15, fq = lane >> 4;
    const int G = gridDim.x, total = 8 * NCH * NB;
    const bf16* Z = (const bf16*)(P.ws + WS_Z);
    float* agg = (float*)(P.ws + WS_AGG);
    const int first = ((int)blockIdx.x - item0 % G + G) % G;
    int n_cur = -1;
    u32x4 raw[2][4], gz[2];
#define LRU_LOADS(it_) do { const int n_ = (it_) % 8, c_ = ((it_) / 8) % NCH, b_ = (it_) / (8 * NCH); const int j0_ = c_ * CHUNK, lo_ = (c_ < 2) ? 0 : CTX, hi_ = (c_ < 2) ? CTX : SU; \
        _Pragma("unroll") for (int q = 0; q < 2; ++q) { const int p = tid + q * NT, t = p >> 3, cg = n_ * 64 + (p & 7) * 8; \
            _Pragma("unroll") for (int k = 0; k < 4; ++k) { const int j = j0_ + t - 2 + k; const int jj = (j >= lo_ && j < hi_) ? j : j0_ + t; raw[q][k] = *(const u32x4*)(Z + (size_t)(b_ * SU + jj) * EVEN_IN_P + 512 + cg); } \
            if (mode == 1) gz[q] = *(const u32x4*)(Z + (size_t)(b_ * SU + j0_ + t) * EVEN_IN_P + cg); } } while (0)
    if (first < total) LRU_LOADS(first);
    for (int it = first; it < total; it += G) {
        const int n = it % 8, c = (it / 8) % NCH, b = it / (8 * NCH);
        const int j0 = c * CHUNK, seg_lo = (c < 2) ? 0 : CTX, seg_hi = (c < 2) ? CTX : SU;
        __syncthreads();
        if (n != n_cur) {
            n_cur = n; int tq = tid; asm volatile("" : "+v"(tq));
#pragma unroll
            for (int i = 0; i < 4; ++i) { const int idx = tq + i * NT, mm = idx >> 9, r = (idx & 511) >> 3, ch = idx & 7;
                *(u32x4*)(WL + mm * 8192 + r * 128 + ((ch ^ ((r >> 1) & 7)) << 4)) = *(const u32x4*)((const bf16*)(P.ws + WS_WLRU) + ((size_t)mm * 8 + n) * 4096 + r * 64 + ch * 8); }
            if (tq < 256) CWL[tq] = P.in[10][(tq >> 6) * LRU_W + n * 64 + (tq & 63)]; else if (tq < 320) CWL[tq] = P.in[11][n * 64 + (tq - 256)];
            if (tq < 384) { const int a = tq >> 7, dl = tq & 127, cgl = (dl >> 6) * LRU_W + n * 64 + (dl & 63);
                GBL[tq] = a == 0 ? P.in[13][cgl] : a == 1 ? P.in[15][cgl] : ((const float*)(P.ws + WS_SCAL))[1024 + cgl]; }
            __syncthreads();
        }
        u32x4 gzc[2];
#pragma unroll
        for (int q = 0; q < 2; ++q) {
            const int p = tid + q * NT, t = p >> 3, c8 = (p & 7) * 8;
            float acc[8];
            { const f32x4 b0 = *(const f32x4*)(CWL + 256 + c8), b1 = *(const f32x4*)(CWL + 256 + c8 + 4);
#pragma unroll
              for (int e = 0; e < 4; ++e) { acc[e] = b0[e]; acc[4 + e] = b1[e]; } }
#pragma unroll
            for (int k = 0; k < 4; ++k) {
                const int j = j0 + t - 2 + k; const bool ok = j >= seg_lo && j < seg_hi;
                const u32x4 rw = raw[q][k];
                const f32x4 w0 = *(const f32x4*)(CWL + k * 64 + c8), w1 = *(const f32x4*)(CWL + k * 64 + c8 + 4);
                const float m = ok ? 1.f : 0.f;
#pragma unroll
                for (int e = 0; e < 4; ++e) { const float lo = __uint_as_float(rw[e] << 16), hi = __uint_as_float(rw[e] & 0xffff0000u);
                    const float wl = (e < 2 ? w0[2 * e] : w1[2 * e - 4]) * m, wh = (e < 2 ? w0[2 * e + 1] : w1[2 * e - 3]) * m;
                    acc[2 * e] += wl * lo; acc[2 * e + 1] += wh * hi; }
            }
            *(f32x4*)(X + t * 68 + c8) = (f32x4){acc[0], acc[1], acc[2], acc[3]}; *(f32x4*)(X + t * 68 + c8 + 4) = (f32x4){acc[4], acc[5], acc[6], acc[7]};
            u32x4 w; w.x = g8::cvt_pk_bf16(acc[0], acc[1]); w.y = g8::cvt_pk_bf16(acc[2], acc[3]); w.z = g8::cvt_pk_bf16(acc[4], acc[5]); w.w = g8::cvt_pk_bf16(acc[6], acc[7]);
            *(u32x4*)(XB + t * 128 + (((c8 >> 3) ^ ((t >> 1) & 7)) << 4)) = w;
            gzc[q] = gz[q];
        }
        if (it + G < total) LRU_LOADS(it + G);
        if (mode == 1 && wid < 2) {
            const int dir = wid, pos = dir == 0 ? c : bwd_pos(c); float h = 0.f;
            for (int p0 = 0; p0 < pos; p0 += 8) {
                float2 ag[8];
#pragma unroll
                for (int i = 0; i < 8; ++i) { const int p = p0 + i, pc = p < pos ? p : p0, cc = dir == 0 ? pc : bwd_chunk_at(pc);
                    ag[i] = *(const float2*)(agg + ((((size_t)b * NCH + cc) * 2 + dir) * 512 + n * 64 + lane) * 2); if (p >= pos) { ag[i].x = 1.f; ag[i].y = 0.f; } }
#pragma unroll
                for (int i = 0; i < 8; ++i) h = ag[i].x * h + ag[i].y;
            }
            CAR[dir * 64 + lane] = h;
        }
        __syncthreads();
        const int trow = 16 * wid + fr;
        const bf16x8 af0 = *(const bf16x8*)(XB + trow * 128 + ((fq ^ ((trow >> 1) & 7)) << 4));
        const bf16x8 af1 = *(const bf16x8*)(XB + trow * 128 + (((4 + fq) ^ ((trow >> 1) & 7)) << 4));
        float av[2][4][4], uv[2][4][4], Ae[2][4], He[2][4];
#pragma unroll
        for (int dir = 0; dir < 2; ++dir) {
            const unsigned char* wa = WL + (dir * 2 + 0) * 8192; const unsigned char* wx = WL + (dir * 2 + 1) * 8192;
#pragma unroll
            for (int ct = 0; ct < 4; ++ct) {
                const int e = 16 * ct + fr, ky = (e >> 1) & 7;
                const bf16x8 wa0 = *(const bf16x8*)(wa + e * 128 + ((fq ^ ky) << 4)), wa1 = *(const bf16x8*)(wa + e * 128 + (((4 + fq) ^ ky) << 4));
                const bf16x8 wx0 = *(const bf16x8*)(wx + e * 128 + ((fq ^ ky) << 4)), wx1 = *(const bf16x8*)(wx + e * 128 + (((4 + fq) ^ ky) << 4));
                f32x4 ga = {0.f, 0.f, 0.f, 0.f}, gx = {0.f, 0.f, 0.f, 0.f};
                ga = __builtin_amdgcn_mfma_f32_16x16x32_bf16(af0, wa0, ga, 0, 0, 0); ga = __builtin_amdgcn_mfma_f32_16x16x32_bf16(af1, wa1, ga, 0, 0, 0);
                gx = __builtin_amdgcn_mfma_f32_16x16x32_bf16(af0, wx0, gx, 0, 0, 0); gx = __builtin_amdgcn_mfma_f32_16x16x32_bf16(af1, wx1, gx, 0, 0, 0);
                const float bav = GBL[dir * 64 + e], bxv = GBL[128 + dir * 64 + e], c8 = GBL[256 + dir * 64 + e];
#pragma unroll
                for (int j = 0; j < 4; ++j) {
                    const float r = fsigmoid(ga[j] + bav), ig = fsigmoid(gx[j] + bxv);
                    const float a = __builtin_amdgcn_exp2f(-c8 * r);
                    av[dir][ct][j] = a; uv[dir][ct][j] = sqrtf(fmaxf(1.f - a * a, 0.f)) * ig * X[(16 * wid + 4 * fq + j) * 68 + e];
                }
                float Al = av[dir][ct][0] * av[dir][ct][1] * av[dir][ct][2] * av[dir][ct][3], Hl;
                if (dir == 0) Hl = ((uv[dir][ct][0] * av[dir][ct][1] + uv[dir][ct][1]) * av[dir][ct][2] + uv[dir][ct][2]) * av[dir][ct][3] + uv[dir][ct][3];
                else Hl = ((uv[dir][ct][3] * av[dir][ct][2] + uv[dir][ct][2]) * av[dir][ct][1] + uv[dir][ct][1]) * av[dir][ct][0] + uv[dir][ct][0];
                const int pq = dir == 0 ? fq : 3 - fq;
                {
                    const float Ap = lane_shift16(Al, dir == 0), Hp = lane_shift16(Hl, dir == 0);
                    if (pq >= 1) { Hl = Al * Hp + Hl; Al = Al * Ap; }
                }
                {
                    const float Ap = lane_xor32(Al), Hp = lane_xor32(Hl);
                    if (pq >= 2) { Hl = Al * Hp + Hl; Al = Al * Ap; }
                }
                {
                    const float Ap = lane_shift16(Al, dir == 0), Hp = lane_shift16(Hl, dir == 0);
                    Ae[dir][ct] = pq >= 1 ? Ap : 1.f; He[dir][ct] = pq >= 1 ? Hp : 0.f;
                }
                if (pq == 3) { float2 sv; sv.x = Al; sv.y = Hl; *(float2*)(SEG + ((dir * 8 + wid) * 64 + e) * 2) = sv; }
            }
        }
        __syncthreads();
        float hs[4][4];
#pragma unroll
        for (int ct = 0; ct < 4; ++ct)
#pragma unroll
            for (int j = 0; j < 4; ++j) hs[ct][j] = 0.f;
#pragma unroll
        for (int dir = 0; dir < 2; ++dir) {
#pragma unroll
            for (int ct = 0; ct < 4; ++ct) {
                const int e = 16 * ct + fr;
                if (mode == 0) {
                    if (wid == 0 && fq == 0) {
                        float Ac = 1.f, Hc = 0.f;
                        for (int sI = 0; sI < 8; ++sI) { const int sg = dir == 0 ? sI : 7 - sI; const float2 sv = *(const float2*)(SEG + ((dir * 8 + sg) * 64 + e) * 2); Hc = sv.x * Hc + sv.y; Ac *= sv.x; }
                        float2 o; o.x = Ac; o.y = Hc; *(float2*)(agg + ((((size_t)b * NCH + c) * 2 + dir) * 512 + n * 64 + e) * 2) = o;
                    }
                } else {
                    float h = CAR[dir * 64 + e];
                    const int nprev = dir == 0 ? wid : 7 - wid;
                    for (int sI = 0; sI < nprev; ++sI) { const int sg = dir == 0 ? sI : 7 - sI; const float2 sv = *(const float2*)(SEG + ((dir * 8 + sg) * 64 + e) * 2); h = sv.x * h + sv.y; }
                    h = Ae[dir][ct] * h + He[dir][ct];
                    if (dir == 0) {
#pragma unroll
                        for (int j = 0; j < 4; ++j) { h = av[dir][ct][j] * h + uv[dir][ct][j]; hs[ct][j] += h; }
                    } else {
#pragma unroll
                        for (int j = 3; j >= 0; --j) { h = av[dir][ct][j] * h + uv[dir][ct][j]; hs[ct][j] += h; }
                    }
                }
            }
        }
        if (mode == 1) {
#pragma unroll
            for (int ct = 0; ct < 4; ++ct)
#pragma unroll
                for (int j = 0; j < 4; ++j) X[(16 * wid + 4 * fq + j) * 68 + 16 * ct + fr] = hs[ct][j];
            __syncthreads();
            bf16* mix = (bf16*)(P.ws + WS_MIX);
#pragma unroll
            for (int q = 0; q < 2; ++q) {
                const int p = tid + q * NT, t = p >> 3, c8 = (p & 7) * 8; const size_t u = (size_t)b * SU + j0 + t;
                const u32x4 gzv = gzc[q];
                const f32x4 r0 = *(const f32x4*)(X + t * 68 + c8), r1 = *(const f32x4*)(X + t * 68 + c8 + 4);
                float o[8];
#pragma unroll
                for (int k = 0; k < 4; ++k) { const float g0 = __uint_as_float(gzv[k] << 16), g1 = __uint_as_float(gzv[k] & 0xffff0000u);
                    const float s0 = fsigmoid(1.5957691216057308f * (g0 + 0.044715f * g0 * g0 * g0)), s1 = fsigmoid(1.5957691216057308f * (g1 + 0.044715f * g1 * g1 * g1));
                    o[2 * k] = g0 * s0 * (k < 2 ? r0[2 * k] : r1[2 * k - 4]); o[2 * k + 1] = g1 * s1 * (k < 2 ? r0[2 * k + 1] : r1[2 * k - 3]); }
                u32x4 w; w.x = g8::cvt_pk_bf16(o[0], o[1]); w.y = g8::cvt_pk_bf16(o[2], o[3]); w.z = g8::cvt_pk_bf16(o[4], o[5]); w.w = g8::cvt_pk_bf16(o[6], o[7]);
                *(u32x4*)(mix + u * D + n * 64 + c8) = w;
            }
        }
    }
#undef LRU_LOADS
    __syncthreads();
}

__device__ __forceinline__ void unpack8(const u32x4 v, float (&f)[8]) {
#pragma unroll
    for (int i = 0; i < 4; ++i) { f[2 * i] = __uint_as_float(v[i] << 16); f[2 * i + 1] = __uint_as_float(v[i] & 0xffff0000u); }
}
__device__ __forceinline__ u32x4 pack8(const float (&f)[8]) {
    u32x4 w; w.x = g8::cvt_pk_bf16(f[0], f[1]); w.y = g8::cvt_pk_bf16(f[2], f[3]); w.z = g8::cvt_pk_bf16(f[4], f[5]); w.w = g8::cvt_pk_bf16(f[6], f[7]); return w;
}
struct MlaRow { u32x4 zq, zk, zr, q0, q1, kv0, kw0, kv1, kw1; f32x4 c0, c1, s0, s1; };
__device__ __forceinline__ MlaRow mla_row_load(const Ptrs& P, int u, int lane) {
    const int hl = lane & 31, hh = lane >> 5; const bool act = hl < 24, tail = hl >= 16 && hl < 24;
    const int j = u % SU; const bool latent = j >= CTX; const int t = latent ? j - CTX : 0;
    const bf16* z = (const bf16*)(P.ws + WS_Z) + (size_t)u * EVEN_IN_P;
    const bf16* qp = (const bf16*)(P.ws + WS_QP) + (size_t)u * 1792; const bf16* kvp = qp + 768;
    const float* rc = (const float*)(P.ws + WS_ROPE); const float* rs = rc + SEQ * 64;
    const u32x4 z4 = {0u, 0u, 0u, 0u}; const f32x4 one4 = {1.f, 1.f, 1.f, 1.f}, zero4 = {0.f, 0.f, 0.f, 0.f};
    MlaRow r;
    r.zq = lane < 48 ? *(const u32x4*)(z + 1024 + lane * 8) : z4;
    r.zk = lane < 32 ? *(const u32x4*)(z + 1408 + lane * 8) : z4;
    r.zr = tail ? *(const u32x4*)(z + 1664 + (hl - 16) * 8) : z4;
    r.q0 = act ? *(const u32x4*)(qp + hh * 192 + hl * 8) : z4;
    r.q1 = act ? *(const u32x4*)(qp + (2 + hh) * 192 + hl * 8) : z4;
    r.kv0 = hl < 16 ? *(const u32x4*)(kvp + hh * 256 + hl * 8) : z4;
    r.kw0 = hl < 16 ? *(const u32x4*)(kvp + hh * 256 + 128 + hl * 8) : z4;
    r.kv1 = hl < 16 ? *(const u32x4*)(kvp + (2 + hh) * 256 + hl * 8) : z4;
    r.kw1 = hl < 16 ? *(const u32x4*)(kvp + (2 + hh) * 256 + 128 + hl * 8) : z4;
    const bool rp = latent && tail; const int ro = t * 64 + (hl - 16) * 8;
    r.c0 = rp ? *(const f32x4*)(rc + ro) : one4; r.c1 = rp ? *(const f32x4*)(rc + ro + 4) : one4;
    r.s0 = rp ? *(const f32x4*)(rs + ro) : zero4; r.s1 = rp ? *(const f32x4*)(rs + ro + 4) : zero4;
    return r;
}
__device__ __forceinline__ void ph_mla_prep(const Ptrs& P) {
    const int wave = threadIdx.x >> 6, lane = threadIdx.x & 63, G = gridDim.x;
    const int hl = lane & 31, hh = lane >> 5;
    const bool act = hl < 24, tail = hl >= 16 && hl < 24;
    const float* qn = P.in[21]; const float* kn = P.in[22];
    float gq[8], gk[8];
#pragma unroll
    for (int i = 0; i < 8; ++i) { gq[i] = act ? qn[hl * 8 + i] : 0.f; gk[i] = act ? kn[hl * 8 + i] : 0.f; }
    const float c2 = 0.07216878364870322f * LOG2E;
    const float sgn = ((hl >> 1) & 1) ? 1.f : -1.f;
    int u = (int)blockIdx.x * 8 + wave;
    if (u >= R) return;
    MlaRow cur = mla_row_load(P, u, lane);
    for (; u < R; u += G * 8) {
        const int un = u + G * 8;
        MlaRow nxt = cur;
        if (un < R) nxt = mla_row_load(P, un, lane);
        float f[8]; float sq = 0.f, sk = 0.f;
        unpack8(cur.zq, f);
#pragma unroll
        for (int i = 0; i < 8; ++i) sq += f[i] * f[i];
        unpack8(cur.zk, f);
#pragma unroll
        for (int i = 0; i < 8; ++i) sk += f[i] * f[i];
        const float rq = rsqrtf(wave_sum(sq) * (1.f / 384.f) + EPS), rk = rsqrtf(wave_sum(sk) * (1.f / 256.f) + EPS);
        float cs[8], sn[8];
#pragma unroll
        for (int i = 0; i < 4; ++i) { cs[i] = cur.c0[i]; cs[4 + i] = cur.c1[i]; sn[i] = cur.s0[i]; sn[4 + i] = cur.s1[i]; }
        bf16* qm = (bf16*)(P.ws + WS_QM) + (size_t)u * 768; bf16* km = (bf16*)(P.ws + WS_KM) + (size_t)u * 768; bf16* vm = (bf16*)(P.ws + WS_VM) + (size_t)u * 512;
#pragma unroll
        for (int pass = 0; pass < 2; ++pass) {
            const int h = pass * 2 + hh;
            {
                float v[8]; float ss = 0.f;
                unpack8(pass ? cur.q1 : cur.q0, v);
#pragma unroll
                for (int i = 0; i < 8; ++i) { v[i] *= rq; ss += v[i] * v[i]; }
                ss = sum32(ss);
                const float r = rsqrtf(ss * (1.f / 192.f) + EPS);
#pragma unroll
                for (int i = 0; i < 8; ++i) { v[i] *= r * gq[i]; const float other = dpp_f<DPP_X2>(v[i]); v[i] = (v[i] * cs[i] + sgn * other * sn[i]) * c2; }
                if (act) *(u32x4*)(qm + h * 192 + hl * 8) = pack8(v);
            }
            {
                float v[8], w[8]; float ss = 0.f;
                if (hl < 16) { unpack8(pass ? cur.kv1 : cur.kv0, v); unpack8(pass ? cur.kw1 : cur.kw0, w);
#pragma unroll
                    for (int i = 0; i < 8; ++i) { v[i] *= rk; w[i] *= rk; } }
                else { unpack8(cur.zr, v);
#pragma unroll
                    for (int i = 0; i < 8; ++i) w[i] = 0.f; }
#pragma unroll
                for (int i = 0; i < 8; ++i) ss += v[i] * v[i];
                ss = sum32(ss);
                const float r = rsqrtf(ss * (1.f / 192.f) + EPS);
#pragma unroll
                for (int i = 0; i < 8; ++i) { v[i] *= r * gk[i]; const float other = dpp_f<DPP_X2>(v[i]); v[i] = v[i] * cs[i] + sgn * other * sn[i]; }
                if (act) *(u32x4*)(km + h * 192 + hl * 8) = pack8(v);
                if (hl < 16) *(u32x4*)(vm + h * 128 + hl * 8) = pack8(w);
            }
        }
        cur = nxt;
    }
}
#ifndef PROBE_SUB
#define PROBE_SUB 0
#define PROBE_SUBDK 0
#endif
#ifndef PROBE_SUBBLK
#define PROBE_SUBBLK 0
#endif
#define PSUB_T0() unsigned ps_t0_ = 0u; if (PROBE_SUB && DK == PROBE_SUBDK) ps_t0_ = __builtin_amdgcn_readfirstlane((unsigned)__builtin_readcyclecounter())
#define PSUB_AT(k) do { if (PROBE_SUB == (k) && DK == PROBE_SUBDK) sacc = __builtin_amdgcn_readfirstlane(sacc + ((unsigned)__builtin_readcyclecounter() - ps_t0_)); } while (0)
namespace att {
using bf16x8 = __attribute__((ext_vector_type(8))) short;
using s16x4  = __attribute__((ext_vector_type(4))) short;
using f32x16 = __attribute__((ext_vector_type(16))) float;
#define SBAR() __builtin_amdgcn_sched_barrier(0)
__device__ __forceinline__ int crow(int r, int hi) { return (r & 3) + 8 * (r >> 2) + 4 * hi; }
__device__ __forceinline__ unsigned cvtpk(float lo, float hi) { unsigned r; asm volatile("v_cvt_pk_bf16_f32 %0, %1, %2" : "=v"(r) : "v"(lo), "v"(hi)); return r; }
template <int DK> __device__ __forceinline__ int kswz(int row, int chunk) { return row * (DK * 2) + ((chunk ^ ((row >> 1) & 7)) << 4); }
__device__ __forceinline__ int v_st(int k, int c) { const int kk = (k & ~0xC) | ((k & 4) << 1) | ((k & 8) >> 1); return ((kk >> 3) * 4 + (c >> 5)) * 512 + ((kk & 7) * 32 + (c & 31)) * 2; }
__device__ __forceinline__ int v_rd_base(int lane) { return ((lane & 3) << 3) | (((lane >> 2) & 3) << 6) | (((lane >> 4) & 1) << 5) | (((lane >> 5) & 1) << 8); }
constexpr int v_rd_off(int d0, int ks, int half) { return d0 * 512 + ks * 4096 + half * 2048; }
template <int OFF> __device__ __forceinline__ s16x4 tr_read(int vb) { s16x4 r; asm volatile("ds_read_b64_tr_b16 %0, %1 offset:%2" : "=&v"(r) : "v"(vb), "i"(OFF) : "memory"); return r; }
template <int D0> __device__ __forceinline__ void pv_one(f32x16& od, int vb, bf16x8 pa0, bf16x8 pa1, bf16x8 pa2, bf16x8 pa3) {
    const s16x4 l0 = tr_read<v_rd_off(D0, 0, 0)>(vb), h0 = tr_read<v_rd_off(D0, 0, 1)>(vb), l1 = tr_read<v_rd_off(D0, 1, 0)>(vb), h1 = tr_read<v_rd_off(D0, 1, 1)>(vb);
    const s16x4 l2 = tr_read<v_rd_off(D0, 2, 0)>(vb), h2 = tr_read<v_rd_off(D0, 2, 1)>(vb), l3 = tr_read<v_rd_off(D0, 3, 0)>(vb), h3 = tr_read<v_rd_off(D0, 3, 1)>(vb);
    asm volatile("s_waitcnt lgkmcnt(0)" ::: "memory"); SBAR();
#define PK(L, H) (bf16x8){L[0], L[1], L[2], L[3], H[0], H[1], H[2], H[3]}
    od = __builtin_amdgcn_mfma_f32_32x32x16_bf16(pa0, PK(l0, h0), od, 0, 0, 0);
    od = __builtin_amdgcn_mfma_f32_32x32x16_bf16(pa1, PK(l1, h1), od, 0, 0, 0);
    od = __builtin_amdgcn_mfma_f32_32x32x16_bf16(pa2, PK(l2, h2), od, 0, 0, 0);
    od = __builtin_amdgcn_mfma_f32_32x32x16_bf16(pa3, PK(l3, h3), od, 0, 0, 0);
#undef PK
}
typedef short v4i16_t __attribute__((ext_vector_type(4)));
template <int OFF> __device__ __forceinline__ s16x4 tr_read_b(int vb) {
    return __builtin_bit_cast(s16x4, __builtin_amdgcn_ds_read_tr16_b64_v4i16((__attribute__((address_space(3))) v4i16_t*)(uintptr_t)(unsigned)(vb + OFF)));
}
template <int D0> __device__ __forceinline__ void pv_one_b(f32x16& od, int vb, bf16x8 pa0, bf16x8 pa1, bf16x8 pa2, bf16x8 pa3) {
    const s16x4 l0 = tr_read_b<v_rd_off(D0, 0, 0)>(vb), h0 = tr_read_b<v_rd_off(D0, 0, 1)>(vb), l1 = tr_read_b<v_rd_off(D0, 1, 0)>(vb), h1 = tr_read_b<v_rd_off(D0, 1, 1)>(vb);
    const s16x4 l2 = tr_read_b<v_rd_off(D0, 2, 0)>(vb), h2 = tr_read_b<v_rd_off(D0, 2, 1)>(vb), l3 = tr_read_b<v_rd_off(D0, 3, 0)>(vb), h3 = tr_read_b<v_rd_off(D0, 3, 1)>(vb);
#define PK(L, H) (bf16x8){L[0], L[1], L[2], L[3], H[0], H[1], H[2], H[3]}
    od = __builtin_amdgcn_mfma_f32_32x32x16_bf16(pa0, PK(l0, h0), od, 0, 0, 0);
    od = __builtin_amdgcn_mfma_f32_32x32x16_bf16(pa1, PK(l1, h1), od, 0, 0, 0);
    od = __builtin_amdgcn_mfma_f32_32x32x16_bf16(pa2, PK(l2, h2), od, 0, 0, 0);
    od = __builtin_amdgcn_mfma_f32_32x32x16_bf16(pa3, PK(l3, h3), od, 0, 0, 0);
#undef PK
}
constexpr int SHM_V = 64 * 128 * 2;
template <int DK, bool PF, bool EARLY>
__device__ __forceinline__ void attn_loop(const bf16* __restrict__ Qrow  , const bf16* __restrict__ Kh, int ldk, const bf16* __restrict__ Vh, int ldv,
                                          int nkeys, float negM, f32x16 (&o)[4], float& l_reg, char* lds_kv, unsigned& sacc) {
    constexpr int NQ = DK / 16, CH = DK / 8, KP = (64 * CH) / NT, SHM_K = 64 * DK * 2;
    const int tid = threadIdx.x, lane = tid & 63, r32 = lane & 31, hi = lane >> 5;
    char* V_lds = lds_kv; char* K_lds = lds_kv + 2 * SHM_V;
    bf16x8 qr[NQ];
#pragma unroll
    for (int d0 = 0; d0 < NQ; ++d0) qr[d0] = *reinterpret_cast<const bf16x8*>(Qrow + d0 * 16);
    const __amdgpu_buffer_rsrc_t krs = __builtin_amdgcn_make_buffer_rsrc((void*)Kh, 0, nkeys * ldk * 2, 0x00020000);
    const __amdgpu_buffer_rsrc_t vrs = __builtin_amdgcn_make_buffer_rsrc((void*)Vh, 0, nkeys * ldv * 2, 0x00020000);
    unsigned kgo[KP]; int kst[KP];
#pragma unroll
    for (int i = 0; i < KP; ++i) { const int p = tid + i * NT, row = p / CH, ch = p % CH; kgo[i] = (unsigned)(row * ldk + ch * 8) * 2u; kst[i] = kswz<DK>(row, ch); }
    const int vrow0 = tid >> 4, vc = (tid & 15) * 8;
    const unsigned vgo = (unsigned)(vrow0 * ldv + vc) * 2u, vstep = (unsigned)(32 * ldv) * 2u;
    const int vst0 = v_st(vrow0, vc); constexpr int vst1d = 8192;
    const int vb0 = (int)(uintptr_t)V_lds + v_rd_base(lane);
    const int kbase = r32 * (DK * 2), kt0 = (hi ^ ((r32 >> 1) & 7)) << 4;
#define kra_(q) (kbase + (kt0 ^ ((q) << 5)))
    u32x4 ks[KP], vs0, vs1;
#define SLOAD(k0) do { const unsigned so_k = (unsigned)((k0) * ldk) * 2u, so_v = (unsigned)((k0) * ldv) * 2u; \
        _Pragma("unroll") for (int i = 0; i < KP; ++i) ks[i] = __builtin_amdgcn_raw_buffer_load_b128(krs, kgo[i], so_k, 0); \
        vs0 = __builtin_amdgcn_raw_buffer_load_b128(vrs, vgo, so_v, 0); vs1 = __builtin_amdgcn_raw_buffer_load_b128(vrs, vgo + vstep, so_v, 0); } while (0)
#define SWRITE(b) do { _Pragma("unroll") for (int i = 0; i < KP; ++i) *reinterpret_cast<u32x4*>(K_lds + (b) * SHM_K + kst[i]) = ks[i]; \
        *reinterpret_cast<u32x4*>(V_lds + (b) * SHM_V + vst0) = vs0; *reinterpret_cast<u32x4*>(V_lds + (b) * SHM_V + vst0 + vst1d) = vs1; } while (0)
    constexpr int KLINES = (64 * DK * 2) / 128, VLINES = 128, LPR = DK / 64;
    unsigned pf_dummy = 0u;
#define PREFETCH(t) do { if (PF && tid < KLINES + VLINES) { const bool isk_ = tid < KLINES; const int l_ = isk_ ? tid : tid - KLINES; \
        const unsigned off_ = isk_ ? (unsigned)(((t) * 64 + l_ / LPR) * ldk + (l_ % LPR) * 64) * 2u : (unsigned)(((t) * 64 + (l_ >> 1)) * ldv + (l_ & 1) * 64) * 2u + (unsigned)((const char*)Vh - (const char*)Kh); \
        asm volatile("global_load_dword %0, %1, %2" : "+v"(pf_dummy) : "v"(off_), "s"(Kh) : "memory"); } } while (0)
    const int ntile = nkeys / 64;
    PREFETCH(1); PREFETCH(2);
    SLOAD(0); SWRITE(0); __syncthreads();
    for (int j = 0; j < ntile; ++j) {
        const int cur = j & 1;
        PSUB_T0();
        if (EARLY && j + 1 < ntile) SLOAD((j + 1) * 64);
        f32x16 p0, p1;
#pragma unroll
        for (int r = 0; r < 16; ++r) { p0[r] = negM; p1[r] = negM; }
        const char* Kb = K_lds + cur * SHM_K;
#pragma unroll
        for (int d0 = 0; d0 < NQ; ++d0) {
            const bf16x8 b0 = *reinterpret_cast<const bf16x8*>(Kb + kra_(d0 & 3) + (d0 >> 2) * 128);
            const bf16x8 b1 = *reinterpret_cast<const bf16x8*>(Kb + kra_(d0 & 3) + (d0 >> 2) * 128 + 32 * DK * 2);
            p0 = __builtin_amdgcn_mfma_f32_32x32x16_bf16(b0, qr[d0], p0, 0, 0, 0);
            p1 = __builtin_amdgcn_mfma_f32_32x32x16_bf16(b1, qr[d0], p1, 0, 0, 0);
            if ((d0 & 3) == 3) SBAR();
        }
        PSUB_AT(1);
        if (!EARLY && j + 1 < ntile) SLOAD((j + 1) * 64);
        float ps = 0.f;
#pragma unroll
        for (int r = 0; r < 16; ++r) { p0[r] = __builtin_amdgcn_exp2f(p0[r]); p1[r] = __builtin_amdgcn_exp2f(p1[r]); ps += p0[r] + p1[r]; }
        l_reg += ps;
        bf16x8 pa0, pa1, pa2, pa3;
#define PK4(P, BASE, OUT) do { unsigned a0 = cvtpk(P[BASE + 0], P[BASE + 1]), a1 = cvtpk(P[BASE + 2], P[BASE + 3]);   \
        unsigned b0_ = cvtpk(P[BASE + 4], P[BASE + 5]), b1_ = cvtpk(P[BASE + 6], P[BASE + 7]);                              \
        auto r0 = __builtin_amdgcn_permlane32_swap(a0, b0_, false, false); auto r1 = __builtin_amdgcn_permlane32_swap(a1, b1_, false, false); \
        u32x4 w = {r0[0], r1[0], r0[1], r1[1]}; OUT = *reinterpret_cast<bf16x8*>(&w); } while (0)
        PK4(p0, 0, pa0); PK4(p0, 8, pa1); PK4(p1, 0, pa2); PK4(p1, 8, pa3);
#undef PK4
        PSUB_AT(2);
        const int vb = vb0 + cur * SHM_V;
        pv_one<0>(o[0], vb, pa0, pa1, pa2, pa3); pv_one<1>(o[1], vb, pa0, pa1, pa2, pa3); pv_one<2>(o[2], vb, pa0, pa1, pa2, pa3); pv_one<3>(o[3], vb, pa0, pa1, pa2, pa3);
        PSUB_AT(3);
        if (j + 1 < ntile) SWRITE(cur ^ 1);
        if (j + 3 < ntile) PREFETCH(j + 3);
        __syncthreads();
        PSUB_AT(4);
    }
    if (PF) asm volatile("s_waitcnt vmcnt(0)" : "+v"(pf_dummy) :: "memory");
#undef PREFETCH
#undef kra_
#undef SLOAD
#undef SWRITE
}
__device__ __forceinline__ void row_recip(float l_reg, float* li_l  , int r32, int hi, float (&rli)[16]) {
    { auto rr = __builtin_amdgcn_permlane32_swap(__float_as_uint(l_reg), __float_as_uint(l_reg), false, false); l_reg = __uint_as_float(rr[0]) + __uint_as_float(rr[1]); }
    if (hi == 0) li_l[r32] = l_reg;
    asm volatile("s_waitcnt lgkmcnt(0)" ::: "memory");
#pragma unroll
    for (int r = 0; r < 16; ++r) rli[r] = __builtin_amdgcn_rcpf(li_l[crow(r, hi)]);
}
#undef SBAR
}

constexpr int ATT_SCR_OFF = RING_BYTES - 2048;
__device__ __forceinline__ void mla_attn_unit(const Ptrs& P, unsigned char* lds, int b, int h, int qb, int ctxq, unsigned& sacc) {
    using namespace att;
    const int tid = threadIdx.x, wid = tid >> 6, lane = tid & 63, r32 = lane & 31, hi = lane >> 5;
    const bf16* Qm = (const bf16*)(P.ws + WS_QM); const bf16* Km = (const bf16*)(P.ws + WS_KM); const bf16* Vm = (const bf16*)(P.ws + WS_VM);
    const size_t u0 = (size_t)b * SU + (ctxq ? 0 : CTX) + qb * 256 + wid * 32;
    f32x16 o[4] = {}; float l_reg = 0.f;
    const float negM = -((const float*)(P.ws + WS_SCAL))[0];
    attn_loop<192, false, false>(Qm + (u0 + r32) * 768 + h * 192 + hi * 8, Km + (size_t)b * SU * 768 + h * 192, 768, Vm + (size_t)b * SU * 512 + h * 128, 512, ctxq ? CTX : SU, negM, o, l_reg, (char*)lds, sacc);
    float rli[16]; row_recip(l_reg, (float*)(lds + ATT_SCR_OFF) + wid * 64, r32, hi, rli);
    bf16* stg = (bf16*)lds + wid * 4096;
#pragma unroll
    for (int r = 0; r < 16; ++r) { const int orow = crow(r, hi);
#pragma unroll
        for (int d0 = 0; d0 < 4; ++d0) stg[orow * 128 + d0 * 32 + r32] = f2bf(o[d0][r] * rli[r]); }
    asm volatile("s_waitcnt lgkmcnt(0)" ::: "memory");
    bf16* mix = (bf16*)(P.ws + WS_MIX) + u0 * D + 512 + h * 128;
#pragma unroll
    for (int i = 0; i < 8; ++i) { const int row = i * 4 + (lane >> 4), ch = lane & 15; const u32x4 v = *(const u32x4*)(stg + row * 128 + ch * 8); *(u32x4*)(mix + (size_t)row * D + ch * 8) = v; }
    asm volatile("s_waitcnt lgkmcnt(0)" ::: "memory");
    __syncthreads();
}
__device__ __forceinline__ void diff_attn_unit(const Ptrs& P, unsigned char* lds, int b, int h, int qb, unsigned& sacc) {
    using namespace att;
    const int tid = threadIdx.x, wid = tid >> 6, lane = tid & 63, r32 = lane & 31, hi = lane >> 5;
    const bf16* Z = (const bf16*)(P.ws + WS_Z);
    const size_t u0 = (size_t)b * SU + CTX + qb * 256 + wid * 32;
    const float* scal = (const float*)(P.ws + WS_SCAL); const float negM = -scal[1], lam = scal[2], oml = scal[3];
    bf16* stg = (bf16*)lds + wid * 4096;
    float* li_l = (float*)(lds + ATT_SCR_OFF) + wid * 64;
    for (int part = 0; part < 2; ++part) {
        f32x16 o[4] = {}; float l_reg = 0.f;
        attn_loop<64, true, true>(Z + (u0 + r32) * ODD_IN + h * 128 + part * 64 + hi * 8, Z + 1024 + (size_t)b * SU * ODD_IN + h * 128 + part * 64, ODD_IN, Z + 2048 + (size_t)b * SU * ODD_IN + h * 128, ODD_IN, SU, negM, o, l_reg, (char*)lds + 65536, sacc);
        float rli[16]; row_recip(l_reg, li_l, r32, hi, rli);
#pragma unroll
        for (int r = 0; r < 16; ++r) { const int orow = crow(r, hi);
#pragma unroll
            for (int d0 = 0; d0 < 4; ++d0) { bf16* s = stg + orow * 128 + d0 * 32 + r32; const float on = o[d0][r] * rli[r];
                if (part == 0) *s = f2bf(on); else *s = f2bf(bf2f(*s) - lam * on); } }
        asm volatile("s_waitcnt lgkmcnt(0)" ::: "memory");
    }
    const float* sg = P.in[31];
    bf16* mix = (bf16*)(P.ws + WS_MIX) + u0 * D + h * 128;
#pragma unroll
    for (int i = 0; i < 8; ++i) { const int row = i * 4 + (lane >> 4), ch = lane & 15; const u32x4 v = *(const u32x4*)(stg + row * 128 + ch * 8);
        float f[8]; float ss = 0.f;
#pragma unroll
        for (int e = 0; e < 4; ++e) { f[2 * e] = __uint_as_float(v[e] << 16); f[2 * e + 1] = __uint_as_float(v[e] & 0xffff0000u); ss += f[2 * e] * f[2 * e] + f[2 * e + 1] * f[2 * e + 1]; }
        ss = sum16(ss);
        const float rs = rsqrtf(ss * (1.f / 128.f) + EPS) * oml;
        const f32x4 g0 = *(const f32x4*)(sg + ch * 8), g1 = *(const f32x4*)(sg + ch * 8 + 4);
        u32x4 w; w.x = att::cvtpk(f[0] * rs * g0[0], f[1] * rs * g0[1]); w.y = att::cvtpk(f[2] * rs * g0[2], f[3] * rs * g0[3]); w.z = att::cvtpk(f[4] * rs * g1[0], f[5] * rs * g1[1]); w.w = att::cvtpk(f[6] * rs * g1[2], f[7] * rs * g1[3]);
        *(u32x4*)(mix + (size_t)row * D + ch * 8) = w; }
    asm volatile("s_waitcnt lgkmcnt(0)" ::: "memory");
    __syncthreads();
}

__device__ __forceinline__ void ph_norm2_router(const Ptrs& P, unsigned char* lds, int layer, int latent_only) {
    const int tid = threadIdx.x, wid = tid >> 6, lane = tid & 63, fr = lane & 15, fq = lane >> 4, G = gridDim.x;
    float* RS = (float*)lds;
    float* LGP = RS + 256;
    int* TOPE = (int*)(LGP + 2 * 4096);
    float* TOPW = (float*)(TOPE + 512);
    int* TOPR = (int*)(TOPW + 512);
    int* LCNT = TOPR + 512;
    int* LBASE = LCNT + 32;
    int* GU0 = LBASE + 32;
    const float* gn = P.in[7] + layer * D;
    const float* rw = P.in[32] + (size_t)layer * D * NE; const float* rb = P.in[33] + layer * NE;
    const int cw0 = 128 * wid + 8 * fq;
    float wv0[4][8], wv1[4][8];
#pragma unroll
    for (int ks = 0; ks < 4; ++ks) { const float* wr = rw + (size_t)(cw0 + 32 * ks) * NE + fr;
#pragma unroll
        for (int j = 0; j < 8; ++j) { wv0[ks][j] = wr[j * NE]; wv1[ks][j] = wr[j * NE + 16]; } }
    const int NG = latent_only ? NB * (SEQ / 16) : R / 16;
    const int q0 = (int)(((long long)blockIdx.x * NG) / G), q1 = (int)(((long long)(blockIdx.x + 1) * NG) / G);
#define N2_U0(q) (latent_only ? ((q) >> 8) * SU + CTX + ((q) & 255) * 16 : (q) * 16)
#define N2_XLOAD(XR, q) do { const bf16* x_ = (const bf16*)(P.ws + WS_XB) + (size_t)(N2_U0(q) + fr) * D + cw0; _Pragma("unroll") for (int ks = 0; ks < 4; ++ks) XR[ks] = *(const u32x4*)(x_ + 32 * ks); } while (0)
#define N2_LO(w) __uint_as_float((w) << 16)
#define N2_HI(w) __uint_as_float((w) & 0xffff0000u)
#define N2_SS(XR, par) do { float ss = 0.f; _Pragma("unroll") for (int ks = 0; ks < 4; ++ks) { const u32x4 r = XR[ks]; \
            ss += N2_LO(r.x) * N2_LO(r.x) + N2_HI(r.x) * N2_HI(r.x) + N2_LO(r.y) * N2_LO(r.y) + N2_HI(r.y) * N2_HI(r.y) + N2_LO(r.z) * N2_LO(r.z) + N2_HI(r.z) * N2_HI(r.z) + N2_LO(r.w) * N2_LO(r.w) + N2_HI(r.w) * N2_HI(r.w); } \
        ss += lane_xor16(ss); ss += lane_xor32(ss); if (fq == 0) RS[(par) * 128 + wid * 16 + fr] = ss; } while (0)
    float A[4][8], Hs[4][8]; int mi_cur = -1;
    for (int qs = q0; qs < q1; qs += 8) {
        const int qe = qs + 8 < q1 ? qs + 8 : q1;
        __syncthreads();
        if (tid < 32) LCNT[tid] = 0;
        u32x4 xr[4], xn[4];
        N2_XLOAD(xr, qs);
        N2_SS(xr, 0);
        __syncthreads();
        for (int q = qs; q < qe; ++q) {
            const int gi = q - qs, par = gi & 1, u0 = N2_U0(q), u = u0 + fr;
            { const int b_ = u0 / SU, mi = (u0 % SU) < CTX ? 4 : b_;
              if (mi != mi_cur) { mi_cur = mi; const float* md = (const float*)(P.ws + WS_MOD) + (size_t)(layer * 5 + mi) * 6144 + 3 * D;
#pragma unroll
                  for (int ks = 0; ks < 4; ++ks) { const int c0 = cw0 + 32 * ks;
                      const f32x4 g0 = *(const f32x4*)(gn + c0), g1 = *(const f32x4*)(gn + c0 + 4), s0 = *(const f32x4*)(md + D + c0), s1 = *(const f32x4*)(md + D + c0 + 4), h0 = *(const f32x4*)(md + c0), h1 = *(const f32x4*)(md + c0 + 4);
#pragma unroll
                      for (int j = 0; j < 4; ++j) { A[ks][j] = g0[j] * (1.f + s0[j]); A[ks][4 + j] = g1[j] * (1.f + s1[j]); Hs[ks][j] = h0[j]; Hs[ks][4 + j] = h1[j]; } } } }
            if (q + 1 < qe) N2_XLOAD(xn, q + 1);
            if (tid == 0) GU0[gi] = u0;
            float tot = 0.f;
#pragma unroll
            for (int w = 0; w < 8; ++w) tot += RS[par * 128 + w * 16 + fr];
            const float rstd = rsqrtf(tot * (1.f / D) + EPS);
            f32x4 acc0 = {0.f, 0.f, 0.f, 0.f}, acc1 = {0.f, 0.f, 0.f, 0.f};
            bf16* h = (bf16*)(P.ws + WS_H) + (size_t)u * D + cw0;
#pragma unroll
            for (int ks = 0; ks < 4; ++ks) {
                float y[8];
                const u32x4 r = xr[ks]; const float xv[8] = {N2_LO(r.x), N2_HI(r.x), N2_LO(r.y), N2_HI(r.y), N2_LO(r.z), N2_HI(r.z), N2_LO(r.w), N2_HI(r.w)};
#pragma unroll
                for (int j = 0; j < 8; ++j) y[j] = xv[j] * rstd * A[ks][j] + Hs[ks][j];
                u32x4 w; w.x = g8::cvt_pk_bf16(y[0], y[1]); w.y = g8::cvt_pk_bf16(y[2], y[3]); w.z = g8::cvt_pk_bf16(y[4], y[5]); w.w = g8::cvt_pk_bf16(y[6], y[7]);
                *(u32x4*)(h + 32 * ks) = w;
#pragma unroll
                for (int j = 0; j < 8; ++j) {
                    acc0 = __builtin_amdgcn_mfma_f32_16x16x4f32(y[j], wv0[ks][j], acc0, 0, 0, 0);
                    acc1 = __builtin_amdgcn_mfma_f32_16x16x4f32(y[j], wv1[ks][j], acc1, 0, 0, 0);
                }
            }
            float* lgp = LGP + par * 4096;
#pragma unroll
            for (int j = 0; j < 4; ++j) { lgp[(wid * 16 + 4 * fq + j) * 32 + fr] = acc0[j]; lgp[(wid * 16 + 4 * fq + j) * 32 + 16 + fr] = acc1[j]; }
            if (q + 1 < qe) { N2_SS(xn, par ^ 1);
#pragma unroll
                for (int ks = 0; ks < 4; ++ks) xr[ks] = xn[ks]; }
            __syncthreads();
            {
                const int e = lane & 31, row = 2 * wid + (lane >> 5);
                float lg = rb[e];
#pragma unroll
                for (int w = 0; w < 8; ++w) lg += lgp[(w * 16 + row) * 32 + e];
                int te[4]; float tv[4];
#pragma unroll
                for (int k = 0; k < 4; ++k) {
                    float bv = lg; int bi = e;
#pragma unroll
                    for (int m = 0; m < 5; ++m) {
                        const float ov = m == 0 ? dpp_f<DPP_X1>(bv) : m == 1 ? dpp_f<DPP_X2>(bv) : m == 2 ? dpp_f<DPP_HM>(bv) : m == 3 ? dpp_f<DPP_RM>(bv) : lane_xor16(bv);
                        const int oi = m == 0 ? dpp_i<DPP_X1>(bi) : m == 1 ? dpp_i<DPP_X2>(bi) : m == 2 ? dpp_i<DPP_HM>(bi) : m == 3 ? dpp_i<DPP_RM>(bi) : lane_xor16i(bi);
                        const bool take = ov > bv || (ov == bv && oi < bi); bv = take ? ov : bv; bi = take ? oi : bi; }
                    te[k] = bi; tv[k] = bv; if (e == bi) lg = -3.4e38f;
                }
                float den = 0.f, w[4];
#pragma unroll
                for (int k = 0; k < 4; ++k) { w[k] = __expf(tv[k] - tv[0]); den += w[k]; }
                const float iden = 1.f / den;
                if (e < 4) { const int ek = e == 0 ? te[0] : e == 1 ? te[1] : e == 2 ? te[2] : te[3]; const float wk = (e == 0 ? w[0] : e == 1 ? w[1] : e == 2 ? w[2] : w[3]) * iden;
                    TOPE[gi * 64 + row * 4 + e] = ek; TOPW[gi * 64 + row * 4 + e] = wk; TOPR[gi * 64 + row * 4 + e] = atomicAdd(&LCNT[ek], 1); }
            }
        }
        __syncthreads();
        if (tid < 32) { int t2 = tid; asm volatile("" : "+v"(t2));
            const int c = LCNT[t2]; LBASE[t2] = c > 0 ? (int)atomicAdd((unsigned*)(P.ws + WS_CTL) + CW_CNT + layer * 64 + t2, (unsigned)c) : 0; }
        __syncthreads();
        int* tok_of = (int*)(P.ws + WS_TOKOF); int* pair_of = (int*)(P.ws + WS_PAIROF); float* gate_of = (float*)(P.ws + WS_GATEOF);
        for (int p = tid; p < (qe - qs) * 64; p += NT) {
            const int e = TOPE[p], rk = LBASE[e] + TOPR[p], ur = GU0[p >> 6] + ((p & 63) >> 2), k = p & 3;
            tok_of[(size_t)e * R + rk] = ur; pair_of[(size_t)e * R + rk] = ur * 4 + k; gate_of[(size_t)e * R + rk] = TOPW[p];
        }
    }
#undef N2_U0
#undef N2_XLOAD
#undef N2_SS
#undef N2_LO
#undef N2_HI
}

__device__ __forceinline__ void prefetch_resid(const Ptrs& P, int layer) {
    g8::DenseOrder S; S.init((const bf16*)P.ws, D, (const bf16*)P.ws, D, R, D, (int)gridDim.x, (int)blockIdx.x, layer);
    const int tid = threadIdx.x; unsigned dummy = 0u;
#pragma unroll 1
    for (int i = 0; i < 2; ++i) {
        g8::Unit u; if (!S.next(i, u)) break;
        if (layer == 0) { const int b = u.pm / 17, jt = u.pm % 17;
            const char* t0 = (const char*)(jt == 0 ? P.in[2] + (size_t)(b * CTX) * D : P.in[0] + (size_t)(b * SEQ + (jt - 1) * 256) * D) + u.pn * 1024;
#pragma unroll
            for (int k = 0; k < 4; ++k) { const int l = tid + k * NT; const char* a = t0 + (size_t)(l >> 3) * 4096 + (l & 7) * 128; asm volatile("global_load_dword %0, %1, off" : "+v"(dummy) : "v"(a) : "memory"); } }
        else { const char* t0 = (const char*)((const bf16*)(P.ws + WS_XB) + (size_t)u.pm * 256 * D) + u.pn * 512;
#pragma unroll
            for (int k = 0; k < 2; ++k) { const int l = tid + k * NT; const char* a = t0 + (size_t)(l >> 2) * 2048 + (l & 3) * 128; asm volatile("global_load_dword %0, %1, off" : "+v"(dummy) : "v"(a) : "memory"); } }
    }
    asm volatile("s_waitcnt vmcnt(0)" : "+v"(dummy) :: "memory");
}

struct Args { Ptrs P; int ph_lo, ph_hi; };
constexpr int N_PHASES = 19;
__global__ void __launch_bounds__(NT, 2) mega(Args args) {
    extern __shared__ __attribute__((aligned(16))) unsigned char lds[];
    const Ptrs& P = args.P;
    unsigned char* ws = P.ws;
    const int tid = threadIdx.x, G = gridDim.x;
    const int vcu = (G % 8 == 0) ? ((int)blockIdx.x % 8) * (G / 8) + (int)blockIdx.x / 8 : (int)blockIdx.x;
    LAS unsigned char* LDSP = (LAS unsigned char*)lds;
    volatile LAS unsigned* MISC = (volatile LAS unsigned*)((LAS unsigned char*)lds + MISC_OFF);
    for (int u = tid; u < (LDS_BYTES - LDSCTL_OFF) / 4; u += NT) ((LAS unsigned*)((LAS unsigned char*)lds + LDSCTL_OFF))[u] = 0u;
    __syncthreads();
    XcdBarrier bar = xcd_barrier_post((unsigned*)(ws + WS_CTL) + CW_BAR, MISC + 8);
    const int lo = args.ph_lo, hi = args.ph_hi;
#ifndef PROBE_MASK
#define PROBE_MASK 0u
#endif
    unsigned long long pr_acc = 0ull, pr_t0 = 0ull; unsigned sub_acc = 0u;
#define IN(k) (lo <= (k) && (k) < hi)
#define SEAM(k) do { if (IN(k) && IN((k) + 1)) xcd_barrier(bar); \
        if (PROBE_MASK) { const unsigned long long t_ = __builtin_amdgcn_s_memrealtime(); if ((PROBE_MASK >> (k)) & 1u) pr_acc += t_ - pr_t0; pr_t0 = t_; } } while (0)
    if (PROBE_MASK) pr_t0 = __builtin_amdgcn_s_memrealtime();
    const bf16* H = (const bf16*)(ws + WS_H); bf16* Z = (bf16*)(ws + WS_Z); const bf16* MIX = (const bf16*)(ws + WS_MIX);
    const bf16* Qm = (const bf16*)(ws + WS_QM); const bf16* Km = (const bf16*)(ws + WS_KM); const bf16* Vm = (const bf16*)(ws + WS_VM);

    if (IN(0)) { ph_prologue(P, lds, sub_acc); } SEAM(0);
    if (IN(1)) { ph_rows(P, 0, 0, 0, 0); } SEAM(1);
    if (IN(2)) { g8::DenseOrder S; S.init(H, D, (const bf16*)(ws + WS_WEVIN), D, R, EVEN_IN_P, G, (int)blockIdx.x, 0); g8::EpiStoreBf16 E{Z, EVEN_IN_P};
        g8::gemm_phase<g8::EpiStoreBf16, g8::DenseOrder, false, true>(LDSP, D, D, S, E); } SEAM(2);
    if (IN(3)) {
        { g8::UpOrder S{(const char*)Z, (const char*)(ws + WS_WUQ), (const char*)(ws + WS_WUKV), G, (int)blockIdx.x}; g8::EpiStoreBf16 E{(bf16*)(ws + WS_QP), 1792};
          g8::gemm_phase<g8::EpiStoreBf16, g8::UpOrder, false, true>(LDSP, EVEN_IN_P, 384, S, E); }
        ph_lru(P, lds, 0, 0);
    } SEAM(3);
    if (IN(4)) { ph_mla_prep(P); } SEAM(4);
    if (IN(5)) {
        ph_lru(P, lds, 1, 128);
        for (int it = vcu; it < 256 + 16; it += G) {
            if (it < 256) mla_attn_unit(P, lds, it / 64, (it / 16) % 4, it % 16, 0, sub_acc);
            else { const int i2 = it - 256; mla_attn_unit(P, lds, i2 / 4, i2 % 4, 0, 1, sub_acc); }
        }
        prefetch_resid(P, 0);
    } SEAM(5);
    if (IN(6)) { g8::DenseOrder S; S.init(MIX, D, (const bf16*)(ws + WS_WEVOUT), D, R, D, G, (int)blockIdx.x, 0); g8::EpiOut E{P, 0};
        g8::gemm_phase<g8::EpiOut, g8::DenseOrder, false, true>(LDSP, D, D, S, E); } SEAM(6);
    if (IN(7)) { ph_norm2_router(P, lds, 0, 0); } SEAM(7);
    if (IN(8)) { g8::MoeOrder S{(const char*)H, (const char*)(ws + WS_WGU) + (size_t)0 * NE * 2048 * 1024 * 2, (const int*)(ws + WS_TOKOF), (size_t)2048 * 1024 * 2, 8, D, G, vcu, 1, nullptr};
        S.init((const unsigned*)(ws + WS_CTL) + CW_CNT + 0 * 64, (LAS int*)(LDSP + MISC_OFF + 256)); g8::EpiMoe1 E{P, 0}; g8::gemm_phase<g8::EpiMoe1, g8::MoeOrder, true, true>(LDSP, D, D, S, E); } SEAM(8);
    if (IN(9)) { g8::MoeOrder S{(const char*)(ws + WS_ACT), (const char*)(ws + WS_WDN) + (size_t)0 * NE * 1024 * 1024 * 2, nullptr, (size_t)1024 * 1024 * 2, 4, D, G, vcu, 0, nullptr};
        S.init((const unsigned*)(ws + WS_CTL) + CW_CNT + 0 * 64, (LAS int*)(LDSP + MISC_OFF + 256)); g8::EpiMoe2 E{P, 0}; g8::gemm_phase<g8::EpiMoe2, g8::MoeOrder, false, true>(LDSP, D, D, S, E); } SEAM(9);
    if (IN(10)) { ph_rows(P, 0, 2, 0, 1); } SEAM(10);
    if (IN(11)) { g8::DenseOrder S; S.init(H, D, (const bf16*)(ws + WS_WODIN), D, R, ODD_IN, G, (int)blockIdx.x, 0);
        g8::EpiDiffIn E{Z, P.in[25], P.in[26], (const float*)(ws + WS_ROPE), (const float*)(ws + WS_ROPE) + SEQ * 64, (LAS float*)(LDSP + MISC_OFF + 1024)};
        g8::gemm_phase<g8::EpiDiffIn, g8::DenseOrder, false, true>(LDSP, D, D, S, E); } SEAM(11);
    if (IN(13)) {
        for (int it = vcu; it < 512; it += G) { unsigned tq0 = 0u; if (PROBE_SUB == 5 && PROBE_SUBDK == 64) tq0 = (unsigned)__builtin_readcyclecounter();
            diff_attn_unit(P, lds, it / 128, (it / 16) % 8, it % 16, sub_acc);
            if (PROBE_SUB == 5 && PROBE_SUBDK == 64) sub_acc += (unsigned)__builtin_readcyclecounter() - tq0; }
        prefetch_resid(P, 1);
    } SEAM(13);
    if (IN(14)) { g8::DenseOrder S; S.init(MIX, D, (const bf16*)(ws + WS_WODOUT), D, R, D, G, (int)blockIdx.x, 1); g8::EpiOut E{P, 1};
        g8::gemm_phase<g8::EpiOut, g8::DenseOrder, false, true>(LDSP, D, D, S, E); } SEAM(14);
    if (IN(15)) { ph_norm2_router(P, lds, 1, 1); } SEAM(15);
    if (IN(16)) { g8::MoeOrder S{(const char*)H, (const char*)(ws + WS_WGU) + (size_t)1 * NE * 2048 * 1024 * 2, (const int*)(ws + WS_TOKOF), (size_t)2048 * 1024 * 2, 8, D, G, vcu, 1, nullptr};
        S.init((const unsigned*)(ws + WS_CTL) + CW_CNT + 1 * 64, (LAS int*)(LDSP + MISC_OFF + 256)); g8::EpiMoe1 E{P, 1}; g8::gemm_phase<g8::EpiMoe1, g8::MoeOrder, true, true>(LDSP, D, D, S, E); } SEAM(16);
    if (IN(17)) { g8::MoeOrder S{(const char*)(ws + WS_ACT), (const char*)(ws + WS_WDN) + (size_t)1 * NE * 1024 * 1024 * 2, nullptr, (size_t)1024 * 1024 * 2, 4, D, G, vcu, 0, nullptr};
        S.init((const unsigned*)(ws + WS_CTL) + CW_CNT + 1 * 64, (LAS int*)(LDSP + MISC_OFF + 256)); g8::EpiMoe2 E{P, 1}; g8::gemm_phase<g8::EpiMoe2, g8::MoeOrder, false, true>(LDSP, D, D, S, E); } SEAM(17);
    if (IN(18)) { ph_rows(P, 1, 2, 1, 0); }
    if (PROBE_MASK) { const unsigned long long t_ = __builtin_amdgcn_s_memrealtime(); if ((PROBE_MASK >> 18) & 1u) pr_acc += t_ - pr_t0;
        if (blockIdx.x == 0) { const unsigned long long t1 = t_ + 8ull * pr_acc; while (__builtin_amdgcn_s_memrealtime() < t1) __builtin_amdgcn_s_sleep(8); } }
    if (PROBE_SUB && (PROBE_SUBBLK < 0 || (int)blockIdx.x == PROBE_SUBBLK)) { const unsigned long long t1 = __builtin_readcyclecounter() + 8ull * (unsigned long long)sub_acc; while (__builtin_readcyclecounter() < t1) __builtin_amdgcn_s_sleep(8); }
#undef IN
#undef SEAM
}

#ifndef MK_PER_PHASE
#define MK_PER_PHASE 0
#endif
extern "C" void kernel_launch(void* const* d_in, const int* in_sizes, int n_in, void* d_out, int out_size, void* d_ws, size_t ws_size, hipStream_t stream) {
    static int grid = 0;
    if (grid == 0) {
        if (n_in != 38 || ws_size < WS_END) { fprintf(stderr, "kernel_launch: bad args n_in=%d ws=%zu need %zu\n", n_in, ws_size, (size_t)WS_END); grid = -1; return; }
        int dev = 0, cus = 0, per_cu = 0;
        if (hipGetDevice(&dev) != hipSuccess || hipDeviceGetAttribute(&cus, hipDeviceAttributeMultiprocessorCount, dev) != hipSuccess) { grid = -1; return; }
        if (hipFuncSetAttribute((const void*)mega, hipFuncAttributeMaxDynamicSharedMemorySize, LDS_BYTES) != hipSuccess) { fprintf(stderr, "kernel_launch: hipFuncSetAttribute failed\n"); grid = -1; return; }
        if (hipOccupancyMaxActiveBlocksPerMultiprocessor(&per_cu, (const void*)mega, NT, LDS_BYTES) != hipSuccess || per_cu < 1) { fprintf(stderr, "kernel_launch: occupancy query says %d blocks/CU\n", per_cu); grid = -1; return; }
        (void)hipGetLastError();
        grid = cus;
    }
    if (grid < 0) return;
    if (hipMemsetAsync((char*)d_ws + WS_CTL, 0, 1u << 20, stream) != hipSuccess) return;
    Args a; memset((void*)&a, 0, sizeof(a));
    for (int i = 0; i < 38; ++i) a.P.in[i] = (const float*)d_in[i];
    a.P.out = (float*)d_out; a.P.ws = (unsigned char*)d_ws;
#if MK_PER_PHASE
    for (int p = 0; p < N_PHASES; ++p) { a.ph_lo = p; a.ph_hi = p + 1; hipLaunchKernelGGL(mega, dim3(grid), dim3(NT), LDS_BYTES, stream, a); }
#else
    a.ph_lo = 0; a.ph_hi = N_PHASES;
    hipLaunchKernelGGL(mega, dim3(grid), dim3(NT), LDS_BYTES, stream, a);
#endif
    const hipError_t le = hipPeekAtLastError();
    if (le != hipSuccess) fprintf(stderr, "kernel_launch: launch failed: %s\n", hipGetErrorName(le));
}
```

```cpp
#include <hip/hip_runtime.h>
#include <cstdio>
#include <cstdint>
#include <cstring>

typedef unsigned short bf16;
typedef unsigned u32x4 __attribute__((ext_vector_type(4)));
typedef float f32x4 __attribute__((ext_vector_type(4)));

constexpr int D = 1024, NB = 4, SEQ = 4096, CTX = 256, SU = SEQ + CTX, R = NB * SU;
constexpr int GRID_W = 64;
constexpr int LRU_W = 512, LRU_NB = 8, LRU_BW = 64;
constexpr int MLA_H = 4, MLA_QR = 384, MLA_KVR = 256, MLA_NOPE = 128, MLA_ROPE = 64, MLA_V = 128, MLA_QK = 192;
constexpr int EVEN_IN = 1728, EVEN_IN_P = 1792;
constexpr int DIFF_H = 8, ODD_IN = 3072;
constexpr int NE = 32, TOPK = 4, DFF = 1024;
constexpr float EPS = 1e-6f;
constexpr int CHUNK = 128, NCH = SU / CHUNK;

constexpr size_t al256(size_t x) { return (x + 255) / 256 * 256; }
constexpr size_t WS_CTL = 0;
constexpr size_t WS_MOD = 1u << 20;
constexpr size_t WS_SCAL = WS_MOD + al256(2 * 5 * 6144 * 4);
constexpr size_t WS_WEVIN = WS_SCAL + 8192;
constexpr size_t WS_WEVOUT = WS_WEVIN + (size_t)EVEN_IN_P * D * 2;
constexpr size_t WS_WUQ = WS_WEVOUT + (size_t)D * D * 2;
constexpr size_t WS_WUKV = WS_WUQ + (size_t)768 * 384 * 2;
constexpr size_t WS_WLRU = WS_WUKV + (size_t)1024 * 384 * 2;
constexpr size_t WS_WODIN = WS_WLRU + (size_t)32 * 4096 * 2;
constexpr size_t WS_WODOUT = WS_WODIN + (size_t)ODD_IN * D * 2;
constexpr size_t WS_WGU = WS_WODOUT + (size_t)D * D * 2;
constexpr size_t WS_WDN = WS_WGU + (size_t)2 * NE * 2048 * 1024 * 2;
constexpr size_t WS_XC = WS_WDN + (size_t)2 * NE * 1024 * 1024 * 2;
constexpr size_t WS_H = WS_XC + (size_t)NB * CTX * D * 4;
constexpr size_t WS_Z = WS_H + (size_t)R * D * 2;
constexpr size_t WS_QP = WS_Z + (size_t)R * ODD_IN * 2;
constexpr size_t WS_KVP = WS_QP + (size_t)R * 768 * 2;
constexpr size_t WS_QM = WS_KVP + (size_t)R * 1024 * 2;
constexpr size_t WS_KM = WS_QM + (size_t)R * 768 * 2;
constexpr size_t WS_VM = WS_KM + (size_t)R * 768 * 2;
constexpr size_t WS_AGG = WS_VM + (size_t)R * 512 * 2;
constexpr size_t WS_MIX = WS_AGG + al256((size_t)NB * NCH * 2 * 512 * 2 * 4);
constexpr size_t WS_TOKOF = WS_MIX + (size_t)R * D * 2;
constexpr size_t WS_PAIROF = WS_TOKOF + (size_t)NE * R * 4;
constexpr size_t WS_GATEOF = WS_PAIROF + (size_t)NE * R * 4;
constexpr size_t ACT_ROWS = (size_t)R * TOPK + NE * 256;
constexpr size_t WS_ACT = WS_GATEOF + (size_t)NE * R * 4;
constexpr size_t WS_Y = WS_ACT + ACT_ROWS * 1024 * 2;
constexpr size_t WS_XB = WS_Y + (size_t)R * TOPK * 1024 * 2;
constexpr size_t WS_ROPE = WS_XB + (size_t)R * D * 2;
constexpr size_t WS_END = WS_ROPE + (size_t)2 * SEQ * 64 * 4;

constexpr int CW_CNT = 64;
constexpr int CW_DEFQ = 256;
constexpr int DEF_GU = 1400, DEF_DN = 700;

__device__ __forceinline__ float bf2f(bf16 v) { return __uint_as_float((unsigned)v << 16); }
__device__ __forceinline__ bf16 f2bf(float f) { unsigned u = __float_as_uint(f); return (bf16)((u + 0x7fffu + ((u >> 16) & 1u)) >> 16); }
template <int CTRL> __device__ __forceinline__ float dpp_f(float x) { return __uint_as_float((unsigned)__builtin_amdgcn_update_dpp(0, (int)__float_as_uint(x), CTRL, 0xf, 0xf, false)); }
template <int CTRL> __device__ __forceinline__ int dpp_i(int x) { return __builtin_amdgcn_update_dpp(0, x, CTRL, 0xf, 0xf, false); }
constexpr int DPP_X1 = 0xB1, DPP_X2 = 0x4E, DPP_HM = 0x141, DPP_RM = 0x140;
__device__ __forceinline__ float lane_xor32(float x) { const auto r = __builtin_amdgcn_permlane32_swap(__float_as_uint(x), __float_as_uint(x), false, false); return __uint_as_float((threadIdx.x & 32) ? r[0] : r[1]); }
__device__ __forceinline__ float lane_xor16(float x) { const auto r = __builtin_amdgcn_permlane16_swap(__float_as_uint(x), __float_as_uint(x), false, false); return __uint_as_float((threadIdx.x & 16) ? r[0] : r[1]); }
__device__ __forceinline__ int lane_xor16i(int x) { const auto r = __builtin_amdgcn_permlane16_swap((unsigned)x, (unsigned)x, false, false); return (int)((threadIdx.x & 16) ? r[0] : r[1]); }
__device__ __forceinline__ float lane_shift16(float x, bool down) { const float y = lane_xor16(x), z = lane_xor32(y); const bool odd = (threadIdx.x & 16) != 0; return (odd == down) ? y : z; }
__device__ __forceinline__ float sum16(float v) { v += dpp_f<DPP_X1>(v); v += dpp_f<DPP_X2>(v); v += dpp_f<DPP_HM>(v); v += dpp_f<DPP_RM>(v); return v; }
__device__ __forceinline__ float sum32(float v) { v = sum16(v); v += lane_xor16(v); return v; }
__device__ __forceinline__ float wave_sum(float v) { v = sum32(v); v += lane_xor32(v); return v; }
__device__ __forceinline__ unsigned g8_cvt_pk(float lo, float hi) { unsigned r; asm volatile("v_cvt_pk_bf16_f32 %0, %1, %2" : "=v"(r) : "v"(lo), "v"(hi)); return r; }
__device__ __forceinline__ float sigmoidf_(float x) { return 1.f / (1.f + __expf(-x)); }
__device__ __forceinline__ float gelu_tanh(float x) { const float t = tanhf(0.7978845608028654f * (x + 0.044715f * x * x * x)); return 0.5f * x * (1.f + t); }

struct Ptrs {
    const float* in[38];
    float* out;
    unsigned char* ws;
};

__device__ __forceinline__ const float* res_in_row(const Ptrs& P, int layer, int u) {
    const int b = u / SU, j = u % SU;
    if (layer == 0) return j < CTX ? P.in[2] + (size_t)(b * CTX + j) * D : P.in[0] + (size_t)(b * SEQ + j - CTX) * D;
    return j < CTX ? (const float*)(P.ws + WS_XC) + (size_t)(b * CTX + j) * D : P.out + (size_t)(b * SEQ + j - CTX) * D;
}
__device__ __forceinline__ float* res_out_row(const Ptrs& P, int u) {
    const int b = u / SU, j = u % SU;
    return j < CTX ? (float*)(P.ws + WS_XC) + (size_t)(b * CTX + j) * D : P.out + (size_t)(b * SEQ + j - CTX) * D;
}
__device__ __forceinline__ const float* mod_row(const Ptrs& P, int layer, int u) {
    const int b = u / SU, j = u % SU;
    return (const float*)(P.ws + WS_MOD) + (size_t)(layer * 5 + (j < CTX ? 4 : b)) * 6144;
}

constexpr float LOG2E = 1.4426950408889634f;
#define GAS __attribute__((address_space(1)))
#define LAS __attribute__((address_space(3)))
constexpr int NT = 512;
constexpr int LDS_BYTES = 147456;
constexpr int RING_BYTES = 131072, LDSCTL_OFF = RING_BYTES, MISC_OFF = LDSCTL_OFF + 320;
constexpr int CW_BAR = 4096;
constexpr int CW_TMO = 0;

#define XB_TMO      128
#define XB_XCNT(j)  (256  + 64 * (j))
#define XB_XSUB(j)  (1280 + 64 * (j))
#define XB_XGEN(j)  (2304 + 64 * (j))
#define XB_TOP      3328
#define XB_TOPGEN   3392
#define XCD_BAR_WORDS 3456
#define XB_SPIN_CAP (1u << 22)
__device__ __forceinline__ unsigned xb_ld(unsigned* p)              { return __hip_atomic_load(p, __ATOMIC_RELAXED, __HIP_MEMORY_SCOPE_AGENT); }
__device__ __forceinline__ unsigned xb_add(unsigned* p, unsigned v) { return __hip_atomic_fetch_add(p, v, __ATOMIC_RELAXED, __HIP_MEMORY_SCOPE_AGENT); }
__device__ __forceinline__ unsigned xb_xcc_id() { return (unsigned)__builtin_amdgcn_s_getreg((3 << 11) | 20) & 0xFu; }
#define XB_SPIN(cond, bar) do { unsigned _sp = 0; while (cond) { __builtin_amdgcn_s_sleep(1); \
    if ((++_sp & 255u) == 0u) { if (xb_ld(&(bar)[XB_TMO])) break; if (_sp > XB_SPIN_CAP) { atomicAdd(&(bar)[XB_TMO], 1u); break; } } } } while (0)
struct XcdBarrier { unsigned* bar; unsigned x; volatile LAS unsigned* st; };
__device__ __forceinline__ XcdBarrier xcd_barrier_post(unsigned* bar, volatile LAS unsigned* st) {
    XcdBarrier b; b.bar = bar; b.x = xb_xcc_id(); b.st = st;
    if (threadIdx.x == 0) (void)xb_add(&bar[XB_XCNT(b.x)], 1u);
    return b;
}
__device__ __forceinline__ void xcd_barrier_complete(unsigned* bar, unsigned x, unsigned& nloc, unsigned& nx) {
    const unsigned G = gridDim.x * gridDim.y * gridDim.z;
    unsigned sum, cnt, mine, sp = 0u;
    for (;;) {
        sum = 0u; cnt = 0u; mine = 0u;
#pragma unroll
        for (unsigned j = 0; j < 16; ++j) { const unsigned c = xb_ld(&bar[XB_XCNT(j)]); sum += c; cnt += (c > 0u) ? 1u : 0u; mine = (j == x) ? c : mine; }
        if (sum == G) break;
        __builtin_amdgcn_s_sleep(1);
        if ((++sp & 255u) == 0u) { if (xb_ld(&bar[XB_TMO])) break; if (sp > XB_SPIN_CAP) { atomicAdd(&bar[XB_TMO], 1u); break; } }
    }
    nloc = mine > 0u ? mine : 1u; nx = cnt > 0u ? cnt : 1u;
}
__device__ __forceinline__ void xcd_barrier(const XcdBarrier& b) {
    asm volatile("s_waitcnt vmcnt(0)" ::: "memory");
    __syncthreads();
    if (threadIdx.x == 0) {
        unsigned* bar = b.bar;
        __builtin_amdgcn_s_waitcnt(0);
        unsigned nloc = b.st[0], nx = b.st[1];
        if (nloc == 0u) { xcd_barrier_complete(bar, b.x, nloc, nx); b.st[0] = nloc; b.st[1] = nx; }
        const unsigned old = xb_add(&bar[XB_XSUB(b.x)], 1u);
        const unsigned gen = old / nloc;
        if (old + 1u == (gen + 1u) * nloc) {
            __builtin_amdgcn_fence(__ATOMIC_RELEASE, "agent");
            asm volatile("s_waitcnt vmcnt(0)" ::: "memory");
            const unsigned og = xb_add(&bar[XB_TOP], 1u);
            const unsigned tg = og / nx;
            if (og + 1u == (tg + 1u) * nx) xb_add(&bar[XB_TOPGEN], 1u);
            else XB_SPIN(xb_ld(&bar[XB_TOPGEN]) == tg, bar);
            __builtin_amdgcn_fence(__ATOMIC_ACQUIRE, "agent");
            xb_add(&bar[XB_XGEN(b.x)], 1u);
            asm volatile("s_waitcnt vmcnt(0)" ::: "memory");
        } else {
            XB_SPIN(xb_ld(&bar[XB_XGEN(b.x)]) == gen, bar);
            __builtin_amdgcn_fence(__ATOMIC_ACQUIRE, "agent");
            asm volatile("s_waitcnt vmcnt(0)" ::: "memory");
        }
    }
    __syncthreads();
}

struct TJob { const float* src; bf16* dst; const float* rs; int K, N, Npad, perm, batch; size_t sstr, dstr; int Ksrc; };
__device__ __forceinline__ void tt_load(const TJob& j, int it, int lane, f32x4 (&v)[16]) {
    const int tn = j.Npad / 64, per = tn * (j.K / 64), z = it / per, r = it % per, n0 = (r % tn) * 64, k0 = (r / tn) * 64;
    const float* src = j.src + z * j.sstr;
    const int n4 = (lane & 15) * 4, np = n0 + n4;
    int sc = np; if (j.perm == 1) sc = (np / 256) * 128 + (np % 128) + ((np % 256) / 128) * 1024;
#pragma unroll
    for (int i = 0; i < 16; ++i) { const int k = k0 + i * 4 + (lane >> 4); f32x4 t = {0.f, 0.f, 0.f, 0.f}; if (sc < j.N && k < j.Ksrc) { t = __builtin_nontemporal_load((const f32x4*)(src + (size_t)k * j.N + sc)); if (j.rs) t = t * j.rs[k]; } v[i] = t; }
}
__device__ __forceinline__ void tt_store(const TJob& j, int it, int lane, const f32x4 (&v)[16], float* wt) {
    const int tn = j.Npad / 64, per = tn * (j.K / 64), z = it / per, r = it % per, n0 = (r % tn) * 64, k0 = (r / tn) * 64;
    bf16* dst = j.dst + z * j.dstr + ((((size_t)(n0 >> 8) * (j.K >> 6) + (k0 >> 6)) << 14) + (((n0 & 255) + lane) << 6));
    const int n4 = (lane & 15) * 4;
#pragma unroll
    for (int half = 0; half < 2; ++half) {
#pragma unroll
        for (int i = 0; i < 8; ++i) *(f32x4*)(wt + (i * 4 + (lane >> 4)) * 68 + n4) = v[half * 8 + i];
        asm volatile("s_waitcnt lgkmcnt(0)" ::: "memory");
#pragma unroll
        for (int kc = 0; kc < 4; ++kc) { float f[8];
#pragma unroll
            for (int q = 0; q < 8; ++q) f[q] = wt[(kc * 8 + q) * 68 + lane];
            u32x4 w; w.x = f2bf(f[0]) | ((unsigned)f2bf(f[1]) << 16); w.y = f2bf(f[2]) | ((unsigned)f2bf(f[3]) << 16); w.z = f2bf(f[4]) | ((unsigned)f2bf(f[5]) << 16); w.w = f2bf(f[6]) | ((unsigned)f2bf(f[7]) << 16);
            *(u32x4*)(dst + half * 32 + kc * 8) = w; }
        asm volatile("s_waitcnt lgkmcnt(0)" ::: "memory");
    }
}
__device__ __forceinline__ void run_tjob(const TJob& j, float* wt, int& base, int NW, int gw, int lane) {
    const int total = (j.Npad / 64) * (j.K / 64) * j.batch;
    int it = (gw - base % NW + NW) % NW;
    if (it < total) {
        f32x4 cur[16], nxt[16];
        tt_load(j, it, lane, cur);
        for (; it < total; it += NW) {
            const bool more = it + NW < total;
            if (more) tt_load(j, it + NW, lane, nxt);
            tt_store(j, it, lane, cur, wt);
            if (more) {
#pragma unroll
                for (int i = 0; i < 16; ++i) cur[i] = nxt[i]; }
        }
    }
    base += total;
}
__device__ __forceinline__ void bt_load(const float* __restrict__ src, int N, int perm, int it, int ntn, f32x4 (&v)[8]) {
    const int wid = threadIdx.x >> 6, lane = threadIdx.x & 63;
    const int per = 16 * ntn, z = it / per, r = it % per, kt = r / ntn, nt = r % ntn;
    const int np = nt * 256 + lane * 4;
    const int sc = perm ? (nt * 128 + (lane & 31) * 4 + (lane >> 5) * 1024) : np;
    const float* p = src + (size_t)z * 1024 * N + (size_t)(kt * 64 + wid * 8) * N + sc;
#pragma unroll
    for (int i = 0; i < 8; ++i) v[i] = __builtin_nontemporal_load((const f32x4*)(p + (size_t)i * N));
}
__device__ __forceinline__ void ph_big_transpose(const float* __restrict__ src, int N, int perm, int batch, bf16* __restrict__ dst, float* tile  , int G, int ndefer) {
    const int tid = threadIdx.x, wid = tid >> 6, lane = tid & 63, ntn = N / 256, total = batch * 16 * ntn - ndefer;
    int it = (int)blockIdx.x;
    if (it >= total) return;
    f32x4 cur[8], nxt[8], nx2[8];
    bt_load(src, N, perm, it, ntn, cur);
    if (it + G < total) bt_load(src, N, perm, it + G, ntn, nxt);
    for (; it < total; it += G) {
        const bool more = it + G < total, more2 = it + 2 * G < total;
        if (more2) bt_load(src, N, perm, it + 2 * G, ntn, nx2);
        __syncthreads();
#pragma unroll
        for (int i = 0; i < 8; ++i) { float* t = tile + (wid * 8 + i) * 257 + lane * 4; t[0] = cur[i][0]; t[1] = cur[i][1]; t[2] = cur[i][2]; t[3] = cur[i][3]; }
        __syncthreads();
        const int per = 16 * ntn, z = it / per, r = it % per, kt = r / ntn, nt = r % ntn;
        bf16* d = dst + (size_t)z * N * 1024 + (((size_t)nt * 16 + kt) << 14);
        const int kc = lane & 7;
#pragma unroll
        for (int pss = 0; pss < 4; ++pss) {
            const int n = wid * 32 + pss * 8 + (lane >> 3); float f[8];
#pragma unroll
            for (int j = 0; j < 8; ++j) f[j] = tile[(kc * 8 + j) * 257 + n];
            u32x4 w; w.x = g8_cvt_pk(f[0], f[1]); w.y = g8_cvt_pk(f[2], f[3]); w.z = g8_cvt_pk(f[4], f[5]); w.w = g8_cvt_pk(f[6], f[7]);
            __builtin_nontemporal_store(w, (u32x4*)(d + n * 64 + kc * 8));
        }
        if (more) {
#pragma unroll
            for (int i = 0; i < 8; ++i) { cur[i] = nxt[i]; nxt[i] = nx2[i]; } }
    }
    __syncthreads();
}
__device__ __forceinline__ void convert_deferred(const Ptrs& P, unsigned char* lds, int quota) {
    const int tid = threadIdx.x, wid = tid >> 6, lane = tid & 63;
    float* tile = (float*)lds;
    volatile __attribute__((address_space(3))) int* slot = (volatile __attribute__((address_space(3))) int*)((__attribute__((address_space(3))) unsigned char*)lds + 131072 + 320 + 11000);
    unsigned* q = (unsigned*)(P.ws + WS_CTL) + CW_DEFQ;
    for (int n = 0; n < quota; ++n) {
        __syncthreads();
        if (tid == 0) *slot = (int)atomicAdd(q, 1u);
        __syncthreads();
        const int t = *slot;
        if (t >= DEF_GU + DEF_DN) break;
        const bool gu = t < DEF_GU;
        const float* src = gu ? P.in[34] : P.in[36]; bf16* dst = (bf16*)(P.ws + (gu ? WS_WGU : WS_WDN));
        const int N = gu ? 2048 : 1024, ntn = N / 256, it = gu ? 2 * NE * 16 * 8 - DEF_GU + t : 2 * NE * 16 * 4 - DEF_DN + (t - DEF_GU);
        f32x4 cur[8];
        bt_load(src, N, gu ? 1 : 0, it, ntn, cur);
#pragma unroll
        for (int i = 0; i < 8; ++i) { float* tp = tile + (wid * 8 + i) * 257 + lane * 4; tp[0] = cur[i][0]; tp[1] = cur[i][1]; tp[2] = cur[i][2]; tp[3] = cur[i][3]; }
        __syncthreads();
        const int per = 16 * ntn, z = it / per, r = it % per, kt = r / ntn, nt = r % ntn;
        bf16* d = dst + (size_t)z * N * 1024 + (((size_t)nt * 16 + kt) << 14);
        const int kc = lane & 7;
#pragma unroll
        for (int pss = 0; pss < 4; ++pss) {
            const int nn = wid * 32 + pss * 8 + (lane >> 3); float f[8];
#pragma unroll
            for (int j = 0; j < 8; ++j) f[j] = tile[(kc * 8 + j) * 257 + nn];
            u32x4 w; w.x = g8_cvt_pk(f[0], f[1]); w.y = g8_cvt_pk(f[2], f[3]); w.z = g8_cvt_pk(f[4], f[5]); w.w = g8_cvt_pk(f[6], f[7]);
            *(u32x4*)(d + nn * 64 + kc * 8) = w;
        }
    }
    __syncthreads();
}
#ifndef PROBE_SUB
#define PROBE_SUB 0
#define PROBE_SUBDK 0
#endif
#define PSEC(k) do { if (PROBE_SUB == (k)) { const unsigned t_ = (unsigned)__builtin_readcyclecounter(); sacc += t_ - pt0; } if (PROBE_SUB >= 10) pt0 = (unsigned)__builtin_readcyclecounter(); } while (0)
__device__ __forceinline__ void ph_prologue(const Ptrs& P, unsigned char* lds, unsigned& sacc) {
    unsigned char* ws = P.ws; const int G = gridDim.x; int base = 0; unsigned pt0 = 0u; PSEC(-1);
    const int wave = threadIdx.x >> 6, lane = threadIdx.x & 63, NW = G * 8, gw = (int)blockIdx.x + G * wave;
    float* wt = (float*)lds + wave * (32 * 68);
    {
        float* s = (float*)lds + 8 * 32 * 68;
        float* part = s + 5 * 1024;
        for (int it = (int)blockIdx.x; it < 2 * 128; it += G) {
            const int layer = it / 128, cb = (it % 128) * 48;
            __syncthreads();
            for (int i = threadIdx.x; i < 5 * 1024; i += NT) { const int r = i / 1024, k = i % 1024; const float c = r < 4 ? P.in[1][r * 1024 + k] : P.in[3][k]; s[i] = c / (1.f + __expf(-c)); }
            __syncthreads();
            const int kr = lane >> 4, c4 = (lane & 15) < 12 ? (lane & 15) * 4 : 44;
            const float* w = P.in[4] + (size_t)layer * 1024 * 6144 + (size_t)(wave * 128 + kr) * 6144 + cb + c4;
            float a[5][4];
#pragma unroll
            for (int r = 0; r < 5; ++r) { a[r][0] = 0.f; a[r][1] = 0.f; a[r][2] = 0.f; a[r][3] = 0.f; }
#pragma unroll 1
            for (int hh = 0; hh < 2; ++hh) {
                f32x4 wv[16];
#pragma unroll
                for (int i = 0; i < 16; ++i) wv[i] = __builtin_nontemporal_load((const f32x4*)(w + (size_t)(hh * 64 + i * 4) * 6144));
#pragma unroll
                for (int i = 0; i < 16; ++i) { const int k = wave * 128 + hh * 64 + i * 4 + kr;
#pragma unroll
                    for (int r = 0; r < 5; ++r) { const float sv = s[r * 1024 + k]; a[r][0] += sv * wv[i][0]; a[r][1] += sv * wv[i][1]; a[r][2] += sv * wv[i][2]; a[r][3] += sv * wv[i][3]; } }
            }
#pragma unroll
            for (int r = 0; r < 5; ++r)
#pragma unroll
                for (int e = 0; e < 4; ++e) { float t = a[r][e]; t += lane_xor16(t); t += lane_xor32(t); if (lane < 12) part[(wave * 5 + r) * 64 + c4 + e] = t; }
            __syncthreads();
            if (threadIdx.x < 320 && (threadIdx.x & 63) < 48) { const int r = threadIdx.x / 64, c = threadIdx.x % 64; float t = P.in[5][layer * 6144 + cb + c];
#pragma unroll
                for (int wv = 0; wv < 8; ++wv) t += part[(wv * 5 + r) * 64 + c];
                ((float*)(ws + WS_MOD))[(size_t)(layer * 5 + r) * 6144 + cb + c] = t; }
        }
        __syncthreads();
    }
    PSEC(10);
    TJob j;
    ph_big_transpose(P.in[34], 2048, 1, 2 * NE, (bf16*)(ws + WS_WGU), (float*)lds, G, DEF_GU);
    PSEC(11);
    ph_big_transpose(P.in[36], 1024, 0, 2 * NE, (bf16*)(ws + WS_WDN), (float*)lds, G, DEF_DN);
    PSEC(12);
    j = TJob{P.in[8], (bf16*)(ws + WS_WEVIN), nullptr, 1024, EVEN_IN, EVEN_IN_P, 0, 1, 0, 0, 1024}; run_tjob(j, wt, base, NW, gw, lane);
    j = TJob{P.in[9], (bf16*)(ws + WS_WEVOUT), nullptr, 1024, 1024, 1024, 0, 1, 0, 0, 1024}; run_tjob(j, wt, base, NW, gw, lane);
    j = TJob{P.in[18], (bf16*)(ws + WS_WUQ), P.in[17], 384, 768, 768, 0, 1, 0, 0, 384}; run_tjob(j, wt, base, NW, gw, lane);
    j = TJob{P.in[20], (bf16*)(ws + WS_WUKV), P.in[19], 384, 1024, 1024, 0, 1, 0, 0, 256}; run_tjob(j, wt, base, NW, gw, lane);
    j = TJob{P.in[12], (bf16*)(ws + WS_WLRU), nullptr, 64, 64, 64, 0, 8, 4096, 4096, 64}; run_tjob(j, wt, base, NW, gw, lane);
    j = TJob{P.in[14], (bf16*)(ws + WS_WLRU) + 8 * 4096, nullptr, 64, 64, 64, 0, 8, 4096, 4096, 64}; run_tjob(j, wt, base, NW, gw, lane);
    j = TJob{P.in[12] + 8 * 4096, (bf16*)(ws + WS_WLRU) + 16 * 4096, nullptr, 64, 64, 64, 0, 8, 4096, 4096, 64}; run_tjob(j, wt, base, NW, gw, lane);
    j = TJob{P.in[14] + 8 * 4096, (bf16*)(ws + WS_WLRU) + 24 * 4096, nullptr, 64, 64, 64, 0, 8, 4096, 4096, 64}; run_tjob(j, wt, base, NW, gw, lane);
    j = TJob{P.in[23], (bf16*)(ws + WS_WODIN), nullptr, 1024, ODD_IN, ODD_IN, 0, 1, 0, 0, 1024}; run_tjob(j, wt, base, NW, gw, lane);
    j = TJob{P.in[24], (bf16*)(ws + WS_WODOUT), nullptr, 1024, 1024, 1024, 0, 1, 0, 0, 1024}; run_tjob(j, wt, base, NW, gw, lane);
    __syncthreads();
    PSEC(13);
    {
        float* rc = (float*)(ws + WS_ROPE); float* rs = rc + SEQ * 64;
        for (int i = (int)blockIdx.x * NT + threadIdx.x; i < SEQ * 64; i += G * NT) {
            const int t = i >> 6, e = i & 63, q = e & 15;
            const float f = exp2f(-(float)(2 * q) / 32.f * 13.287712379549449f);
            const float ang = (float)((e >> 5) ? (t % GRID_W) : (t / GRID_W)) * f;
            float sv, cv; sincosf(ang, &sv, &cv); rc[i] = cv; rs[i] = sv;
        }
    }
    if ((int)blockIdx.x == G - 2) { float* c8t = (float*)(ws + WS_SCAL) + 1024; for (int i = threadIdx.x; i < 2 * LRU_W; i += NT) c8t[i] = 8.f * LOG2E * log1pf(__expf(-P.in[16][i])); }
    if ((int)blockIdx.x == G - 1 && threadIdx.x == 0) {
        float* sc = (float*)(ws + WS_SCAL);
        float mq = 0, mk = 0;
        for (int i = 0; i < 192; ++i) { mq = fmaxf(mq, fabsf(P.in[21][i])); mk = fmaxf(mk, fabsf(P.in[22][i])); }
        sc[0] = sqrtf(192.f) * mq * mk * LOG2E;
        mq = 0; mk = 0;
        for (int i = 0; i < 64; ++i) { mq = fmaxf(mq, fabsf(P.in[25][i])); mk = fmaxf(mk, fabsf(P.in[26][i])); }
        sc[1] = 8.f * mq * mk * LOG2E;
        float s1 = 0, s2 = 0;
        for (int i = 0; i < 64; ++i) { s1 += P.in[27][i] * P.in[28][i]; s2 += P.in[29][i] * P.in[30][i]; }
        const float lam_init = 0.8f - 0.6f * expf(-0.3f * 1.f);
        sc[2] = expf(s1) - expf(s2) + lam_init;
        sc[3] = 1.f - lam_init;
    }
}

__device__ __forceinline__ void norm_mod_store(const Ptrs& P, float (&v)[16], int lane, int u, int layer, int which) {
    const float* g = (which == 0 ? P.in[6] : P.in[7]) + layer * D;
    const float* md = mod_row(P, layer, u) + (which == 0 ? 0 : 3 * D);
    f32x4 gv[4], scv[4], shv[4];
#pragma unroll
    for (int j = 0; j < 4; ++j) { const int c = j * 256 + lane * 4; gv[j] = *(const f32x4*)(g + c); scv[j] = *(const f32x4*)(md + D + c); shv[j] = *(const f32x4*)(md + c); }
    float ss = 0.f;
#pragma unroll
    for (int i = 0; i < 16; ++i) ss += v[i] * v[i];
    const float rstd = rsqrtf(wave_sum(ss) * (1.f / D) + EPS);
    bf16* h = (bf16*)(P.ws + WS_H) + (size_t)u * D;
#pragma unroll
    for (int j = 0; j < 4; ++j) {
        const int c = j * 256 + lane * 4;
#pragma unroll
        for (int e = 0; e < 4; ++e) v[4 * j + e] = v[4 * j + e] * rstd * gv[j][e] * (1.f + scv[j][e]) + shv[j][e];
        const unsigned lo = f2bf(v[4 * j]) | ((unsigned)f2bf(v[4 * j + 1]) << 16), hi = f2bf(v[4 * j + 2]) | ((unsigned)f2bf(v[4 * j + 3]) << 16);
        *(uint2*)(h + c) = make_uint2(lo, hi);
    }
}
struct RowIn { f32x4 xf[4]; uint2 xb[4]; uint2 y[4][4]; };
__device__ __forceinline__ RowIn rows_load(const Ptrs& P, int layer, int mode, int u, int lane) {
    RowIn r{};
    if (mode == 0) { const float* x = res_in_row(P, layer, u);
#pragma unroll
        for (int j = 0; j < 4; ++j) r.xf[j] = *(const f32x4*)(x + j * 256 + lane * 4); }
    else { const bf16* x = (const bf16*)(P.ws + WS_XB) + (size_t)u * D; const bf16* y = (const bf16*)(P.ws + WS_Y) + (size_t)u * 4 * 1024;
#pragma unroll
        for (int j = 0; j < 4; ++j) { const int c = j * 256 + lane * 4; r.xb[j] = *(const uint2*)(x + c);
#pragma unroll
            for (int k = 0; k < 4; ++k) r.y[k][j] = *(const uint2*)(y + k * 1024 + c); } }
    return r;
}
__device__ __forceinline__ void ph_rows(const Ptrs& P, int layer, int mode, int latent_only, int next_norm) {
    const int wave = threadIdx.x >> 6, lane = threadIdx.x & 63, G = gridDim.x;
    const int NR = latent_only ? NB * SEQ : R;
#define ROW_U(q) (latent_only ? ((q) / SEQ) * SU + CTX + (q) % SEQ : (q))
    const int gw = (int)blockIdx.x * 8 + wave, NWV = G * 8;
    const int q0 = (int)(((long long)gw * NR) / NWV), q1 = (int)(((long long)(gw + 1) * NR) / NWV);
    if (q0 >= q1) return;
    const bool do_norm = mode == 0 || next_norm; const int nlayer = mode == 0 ? layer : layer + 1;
    f32x4 A[4], sh[4], g2v[4]; int mi_cur = -1;
    RowIn cur = rows_load(P, layer, mode, ROW_U(q0), lane);
    for (int q = q0; q < q1; ++q) {
        const int u = ROW_U(q);
        RowIn nxt = cur;
        if (q + 1 < q1) nxt = rows_load(P, layer, mode, ROW_U(q + 1), lane);
        { const int b_ = u / SU, mi = (u % SU) < CTX ? 4 : b_;
          if (mi != mi_cur) { mi_cur = mi;
              if (do_norm) { const float* g = P.in[6] + nlayer * D; const float* md = (const float*)(P.ws + WS_MOD) + (size_t)(nlayer * 5 + mi) * 6144;
#pragma unroll
                  for (int j = 0; j < 4; ++j) { const int c = j * 256 + lane * 4; const f32x4 gv = *(const f32x4*)(g + c), scv = *(const f32x4*)(md + D + c); sh[j] = *(const f32x4*)(md + c);
#pragma unroll
                      for (int e = 0; e < 4; ++e) A[j][e] = gv[e] * (1.f + scv[e]); } }
              if (mode != 0) { const float* g2 = (const float*)(P.ws + WS_MOD) + (size_t)(layer * 5 + mi) * 6144 + 5 * D;
#pragma unroll
                  for (int j = 0; j < 4; ++j) g2v[j] = *(const f32x4*)(g2 + j * 256 + lane * 4); } } }
        float v[16];
        if (mode == 0) {
#pragma unroll
            for (int j = 0; j < 4; ++j) { v[4 * j] = cur.xf[j][0]; v[4 * j + 1] = cur.xf[j][1]; v[4 * j + 2] = cur.xf[j][2]; v[4 * j + 3] = cur.xf[j][3]; }
        } else {
            float* xo = res_out_row(P, u); bf16* xbo = (bf16*)(P.ws + WS_XB) + (size_t)u * D;
#pragma unroll
            for (int j = 0; j < 4; ++j) { const int c = j * 256 + lane * 4; f32x4 o;
                const uint2 t = cur.xb[j];
                v[4 * j] = __uint_as_float(t.x << 16); v[4 * j + 1] = __uint_as_float(t.x & 0xffff0000u); v[4 * j + 2] = __uint_as_float(t.y << 16); v[4 * j + 3] = __uint_as_float(t.y & 0xffff0000u);
                float f[4] = {0.f, 0.f, 0.f, 0.f};
#pragma unroll
                for (int k = 0; k < 4; ++k) { const uint2 w = cur.y[k][j]; f[0] += __uint_as_float(w.x << 16); f[1] += __uint_as_float(w.x & 0xffff0000u); f[2] += __uint_as_float(w.y << 16); f[3] += __uint_as_float(w.y & 0xffff0000u); }
#pragma unroll
                for (int e = 0; e < 4; ++e) { v[4 * j + e] += g2v[j][e] * f[e]; o[e] = v[4 * j + e]; }
                if (next_norm) { uint2 w; w.x = g8_cvt_pk(o[0], o[1]); w.y = g8_cvt_pk(o[2], o[3]); *(uint2*)(xbo + c) = w; }
                else *(f32x4*)(xo + c) = o; }
        }
        if (do_norm) {
            float ss = 0.f;
#pragma unroll
            for (int i = 0; i < 16; ++i) ss += v[i] * v[i];
            const float rstd = rsqrtf(wave_sum(ss) * (1.f / D) + EPS);
            bf16* h = (bf16*)(P.ws + WS_H) + (size_t)u * D;
#pragma unroll
            for (int j = 0; j < 4; ++j) { const int c = j * 256 + lane * 4; float y[4];
#pragma unroll
                for (int e = 0; e < 4; ++e) y[e] = v[4 * j + e] * rstd * A[j][e] + sh[j][e];
                uint2 w; w.x = g8_cvt_pk(y[0], y[1]); w.y = g8_cvt_pk(y[2], y[3]); *(uint2*)(h + c) = w; }
        }
        cur = nxt;
    }
#undef ROW_U
}

namespace g8 {
typedef short bf16x8 __attribute__((ext_vector_type(8)));
constexpr int BM = 256, BK = 64, HALF = 128, HTB = HALF * BK * 2, STAGE_BYTES = 8 * HTB, NXCD = 8, WGM = 8;
__host__ __device__ __forceinline__ int lds_byte(int r, int c) { const int st = (r >> 4) * 2 + (c >> 5), rr = r & 15, cc = c & 31, ob = rr * 64 + cc * 2; return st * 1024 + (ob ^ (((ob >> 9) & 1) << 5)); }
__host__ __device__ __forceinline__ void stage_rc(int b, int& R, int& C) { const int st = b / 1024, sb = b % 1024, swz = sb ^ (((sb >> 9) & 1) << 5); R = (st >> 1) * 16 + swz / 64; C = (st & 1) * 32 + (swz % 64) / 2; }
__host__ __device__ __forceinline__ int perm32(int rho) { const int n = rho >> 4, i = rho & 15; return 8 * (i >> 2) + 4 * n + (i & 3); }
struct Unit { const char* a; const char* b; int pm, pn, e, aux, cnt; };
__device__ __forceinline__ unsigned cvt_pk_bf16(float lo, float hi) { unsigned r; asm volatile("v_cvt_pk_bf16_f32 %0, %1, %2" : "=v"(r) : "v"(lo), "v"(hi)); return r; }

template <class Epi, class Sched, bool GATHER, bool ALIGN_EPI, bool PFB = false>
__device__ __forceinline__ void gemm_phase(LAS unsigned char* lds, const int lda, const int K, const Sched& S, const Epi& E) {
    const int tid = threadIdx.x, wid = __builtin_amdgcn_readfirstlane(tid >> 6), lane = tid & 63, wr = wid >> 2, wc = wid & 3, fr = lane & 15, fq = lane >> 4;
    const int nt = K / BK;
    int Rr[2], Cc[2]; unsigned voffB[2];
#pragma unroll
    for (int i = 0; i < 2; ++i) { stage_rc(tid * 16 + i * 8192, Rr[i], Cc[i]); const int Rb = Epi::PERM ? ((Rr[i] & ~31) + perm32(Rr[i] & 31)) : Rr[i]; voffB[i] = (unsigned)(Rb * BK + Cc[i]) * 2u; }
    const size_t kstep = (size_t)(BK * 2), kstepB = (size_t)BM * BK * 2;
    const size_t hstepB = (size_t)HALF * BK * 2;
    const unsigned ldsw = (unsigned)wid * 1024u;
    const int aoff = lds_byte(wr * 64 + fr, fq * 8), boff = lds_byte(wc * 32 + fr, fq * 8);
#define G8_SA(b, h) (((b) * 2 + (h)) * HTB)
#define G8_SB(b, h) ((4 + (b) * 2 + (h)) * HTB)
#define G8_STAGE(bufoff, gbase, v0, v1) do { \
        __builtin_amdgcn_global_load_lds((const unsigned*)((const char*)(gbase) + (v0)), (LAS unsigned*)(lds + (bufoff) + ldsw), 16, 0, 0); \
        __builtin_amdgcn_global_load_lds((const unsigned*)((const char*)(gbase) + (v1)), (LAS unsigned*)(lds + (bufoff) + ldsw + 8192), 16, 0, 0); } while (0)
#define G8_LDA(dst, b, h) do { _Pragma("unroll") for (int m = 0; m < 4; ++m) _Pragma("unroll") for (int k = 0; k < 2; ++k) dst[m][k] = *(const LAS bf16x8*)(lds + G8_SA(b, h) + aoff + m * 2048 + k * 1024); } while (0)
#define G8_LDB(dst, b, h) do { _Pragma("unroll") for (int n = 0; n < 2; ++n) _Pragma("unroll") for (int k = 0; k < 2; ++k) dst[n][k] = *(const LAS bf16x8*)(lds + G8_SB(b, h) + boff + n * 2048 + k * 1024); } while (0)
#define G8_MMA(ai, bj, At, Bt) do { __builtin_amdgcn_s_setprio(1); _Pragma("unroll") for (int m = 0; m < 4; ++m) _Pragma("unroll") for (int n = 0; n < 2; ++n) _Pragma("unroll") for (int k = 0; k < 2; ++k) \
        acc[ai][bj][m][n] = __builtin_amdgcn_mfma_f32_16x16x32_bf16(Bt[n][k], At[m][k], acc[ai][bj][m][n], 0, 0, 0); __builtin_amdgcn_s_setprio(0); } while (0)
#define G8_WAIT_V(n) asm volatile("s_waitcnt vmcnt(" #n ")" ::: "memory")
#define G8_WAIT_L(n) asm volatile("s_waitcnt lgkmcnt(" #n ")" ::: "memory")
#define G8_BAR __builtin_amdgcn_s_barrier()
#define G8_SCHED __builtin_amdgcn_sched_barrier(0)
    Unit cur, nxt; int ui = 0;
    if (!S.next(0, cur)) return;
    unsigned vA0[2], vA1[2], nA0[2], nA1[2];
#pragma unroll
    for (int i = 0; i < 2; ++i) {
        if (GATHER) { vA0[i] = S.arow_off(cur, Rr[i]) + (unsigned)Cc[i] * 2u; vA1[i] = S.arow_off(cur, HALF + Rr[i]) + (unsigned)Cc[i] * 2u; }
        else { vA0[i] = (unsigned)(Rr[i] * lda + Cc[i]) * 2u; vA1[i] = (unsigned)((HALF + Rr[i]) * lda + Cc[i]) * 2u; }
        nA0[i] = vA0[i]; nA1[i] = vA1[i];
    }
    f32x4 acc[2][2][4][2];
#pragma unroll
    for (int a = 0; a < 2; ++a)
#pragma unroll
        for (int b = 0; b < 2; ++b)
#pragma unroll
            for (int m = 0; m < 4; ++m)
#pragma unroll
                for (int n = 0; n < 2; ++n) acc[a][b][m][n] = (f32x4){0.f, 0.f, 0.f, 0.f};
    bf16x8 At[4][2], B0[2][2], B1[2][2];
    const char* cA = cur.a; const char* cB = cur.b;
    G8_STAGE(G8_SB(0, 0), cB, voffB[0], voffB[1]); G8_STAGE(G8_SB(0, 1), cB + hstepB, voffB[0], voffB[1]); G8_STAGE(G8_SA(0, 0), cA, vA0[0], vA0[1]); G8_STAGE(G8_SA(0, 1), cA, vA1[0], vA1[1]);
    if (wr == 1) G8_BAR;
    G8_WAIT_V(2); G8_BAR;
    G8_STAGE(G8_SB(1, 0), cB + kstepB, voffB[0], voffB[1]); G8_STAGE(G8_SA(1, 0), cA + kstep, vA0[0], vA0[1]); G8_STAGE(G8_SB(1, 1), cB + hstepB + kstepB, voffB[0], voffB[1]);
    G8_WAIT_V(6); G8_BAR;
    for (;;) {
        const bool has_next = S.next(ui + 1, nxt);
        const char* nA = has_next ? nxt.a : cA; const char* nB = has_next ? nxt.b : cB;
        unsigned pf_dummy = 0u;
        if (PFB && has_next && nB != cB) {
            const char* pb = nB + (size_t)tid * 128;
#pragma unroll
            for (int i = 0; i < 8; ++i) { if (i * NT * 128 < 256 * K * 2) asm volatile("global_load_dword %0, %1, off" : "+v"(pf_dummy) : "v"(pb + (size_t)i * NT * 128) : "memory"); }
        }
        if (GATHER) {
#pragma unroll
            for (int i = 0; i < 2; ++i) { if (has_next) { nA0[i] = S.arow_off(nxt, Rr[i]) + (unsigned)Cc[i] * 2u; nA1[i] = S.arow_off(nxt, HALF + Rr[i]) + (unsigned)Cc[i] * 2u; } else { nA0[i] = vA0[i]; nA1[i] = vA1[i]; } }
        }
#pragma unroll 1
        for (int t = 0; t < nt; t += 2) {
            const bool last = (t == nt - 2);
            const char* a1 = cA + (size_t)(t + 1) * kstep;
            const char* a2 = last ? nA : cA + (size_t)(t + 2) * kstep; const char* b2 = last ? nB : cB + (size_t)(t + 2) * kstepB;
            const char* a3 = a2 + kstep; const char* b3 = b2 + kstepB;
            unsigned x00 = vA0[0], x01 = vA0[1], x10 = vA1[0], x11 = vA1[1];
            if (GATHER) { x00 = last ? nA0[0] : vA0[0]; x01 = last ? nA0[1] : vA0[1]; x10 = last ? nA1[0] : vA1[0]; x11 = last ? nA1[1] : vA1[1]; }
            G8_LDB(B0, 0, 0); G8_LDB(B1, 0, 1); G8_SCHED; G8_LDA(At, 0, 0); G8_STAGE(G8_SA(1, 1), a1, vA1[0], vA1[1]);
            G8_WAIT_V(8); if (PFB) asm volatile("" : "+v"(pf_dummy)); G8_WAIT_L(0); G8_BAR; G8_MMA(0, 0, At, B0); G8_MMA(0, 1, At, B1); G8_BAR; G8_SCHED;
            G8_LDA(At, 0, 1); G8_STAGE(G8_SB(0, 0), b2, voffB[0], voffB[1]); G8_STAGE(G8_SB(0, 1), b2 + hstepB, voffB[0], voffB[1]); G8_STAGE(G8_SA(0, 0), a2, x00, x01);
            G8_WAIT_V(8); G8_WAIT_L(0); G8_BAR; G8_MMA(1, 0, At, B0); G8_MMA(1, 1, At, B1); G8_BAR; G8_SCHED;
            G8_LDB(B0, 1, 0); G8_LDB(B1, 1, 1); G8_SCHED; G8_LDA(At, 1, 0); G8_STAGE(G8_SA(0, 1), a2, x10, x11);
            G8_WAIT_V(8); G8_WAIT_L(0); G8_BAR; G8_MMA(0, 0, At, B0); G8_MMA(0, 1, At, B1); G8_BAR; G8_SCHED;
            G8_LDA(At, 1, 1); G8_STAGE(G8_SB(1, 0), b3, voffB[0], voffB[1]); G8_STAGE(G8_SB(1, 1), b3 + hstepB, voffB[0], voffB[1]); G8_STAGE(G8_SA(1, 0), a3, x00, x01);
            G8_WAIT_V(8); G8_WAIT_L(0); G8_BAR; G8_MMA(1, 0, At, B0); G8_MMA(1, 1, At, B1); G8_BAR; G8_SCHED;
        }
        if constexpr (ALIGN_EPI) { if (wr == 0) G8_BAR; }
        E(acc, cur, wr, wc, fr, fq);
        if (!has_next) break;
#pragma unroll
        for (int a = 0; a < 2; ++a)
#pragma unroll
            for (int b = 0; b < 2; ++b)
#pragma unroll
                for (int m = 0; m < 4; ++m)
#pragma unroll
                    for (int n = 0; n < 2; ++n) acc[a][b][m][n] = (f32x4){0.f, 0.f, 0.f, 0.f};
        cur = nxt; cA = nA; cB = nB; ++ui;
        if (GATHER) {
#pragma unroll
            for (int i = 0; i < 2; ++i) { vA0[i] = nA0[i]; vA1[i] = nA1[i]; }
        }
        if constexpr (ALIGN_EPI) { if (wr == 1) G8_BAR; }
    }
    G8_WAIT_V(0);
    if constexpr (!ALIGN_EPI) { if (wr == 0) G8_BAR; }
    G8_BAR;
#undef G8_SA
#undef G8_SB
#undef G8_STAGE
#undef G8_LDA
#undef G8_LDB
#undef G8_MMA
#undef G8_WAIT_V
#undef G8_WAIT_L
#undef G8_BAR
#undef G8_SCHED
}

struct DenseOrder {
    const char* A; const char* Bt; int lda, K, nM, nN, nwg, G, c, skip_ctx;
    __device__ __forceinline__ void init(const bf16* A_, int lda_, const bf16* Bt_, int K_, int M, int N, int G_, int c_, int skip_ctx_) {
        A = (const char*)A_; Bt = (const char*)Bt_; lda = lda_; K = K_; skip_ctx = skip_ctx_; nM = M / BM; if (skip_ctx) nM = nM / 17 * 16; nN = N / BM; nwg = nM * nN; G = G_; c = c_; }
    __device__ __forceinline__ bool next(int i, Unit& u) const {
        const long L = (long)i * G + c; if (L >= nwg) return false;
        int wgid = (int)L; { const int q = nwg / NXCD, r = nwg % NXCD, xcd = wgid % NXCD, off = wgid / NXCD; wgid = (xcd < r ? xcd * (q + 1) : r * (q + 1) + (xcd - r) * q) + off; }
        const int nig = WGM * nN, gid = wgid / nig, fm = gid * WGM, gsz = (nM - fm) < WGM ? (nM - fm) : WGM;
        int pm = fm + ((wgid % nig) % gsz); const int pn = (wgid % nig) / gsz;
        if (skip_ctx) pm = (pm / 16) * 17 + 1 + (pm % 16);
        u.pm = pm; u.pn = pn; u.e = 0; u.aux = 0; u.cnt = 0;
        u.a = A + (size_t)pm * BM * lda * 2; u.b = Bt + (size_t)pn * BM * K * 2; return true;
    }
    __device__ __forceinline__ unsigned arow_off(const Unit&, int) const { return 0u; }
};
}
namespace g8 {
struct MoeOrder {
    const char* Abase; const char* Bbase; const int* rowtab; size_t bstride; int nN, K, G, vcu, gather;
    LAS int* tab;
    __device__ __forceinline__ void init(const unsigned* cnt, LAS int* tab_) {
        tab = tab_;
        __syncthreads();
        if (threadIdx.x < 64) {
            const int lane = threadIdx.x, me = lane & 31;
            const int c = (int)cnt[me];
            int run = 0, ab = 0, ms = 0, mab = 0;
            for (int e = 0; e < NE; ++e) { const int ce = __builtin_amdgcn_readlane(c, e), mt = (ce + 255) >> 8; if (me == e) { ms = run; mab = ab; } run += mt * nN; ab += mt << 8; }
            if (lane < 32) { tab[lane] = ms; tab[32 + lane] = c; tab[64 + lane] = mab; }
            if (lane == 0) tab[96] = run;
        }
        __syncthreads();
    }
    __device__ __forceinline__ bool next(int i, Unit& u) const {
        const int L = i * G + vcu;
        if (L >= tab[96]) return false;
        const int me = threadIdx.x & 31;
        const int st_l = tab[me], c_l = tab[32 + me];
        const unsigned long long m = __ballot(L >= st_l && L < st_l + ((c_l + 255) >> 8) * nN);
        const int e = __builtin_amdgcn_readfirstlane(__builtin_ctzll(m) & 31);
        const int st = tab[e], c = tab[32 + e], ab = tab[64 + e];
        const int l = L - st;
        const int sh = nN == 8 ? 3 : 2;
        u.e = e; u.pm = l >> sh; u.pn = l & (nN - 1); u.aux = ab; u.cnt = c;
        u.a = gather ? Abase : Abase + (size_t)(ab + u.pm * 256) * 1024 * 2; u.b = Bbase + (size_t)e * bstride + (size_t)u.pn * 256 * K * 2; return true;
    }
    __device__ __forceinline__ unsigned arow_off(const Unit& u, int r) const { int rr = u.pm * 256 + r; rr = rr < u.cnt ? rr : u.cnt - 1; return (unsigned)rowtab[(size_t)u.e * R + rr] * (unsigned)(D * 2); }
};
struct UpOrder {
    const char* Z; const char* Wq; const char* Wkv; int G, c;
    __device__ __forceinline__ bool next(int i, Unit& u) const {
        const int L = i * G + c; if (L >= 476) return false;
        const int kv = L >= 204, l = kv ? L - 204 : L, pn = l / 68, pm = l % 68;
        u.pm = pm; u.pn = kv ? 3 + pn : pn; u.e = 0; u.aux = kv; u.cnt = 0;
        u.a = Z + ((size_t)pm * BM * EVEN_IN_P + 1024 + kv * 384) * 2; u.b = Wq + (size_t)u.pn * BM * 384 * 2; return true;
    }
    __device__ __forceinline__ unsigned arow_off(const Unit&, int) const { return 0u; }
};
struct EpiStoreBf16 {
    static constexpr bool PERM = true; bf16* C; int ldc;
    __device__ __forceinline__ void operator()(const f32x4 (&acc)[2][2][4][2], const Unit& u, int wr, int wc, int fr, int fq) const {
        const int row0 = u.pm * BM + wr * 64 + fr, col0 = u.pn * BM + wc * 32 + 8 * fq;
#pragma unroll
        for (int ai = 0; ai < 2; ++ai)
#pragma unroll
            for (int m = 0; m < 4; ++m) { bf16* rowp = C + (size_t)(row0 + ai * HALF + m * 16) * ldc + col0;
#pragma unroll
                for (int bj = 0; bj < 2; ++bj) { const f32x4 v0 = acc[ai][bj][m][0], v1 = acc[ai][bj][m][1];
                    u32x4 w; w.x = cvt_pk_bf16(v0[0], v0[1]); w.y = cvt_pk_bf16(v0[2], v0[3]); w.z = cvt_pk_bf16(v1[0], v1[1]); w.w = cvt_pk_bf16(v1[2], v1[3]);
                    *(u32x4*)(rowp + bj * HALF) = w; } }
    }
};
struct EpiDiffIn {
    static constexpr bool PERM = true; bf16* C; const float* qn; const float* kn; const float* rc; const float* rs; LAS float* xch  ;
    __device__ __forceinline__ void operator()(const f32x4 (&acc)[2][2][4][2], const Unit& u, int wr, int wc, int fr, int fq) const {
        const int row0 = u.pm * BM + wr * 64 + fr, col0 = u.pn * BM + wc * 32 + 8 * fq, wid = wr * 4 + wc;
        const bool isv = u.pn >= 8;
        float rstd[2][4][2];
#pragma unroll
        for (int ai = 0; ai < 2; ++ai)
#pragma unroll
            for (int m = 0; m < 4; ++m)
#pragma unroll
                for (int bj = 0; bj < 2; ++bj) { const f32x4 v0 = acc[ai][bj][m][0], v1 = acc[ai][bj][m][1];
                    float ss = v0[0] * v0[0] + v0[1] * v0[1] + v0[2] * v0[2] + v0[3] * v0[3] + v1[0] * v1[0] + v1[1] * v1[1] + v1[2] * v1[2] + v1[3] * v1[3];
                    ss += lane_xor16(ss); ss += lane_xor32(ss);
                    rstd[ai][m][bj] = ss;
                    if (fq == 0) xch[wid * 256 + ((ai * 4 + m) * 2 + bj) * 16 + fr] = ss; }
        asm volatile("s_waitcnt lgkmcnt(0)" ::: "memory"); __builtin_amdgcn_s_barrier(); asm volatile("" ::: "memory");
#pragma unroll
        for (int ai = 0; ai < 2; ++ai)
#pragma unroll
            for (int m = 0; m < 4; ++m)
#pragma unroll
                for (int bj = 0; bj < 2; ++bj) rstd[ai][m][bj] = rsqrtf((rstd[ai][m][bj] + xch[(wid ^ 1) * 256 + ((ai * 4 + m) * 2 + bj) * 16 + fr]) * (1.f / 64.f) + EPS);
        const int e0 = (wc & 1) * 32 + 8 * fq;
        const float* gn = u.pn < 4 ? qn : kn; const float qs = u.pn < 4 ? 0.125f * LOG2E : 1.f;
        f32x4 g0 = *(const f32x4*)(gn + e0), g1 = *(const f32x4*)(gn + e0 + 4);
        g0 = g0 * qs; g1 = g1 * qs;
        const float sgn = (fq & 2) ? 1.f : -1.f;
        const int jt = u.pm % 17; const bool latent = jt != 0;
#pragma unroll
        for (int ai = 0; ai < 2; ++ai)
#pragma unroll
            for (int m = 0; m < 4; ++m) { const int r = row0 + ai * HALF + m * 16; bf16* rowp = C + (size_t)r * ODD_IN + col0;
                f32x4 c0 = {1.f, 1.f, 1.f, 1.f}, c1 = c0, s0 = {0.f, 0.f, 0.f, 0.f}, s1 = s0;
                if (!isv && latent) { const int t = (jt - 1) * 256 + ai * HALF + wr * 64 + m * 16 + fr;
                    c0 = *(const f32x4*)(rc + t * 64 + e0); c1 = *(const f32x4*)(rc + t * 64 + e0 + 4); s0 = *(const f32x4*)(rs + t * 64 + e0); s1 = *(const f32x4*)(rs + t * 64 + e0 + 4); }
#pragma unroll
                for (int bj = 0; bj < 2; ++bj) { f32x4 v0 = acc[ai][bj][m][0], v1 = acc[ai][bj][m][1];
                    if (!isv) { const float rr = rstd[ai][m][bj]; v0 = v0 * rr * g0; v1 = v1 * rr * g1;
                        f32x4 o0, o1;
#pragma unroll
                        for (int j = 0; j < 4; ++j) { o0[j] = lane_xor32(v0[j]); o1[j] = lane_xor32(v1[j]); }
                        v0 = v0 * c0 + o0 * s0 * sgn; v1 = v1 * c1 + o1 * s1 * sgn; }
                    u32x4 w; w.x = cvt_pk_bf16(v0[0], v0[1]); w.y = cvt_pk_bf16(v0[2], v0[3]); w.z = cvt_pk_bf16(v1[0], v1[1]); w.w = cvt_pk_bf16(v1[2], v1[3]);
                    *(u32x4*)(rowp + bj * HALF) = w; } }
        asm volatile("s_waitcnt lgkmcnt(0)" ::: "memory"); __builtin_amdgcn_s_barrier(); asm volatile("" ::: "memory");
    }
};
struct EpiOut {
    static constexpr bool PERM = true; Ptrs P; int layer;
    __device__ __forceinline__ void operator()(const f32x4 (&acc)[2][2][4][2], const Unit& u, int wr, int wc, int fr, int fq) const {
        const int b = u.pm / 17, jt = u.pm % 17;
        const float* g1 = (const float*)(P.ws + WS_MOD) + (size_t)(layer * 5 + (jt == 0 ? 4 : b)) * 6144 + 2 * D;
        const float* in0 = jt == 0 ? P.in[2] + (size_t)(b * CTX) * D : P.in[0] + (size_t)(b * SEQ + (jt - 1) * 256) * D;
        bf16* xb0 = (bf16*)(P.ws + WS_XB) + (size_t)u.pm * BM * D;
        const int col0 = u.pn * BM + wc * 32 + 8 * fq;
        f32x4 gv[2][2];
#pragma unroll
        for (int bj = 0; bj < 2; ++bj)
#pragma unroll
            for (int n = 0; n < 2; ++n) gv[bj][n] = *(const f32x4*)(g1 + col0 + bj * HALF + 4 * n);
#pragma unroll
        for (int ai = 0; ai < 2; ++ai)
#pragma unroll
            for (int m = 0; m < 4; ++m) { const size_t off = (size_t)(ai * HALF + wr * 64 + m * 16 + fr) * D + col0;
#pragma unroll
                for (int bj = 0; bj < 2; ++bj) {
                    f32x4 x0, x1;
                    if (layer == 0) { x0 = *(const f32x4*)(in0 + off + bj * HALF); x1 = *(const f32x4*)(in0 + off + bj * HALF + 4); }
                    else { const u32x4 r = *(const u32x4*)(xb0 + off + bj * HALF);
                        x0 = (f32x4){__uint_as_float(r.x << 16), __uint_as_float(r.x & 0xffff0000u), __uint_as_float(r.y << 16), __uint_as_float(r.y & 0xffff0000u)};
                        x1 = (f32x4){__uint_as_float(r.z << 16), __uint_as_float(r.z & 0xffff0000u), __uint_as_float(r.w << 16), __uint_as_float(r.w & 0xffff0000u)}; }
                    const f32x4 v0 = x0 + gv[bj][0] * acc[ai][bj][m][0], v1 = x1 + gv[bj][1] * acc[ai][bj][m][1];
                    u32x4 w; w.x = cvt_pk_bf16(v0[0], v0[1]); w.y = cvt_pk_bf16(v0[2], v0[3]); w.z = cvt_pk_bf16(v1[0], v1[1]); w.w = cvt_pk_bf16(v1[2], v1[3]);
                    *(u32x4*)(xb0 + off + bj * HALF) = w; } }
    }
};
struct EpiMoe1 {
    static constexpr bool PERM = true; Ptrs P; int layer;
    __device__ __forceinline__ void operator()(const f32x4 (&acc)[2][2][4][2], const Unit& u, int wr, int wc, int fr, int fq) const {
        typedef float f32x2 __attribute__((ext_vector_type(2)));
        const float* bgu = P.in[35] + (size_t)(layer * NE + u.e) * 2048;
        const int cl = u.pn * 128 + wc * 32 + 8 * fq;
        f32x4 bg[2], bu[2];
#pragma unroll
        for (int n = 0; n < 2; ++n) { bg[n] = *(const f32x4*)(bgu + cl + 4 * n); bu[n] = *(const f32x4*)(bgu + 1024 + cl + 4 * n) + 1.f; }
        bf16* act = (bf16*)(P.ws + WS_ACT) + (size_t)(u.aux + u.pm * 256 + wr * 64 + fr) * 1024 + cl;
        const f32x2 kk = {-1.702f * LOG2E, -1.702f * LOG2E}, one2 = {1.f, 1.f};
#pragma unroll
        for (int ai = 0; ai < 2; ++ai)
#pragma unroll
            for (int m = 0; m < 4; ++m) { unsigned wv[4];
#pragma unroll
                for (int n = 0; n < 2; ++n)
#pragma unroll
                    for (int jp = 0; jp < 2; ++jp) {
                        f32x2 g = (f32x2){acc[ai][0][m][n][2 * jp], acc[ai][0][m][n][2 * jp + 1]} + (f32x2){bg[n][2 * jp], bg[n][2 * jp + 1]};
                        f32x2 uu = (f32x2){acc[ai][1][m][n][2 * jp], acc[ai][1][m][n][2 * jp + 1]} + (f32x2){bu[n][2 * jp], bu[n][2 * jp + 1]};
                        g.x = fminf(g.x, 7.f); g.y = fminf(g.y, 7.f);
                        uu.x = __builtin_amdgcn_fmed3f(uu.x, -6.f, 8.f); uu.y = __builtin_amdgcn_fmed3f(uu.y, -6.f, 8.f);
                        f32x2 t = g * kk;
                        t.x = __builtin_amdgcn_exp2f(t.x); t.y = __builtin_amdgcn_exp2f(t.y);
                        t = t + one2;
                        t.x = __builtin_amdgcn_rcpf(t.x); t.y = __builtin_amdgcn_rcpf(t.y);
                        const f32x2 o = uu * (g * t);
                        wv[n * 2 + jp] = cvt_pk_bf16(o.x, o.y); }
                u32x4 w; w.x = wv[0]; w.y = wv[1]; w.z = wv[2]; w.w = wv[3];
                *(u32x4*)(act + (size_t)(ai * HALF + m * 16) * 1024) = w; }
    }
};
struct EpiMoe2 {
    static constexpr bool PERM = true; Ptrs P; int layer;
    __device__ __forceinline__ void operator()(const f32x4 (&acc)[2][2][4][2], const Unit& u, int wr, int wc, int fr, int fq) const {
        const float* bd = P.in[37] + (size_t)(layer * NE + u.e) * 1024;
        const int col0 = u.pn * BM + wc * 32 + 8 * fq;
        f32x4 bv[2][2];
#pragma unroll
        for (int bj = 0; bj < 2; ++bj)
#pragma unroll
            for (int n = 0; n < 2; ++n) bv[bj][n] = *(const f32x4*)(bd + col0 + bj * HALF + 4 * n);
        const int* pair_of = (const int*)(P.ws + WS_PAIROF) + (size_t)u.e * R; const float* gate_of = (const float*)(P.ws + WS_GATEOF) + (size_t)u.e * R;
        bf16* Y = (bf16*)(P.ws + WS_Y);
        int pr[2][4]; float gwv[2][4];
#pragma unroll
        for (int ai = 0; ai < 2; ++ai)
#pragma unroll
            for (int m = 0; m < 4; ++m) { const int r = u.pm * 256 + ai * HALF + wr * 64 + m * 16 + fr, rc = r < u.cnt ? r : u.cnt - 1; pr[ai][m] = pair_of[rc]; gwv[ai][m] = gate_of[rc]; }
#pragma unroll
        for (int ai = 0; ai < 2; ++ai)
#pragma unroll
            for (int m = 0; m < 4; ++m) { const int r = u.pm * 256 + ai * HALF + wr * 64 + m * 16 + fr;
                if (r < u.cnt) { const float gw = gwv[ai][m]; bf16* rowp = Y + (size_t)pr[ai][m] * 1024 + col0;
#pragma unroll
                    for (int bj = 0; bj < 2; ++bj) { const f32x4 v0 = (acc[ai][bj][m][0] + bv[bj][0]) * gw, v1 = (acc[ai][bj][m][1] + bv[bj][1]) * gw;
                        u32x4 w; w.x = cvt_pk_bf16(v0[0], v0[1]); w.y = cvt_pk_bf16(v0[2], v0[3]); w.z = cvt_pk_bf16(v1[0], v1[1]); w.w = cvt_pk_bf16(v1[2], v1[3]);
                        *(u32x4*)(rowp + bj * HALF) = w; } } }
    }
};
}

__device__ __forceinline__ int bwd_pos(int c) { return c < 2 ? 1 - c : 2 + (NCH - 1 - c); }
__device__ __forceinline__ int bwd_chunk_at(int p) { return p < 2 ? 1 - p : NCH - 1 - (p - 2); }
__device__ __forceinline__ float fsigmoid(float x) { return __builtin_amdgcn_rcpf(1.f + __builtin_amdgcn_exp2f(-LOG2E * x)); }
__device__ __forceinline__ void ph_lru(const Ptrs& P, unsigned char* lds, int mode, int item0) {
    typedef short bf16x8 __attribute__((ext_vector_type(8)));
    float* X = (float*)lds;
    unsigned char* XB = lds + 128 * 68 * 4;
    float* SEG = (float*)(lds + 128 * 68 * 4 + 16384);
    float* CAR = SEG + 2 * 8 * 64 * 2;
    unsigned char* WL = (unsigned char*)(CAR + 128);
    float* CWL = (float*)(WL + 32768);
    float* GBL = CWL + 320;
    const int tid = threadIdx.x, wid = tid >> 6, lane = tid & 63, fr = lane & 15, fq = lane >> 4;
    const int G = gridDim.x, total = 8 * NCH * NB;
    const bf16* Z = (const bf16*)(P.ws + WS_Z);
    float* agg = (float*)(P.ws + WS_AGG);
    const int first = ((int)blockIdx.x - item0 % G + G) % G;
    int n_cur = -1;
    u32x4 raw[2][4], gz[2];
#define LRU_LOADS(it_) do { const int n_ = (it_) % 8, c_ = ((it_) / 8) % NCH, b_ = (it_) / (8 * NCH); const int j0_ = c_ * CHUNK, lo_ = (c_ < 2) ? 0 : CTX, hi_ = (c_ < 2) ? CTX : SU; \
        _Pragma("unroll") for (int q = 0; q < 2; ++q) { const int p = tid + q * NT, t = p >> 3, cg = n_ * 64 + (p & 7) * 8; \
            _Pragma("unroll") for (int k = 0; k < 4; ++k) { const int j = j0_ + t - 2 + k; const int jj = (j >= lo_ && j < hi_) ? j : j0_ + t; raw[q][k] = *(const u32x4*)(Z + (size_t)(b_ * SU + jj) * EVEN_IN_P + 512 + cg); } \
            if (mode == 1) gz[q] = *(const u32x4*)(Z + (size_t)(b_ * SU + j0_ + t) * EVEN_IN_P + cg); } } while (0)
    if (first < total) LRU_LOADS(first);
    for (int it = first; it < total; it += G) {
        const int n = it % 8, c = (it / 8) % NCH, b = it / (8 * NCH);
        const int j0 = c * CHUNK, seg_lo = (c < 2) ? 0 : CTX, seg_hi = (c < 2) ? CTX : SU;
        __syncthreads();
        if (n != n_cur) {
            n_cur = n; int tq = tid; asm volatile("" : "+v"(tq));
#pragma unroll
            for (int i = 0; i < 4; ++i) { const int idx = tq + i * NT, mm = idx >> 9, r = (idx & 511) >> 3, ch = idx & 7;
                *(u32x4*)(WL + mm * 8192 + r * 128 + ((ch ^ ((r >> 1) & 7)) << 4)) = *(const u32x4*)((const bf16*)(P.ws + WS_WLRU) + ((size_t)mm * 8 + n) * 4096 + r * 64 + ch * 8); }
            if (tq < 256) CWL[tq] = P.in[10][(tq >> 6) * LRU_W + n * 64 + (tq & 63)]; else if (tq < 320) CWL[tq] = P.in[11][n * 64 + (tq - 256)];
            if (tq < 384) { const int a = tq >> 7, dl = tq & 127, cgl = (dl >> 6) * LRU_W + n * 64 + (dl & 63);
                GBL[tq] = a == 0 ? P.in[13][cgl] : a == 1 ? P.in[15][cgl] : ((const float*)(P.ws + WS_SCAL))[1024 + cgl]; }
            __syncthreads();
        }
        u32x4 gzc[2];
#pragma unroll
        for (int q = 0; q < 2; ++q) {
            const int p = tid + q * NT, t = p >> 3, c8 = (p & 7) * 8;
            float acc[8];
            { const f32x4 b0 = *(const f32x4*)(CWL + 256 + c8), b1 = *(const f32x4*)(CWL + 256 + c8 + 4);
#pragma unroll
              for (int e = 0; e < 4; ++e) { acc[e] = b0[e]; acc[4 + e] = b1[e]; } }
#pragma unroll
            for (int k = 0; k < 4; ++k) {
                const int j = j0 + t - 2 + k; const bool ok = j >= seg_lo && j < seg_hi;
                const u32x4 rw = raw[q][k];
                const f32x4 w0 = *(const f32x4*)(CWL + k * 64 + c8), w1 = *(const f32x4*)(CWL + k * 64 + c8 + 4);
                const float m = ok ? 1.f : 0.f;
#pragma unroll
                for (int e = 0; e < 4; ++e) { const float lo = __uint_as_float(rw[e] << 16), hi = __uint_as_float(rw[e] & 0xffff0000u);
                    const float wl = (e < 2 ? w0[2 * e] : w1[2 * e - 4]) * m, wh = (e < 2 ? w0[2 * e + 1] : w1[2 * e - 3]) * m;
                    acc[2 * e] += wl * lo; acc[2 * e + 1] += wh * hi; }
            }
            *(f32x4*)(X + t * 68 + c8) = (f32x4){acc[0], acc[1], acc[2], acc[3]}; *(f32x4*)(X + t * 68 + c8 + 4) = (f32x4){acc[4], acc[5], acc[6], acc[7]};
            u32x4 w; w.x = g8::cvt_pk_bf16(acc[0], acc[1]); w.y = g8::cvt_pk_bf16(acc[2], acc[3]); w.z = g8::cvt_pk_bf16(acc[4], acc[5]); w.w = g8::cvt_pk_bf16(acc[6], acc[7]);
            *(u32x4*)(XB + t * 128 + (((c8 >> 3) ^ ((t >> 1) & 7)) << 4)) = w;
            gzc[q] = gz[q];
        }
        if (it + G < total) LRU_LOADS(it + G);
        if (mode == 1 && wid < 2) {
            const int dir = wid, pos = dir == 0 ? c : bwd_pos(c); float h = 0.f;
            for (int p0 = 0; p0 < pos; p0 += 8) {
                float2 ag[8];
#pragma unroll
                for (int i = 0; i < 8; ++i) { const int p = p0 + i, pc = p < pos ? p : p0, cc = dir == 0 ? pc : bwd_chunk_at(pc);
                    ag[i] = *(const float2*)(agg + ((((size_t)b * NCH + cc) * 2 + dir) * 512 + n * 64 + lane) * 2); if (p >= pos) { ag[i].x = 1.f; ag[i].y = 0.f; } }
#pragma unroll
                for (int i = 0; i < 8; ++i) h = ag[i].x * h + ag[i].y;
            }
            CAR[dir * 64 + lane] = h;
        }
        __syncthreads();
        const int trow = 16 * wid + fr;
        const bf16x8 af0 = *(const bf16x8*)(XB + trow * 128 + ((fq ^ ((trow >> 1) & 7)) << 4));
        const bf16x8 af1 = *(const bf16x8*)(XB + trow * 128 + (((4 + fq) ^ ((trow >> 1) & 7)) << 4));
        float av[2][4][4], uv[2][4][4], Ae[2][4], He[2][4];
#pragma unroll
        for (int dir = 0; dir < 2; ++dir) {
            const unsigned char* wa = WL + (dir * 2 + 0) * 8192; const unsigned char* wx = WL + (dir * 2 + 1) * 8192;
#pragma unroll
            for (int ct = 0; ct < 4; ++ct) {
                const int e = 16 * ct + fr, ky = (e >> 1) & 7;
                const bf16x8 wa0 = *(const bf16x8*)(wa + e * 128 + ((fq ^ ky) << 4)), wa1 = *(const bf16x8*)(wa + e * 128 + (((4 + fq) ^ ky) << 4));
                const bf16x8 wx0 = *(const bf16x8*)(wx + e * 128 + ((fq ^ ky) << 4)), wx1 = *(const bf16x8*)(wx + e * 128 + (((4 + fq) ^ ky) << 4));
                f32x4 ga = {0.f, 0.f, 0.f, 0.f}, gx = {0.f, 0.f, 0.f, 0.f};
                ga = __builtin_amdgcn_mfma_f32_16x16x32_bf16(af0, wa0, ga, 0, 0, 0); ga = __builtin_amdgcn_mfma_f32_16x16x32_bf16(af1, wa1, ga, 0, 0, 0);
                gx = __builtin_amdgcn_mfma_f32_16x16x32_bf16(af0, wx0, gx, 0, 0, 0); gx = __builtin_amdgcn_mfma_f32_16x16x32_bf16(af1, wx1, gx, 0, 0, 0);
                const float bav = GBL[dir * 64 + e], bxv = GBL[128 + dir * 64 + e], c8 = GBL[256 + dir * 64 + e];
#pragma unroll
                for (int j = 0; j < 4; ++j) {
                    const float r = fsigmoid(ga[j] + bav), ig = fsigmoid(gx[j] + bxv);
                    const float a = __builtin_amdgcn_exp2f(-c8 * r);
                    av[dir][ct][j] = a; uv[dir][ct][j] = sqrtf(fmaxf(1.f - a * a, 0.f)) * ig * X[(16 * wid + 4 * fq + j) * 68 + e];
                }
                float Al = av[dir][ct][0] * av[dir][ct][1] * av[dir][ct][2] * av[dir][ct][3], Hl;
                if (dir == 0) Hl = ((uv[dir][ct][0] * av[dir][ct][1] + uv[dir][ct][1]) * av[dir][ct][2] + uv[dir][ct][2]) * av[dir][ct][3] + uv[dir][ct][3];
                else Hl = ((uv[dir][ct][3] * av[dir][ct][2] + uv[dir][ct][2]) * av[dir][ct][1] + uv[dir][ct][1]) * av[dir][ct][0] + uv[dir][ct][0];
                const int pq = dir == 0 ? fq : 3 - fq;
                {
                    const float Ap = lane_shift16(Al, dir == 0), Hp = lane_shift16(Hl, dir == 0);
                    if (pq >= 1) { Hl = Al * Hp + Hl; Al = Al * Ap; }
                }
                {
                    const float Ap = lane_xor32(Al), Hp = lane_xor32(Hl);
                    if (pq >= 2) { Hl = Al * Hp + Hl; Al = Al * Ap; }
                }
                {
                    const float Ap = lane_shift16(Al, dir == 0), Hp = lane_shift16(Hl, dir == 0);
                    Ae[dir][ct] = pq >= 1 ? Ap : 1.f; He[dir][ct] = pq >= 1 ? Hp : 0.f;
                }
                if (pq == 3) { float2 sv; sv.x = Al; sv.y = Hl; *(float2*)(SEG + ((dir * 8 + wid) * 64 + e) * 2) = sv; }
            }
        }
        __syncthreads();
        float hs[4][4];
#pragma unroll
        for (int ct = 0; ct < 4; ++ct)
#pragma unroll
            for (int j = 0; j < 4; ++j) hs[ct][j] = 0.f;
#pragma unroll
        for (int dir = 0; dir < 2; ++dir) {
#pragma unroll
            for (int ct = 0; ct < 4; ++ct) {
                const int e = 16 * ct + fr;
                if (mode == 0) {
                    if (wid == 0 && fq == 0) {
                        float Ac = 1.f, Hc = 0.f;
                        for (int sI = 0; sI < 8; ++sI) { const int sg = dir == 0 ? sI : 7 - sI; const float2 sv = *(const float2*)(SEG + ((dir * 8 + sg) * 64 + e) * 2); Hc = sv.x * Hc + sv.y; Ac *= sv.x; }
                        float2 o; o.x = Ac; o.y = Hc; *(float2*)(agg + ((((size_t)b * NCH + c) * 2 + dir) * 512 + n * 64 + e) * 2) = o;
                    }
                } else {
                    float h = CAR[dir * 64 + e];
                    const int nprev = dir == 0 ? wid : 7 - wid;
                    for (int sI = 0; sI < nprev; ++sI) { const int sg = dir == 0 ? sI : 7 - sI; const float2 sv = *(const float2*)(SEG + ((dir * 8 + sg) * 64 + e) * 2); h = sv.x * h + sv.y; }
                    h = Ae[dir][ct] * h + He[dir][ct];
                    if (dir == 0) {
#pragma unroll
                        for (int j = 0; j < 4; ++j) { h = av[dir][ct][j] * h + uv[dir][ct][j]; hs[ct][j] += h; }
                    } else {
#pragma unroll
                        for (int j = 3; j >= 0; --j) { h = av[dir][ct][j] * h + uv[dir][ct][j]; hs[ct][j] += h; }
                    }
                }
            }
        }
        if (mode == 1) {
#pragma unroll
            for (int ct = 0; ct < 4; ++ct)
#pragma unroll
                for (int j = 0; j < 4; ++j) X[(16 * wid + 4 * fq + j) * 68 + 16 * ct + fr] = hs[ct][j];
            __syncthreads();
            bf16* mix = (bf16*)(P.ws + WS_MIX);
#pragma unroll
            for (int q = 0; q < 2; ++q) {
                const int p = tid + q * NT, t = p >> 3, c8 = (p & 7) * 8; const size_t u = (size_t)b * SU + j0 + t;
                const u32x4 gzv = gzc[q];
                const f32x4 r0 = *(const f32x4*)(X + t * 68 + c8), r1 = *(const f32x4*)(X + t * 68 + c8 + 4);
                float o[8];
#pragma unroll
                for (int k = 0; k < 4; ++k) { const float g0 = __uint_as_float(gzv[k] << 16), g1 = __uint_as_float(gzv[k] & 0xffff0000u);
                    const float s0 = fsigmoid(1.5957691216057308f * (g0 + 0.044715f * g0 * g0 * g0)), s1 = fsigmoid(1.5957691216057308f * (g1 + 0.044715f * g1 * g1 * g1));
                    o[2 * k] = g0 * s0 * (k < 2 ? r0[2 * k] : r1[2 * k - 4]); o[2 * k + 1] = g1 * s1 * (k < 2 ? r0[2 * k + 1] : r1[2 * k - 3]); }
                u32x4 w; w.x = g8::cvt_pk_bf16(o[0], o[1]); w.y = g8::cvt_pk_bf16(o[2], o[3]); w.z = g8::cvt_pk_bf16(o[4], o[5]); w.w = g8::cvt_pk_bf16(o[6], o[7]);
                *(u32x4*)(mix + u * D + n * 64 + c8) = w;
            }
        }
    }
#undef LRU_LOADS
    __syncthreads();
}

__device__ __forceinline__ void unpack8(const u32x4 v, float (&f)[8]) {
#pragma unroll
    for (int i = 0; i < 4; ++i) { f[2 * i] = __uint_as_float(v[i] << 16); f[2 * i + 1] = __uint_as_float(v[i] & 0xffff0000u); }
}
__device__ __forceinline__ u32x4 pack8(const float (&f)[8]) {
    u32x4 w; w.x = g8::cvt_pk_bf16(f[0], f[1]); w.y = g8::cvt_pk_bf16(f[2], f[3]); w.z = g8::cvt_pk_bf16(f[4], f[5]); w.w = g8::cvt_pk_bf16(f[6], f[7]); return w;
}
struct MlaRow { u32x4 zq, zk, zr, q0, q1, kv0, kw0, kv1, kw1; f32x4 c0, c1, s0, s1; };
__device__ __forceinline__ MlaRow mla_row_load(const Ptrs& P, int u, int lane) {
    const int hl = lane & 31, hh = lane >> 5; const bool act = hl < 24, tail = hl >= 16 && hl < 24;
    const int j = u % SU; const bool latent = j >= CTX; const int t = latent ? j - CTX : 0;
    const bf16* z = (const bf16*)(P.ws + WS_Z) + (size_t)u * EVEN_IN_P;
    const bf16* qp = (const bf16*)(P.ws + WS_QP) + (size_t)u * 1792; const bf16* kvp = qp + 768;
    const float* rc = (const float*)(P.ws + WS_ROPE); const float* rs = rc + SEQ * 64;
    const u32x4 z4 = {0u, 0u, 0u, 0u}; const f32x4 one4 = {1.f, 1.f, 1.f, 1.f}, zero4 = {0.f, 0.f, 0.f, 0.f};
    MlaRow r;
    r.zq = lane < 48 ? *(const u32x4*)(z + 1024 + lane * 8) : z4;
    r.zk = lane < 32 ? *(const u32x4*)(z + 1408 + lane * 8) : z4;
    r.zr = tail ? *(const u32x4*)(z + 1664 + (hl - 16) * 8) : z4;
    r.q0 = act ? *(const u32x4*)(qp + hh * 192 + hl * 8) : z4;
    r.q1 = act ? *(const u32x4*)(qp + (2 + hh) * 192 + hl * 8) : z4;
    r.kv0 = hl < 16 ? *(const u32x4*)(kvp + hh * 256 + hl * 8) : z4;
    r.kw0 = hl < 16 ? *(const u32x4*)(kvp + hh * 256 + 128 + hl * 8) : z4;
    r.kv1 = hl < 16 ? *(const u32x4*)(kvp + (2 + hh) * 256 + hl * 8) : z4;
    r.kw1 = hl < 16 ? *(const u32x4*)(kvp + (2 + hh) * 256 + 128 + hl * 8) : z4;
    const bool rp = latent && tail; const int ro = t * 64 + (hl - 16) * 8;
    r.c0 = rp ? *(const f32x4*)(rc + ro) : one4; r.c1 = rp ? *(const f32x4*)(rc + ro + 4) : one4;
    r.s0 = rp ? *(const f32x4*)(rs + ro) : zero4; r.s1 = rp ? *(const f32x4*)(rs + ro + 4) : zero4;
    return r;
}
__device__ __forceinline__ void ph_mla_prep(const Ptrs& P) {
    const int wave = threadIdx.x >> 6, lane = threadIdx.x & 63, G = gridDim.x;
    const int hl = lane & 31, hh = lane >> 5;
    const bool act = hl < 24, tail = hl >= 16 && hl < 24;
    const float* qn = P.in[21]; const float* kn = P.in[22];
    float gq[8], gk[8];
#pragma unroll
    for (int i = 0; i < 8; ++i) { gq[i] = act ? qn[hl * 8 + i] : 0.f; gk[i] = act ? kn[hl * 8 + i] : 0.f; }
    const float c2 = 0.07216878364870322f * LOG2E;
    const float sgn = ((hl >> 1) & 1) ? 1.f : -1.f;
    int u = (int)blockIdx.x * 8 + wave;
    if (u >= R) return;
    MlaRow cur = mla_row_load(P, u, lane);
    for (; u < R; u += G * 8) {
        const int un = u + G * 8;
        MlaRow nxt = cur;
        if (un < R) nxt = mla_row_load(P, un, lane);
        float f[8]; float sq = 0.f, sk = 0.f;
        unpack8(cur.zq, f);
#pragma unroll
        for (int i = 0; i < 8; ++i) sq += f[i] * f[i];
        unpack8(cur.zk, f);
#pragma unroll
        for (int i = 0; i < 8; ++i) sk += f[i] * f[i];
        const float rq = rsqrtf(wave_sum(sq) * (1.f / 384.f) + EPS), rk = rsqrtf(wave_sum(sk) * (1.f / 256.f) + EPS);
        float cs[8], sn[8];
#pragma unroll
        for (int i = 0; i < 4; ++i) { cs[i] = cur.c0[i]; cs[4 + i] = cur.c1[i]; sn[i] = cur.s0[i]; sn[4 + i] = cur.s1[i]; }
        bf16* qm = (bf16*)(P.ws + WS_QM) + (size_t)u * 768; bf16* km = (bf16*)(P.ws + WS_KM) + (size_t)u * 768; bf16* vm = (bf16*)(P.ws + WS_VM) + (size_t)u * 512;
#pragma unroll
        for (int pass = 0; pass < 2; ++pass) {
            const int h = pass * 2 + hh;
            {
                float v[8]; float ss = 0.f;
                unpack8(pass ? cur.q1 : cur.q0, v);
#pragma unroll
                for (int i = 0; i < 8; ++i) { v[i] *= rq; ss += v[i] * v[i]; }
                ss = sum32(ss);
                const float r = rsqrtf(ss * (1.f / 192.f) + EPS);
#pragma unroll
                for (int i = 0; i < 8; ++i) { v[i] *= r * gq[i]; const float other = dpp_f<DPP_X2>(v[i]); v[i] = (v[i] * cs[i] + sgn * other * sn[i]) * c2; }
                if (act) *(u32x4*)(qm + h * 192 + hl * 8) = pack8(v);
            }
            {
                float v[8], w[8]; float ss = 0.f;
                if (hl < 16) { unpack8(pass ? cur.kv1 : cur.kv0, v); unpack8(pass ? cur.kw1 : cur.kw0, w);
#pragma unroll
                    for (int i = 0; i < 8; ++i) { v[i] *= rk; w[i] *= rk; } }
                else { unpack8(cur.zr, v);
#pragma unroll
                    for (int i = 0; i < 8; ++i) w[i] = 0.f; }
#pragma unroll
                for (int i = 0; i < 8; ++i) ss += v[i] * v[i];
                ss = sum32(ss);
                const float r = rsqrtf(ss * (1.f / 192.f) + EPS);
#pragma unroll
                for (int i = 0; i < 8; ++i) { v[i] *= r * gk[i]; const float other = dpp_f<DPP_X2>(v[i]); v[i] = v[i] * cs[i] + sgn * other * sn[i]; }
                if (act) *(u32x4*)(km + h * 192 + hl * 8) = pack8(v);
                if (hl < 16) *(u32x4*)(vm + h * 128 + hl * 8) = pack8(w);
            }
        }
        cur = nxt;
    }
}
#ifndef PROBE_SUB
#define PROBE_SUB 0
#define PROBE_SUBDK 0
#endif
#ifndef PROBE_SUBBLK
#define PROBE_SUBBLK 0
#endif
#define PSUB_T0() unsigned ps_t0_ = 0u; if (PROBE_SUB && DK == PROBE_SUBDK) ps_t0_ = __builtin_amdgcn_readfirstlane((unsigned)__builtin_readcyclecounter())
#define PSUB_AT(k) do { if (PROBE_SUB == (k) && DK == PROBE_SUBDK) sacc = __builtin_amdgcn_readfirstlane(sacc + ((unsigned)__builtin_readcyclecounter() - ps_t0_)); } while (0)
namespace att {
using bf16x8 = __attribute__((ext_vector_type(8))) short;
using s16x4  = __attribute__((ext_vector_type(4))) short;
using f32x16 = __attribute__((ext_vector_type(16))) float;
#define SBAR() __builtin_amdgcn_sched_barrier(0)
__device__ __forceinline__ int crow(int r, int hi) { return (r & 3) + 8 * (r >> 2) + 4 * hi; }
__device__ __forceinline__ unsigned cvtpk(float lo, float hi) { unsigned r; asm volatile("v_cvt_pk_bf16_f32 %0, %1, %2" : "=v"(r) : "v"(lo), "v"(hi)); return r; }
template <int DK> __device__ __forceinline__ int kswz(int row, int chunk) { return row * (DK * 2) + ((chunk ^ ((row >> 1) & 7)) << 4); }
__device__ __forceinline__ int v_st(int k, int c) { const int kk = (k & ~0xC) | ((k & 4) << 1) | ((k & 8) >> 1); return ((kk >> 3) * 4 + (c >> 5)) * 512 + ((kk & 7) * 32 + (c & 31)) * 2; }
__device__ __forceinline__ int v_rd_base(int lane) { return ((lane & 3) << 3) | (((lane >> 2) & 3) << 6) | (((lane >> 4) & 1) << 5) | (((lane >> 5) & 1) << 8); }
constexpr int v_rd_off(int d0, int ks, int half) { return d0 * 512 + ks * 4096 + half * 2048; }
template <int OFF> __device__ __forceinline__ s16x4 tr_read(int vb) { s16x4 r; asm volatile("ds_read_b64_tr_b16 %0, %1 offset:%2" : "=&v"(r) : "v"(vb), "i"(OFF) : "memory"); return r; }
template <int D0> __device__ __forceinline__ void pv_one(f32x16& od, int vb, bf16x8 pa0, bf16x8 pa1, bf16x8 pa2, bf16x8 pa3) {
    const s16x4 l0 = tr_read<v_rd_off(D0, 0, 0)>(vb), h0 = tr_read<v_rd_off(D0, 0, 1)>(vb), l1 = tr_read<v_rd_off(D0, 1, 0)>(vb), h1 = tr_read<v_rd_off(D0, 1, 1)>(vb);
    const s16x4 l2 = tr_read<v_rd_off(D0, 2, 0)>(vb), h2 = tr_read<v_rd_off(D0, 2, 1)>(vb), l3 = tr_read<v_rd_off(D0, 3, 0)>(vb), h3 = tr_read<v_rd_off(D0, 3, 1)>(vb);
    asm volatile("s_waitcnt lgkmcnt(0)" ::: "memory"); SBAR();
#define PK(L, H) (bf16x8){L[0], L[1], L[2], L[3], H[0], H[1], H[2], H[3]}
    od = __builtin_amdgcn_mfma_f32_32x32x16_bf16(pa0, PK(l0, h0), od, 0, 0, 0);
    od = __builtin_amdgcn_mfma_f32_32x32x16_bf16(pa1, PK(l1, h1), od, 0, 0, 0);
    od = __builtin_amdgcn_mfma_f32_32x32x16_bf16(pa2, PK(l2, h2), od, 0, 0, 0);
    od = __builtin_amdgcn_mfma_f32_32x32x16_bf16(pa3, PK(l3, h3), od, 0, 0, 0);
#undef PK
}
typedef short v4i16_t __attribute__((ext_vector_type(4)));
template <int OFF> __device__ __forceinline__ s16x4 tr_read_b(int vb) {
    return __builtin_bit_cast(s16x4, __builtin_amdgcn_ds_read_tr16_b64_v4i16((__attribute__((address_space(3))) v4i16_t*)(uintptr_t)(unsigned)(vb + OFF)));
}
template <int D0> __device__ __forceinline__ void pv_one_b(f32x16& od, int vb, bf16x8 pa0, bf16x8 pa1, bf16x8 pa2, bf16x8 pa3) {
    const s16x4 l0 = tr_read_b<v_rd_off(D0, 0, 0)>(vb), h0 = tr_read_b<v_rd_off(D0, 0, 1)>(vb), l1 = tr_read_b<v_rd_off(D0, 1, 0)>(vb), h1 = tr_read_b<v_rd_off(D0, 1, 1)>(vb);
    const s16x4 l2 = tr_read_b<v_rd_off(D0, 2, 0)>(vb), h2 = tr_read_b<v_rd_off(D0, 2, 1)>(vb), l3 = tr_read_b<v_rd_off(D0, 3, 0)>(vb), h3 = tr_read_b<v_rd_off(D0, 3, 1)>(vb);
#define PK(L, H) (bf16x8){L[0], L[1], L[2], L[3], H[0], H[1], H[2], H[3]}
    od = __builtin_amdgcn_mfma_f32_32x32x16_bf16(pa0, PK(l0, h0), od, 0, 0, 0);
    od = __builtin_amdgcn_mfma_f32_32x32x16_bf16(pa1, PK(l1, h1), od, 0, 0, 0);
    od = __builtin_amdgcn_mfma_f32_32x32x16_bf16(pa2, PK(l2, h2), od, 0, 0, 0);
    od = __builtin_amdgcn_mfma_f32_32x32x16_bf16(pa3, PK(l3, h3), od, 0, 0, 0);
#undef PK
}
constexpr int SHM_V = 64 * 128 * 2;
template <int DK, bool PF, bool EARLY, bool PFD = false>
__device__ __forceinline__ void attn_loop(const bf16* __restrict__ Qrow  , const bf16* __restrict__ Kh, int ldk, const bf16* __restrict__ Vh, int ldv,
                                          int nkeys, float negM, f32x16 (&o)[4], float& l_reg, char* lds_kv, unsigned& sacc) {
    constexpr int NQ = DK / 16, CH = DK / 8, KP = (64 * CH) / NT, SHM_K = 64 * DK * 2;
    const int tid = threadIdx.x, lane = tid & 63, r32 = lane & 31, hi = lane >> 5;
    char* V_lds = lds_kv; char* K_lds = lds_kv + 2 * SHM_V;
    bf16x8 qr[NQ];
#pragma unroll
    for (int d0 = 0; d0 < NQ; ++d0) qr[d0] = *reinterpret_cast<const bf16x8*>(Qrow + d0 * 16);
    const __amdgpu_buffer_rsrc_t krs = __builtin_amdgcn_make_buffer_rsrc((void*)Kh, 0, nkeys * ldk * 2, 0x00020000);
    const __amdgpu_buffer_rsrc_t vrs = __builtin_amdgcn_make_buffer_rsrc((void*)Vh, 0, nkeys * ldv * 2, 0x00020000);
    unsigned kgo[KP]; int kst[KP];
#pragma unroll
    for (int i = 0; i < KP; ++i) { const int p = tid + i * NT, row = p / CH, ch = p % CH; kgo[i] = (unsigned)(row * ldk + ch * 8) * 2u; kst[i] = kswz<DK>(row, ch); }
    const int vrow0 = tid >> 4, vc = (tid & 15) * 8;
    const unsigned vgo = (unsigned)(vrow0 * ldv + vc) * 2u, vstep = (unsigned)(32 * ldv) * 2u;
    const int vst0 = v_st(vrow0, vc); constexpr int vst1d = 8192;
    const int vb0 = (int)(uintptr_t)V_lds + v_rd_base(lane);
    const int kbase = r32 * (DK * 2), kt0 = (hi ^ ((r32 >> 1) & 7)) << 4;
#define kra_(q) (kbase + (kt0 ^ ((q) << 5)))
    u32x4 ks[KP], vs0, vs1;
#define SLOAD(k0) do { const unsigned so_k = (unsigned)((k0) * ldk) * 2u, so_v = (unsigned)((k0) * ldv) * 2u; \
        _Pragma("unroll") for (int i = 0; i < KP; ++i) ks[i] = __builtin_amdgcn_raw_buffer_load_b128(krs, kgo[i], so_k, 0); \
        vs0 = __builtin_amdgcn_raw_buffer_load_b128(vrs, vgo, so_v, 0); vs1 = __builtin_amdgcn_raw_buffer_load_b128(vrs, vgo + vstep, so_v, 0); } while (0)
#define SWRITE(b) do { _Pragma("unroll") for (int i = 0; i < KP; ++i) *reinterpret_cast<u32x4*>(K_lds + (b) * SHM_K + kst[i]) = ks[i]; \
        *reinterpret_cast<u32x4*>(V_lds + (b) * SHM_V + vst0) = vs0; *reinterpret_cast<u32x4*>(V_lds + (b) * SHM_V + vst0 + vst1d) = vs1; } while (0)
    constexpr int KLINES = (64 * DK * 2) / 128, VLINES = 128, LPR = DK / 64;
    unsigned pf_dummy = 0u;
#define PREFETCH(t) do { if (PF && tid < KLINES + VLINES) { const bool isk_ = tid < KLINES; const int l_ = isk_ ? tid : tid - KLINES; \
        const unsigned off_ = isk_ ? (unsigned)(((t) * 64 + l_ / LPR) * ldk + (l_ % LPR) * 64) * 2u : (unsigned)(((t) * 64 + (l_ >> 1)) * ldv + (l_ & 1) * 64) * 2u + (unsigned)((const char*)Vh - (const char*)Kh); \
        if (PFD) { unsigned m0s_; asm volatile("s_mov_b32 %0, m0\n\ts_mov_b32 m0, %3\n\tglobal_load_lds_dword %1, %2\n\ts_mov_b32 m0, %0" : "=&s"(m0s_) : "v"(off_), "s"(Kh), "i"(LDSCTL_OFF + 320 + 12288) : "memory"); }     \
        else asm volatile("global_load_dword %0, %1, %2" : "+v"(pf_dummy) : "v"(off_), "s"(Kh) : "memory"); } } while (0)
    const int ntile = nkeys / 64;
    if (tid >= 256) __builtin_amdgcn_s_setprio(1);
    PREFETCH(1); PREFETCH(2);
    SLOAD(0); SWRITE(0); __syncthreads();
    for (int j = 0; j < ntile; ++j) {
        const int cur = j & 1;
        PSUB_T0();
        if (EARLY && j + 1 < ntile) SLOAD((j + 1) * 64);
        f32x16 p0, p1;
#pragma unroll
        for (int r = 0; r < 16; ++r) { p0[r] = negM; p1[r] = negM; }
        const char* Kb = K_lds + cur * SHM_K;
#pragma unroll
        for (int d0 = 0; d0 < NQ; ++d0) {
            const bf16x8 b0 = *reinterpret_cast<const bf16x8*>(Kb + kra_(d0 & 3) + (d0 >> 2) * 128);
            const bf16x8 b1 = *reinterpret_cast<const bf16x8*>(Kb + kra_(d0 & 3) + (d0 >> 2) * 128 + 32 * DK * 2);
            p0 = __builtin_amdgcn_mfma_f32_32x32x16_bf16(b0, qr[d0], p0, 0, 0, 0);
            p1 = __builtin_amdgcn_mfma_f32_32x32x16_bf16(b1, qr[d0], p1, 0, 0, 0);
            if ((d0 & 3) == 3) SBAR();
        }
        PSUB_AT(1);
        if (!EARLY && j + 1 < ntile) SLOAD((j + 1) * 64);
        float ps = 0.f, ps1 = 0.f;
#pragma unroll
        for (int r = 0; r < 16; ++r) { p0[r] = __builtin_amdgcn_exp2f(p0[r]); p1[r] = __builtin_amdgcn_exp2f(p1[r]); ps += p0[r]; asm("" : "+v"(ps)); ps1 += p1[r]; asm("" : "+v"(ps1)); }
        l_reg += ps + ps1;
        bf16x8 pa0, pa1, pa2, pa3;
#define PK4(P, BASE, OUT) do { unsigned a0 = cvtpk(P[BASE + 0], P[BASE + 1]), a1 = cvtpk(P[BASE + 2], P[BASE + 3]);   \
        unsigned b0_ = cvtpk(P[BASE + 4], P[BASE + 5]), b1_ = cvtpk(P[BASE + 6], P[BASE + 7]);                              \
        auto r0 = __builtin_amdgcn_permlane32_swap(a0, b0_, false, false); auto r1 = __builtin_amdgcn_permlane32_swap(a1, b1_, false, false); \
        u32x4 w = {r0[0], r1[0], r0[1], r1[1]}; OUT = *reinterpret_cast<bf16x8*>(&w); } while (0)
        PK4(p0, 0, pa0); PK4(p0, 8, pa1); PK4(p1, 0, pa2); PK4(p1, 8, pa3);
#undef PK4
        PSUB_AT(2);
        const int vb = vb0 + cur * SHM_V;
        pv_one<0>(o[0], vb, pa0, pa1, pa2, pa3); pv_one<1>(o[1], vb, pa0, pa1, pa2, pa3); pv_one<2>(o[2], vb, pa0, pa1, pa2, pa3); pv_one<3>(o[3], vb, pa0, pa1, pa2, pa3);
        PSUB_AT(3);
        if (j + 1 < ntile) SWRITE(cur ^ 1);
        if (j + 3 < ntile) PREFETCH(j + 3);
        __syncthreads();
        PSUB_AT(4);
    }
    __builtin_amdgcn_s_setprio(0);
    if (PF && !PFD) asm volatile("s_waitcnt vmcnt(0)" : "+v"(pf_dummy) :: "memory");
#undef PREFETCH
#undef kra_
#undef SLOAD
#undef SWRITE
}
__device__ __forceinline__ void row_recip(float l_reg, float* li_l  , int r32, int hi, float (&rli)[16]) {
    { auto rr = __builtin_amdgcn_permlane32_swap(__float_as_uint(l_reg), __float_as_uint(l_reg), false, false); l_reg = __uint_as_float(rr[0]) + __uint_as_float(rr[1]); }
    if (hi == 0) li_l[r32] = l_reg;
    asm volatile("s_waitcnt lgkmcnt(0)" ::: "memory");
#pragma unroll
    for (int r = 0; r < 16; ++r) rli[r] = __builtin_amdgcn_rcpf(li_l[crow(r, hi)]);
}
#undef SBAR
}

constexpr int ATT_SCR_OFF = RING_BYTES - 2048;
__device__ __forceinline__ void mla_attn_unit(const Ptrs& P, unsigned char* lds, int b, int h, int qb, int ctxq, unsigned& sacc) {
    using namespace att;
    const int tid = threadIdx.x, wid = tid >> 6, lane = tid & 63, r32 = lane & 31, hi = lane >> 5;
    const bf16* Qm = (const bf16*)(P.ws + WS_QM); const bf16* Km = (const bf16*)(P.ws + WS_KM); const bf16* Vm = (const bf16*)(P.ws + WS_VM);
    const size_t u0 = (size_t)b * SU + (ctxq ? 0 : CTX) + qb * 256 + wid * 32;
    f32x16 o[4] = {}; float l_reg = 0.f;
    const float negM = -((const float*)(P.ws + WS_SCAL))[0];
    attn_loop<192, false, false>(Qm + (u0 + r32) * 768 + h * 192 + hi * 8, Km + (size_t)b * SU * 768 + h * 192, 768, Vm + (size_t)b * SU * 512 + h * 128, 512, ctxq ? CTX : SU, negM, o, l_reg, (char*)lds, sacc);
    float rli[16]; row_recip(l_reg, (float*)(lds + ATT_SCR_OFF) + wid * 64, r32, hi, rli);
    bf16* stg = (bf16*)lds + wid * 4096;
#pragma unroll
    for (int r = 0; r < 16; ++r) { const int orow = crow(r, hi);
#pragma unroll
        for (int d0 = 0; d0 < 4; ++d0) stg[orow * 128 + d0 * 32 + r32] = f2bf(o[d0][r] * rli[r]); }
    asm volatile("s_waitcnt lgkmcnt(0)" ::: "memory");
    bf16* mix = (bf16*)(P.ws + WS_MIX) + u0 * D + 512 + h * 128;
#pragma unroll
    for (int i = 0; i < 8; ++i) { const int row = i * 4 + (lane >> 4), ch = lane & 15; const u32x4 v = *(const u32x4*)(stg + row * 128 + ch * 8); *(u32x4*)(mix + (size_t)row * D + ch * 8) = v; }
    asm volatile("s_waitcnt lgkmcnt(0)" ::: "memory");
    __syncthreads();
}
__device__ __forceinline__ void diff_attn_unit(const Ptrs& P, unsigned char* lds, int b, int h, int qb, unsigned& sacc) {
    using namespace att;
    const int tid = threadIdx.x, wid = tid >> 6, lane = tid & 63, r32 = lane & 31, hi = lane >> 5;
    const bf16* Z = (const bf16*)(P.ws + WS_Z);
    const size_t u0 = (size_t)b * SU + CTX + qb * 256 + wid * 32;
    const float* scal = (const float*)(P.ws + WS_SCAL); const float negM = -scal[1], lam = scal[2], oml = scal[3];
    bf16* stg = (bf16*)lds + wid * 4096;
    float* li_l = (float*)(lds + ATT_SCR_OFF) + wid * 64;
    for (int part = 0; part < 2; ++part) {
        f32x16 o[4] = {}; float l_reg = 0.f;
        attn_loop<64, true, true, true>(Z + (u0 + r32) * ODD_IN + h * 128 + part * 64 + hi * 8, Z + 1024 + (size_t)b * SU * ODD_IN + h * 128 + part * 64, ODD_IN, Z + 2048 + (size_t)b * SU * ODD_IN + h * 128, ODD_IN, SU, negM, o, l_reg, (char*)lds + 65536, sacc);
        float rli[16]; row_recip(l_reg, li_l, r32, hi, rli);
#pragma unroll
        for (int r = 0; r < 16; ++r) { const int orow = crow(r, hi);
#pragma unroll
            for (int d0 = 0; d0 < 4; ++d0) { bf16* s = stg + orow * 128 + d0 * 32 + r32; const float on = o[d0][r] * rli[r];
                if (part == 0) *s = f2bf(on); else *s = f2bf(bf2f(*s) - lam * on); } }
        asm volatile("s_waitcnt lgkmcnt(0)" ::: "memory");
    }
    const float* sg = P.in[31];
    bf16* mix = (bf16*)(P.ws + WS_MIX) + u0 * D + h * 128;
#pragma unroll
    for (int i = 0; i < 8; ++i) { const int row = i * 4 + (lane >> 4), ch = lane & 15; const u32x4 v = *(const u32x4*)(stg + row * 128 + ch * 8);
        float f[8]; float ss = 0.f;
#pragma unroll
        for (int e = 0; e < 4; ++e) { f[2 * e] = __uint_as_float(v[e] << 16); f[2 * e + 1] = __uint_as_float(v[e] & 0xffff0000u); ss += f[2 * e] * f[2 * e] + f[2 * e + 1] * f[2 * e + 1]; }
        ss = sum16(ss);
        const float rs = rsqrtf(ss * (1.f / 128.f) + EPS) * oml;
        const f32x4 g0 = *(const f32x4*)(sg + ch * 8), g1 = *(const f32x4*)(sg + ch * 8 + 4);
        u32x4 w; w.x = att::cvtpk(f[0] * rs * g0[0], f[1] * rs * g0[1]); w.y = att::cvtpk(f[2] * rs * g0[2], f[3] * rs * g0[3]); w.z = att::cvtpk(f[4] * rs * g1[0], f[5] * rs * g1[1]); w.w = att::cvtpk(f[6] * rs * g1[2], f[7] * rs * g1[3]);
        *(u32x4*)(mix + (size_t)row * D + ch * 8) = w; }
    asm volatile("s_waitcnt lgkmcnt(0)" ::: "memory");
    __syncthreads();
}

__device__ __forceinline__ void ph_norm2_router(const Ptrs& P, unsigned char* lds, int layer, int latent_only) {
    const int tid = threadIdx.x, wid = tid >> 6, lane = tid & 63, fr = lane & 15, fq = lane >> 4, G = gridDim.x;
    float* RS = (float*)lds;
    float* LGP = RS + 256;
    int* TOPE = (int*)(LGP + 2 * 4096);
    float* TOPW = (float*)(TOPE + 512);
    int* TOPR = (int*)(TOPW + 512);
    int* LCNT = TOPR + 512;
    int* LBASE = LCNT + 32;
    int* GU0 = LBASE + 32;
    const float* gn = P.in[7] + layer * D;
    const float* rw = P.in[32] + (size_t)layer * D * NE; const float* rb = P.in[33] + layer * NE;
    const int cw0 = 128 * wid + 8 * fq;
    float wv0[4][8], wv1[4][8];
#pragma unroll
    for (int ks = 0; ks < 4; ++ks) { const float* wr = rw + (size_t)(cw0 + 32 * ks) * NE + fr;
#pragma unroll
        for (int j = 0; j < 8; ++j) { wv0[ks][j] = wr[j * NE]; wv1[ks][j] = wr[j * NE + 16]; } }
    const int NG = latent_only ? NB * (SEQ / 16) : R / 16;
    const int q0 = (int)(((long long)blockIdx.x * NG) / G), q1 = (int)(((long long)(blockIdx.x + 1) * NG) / G);
#define N2_U0(q) (latent_only ? ((q) >> 8) * SU + CTX + ((q) & 255) * 16 : (q) * 16)
#define N2_XLOAD(XR, q) do { const bf16* x_ = (const bf16*)(P.ws + WS_XB) + (size_t)(N2_U0(q) + fr) * D + cw0; _Pragma("unroll") for (int ks = 0; ks < 4; ++ks) XR[ks] = *(const u32x4*)(x_ + 32 * ks); } while (0)
#define N2_LO(w) __uint_as_float((w) << 16)
#define N2_HI(w) __uint_as_float((w) & 0xffff0000u)
#define N2_SS(XR, par) do { float ss = 0.f; _Pragma("unroll") for (int ks = 0; ks < 4; ++ks) { const u32x4 r = XR[ks]; \
            ss += N2_LO(r.x) * N2_LO(r.x) + N2_HI(r.x) * N2_HI(r.x) + N2_LO(r.y) * N2_LO(r.y) + N2_HI(r.y) * N2_HI(r.y) + N2_LO(r.z) * N2_LO(r.z) + N2_HI(r.z) * N2_HI(r.z) + N2_LO(r.w) * N2_LO(r.w) + N2_HI(r.w) * N2_HI(r.w); } \
        ss += lane_xor16(ss); ss += lane_xor32(ss); if (fq == 0) RS[(par) * 128 + wid * 16 + fr] = ss; } while (0)
    float A[4][8], Hs[4][8]; int mi_cur = -1;
    for (int qs = q0; qs < q1; qs += 8) {
        const int qe = qs + 8 < q1 ? qs + 8 : q1;
        __syncthreads();
        if (tid < 32) LCNT[tid] = 0;
        u32x4 xr[4], xn[4];
        N2_XLOAD(xr, qs);
        N2_SS(xr, 0);
        __syncthreads();
        for (int q = qs; q < qe; ++q) {
            const int gi = q - qs, par = gi & 1, u0 = N2_U0(q), u = u0 + fr;
            { const int b_ = u0 / SU, mi = (u0 % SU) < CTX ? 4 : b_;
              if (mi != mi_cur) { mi_cur = mi; const float* md = (const float*)(P.ws + WS_MOD) + (size_t)(layer * 5 + mi) * 6144 + 3 * D;
#pragma unroll
                  for (int ks = 0; ks < 4; ++ks) { const int c0 = cw0 + 32 * ks;
                      const f32x4 g0 = *(const f32x4*)(gn + c0), g1 = *(const f32x4*)(gn + c0 + 4), s0 = *(const f32x4*)(md + D + c0), s1 = *(const f32x4*)(md + D + c0 + 4), h0 = *(const f32x4*)(md + c0), h1 = *(const f32x4*)(md + c0 + 4);
#pragma unroll
                      for (int j = 0; j < 4; ++j) { A[ks][j] = g0[j] * (1.f + s0[j]); A[ks][4 + j] = g1[j] * (1.f + s1[j]); Hs[ks][j] = h0[j]; Hs[ks][4 + j] = h1[j]; } } } }
            if (q + 1 < qe) N2_XLOAD(xn, q + 1);
            if (tid == 0) GU0[gi] = u0;
            float tot = 0.f;
#pragma unroll
            for (int w = 0; w < 8; ++w) tot += RS[par * 128 + w * 16 + fr];
            const float rstd = rsqrtf(tot * (1.f / D) + EPS);
            f32x4 acc0 = {0.f, 0.f, 0.f, 0.f}, acc1 = {0.f, 0.f, 0.f, 0.f};
            bf16* h = (bf16*)(P.ws + WS_H) + (size_t)u * D + cw0;
#pragma unroll
            for (int ks = 0; ks < 4; ++ks) {
                float y[8];
                const u32x4 r = xr[ks]; const float xv[8] = {N2_LO(r.x), N2_HI(r.x), N2_LO(r.y), N2_HI(r.y), N2_LO(r.z), N2_HI(r.z), N2_LO(r.w), N2_HI(r.w)};
#pragma unroll
                for (int j = 0; j < 8; ++j) y[j] = xv[j] * rstd * A[ks][j] + Hs[ks][j];
                u32x4 w; w.x = g8::cvt_pk_bf16(y[0], y[1]); w.y = g8::cvt_pk_bf16(y[2], y[3]); w.z = g8::cvt_pk_bf16(y[4], y[5]); w.w = g8::cvt_pk_bf16(y[6], y[7]);
                *(u32x4*)(h + 32 * ks) = w;
#pragma unroll
                for (int j = 0; j < 8; ++j) {
                    acc0 = __builtin_amdgcn_mfma_f32_16x16x4f32(y[j], wv0[ks][j], acc0, 0, 0, 0);
                    acc1 = __builtin_amdgcn_mfma_f32_16x16x4f32(y[j], wv1[ks][j], acc1, 0, 0, 0);
                }
            }
            float* lgp = LGP + par * 4096;
#pragma unroll
            for (int j = 0; j < 4; ++j) { lgp[(wid * 16 + 4 * fq + j) * 32 + fr] = acc0[j]; lgp[(wid * 16 + 4 * fq + j) * 32 + 16 + fr] = acc1[j]; }
            if (q + 1 < qe) { N2_SS(xn, par ^ 1);
#pragma unroll
                for (int ks = 0; ks < 4; ++ks) xr[ks] = xn[ks]; }
            __syncthreads();
            {
                const int e = lane & 31, row = 2 * wid + (lane >> 5);
                float lg = rb[e];
#pragma unroll
                for (int w = 0; w < 8; ++w) lg += lgp[(w * 16 + row) * 32 + e];
                int te[4]; float tv[4];
#pragma unroll
                for (int k = 0; k < 4; ++k) {
                    float bv = lg; int bi = e;
#pragma unroll
                    for (int m = 0; m < 5; ++m) {
                        const float ov = m == 0 ? dpp_f<DPP_X1>(bv) : m == 1 ? dpp_f<DPP_X2>(bv) : m == 2 ? dpp_f<DPP_HM>(bv) : m == 3 ? dpp_f<DPP_RM>(bv) : lane_xor16(bv);
                        const int oi = m == 0 ? dpp_i<DPP_X1>(bi) : m == 1 ? dpp_i<DPP_X2>(bi) : m == 2 ? dpp_i<DPP_HM>(bi) : m == 3 ? dpp_i<DPP_RM>(bi) : lane_xor16i(bi);
                        const bool take = ov > bv || (ov == bv && oi < bi); bv = take ? ov : bv; bi = take ? oi : bi; }
                    te[k] = bi; tv[k] = bv; if (e == bi) lg = -3.4e38f;
                }
                float den = 0.f, w[4];
#pragma unroll
                for (int k = 0; k < 4; ++k) { w[k] = __expf(tv[k] - tv[0]); den += w[k]; }
                const float iden = 1.f / den;
                if (e < 4) { const int ek = e == 0 ? te[0] : e == 1 ? te[1] : e == 2 ? te[2] : te[3]; const float wk = (e == 0 ? w[0] : e == 1 ? w[1] : e == 2 ? w[2] : w[3]) * iden;
                    TOPE[gi * 64 + row * 4 + e] = ek; TOPW[gi * 64 + row * 4 + e] = wk; TOPR[gi * 64 + row * 4 + e] = atomicAdd(&LCNT[ek], 1); }
            }
        }
        __syncthreads();
        if (tid < 32) { int t2 = tid; asm volatile("" : "+v"(t2));
            const int c = LCNT[t2]; LBASE[t2] = c > 0 ? (int)atomicAdd((unsigned*)(P.ws + WS_CTL) + CW_CNT + layer * 64 + t2, (unsigned)c) : 0; }
        __syncthreads();
        int* tok_of = (int*)(P.ws + WS_TOKOF); int* pair_of = (int*)(P.ws + WS_PAIROF); float* gate_of = (float*)(P.ws + WS_GATEOF);
        for (int p = tid; p < (qe - qs) * 64; p += NT) {
            const int e = TOPE[p], rk = LBASE[e] + TOPR[p], ur = GU0[p >> 6] + ((p & 63) >> 2), k = p & 3;
            tok_of[(size_t)e * R + rk] = ur; pair_of[(size_t)e * R + rk] = ur * 4 + k; gate_of[(size_t)e * R + rk] = TOPW[p];
        }
    }
#undef N2_U0
#undef N2_XLOAD
#undef N2_SS
#undef N2_LO
#undef N2_HI
}

__device__ __forceinline__ void prefetch_resid(const Ptrs& P, int layer, LAS unsigned char* lds) {
    g8::DenseOrder S; S.init((const bf16*)P.ws, D, (const bf16*)P.ws, D, R, D, (int)gridDim.x, (int)blockIdx.x, layer);
    const int tid = threadIdx.x; LAS unsigned* dump = (LAS unsigned*)(lds + LDSCTL_OFF + 320 + 12288 + (tid >> 6) * 256);
#pragma unroll 1
    for (int i = 0; i < 2; ++i) {
        g8::Unit u; if (!S.next(i, u)) break;
        if (layer == 0) { const int b = u.pm / 17, jt = u.pm % 17;
            const char* t0 = (const char*)(jt == 0 ? P.in[2] + (size_t)(b * CTX) * D : P.in[0] + (size_t)(b * SEQ + (jt - 1) * 256) * D) + u.pn * 1024;
#pragma unroll
            for (int k = 0; k < 4; ++k) { const int l = tid + k * NT; __builtin_amdgcn_global_load_lds((const unsigned*)(t0 + (size_t)(l >> 3) * 4096 + (l & 7) * 128), dump, 4, 0, 0); } }
        else { const char* t0 = (const char*)((const bf16*)(P.ws + WS_XB) + (size_t)u.pm * 256 * D) + u.pn * 512;
#pragma unroll
            for (int k = 0; k < 2; ++k) { const int l = tid + k * NT; __builtin_amdgcn_global_load_lds((const unsigned*)(t0 + (size_t)(l >> 2) * 2048 + (l & 3) * 128), dump, 4, 0, 0); } }
    }
}

struct Args { Ptrs P; int ph_lo, ph_hi; };
constexpr int N_PHASES = 19;
__global__ void __launch_bounds__(NT, 2) mega(Args args) {
    extern __shared__ __attribute__((aligned(16))) unsigned char lds[];
    const Ptrs& P = args.P;
    unsigned char* ws = P.ws;
    const int tid = threadIdx.x, G = gridDim.x;
    const int vcu = (G % 8 == 0) ? ((int)blockIdx.x % 8) * (G / 8) + (int)blockIdx.x / 8 : (int)blockIdx.x;
    LAS unsigned char* LDSP = (LAS unsigned char*)lds;
    volatile LAS unsigned* MISC = (volatile LAS unsigned*)((LAS unsigned char*)lds + MISC_OFF);
    for (int u = tid; u < (LDS_BYTES - LDSCTL_OFF) / 4; u += NT) ((LAS unsigned*)((LAS unsigned char*)lds + LDSCTL_OFF))[u] = 0u;
    __syncthreads();
    XcdBarrier bar = xcd_barrier_post((unsigned*)(ws + WS_CTL) + CW_BAR, MISC + 8);
    const int lo = args.ph_lo, hi = args.ph_hi;
#ifndef PROBE_MASK
#define PROBE_MASK 0u
#endif
    unsigned long long pr_acc = 0ull, pr_t0 = 0ull; unsigned sub_acc = 0u;
#define IN(k) (lo <= (k) && (k) < hi)
#define IDLE_LAST(nwg) (((nwg) % G) != 0 && (int)blockIdx.x >= ((nwg) % G))
#define SEAM(k) do { if (IN(k) && IN((k) + 1)) xcd_barrier(bar); \
        if (PROBE_MASK) { const unsigned long long t_ = __builtin_amdgcn_s_memrealtime(); if ((PROBE_MASK >> (k)) & 1u) pr_acc += t_ - pr_t0; pr_t0 = t_; } } while (0)
    if (PROBE_MASK) pr_t0 = __builtin_amdgcn_s_memrealtime();
    const bf16* H = (const bf16*)(ws + WS_H); bf16* Z = (bf16*)(ws + WS_Z); const bf16* MIX = (const bf16*)(ws + WS_MIX);
    const bf16* Qm = (const bf16*)(ws + WS_QM); const bf16* Km = (const bf16*)(ws + WS_KM); const bf16* Vm = (const bf16*)(ws + WS_VM);

    if (IN(0)) { ph_prologue(P, lds, sub_acc); } SEAM(0);
    if (IN(1)) { ph_rows(P, 0, 0, 0, 0); } SEAM(1);
    if (IN(2)) { g8::DenseOrder S; S.init(H, D, (const bf16*)(ws + WS_WEVIN), D, R, EVEN_IN_P, G, (int)blockIdx.x, 0); g8::EpiStoreBf16 E{Z, EVEN_IN_P};
        g8::gemm_phase<g8::EpiStoreBf16, g8::DenseOrder, false, true>(LDSP, D, D, S, E);
        if (IDLE_LAST(68 * 7)) convert_deferred(P, lds, 4); } SEAM(2);
    if (IN(3)) {
        { g8::UpOrder S{(const char*)Z, (const char*)(ws + WS_WUQ), (const char*)(ws + WS_WUKV), G, (int)blockIdx.x}; g8::EpiStoreBf16 E{(bf16*)(ws + WS_QP), 1792};
          g8::gemm_phase<g8::EpiStoreBf16, g8::UpOrder, false, true>(LDSP, EVEN_IN_P, 384, S, E); }
        ph_lru(P, lds, 0, 0);
    } SEAM(3);
    if (IN(4)) { ph_mla_prep(P); } SEAM(4);
    if (IN(5)) {
        ph_lru(P, lds, 1, 128);
        for (int it = vcu; it < 256 + 16; it += G) {
            if (it < 256) mla_attn_unit(P, lds, it / 64, (it / 16) % 4, it % 16, 0, sub_acc);
            else { const int i2 = it - 256; mla_attn_unit(P, lds, i2 / 4, i2 % 4, 0, 1, sub_acc); }
        }
        prefetch_resid(P, 0, LDSP);
    } SEAM(5);
    if (IN(6)) { g8::DenseOrder S; S.init(MIX, D, (const bf16*)(ws + WS_WEVOUT), D, R, D, G, (int)blockIdx.x, 0); g8::EpiOut E{P, 0};
        g8::gemm_phase<g8::EpiOut, g8::DenseOrder, false, true>(LDSP, D, D, S, E);
        if (IDLE_LAST(68 * 4)) convert_deferred(P, lds, 4); } SEAM(6);
    if (IN(7)) { ph_norm2_router(P, lds, 0, 0); } SEAM(7);
    if (IN(8)) { g8::MoeOrder S{(const char*)H, (const char*)(ws + WS_WGU) + (size_t)0 * NE * 2048 * 1024 * 2, (const int*)(ws + WS_TOKOF), (size_t)2048 * 1024 * 2, 8, D, G, vcu, 1, nullptr};
        S.init((const unsigned*)(ws + WS_CTL) + CW_CNT + 0 * 64, (LAS int*)(LDSP + MISC_OFF + 256)); g8::EpiMoe1 E{P, 0}; g8::gemm_phase<g8::EpiMoe1, g8::MoeOrder, true, true>(LDSP, D, D, S, E); } SEAM(8);
    if (IN(9)) { g8::MoeOrder S{(const char*)(ws + WS_ACT), (const char*)(ws + WS_WDN) + (size_t)0 * NE * 1024 * 1024 * 2, nullptr, (size_t)1024 * 1024 * 2, 4, D, G, vcu, 0, nullptr};
        S.init((const unsigned*)(ws + WS_CTL) + CW_CNT + 0 * 64, (LAS int*)(LDSP + MISC_OFF + 256)); g8::EpiMoe2 E{P, 0}; g8::gemm_phase<g8::EpiMoe2, g8::MoeOrder, false, true>(LDSP, D, D, S, E);
        { const int rem_ = ((LAS int*)(LDSP + MISC_OFF + 256))[96] % G; if (rem_ != 0 && vcu >= rem_) convert_deferred(P, lds, 5); } } SEAM(9);
    if (IN(10)) { ph_rows(P, 0, 2, 0, 1); } SEAM(10);
    if (IN(11)) { g8::DenseOrder S; S.init(H, D, (const bf16*)(ws + WS_WODIN), D, R, ODD_IN, G, (int)blockIdx.x, 0);
        g8::EpiDiffIn E{Z, P.in[25], P.in[26], (const float*)(ws + WS_ROPE), (const float*)(ws + WS_ROPE) + SEQ * 64, (LAS float*)(LDSP + MISC_OFF + 1024)};
        g8::gemm_phase<g8::EpiDiffIn, g8::DenseOrder, false, true>(LDSP, D, D, S, E);
        if (IDLE_LAST(68 * 12)) convert_deferred(P, lds, 4); } SEAM(11);
    if (IN(13)) {
        for (int it = vcu; it < 512; it += G) { unsigned tq0 = 0u; if (it + G >= 512) prefetch_resid(P, 1, LDSP);
            if (PROBE_SUB == 5 && PROBE_SUBDK == 64) tq0 = (unsigned)__builtin_readcyclecounter();
            diff_attn_unit(P, lds, it / 128, (it / 16) % 8, it % 16, sub_acc);
            if (PROBE_SUB == 5 && PROBE_SUBDK == 64) sub_acc += (unsigned)__builtin_readcyclecounter() - tq0; }
    } SEAM(13);
    if (IN(14)) { g8::DenseOrder S; S.init(MIX, D, (const bf16*)(ws + WS_WODOUT), D, R, D, G, (int)blockIdx.x, 1); g8::EpiOut E{P, 1};
        g8::gemm_phase<g8::EpiOut, g8::DenseOrder, false, true>(LDSP, D, D, S, E); } SEAM(14);
    if (IN(15)) { ph_norm2_router(P, lds, 1, 1); convert_deferred(P, lds, 1 << 20); } SEAM(15);
    if (IN(16)) { g8::MoeOrder S{(const char*)H, (const char*)(ws + WS_WGU) + (size_t)1 * NE * 2048 * 1024 * 2, (const int*)(ws + WS_TOKOF), (size_t)2048 * 1024 * 2, 8, D, G, vcu, 1, nullptr};
        S.init((const unsigned*)(ws + WS_CTL) + CW_CNT + 1 * 64, (LAS int*)(LDSP + MISC_OFF + 256)); g8::EpiMoe1 E{P, 1}; g8::gemm_phase<g8::EpiMoe1, g8::MoeOrder, true, true>(LDSP, D, D, S, E); } SEAM(16);
    if (IN(17)) { g8::MoeOrder S{(const char*)(ws + WS_ACT), (const char*)(ws + WS_WDN) + (size_t)1 * NE * 1024 * 1024 * 2, nullptr, (size_t)1024 * 1024 * 2, 4, D, G, vcu, 0, nullptr};
        S.init((const unsigned*)(ws + WS_CTL) + CW_CNT + 1 * 64, (LAS int*)(LDSP + MISC_OFF + 256)); g8::EpiMoe2 E{P, 1}; g8::gemm_phase<g8::EpiMoe2, g8::MoeOrder, false, true>(LDSP, D, D, S, E); } SEAM(17);
    if (IN(18)) { ph_rows(P, 1, 2, 1, 0); }
    if (PROBE_MASK) { const unsigned long long t_ = __builtin_amdgcn_s_memrealtime(); if ((PROBE_MASK >> 18) & 1u) pr_acc += t_ - pr_t0;
        if (blockIdx.x == 0) { const unsigned long long t1 = t_ + 8ull * pr_acc; while (__builtin_amdgcn_s_memrealtime() < t1) __builtin_amdgcn_s_sleep(8); } }
    if (PROBE_SUB && (PROBE_SUBBLK < 0 || (int)blockIdx.x == PROBE_SUBBLK)) { const unsigned long long t1 = __builtin_readcyclecounter() + 8ull * (unsigned long long)sub_acc; while (__builtin_readcyclecounter() < t1) __builtin_amdgcn_s_sleep(8); }
#undef IN
#undef SEAM
}

#ifndef MK_PER_PHASE
#define MK_PER_PHASE 0
#endif
extern "C" void kernel_launch(void* const* d_in, const int* in_sizes, int n_in, void* d_out, int out_size, void* d_ws, size_t ws_size, hipStream_t stream) {
    static int grid = 0;
    if (grid == 0) {
        if (n_in != 38 || ws_size < WS_END) { fprintf(stderr, "kernel_launch: bad args n_in=%d ws=%zu need %zu\n", n_in, ws_size, (size_t)WS_END); grid = -1; return; }
        int dev = 0, cus = 0, per_cu = 0;
        if (hipGetDevice(&dev) != hipSuccess || hipDeviceGetAttribute(&cus, hipDeviceAttributeMultiprocessorCount, dev) != hipSuccess) { grid = -1; return; }
        if (hipFuncSetAttribute((const void*)mega, hipFuncAttributeMaxDynamicSharedMemorySize, LDS_BYTES) != hipSuccess) { fprintf(stderr, "kernel_launch: hipFuncSetAttribute failed\n"); grid = -1; return; }
        if (hipOccupancyMaxActiveBlocksPerMultiprocessor(&per_cu, (const void*)mega, NT, LDS_BYTES) != hipSuccess || per_cu < 1) { fprintf(stderr, "kernel_launch: occupancy query says %d blocks/CU\n", per_cu); grid = -1; return; }
        (void)hipGetLastError();
        grid = cus;
    }
    if (grid < 0) return;
    static_assert((CW_BAR + XCD_BAR_WORDS) * 4 <= 32768 && (CW_DEFQ + 1) * 4 <= 32768 && (CW_CNT + 128) * 4 <= 32768, "control words must lie inside the zeroed 32 KiB");
    if (hipMemsetAsync((char*)d_ws + WS_CTL, 0, 32768, stream) != hipSuccess) return;
    Args a; memset((void*)&a, 0, sizeof(a));
    for (int i = 0; i < 38; ++i) a.P.in[i] = (const float*)d_in[i];
    a.P.out = (float*)d_out; a.P.ws = (unsigned char*)d_ws;
#if MK_PER_PHASE
    for (int p = 0; p < N_PHASES; ++p) { a.ph_lo = p; a.ph_hi = p + 1; hipLaunchKernelGGL(mega, dim3(grid), dim3(NT), LDS_BYTES, stream, a); }
#else
    a.ph_lo = 0; a.ph_hi = N_PHASES;
    hipLaunchKernelGGL(mega, dim3(grid), dim3(NT), LDS_BYTES, stream, a);
#endif
    const hipError_t le = hipPeekAtLastError();
    if (le != hipSuccess) fprintf(stderr, "kernel_launch: launch failed: %s\n", hipGetErrorName(le));
}
```
